# Optimizing an MI355X kernel written in HIP

```python
import math
import jax
import jax.numpy as jnp
from jax import lax
import numpy as np

D_MODEL = 1024
BATCH = 16
SEQ = 2048
DEPTH = 4
DEC_BATCH = 8
DEC_SEQ = 64
PAST_LEN = 4096

CHUNK = 64
EPS = 1e-6
H_A = 4
DK_A = 128
DV_A = 128
CONV_A = 4
H_B = 4
DK_B = 64
DV_B = 128
GATE_RANK = 16
GATE_NORM = 16.0
N_MEM = 256
MEM_HEADS = 4
MEM_HD = D_MODEL // MEM_HEADS
D_FF = 2816
CONV_F = 3
QA = H_A * DK_A
VA = H_A * DV_A
QKV_A = 2 * QA + VA
KB = H_B * DK_B
VB = H_B * DV_B
IN_SIZES = (QKV_A, H_A, H_A, VA, KB, KB, VB, GATE_RANK, VB, D_MODEL, D_MODEL)
N_IN = sum(IN_SIZES)

kernel_name = 'hybrid_gdn_gla_stream_step'


def _rmsnorm(x, g):
    xf = x.astype(jnp.float32)
    y = xf * lax.rsqrt(jnp.mean(xf * xf, axis=-1, keepdims=True) + EPS)
    return (y * g.astype(jnp.float32)).astype(x.dtype)


def _l2norm(x):
    return x * lax.rsqrt(jnp.sum(x * x, axis=-1, keepdims=True) + EPS)


def _split_cols(x, sizes):
    out, start = [], 0
    for s in sizes:
        out.append(x[..., start:start + s])
        start += s
    return out


def _causal_dwconv(x, w, prev):
    width, L = w.shape[0], x.shape[1]
    xp = jnp.concatenate([prev.astype(x.dtype), x], axis=1)
    y = xp[:, 0:L] * w[0]
    for i in range(1, width):
        y = y + xp[:, i:i + L] * w[i]
    return y, xp[:, L:]


def _pad_seq(x, lp):
    pad = [(0, 0)] * x.ndim
    pad[1] = (0, lp - x.shape[1])
    return jnp.pad(x, pad)


def _to_chunks(x):
    b, lp, h = x.shape[:3]
    x = x.reshape((b, lp // CHUNK, CHUNK, h) + x.shape[3:])
    return jnp.moveaxis(x, (1, 3), (0, 2))


def _from_chunks(x):
    x = jnp.moveaxis(x, (0, 2), (1, 3))
    return x.reshape((x.shape[0], x.shape[1] * x.shape[2]) + x.shape[3:])


def _gated_delta_chunked(q, k, v, g, beta, s0):
    L, dk = q.shape[1], q.shape[-1]
    lp = -(-L // CHUNK) * CHUNK
    valid = (jnp.arange(lp) < L)[None, :, None]
    qc = _to_chunks(_pad_seq(q, lp))
    kc = _to_chunks(_pad_seq(k, lp))
    vc = _to_chunks(_pad_seq(v, lp))
    gc = _to_chunks(jnp.where(valid, _pad_seq(g, lp), 0.0))
    bc = _to_chunks(jnp.where(valid, _pad_seq(beta, lp), 0.0))
    G = jnp.cumsum(gc, axis=-1)
    tri = jnp.tril(jnp.ones((CHUNK, CHUNK), dtype=bool))
    strict = tri & ~jnp.eye(CHUNK, dtype=bool)
    decay = jnp.exp(jnp.where(tri, G[..., :, None] - G[..., None, :], -jnp.inf))
    kb = kc * bc[..., None]
    a_kk = jnp.where(strict, jnp.einsum('nbhcd,nbhsd->nbhcs', kb, kc) * decay, 0.0)
    eye = jnp.eye(CHUNK, dtype=q.dtype)
    rhs = jnp.concatenate([kb * jnp.exp(G)[..., None], vc * bc[..., None]], axis=-1)
    wu = lax.linalg.triangular_solve(eye + a_kk, rhs, left_side=True, lower=True, unit_diagonal=True)
    wc, uc = wu[..., :dk], wu[..., dk:]
    a_qk = jnp.einsum('nbhcd,nbhsd->nbhcs', qc, kc) * decay
    qg = qc * jnp.exp(G)[..., None]
    kg = kc * jnp.exp(G[..., -1:] - G)[..., None]
    dl = jnp.exp(G[..., -1])

    def step(s, inp):
        qg_n, kg_n, w_n, u_n, aqk_n, dl_n = inp
        v_new = u_n - jnp.einsum('bhcd,bhdv->bhcv', w_n, s)
        o = jnp.einsum('bhcd,bhdv->bhcv', qg_n, s) + jnp.einsum('bhcs,bhsv->bhcv', aqk_n, v_new)
        s = s * dl_n[..., None, None] + jnp.einsum('bhcd,bhcv->bhdv', kg_n, v_new)
        return s, o

    s, o = lax.scan(step, s0, (qg, kg, wc, uc, a_qk, dl))
    return _from_chunks(o)[:, :L], s


def _gla_chunked(q, k, v, log_a, s0):
    L = q.shape[1]
    lp = -(-L // CHUNK) * CHUNK
    valid = (jnp.arange(lp) < L)[None, :, None, None]
    qc = _to_chunks(_pad_seq(q, lp))
    kc = _to_chunks(_pad_seq(k, lp))
    vc = _to_chunks(_pad_seq(v, lp))
    lc = _to_chunks(jnp.where(valid, _pad_seq(log_a, lp), 0.0))
    G = jnp.cumsum(lc, axis=-2)
    tri = jnp.tril(jnp.ones((CHUNK, CHUNK), dtype=bool))
    qg = qc * jnp.exp(G)
    a_qk = jnp.where(tri, jnp.einsum('nbhcd,nbhsd->nbhcs', qg, kc * jnp.exp(-G)), 0.0)
    kg = kc * jnp.exp(G[..., -1:, :] - G)
    dl = jnp.exp(G[..., -1, :])

    def step(s, inp):
        qg_n, kg_n, v_n, aqk_n, dl_n = inp
        o = jnp.einsum('bhcd,bhdv->bhcv', qg_n, s) + jnp.einsum('bhcs,bhsv->bhcv', aqk_n, v_n)
        s = s * dl_n[..., None] + jnp.einsum('bhcd,bhcv->bhdv', kg_n, v_n)
        return s, o

    s, o = lax.scan(step, s0, (qg, kg, vc, a_qk, dl))
    return _from_chunks(o)[:, :L], s


def _mixer(h, p, l, conv_prev, s_a, s_b):
    f32 = jnp.float32
    B, L, _ = h.shape
    proj = h @ p['w_in'][l]
    qkv, b_raw, a_raw, z_a, q_b, k_b, v_b, g_lr, z_b, gt_a, gt_b = _split_cols(proj, IN_SIZES)
    qkv, conv_new = _causal_dwconv(qkv, p['conv_a_w'][l], conv_prev)
    qkv = jax.nn.silu(qkv.astype(f32))
    q_a = _l2norm(qkv[..., :QA].reshape(B, L, H_A, DK_A)) * (DK_A ** -0.5)
    k_a = _l2norm(qkv[..., QA:2 * QA].reshape(B, L, H_A, DK_A))
    v_a = qkv[..., 2 * QA:].reshape(B, L, H_A, DV_A)
    beta = jax.nn.sigmoid(b_raw.astype(f32))
    g_a = -jnp.exp(p['a_log'][l].astype(f32)) * jax.nn.softplus(a_raw.astype(f32) + p['dt_bias'][l].astype(f32))
    o_a, s_a_new = _gated_delta_chunked(q_a, k_a, v_a, g_a, beta, s_a.astype(f32))
    o_a = _rmsnorm(o_a, p['onorm_a'][l]) * jax.nn.silu(z_a.astype(f32).reshape(B, L, H_A, DV_A))
    q_b = q_b.astype(f32).reshape(B, L, H_B, DK_B) * (DK_B ** -0.5)
    k_b = k_b.astype(f32).reshape(B, L, H_B, DK_B)
    v_b = v_b.astype(f32).reshape(B, L, H_B, DV_B)
    log_a = jax.nn.log_sigmoid((g_lr @ p['w_gate_b2'][l] + p['b_gate_b'][l]).astype(f32)).reshape(B, L, H_B, DK_B) / GATE_NORM
    o_b, s_b_new = _gla_chunked(q_b, k_b, v_b, log_a, s_b.astype(f32))
    o_b = _rmsnorm(o_b, p['onorm_b'][l]) * jax.nn.silu(z_b.astype(f32).reshape(B, L, H_B, DV_B))
    y_a = o_a.reshape(B, L, VA).astype(h.dtype) @ p['w_out_a'][l]
    y_b = o_b.reshape(B, L, VB).astype(h.dtype) @ p['w_out_b'][l]
    merged = jax.nn.sigmoid(gt_a) * y_a + jax.nn.sigmoid(gt_b) * y_b
    return merged @ p['w_o'][l], conv_new, s_a_new, s_b_new


def _mem_kv(mem, g, w_k, w_v):
    B, M, _ = mem.shape
    m = _rmsnorm(mem, g)
    return (m @ w_k).reshape(B, M, MEM_HEADS, MEM_HD), (m @ w_v).reshape(B, M, MEM_HEADS, MEM_HD)


def _cross_attn(h, k, v, w_q, w_o):
    B, L, _ = h.shape
    q = (h @ w_q).reshape(B, L, MEM_HEADS, MEM_HD).astype(jnp.float32)
    s = jnp.einsum('blhd,bmhd->bhlm', q, k.astype(jnp.float32)) * (MEM_HD ** -0.5)
    a = jax.nn.softmax(s, axis=-1)
    o = jnp.einsum('bhlm,bmhd->blhd', a, v.astype(jnp.float32)).reshape(B, L, D_MODEL)
    return o.astype(h.dtype) @ w_o


def _conv_ffn(h, w_up, conv_w, conv_b, w_down, prev):
    u, new = _causal_dwconv(h @ w_up, conv_w, prev)
    u = u + conv_b
    gate, val = u[..., :D_FF], u[..., D_FF:]
    return (jax.nn.silu(gate) * val) @ w_down, new


def _trunk(x, mem_k, mem_v, conv_a_prev, s_gdn, s_gla, ffn_prev, p):
    conv_out, sa_out, sb_out, ffn_out = [], [], [], []
    for l in range(DEPTH):
        y, c_new, sa, sb = _mixer(_rmsnorm(x, p['norm_mix'][l]), p, l, conv_a_prev[l], s_gdn[l], s_gla[l])
        x = x + y.astype(x.dtype)
        x = x + _cross_attn(_rmsnorm(x, p['norm_mem'][l]), mem_k[l], mem_v[l], p['w_mq'][l], p['w_mo'][l]).astype(x.dtype)
        f, f_new = _conv_ffn(_rmsnorm(x, p['norm_ffn'][l]), p['w_up'][l], p['conv_f_w'][l], p['conv_f_b'][l], p['w_down'][l], ffn_prev[l])
        x = x + f.astype(x.dtype)
        conv_out.append(c_new)
        sa_out.append(sa)
        sb_out.append(sb)
        ffn_out.append(f_new)
    return (_rmsnorm(x, p['norm_final']), jnp.stack(conv_out), jnp.stack(sa_out), jnp.stack(sb_out), jnp.stack(ffn_out))


def setup_inputs(seed: int = 0) -> dict:
    key = jax.random.key(seed)
    ks = iter(jax.random.split(key, 48))

    def nrm(shape, scale):
        return jax.random.normal(next(ks), shape, jnp.float32) * scale

    def gain(shape):
        return 1.0 + nrm(shape, 0.02)

    a_log = jnp.log(jax.random.uniform(next(ks), (DEPTH, H_A), jnp.float32, 1.0, 16.0))
    dt = jnp.exp(jax.random.uniform(next(ks), (DEPTH, H_A), jnp.float32, math.log(1e-3), math.log(1e-1)))
    dt_bias = dt + jnp.log(-jnp.expm1(-dt))
    return {
        'x_prompt': nrm((BATCH, SEQ, D_MODEL), 1.0),
        'x_sample': nrm((DEC_BATCH, DEC_SEQ, D_MODEL), 1.0),
        'state_gdn': nrm((DEPTH, DEC_BATCH, H_A, DK_A, DV_A), 0.3),
        'state_gdn_conv': nrm((DEPTH, DEC_BATCH, CONV_A - 1, QKV_A), 1.0),
        'state_gla': nrm((DEPTH, DEC_BATCH, H_B, DK_B, DV_B), 0.5),
        'state_ffn_conv': nrm((DEPTH, DEC_BATCH, CONV_F - 1, 2 * D_FF), 1.0),
        'cache_mem_k': nrm((DEPTH, DEC_BATCH, N_MEM, MEM_HEADS, MEM_HD), 1.0),
        'cache_mem_v': nrm((DEPTH, DEC_BATCH, N_MEM, MEM_HEADS, MEM_HD), 1.0),
        'mem_prompt': nrm((BATCH, N_MEM, D_MODEL), 1.0),
        'norm_mix': gain((DEPTH, D_MODEL)),
        'w_in': nrm((DEPTH, D_MODEL, N_IN), D_MODEL ** -0.5),
        'conv_a_w': nrm((DEPTH, CONV_A, QKV_A), CONV_A ** -0.5),
        'a_log': a_log,
        'dt_bias': dt_bias,
        'onorm_a': gain((DEPTH, DV_A)),
        'w_gate_b2': nrm((DEPTH, GATE_RANK, KB), GATE_RANK ** -0.5),
        'b_gate_b': nrm((DEPTH, KB), 0.1),
        'onorm_b': gain((DEPTH, DV_B)),
        'w_out_a': nrm((DEPTH, VA, D_MODEL), VA ** -0.5),
        'w_out_b': nrm((DEPTH, VB, D_MODEL), VB ** -0.5),
        'w_o': nrm((DEPTH, D_MODEL, D_MODEL), D_MODEL ** -0.5),
        'norm_mem': gain((DEPTH, D_MODEL)),
        'norm_memkv': gain((DEPTH, D_MODEL)),
        'w_mq': nrm((DEPTH, D_MODEL, D_MODEL), D_MODEL ** -0.5),
        'w_mk': nrm((DEPTH, D_MODEL, D_MODEL), D_MODEL ** -0.5),
        'w_mv': nrm((DEPTH, D_MODEL, D_MODEL), D_MODEL ** -0.5),
        'w_mo': nrm((DEPTH, D_MODEL, D_MODEL), D_MODEL ** -0.5),
        'norm_ffn': gain((DEPTH, D_MODEL)),
        'w_up': nrm((DEPTH, D_MODEL, 2 * D_FF), D_MODEL ** -0.5),
        'conv_f_w': nrm((DEPTH, CONV_F, 2 * D_FF), CONV_F ** -0.5),
        'conv_f_b': nrm((DEPTH, 2 * D_FF), 0.02),
        'w_down': nrm((DEPTH, D_FF, D_MODEL), D_FF ** -0.5),
        'norm_final': gain((D_MODEL,)),
    }


def reference(x_prompt, x_sample, state_gdn, state_gdn_conv, state_gla, state_ffn_conv, cache_mem_k, cache_mem_v, mem_prompt, norm_mix, w_in, conv_a_w, a_log, dt_bias, onorm_a, w_gate_b2, b_gate_b, onorm_b, w_out_a, w_out_b, w_o, norm_mem, norm_memkv, w_mq, w_mk, w_mv, w_mo, norm_ffn, w_up, conv_f_w, conv_f_b, w_down, norm_final):
    p = dict(norm_mix=norm_mix, w_in=w_in, conv_a_w=conv_a_w, a_log=a_log, dt_bias=dt_bias, onorm_a=onorm_a, w_gate_b2=w_gate_b2, b_gate_b=b_gate_b, onorm_b=onorm_b, w_out_a=w_out_a, w_out_b=w_out_b, w_o=w_o, norm_mem=norm_mem, w_mq=w_mq, w_mo=w_mo, norm_ffn=norm_ffn, w_up=w_up, conv_f_w=conv_f_w, conv_f_b=conv_f_b, w_down=w_down, norm_final=norm_final)
    mk, mv = [], []
    for l in range(DEPTH):
        k_l, v_l = _mem_kv(mem_prompt, norm_memkv[l], w_mk[l], w_mv[l])
        mk.append(k_l)
        mv.append(v_l)
    mem_k_p = jnp.stack(mk)
    mem_v_p = jnp.stack(mv)
    B = x_prompt.shape[0]
    zc = jnp.zeros((DEPTH, B, CONV_A - 1, QKV_A), x_prompt.dtype)
    za = jnp.zeros((DEPTH, B, H_A, DK_A, DV_A), jnp.float32)
    zb = jnp.zeros((DEPTH, B, H_B, DK_B, DV_B), jnp.float32)
    zf = jnp.zeros((DEPTH, B, CONV_F - 1, 2 * D_FF), x_prompt.dtype)
    y_prompt, gdn_conv_p, gdn_p, gla_p, ffn_conv_p = _trunk(x_prompt, mem_k_p, mem_v_p, zc, za, zb, zf, p)
    y_sample, gdn_conv_s, gdn_s, gla_s, ffn_conv_s = _trunk(x_sample, cache_mem_k, cache_mem_v, state_gdn_conv, state_gdn, state_gla, state_ffn_conv, p)
    return (y_prompt, y_sample, gdn_p, gdn_conv_p, gla_p, ffn_conv_p, mem_k_p, mem_v_p, gdn_s, gdn_conv_s, gla_s, ffn_conv_s)
```

```cpp
#include <hip/hip_runtime.h>
#include <hip/hip_cooperative_groups.h>
#include <cstdint>
#include <cstdio>
namespace cg = cooperative_groups;

typedef unsigned short bf16_t;
typedef short bf16x8 __attribute__((ext_vector_type(8)));
typedef float f32x4 __attribute__((ext_vector_type(4)));
typedef float f32x2 __attribute__((ext_vector_type(2)));
typedef unsigned u32x2 __attribute__((ext_vector_type(2)));
typedef unsigned u32x4 __attribute__((ext_vector_type(4)));
#define DEV __device__ __forceinline__

constexpr int DM = 1024, TT = 33280, NCH = 520, LDP = 5632, LDE = 768;
constexpr int C_QA = 0, C_KA = 512, C_VA = 1024, C_ZA = 1536, C_QB = 2048, C_KB = 2304, C_VB = 2560, C_ZB = 3072, C_GA = 3584, C_GB = 4608;
constexpr int C_MRG = 0, C_PR = 1024, C_Q = 2048, C_O = 3072;
constexpr size_t O_Y = 0;
constexpr size_t O_GDN_P = 34078720ull;
constexpr size_t O_GDNC_P = O_GDN_P + 4194304ull;
constexpr size_t O_GLA_P = O_GDNC_P + 294912ull;
constexpr size_t O_FFNC_P = O_GLA_P + 2097152ull;
constexpr size_t O_MEMK = O_FFNC_P + 720896ull;
constexpr size_t O_MEMV = O_MEMK + 16777216ull;
constexpr size_t O_GDN_S = O_MEMV + 16777216ull;
constexpr size_t O_GDNC_S = O_GDN_S + 2097152ull;
constexpr size_t O_GLA_S = O_GDNC_S + 147456ull;
constexpr size_t O_FFNC_S = O_GLA_S + 1048576ull;
constexpr size_t al256(size_t x) { return (x + 255) & ~(size_t)255; }
constexpr size_t WS_WMIX = 0;
constexpr size_t WM_WIN = 0, WM_WSM = WM_WIN + 5632ull * 1024, WM_WOA = WM_WSM + 32 * 1024, WM_WOB = WM_WOA + 524288, WM_WO = WM_WOB + 524288,
                 WM_WMQ = WM_WO + 1048576, WM_WMK = WM_WMQ + 1048576, WM_WMV = WM_WMK + 1048576, WM_WMO = WM_WMV + 1048576, WM_END = WM_WMO + 1048576;
constexpr size_t WS_WFFN = al256(WS_WMIX + WM_END * 2);
constexpr size_t WF_UP = 0, WF_DN = 5632ull * 1024, WF_END = WF_DN + 1024ull * 2816;
constexpr size_t WS_XB = al256(WS_WFFN + WF_END * 2);
constexpr size_t WS_P = al256(WS_XB + (size_t)TT * 1024 * 2);
constexpr size_t WS_KV = al256(WS_P + (size_t)TT * LDP * 2);
constexpr size_t KV_BYTES = 2ull * 6144 * 1024 * 2;
constexpr size_t WS_MB = al256(WS_KV + KV_BYTES);
constexpr size_t WS_MRS = al256(WS_MB + 4096ull * 1024 * 2);
constexpr size_t WS_SSQ = al256(WS_MRS + 4096 * 4);
constexpr size_t WS_SC = al256(WS_SSQ + (size_t)TT * 16 * 4);
constexpr size_t WS_DL = al256(WS_SC + (size_t)TT * 32 * 4);
constexpr size_t WS_BG = al256(WS_DL + 520ull * 4 * 64 * 4);
constexpr size_t WS_TOTAL = al256(WS_BG + 520ull * 4 * 128 * 4);
constexpr int LDS_BYTES = 147456;
constexpr int NPH = 46;
#ifndef PH_HI
#define PH_HI NPH
#endif

struct Params { const float* in[33]; float* out; unsigned char* ws; int ph_lo, ph_hi; };

typedef __bf16 bf16x2_t __attribute__((ext_vector_type(2)));
DEV unsigned pk2(float lo, float hi) { f32x2 f = {lo, hi}; bf16x2_t v = __builtin_convertvector(f, bf16x2_t); return __builtin_bit_cast(unsigned, v); }
DEV float bf2f(bf16_t b) { return __uint_as_float(((unsigned)b) << 16); }
DEV float bflo(unsigned u) { return __uint_as_float(u << 16); }
DEV float bfhi(unsigned u) { return __uint_as_float(u & 0xffff0000u); }
DEV u32x2 pk4(f32x4 v) { u32x2 r; r.x = pk2(v[0], v[1]); r.y = pk2(v[2], v[3]); return r; }
DEV f32x4 unpk4(u32x2 u) { return (f32x4){bflo(u.x), bfhi(u.x), bflo(u.y), bfhi(u.y)}; }
DEV bf16x8 mk8(u32x2 a, u32x2 b) { u32x4 t = {a.x, a.y, b.x, b.y}; return __builtin_bit_cast(bf16x8, t); }
DEV float sigm(float x) { return 1.f / (1.f + __expf(-x)); }
DEV float silu(float x) { return x / (1.f + __expf(-x)); }
DEV float softplus(float x) { return x > 20.f ? x : __logf(1.f + __expf(x)); }
DEV float logsigmoid(float x) { return fminf(x, 0.f) - __logf(1.f + __expf(-fabsf(x))); }
DEV float row_rstd(const float* ssq, int row) {
    const f32x4 a = *(const f32x4*)(ssq + (size_t)row * 4), b = *(const f32x4*)(ssq + ((size_t)TT + row) * 4);
    const f32x4 c = *(const f32x4*)(ssq + ((size_t)2 * TT + row) * 4), d = *(const f32x4*)(ssq + ((size_t)3 * TT + row) * 4);
    float s = ((a[0] + a[1]) + (a[2] + a[3])) + ((b[0] + b[1]) + (b[2] + b[3])) + ((c[0] + c[1]) + (c[2] + c[3])) + ((d[0] + d[1]) + (d[2] + d[3]));
    return rsqrtf(s * (1.f / 1024.f) + 1e-6f);
}
DEV bf16x8 ldfragp(const bf16_t* base, int row, int stride, int k0, int fq) {
    const bf16_t* p = base + row * stride + k0 + 4 * fq;
    return mk8(*(const u32x2*)p, *(const u32x2*)(p + 16));
}
DEV bf16x8 ldfrag(const bf16_t* base, int row, int stride, int k0, int fq) {
    return *(const bf16x8*)(base + row * stride + k0 + 8 * fq);
}
#define MFMA16(a, b, c) __builtin_amdgcn_mfma_f32_16x16x32_bf16((a), (b), (c), 0, 0, 0)

constexpr int BM = 256, BK = 64, HALF = 128, HT = HALF * BK;
DEV int lds_byte(int r, int c) { int st = (r >> 4) * 2 + (c >> 5), rr = r & 15, cc = c & 31, ob = rr * 64 + cc * 2; return st * 1024 + (ob ^ (((ob >> 9) & 1) << 5)); }
DEV void stage_rc(int b, int& R, int& C) { int st = b / 1024, sb = b % 1024, swz = sb ^ (((sb >> 9) & 1) << 5); R = (st >> 1) * 16 + swz / 64; C = (st & 1) * 32 + (swz % 64) / 2; }

DEV void gemm_core(const bf16_t* __restrict__ A, int lda, const bf16_t* __restrict__ Bt, int ldb, int K, int brow, int bcol, f32x4 (&acc)[2][2][4][2], bf16_t* shm) {
#define SA(b, h) (shm + ((b) * 2 + (h)) * HT)
#define SB(b, h) (shm + (4 + (b) * 2 + (h)) * HT)
#define STAGE(P, BASE, LD, br, kt) do { const char* _gb = (const char*)((BASE) + (long)(br) * (LD) + (long)(kt) * BK); \
    const unsigned _vo = (unsigned)((sr0 * (int)(LD) + sc0) * 2); \
    for (int _i = 0; _i < 2; ++_i) { \
      __builtin_amdgcn_global_load_lds((const unsigned*)(_gb + (long)(_i * 128) * (LD) + _vo), (unsigned*)((char*)(P) + wbase + _i * 8192), 16, 0, 0); } } while (0)
#define LDA(dst, b, h) for (int m = 0; m < 4; ++m) for (int k = 0; k < 2; ++k) \
    dst[m][k] = *reinterpret_cast<const bf16x8*>((char*)SA(b, h) + lds_byte(wr * 64 + m * 16 + fr, k * 32 + fq * 8))
#define LDB(dst, b, h) for (int n = 0; n < 2; ++n) for (int k = 0; k < 2; ++k) \
    dst[n][k] = *reinterpret_cast<const bf16x8*>((char*)SB(b, h) + lds_byte(wc * 32 + n * 16 + fr, k * 32 + fq * 8))
#define MMA(ai, bj, At_, Bt_) do { __builtin_amdgcn_s_setprio(1); \
    for (int m = 0; m < 4; ++m) for (int n = 0; n < 2; ++n) for (int k = 0; k < 2; ++k) \
      acc[ai][bj][m][n] = __builtin_amdgcn_mfma_f32_16x16x32_bf16(Bt_[n][k], At_[m][k], acc[ai][bj][m][n], 0, 0, 0); \
    __builtin_amdgcn_s_setprio(0); } while (0)
#define WAIT_V(n) asm volatile("s_waitcnt vmcnt(" #n ")" ::: "memory")
#define WAIT_L(n) asm volatile("s_waitcnt lgkmcnt(" #n ")" ::: "memory")
#define BAR __builtin_amdgcn_s_barrier()
#define SCHED __builtin_amdgcn_sched_barrier(0)
    int tidx = threadIdx.x; asm volatile("" : "+v"(tidx));
    const int wid = __builtin_amdgcn_readfirstlane(tidx >> 6), lane = tidx & 63, wr = wid >> 2, wc = wid & 3, fr = lane & 15, fq = lane >> 4;
    const int wbase = wid * 1024;
    int sr0, sc0; stage_rc(tidx * 16, sr0, sc0);
#pragma unroll
    for (int a = 0; a < 2; ++a)
#pragma unroll
        for (int b = 0; b < 2; ++b)
#pragma unroll
            for (int m = 0; m < 4; ++m)
#pragma unroll
                for (int n = 0; n < 2; ++n) acc[a][b][m][n] = (f32x4){0.f, 0.f, 0.f, 0.f};
    bf16x8 At[4][2], B0[2][2], B1[2][2];
    const int nt = K / BK;
    STAGE(SB(0, 0), Bt, ldb, bcol, 0); STAGE(SA(0, 0), A, lda, brow, 0);
    STAGE(SB(0, 1), Bt, ldb, bcol + HALF, 0); STAGE(SA(0, 1), A, lda, brow + HALF, 0);
    if (wr == 1) BAR;
    WAIT_V(4); BAR;
    STAGE(SB(1, 0), Bt, ldb, bcol, 1); STAGE(SA(1, 0), A, lda, brow, 1); STAGE(SB(1, 1), Bt, ldb, bcol + HALF, 1);
    WAIT_V(6); BAR;
    for (int t = 0; t < nt - 2; t += 2) {
        LDB(B0, 0, 0); SCHED; LDA(At, 0, 0); STAGE(SA(1, 1), A, lda, brow + HALF, t + 1);
        WAIT_L(8); BAR; WAIT_L(0); MMA(0, 0, At, B0); BAR; SCHED;
        LDB(B1, 0, 1); STAGE(SB(0, 0), Bt, ldb, bcol, t + 2);
        BAR; WAIT_L(0); MMA(0, 1, At, B1); BAR;
        LDA(At, 0, 1); STAGE(SA(0, 0), A, lda, brow, t + 2);
        BAR; WAIT_L(0); MMA(1, 0, At, B0); BAR; SCHED;
        STAGE(SB(0, 1), Bt, ldb, bcol + HALF, t + 2);
        WAIT_V(6); BAR; MMA(1, 1, At, B1); BAR;
        LDB(B0, 1, 0); SCHED; LDA(At, 1, 0); STAGE(SA(0, 1), A, lda, brow + HALF, t + 2);
        WAIT_L(8); BAR; WAIT_L(0); MMA(0, 0, At, B0); BAR; SCHED;
        LDB(B1, 1, 1); STAGE(SB(1, 0), Bt, ldb, bcol, t + 3);
        BAR; WAIT_L(0); MMA(0, 1, At, B1); BAR;
        LDA(At, 1, 1); STAGE(SA(1, 0), A, lda, brow, t + 3);
        BAR; WAIT_L(0); MMA(1, 0, At, B0); BAR; SCHED;
        STAGE(SB(1, 1), Bt, ldb, bcol + HALF, t + 3);
        WAIT_V(6); BAR; MMA(1, 1, At, B1); BAR;
    }
    { LDB(B0, 0, 0); LDA(At, 0, 0); STAGE(SA(1, 1), A, lda, brow + HALF, nt - 1);
      BAR; WAIT_L(0); MMA(0, 0, At, B0); BAR;
      LDB(B1, 0, 1); BAR; WAIT_L(0); MMA(0, 1, At, B1); BAR;
      LDA(At, 0, 1); WAIT_V(4); BAR; WAIT_L(0); MMA(1, 0, At, B0); MMA(1, 1, At, B1); BAR; }
    { LDB(B0, 1, 0); LDA(At, 1, 0); WAIT_V(2); BAR; WAIT_L(0); MMA(0, 0, At, B0); BAR;
      LDB(B1, 1, 1); WAIT_V(0); BAR; WAIT_L(0); MMA(0, 1, At, B1); BAR;
      LDA(At, 1, 1); BAR; WAIT_L(0); MMA(1, 0, At, B0); MMA(1, 1, At, B1); BAR; }
    if (wr == 0) BAR;
#undef SA
#undef SB
}

typedef const float* const __attribute__((address_space(4)))* InTab;
struct Frame {
    InTab in; float* out; unsigned char* ws; unsigned char* lds;
    int tid, lane, wid, nb, bid;
};
#define REFRAME Frame F = F0; { int t_ = threadIdx.x; asm volatile("" : "+v"(t_)); F.tid = t_; F.lane = t_ & 63; unsigned char* w_ = F.ws; asm volatile("" : "+s"(w_)); F.ws = w_; float* o_ = F.out; asm volatile("" : "+s"(o_)); F.out = o_; InTab i_ = (InTab)__builtin_amdgcn_kernarg_segment_ptr(); asm volatile("" : "+s"(i_)); F.in = i_; int a_ = F.wid, b_ = F.bid, c_ = F.nb; asm volatile("" : "+s"(a_), "+s"(b_), "+s"(c_)); F.wid = a_; F.bid = b_; F.nb = c_; }

enum { EPI_PROJ = 0, EPI_UP, EPI_RESID, EPI_Q, EPI_MEMK, EPI_MEMV, EPI_OUTA, EPI_OUTB, EPI_SOFTMAX, EPI_ATTNO };
struct GDesc { const bf16_t* A; int lda; const bf16_t* Bt; int ldb; int K, brow, bcol, epi, orow, ocol, head, vai, vwr; };

DEV void cvt_mat(const Frame& F0, const float* src, int ldsrc, int K, int N, int wincols, const float* gain, bf16_t* dst) {
    REFRAME;
    float* T = (float*)F.lds;
    const int nkt = K / 64, nnt = N / 64, ntile = nkt * nnt;
    for (int t = F.bid; t < ntile; t += F.nb) {
        const int kt = t / nnt, ntl = t % nnt, k0 = kt * 64, n0 = ntl * 64;
        int coff = 0; if (wincols) coff = (n0 < 1536) ? 0 : (n0 < 3072 ? 8 : 24);
        __syncthreads();
#pragma unroll
        for (int i = 0; i < 2; ++i) {
            const int kr = (F.tid >> 4) + 32 * i, nc = (F.tid & 15) * 4;
            f32x4 v = *(const f32x4*)(src + (size_t)(k0 + kr) * ldsrc + n0 + coff + nc);
            const float g = gain ? gain[k0 + kr] : 1.f;
            T[kr * 65 + nc + 0] = v[0] * g; T[kr * 65 + nc + 1] = v[1] * g; T[kr * 65 + nc + 2] = v[2] * g; T[kr * 65 + nc + 3] = v[3] * g;
        }
        __syncthreads();
        const int n = F.tid >> 3, kc = (F.tid & 7) * 8;
        u32x4 w;
        w.x = pk2(T[(kc + 0) * 65 + n], T[(kc + 1) * 65 + n]); w.y = pk2(T[(kc + 2) * 65 + n], T[(kc + 3) * 65 + n]);
        w.z = pk2(T[(kc + 4) * 65 + n], T[(kc + 5) * 65 + n]); w.w = pk2(T[(kc + 6) * 65 + n], T[(kc + 7) * 65 + n]);
        *(u32x4*)(dst + (size_t)(n0 + n) * K + k0 + kc) = w;
    }
    __syncthreads();
}
DEV void cvt_mixer(const Frame& F0, int l) {
    REFRAME;
    InTab in = F.in;
    cvt_mat(F, in[10] + (size_t)l * 1024 * 5656, 5656, 1024, 5632, 1, in[9] + l * 1024, ((bf16_t*)(F.ws + WS_WMIX)) + WM_WIN);
    cvt_mat(F, in[18] + (size_t)l * 512 * 1024, 1024, 512, 1024, 0, nullptr, ((bf16_t*)(F.ws + WS_WMIX)) + WM_WOA);
    cvt_mat(F, in[19] + (size_t)l * 512 * 1024, 1024, 512, 1024, 0, nullptr, ((bf16_t*)(F.ws + WS_WMIX)) + WM_WOB);
    cvt_mat(F, in[20] + (size_t)l * 1048576, 1024, 1024, 1024, 0, nullptr, ((bf16_t*)(F.ws + WS_WMIX)) + WM_WO);
    cvt_mat(F, in[23] + (size_t)l * 1048576, 1024, 1024, 1024, 0, in[21] + l * 1024, ((bf16_t*)(F.ws + WS_WMIX)) + WM_WMQ);
    cvt_mat(F, in[24] + (size_t)l * 1048576, 1024, 1024, 1024, 0, in[22] + l * 1024, ((bf16_t*)(F.ws + WS_WMIX)) + WM_WMK);
    cvt_mat(F, in[25] + (size_t)l * 1048576, 1024, 1024, 1024, 0, in[22] + l * 1024, ((bf16_t*)(F.ws + WS_WMIX)) + WM_WMV);
    cvt_mat(F, in[26] + (size_t)l * 1048576, 1024, 1024, 1024, 0, nullptr, ((bf16_t*)(F.ws + WS_WMIX)) + WM_WMO);
    const float* win = in[10] + (size_t)l * 1024 * 5656; const float* g = in[9] + l * 1024;
    for (int i = F.bid * 512 + F.tid; i < 32 * 1024; i += F.nb * 512) {
        const int n = i >> 10, k = i & 1023;
        float v = 0.f;
        if (n < 8) v = win[(size_t)k * 5656 + 1536 + n] * g[k]; else if (n < 24) v = win[(size_t)k * 5656 + 3080 + (n - 8)] * g[k];
        ((bf16_t*)(F.ws + WS_WMIX))[WM_WSM + i] = (bf16_t)(pk2(v, 0.f) & 0xffff);
    }
}
DEV void cvt_ffn(const Frame& F, int l) {
    cvt_mat(F, F.in[28] + (size_t)l * 1024 * 5632, 5632, 1024, 5632, 0, F.in[27] + l * 1024, ((bf16_t*)(F.ws + WS_WFFN)) + WF_UP);
    cvt_mat(F, F.in[31] + (size_t)l * 2816 * 1024, 1024, 2816, 1024, 0, nullptr, ((bf16_t*)(F.ws + WS_WFFN)) + WF_DN);
}

DEV void phase0(const Frame& F0) {
    REFRAME;
    const int gw = F.bid * 8 + F.wid, nw = F.nb * 8, lane = F.lane;
    for (int row = gw; row < TT + 4096; row += nw) {
        const bool ismem = row >= TT;
        const float* src = ismem ? F.in[8] + (size_t)(row - TT) * 1024 : (row < 32768 ? F.in[0] + (size_t)row * 1024 : F.in[1] + (size_t)(row - 32768) * 1024);
        f32x4 v[4]; float s = 0.f;
#pragma unroll
        for (int i = 0; i < 4; ++i) { v[i] = *(const f32x4*)(src + lane * 16 + i * 4); s += v[i][0] * v[i][0] + v[i][1] * v[i][1] + v[i][2] * v[i][2] + v[i][3] * v[i][3]; }
        u32x4 w0, w1;
        w0.x = pk2(v[0][0], v[0][1]); w0.y = pk2(v[0][2], v[0][3]); w0.z = pk2(v[1][0], v[1][1]); w0.w = pk2(v[1][2], v[1][3]);
        w1.x = pk2(v[2][0], v[2][1]); w1.y = pk2(v[2][2], v[2][3]); w1.z = pk2(v[3][0], v[3][1]); w1.w = pk2(v[3][2], v[3][3]);
        s += __shfl_xor(s, 1); s += __shfl_xor(s, 2);
        if (!ismem) {
            float* X = F.out + (size_t)row * 1024 + lane * 16;
#pragma unroll
            for (int i = 0; i < 4; ++i) *(f32x4*)(X + i * 4) = v[i];
            bf16_t* xb = ((bf16_t*)(F.ws + WS_XB)) + (size_t)row * 1024 + lane * 16;
            *(u32x4*)xb = w0; *(u32x4*)(xb + 8) = w1;
            if ((lane & 3) == 0) ((float*)(F.ws + WS_SSQ))[((size_t)(lane >> 4) * TT + row) * 4 + ((lane >> 2) & 3)] = s;
        } else {
            const int mr = row - TT;
            bf16_t* mb = ((bf16_t*)(F.ws + WS_MB)) + (size_t)mr * 1024 + lane * 16;
            *(u32x4*)mb = w0; *(u32x4*)(mb + 8) = w1;
            s += __shfl_xor(s, 4); s += __shfl_xor(s, 8); s += __shfl_xor(s, 16); s += __shfl_xor(s, 32);
            if (lane == 0) ((float*)(F.ws + WS_MRS))[mr] = rsqrtf(s * (1.f / 1024.f) + 1e-6f);
        }
    }
    cvt_mixer(F, 0);
    cvt_ffn(F, 0);
}

DEV void small_proj(const Frame& F0) {
    REFRAME;
    const int lane = F.lane, fr = lane & 15, fq = lane >> 4, mt = F.wid & 3, nt = F.wid >> 2;
    for (int c = F.bid; c < NCH; c += F.nb) {
        const int row = c * 64 + mt * 16 + fr;
        const bf16_t* a = ((bf16_t*)(F.ws + WS_XB)) + (size_t)row * 1024 + 8 * fq;
        const bf16_t* b = ((bf16_t*)(F.ws + WS_WMIX)) + WM_WSM + (size_t)(nt * 16 + fr) * 1024 + 8 * fq;
        f32x4 acc = {0.f, 0.f, 0.f, 0.f};
#pragma unroll 4
        for (int k = 0; k < 32; ++k) acc = MFMA16(*(const bf16x8*)(b + k * 32), *(const bf16x8*)(a + k * 32), acc);
        const float rs = row_rstd(((float*)(F.ws + WS_SSQ)), row);
        *(f32x4*)(((float*)(F.ws + WS_SC)) + (size_t)row * 32 + nt * 16 + 4 * fq) = acc * rs;
    }
}

DEV void gemm_epilogue(const Frame& F0, const GDesc& d, int l, f32x4 (&acc)[2][2][4][2]) {
    REFRAME;
    int lane_ = F.lane; asm volatile("" : "+v"(lane_));
    const int wr = F.wid >> 2, wc = F.wid & 3, fr = lane_ & 15, fq = lane_ >> 4;
    float* red = (float*)(F.lds + 131072);
    if (d.epi == EPI_SOFTMAX) {
        float mx[2][4];
#pragma unroll
        for (int ai = 0; ai < 2; ++ai)
#pragma unroll
            for (int m = 0; m < 4; ++m) {
                float v = -3.0e38f;
#pragma unroll
                for (int bj = 0; bj < 2; ++bj)
#pragma unroll
                    for (int n = 0; n < 2; ++n) { const f32x4 x = acc[ai][bj][m][n]; v = fmaxf(v, fmaxf(fmaxf(x[0], x[1]), fmaxf(x[2], x[3]))); }
                v = fmaxf(v, __shfl_xor(v, 16)); v = fmaxf(v, __shfl_xor(v, 32));
                if (fq == 0) red[(ai * 128 + wr * 64 + m * 16 + fr) * 4 + wc] = v;
            }
        __syncthreads();
#pragma unroll
        for (int ai = 0; ai < 2; ++ai)
#pragma unroll
            for (int m = 0; m < 4; ++m) {
                const f32x4 r4 = *(const f32x4*)(red + (ai * 128 + wr * 64 + m * 16 + fr) * 4);
                const float rm = fmaxf(fmaxf(r4[0], r4[1]), fmaxf(r4[2], r4[3]));
                mx[ai][m] = rm; float s = 0.f;
#pragma unroll
                for (int bj = 0; bj < 2; ++bj)
#pragma unroll
                    for (int n = 0; n < 2; ++n) { f32x4 x = acc[ai][bj][m][n];
#pragma unroll
                        for (int j = 0; j < 4; ++j) { x[j] = __expf(x[j] - rm); s += x[j]; }
                        acc[ai][bj][m][n] = x; }
                s += __shfl_xor(s, 16); s += __shfl_xor(s, 32);
                if (fq == 0) red[1024 + (ai * 128 + wr * 64 + m * 16 + fr) * 4 + wc] = s;
            }
        (void)mx;
        __syncthreads();
#pragma unroll
        for (int ai = 0; ai < 2; ++ai)
#pragma unroll
            for (int m = 0; m < 4; ++m) {
                const f32x4 r4 = *(const f32x4*)(red + 1024 + (ai * 128 + wr * 64 + m * 16 + fr) * 4);
                const float inv = 1.f / ((r4[0] + r4[1]) + (r4[2] + r4[3]));
                const bool valid = d.vai < 0 || (d.vai == ai && d.vwr == wr);
                const int row = d.orow + ai * 128 + wr * 64 + m * 16 + fr;
                if (valid) {
#pragma unroll
                    for (int bj = 0; bj < 2; ++bj)
#pragma unroll
                        for (int n = 0; n < 2; ++n) {
                            const int col = bj * 128 + wc * 32 + n * 16 + fq * 4;
                            *(u32x2*)(((bf16_t*)(F.ws + WS_P)) + (size_t)row * LDP + C_PR + d.head * 256 + col) = pk4(acc[ai][bj][m][n] * inv);
                        }
                }
            }
        __syncthreads();
        return;
    }
#pragma unroll
    for (int ai = 0; ai < 2; ++ai)
#pragma unroll
        for (int m = 0; m < 4; ++m) {
            const int row = d.orow + ai * 128 + wr * 64 + m * 16 + fr;
            float rs = 1.f, ss = 0.f;
            if (d.epi == EPI_PROJ || d.epi == EPI_UP || d.epi == EPI_Q) rs = row_rstd(((float*)(F.ws + WS_SSQ)), row);
            if (d.epi == EPI_Q) rs *= 0.0625f;
            if (d.epi == EPI_MEMK) rs = ((float*)(F.ws + WS_MRS))[row];
#pragma unroll
            for (int bj = 0; bj < 2; ++bj)
#pragma unroll
                for (int n = 0; n < 2; ++n) {
                    const int col = d.ocol + bj * 128 + wc * 32 + n * 16 + fq * 4;
                    f32x4 v = acc[ai][bj][m][n];
                    switch (d.epi) {
                    case EPI_PROJ: case EPI_UP: {
                        v = v * rs; const u32x2 w = pk4(v);
                        *(u32x2*)(((bf16_t*)(F.ws + WS_P)) + (size_t)row * LDP + col) = w;
                        const int nh = d.epi == EPI_PROJ ? 3 : 2, width = d.epi == EPI_PROJ ? 1536 : 5632;
                        if (m == 3 && fr >= 16 - nh && (d.epi == EPI_UP || col < 1536)) {
                            const int chunk = row >> 6, hr = fr - (16 - nh);
                            bf16_t* halo = d.epi == EPI_PROJ ? ((bf16_t*)(F.ws + WS_KV)) : ((bf16_t*)(F.ws + WS_KV));
                            *(u32x2*)(halo + ((size_t)chunk * nh + hr) * width + col) = w;
                            if (chunk >= 512 || (chunk & 31) == 31) {
                                float* o;
                                if (d.epi == EPI_PROJ) o = chunk < 512 ? F.out + O_GDNC_P + ((size_t)(l * 16 + (chunk >> 5)) * 3 + hr) * 1536 + col
                                                                       : F.out + O_GDNC_S + ((size_t)(l * 8 + (chunk - 512)) * 3 + hr) * 1536 + col;
                                else o = chunk < 512 ? F.out + O_FFNC_P + ((size_t)(l * 16 + (chunk >> 5)) * 2 + hr) * 5632 + col
                                                     : F.out + O_FFNC_S + ((size_t)(l * 8 + (chunk - 512)) * 2 + hr) * 5632 + col;
                                *(f32x4*)o = v;
                            }
                        }
                    } break;
                    case EPI_RESID: {
                        float* X = F.out + (size_t)row * 1024 + col;
                        f32x4 x = *(const f32x4*)X; x = x + v; *(f32x4*)X = x;
                        *(u32x2*)(((bf16_t*)(F.ws + WS_XB)) + (size_t)row * 1024 + col) = pk4(x);
                        ss += (x[0] * x[0] + x[1] * x[1]) + (x[2] * x[2] + x[3] * x[3]);
                    } break;
                    case EPI_Q: *(u32x2*)(((bf16_t*)(F.ws + WS_P)) + (size_t)row * LDP + C_Q + col) = pk4(v * rs); break;
                    case EPI_MEMK: {
                        v = v * rs;
                        *(f32x4*)(F.out + O_MEMK + ((size_t)l * 4096 + row) * 1024 + col) = v;
                        *(u32x2*)(((bf16_t*)(F.ws + WS_KV)) + (size_t)row * 1024 + col) = pk4(v);
                    } break;
                    case EPI_MEMV: {
                        const f32x4 r4 = *(const f32x4*)(((float*)(F.ws + WS_MRS)) + col);
                        v = v * r4;
                        float* o = F.out + O_MEMV + ((size_t)l * 4096 + col) * 1024 + row;
                        o[0] = v[0]; o[1024] = v[1]; o[2048] = v[2]; o[3072] = v[3];
                        const int b = col >> 8, h = row >> 8;
                        *(u32x2*)(((bf16_t*)(F.ws + WS_KV + 6144ull * 1024 * 2)) + ((size_t)(b * 4 + h) * 256 + (row & 255)) * 256 + (col & 255)) = pk4(v);
                    } break;
                    case EPI_OUTA: {
                        const f32x4 g = unpk4(*(const u32x2*)(((bf16_t*)(F.ws + WS_P)) + (size_t)row * LDP + C_GA + col));
                        f32x4 o; for (int j = 0; j < 4; ++j) o[j] = sigm(g[j]) * v[j];
                        *(u32x2*)(((bf16_t*)(F.ws + WS_P)) + (size_t)row * LDP + C_MRG + col) = pk4(o);
                    } break;
                    case EPI_OUTB: {
                        const f32x4 g = unpk4(*(const u32x2*)(((bf16_t*)(F.ws + WS_P)) + (size_t)row * LDP + C_GB + col));
                        f32x4 o = unpk4(*(const u32x2*)(((bf16_t*)(F.ws + WS_P)) + (size_t)row * LDP + C_MRG + col));
                        for (int j = 0; j < 4; ++j) o[j] += sigm(g[j]) * v[j];
                        *(u32x2*)(((bf16_t*)(F.ws + WS_P)) + (size_t)row * LDP + C_MRG + col) = pk4(o);
                    } break;
                    case EPI_ATTNO: {
                        const bool valid = d.vai < 0 || (d.vai == ai && d.vwr == wr);
                        if (valid) *(u32x2*)(((bf16_t*)(F.ws + WS_P)) + (size_t)row * LDP + C_O + d.head * 256 + col) = pk4(v);
                    } break;
                    default: break;
                    }
                }
            if (d.epi == EPI_RESID) {
                ss += __shfl_xor(ss, 16); ss += __shfl_xor(ss, 32);
                if (fq == 0) ((float*)(F.ws + WS_SSQ))[((size_t)(d.ocol >> 8) * TT + row) * 4 + wc] = ss;
            }
        }
}

enum { GP_IN = 0, GP_OUT, GP_WO, GP_MQ, GP_ATTN, GP_MO, GP_UP, GP_DOWN };
DEV void gemm_phase(const Frame& F0, int kind, int l) {
    REFRAME;
    int nunits = 0;
    switch (kind) { case GP_IN: case GP_UP: nunits = 130 * 22; break; case GP_OUT: nunits = 520 + 128; break; case GP_ATTN: nunits = 512 + 32; break; default: nunits = 520; }
    f32x4 acc[2][2][4][2];
    for (int u = F.bid; u < nunits; u += F.nb) {
        const int nsub = (kind == GP_ATTN || (kind == GP_OUT && u < 520)) ? 2 : 1;
        for (int sub = 0; sub < nsub; ++sub) {
            GDesc d; d.vai = -1; d.vwr = 0; d.head = 0;
            switch (kind) {
            case GP_IN: { const int pm = u / 22, pn = u % 22; d.A = ((bf16_t*)(F.ws + WS_XB)); d.lda = 1024; d.Bt = ((bf16_t*)(F.ws + WS_WMIX)) + WM_WIN; d.ldb = 1024; d.K = 1024; d.brow = pm * 256; d.bcol = pn * 256; d.epi = EPI_PROJ; d.orow = d.brow; d.ocol = d.bcol; } break;
            case GP_UP: { const int pm = u / 22, pn = u % 22; d.A = ((bf16_t*)(F.ws + WS_XB)); d.lda = 1024; d.Bt = ((bf16_t*)(F.ws + WS_WFFN)) + WF_UP; d.ldb = 1024; d.K = 1024; d.brow = pm * 256; d.bcol = pn * 256; d.epi = EPI_UP; d.orow = d.brow; d.ocol = d.bcol; } break;
            case GP_OUT:
                if (u < 520) { const int pm = u >> 2, pn = u & 3; d.A = ((bf16_t*)(F.ws + WS_P)) + (sub == 0 ? C_ZA : C_ZB); d.lda = LDP; d.Bt = ((bf16_t*)(F.ws + WS_WMIX)) + (sub == 0 ? WM_WOA : WM_WOB); d.ldb = 512; d.K = 512;
                               d.brow = pm * 256; d.bcol = pn * 256; d.epi = sub == 0 ? EPI_OUTA : EPI_OUTB; d.orow = d.brow; d.ocol = d.bcol; }
                else if (u < 520 + 64) { const int v = u - 520, pm = v >> 2, pn = v & 3; d.A = ((bf16_t*)(F.ws + WS_MB)); d.lda = 1024; d.Bt = ((bf16_t*)(F.ws + WS_WMIX)) + WM_WMK; d.ldb = 1024; d.K = 1024; d.brow = pm * 256; d.bcol = pn * 256; d.epi = EPI_MEMK; d.orow = d.brow; d.ocol = d.bcol; }
                else { const int v = u - 584, pm = v & 3, pn = v >> 2; d.A = ((bf16_t*)(F.ws + WS_WMIX)) + WM_WMV; d.lda = 1024; d.Bt = ((bf16_t*)(F.ws + WS_MB)); d.ldb = 1024; d.K = 1024; d.brow = pm * 256; d.bcol = pn * 256; d.epi = EPI_MEMV; d.orow = d.brow; d.ocol = d.bcol; }
                break;
            case GP_WO: { const int pm = u >> 2, pn = u & 3; d.A = ((bf16_t*)(F.ws + WS_P)) + C_MRG; d.lda = LDP; d.Bt = ((bf16_t*)(F.ws + WS_WMIX)) + WM_WO; d.ldb = 1024; d.K = 1024; d.brow = pm * 256; d.bcol = pn * 256; d.epi = EPI_RESID; d.orow = d.brow; d.ocol = d.bcol; } break;
            case GP_MQ: { const int pm = u >> 2, pn = u & 3; d.A = ((bf16_t*)(F.ws + WS_XB)); d.lda = 1024; d.Bt = ((bf16_t*)(F.ws + WS_WMIX)) + WM_WMQ; d.ldb = 1024; d.K = 1024; d.brow = pm * 256; d.bcol = pn * 256; d.epi = EPI_Q; d.orow = d.brow; d.ocol = d.bcol; } break;
            case GP_MO: { const int pm = u >> 2, pn = u & 3; d.A = ((bf16_t*)(F.ws + WS_P)) + C_O; d.lda = LDP; d.Bt = ((bf16_t*)(F.ws + WS_WMIX)) + WM_WMO; d.ldb = 1024; d.K = 1024; d.brow = pm * 256; d.bcol = pn * 256; d.epi = EPI_RESID; d.orow = d.brow; d.ocol = d.bcol; } break;
            case GP_DOWN: { const int pm = u >> 2, pn = u & 3; d.A = ((bf16_t*)(F.ws + WS_P)); d.lda = LDP; d.Bt = ((bf16_t*)(F.ws + WS_WFFN)) + WF_DN; d.ldb = 2816; d.K = 2816; d.brow = pm * 256; d.bcol = pn * 256; d.epi = EPI_RESID; d.orow = d.brow; d.ocol = d.bcol; } break;
            case GP_ATTN: {
                int pm, h, b;
                if (u < 512) { pm = u >> 2; h = u & 3; b = pm >> 3; }
                else { const int v = u - 512; h = v & 3; const int bi = (v >> 2) & 3, t = v >> 4; pm = 128 + t; b = 16 + 4 * t + bi; d.vai = bi >> 1; d.vwr = bi & 1; }
                d.head = h; d.brow = pm * 256; d.orow = d.brow; d.ocol = 0; d.K = 256; d.bcol = 0;
                if (sub == 0) { d.A = ((bf16_t*)(F.ws + WS_P)) + C_Q + h * 256; d.lda = LDP; d.Bt = ((bf16_t*)(F.ws + WS_KV)) + (size_t)b * 256 * 1024 + h * 256; d.ldb = 1024; d.epi = EPI_SOFTMAX; }
                else { d.A = ((bf16_t*)(F.ws + WS_P)) + C_PR + h * 256; d.lda = LDP; d.Bt = ((bf16_t*)(F.ws + WS_KV + 6144ull * 1024 * 2)) + (size_t)(b * 4 + h) * 65536; d.ldb = 256; d.epi = EPI_ATTNO; }
            } break;
            }
            gemm_core(d.A, d.lda, d.Bt, d.ldb, d.K, d.brow, d.bcol, acc, (bf16_t*)F.lds);
            gemm_epilogue(F, d, l, acc);
            if (nsub == 2) { __threadfence(); __syncthreads(); }
        }
    }
}

DEV void sample_kv(const Frame& F0, int l) {
    REFRAME;
    const float* ck = F.in[6] + (size_t)l * 2097152; const float* cv = F.in[7] + (size_t)l * 2097152;
    for (int i = F.bid * 512 + F.tid; i < 262144; i += F.nb * 512) {
        const f32x4 a = *(const f32x4*)(ck + (size_t)i * 8), b = *(const f32x4*)(ck + (size_t)i * 8 + 4);
        u32x4 w; w.x = pk2(a[0], a[1]); w.y = pk2(a[2], a[3]); w.z = pk2(b[0], b[1]); w.w = pk2(b[2], b[3]);
        *(u32x4*)(((bf16_t*)(F.ws + WS_KV)) + 4096ull * 1024 + (size_t)i * 8) = w;
        const int dd = i & 255, m8 = (i >> 8) & 31, h = (i >> 13) & 3, bb = i >> 15;
        const float* s = cv + ((size_t)(bb * 256 + m8 * 8) * 4 + h) * 256 + dd;
        u32x4 x; x.x = pk2(s[0], s[1024]); x.y = pk2(s[2048], s[3072]); x.z = pk2(s[4096], s[5120]); x.w = pk2(s[6144], s[7168]);
        *(u32x4*)(((bf16_t*)(F.ws + WS_KV + 6144ull * 1024 * 2)) + ((size_t)((16 + bb) * 4 + h) * 256 + dd) * 256 + m8 * 8) = x;
    }
}

DEV void g1_gdn(const Frame& F0, int l, int c, int h) {
    REFRAME;
    float* Fq = (float*)F.lds;
    bf16_t* VS = (bf16_t*)(F.lds + 66560);
    bf16_t* QN = (bf16_t*)(F.lds + 82944);
    bf16_t* KN = (bf16_t*)(F.lds + 100352);
    float* AM = (float*)(F.lds + 117760);
    float* sB = (float*)(F.lds + 135168); float* sG = sB + 64; float* sRQ = sB + 128; float* sRK = sB + 192;
    const int tid = F.tid, lane = F.lane, t0 = c * 64;
    const bool first = c >= 512 || (c & 31) == 0; const bool sample = c >= 512;
    __syncthreads();
    if (F.wid == 0) {
        const int t = t0 + lane;
        const float braw = ((float*)(F.ws + WS_SC))[(size_t)t * 32 + h], araw = ((float*)(F.ws + WS_SC))[(size_t)t * 32 + 4 + h];
        const float beta = sigm(braw);
        float g = -__expf(F.in[12][l * 4 + h]) * softplus(araw + F.in[13][l * 4 + h]);
#pragma unroll
        for (int off = 1; off < 64; off <<= 1) { const float n = __shfl_up(g, off); if (lane >= off) g += n; }
        sB[lane] = beta; sG[lane] = g;
        ((float*)(F.ws + WS_BG))[((size_t)c * 4 + h) * 128 + lane] = beta; ((float*)(F.ws + WS_BG))[((size_t)c * 4 + h) * 128 + 64 + lane] = g;
    }
    __syncthreads();
    const float* cw = F.in[11] + (size_t)l * 4 * 1536;
    for (int idx = tid; idx < 64 * 192; idx += 512) {
        const int r = idx / 192, cp = idx % 192, which = cp >> 6, cc = (cp & 63) * 2, pcol = which * 512 + h * 128 + cc;
        float a0 = 0.f, a1 = 0.f;
#pragma unroll
        for (int i = 0; i < 4; ++i) {
            const int src = r - 3 + i; float x0 = 0.f, x1 = 0.f;
            if (src >= 0) { const unsigned u = *(const unsigned*)(((bf16_t*)(F.ws + WS_P)) + (size_t)(t0 + src) * LDP + pcol); x0 = bflo(u); x1 = bfhi(u); }
            else if (!first) { const unsigned u = *(const unsigned*)(((bf16_t*)(F.ws + WS_KV)) + ((size_t)(c - 1) * 3 + (src + 3)) * 1536 + pcol); x0 = bflo(u); x1 = bfhi(u); }
            else if (sample) { const f32x2 f = *(const f32x2*)(F.in[3] + ((size_t)(l * 8 + (c - 512)) * 3 + (src + 3)) * 1536 + pcol); x0 = f[0]; x1 = f[1]; }
            const f32x2 w = *(const f32x2*)(cw + i * 1536 + pcol);
            a0 += w[0] * x0; a1 += w[1] * x1;
        }
        a0 = silu(a0); a1 = silu(a1);
        if (which < 2) { *(f32x2*)(Fq + r * 260 + which * 128 + cc) = (f32x2){a0, a1}; }
        else { const float be = sB[r]; *(unsigned*)(VS + r * 128 + cc) = pk2(a0 * be, a1 * be); }
    }
    __syncthreads();
    {
        const int r = tid >> 3, j = tid & 7; const float* p = Fq + r * 260 + j * 32; float s = 0.f;
#pragma unroll
        for (int i = 0; i < 32; ++i) s += p[i] * p[i];
        s += __shfl_xor(s, 1); s += __shfl_xor(s, 2);
        if ((j & 3) == 0) { if (j == 0) sRQ[r] = rsqrtf(s + 1e-6f) * 0.08838834764831845f; else sRK[r] = rsqrtf(s + 1e-6f); }
    }
    __syncthreads();
    for (int idx = tid; idx < 64 * 64; idx += 512) {
        const int r = idx >> 6, c4 = (idx & 63) * 4; const bool isq = c4 < 128;
        f32x4 v = *(const f32x4*)(Fq + r * 260 + c4); v = v * (isq ? sRQ[r] : sRK[r]);
        const u32x2 w = pk4(v);
        if (isq) { *(u32x2*)(QN + r * 136 + c4) = w; *(u32x2*)(((bf16_t*)(F.ws + WS_P)) + (size_t)(t0 + r) * LDP + C_QA + h * 128 + c4) = w; }
        else { *(u32x2*)(KN + r * 136 + c4 - 128) = w; *(u32x2*)(((bf16_t*)(F.ws + WS_P)) + (size_t)(t0 + r) * LDP + C_KA + h * 128 + c4 - 128) = w; }
    }
    for (int idx = tid; idx < 64 * 32; idx += 512) {
        const int r = idx >> 5, c4 = (idx & 31) * 4;
        *(u32x2*)(((bf16_t*)(F.ws + WS_P)) + (size_t)(t0 + r) * LDP + C_VA + h * 128 + c4) = *(const u32x2*)(VS + r * 128 + c4);
    }
    __syncthreads();
    {
        const int fr = lane & 15, fq = lane >> 4, which = F.wid >> 2, it = F.wid & 3;
        const bf16_t* X = which ? QN : KN;
        const int crow = 16 * it + fr; const float gc = sG[crow], bc = sB[crow];
        for (int jt = 0; jt < 4; ++jt) {
            f32x4 a = {0.f, 0.f, 0.f, 0.f};
            if (jt <= it) {
#pragma unroll
                for (int ks = 0; ks < 4; ++ks) a = MFMA16(ldfrag(KN, 16 * jt + fr, 136, 32 * ks, fq), ldfrag(X, crow, 136, 32 * ks, fq), a);
            }
            f32x4 o;
#pragma unroll
            for (int j = 0; j < 4; ++j) {
                const int s = 16 * jt + 4 * fq + j;
                const bool keep = which ? (s <= crow) : (s < crow);
                const float dec = keep ? __expf(gc - sG[s]) : 0.f;
                o[j] = a[j] * dec * (which ? 1.f : bc);
            }
            if (which) *(u32x2*)(((bf16_t*)(F.ws + WS_XB)) + (size_t)(t0 + crow) * LDE + h * 128 + 64 + 16 * jt + 4 * fq) = pk4(o);
            else *(f32x4*)(AM + crow * 68 + 16 * jt + 4 * fq) = o;
        }
    }
    __syncthreads();
    if (F.wid == 0) {
        float Tc[64]; const float lanef = (float)lane;
        typedef __attribute__((address_space(3))) const f32x4 LDSF4;
        __attribute__((address_space(3))) const char* aml = (__attribute__((address_space(3))) const char*)AM; asm volatile("" : "+v"(aml));
#pragma unroll
        for (int i = 0; i < 64; ++i) {
            float a = fmaxf(0.f, 1.f - fabsf(lanef - (float)i));
#pragma unroll
            for (int j4 = 0; j4 < (i + 3) / 4; ++j4) {
                const f32x4 av = *(const LDSF4*)(aml + (i * 68 + j4 * 4) * 4);
#pragma unroll
                for (int jj = 0; jj < 4; ++jj) if (j4 * 4 + jj < i) a -= av[jj] * Tc[j4 * 4 + jj];
            }
            Tc[i] = a;
        }
#pragma unroll
        for (int i = 0; i < 64; i += 2) {
            const unsigned w = pk2(Tc[i], Tc[i + 1]);
            ((bf16_t*)(F.ws + WS_XB))[(size_t)(t0 + i) * LDE + h * 128 + lane] = (bf16_t)(w & 0xffff);
            ((bf16_t*)(F.ws + WS_XB))[(size_t)(t0 + i + 1) * LDE + h * 128 + lane] = (bf16_t)(w >> 16);
        }
    }
}

DEV void g1_gla(const Frame& F0, int l, int c, int h) {
    REFRAME;
    float* GL = (float*)F.lds;
    float* LA = (float*)(F.lds + 4096);
    bf16_t* QG = (bf16_t*)(F.lds + 20736);
    bf16_t* KI = (bf16_t*)(F.lds + 29952);
    const int tid = F.tid, lane = F.lane, t0 = c * 64;
    __syncthreads();
    if (tid < 256) { const int r = tid >> 2, q4 = (tid & 3) * 4; *(f32x4*)(GL + r * 16 + q4) = *(const f32x4*)(((float*)(F.ws + WS_SC)) + (size_t)(t0 + r) * 32 + 8 + q4); }
    __syncthreads();
    {
        const int dk = tid & 63, rb = tid >> 6;
        float w2[16];
#pragma unroll
        for (int i = 0; i < 16; ++i) w2[i] = F.in[15][(size_t)(l * 16 + i) * 256 + h * 64 + dk];
        const float bias = F.in[16][l * 256 + h * 64 + dk];
#pragma unroll
        for (int rr = 0; rr < 8; ++rr) {
            const int r = rb * 8 + rr; float x = bias;
#pragma unroll
            for (int i = 0; i < 16; ++i) x += GL[r * 16 + i] * w2[i];
            LA[r * 65 + dk] = logsigmoid(x) * 0.0625f;
        }
    }
    __syncthreads();
    if (tid < 64) {
        float g = 0.f;
#pragma unroll 8
        for (int r = 0; r < 64; ++r) { g += LA[r * 65 + tid]; LA[r * 65 + tid] = g; }
        ((float*)(F.ws + WS_DL))[((size_t)c * 4 + h) * 64 + tid] = __expf(g);
    }
    __syncthreads();
    for (int idx = tid; idx < 64 * 16; idx += 512) {
        const int r = idx >> 4, c4 = (idx & 15) * 4;
        bf16_t* qp = ((bf16_t*)(F.ws + WS_P)) + (size_t)(t0 + r) * LDP + C_QB + h * 64 + c4; bf16_t* kp = ((bf16_t*)(F.ws + WS_P)) + (size_t)(t0 + r) * LDP + C_KB + h * 64 + c4;
        const f32x4 q = unpk4(*(const u32x2*)qp), k = unpk4(*(const u32x2*)kp);
        f32x4 qg, ki, kg;
#pragma unroll
        for (int j = 0; j < 4; ++j) { const float g = LA[r * 65 + c4 + j], gl = LA[63 * 65 + c4 + j];
            qg[j] = q[j] * 0.125f * __expf(g); ki[j] = k[j] * __expf(-g); kg[j] = k[j] * __expf(gl - g); }
        const u32x2 wq = pk4(qg);
        *(u32x2*)(QG + r * 72 + c4) = wq; *(u32x2*)(KI + r * 72 + c4) = pk4(ki);
        *(u32x2*)qp = wq; *(u32x2*)kp = pk4(kg);
    }
    __syncthreads();
    {
        const int fr = lane & 15, fq = lane >> 4, it = F.wid >> 1; const int crow = 16 * it + fr;
#pragma unroll
        for (int q = 0; q < 2; ++q) {
            const int jt = (F.wid & 1) * 2 + q;
            f32x4 a = {0.f, 0.f, 0.f, 0.f};
            if (jt <= it) {
#pragma unroll
                for (int ks = 0; ks < 2; ++ks) a = MFMA16(ldfrag(KI, 16 * jt + fr, 72, 32 * ks, fq), ldfrag(QG, crow, 72, 32 * ks, fq), a);
            }
#pragma unroll
            for (int j = 0; j < 4; ++j) if (16 * jt + 4 * fq + j > crow) a[j] = 0.f;
            *(u32x2*)(((bf16_t*)(F.ws + WS_XB)) + (size_t)(t0 + crow) * LDE + 512 + h * 64 + 16 * jt + 4 * fq) = pk4(a);
        }
    }
}

DEV void g2_gdn(const Frame& F0, int l, int s, int h) {
    REFRAME;
    bf16_t* QN = (bf16_t*)F.lds;
    bf16_t* KN = (bf16_t*)(F.lds + 17408);
    bf16_t* KT = (bf16_t*)(F.lds + 34816);
    bf16_t* TM = (bf16_t*)(F.lds + 53248);
    bf16_t* AQ = (bf16_t*)(F.lds + 62464);
    float* sB = (float*)(F.lds + 71680); float* sG = sB + 64;
    float* RED = (float*)(F.lds + 72192);
    const int tid = F.tid, lane = F.lane, w = F.wid, fr = lane & 15, fq = lane >> 4;
    const bool sample = s >= 16; const int nchunk = sample ? 1 : 32; const int tbase = sample ? 32768 + (s - 16) * 64 : s * 2048;
    const int dvc = h * 128 + 16 * w + fr;
    f32x4 S[8];
#pragma unroll
    for (int mt = 0; mt < 8; ++mt) {
        if (sample) { const float* sp = F.in[2] + ((size_t)((l * 8 + (s - 16)) * 4 + h) * 128) * 128;
#pragma unroll
            for (int j = 0; j < 4; ++j) S[mt][j] = sp[(size_t)(16 * mt + 4 * fq + j) * 128 + 16 * w + fr]; }
        else S[mt] = (f32x4){0.f, 0.f, 0.f, 0.f};
    }
    const float gn = F.in[14][l * 128 + 16 * w + fr];
    for (int n = 0; n < nchunk; ++n) {
        const int t0 = tbase + n * 64;
        __syncthreads();
#pragma unroll
        for (int i = 0; i < 2; ++i) {
            const int p = tid + 512 * i, r = p >> 4, c8 = (p & 15) * 8;
            const u32x4 q = *(const u32x4*)(((bf16_t*)(F.ws + WS_P)) + (size_t)(t0 + r) * LDP + C_QA + h * 128 + c8);
            const u32x4 k = *(const u32x4*)(((bf16_t*)(F.ws + WS_P)) + (size_t)(t0 + r) * LDP + C_KA + h * 128 + c8);
            *(u32x4*)(QN + r * 136 + c8) = q; *(u32x4*)(KN + r * 136 + c8) = k;
            KT[(c8 + 0) * 72 + r] = (bf16_t)(k.x & 0xffff); KT[(c8 + 1) * 72 + r] = (bf16_t)(k.x >> 16);
            KT[(c8 + 2) * 72 + r] = (bf16_t)(k.y & 0xffff); KT[(c8 + 3) * 72 + r] = (bf16_t)(k.y >> 16);
            KT[(c8 + 4) * 72 + r] = (bf16_t)(k.z & 0xffff); KT[(c8 + 5) * 72 + r] = (bf16_t)(k.z >> 16);
            KT[(c8 + 6) * 72 + r] = (bf16_t)(k.w & 0xffff); KT[(c8 + 7) * 72 + r] = (bf16_t)(k.w >> 16);
        }
        {
            const int r = tid >> 3, c8 = (tid & 7) * 8;
            *(u32x4*)(TM + r * 72 + c8) = *(const u32x4*)(((bf16_t*)(F.ws + WS_XB)) + (size_t)(t0 + r) * LDE + h * 128 + c8);
            *(u32x4*)(AQ + r * 72 + c8) = *(const u32x4*)(((bf16_t*)(F.ws + WS_XB)) + (size_t)(t0 + r) * LDE + h * 128 + 64 + c8);
        }
        if (tid < 128) sB[tid] = ((float*)(F.ws + WS_BG))[((size_t)(t0 >> 6) * 4 + h) * 128 + tid];
        __syncthreads();
        f32x4 kS[4], qS[4], vn[4], o[4];
#pragma unroll
        for (int mt = 0; mt < 4; ++mt) { kS[mt] = (f32x4){0.f, 0.f, 0.f, 0.f}; qS[mt] = kS[mt]; vn[mt] = kS[mt]; }
#pragma unroll
        for (int ks = 0; ks < 4; ++ks) {
            const bf16x8 sf = mk8(pk4(S[2 * ks]), pk4(S[2 * ks + 1]));
#pragma unroll
            for (int mt = 0; mt < 4; ++mt) {
                kS[mt] = MFMA16(ldfragp(KN, 16 * mt + fr, 136, 32 * ks, fq), sf, kS[mt]);
                qS[mt] = MFMA16(ldfragp(QN, 16 * mt + fr, 136, 32 * ks, fq), sf, qS[mt]);
            }
        }
        const float glast = sG[63];
        f32x4 eg[4], tmp[4];
#pragma unroll
        for (int mt = 0; mt < 4; ++mt)
#pragma unroll
            for (int j = 0; j < 4; ++j) {
                const int row = 16 * mt + 4 * fq + j;
                const float e = __expf(sG[row]); eg[mt][j] = e;
                const float vv = bf2f(((bf16_t*)(F.ws + WS_P))[(size_t)(t0 + row) * LDP + C_VA + dvc]);
                tmp[mt][j] = vv - sB[row] * e * kS[mt][j];
            }
#pragma unroll
        for (int ks = 0; ks < 2; ++ks) {
            const bf16x8 tf = mk8(pk4(tmp[2 * ks]), pk4(tmp[2 * ks + 1]));
#pragma unroll
            for (int mt = 0; mt < 4; ++mt) vn[mt] = MFMA16(ldfragp(TM, 16 * mt + fr, 72, 32 * ks, fq), tf, vn[mt]);
        }
#pragma unroll
        for (int mt = 0; mt < 4; ++mt) o[mt] = eg[mt] * qS[mt];
#pragma unroll
        for (int ks = 0; ks < 2; ++ks) {
            const bf16x8 vf = mk8(pk4(vn[2 * ks]), pk4(vn[2 * ks + 1]));
#pragma unroll
            for (int mt = 0; mt < 4; ++mt) o[mt] = MFMA16(ldfragp(AQ, 16 * mt + fr, 72, 32 * ks, fq), vf, o[mt]);
        }
        const float dl = __expf(glast);
#pragma unroll
        for (int mt = 0; mt < 4; ++mt)
#pragma unroll
            for (int j = 0; j < 4; ++j) vn[mt][j] *= __expf(glast - sG[16 * mt + 4 * fq + j]);
#pragma unroll
        for (int mt = 0; mt < 8; ++mt) S[mt] = S[mt] * dl;
#pragma unroll
        for (int ks = 0; ks < 2; ++ks) {
            const bf16x8 vf = mk8(pk4(vn[2 * ks]), pk4(vn[2 * ks + 1]));
#pragma unroll
            for (int mt = 0; mt < 8; ++mt) S[mt] = MFMA16(ldfragp(KT, 16 * mt + fr, 72, 32 * ks, fq), vf, S[mt]);
        }
#pragma unroll
        for (int mt = 0; mt < 4; ++mt)
#pragma unroll
            for (int j = 0; j < 4; ++j) {
                float p = o[mt][j] * o[mt][j];
                p += __shfl_xor(p, 1); p += __shfl_xor(p, 2); p += __shfl_xor(p, 4); p += __shfl_xor(p, 8);
                if (fr == 0) RED[(16 * mt + 4 * fq + j) * 8 + w] = p;
            }
        __syncthreads();
#pragma unroll
        for (int mt = 0; mt < 4; ++mt)
#pragma unroll
            for (int j = 0; j < 4; ++j) {
                const int row = 16 * mt + 4 * fq + j;
                const f32x4 r0 = *(const f32x4*)(RED + row * 8), r1 = *(const f32x4*)(RED + row * 8 + 4);
                const float ssum = ((r0[0] + r0[1]) + (r0[2] + r0[3])) + ((r1[0] + r1[1]) + (r1[2] + r1[3]));
                const float rs = rsqrtf(ssum * (1.f / 128.f) + 1e-6f);
                bf16_t* zp = ((bf16_t*)(F.ws + WS_P)) + (size_t)(t0 + row) * LDP + C_ZA + dvc;
                const float z = bf2f(*zp);
                *zp = (bf16_t)(pk2(o[mt][j] * rs * gn * silu(z), 0.f) & 0xffff);
            }
    }
    float* so = sample ? F.out + O_GDN_S + ((size_t)((l * 8 + (s - 16)) * 4 + h) * 128) * 128 : F.out + O_GDN_P + ((size_t)((l * 16 + s) * 4 + h) * 128) * 128;
#pragma unroll
    for (int mt = 0; mt < 8; ++mt)
#pragma unroll
        for (int j = 0; j < 4; ++j) so[(size_t)(16 * mt + 4 * fq + j) * 128 + 16 * w + fr] = S[mt][j];
}

DEV void g2_gla(const Frame& F0, int l, int s, int h) {
    REFRAME;
    bf16_t* QG = (bf16_t*)F.lds;
    bf16_t* KGT = (bf16_t*)(F.lds + 9216);
    bf16_t* AQ = (bf16_t*)(F.lds + 18432);
    float* sDL = (float*)(F.lds + 27648);
    float* RED = (float*)(F.lds + 27904);
    const int tid = F.tid, lane = F.lane, w = F.wid, fr = lane & 15, fq = lane >> 4;
    const bool sample = s >= 16; const int nchunk = sample ? 1 : 32; const int tbase = sample ? 32768 + (s - 16) * 64 : s * 2048;
    const int dvc = h * 128 + 16 * w + fr;
    f32x4 S[4];
#pragma unroll
    for (int mt = 0; mt < 4; ++mt) {
        if (sample) { const float* sp = F.in[4] + ((size_t)((l * 8 + (s - 16)) * 4 + h) * 64) * 128;
#pragma unroll
            for (int j = 0; j < 4; ++j) S[mt][j] = sp[(size_t)(16 * mt + 4 * fq + j) * 128 + 16 * w + fr]; }
        else S[mt] = (f32x4){0.f, 0.f, 0.f, 0.f};
    }
    const float gn = F.in[17][l * 128 + 16 * w + fr];
    for (int n = 0; n < nchunk; ++n) {
        const int t0 = tbase + n * 64, chunk = t0 >> 6;
        __syncthreads();
        {
            const int r = tid >> 3, c8 = (tid & 7) * 8;
            *(u32x4*)(QG + r * 72 + c8) = *(const u32x4*)(((bf16_t*)(F.ws + WS_P)) + (size_t)(t0 + r) * LDP + C_QB + h * 64 + c8);
            const u32x4 k = *(const u32x4*)(((bf16_t*)(F.ws + WS_P)) + (size_t)(t0 + r) * LDP + C_KB + h * 64 + c8);
            KGT[(c8 + 0) * 72 + r] = (bf16_t)(k.x & 0xffff); KGT[(c8 + 1) * 72 + r] = (bf16_t)(k.x >> 16);
            KGT[(c8 + 2) * 72 + r] = (bf16_t)(k.y & 0xffff); KGT[(c8 + 3) * 72 + r] = (bf16_t)(k.y >> 16);
            KGT[(c8 + 4) * 72 + r] = (bf16_t)(k.z & 0xffff); KGT[(c8 + 5) * 72 + r] = (bf16_t)(k.z >> 16);
            KGT[(c8 + 6) * 72 + r] = (bf16_t)(k.w & 0xffff); KGT[(c8 + 7) * 72 + r] = (bf16_t)(k.w >> 16);
            *(u32x4*)(AQ + r * 72 + c8) = *(const u32x4*)(((bf16_t*)(F.ws + WS_XB)) + (size_t)(t0 + r) * LDE + 512 + h * 64 + c8);
        }
        if (tid < 64) sDL[tid] = ((float*)(F.ws + WS_DL))[((size_t)chunk * 4 + h) * 64 + tid];
        bf16x8 vf[2];
#pragma unroll
        for (int ks = 0; ks < 2; ++ks) {
            unsigned e[8];
#pragma unroll
            for (int j = 0; j < 8; ++j) { const int row = 32 * ks + (j < 4 ? 4 * fq + j : 16 + 4 * fq + (j - 4)); e[j] = ((bf16_t*)(F.ws + WS_P))[(size_t)(t0 + row) * LDP + C_VB + dvc]; }
            u32x4 t; t.x = e[0] | (e[1] << 16); t.y = e[2] | (e[3] << 16); t.z = e[4] | (e[5] << 16); t.w = e[6] | (e[7] << 16);
            vf[ks] = __builtin_bit_cast(bf16x8, t);
        }
        __syncthreads();
        f32x4 o[4];
#pragma unroll
        for (int mt = 0; mt < 4; ++mt) o[mt] = (f32x4){0.f, 0.f, 0.f, 0.f};
#pragma unroll
        for (int ks = 0; ks < 2; ++ks) {
            const bf16x8 sf = mk8(pk4(S[2 * ks]), pk4(S[2 * ks + 1]));
#pragma unroll
            for (int mt = 0; mt < 4; ++mt) {
                o[mt] = MFMA16(ldfragp(QG, 16 * mt + fr, 72, 32 * ks, fq), sf, o[mt]);
                o[mt] = MFMA16(ldfragp(AQ, 16 * mt + fr, 72, 32 * ks, fq), vf[ks], o[mt]);
            }
        }
#pragma unroll
        for (int mt = 0; mt < 4; ++mt) {
#pragma unroll
            for (int j = 0; j < 4; ++j) S[mt][j] *= sDL[16 * mt + 4 * fq + j];
#pragma unroll
            for (int ks = 0; ks < 2; ++ks) S[mt] = MFMA16(ldfragp(KGT, 16 * mt + fr, 72, 32 * ks, fq), vf[ks], S[mt]);
        }
#pragma unroll
        for (int mt = 0; mt < 4; ++mt)
#pragma unroll
            for (int j = 0; j < 4; ++j) {
                float p = o[mt][j] * o[mt][j];
                p += __shfl_xor(p, 1); p += __shfl_xor(p, 2); p += __shfl_xor(p, 4); p += __shfl_xor(p, 8);
                if (fr == 0) RED[(16 * mt + 4 * fq + j) * 8 + w] = p;
            }
        __syncthreads();
#pragma unroll
        for (int mt = 0; mt < 4; ++mt)
#pragma unroll
            for (int j = 0; j < 4; ++j) {
                const int row = 16 * mt + 4 * fq + j;
                const f32x4 r0 = *(const f32x4*)(RED + row * 8), r1 = *(const f32x4*)(RED + row * 8 + 4);
                const float ssum = ((r0[0] + r0[1]) + (r0[2] + r0[3])) + ((r1[0] + r1[1]) + (r1[2] + r1[3]));
                const float rs = rsqrtf(ssum * (1.f / 128.f) + 1e-6f);
                bf16_t* zp = ((bf16_t*)(F.ws + WS_P)) + (size_t)(t0 + row) * LDP + C_ZB + dvc;
                const float z = bf2f(*zp);
                *zp = (bf16_t)(pk2(o[mt][j] * rs * gn * silu(z), 0.f) & 0xffff);
            }
    }
    float* so = sample ? F.out + O_GLA_S + ((size_t)((l * 8 + (s - 16)) * 4 + h) * 64) * 128 : F.out + O_GLA_P + ((size_t)((l * 16 + s) * 4 + h) * 64) * 128;
#pragma unroll
    for (int mt = 0; mt < 4; ++mt)
#pragma unroll
        for (int j = 0; j < 4; ++j) so[(size_t)(16 * mt + 4 * fq + j) * 128 + 16 * w + fr] = S[mt][j];
}

DEV void ffn_mid(const Frame& F0, int l) {
    REFRAME;
    const float* cw = F.in[29] + (size_t)l * 3 * 5632; const float* cb = F.in[30] + (size_t)l * 5632;
    const int total = NCH * 1408;
    for (int idx = F.bid * 512 + F.tid; idx < total; idx += F.nb * 512) {
        const int c = idx / 1408, cp = idx % 1408, col = cp * 2;
        const bool first = c >= 512 || (c & 31) == 0, sample = c >= 512;
        float g2[2] = {0.f, 0.f}, g1[2] = {0.f, 0.f}, v2[2] = {0.f, 0.f}, v1[2] = {0.f, 0.f};
        if (!first) {
            const bf16_t* hp = ((bf16_t*)(F.ws + WS_KV)) + (size_t)(c - 1) * 2 * 5632;
            unsigned u = *(const unsigned*)(hp + col); g2[0] = bflo(u); g2[1] = bfhi(u);
            u = *(const unsigned*)(hp + 5632 + col); g1[0] = bflo(u); g1[1] = bfhi(u);
            u = *(const unsigned*)(hp + 2816 + col); v2[0] = bflo(u); v2[1] = bfhi(u);
            u = *(const unsigned*)(hp + 5632 + 2816 + col); v1[0] = bflo(u); v1[1] = bfhi(u);
        } else if (sample) {
            const float* sp = F.in[5] + (size_t)(l * 8 + (c - 512)) * 2 * 5632;
            g2[0] = sp[col]; g2[1] = sp[col + 1]; g1[0] = sp[5632 + col]; g1[1] = sp[5632 + col + 1];
            v2[0] = sp[2816 + col]; v2[1] = sp[2816 + col + 1]; v1[0] = sp[5632 + 2816 + col]; v1[1] = sp[5632 + 2816 + col + 1];
        }
        const f32x2 wg0 = *(const f32x2*)(cw + col), wg1 = *(const f32x2*)(cw + 5632 + col), wg2 = *(const f32x2*)(cw + 2 * 5632 + col), bg = *(const f32x2*)(cb + col);
        const f32x2 wv0 = *(const f32x2*)(cw + 2816 + col), wv1 = *(const f32x2*)(cw + 5632 + 2816 + col), wv2 = *(const f32x2*)(cw + 2 * 5632 + 2816 + col), bv = *(const f32x2*)(cb + 2816 + col);
        bf16_t* up = ((bf16_t*)(F.ws + WS_P)) + (size_t)c * 64 * LDP + col;
#pragma unroll 8
        for (int r = 0; r < 64; ++r) {
            const unsigned ug = *(const unsigned*)(up + (size_t)r * LDP), uv = *(const unsigned*)(up + (size_t)r * LDP + 2816);
            const float g0[2] = {bflo(ug), bfhi(ug)}, v0[2] = {bflo(uv), bfhi(uv)};
            const float yg0 = wg0[0] * g2[0] + wg1[0] * g1[0] + wg2[0] * g0[0] + bg[0], yg1 = wg0[1] * g2[1] + wg1[1] * g1[1] + wg2[1] * g0[1] + bg[1];
            const float yv0 = wv0[0] * v2[0] + wv1[0] * v1[0] + wv2[0] * v0[0] + bv[0], yv1 = wv0[1] * v2[1] + wv1[1] * v1[1] + wv2[1] * v0[1] + bv[1];
            *(unsigned*)(up + (size_t)r * LDP) = pk2(silu(yg0) * yv0, silu(yg1) * yv1);
            g2[0] = g1[0]; g2[1] = g1[1]; g1[0] = g0[0]; g1[1] = g0[1]; v2[0] = v1[0]; v2[1] = v1[1]; v1[0] = v0[0]; v1[1] = v0[1];
        }
    }
}

DEV void final_norm(const Frame& F0) {
    REFRAME;
    const int gw = F.bid * 8 + F.wid, nw = F.nb * 8, lane = F.lane;
    const float* g = F.in[32];
    for (int row = gw; row < TT; row += nw) {
        const float rs = row_rstd(((float*)(F.ws + WS_SSQ)), row);
        float* X = F.out + (size_t)row * 1024;
#pragma unroll
        for (int i = 0; i < 4; ++i) { const int cidx = i * 256 + lane * 4; f32x4 v = *(const f32x4*)(X + cidx); const f32x4 gg = *(const f32x4*)(g + cidx); *(f32x4*)(X + cidx) = v * rs * gg; }
    }
}

#ifdef DBG_COL
DEV void dbg_dump(const Frame& F0) {
    REFRAME;
    for (int i = F.bid * 512 + F.tid; i < TT * 256; i += F.nb * 512) {
        const int row = i >> 8, c = (i & 255) * 4;
        const f32x4 v = c < 512 ? unpk4(*(const u32x2*)(((bf16_t*)(F.ws + WS_P)) + (size_t)row * LDP + DBG_COL + c)) : (f32x4){0.f, 0.f, 0.f, 0.f};
        *(f32x4*)(F.out + (size_t)row * 1024 + c) = (row DBG_ROWSEL) ? v : (f32x4){0.f, 0.f, 0.f, 0.f};
    }
}
#endif
__global__ void __launch_bounds__(512, 2) fwd_kernel(Params p) {
    extern __shared__ __attribute__((aligned(16))) unsigned char lds[];
    cg::grid_group grid = cg::this_grid();
    Frame F;
    F.in = (InTab)__builtin_amdgcn_kernarg_segment_ptr(); F.out = p.out; F.ws = p.ws; F.lds = lds;
    F.tid = threadIdx.x; F.lane = threadIdx.x & 63; F.wid = __builtin_amdgcn_readfirstlane(threadIdx.x >> 6); F.nb = gridDim.x; F.bid = blockIdx.x;
    for (int ph = p.ph_lo; ph < p.ph_hi; ++ph) {
#ifndef PHM
#define PHM 0xffff
#endif
        if (ph == 0) { if (PHM & 0x1000) phase0(F); }
        else if (ph == NPH - 1) { if (PHM & 0x2000) final_norm(F); }
        else {
            const int l = (ph - 1) / 11, k = (ph - 1) % 11;
            int gk = -1;
            switch (k) { case 0: gk = GP_IN; break; case 3: gk = GP_OUT; break; case 4: gk = GP_WO; break; case 5: gk = GP_MQ; break; case 6: gk = GP_ATTN; break;
                         case 7: gk = GP_MO; break; case 8: gk = GP_UP; break; case 10: gk = GP_DOWN; break; default: break; }
            if (gk >= 0 && (PHM & 1)) gemm_phase(F, gk, l);
            if (k == 0 && (PHM & 1)) small_proj(F);
            if (k == 3 && (PHM & 8)) sample_kv(F, l);
            if (k == 1 && (PHM & 2)) {
                for (int it = F.bid; it < NCH * 8; it += F.nb) { const int c = it >> 3, h = it & 3; if (it & 4) g1_gla(F, l, c, h); else g1_gdn(F, l, c, h); }
                __syncthreads();
                if (l > 0) cvt_ffn(F, l);
            }
            if (k == 2 && (PHM & 4)) {
                for (int it = F.bid; it < 192; it += F.nb) {
                    int s, h, br;
                    if (it < 128) { br = it & 1; h = (it >> 1) & 3; s = it >> 3; } else { const int v = it - 128; br = v & 1; h = (v >> 1) & 3; s = 16 + (v >> 3); }
                    if (br) g2_gla(F, l, s, h); else g2_gdn(F, l, s, h);
                    __syncthreads();
                }
            }
            if (k == 9 && (PHM & 0x200)) { ffn_mid(F, l); if (l < 3) { __syncthreads(); cvt_mixer(F, l + 1); } }
        }
        if (ph + 1 < p.ph_hi) { __threadfence(); grid.sync(); __threadfence(); }
    }
#ifdef DBG_COL
    __threadfence(); grid.sync(); __threadfence();
    dbg_dump(F);
#endif
}

extern "C" void kernel_launch(void* const* d_in, const int* in_sizes, int n_in, void* d_out, int out_size, void* d_ws, size_t ws_size, hipStream_t stream) {
    static int grid_blocks = 0;
    if (grid_blocks == 0) {
        if (n_in != 33 || ws_size < WS_TOTAL) { fprintf(stderr, "kernel_launch: bad n_in %d or ws %zu < %zu\n", n_in, ws_size, (size_t)WS_TOTAL); grid_blocks = -1; return; }
        int dev = 0, cus = 0, per_cu = 0;
        hipGetDevice(&dev);
        hipDeviceGetAttribute(&cus, hipDeviceAttributeMultiprocessorCount, dev);
        if (hipFuncSetAttribute((const void*)fwd_kernel, hipFuncAttributeMaxDynamicSharedMemorySize, LDS_BYTES) != hipSuccess) { fprintf(stderr, "hipFuncSetAttribute failed\n"); grid_blocks = -1; return; }
        hipOccupancyMaxActiveBlocksPerMultiprocessor(&per_cu, (const void*)fwd_kernel, 512, LDS_BYTES);
        if (per_cu < 1) per_cu = 1;
        (void)hipGetLastError();
        grid_blocks = cus * 1;
        if (grid_blocks <= 0) grid_blocks = 256;
    }
    if (grid_blocks < 0) return;
    Params p{};
    for (int i = 0; i < 33; ++i) p.in[i] = (const float*)d_in[i];
    p.out = (float*)d_out; p.ws = (unsigned char*)d_ws; p.ph_lo = 0; p.ph_hi = PH_HI;
    void* args[] = {&p};
    hipError_t e = hipLaunchCooperativeKernel((const void*)fwd_kernel, dim3(grid_blocks), dim3(512), args, LDS_BYTES, stream);
    if (e != hipSuccess) fprintf(stderr, "cooperative launch failed: %s (grid %d)\n", hipGetErrorString(e), grid_blocks);
}
```

```cpp
#include <hip/hip_runtime.h>
#include <hip/hip_cooperative_groups.h>
#include <cstdint>
#include <cstdio>
namespace cg = cooperative_groups;

typedef unsigned short bf16_t;
typedef short bf16x8 __attribute__((ext_vector_type(8)));
typedef float f32x4 __attribute__((ext_vector_type(4)));
typedef float f32x2 __attribute__((ext_vector_type(2)));
typedef unsigned u32x2 __attribute__((ext_vector_type(2)));
typedef unsigned u32x4 __attribute__((ext_vector_type(4)));
#define DEV __device__ __forceinline__

constexpr int DM = 1024, TT = 33280, NCH = 520, LDP = 5632, LDE = 768;
constexpr int C_QA = 0, C_KA = 512, C_VA = 1024, C_ZA = 1536, C_QB = 2048, C_KB = 2304, C_VB = 2560, C_ZB = 3072, C_GA = 3584, C_GB = 4608;
constexpr int C_MRG = 0, C_PR = 1024, C_Q = 2048, C_O = 3072;
constexpr size_t O_Y = 0;
constexpr size_t O_GDN_P = 34078720ull;
constexpr size_t O_GDNC_P = O_GDN_P + 4194304ull;
constexpr size_t O_GLA_P = O_GDNC_P + 294912ull;
constexpr size_t O_FFNC_P = O_GLA_P + 2097152ull;
constexpr size_t O_MEMK = O_FFNC_P + 720896ull;
constexpr size_t O_MEMV = O_MEMK + 16777216ull;
constexpr size_t O_GDN_S = O_MEMV + 16777216ull;
constexpr size_t O_GDNC_S = O_GDN_S + 2097152ull;
constexpr size_t O_GLA_S = O_GDNC_S + 147456ull;
constexpr size_t O_FFNC_S = O_GLA_S + 1048576ull;
constexpr size_t al256(size_t x) { return (x + 255) & ~(size_t)255; }
constexpr size_t WS_WMIX = 0;
constexpr size_t WM_WIN = 0, WM_WSM = WM_WIN + 5632ull * 1024, WM_WOA = WM_WSM + 32 * 1024, WM_WOB = WM_WOA + 524288, WM_WO = WM_WOB + 524288,
                 WM_WMQ = WM_WO + 1048576, WM_WMK = WM_WMQ + 1048576, WM_WMV = WM_WMK + 1048576, WM_WMO = WM_WMV + 1048576, WM_END = WM_WMO + 1048576;
constexpr size_t WS_WFFN = al256(WS_WMIX + WM_END * 2);
constexpr size_t WF_UP = 0, WF_DN = 5632ull * 1024, WF_END = WF_DN + 1024ull * 2816;
constexpr size_t WS_XB = al256(WS_WFFN + WF_END * 2);
constexpr size_t WS_P = al256(WS_XB + (size_t)TT * 1024 * 2);
constexpr size_t WS_KV = al256(WS_P + (size_t)TT * LDP * 2);
constexpr size_t KV_BYTES = 2ull * 6144 * 1024 * 2;
constexpr size_t WS_MB = al256(WS_KV + KV_BYTES);
constexpr size_t WS_MRS = al256(WS_MB + 4096ull * 1024 * 2);
constexpr size_t WS_SSQ = al256(WS_MRS + 4096 * 4);
constexpr size_t WS_SC = al256(WS_SSQ + (size_t)TT * 16 * 4);
constexpr size_t WS_DL = al256(WS_SC + (size_t)TT * 32 * 4);
constexpr size_t WS_BG = al256(WS_DL + 520ull * 4 * 64 * 4);
constexpr size_t WS_TOTAL = al256(WS_BG + 520ull * 4 * 128 * 4);
constexpr int LDS_BYTES = 147456;
constexpr int NPH = 46;
#ifndef PH_HI
#define PH_HI NPH
#define REPMASK 0
#define SYNCREP 1
#endif

struct Params { const float* in[33]; float* out; unsigned char* ws; int ph_lo, ph_hi; };

typedef __bf16 bf16x2_t __attribute__((ext_vector_type(2)));
DEV unsigned pk2(float lo, float hi) { f32x2 f = {lo, hi}; bf16x2_t v = __builtin_convertvector(f, bf16x2_t); return __builtin_bit_cast(unsigned, v); }
DEV float bf2f(bf16_t b) { return __uint_as_float(((unsigned)b) << 16); }
DEV float bflo(unsigned u) { return __uint_as_float(u << 16); }
DEV float bfhi(unsigned u) { return __uint_as_float(u & 0xffff0000u); }
DEV u32x2 pk4(f32x4 v) { u32x2 r; r.x = pk2(v[0], v[1]); r.y = pk2(v[2], v[3]); return r; }
DEV f32x4 unpk4(u32x2 u) { return (f32x4){bflo(u.x), bfhi(u.x), bflo(u.y), bfhi(u.y)}; }
DEV bf16x8 mk8(u32x2 a, u32x2 b) { u32x4 t = {a.x, a.y, b.x, b.y}; return __builtin_bit_cast(bf16x8, t); }
DEV float sigm(float x) { return 1.f / (1.f + __expf(-x)); }
DEV float silu(float x) { return x / (1.f + __expf(-x)); }
DEV float softplus(float x) { return x > 20.f ? x : __logf(1.f + __expf(x)); }
DEV float logsigmoid(float x) { return fminf(x, 0.f) - __logf(1.f + __expf(-fabsf(x))); }
DEV float row_rstd(const float* ssq, int row) {
    const f32x4 a = *(const f32x4*)(ssq + (size_t)row * 4), b = *(const f32x4*)(ssq + ((size_t)TT + row) * 4);
    const f32x4 c = *(const f32x4*)(ssq + ((size_t)2 * TT + row) * 4), d = *(const f32x4*)(ssq + ((size_t)3 * TT + row) * 4);
    float s = ((a[0] + a[1]) + (a[2] + a[3])) + ((b[0] + b[1]) + (b[2] + b[3])) + ((c[0] + c[1]) + (c[2] + c[3])) + ((d[0] + d[1]) + (d[2] + d[3]));
    return rsqrtf(s * (1.f / 1024.f) + 1e-6f);
}
DEV bf16x8 ldfragp(const bf16_t* base, int row, int stride, int k0, int fq) {
    const bf16_t* p = base + row * stride + k0 + 4 * fq;
    return mk8(*(const u32x2*)p, *(const u32x2*)(p + 16));
}
DEV bf16x8 ldfrag(const bf16_t* base, int row, int stride, int k0, int fq) {
    return *(const bf16x8*)(base + row * stride + k0 + 8 * fq);
}
#define MFMA16(a, b, c) __builtin_amdgcn_mfma_f32_16x16x32_bf16((a), (b), (c), 0, 0, 0)

constexpr int BM = 256, BK = 64, HALF = 128, HT = HALF * BK;
DEV int lds_byte(int r, int c) { int st = (r >> 4) * 2 + (c >> 5), rr = r & 15, cc = c & 31, ob = rr * 64 + cc * 2; return st * 1024 + (ob ^ (((ob >> 9) & 1) << 5)); }
DEV void stage_rc(int b, int& R, int& C) { int st = b / 1024, sb = b % 1024, swz = sb ^ (((sb >> 9) & 1) << 5); R = (st >> 1) * 16 + swz / 64; C = (st & 1) * 32 + (swz % 64) / 2; }

DEV void gemm_core(const bf16_t* __restrict__ A, int lda, const bf16_t* __restrict__ Bt, int ldb, int K, int brow, int bcol, f32x4 (&acc)[2][2][4][2], bf16_t* shm) {
#define SA(b, h) (shm + ((b) * 2 + (h)) * HT)
#define SB(b, h) (shm + (4 + (b) * 2 + (h)) * HT)
#define STAGE(P, BASE, LD, br, kt) do { const char* _gb = (const char*)((BASE) + (long)(br) * (LD) + (long)(kt) * BK); \
    const unsigned _vo = (unsigned)((sr0 * (int)(LD) + sc0) * 2); \
    for (int _i = 0; _i < 2; ++_i) { \
      __builtin_amdgcn_global_load_lds((const unsigned*)(_gb + (long)(_i * 128) * (LD) + _vo), (unsigned*)((char*)(P) + wbase + _i * 8192), 16, 0, 0); } } while (0)
#define LDA(dst, b, h) for (int m = 0; m < 4; ++m) for (int k = 0; k < 2; ++k) \
    dst[m][k] = *reinterpret_cast<const bf16x8*>((char*)SA(b, h) + lds_byte(wr * 64 + m * 16 + fr, k * 32 + fq * 8))
#define LDB(dst, b, h) for (int n = 0; n < 2; ++n) for (int k = 0; k < 2; ++k) \
    dst[n][k] = *reinterpret_cast<const bf16x8*>((char*)SB(b, h) + lds_byte(wc * 32 + n * 16 + fr, k * 32 + fq * 8))
#define MMA(ai, bj, At_, Bt_) do { __builtin_amdgcn_s_setprio(1); \
    for (int m = 0; m < 4; ++m) for (int n = 0; n < 2; ++n) for (int k = 0; k < 2; ++k) \
      acc[ai][bj][m][n] = __builtin_amdgcn_mfma_f32_16x16x32_bf16(Bt_[n][k], At_[m][k], acc[ai][bj][m][n], 0, 0, 0); \
    __builtin_amdgcn_s_setprio(0); } while (0)
#define WAIT_V(n) asm volatile("s_waitcnt vmcnt(" #n ")" ::: "memory")
#define WAIT_L(n) asm volatile("s_waitcnt lgkmcnt(" #n ")" ::: "memory")
#define BAR __builtin_amdgcn_s_barrier()
#define SCHED __builtin_amdgcn_sched_barrier(0)
    int tidx = threadIdx.x; asm volatile("" : "+v"(tidx));
    const int wid = __builtin_amdgcn_readfirstlane(tidx >> 6), lane = tidx & 63, wr = wid >> 2, wc = wid & 3, fr = lane & 15, fq = lane >> 4;
    const int wbase = wid * 1024;
    int sr0, sc0; stage_rc(tidx * 16, sr0, sc0);
#pragma unroll
    for (int a = 0; a < 2; ++a)
#pragma unroll
        for (int b = 0; b < 2; ++b)
#pragma unroll
            for (int m = 0; m < 4; ++m)
#pragma unroll
                for (int n = 0; n < 2; ++n) acc[a][b][m][n] = (f32x4){0.f, 0.f, 0.f, 0.f};
    bf16x8 At[4][2], B0[2][2], B1[2][2];
    const int nt = K / BK;
    STAGE(SB(0, 0), Bt, ldb, bcol, 0); STAGE(SA(0, 0), A, lda, brow, 0);
    STAGE(SB(0, 1), Bt, ldb, bcol + HALF, 0); STAGE(SA(0, 1), A, lda, brow + HALF, 0);
    if (wr == 1) BAR;
    WAIT_V(4); BAR;
    STAGE(SB(1, 0), Bt, ldb, bcol, 1); STAGE(SA(1, 0), A, lda, brow, 1); STAGE(SB(1, 1), Bt, ldb, bcol + HALF, 1);
    WAIT_V(6); BAR;
    for (int t = 0; t < nt - 2; t += 2) {
        LDB(B0, 0, 0); SCHED; LDA(At, 0, 0); STAGE(SA(1, 1), A, lda, brow + HALF, t + 1);
        WAIT_L(8); BAR; WAIT_L(0); MMA(0, 0, At, B0); BAR; SCHED;
        LDB(B1, 0, 1); STAGE(SB(0, 0), Bt, ldb, bcol, t + 2);
        BAR; WAIT_L(0); MMA(0, 1, At, B1); BAR;
        LDA(At, 0, 1); STAGE(SA(0, 0), A, lda, brow, t + 2);
        BAR; WAIT_L(0); MMA(1, 0, At, B0); BAR; SCHED;
        STAGE(SB(0, 1), Bt, ldb, bcol + HALF, t + 2);
        WAIT_V(6); BAR; MMA(1, 1, At, B1); BAR;
        LDB(B0, 1, 0); SCHED; LDA(At, 1, 0); STAGE(SA(0, 1), A, lda, brow + HALF, t + 2);
        WAIT_L(8); BAR; WAIT_L(0); MMA(0, 0, At, B0); BAR; SCHED;
        LDB(B1, 1, 1); STAGE(SB(1, 0), Bt, ldb, bcol, t + 3);
        BAR; WAIT_L(0); MMA(0, 1, At, B1); BAR;
        LDA(At, 1, 1); STAGE(SA(1, 0), A, lda, brow, t + 3);
        BAR; WAIT_L(0); MMA(1, 0, At, B0); BAR; SCHED;
        STAGE(SB(1, 1), Bt, ldb, bcol + HALF, t + 3);
        WAIT_V(6); BAR; MMA(1, 1, At, B1); BAR;
    }
    { LDB(B0, 0, 0); LDA(At, 0, 0); STAGE(SA(1, 1), A, lda, brow + HALF, nt - 1);
      BAR; WAIT_L(0); MMA(0, 0, At, B0); BAR;
      LDB(B1, 0, 1); BAR; WAIT_L(0); MMA(0, 1, At, B1); BAR;
      LDA(At, 0, 1); WAIT_V(4); BAR; WAIT_L(0); MMA(1, 0, At, B0); MMA(1, 1, At, B1); BAR; }
    { LDB(B0, 1, 0); LDA(At, 1, 0); WAIT_V(2); BAR; WAIT_L(0); MMA(0, 0, At, B0); BAR;
      LDB(B1, 1, 1); WAIT_V(0); BAR; WAIT_L(0); MMA(0, 1, At, B1); BAR;
      LDA(At, 1, 1); BAR; WAIT_L(0); MMA(1, 0, At, B0); MMA(1, 1, At, B1); BAR; }
    if (wr == 0) BAR;
#undef SA
#undef SB
}

typedef const float* const __attribute__((address_space(4)))* InTab;
struct Frame {
    InTab in; float* out; unsigned char* ws; unsigned char* lds;
    int tid, lane, wid, nb, bid;
};
#define REFRAME Frame F = F0; { int t_ = threadIdx.x; asm volatile("" : "+v"(t_)); F.tid = t_; F.lane = t_ & 63; unsigned char* w_ = F.ws; asm volatile("" : "+s"(w_)); F.ws = w_; float* o_ = F.out; asm volatile("" : "+s"(o_)); F.out = o_; InTab i_ = (InTab)__builtin_amdgcn_kernarg_segment_ptr(); asm volatile("" : "+s"(i_)); F.in = i_; int a_ = F.wid, b_ = F.bid, c_ = F.nb; asm volatile("" : "+s"(a_), "+s"(b_), "+s"(c_)); F.wid = a_; F.bid = b_; F.nb = c_; }

enum { EPI_PROJ = 0, EPI_UP, EPI_RESID, EPI_Q, EPI_MEMK, EPI_MEMV, EPI_OUTA, EPI_OUTB, EPI_SOFTMAX, EPI_ATTNO };
struct GDesc { const bf16_t* A; int lda; const bf16_t* Bt; int ldb; int K, brow, bcol, epi, orow, ocol, head, vai, vwr; };

DEV void cvt_mat(const Frame& F0, const float* src, int ldsrc, int K, int N, int wincols, const float* gain, bf16_t* dst) {
    REFRAME;
    float* T = (float*)F.lds;
    const int nkt = K / 64, nnt = N / 64, ntile = nkt * nnt;
    for (int t = F.bid; t < ntile; t += F.nb) {
        const int kt = t / nnt, ntl = t % nnt, k0 = kt * 64, n0 = ntl * 64;
        int coff = 0; if (wincols) coff = (n0 < 1536) ? 0 : (n0 < 3072 ? 8 : 24);
        __syncthreads();
#pragma unroll
        for (int i = 0; i < 2; ++i) {
            const int kr = (F.tid >> 4) + 32 * i, nc = (F.tid & 15) * 4;
            f32x4 v = *(const f32x4*)(src + (size_t)(k0 + kr) * ldsrc + n0 + coff + nc);
            const float g = gain ? gain[k0 + kr] : 1.f;
            T[kr * 65 + nc + 0] = v[0] * g; T[kr * 65 + nc + 1] = v[1] * g; T[kr * 65 + nc + 2] = v[2] * g; T[kr * 65 + nc + 3] = v[3] * g;
        }
        __syncthreads();
        const int n = F.tid >> 3, kc = (F.tid & 7) * 8;
        u32x4 w;
        w.x = pk2(T[(kc + 0) * 65 + n], T[(kc + 1) * 65 + n]); w.y = pk2(T[(kc + 2) * 65 + n], T[(kc + 3) * 65 + n]);
        w.z = pk2(T[(kc + 4) * 65 + n], T[(kc + 5) * 65 + n]); w.w = pk2(T[(kc + 6) * 65 + n], T[(kc + 7) * 65 + n]);
        *(u32x4*)(dst + (size_t)(n0 + n) * K + k0 + kc) = w;
    }
    __syncthreads();
}
DEV void cvt_mixer(const Frame& F0, int l) {
    REFRAME;
    InTab in = F.in;
    cvt_mat(F, in[10] + (size_t)l * 1024 * 5656, 5656, 1024, 5632, 1, in[9] + l * 1024, ((bf16_t*)(F.ws + WS_WMIX)) + WM_WIN);
    cvt_mat(F, in[18] + (size_t)l * 512 * 1024, 1024, 512, 1024, 0, nullptr, ((bf16_t*)(F.ws + WS_WMIX)) + WM_WOA);
    cvt_mat(F, in[19] + (size_t)l * 512 * 1024, 1024, 512, 1024, 0, nullptr, ((bf16_t*)(F.ws + WS_WMIX)) + WM_WOB);
    cvt_mat(F, in[20] + (size_t)l * 1048576, 1024, 1024, 1024, 0, nullptr, ((bf16_t*)(F.ws + WS_WMIX)) + WM_WO);
    cvt_mat(F, in[23] + (size_t)l * 1048576, 1024, 1024, 1024, 0, in[21] + l * 1024, ((bf16_t*)(F.ws + WS_WMIX)) + WM_WMQ);
    cvt_mat(F, in[24] + (size_t)l * 1048576, 1024, 1024, 1024, 0, in[22] + l * 1024, ((bf16_t*)(F.ws + WS_WMIX)) + WM_WMK);
    cvt_mat(F, in[25] + (size_t)l * 1048576, 1024, 1024, 1024, 0, in[22] + l * 1024, ((bf16_t*)(F.ws + WS_WMIX)) + WM_WMV);
    cvt_mat(F, in[26] + (size_t)l * 1048576, 1024, 1024, 1024, 0, nullptr, ((bf16_t*)(F.ws + WS_WMIX)) + WM_WMO);
    const float* win = in[10] + (size_t)l * 1024 * 5656; const float* g = in[9] + l * 1024;
    for (int i = F.bid * 512 + F.tid; i < 32 * 1024; i += F.nb * 512) {
        const int n = i >> 10, k = i & 1023;
        float v = 0.f;
        if (n < 8) v = win[(size_t)k * 5656 + 1536 + n] * g[k]; else if (n < 24) v = win[(size_t)k * 5656 + 3080 + (n - 8)] * g[k];
        ((bf16_t*)(F.ws + WS_WMIX))[WM_WSM + i] = (bf16_t)(pk2(v, 0.f) & 0xffff);
    }
}
DEV void cvt_ffn(const Frame& F, int l) {
    cvt_mat(F, F.in[28] + (size_t)l * 1024 * 5632, 5632, 1024, 5632, 0, F.in[27] + l * 1024, ((bf16_t*)(F.ws + WS_WFFN)) + WF_UP);
    cvt_mat(F, F.in[31] + (size_t)l * 2816 * 1024, 1024, 2816, 1024, 0, nullptr, ((bf16_t*)(F.ws + WS_WFFN)) + WF_DN);
}

DEV void phase0(const Frame& F0) {
    REFRAME;
    const int gw = F.bid * 8 + F.wid, nw = F.nb * 8, lane = F.lane;
    for (int row = gw; row < TT + 4096; row += nw) {
        const bool ismem = row >= TT;
        const float* src = ismem ? F.in[8] + (size_t)(row - TT) * 1024 : (row < 32768 ? F.in[0] + (size_t)row * 1024 : F.in[1] + (size_t)(row - 32768) * 1024);
        f32x4 v[4]; float s = 0.f;
#pragma unroll
        for (int i = 0; i < 4; ++i) { v[i] = *(const f32x4*)(src + lane * 16 + i * 4); s += v[i][0] * v[i][0] + v[i][1] * v[i][1] + v[i][2] * v[i][2] + v[i][3] * v[i][3]; }
        u32x4 w0, w1;
        w0.x = pk2(v[0][0], v[0][1]); w0.y = pk2(v[0][2], v[0][3]); w0.z = pk2(v[1][0], v[1][1]); w0.w = pk2(v[1][2], v[1][3]);
        w1.x = pk2(v[2][0], v[2][1]); w1.y = pk2(v[2][2], v[2][3]); w1.z = pk2(v[3][0], v[3][1]); w1.w = pk2(v[3][2], v[3][3]);
        s += __shfl_xor(s, 1); s += __shfl_xor(s, 2);
        if (!ismem) {
            float* X = F.out + (size_t)row * 1024 + lane * 16;
#pragma unroll
            for (int i = 0; i < 4; ++i) *(f32x4*)(X + i * 4) = v[i];
            bf16_t* xb = ((bf16_t*)(F.ws + WS_XB)) + (size_t)row * 1024 + lane * 16;
            *(u32x4*)xb = w0; *(u32x4*)(xb + 8) = w1;
            if ((lane & 3) == 0) ((float*)(F.ws + WS_SSQ))[((size_t)(lane >> 4) * TT + row) * 4 + ((lane >> 2) & 3)] = s;
        } else {
            const int mr = row - TT;
            bf16_t* mb = ((bf16_t*)(F.ws + WS_MB)) + (size_t)mr * 1024 + lane * 16;
            *(u32x4*)mb = w0; *(u32x4*)(mb + 8) = w1;
            s += __shfl_xor(s, 4); s += __shfl_xor(s, 8); s += __shfl_xor(s, 16); s += __shfl_xor(s, 32);
            if (lane == 0) ((float*)(F.ws + WS_MRS))[mr] = rsqrtf(s * (1.f / 1024.f) + 1e-6f);
        }
    }
    cvt_mixer(F, 0);
    cvt_ffn(F, 0);
}

DEV void small_proj(const Frame& F0) {
    REFRAME;
    const int lane = F.lane, fr = lane & 15, fq = lane >> 4, mt = F.wid & 3, nt = F.wid >> 2;
    for (int c = F.bid; c < NCH; c += F.nb) {
        const int row = c * 64 + mt * 16 + fr;
        const bf16_t* a = ((bf16_t*)(F.ws + WS_XB)) + (size_t)row * 1024 + 8 * fq;
        const bf16_t* b = ((bf16_t*)(F.ws + WS_WMIX)) + WM_WSM + (size_t)(nt * 16 + fr) * 1024 + 8 * fq;
        f32x4 acc = {0.f, 0.f, 0.f, 0.f};
#pragma unroll 4
        for (int k = 0; k < 32; ++k) acc = MFMA16(*(const bf16x8*)(b + k * 32), *(const bf16x8*)(a + k * 32), acc);
        const float rs = row_rstd(((float*)(F.ws + WS_SSQ)), row);
        *(f32x4*)(((float*)(F.ws + WS_SC)) + (size_t)row * 32 + nt * 16 + 4 * fq) = acc * rs;
    }
}

DEV void gemm_epilogue(const Frame& F0, const GDesc& d, int l, f32x4 (&acc)[2][2][4][2]) {
    REFRAME;
    int lane_ = F.lane; asm volatile("" : "+v"(lane_));
    const int wr = F.wid >> 2, wc = F.wid & 3, fr = lane_ & 15, fq = lane_ >> 4;
    float* red = (float*)(F.lds + 131072);
    if (d.epi == EPI_SOFTMAX) {
        float mx[2][4];
#pragma unroll
        for (int ai = 0; ai < 2; ++ai)
#pragma unroll
            for (int m = 0; m < 4; ++m) {
                float v = -3.0e38f;
#pragma unroll
                for (int bj = 0; bj < 2; ++bj)
#pragma unroll
                    for (int n = 0; n < 2; ++n) { const f32x4 x = acc[ai][bj][m][n]; v = fmaxf(v, fmaxf(fmaxf(x[0], x[1]), fmaxf(x[2], x[3]))); }
                v = fmaxf(v, __shfl_xor(v, 16)); v = fmaxf(v, __shfl_xor(v, 32));
                if (fq == 0) red[(ai * 128 + wr * 64 + m * 16 + fr) * 4 + wc] = v;
            }
        __syncthreads();
#pragma unroll
        for (int ai = 0; ai < 2; ++ai)
#pragma unroll
            for (int m = 0; m < 4; ++m) {
                const f32x4 r4 = *(const f32x4*)(red + (ai * 128 + wr * 64 + m * 16 + fr) * 4);
                const float rm = fmaxf(fmaxf(r4[0], r4[1]), fmaxf(r4[2], r4[3]));
                mx[ai][m] = rm; float s = 0.f;
#pragma unroll
                for (int bj = 0; bj < 2; ++bj)
#pragma unroll
                    for (int n = 0; n < 2; ++n) { f32x4 x = acc[ai][bj][m][n];
#pragma unroll
                        for (int j = 0; j < 4; ++j) { x[j] = __expf(x[j] - rm); s += x[j]; }
                        acc[ai][bj][m][n] = x; }
                s += __shfl_xor(s, 16); s += __shfl_xor(s, 32);
                if (fq == 0) red[1024 + (ai * 128 + wr * 64 + m * 16 + fr) * 4 + wc] = s;
            }
        (void)mx;
        __syncthreads();
#pragma unroll
        for (int ai = 0; ai < 2; ++ai)
#pragma unroll
            for (int m = 0; m < 4; ++m) {
                const f32x4 r4 = *(const f32x4*)(red + 1024 + (ai * 128 + wr * 64 + m * 16 + fr) * 4);
                const float inv = 1.f / ((r4[0] + r4[1]) + (r4[2] + r4[3]));
                const bool valid = d.vai < 0 || (d.vai == ai && d.vwr == wr);
                const int row = d.orow + ai * 128 + wr * 64 + m * 16 + fr;
                if (valid) {
#pragma unroll
                    for (int bj = 0; bj < 2; ++bj)
#pragma unroll
                        for (int n = 0; n < 2; ++n) {
                            const int col = bj * 128 + wc * 32 + n * 16 + fq * 4;
                            *(u32x2*)(((bf16_t*)(F.ws + WS_P)) + (size_t)row * LDP + C_PR + d.head * 256 + col) = pk4(acc[ai][bj][m][n] * inv);
                        }
                }
            }
        __syncthreads();
        return;
    }
#pragma unroll
    for (int ai = 0; ai < 2; ++ai)
#pragma unroll
        for (int m = 0; m < 4; ++m) {
            const int row = d.orow + ai * 128 + wr * 64 + m * 16 + fr;
            float rs = 1.f, ss = 0.f;
            if (d.epi == EPI_PROJ || d.epi == EPI_UP || d.epi == EPI_Q) rs = row_rstd(((float*)(F.ws + WS_SSQ)), row);
            if (d.epi == EPI_Q) rs *= 0.0625f;
            if (d.epi == EPI_MEMK) rs = ((float*)(F.ws + WS_MRS))[row];
#pragma unroll
            for (int bj = 0; bj < 2; ++bj)
#pragma unroll
                for (int n = 0; n < 2; ++n) {
                    const int col = d.ocol + bj * 128 + wc * 32 + n * 16 + fq * 4;
                    f32x4 v = acc[ai][bj][m][n];
                    switch (d.epi) {
                    case EPI_PROJ: case EPI_UP: {
                        v = v * rs; const u32x2 w = pk4(v);
                        *(u32x2*)(((bf16_t*)(F.ws + WS_P)) + (size_t)row * LDP + col) = w;
                        const int nh = d.epi == EPI_PROJ ? 3 : 2, width = d.epi == EPI_PROJ ? 1536 : 5632;
                        if (m == 3 && fr >= 16 - nh && (d.epi == EPI_UP || col < 1536)) {
                            const int chunk = row >> 6, hr = fr - (16 - nh);
                            bf16_t* halo = d.epi == EPI_PROJ ? ((bf16_t*)(F.ws + WS_KV)) : ((bf16_t*)(F.ws + WS_KV));
                            *(u32x2*)(halo + ((size_t)chunk * nh + hr) * width + col) = w;
                            if (chunk >= 512 || (chunk & 31) == 31) {
                                float* o;
                                if (d.epi == EPI_PROJ) o = chunk < 512 ? F.out + O_GDNC_P + ((size_t)(l * 16 + (chunk >> 5)) * 3 + hr) * 1536 + col
                                                                       : F.out + O_GDNC_S + ((size_t)(l * 8 + (chunk - 512)) * 3 + hr) * 1536 + col;
                                else o = chunk < 512 ? F.out + O_FFNC_P + ((size_t)(l * 16 + (chunk >> 5)) * 2 + hr) * 5632 + col
                                                     : F.out + O_FFNC_S + ((size_t)(l * 8 + (chunk - 512)) * 2 + hr) * 5632 + col;
                                *(f32x4*)o = v;
                            }
                        }
                    } break;
                    case EPI_RESID: {
                        float* X = F.out + (size_t)row * 1024 + col;
                        f32x4 x = *(const f32x4*)X; x = x + v; *(f32x4*)X = x;
                        *(u32x2*)(((bf16_t*)(F.ws + WS_XB)) + (size_t)row * 1024 + col) = pk4(x);
                        ss += (x[0] * x[0] + x[1] * x[1]) + (x[2] * x[2] + x[3] * x[3]);
                    } break;
                    case EPI_Q: *(u32x2*)(((bf16_t*)(F.ws + WS_P)) + (size_t)row * LDP + C_Q + col) = pk4(v * rs); break;
                    case EPI_MEMK: {
                        v = v * rs;
                        *(f32x4*)(F.out + O_MEMK + ((size_t)l * 4096 + row) * 1024 + col) = v;
                        *(u32x2*)(((bf16_t*)(F.ws + WS_KV)) + (size_t)row * 1024 + col) = pk4(v);
                    } break;
                    case EPI_MEMV: {
                        const f32x4 r4 = *(const f32x4*)(((float*)(F.ws + WS_MRS)) + col);
                        v = v * r4;
                        float* o = F.out + O_MEMV + ((size_t)l * 4096 + col) * 1024 + row;
                        o[0] = v[0]; o[1024] = v[1]; o[2048] = v[2]; o[3072] = v[3];
                        const int b = col >> 8, h = row >> 8;
                        *(u32x2*)(((bf16_t*)(F.ws + WS_KV + 6144ull * 1024 * 2)) + ((size_t)(b * 4 + h) * 256 + (row & 255)) * 256 + (col & 255)) = pk4(v);
                    } break;
                    case EPI_OUTA: {
                        const f32x4 g = unpk4(*(const u32x2*)(((bf16_t*)(F.ws + WS_P)) + (size_t)row * LDP + C_GA + col));
                        f32x4 o; for (int j = 0; j < 4; ++j) o[j] = sigm(g[j]) * v[j];
                        *(u32x2*)(((bf16_t*)(F.ws + WS_P)) + (size_t)row * LDP + C_MRG + col) = pk4(o);
                    } break;
                    case EPI_OUTB: {
                        const f32x4 g = unpk4(*(const u32x2*)(((bf16_t*)(F.ws + WS_P)) + (size_t)row * LDP + C_GB + col));
                        f32x4 o = unpk4(*(const u32x2*)(((bf16_t*)(F.ws + WS_P)) + (size_t)row * LDP + C_MRG + col));
                        for (int j = 0; j < 4; ++j) o[j] += sigm(g[j]) * v[j];
                        *(u32x2*)(((bf16_t*)(F.ws + WS_P)) + (size_t)row * LDP + C_MRG + col) = pk4(o);
                    } break;
                    case EPI_ATTNO: {
                        const bool valid = d.vai < 0 || (d.vai == ai && d.vwr == wr);
                        if (valid) *(u32x2*)(((bf16_t*)(F.ws + WS_P)) + (size_t)row * LDP + C_O + d.head * 256 + col) = pk4(v);
                    } break;
                    default: break;
                    }
                }
            if (d.epi == EPI_RESID) {
                ss += __shfl_xor(ss, 16); ss += __shfl_xor(ss, 32);
                if (fq == 0) ((float*)(F.ws + WS_SSQ))[((size_t)(d.ocol >> 8) * TT + row) * 4 + wc] = ss;
            }
        }
}

enum { GP_IN = 0, GP_OUT, GP_WO, GP_MQ, GP_ATTN, GP_MO, GP_UP, GP_DOWN };
DEV void gemm_phase(const Frame& F0, int kind, int l) {
    REFRAME;
    int nunits = 0;
    switch (kind) { case GP_IN: case GP_UP: nunits = 130 * 22; break; case GP_OUT: nunits = 520 + 128; break; case GP_ATTN: nunits = 512 + 32; break; default: nunits = 520; }
    f32x4 acc[2][2][4][2];
    for (int u = F.bid; u < nunits; u += F.nb) {
        const int nsub = (kind == GP_ATTN || (kind == GP_OUT && u < 520)) ? 2 : 1;
        for (int sub = 0; sub < nsub; ++sub) {
            GDesc d; d.vai = -1; d.vwr = 0; d.head = 0;
            switch (kind) {
            case GP_IN: { const int pm = u / 22, pn = u % 22; d.A = ((bf16_t*)(F.ws + WS_XB)); d.lda = 1024; d.Bt = ((bf16_t*)(F.ws + WS_WMIX)) + WM_WIN; d.ldb = 1024; d.K = 1024; d.brow = pm * 256; d.bcol = pn * 256; d.epi = EPI_PROJ; d.orow = d.brow; d.ocol = d.bcol; } break;
            case GP_UP: { const int pm = u / 22, pn = u % 22; d.A = ((bf16_t*)(F.ws + WS_XB)); d.lda = 1024; d.Bt = ((bf16_t*)(F.ws + WS_WFFN)) + WF_UP; d.ldb = 1024; d.K = 1024; d.brow = pm * 256; d.bcol = pn * 256; d.epi = EPI_UP; d.orow = d.brow; d.ocol = d.bcol; } break;
            case GP_OUT:
                if (u < 520) { const int pm = u >> 2, pn = u & 3; d.A = ((bf16_t*)(F.ws + WS_P)) + (sub == 0 ? C_ZA : C_ZB); d.lda = LDP; d.Bt = ((bf16_t*)(F.ws + WS_WMIX)) + (sub == 0 ? WM_WOA : WM_WOB); d.ldb = 512; d.K = 512;
                               d.brow = pm * 256; d.bcol = pn * 256; d.epi = sub == 0 ? EPI_OUTA : EPI_OUTB; d.orow = d.brow; d.ocol = d.bcol; }
                else if (u < 520 + 64) { const int v = u - 520, pm = v >> 2, pn = v & 3; d.A = ((bf16_t*)(F.ws + WS_MB)); d.lda = 1024; d.Bt = ((bf16_t*)(F.ws + WS_WMIX)) + WM_WMK; d.ldb = 1024; d.K = 1024; d.brow = pm * 256; d.bcol = pn * 256; d.epi = EPI_MEMK; d.orow = d.brow; d.ocol = d.bcol; }
                else { const int v = u - 584, pm = v & 3, pn = v >> 2; d.A = ((bf16_t*)(F.ws + WS_WMIX)) + WM_WMV; d.lda = 1024; d.Bt = ((bf16_t*)(F.ws + WS_MB)); d.ldb = 1024; d.K = 1024; d.brow = pm * 256; d.bcol = pn * 256; d.epi = EPI_MEMV; d.orow = d.brow; d.ocol = d.bcol; }
                break;
            case GP_WO: { const int pm = u >> 2, pn = u & 3; d.A = ((bf16_t*)(F.ws + WS_P)) + C_MRG; d.lda = LDP; d.Bt = ((bf16_t*)(F.ws + WS_WMIX)) + WM_WO; d.ldb = 1024; d.K = 1024; d.brow = pm * 256; d.bcol = pn * 256; d.epi = EPI_RESID; d.orow = d.brow; d.ocol = d.bcol; } break;
            case GP_MQ: { const int pm = u >> 2, pn = u & 3; d.A = ((bf16_t*)(F.ws + WS_XB)); d.lda = 1024; d.Bt = ((bf16_t*)(F.ws + WS_WMIX)) + WM_WMQ; d.ldb = 1024; d.K = 1024; d.brow = pm * 256; d.bcol = pn * 256; d.epi = EPI_Q; d.orow = d.brow; d.ocol = d.bcol; } break;
            case GP_MO: { const int pm = u >> 2, pn = u & 3; d.A = ((bf16_t*)(F.ws + WS_P)) + C_O; d.lda = LDP; d.Bt = ((bf16_t*)(F.ws + WS_WMIX)) + WM_WMO; d.ldb = 1024; d.K = 1024; d.brow = pm * 256; d.bcol = pn * 256; d.epi = EPI_RESID; d.orow = d.brow; d.ocol = d.bcol; } break;
            case GP_DOWN: { const int pm = u >> 2, pn = u & 3; d.A = ((bf16_t*)(F.ws + WS_P)); d.lda = LDP; d.Bt = ((bf16_t*)(F.ws + WS_WFFN)) + WF_DN; d.ldb = 2816; d.K = 2816; d.brow = pm * 256; d.bcol = pn * 256; d.epi = EPI_RESID; d.orow = d.brow; d.ocol = d.bcol; } break;
            case GP_ATTN: {
                int pm, h, b;
                if (u < 512) { pm = u >> 2; h = u & 3; b = pm >> 3; }
                else { const int v = u - 512; h = v & 3; const int bi = (v >> 2) & 3, t = v >> 4; pm = 128 + t; b = 16 + 4 * t + bi; d.vai = bi >> 1; d.vwr = bi & 1; }
                d.head = h; d.brow = pm * 256; d.orow = d.brow; d.ocol = 0; d.K = 256; d.bcol = 0;
                if (sub == 0) { d.A = ((bf16_t*)(F.ws + WS_P)) + C_Q + h * 256; d.lda = LDP; d.Bt = ((bf16_t*)(F.ws + WS_KV)) + (size_t)b * 256 * 1024 + h * 256; d.ldb = 1024; d.epi = EPI_SOFTMAX; }
                else { d.A = ((bf16_t*)(F.ws + WS_P)) + C_PR + h * 256; d.lda = LDP; d.Bt = ((bf16_t*)(F.ws + WS_KV + 6144ull * 1024 * 2)) + (size_t)(b * 4 + h) * 65536; d.ldb = 256; d.epi = EPI_ATTNO; }
            } break;
            }
            gemm_core(d.A, d.lda, d.Bt, d.ldb, d.K, d.brow, d.bcol, acc, (bf16_t*)F.lds);
            gemm_epilogue(F, d, l, acc);
            if (nsub == 2) { __threadfence(); __syncthreads(); }
        }
    }
}

DEV void sample_kv(const Frame& F0, int l) {
    REFRAME;
    const float* ck = F.in[6] + (size_t)l * 2097152; const float* cv = F.in[7] + (size_t)l * 2097152;
    for (int i = F.bid * 512 + F.tid; i < 262144; i += F.nb * 512) {
        const f32x4 a = *(const f32x4*)(ck + (size_t)i * 8), b = *(const f32x4*)(ck + (size_t)i * 8 + 4);
        u32x4 w; w.x = pk2(a[0], a[1]); w.y = pk2(a[2], a[3]); w.z = pk2(b[0], b[1]); w.w = pk2(b[2], b[3]);
        *(u32x4*)(((bf16_t*)(F.ws + WS_KV)) + 4096ull * 1024 + (size_t)i * 8) = w;
        const int dd = i & 255, m8 = (i >> 8) & 31, h = (i >> 13) & 3, bb = i >> 15;
        const float* s = cv + ((size_t)(bb * 256 + m8 * 8) * 4 + h) * 256 + dd;
        u32x4 x; x.x = pk2(s[0], s[1024]); x.y = pk2(s[2048], s[3072]); x.z = pk2(s[4096], s[5120]); x.w = pk2(s[6144], s[7168]);
        *(u32x4*)(((bf16_t*)(F.ws + WS_KV + 6144ull * 1024 * 2)) + ((size_t)((16 + bb) * 4 + h) * 256 + dd) * 256 + m8 * 8) = x;
    }
}

DEV void g1_gdn(const Frame& F0, int l, int c, int h) {
    REFRAME;
    float* Fq = (float*)F.lds;
    bf16_t* VS = (bf16_t*)(F.lds + 66560);
    bf16_t* QN = (bf16_t*)(F.lds + 82944);
    bf16_t* KN = (bf16_t*)(F.lds + 100352);
    float* AM = (float*)(F.lds + 117760);
    float* sB = (float*)(F.lds + 135168); float* sG = sB + 64; float* sRQ = sB + 128; float* sRK = sB + 192;
    const int tid = F.tid, lane = F.lane, t0 = c * 64;
    const bool first = c >= 512 || (c & 31) == 0; const bool sample = c >= 512;
    __syncthreads();
    if (F.wid == 0) {
        const int t = t0 + lane;
        const float braw = ((float*)(F.ws + WS_SC))[(size_t)t * 32 + h], araw = ((float*)(F.ws + WS_SC))[(size_t)t * 32 + 4 + h];
        const float beta = sigm(braw);
        float g = -__expf(F.in[12][l * 4 + h]) * softplus(araw + F.in[13][l * 4 + h]);
#pragma unroll
        for (int off = 1; off < 64; off <<= 1) { const float n = __shfl_up(g, off); if (lane >= off) g += n; }
        sB[lane] = beta; sG[lane] = g;
        ((float*)(F.ws + WS_BG))[((size_t)c * 4 + h) * 128 + lane] = beta; ((float*)(F.ws + WS_BG))[((size_t)c * 4 + h) * 128 + 64 + lane] = g;
    }
    __syncthreads();
    const float* cw = F.in[11] + (size_t)l * 4 * 1536;
    for (int idx = tid; idx < 64 * 192; idx += 512) {
        const int r = idx / 192, cp = idx % 192, which = cp >> 6, cc = (cp & 63) * 2, pcol = which * 512 + h * 128 + cc;
        float a0 = 0.f, a1 = 0.f;
#pragma unroll
        for (int i = 0; i < 4; ++i) {
            const int src = r - 3 + i; float x0 = 0.f, x1 = 0.f;
            if (src >= 0) { const unsigned u = *(const unsigned*)(((bf16_t*)(F.ws + WS_P)) + (size_t)(t0 + src) * LDP + pcol); x0 = bflo(u); x1 = bfhi(u); }
            else if (!first) { const unsigned u = *(const unsigned*)(((bf16_t*)(F.ws + WS_KV)) + ((size_t)(c - 1) * 3 + (src + 3)) * 1536 + pcol); x0 = bflo(u); x1 = bfhi(u); }
            else if (sample) { const f32x2 f = *(const f32x2*)(F.in[3] + ((size_t)(l * 8 + (c - 512)) * 3 + (src + 3)) * 1536 + pcol); x0 = f[0]; x1 = f[1]; }
            const f32x2 w = *(const f32x2*)(cw + i * 1536 + pcol);
            a0 += w[0] * x0; a1 += w[1] * x1;
        }
        a0 = silu(a0); a1 = silu(a1);
        if (which < 2) { *(f32x2*)(Fq + r * 260 + which * 128 + cc) = (f32x2){a0, a1}; }
        else { const float be = sB[r]; *(unsigned*)(VS + r * 128 + cc) = pk2(a0 * be, a1 * be); }
    }
    __syncthreads();
    {
        const int r = tid >> 3, j = tid & 7; const float* p = Fq + r * 260 + j * 32; float s = 0.f;
#pragma unroll
        for (int i = 0; i < 32; ++i) s += p[i] * p[i];
        s += __shfl_xor(s, 1); s += __shfl_xor(s, 2);
        if ((j & 3) == 0) { if (j == 0) sRQ[r] = rsqrtf(s + 1e-6f) * 0.08838834764831845f; else sRK[r] = rsqrtf(s + 1e-6f); }
    }
    __syncthreads();
    for (int idx = tid; idx < 64 * 64; idx += 512) {
        const int r = idx >> 6, c4 = (idx & 63) * 4; const bool isq = c4 < 128;
        f32x4 v = *(const f32x4*)(Fq + r * 260 + c4); v = v * (isq ? sRQ[r] : sRK[r]);
        const u32x2 w = pk4(v);
        if (isq) { *(u32x2*)(QN + r * 136 + c4) = w; *(u32x2*)(((bf16_t*)(F.ws + WS_P)) + (size_t)(t0 + r) * LDP + C_QA + h * 128 + c4) = w; }
        else { *(u32x2*)(KN + r * 136 + c4 - 128) = w; *(u32x2*)(((bf16_t*)(F.ws + WS_P)) + (size_t)(t0 + r) * LDP + C_KA + h * 128 + c4 - 128) = w; }
    }
    for (int idx = tid; idx < 64 * 32; idx += 512) {
        const int r = idx >> 5, c4 = (idx & 31) * 4;
        *(u32x2*)(((bf16_t*)(F.ws + WS_P)) + (size_t)(t0 + r) * LDP + C_VA + h * 128 + c4) = *(const u32x2*)(VS + r * 128 + c4);
    }
    __syncthreads();
    {
        const int fr = lane & 15, fq = lane >> 4, which = F.wid >> 2, it = F.wid & 3;
        const bf16_t* X = which ? QN : KN;
        const int crow = 16 * it + fr; const float gc = sG[crow], bc = sB[crow];
        for (int jt = 0; jt < 4; ++jt) {
            f32x4 a = {0.f, 0.f, 0.f, 0.f};
            if (jt <= it) {
#pragma unroll
                for (int ks = 0; ks < 4; ++ks) a = MFMA16(ldfrag(KN, 16 * jt + fr, 136, 32 * ks, fq), ldfrag(X, crow, 136, 32 * ks, fq), a);
            }
            f32x4 o;
#pragma unroll
            for (int j = 0; j < 4; ++j) {
                const int s = 16 * jt + 4 * fq + j;
                const bool keep = which ? (s <= crow) : (s < crow);
                const float dec = keep ? __expf(gc - sG[s]) : 0.f;
                o[j] = a[j] * dec * (which ? 1.f : bc);
            }
            if (which) *(u32x2*)(((bf16_t*)(F.ws + WS_XB)) + (size_t)(t0 + crow) * LDE + h * 128 + 64 + 16 * jt + 4 * fq) = pk4(o);
            else *(f32x4*)(AM + crow * 68 + 16 * jt + 4 * fq) = o;
        }
    }
    __syncthreads();
    if (F.wid == 0) {
        float Tc[64]; const float lanef = (float)lane;
        typedef __attribute__((address_space(3))) const f32x4 LDSF4;
        __attribute__((address_space(3))) const char* aml = (__attribute__((address_space(3))) const char*)AM; asm volatile("" : "+v"(aml));
#pragma unroll
        for (int i = 0; i < 64; ++i) {
            float a = fmaxf(0.f, 1.f - fabsf(lanef - (float)i));
#pragma unroll
            for (int j4 = 0; j4 < (i + 3) / 4; ++j4) {
                const f32x4 av = *(const LDSF4*)(aml + (i * 68 + j4 * 4) * 4);
#pragma unroll
                for (int jj = 0; jj < 4; ++jj) if (j4 * 4 + jj < i) a -= av[jj] * Tc[j4 * 4 + jj];
            }
            Tc[i] = a;
        }
#pragma unroll
        for (int i = 0; i < 64; i += 2) {
            const unsigned w = pk2(Tc[i], Tc[i + 1]);
            ((bf16_t*)(F.ws + WS_XB))[(size_t)(t0 + i) * LDE + h * 128 + lane] = (bf16_t)(w & 0xffff);
            ((bf16_t*)(F.ws + WS_XB))[(size_t)(t0 + i + 1) * LDE + h * 128 + lane] = (bf16_t)(w >> 16);
        }
    }
}

DEV void g1_gla(const Frame& F0, int l, int c, int h) {
    REFRAME;
    float* GL = (float*)F.lds;
    float* LA = (float*)(F.lds + 4096);
    bf16_t* QG = (bf16_t*)(F.lds + 20736);
    bf16_t* KI = (bf16_t*)(F.lds + 29952);
    const int tid = F.tid, lane = F.lane, t0 = c * 64;
    __syncthreads();
    if (tid < 256) { const int r = tid >> 2, q4 = (tid & 3) * 4; *(f32x4*)(GL + r * 16 + q4) = *(const f32x4*)(((float*)(F.ws + WS_SC)) + (size_t)(t0 + r) * 32 + 8 + q4); }
    __syncthreads();
    {
        const int dk = tid & 63, rb = tid >> 6;
        float w2[16];
#pragma unroll
        for (int i = 0; i < 16; ++i) w2[i] = F.in[15][(size_t)(l * 16 + i) * 256 + h * 64 + dk];
        const float bias = F.in[16][l * 256 + h * 64 + dk];
#pragma unroll
        for (int rr = 0; rr < 8; ++rr) {
            const int r = rb * 8 + rr; float x = bias;
#pragma unroll
            for (int i = 0; i < 16; ++i) x += GL[r * 16 + i] * w2[i];
            LA[r * 65 + dk] = logsigmoid(x) * 0.0625f;
        }
    }
    __syncthreads();
    if (tid < 64) {
        float g = 0.f;
#pragma unroll 8
        for (int r = 0; r < 64; ++r) { g += LA[r * 65 + tid]; LA[r * 65 + tid] = g; }
        ((float*)(F.ws + WS_DL))[((size_t)c * 4 + h) * 64 + tid] = __expf(g);
    }
    __syncthreads();
    for (int idx = tid; idx < 64 * 16; idx += 512) {
        const int r = idx >> 4, c4 = (idx & 15) * 4;
        bf16_t* qp = ((bf16_t*)(F.ws + WS_P)) + (size_t)(t0 + r) * LDP + C_QB + h * 64 + c4; bf16_t* kp = ((bf16_t*)(F.ws + WS_P)) + (size_t)(t0 + r) * LDP + C_KB + h * 64 + c4;
        const f32x4 q = unpk4(*(const u32x2*)qp), k = unpk4(*(const u32x2*)kp);
        f32x4 qg, ki, kg;
#pragma unroll
        for (int j = 0; j < 4; ++j) { const float g = LA[r * 65 + c4 + j], gl = LA[63 * 65 + c4 + j];
            qg[j] = q[j] * 0.125f * __expf(g); ki[j] = k[j] * __expf(-g); kg[j] = k[j] * __expf(gl - g); }
        const u32x2 wq = pk4(qg);
        *(u32x2*)(QG + r * 72 + c4) = wq; *(u32x2*)(KI + r * 72 + c4) = pk4(ki);
        *(u32x2*)qp = wq; *(u32x2*)kp = pk4(kg);
    }
    __syncthreads();
    {
        const int fr = lane & 15, fq = lane >> 4, it = F.wid >> 1; const int crow = 16 * it + fr;
#pragma unroll
        for (int q = 0; q < 2; ++q) {
            const int jt = (F.wid & 1) * 2 + q;
            f32x4 a = {0.f, 0.f, 0.f, 0.f};
            if (jt <= it) {
#pragma unroll
                for (int ks = 0; ks < 2; ++ks) a = MFMA16(ldfrag(KI, 16 * jt + fr, 72, 32 * ks, fq), ldfrag(QG, crow, 72, 32 * ks, fq), a);
            }
#pragma unroll
            for (int j = 0; j < 4; ++j) if (16 * jt + 4 * fq + j > crow) a[j] = 0.f;
            *(u32x2*)(((bf16_t*)(F.ws + WS_XB)) + (size_t)(t0 + crow) * LDE + 512 + h * 64 + 16 * jt + 4 * fq) = pk4(a);
        }
    }
}

DEV void g2_gdn(const Frame& F0, int l, int s, int h) {
    REFRAME;
    bf16_t* QN = (bf16_t*)F.lds;
    bf16_t* KN = (bf16_t*)(F.lds + 17408);
    bf16_t* KT = (bf16_t*)(F.lds + 34816);
    bf16_t* TM = (bf16_t*)(F.lds + 53248);
    bf16_t* AQ = (bf16_t*)(F.lds + 62464);
    float* sB = (float*)(F.lds + 71680); float* sG = sB + 64;
    float* RED = (float*)(F.lds + 72192);
    const int tid = F.tid, lane = F.lane, w = F.wid, fr = lane & 15, fq = lane >> 4;
    const bool sample = s >= 16; const int nchunk = sample ? 1 : 32; const int tbase = sample ? 32768 + (s - 16) * 64 : s * 2048;
    const int dvc = h * 128 + 16 * w + fr;
    f32x4 S[8];
#pragma unroll
    for (int mt = 0; mt < 8; ++mt) {
        if (sample) { const float* sp = F.in[2] + ((size_t)((l * 8 + (s - 16)) * 4 + h) * 128) * 128;
#pragma unroll
            for (int j = 0; j < 4; ++j) S[mt][j] = sp[(size_t)(16 * mt + 4 * fq + j) * 128 + 16 * w + fr]; }
        else S[mt] = (f32x4){0.f, 0.f, 0.f, 0.f};
    }
    const float gn = F.in[14][l * 128 + 16 * w + fr];
    for (int n = 0; n < nchunk; ++n) {
        const int t0 = tbase + n * 64;
        __syncthreads();
#pragma unroll
        for (int i = 0; i < 2; ++i) {
            const int p = tid + 512 * i, r = p >> 4, c8 = (p & 15) * 8;
            const u32x4 q = *(const u32x4*)(((bf16_t*)(F.ws + WS_P)) + (size_t)(t0 + r) * LDP + C_QA + h * 128 + c8);
            const u32x4 k = *(const u32x4*)(((bf16_t*)(F.ws + WS_P)) + (size_t)(t0 + r) * LDP + C_KA + h * 128 + c8);
            *(u32x4*)(QN + r * 136 + c8) = q; *(u32x4*)(KN + r * 136 + c8) = k;
            KT[(c8 + 0) * 72 + r] = (bf16_t)(k.x & 0xffff); KT[(c8 + 1) * 72 + r] = (bf16_t)(k.x >> 16);
            KT[(c8 + 2) * 72 + r] = (bf16_t)(k.y & 0xffff); KT[(c8 + 3) * 72 + r] = (bf16_t)(k.y >> 16);
            KT[(c8 + 4) * 72 + r] = (bf16_t)(k.z & 0xffff); KT[(c8 + 5) * 72 + r] = (bf16_t)(k.z >> 16);
            KT[(c8 + 6) * 72 + r] = (bf16_t)(k.w & 0xffff); KT[(c8 + 7) * 72 + r] = (bf16_t)(k.w >> 16);
        }
        {
            const int r = tid >> 3, c8 = (tid & 7) * 8;
            *(u32x4*)(TM + r * 72 + c8) = *(const u32x4*)(((bf16_t*)(F.ws + WS_XB)) + (size_t)(t0 + r) * LDE + h * 128 + c8);
            *(u32x4*)(AQ + r * 72 + c8) = *(const u32x4*)(((bf16_t*)(F.ws + WS_XB)) + (size_t)(t0 + r) * LDE + h * 128 + 64 + c8);
        }
        if (tid < 128) sB[tid] = ((float*)(F.ws + WS_BG))[((size_t)(t0 >> 6) * 4 + h) * 128 + tid];
        __syncthreads();
        f32x4 kS[4], qS[4], vn[4], o[4];
#pragma unroll
        for (int mt = 0; mt < 4; ++mt) { kS[mt] = (f32x4){0.f, 0.f, 0.f, 0.f}; qS[mt] = kS[mt]; vn[mt] = kS[mt]; }
#pragma unroll
        for (int ks = 0; ks < 4; ++ks) {
            const bf16x8 sf = mk8(pk4(S[2 * ks]), pk4(S[2 * ks + 1]));
#pragma unroll
            for (int mt = 0; mt < 4; ++mt) {
                kS[mt] = MFMA16(ldfragp(KN, 16 * mt + fr, 136, 32 * ks, fq), sf, kS[mt]);
                qS[mt] = MFMA16(ldfragp(QN, 16 * mt + fr, 136, 32 * ks, fq), sf, qS[mt]);
            }
        }
        const float glast = sG[63];
        f32x4 eg[4], tmp[4];
#pragma unroll
        for (int mt = 0; mt < 4; ++mt)
#pragma unroll
            for (int j = 0; j < 4; ++j) {
                const int row = 16 * mt + 4 * fq + j;
                const float e = __expf(sG[row]); eg[mt][j] = e;
                const float vv = bf2f(((bf16_t*)(F.ws + WS_P))[(size_t)(t0 + row) * LDP + C_VA + dvc]);
                tmp[mt][j] = vv - sB[row] * e * kS[mt][j];
            }
#pragma unroll
        for (int ks = 0; ks < 2; ++ks) {
            const bf16x8 tf = mk8(pk4(tmp[2 * ks]), pk4(tmp[2 * ks + 1]));
#pragma unroll
            for (int mt = 0; mt < 4; ++mt) vn[mt] = MFMA16(ldfragp(TM, 16 * mt + fr, 72, 32 * ks, fq), tf, vn[mt]);
        }
#pragma unroll
        for (int mt = 0; mt < 4; ++mt) o[mt] = eg[mt] * qS[mt];
#pragma unroll
        for (int ks = 0; ks < 2; ++ks) {
            const bf16x8 vf = mk8(pk4(vn[2 * ks]), pk4(vn[2 * ks + 1]));
#pragma unroll
            for (int mt = 0; mt < 4; ++mt) o[mt] = MFMA16(ldfragp(AQ, 16 * mt + fr, 72, 32 * ks, fq), vf, o[mt]);
        }
        const float dl = __expf(glast);
#pragma unroll
        for (int mt = 0; mt < 4; ++mt)
#pragma unroll
            for (int j = 0; j < 4; ++j) vn[mt][j] *= __expf(glast - sG[16 * mt + 4 * fq + j]);
#pragma unroll
        for (int mt = 0; mt < 8; ++mt) S[mt] = S[mt] * dl;
#pragma unroll
        for (int ks = 0; ks < 2; ++ks) {
            const bf16x8 vf = mk8(pk4(vn[2 * ks]), pk4(vn[2 * ks + 1]));
#pragma unroll
            for (int mt = 0; mt < 8; ++mt) S[mt] = MFMA16(ldfragp(KT, 16 * mt + fr, 72, 32 * ks, fq), vf, S[mt]);
        }
#pragma unroll
        for (int mt = 0; mt < 4; ++mt)
#pragma unroll
            for (int j = 0; j < 4; ++j) {
                float p = o[mt][j] * o[mt][j];
                p += __shfl_xor(p, 1); p += __shfl_xor(p, 2); p += __shfl_xor(p, 4); p += __shfl_xor(p, 8);
                if (fr == 0) RED[(16 * mt + 4 * fq + j) * 8 + w] = p;
            }
        __syncthreads();
#pragma unroll
        for (int mt = 0; mt < 4; ++mt)
#pragma unroll
            for (int j = 0; j < 4; ++j) {
                const int row = 16 * mt + 4 * fq + j;
                const f32x4 r0 = *(const f32x4*)(RED + row * 8), r1 = *(const f32x4*)(RED + row * 8 + 4);
                const float ssum = ((r0[0] + r0[1]) + (r0[2] + r0[3])) + ((r1[0] + r1[1]) + (r1[2] + r1[3]));
                const float rs = rsqrtf(ssum * (1.f / 128.f) + 1e-6f);
                bf16_t* zp = ((bf16_t*)(F.ws + WS_P)) + (size_t)(t0 + row) * LDP + C_ZA + dvc;
                const float z = bf2f(*zp);
                *zp = (bf16_t)(pk2(o[mt][j] * rs * gn * silu(z), 0.f) & 0xffff);
            }
    }
    float* so = sample ? F.out + O_GDN_S + ((size_t)((l * 8 + (s - 16)) * 4 + h) * 128) * 128 : F.out + O_GDN_P + ((size_t)((l * 16 + s) * 4 + h) * 128) * 128;
#pragma unroll
    for (int mt = 0; mt < 8; ++mt)
#pragma unroll
        for (int j = 0; j < 4; ++j) so[(size_t)(16 * mt + 4 * fq + j) * 128 + 16 * w + fr] = S[mt][j];
}

DEV void g2_gla(const Frame& F0, int l, int s, int h) {
    REFRAME;
    bf16_t* QG = (bf16_t*)F.lds;
    bf16_t* KGT = (bf16_t*)(F.lds + 9216);
    bf16_t* AQ = (bf16_t*)(F.lds + 18432);
    float* sDL = (float*)(F.lds + 27648);
    float* RED = (float*)(F.lds + 27904);
    const int tid = F.tid, lane = F.lane, w = F.wid, fr = lane & 15, fq = lane >> 4;
    const bool sample = s >= 16; const int nchunk = sample ? 1 : 32; const int tbase = sample ? 32768 + (s - 16) * 64 : s * 2048;
    const int dvc = h * 128 + 16 * w + fr;
    f32x4 S[4];
#pragma unroll
    for (int mt = 0; mt < 4; ++mt) {
        if (sample) { const float* sp = F.in[4] + ((size_t)((l * 8 + (s - 16)) * 4 + h) * 64) * 128;
#pragma unroll
            for (int j = 0; j < 4; ++j) S[mt][j] = sp[(size_t)(16 * mt + 4 * fq + j) * 128 + 16 * w + fr]; }
        else S[mt] = (f32x4){0.f, 0.f, 0.f, 0.f};
    }
    const float gn = F.in[17][l * 128 + 16 * w + fr];
    for (int n = 0; n < nchunk; ++n) {
        const int t0 = tbase + n * 64, chunk = t0 >> 6;
        __syncthreads();
        {
            const int r = tid >> 3, c8 = (tid & 7) * 8;
            *(u32x4*)(QG + r * 72 + c8) = *(const u32x4*)(((bf16_t*)(F.ws + WS_P)) + (size_t)(t0 + r) * LDP + C_QB + h * 64 + c8);
            const u32x4 k = *(const u32x4*)(((bf16_t*)(F.ws + WS_P)) + (size_t)(t0 + r) * LDP + C_KB + h * 64 + c8);
            KGT[(c8 + 0) * 72 + r] = (bf16_t)(k.x & 0xffff); KGT[(c8 + 1) * 72 + r] = (bf16_t)(k.x >> 16);
            KGT[(c8 + 2) * 72 + r] = (bf16_t)(k.y & 0xffff); KGT[(c8 + 3) * 72 + r] = (bf16_t)(k.y >> 16);
            KGT[(c8 + 4) * 72 + r] = (bf16_t)(k.z & 0xffff); KGT[(c8 + 5) * 72 + r] = (bf16_t)(k.z >> 16);
            KGT[(c8 + 6) * 72 + r] = (bf16_t)(k.w & 0xffff); KGT[(c8 + 7) * 72 + r] = (bf16_t)(k.w >> 16);
            *(u32x4*)(AQ + r * 72 + c8) = *(const u32x4*)(((bf16_t*)(F.ws + WS_XB)) + (size_t)(t0 + r) * LDE + 512 + h * 64 + c8);
        }
        if (tid < 64) sDL[tid] = ((float*)(F.ws + WS_DL))[((size_t)chunk * 4 + h) * 64 + tid];
        bf16x8 vf[2];
#pragma unroll
        for (int ks = 0; ks < 2; ++ks) {
            unsigned e[8];
#pragma unroll
            for (int j = 0; j < 8; ++j) { const int row = 32 * ks + (j < 4 ? 4 * fq + j : 16 + 4 * fq + (j - 4)); e[j] = ((bf16_t*)(F.ws + WS_P))[(size_t)(t0 + row) * LDP + C_VB + dvc]; }
            u32x4 t; t.x = e[0] | (e[1] << 16); t.y = e[2] | (e[3] << 16); t.z = e[4] | (e[5] << 16); t.w = e[6] | (e[7] << 16);
            vf[ks] = __builtin_bit_cast(bf16x8, t);
        }
        __syncthreads();
        f32x4 o[4];
#pragma unroll
        for (int mt = 0; mt < 4; ++mt) o[mt] = (f32x4){0.f, 0.f, 0.f, 0.f};
#pragma unroll
        for (int ks = 0; ks < 2; ++ks) {
            const bf16x8 sf = mk8(pk4(S[2 * ks]), pk4(S[2 * ks + 1]));
#pragma unroll
            for (int mt = 0; mt < 4; ++mt) {
                o[mt] = MFMA16(ldfragp(QG, 16 * mt + fr, 72, 32 * ks, fq), sf, o[mt]);
                o[mt] = MFMA16(ldfragp(AQ, 16 * mt + fr, 72, 32 * ks, fq), vf[ks], o[mt]);
            }
        }
#pragma unroll
        for (int mt = 0; mt < 4; ++mt) {
#pragma unroll
            for (int j = 0; j < 4; ++j) S[mt][j] *= sDL[16 * mt + 4 * fq + j];
#pragma unroll
            for (int ks = 0; ks < 2; ++ks) S[mt] = MFMA16(ldfragp(KGT, 16 * mt + fr, 72, 32 * ks, fq), vf[ks], S[mt]);
        }
#pragma unroll
        for (int mt = 0; mt < 4; ++mt)
#pragma unroll
            for (int j = 0; j < 4; ++j) {
                float p = o[mt][j] * o[mt][j];
                p += __shfl_xor(p, 1); p += __shfl_xor(p, 2); p += __shfl_xor(p, 4); p += __shfl_xor(p, 8);
                if (fr == 0) RED[(16 * mt + 4 * fq + j) * 8 + w] = p;
            }
        __syncthreads();
#pragma unroll
        for (int mt = 0; mt < 4; ++mt)
#pragma unroll
            for (int j = 0; j < 4; ++j) {
                const int row = 16 * mt + 4 * fq + j;
                const f32x4 r0 = *(const f32x4*)(RED + row * 8), r1 = *(const f32x4*)(RED + row * 8 + 4);
                const float ssum = ((r0[0] + r0[1]) + (r0[2] + r0[3])) + ((r1[0] + r1[1]) + (r1[2] + r1[3]));
                const float rs = rsqrtf(ssum * (1.f / 128.f) + 1e-6f);
                bf16_t* zp = ((bf16_t*)(F.ws + WS_P)) + (size_t)(t0 + row) * LDP + C_ZB + dvc;
                const float z = bf2f(*zp);
                *zp = (bf16_t)(pk2(o[mt][j] * rs * gn * silu(z), 0.f) & 0xffff);
            }
    }
    float* so = sample ? F.out + O_GLA_S + ((size_t)((l * 8 + (s - 16)) * 4 + h) * 64) * 128 : F.out + O_GLA_P + ((size_t)((l * 16 + s) * 4 + h) * 64) * 128;
#pragma unroll
    for (int mt = 0; mt < 4; ++mt)
#pragma unroll
        for (int j = 0; j < 4; ++j) so[(size_t)(16 * mt + 4 * fq + j) * 128 + 16 * w + fr] = S[mt][j];
}

DEV void ffn_mid(const Frame& F0, int l) {
    REFRAME;
    const float* cw = F.in[29] + (size_t)l * 3 * 5632; const float* cb = F.in[30] + (size_t)l * 5632;
    const int total = NCH * 1408;
    for (int idx = F.bid * 512 + F.tid; idx < total; idx += F.nb * 512) {
        const int c = idx / 1408, cp = idx % 1408, col = cp * 2;
        const bool first = c >= 512 || (c & 31) == 0, sample = c >= 512;
        float g2[2] = {0.f, 0.f}, g1[2] = {0.f, 0.f}, v2[2] = {0.f, 0.f}, v1[2] = {0.f, 0.f};
        if (!first) {
            const bf16_t* hp = ((bf16_t*)(F.ws + WS_KV)) + (size_t)(c - 1) * 2 * 5632;
            unsigned u = *(const unsigned*)(hp + col); g2[0] = bflo(u); g2[1] = bfhi(u);
            u = *(const unsigned*)(hp + 5632 + col); g1[0] = bflo(u); g1[1] = bfhi(u);
            u = *(const unsigned*)(hp + 2816 + col); v2[0] = bflo(u); v2[1] = bfhi(u);
            u = *(const unsigned*)(hp + 5632 + 2816 + col); v1[0] = bflo(u); v1[1] = bfhi(u);
        } else if (sample) {
            const float* sp = F.in[5] + (size_t)(l * 8 + (c - 512)) * 2 * 5632;
            g2[0] = sp[col]; g2[1] = sp[col + 1]; g1[0] = sp[5632 + col]; g1[1] = sp[5632 + col + 1];
            v2[0] = sp[2816 + col]; v2[1] = sp[2816 + col + 1]; v1[0] = sp[5632 + 2816 + col]; v1[1] = sp[5632 + 2816 + col + 1];
        }
        const f32x2 wg0 = *(const f32x2*)(cw + col), wg1 = *(const f32x2*)(cw + 5632 + col), wg2 = *(const f32x2*)(cw + 2 * 5632 + col), bg = *(const f32x2*)(cb + col);
        const f32x2 wv0 = *(const f32x2*)(cw + 2816 + col), wv1 = *(const f32x2*)(cw + 5632 + 2816 + col), wv2 = *(const f32x2*)(cw + 2 * 5632 + 2816 + col), bv = *(const f32x2*)(cb + 2816 + col);
        bf16_t* up = ((bf16_t*)(F.ws + WS_P)) + (size_t)c * 64 * LDP + col;
#pragma unroll 8
        for (int r = 0; r < 64; ++r) {
            const unsigned ug = *(const unsigned*)(up + (size_t)r * LDP), uv = *(const unsigned*)(up + (size_t)r * LDP + 2816);
            const float g0[2] = {bflo(ug), bfhi(ug)}, v0[2] = {bflo(uv), bfhi(uv)};
            const float yg0 = wg0[0] * g2[0] + wg1[0] * g1[0] + wg2[0] * g0[0] + bg[0], yg1 = wg0[1] * g2[1] + wg1[1] * g1[1] + wg2[1] * g0[1] + bg[1];
            const float yv0 = wv0[0] * v2[0] + wv1[0] * v1[0] + wv2[0] * v0[0] + bv[0], yv1 = wv0[1] * v2[1] + wv1[1] * v1[1] + wv2[1] * v0[1] + bv[1];
            *(unsigned*)(up + (size_t)r * LDP) = pk2(silu(yg0) * yv0, silu(yg1) * yv1);
            g2[0] = g1[0]; g2[1] = g1[1]; g1[0] = g0[0]; g1[1] = g0[1]; v2[0] = v1[0]; v2[1] = v1[1]; v1[0] = v0[0]; v1[1] = v0[1];
        }
    }
}

DEV void final_norm(const Frame& F0) {
    REFRAME;
    const int gw = F.bid * 8 + F.wid, nw = F.nb * 8, lane = F.lane;
    const float* g = F.in[32];
    for (int row = gw; row < TT; row += nw) {
        const float rs = row_rstd(((float*)(F.ws + WS_SSQ)), row);
        float* X = F.out + (size_t)row * 1024;
#pragma unroll
        for (int i = 0; i < 4; ++i) { const int cidx = i * 256 + lane * 4; f32x4 v = *(const f32x4*)(X + cidx); const f32x4 gg = *(const f32x4*)(g + cidx); *(f32x4*)(X + cidx) = v * rs * gg; }
    }
}

#ifdef DBG_COL
DEV void dbg_dump(const Frame& F0) {
    REFRAME;
    for (int i = F.bid * 512 + F.tid; i < TT * 256; i += F.nb * 512) {
        const int row = i >> 8, c = (i & 255) * 4;
        const f32x4 v = c < 512 ? unpk4(*(const u32x2*)(((bf16_t*)(F.ws + WS_P)) + (size_t)row * LDP + DBG_COL + c)) : (f32x4){0.f, 0.f, 0.f, 0.f};
        *(f32x4*)(F.out + (size_t)row * 1024 + c) = (row DBG_ROWSEL) ? v : (f32x4){0.f, 0.f, 0.f, 0.f};
    }
}
#endif
__global__ void __launch_bounds__(512, 2) fwd_kernel(Params p) {
    extern __shared__ __attribute__((aligned(16))) unsigned char lds[];
    cg::grid_group grid = cg::this_grid();
    Frame F;
    F.in = (InTab)__builtin_amdgcn_kernarg_segment_ptr(); F.out = p.out; F.ws = p.ws; F.lds = lds;
    F.tid = threadIdx.x; F.lane = threadIdx.x & 63; F.wid = __builtin_amdgcn_readfirstlane(threadIdx.x >> 6); F.nb = gridDim.x; F.bid = blockIdx.x;
    for (int ph = p.ph_lo; ph < p.ph_hi; ++ph) {
#ifndef PHM
#define PHM 0xffff
#endif
        if (ph == 0) { if (PHM & 0x1000) phase0(F); }
        else if (ph == NPH - 1) { if (PHM & 0x2000) final_norm(F); }
        else {
            const int l = (ph - 1) / 11, k = (ph - 1) % 11;
            int gk = -1;
            switch (k) { case 0: gk = GP_IN; break; case 3: gk = GP_OUT; break; case 4: gk = GP_WO; break; case 5: gk = GP_MQ; break; case 6: gk = GP_ATTN; break;
                         case 7: gk = GP_MO; break; case 8: gk = GP_UP; break; case 10: gk = GP_DOWN; break; default: break; }
#ifndef REPMASK
#define REPMASK 0
#endif
            if (gk >= 0 && (PHM & 1)) { const int nrep = ((REPMASK >> k) & 1) ? 2 : 1; for (int rep = 0; rep < nrep; ++rep) gemm_phase(F, gk, l); }
            if (k == 0 && (PHM & 1)) small_proj(F);
            if (k == 3 && (PHM & 8)) sample_kv(F, l);
            if (k == 1 && (PHM & 2)) {
                for (int it = F.bid; it < NCH * 8; it += F.nb) { const int c = it >> 3, h = it & 3; if (it & 4) g1_gla(F, l, c, h); else g1_gdn(F, l, c, h); }
                __syncthreads();
                if (l > 0) cvt_ffn(F, l);
            }
            if (k == 2 && (PHM & 4)) {
                for (int it = F.bid; it < 192; it += F.nb) {
                    int s, h, br;
                    if (it < 128) { br = it & 1; h = (it >> 1) & 3; s = it >> 3; } else { const int v = it - 128; br = v & 1; h = (v >> 1) & 3; s = 16 + (v >> 3); }
                    if (br) g2_gla(F, l, s, h); else g2_gdn(F, l, s, h);
                    __syncthreads();
                }
            }
            if (k == 9 && (PHM & 0x200)) { ffn_mid(F, l); if (l < 3) { __syncthreads(); cvt_mixer(F, l + 1); } }
        }
#ifndef SYNCREP
#define SYNCREP 1
#endif
        if (ph + 1 < p.ph_hi) { for (int sr = 0; sr < SYNCREP; ++sr) { grid.sync(); } }
    }
#ifdef DBG_COL
    __threadfence(); grid.sync(); __threadfence();
    dbg_dump(F);
#endif
}

extern "C" void kernel_launch(void* const* d_in, const int* in_sizes, int n_in, void* d_out, int out_size, void* d_ws, size_t ws_size, hipStream_t stream) {
    static int grid_blocks = 0;
    if (grid_blocks == 0) {
        if (n_in != 33 || ws_size < WS_TOTAL) { fprintf(stderr, "kernel_launch: bad n_in %d or ws %zu < %zu\n", n_in, ws_size, (size_t)WS_TOTAL); grid_blocks = -1; return; }
        int dev = 0, cus = 0, per_cu = 0;
        hipGetDevice(&dev);
        hipDeviceGetAttribute(&cus, hipDeviceAttributeMultiprocessorCount, dev);
        if (hipFuncSetAttribute((const void*)fwd_kernel, hipFuncAttributeMaxDynamicSharedMemorySize, LDS_BYTES) != hipSuccess) { fprintf(stderr, "hipFuncSetAttribute failed\n"); grid_blocks = -1; return; }
        hipOccupancyMaxActiveBlocksPerMultiprocessor(&per_cu, (const void*)fwd_kernel, 512, LDS_BYTES);
        if (per_cu < 1) per_cu = 1;
        (void)hipGetLastError();
        grid_blocks = cus * 1;
        if (grid_blocks <= 0) grid_blocks = 256;
    }
    if (grid_blocks < 0) return;
    Params p{};
    for (int i = 0; i < 33; ++i) p.in[i] = (const float*)d_in[i];
    p.out = (float*)d_out; p.ws = (unsigned char*)d_ws; p.ph_lo = 0; p.ph_hi = PH_HI;
    void* args[] = {&p};
    hipError_t e = hipLaunchCooperativeKernel((const void*)fwd_kernel, dim3(grid_blocks), dim3(512), args, LDS_BYTES, stream);
    if (e != hipSuccess) fprintf(stderr, "cooperative launch failed: %s (grid %d)\n", hipGetErrorString(e), grid_blocks);
}
```

```cpp
#include <hip/hip_runtime.h>
#include <hip/hip_cooperative_groups.h>
#include <cstdint>
#include <cstdio>
namespace cg = cooperative_groups;

typedef unsigned short bf16_t;
typedef short bf16x8 __attribute__((ext_vector_type(8)));
typedef float f32x4 __attribute__((ext_vector_type(4)));
typedef float f32x2 __attribute__((ext_vector_type(2)));
typedef unsigned u32x2 __attribute__((ext_vector_type(2)));
typedef unsigned u32x4 __attribute__((ext_vector_type(4)));
#define DEV __device__ __forceinline__

constexpr int DM = 1024, TT = 33280, NCH = 520, LDP = 5632, LDE = 768;
constexpr int C_QA = 0, C_KA = 512, C_VA = 1024, C_ZA = 1536, C_QB = 2048, C_KB = 2304, C_VB = 2560, C_ZB = 3072, C_GA = 3584, C_GB = 4608;
constexpr int C_MRG = 0, C_PR = 1024, C_Q = 2048, C_O = 3072;
constexpr size_t O_Y = 0;
constexpr size_t O_GDN_P = 34078720ull;
constexpr size_t O_GDNC_P = O_GDN_P + 4194304ull;
constexpr size_t O_GLA_P = O_GDNC_P + 294912ull;
constexpr size_t O_FFNC_P = O_GLA_P + 2097152ull;
constexpr size_t O_MEMK = O_FFNC_P + 720896ull;
constexpr size_t O_MEMV = O_MEMK + 16777216ull;
constexpr size_t O_GDN_S = O_MEMV + 16777216ull;
constexpr size_t O_GDNC_S = O_GDN_S + 2097152ull;
constexpr size_t O_GLA_S = O_GDNC_S + 147456ull;
constexpr size_t O_FFNC_S = O_GLA_S + 1048576ull;
constexpr size_t al256(size_t x) { return (x + 255) & ~(size_t)255; }
constexpr size_t WS_WMIX = 0;
constexpr size_t WM_WIN = 0, WM_WSM = WM_WIN + 5632ull * 1024, WM_WOA = WM_WSM + 32 * 1024, WM_WOB = WM_WOA + 524288, WM_WO = WM_WOB + 524288,
                 WM_WMQ = WM_WO + 1048576, WM_WMK = WM_WMQ + 1048576, WM_WMV = WM_WMK + 1048576, WM_WMO = WM_WMV + 1048576, WM_END = WM_WMO + 1048576;
constexpr size_t WS_WFFN = al256(WS_WMIX + WM_END * 2);
constexpr size_t WF_UP = 0, WF_DN = 5632ull * 1024, WF_END = WF_DN + 1024ull * 2816;
constexpr size_t WS_XB = al256(WS_WFFN + WF_END * 2);
constexpr size_t WS_P = al256(WS_XB + (size_t)TT * 1024 * 2);
constexpr size_t WS_KV = al256(WS_P + (size_t)TT * LDP * 2);
constexpr size_t KV_BYTES = 2ull * 6144 * 1024 * 2;
constexpr size_t WS_MB = al256(WS_KV + KV_BYTES);
constexpr size_t WS_MRS = al256(WS_MB + 4096ull * 1024 * 2);
constexpr size_t WS_SSQ = al256(WS_MRS + 4096 * 4);
constexpr size_t WS_SC = al256(WS_SSQ + (size_t)TT * 16 * 4);
constexpr size_t WS_DL = al256(WS_SC + (size_t)TT * 32 * 4);
constexpr size_t WS_BG = al256(WS_DL + 520ull * 4 * 64 * 4);
constexpr size_t WS_TOTAL = al256(WS_BG + 520ull * 4 * 128 * 4);
constexpr int LDS_BYTES = 147456;
constexpr int NPH = 54;
#ifndef PH_HI
#define PH_HI NPH
#define REPMASK 0
#define SYNCREP 1
#define DRYMASK 0
#endif

struct Params { const float* in[33]; float* out; unsigned char* ws; int ph_lo, ph_hi; };

typedef __bf16 bf16x2_t __attribute__((ext_vector_type(2)));
DEV unsigned pk2(float lo, float hi) { f32x2 f = {lo, hi}; bf16x2_t v = __builtin_convertvector(f, bf16x2_t); return __builtin_bit_cast(unsigned, v); }
DEV float bf2f(bf16_t b) { return __uint_as_float(((unsigned)b) << 16); }
DEV float bflo(unsigned u) { return __uint_as_float(u << 16); }
DEV float bfhi(unsigned u) { return __uint_as_float(u & 0xffff0000u); }
DEV u32x2 pk4(f32x4 v) { u32x2 r; r.x = pk2(v[0], v[1]); r.y = pk2(v[2], v[3]); return r; }
DEV f32x4 unpk4(u32x2 u) { return (f32x4){bflo(u.x), bfhi(u.x), bflo(u.y), bfhi(u.y)}; }
DEV bf16x8 mk8(u32x2 a, u32x2 b) { u32x4 t = {a.x, a.y, b.x, b.y}; return __builtin_bit_cast(bf16x8, t); }
DEV float sigm(float x) { return 1.f / (1.f + __expf(-x)); }
DEV float silu(float x) { return x / (1.f + __expf(-x)); }
DEV float softplus(float x) { return x > 20.f ? x : __logf(1.f + __expf(x)); }
DEV float logsigmoid(float x) { return fminf(x, 0.f) - __logf(1.f + __expf(-fabsf(x))); }
DEV float row_rstd(const float* ssq, int row) {
    const f32x4 a = *(const f32x4*)(ssq + (size_t)row * 4), b = *(const f32x4*)(ssq + ((size_t)TT + row) * 4);
    const f32x4 c = *(const f32x4*)(ssq + ((size_t)2 * TT + row) * 4), d = *(const f32x4*)(ssq + ((size_t)3 * TT + row) * 4);
    float s = ((a[0] + a[1]) + (a[2] + a[3])) + ((b[0] + b[1]) + (b[2] + b[3])) + ((c[0] + c[1]) + (c[2] + c[3])) + ((d[0] + d[1]) + (d[2] + d[3]));
    return rsqrtf(s * (1.f / 1024.f) + 1e-6f);
}
DEV bf16x8 ldfragp(const bf16_t* base, int row, int stride, int k0, int fq) {
    const bf16_t* p = base + row * stride + k0 + 4 * fq;
    return mk8(*(const u32x2*)p, *(const u32x2*)(p + 16));
}
DEV bf16x8 ldfrag(const bf16_t* base, int row, int stride, int k0, int fq) {
    return *(const bf16x8*)(base + row * stride + k0 + 8 * fq);
}
#define MFMA16(a, b, c) __builtin_amdgcn_mfma_f32_16x16x32_bf16((a), (b), (c), 0, 0, 0)

constexpr int BM = 256, BK = 64, HALF = 128, HT = HALF * BK;
DEV int lds_byte(int r, int c) { int st = (r >> 4) * 2 + (c >> 5), rr = r & 15, cc = c & 31, ob = rr * 64 + cc * 2; return st * 1024 + (ob ^ (((ob >> 9) & 1) << 5)); }
DEV void stage_rc(int b, int& R, int& C) { int st = b / 1024, sb = b % 1024, swz = sb ^ (((sb >> 9) & 1) << 5); R = (st >> 1) * 16 + swz / 64; C = (st & 1) * 32 + (swz % 64) / 2; }

DEV void gemm_core(const bf16_t* __restrict__ A, int lda, const bf16_t* __restrict__ Bt, int ldb, int K, int brow, int bcol, f32x4 (&acc)[2][2][4][2], bf16_t* shm) {
#define SA(b, h) (shm + ((b) * 2 + (h)) * HT)
#define SB(b, h) (shm + (4 + (b) * 2 + (h)) * HT)
#define STAGE(P, BASE, LD, br, kt) do { const char* _gb = (const char*)((BASE) + (long)(br) * (LD) + (long)(kt) * BK); \
    const unsigned _vo = (unsigned)((sr0 * (int)(LD) + sc0) * 2); \
    for (int _i = 0; _i < 2; ++_i) { \
      __builtin_amdgcn_global_load_lds((const unsigned*)(_gb + (long)(_i * 128) * (LD) + _vo), (unsigned*)((char*)(P) + wbase + _i * 8192), 16, 0, 0); } } while (0)
#define LDA(dst, b, h) for (int m = 0; m < 4; ++m) for (int k = 0; k < 2; ++k) \
    dst[m][k] = *reinterpret_cast<const bf16x8*>((char*)SA(b, h) + lds_byte(wr * 64 + m * 16 + fr, k * 32 + fq * 8))
#define LDB(dst, b, h) for (int n = 0; n < 2; ++n) for (int k = 0; k < 2; ++k) \
    dst[n][k] = *reinterpret_cast<const bf16x8*>((char*)SB(b, h) + lds_byte(wc * 32 + n * 16 + fr, k * 32 + fq * 8))
#define MMA(ai, bj, At_, Bt_) do { __builtin_amdgcn_s_setprio(1); \
    for (int m = 0; m < 4; ++m) for (int n = 0; n < 2; ++n) for (int k = 0; k < 2; ++k) \
      acc[ai][bj][m][n] = __builtin_amdgcn_mfma_f32_16x16x32_bf16(Bt_[n][k], At_[m][k], acc[ai][bj][m][n], 0, 0, 0); \
    __builtin_amdgcn_s_setprio(0); } while (0)
#define WAIT_V(n) asm volatile("s_waitcnt vmcnt(" #n ")" ::: "memory")
#define WAIT_L(n) asm volatile("s_waitcnt lgkmcnt(" #n ")" ::: "memory")
#define BAR __builtin_amdgcn_s_barrier()
#define SCHED __builtin_amdgcn_sched_barrier(0)
    int tidx = threadIdx.x; asm volatile("" : "+v"(tidx));
    const int wid = __builtin_amdgcn_readfirstlane(tidx >> 6), lane = tidx & 63, wr = wid >> 2, wc = wid & 3, fr = lane & 15, fq = lane >> 4;
    const int wbase = wid * 1024;
    int sr0, sc0; stage_rc(tidx * 16, sr0, sc0);
#pragma unroll
    for (int a = 0; a < 2; ++a)
#pragma unroll
        for (int b = 0; b < 2; ++b)
#pragma unroll
            for (int m = 0; m < 4; ++m)
#pragma unroll
                for (int n = 0; n < 2; ++n) acc[a][b][m][n] = (f32x4){0.f, 0.f, 0.f, 0.f};
    bf16x8 At[4][2], B0[2][2], B1[2][2];
    const int nt = K / BK;
    STAGE(SB(0, 0), Bt, ldb, bcol, 0); STAGE(SA(0, 0), A, lda, brow, 0);
    STAGE(SB(0, 1), Bt, ldb, bcol + HALF, 0); STAGE(SA(0, 1), A, lda, brow + HALF, 0);
    if (wr == 1) BAR;
    WAIT_V(4); BAR;
    STAGE(SB(1, 0), Bt, ldb, bcol, 1); STAGE(SA(1, 0), A, lda, brow, 1); STAGE(SB(1, 1), Bt, ldb, bcol + HALF, 1);
    WAIT_V(6); BAR;
    for (int t = 0; t < nt - 2; t += 2) {
        LDB(B0, 0, 0); SCHED; LDA(At, 0, 0); STAGE(SA(1, 1), A, lda, brow + HALF, t + 1);
        WAIT_L(8); BAR; WAIT_L(0); MMA(0, 0, At, B0); BAR; SCHED;
        LDB(B1, 0, 1); STAGE(SB(0, 0), Bt, ldb, bcol, t + 2);
        BAR; WAIT_L(0); MMA(0, 1, At, B1); BAR;
        LDA(At, 0, 1); STAGE(SA(0, 0), A, lda, brow, t + 2);
        BAR; WAIT_L(0); MMA(1, 0, At, B0); BAR; SCHED;
        STAGE(SB(0, 1), Bt, ldb, bcol + HALF, t + 2);
        WAIT_V(6); BAR; MMA(1, 1, At, B1); BAR;
        LDB(B0, 1, 0); SCHED; LDA(At, 1, 0); STAGE(SA(0, 1), A, lda, brow + HALF, t + 2);
        WAIT_L(8); BAR; WAIT_L(0); MMA(0, 0, At, B0); BAR; SCHED;
        LDB(B1, 1, 1); STAGE(SB(1, 0), Bt, ldb, bcol, t + 3);
        BAR; WAIT_L(0); MMA(0, 1, At, B1); BAR;
        LDA(At, 1, 1); STAGE(SA(1, 0), A, lda, brow, t + 3);
        BAR; WAIT_L(0); MMA(1, 0, At, B0); BAR; SCHED;
        STAGE(SB(1, 1), Bt, ldb, bcol + HALF, t + 3);
        WAIT_V(6); BAR; MMA(1, 1, At, B1); BAR;
    }
    { LDB(B0, 0, 0); LDA(At, 0, 0); STAGE(SA(1, 1), A, lda, brow + HALF, nt - 1);
      BAR; WAIT_L(0); MMA(0, 0, At, B0); BAR;
      LDB(B1, 0, 1); BAR; WAIT_L(0); MMA(0, 1, At, B1); BAR;
      LDA(At, 0, 1); WAIT_V(4); BAR; WAIT_L(0); MMA(1, 0, At, B0); MMA(1, 1, At, B1); BAR; }
    { LDB(B0, 1, 0); LDA(At, 1, 0); WAIT_V(2); BAR; WAIT_L(0); MMA(0, 0, At, B0); BAR;
      LDB(B1, 1, 1); WAIT_V(0); BAR; WAIT_L(0); MMA(0, 1, At, B1); BAR;
      LDA(At, 1, 1); BAR; WAIT_L(0); MMA(1, 0, At, B0); MMA(1, 1, At, B1); BAR; }
    if (wr == 0) BAR;
#undef SA
#undef SB
}

typedef const float* const __attribute__((address_space(4)))* InTab;
struct Frame {
    InTab in; float* out; unsigned char* ws; unsigned char* lds;
    int tid, lane, wid, nb, bid, dry;
};
#define REFRAME Frame F = F0; { int t_ = threadIdx.x; asm volatile("" : "+v"(t_)); F.tid = t_; F.lane = t_ & 63; unsigned char* w_ = F.ws; asm volatile("" : "+s"(w_)); F.ws = w_; float* o_ = F.out; asm volatile("" : "+s"(o_)); F.out = o_; InTab i_ = (InTab)__builtin_amdgcn_kernarg_segment_ptr(); asm volatile("" : "+s"(i_)); F.in = i_; int a_ = F.wid, b_ = F.bid, c_ = F.nb; asm volatile("" : "+s"(a_), "+s"(b_), "+s"(c_)); F.wid = a_; F.bid = b_; F.nb = c_; }

enum { EPI_PROJ = 0, EPI_UP, EPI_RESID, EPI_Q, EPI_MEMK, EPI_MEMV, EPI_OUTA, EPI_OUTB, EPI_SOFTMAX, EPI_ATTNO };
struct GDesc { const bf16_t* A; int lda; const bf16_t* Bt; int ldb; int K, brow, bcol, epi, orow, ocol, head, vai, vwr; };

DEV void cvt_mat(const Frame& F0, const float* src, int ldsrc, int K, int N, int wincols, const float* gain, bf16_t* dst) {
    REFRAME;
    float* T = (float*)F.lds;
    const int nkt = K / 64, nnt = N / 64, ntile = nkt * nnt;
    for (int t = F.bid; t < ntile; t += F.nb) {
        const int kt = t / nnt, ntl = t % nnt, k0 = kt * 64, n0 = ntl * 64;
        int coff = 0; if (wincols) coff = (n0 < 1536) ? 0 : (n0 < 3072 ? 8 : 24);
        __syncthreads();
#pragma unroll
        for (int i = 0; i < 2; ++i) {
            const int kr = (F.tid >> 4) + 32 * i, nc = (F.tid & 15) * 4;
            f32x4 v = *(const f32x4*)(src + (size_t)(k0 + kr) * ldsrc + n0 + coff + nc);
            const float g = gain ? gain[k0 + kr] : 1.f;
            T[kr * 65 + nc + 0] = v[0] * g; T[kr * 65 + nc + 1] = v[1] * g; T[kr * 65 + nc + 2] = v[2] * g; T[kr * 65 + nc + 3] = v[3] * g;
        }
        __syncthreads();
        const int n = F.tid >> 3, kc = (F.tid & 7) * 8;
        u32x4 w;
        w.x = pk2(T[(kc + 0) * 65 + n], T[(kc + 1) * 65 + n]); w.y = pk2(T[(kc + 2) * 65 + n], T[(kc + 3) * 65 + n]);
        w.z = pk2(T[(kc + 4) * 65 + n], T[(kc + 5) * 65 + n]); w.w = pk2(T[(kc + 6) * 65 + n], T[(kc + 7) * 65 + n]);
        *(u32x4*)(dst + (size_t)(n0 + n) * K + k0 + kc) = w;
    }
    __syncthreads();
}
DEV void cvt_mixer(const Frame& F0, int l) {
    REFRAME;
    InTab in = F.in;
    cvt_mat(F, in[10] + (size_t)l * 1024 * 5656, 5656, 1024, 5632, 1, in[9] + l * 1024, ((bf16_t*)(F.ws + WS_WMIX)) + WM_WIN);
    cvt_mat(F, in[18] + (size_t)l * 512 * 1024, 1024, 512, 1024, 0, nullptr, ((bf16_t*)(F.ws + WS_WMIX)) + WM_WOA);
    cvt_mat(F, in[19] + (size_t)l * 512 * 1024, 1024, 512, 1024, 0, nullptr, ((bf16_t*)(F.ws + WS_WMIX)) + WM_WOB);
    cvt_mat(F, in[20] + (size_t)l * 1048576, 1024, 1024, 1024, 0, nullptr, ((bf16_t*)(F.ws + WS_WMIX)) + WM_WO);
    cvt_mat(F, in[23] + (size_t)l * 1048576, 1024, 1024, 1024, 0, in[21] + l * 1024, ((bf16_t*)(F.ws + WS_WMIX)) + WM_WMQ);
    cvt_mat(F, in[24] + (size_t)l * 1048576, 1024, 1024, 1024, 0, in[22] + l * 1024, ((bf16_t*)(F.ws + WS_WMIX)) + WM_WMK);
    cvt_mat(F, in[25] + (size_t)l * 1048576, 1024, 1024, 1024, 0, in[22] + l * 1024, ((bf16_t*)(F.ws + WS_WMIX)) + WM_WMV);
    cvt_mat(F, in[26] + (size_t)l * 1048576, 1024, 1024, 1024, 0, nullptr, ((bf16_t*)(F.ws + WS_WMIX)) + WM_WMO);
    const float* win = in[10] + (size_t)l * 1024 * 5656; const float* g = in[9] + l * 1024;
    for (int i = F.bid * 512 + F.tid; i < 32 * 1024; i += F.nb * 512) {
        const int n = i >> 10, k = i & 1023;
        float v = 0.f;
        if (n < 8) v = win[(size_t)k * 5656 + 1536 + n] * g[k]; else if (n < 24) v = win[(size_t)k * 5656 + 3080 + (n - 8)] * g[k];
        ((bf16_t*)(F.ws + WS_WMIX))[WM_WSM + i] = (bf16_t)(pk2(v, 0.f) & 0xffff);
    }
}
DEV void cvt_ffn(const Frame& F, int l) {
    cvt_mat(F, F.in[28] + (size_t)l * 1024 * 5632, 5632, 1024, 5632, 0, F.in[27] + l * 1024, ((bf16_t*)(F.ws + WS_WFFN)) + WF_UP);
    cvt_mat(F, F.in[31] + (size_t)l * 2816 * 1024, 1024, 2816, 1024, 0, nullptr, ((bf16_t*)(F.ws + WS_WFFN)) + WF_DN);
}

DEV void phase0(const Frame& F0) {
    REFRAME;
    const int gw = F.bid * 8 + F.wid, nw = F.nb * 8, lane = F.lane;
    for (int row = gw; row < TT + 4096; row += nw) {
        const bool ismem = row >= TT;
        const float* src = ismem ? F.in[8] + (size_t)(row - TT) * 1024 : (row < 32768 ? F.in[0] + (size_t)row * 1024 : F.in[1] + (size_t)(row - 32768) * 1024);
        f32x4 v[4]; float s = 0.f;
#pragma unroll
        for (int i = 0; i < 4; ++i) { v[i] = *(const f32x4*)(src + lane * 16 + i * 4); s += v[i][0] * v[i][0] + v[i][1] * v[i][1] + v[i][2] * v[i][2] + v[i][3] * v[i][3]; }
        u32x4 w0, w1;
        w0.x = pk2(v[0][0], v[0][1]); w0.y = pk2(v[0][2], v[0][3]); w0.z = pk2(v[1][0], v[1][1]); w0.w = pk2(v[1][2], v[1][3]);
        w1.x = pk2(v[2][0], v[2][1]); w1.y = pk2(v[2][2], v[2][3]); w1.z = pk2(v[3][0], v[3][1]); w1.w = pk2(v[3][2], v[3][3]);
        s += __shfl_xor(s, 1); s += __shfl_xor(s, 2);
        if (!ismem) {
            float* X = F.out + (size_t)row * 1024 + lane * 16;
#pragma unroll
            for (int i = 0; i < 4; ++i) *(f32x4*)(X + i * 4) = v[i];
            bf16_t* xb = ((bf16_t*)(F.ws + WS_XB)) + (size_t)row * 1024 + lane * 16;
            *(u32x4*)xb = w0; *(u32x4*)(xb + 8) = w1;
            if ((lane & 3) == 0) ((float*)(F.ws + WS_SSQ))[((size_t)(lane >> 4) * TT + row) * 4 + ((lane >> 2) & 3)] = s;
        } else {
            const int mr = row - TT;
            bf16_t* mb = ((bf16_t*)(F.ws + WS_MB)) + (size_t)mr * 1024 + lane * 16;
            *(u32x4*)mb = w0; *(u32x4*)(mb + 8) = w1;
            s += __shfl_xor(s, 4); s += __shfl_xor(s, 8); s += __shfl_xor(s, 16); s += __shfl_xor(s, 32);
            if (lane == 0) ((float*)(F.ws + WS_MRS))[mr] = rsqrtf(s * (1.f / 1024.f) + 1e-6f);
        }
    }
    cvt_mixer(F, 0);
    cvt_ffn(F, 0);
}

DEV void small_proj(const Frame& F0) {
    REFRAME;
    const int lane = F.lane, fr = lane & 15, fq = lane >> 4, mt = F.wid & 3, nt = F.wid >> 2;
    for (int c = F.bid; c < NCH; c += F.nb) {
        const int row = c * 64 + mt * 16 + fr;
        const bf16_t* a = ((bf16_t*)(F.ws + WS_XB)) + (size_t)row * 1024 + 8 * fq;
        const bf16_t* b = ((bf16_t*)(F.ws + WS_WMIX)) + WM_WSM + (size_t)(nt * 16 + fr) * 1024 + 8 * fq;
        f32x4 acc = {0.f, 0.f, 0.f, 0.f};
#pragma unroll 4
        for (int k = 0; k < 32; ++k) acc = MFMA16(*(const bf16x8*)(b + k * 32), *(const bf16x8*)(a + k * 32), acc);
        const float rs = row_rstd(((float*)(F.ws + WS_SSQ)), row);
        *(f32x4*)(((float*)(F.ws + WS_SC)) + (size_t)row * 32 + nt * 16 + 4 * fq) = acc * rs;
    }
}

DEV void gemm_epilogue(const Frame& F0, const GDesc& d, int l, f32x4 (&acc)[2][2][4][2]) {
    REFRAME;
    int lane_ = F.lane; asm volatile("" : "+v"(lane_));
    const int wr = F.wid >> 2, wc = F.wid & 3, fr = lane_ & 15, fq = lane_ >> 4;
    float* red = (float*)(F.lds + 131072);
    if (d.epi == EPI_SOFTMAX) {
        float mx[2][4];
#pragma unroll
        for (int ai = 0; ai < 2; ++ai)
#pragma unroll
            for (int m = 0; m < 4; ++m) {
                float v = -3.0e38f;
#pragma unroll
                for (int bj = 0; bj < 2; ++bj)
#pragma unroll
                    for (int n = 0; n < 2; ++n) { const f32x4 x = acc[ai][bj][m][n]; v = fmaxf(v, fmaxf(fmaxf(x[0], x[1]), fmaxf(x[2], x[3]))); }
                v = fmaxf(v, __shfl_xor(v, 16)); v = fmaxf(v, __shfl_xor(v, 32));
                if (fq == 0) red[(ai * 128 + wr * 64 + m * 16 + fr) * 4 + wc] = v;
            }
        __syncthreads();
#pragma unroll
        for (int ai = 0; ai < 2; ++ai)
#pragma unroll
            for (int m = 0; m < 4; ++m) {
                const f32x4 r4 = *(const f32x4*)(red + (ai * 128 + wr * 64 + m * 16 + fr) * 4);
                const float rm = fmaxf(fmaxf(r4[0], r4[1]), fmaxf(r4[2], r4[3]));
                mx[ai][m] = rm; float s = 0.f;
#pragma unroll
                for (int bj = 0; bj < 2; ++bj)
#pragma unroll
                    for (int n = 0; n < 2; ++n) { f32x4 x = acc[ai][bj][m][n];
#pragma unroll
                        for (int j = 0; j < 4; ++j) { x[j] = __expf(x[j] - rm); s += x[j]; }
                        acc[ai][bj][m][n] = x; }
                s += __shfl_xor(s, 16); s += __shfl_xor(s, 32);
                if (fq == 0) red[1024 + (ai * 128 + wr * 64 + m * 16 + fr) * 4 + wc] = s;
            }
        (void)mx;
        __syncthreads();
#pragma unroll
        for (int ai = 0; ai < 2; ++ai)
#pragma unroll
            for (int m = 0; m < 4; ++m) {
                const f32x4 r4 = *(const f32x4*)(red + 1024 + (ai * 128 + wr * 64 + m * 16 + fr) * 4);
                const float inv = 1.f / ((r4[0] + r4[1]) + (r4[2] + r4[3]));
                const bool valid = d.vai < 0 || (d.vai == ai && d.vwr == wr);
                const int row = d.orow + ai * 128 + wr * 64 + m * 16 + fr;
                if (valid) {
#pragma unroll
                    for (int bj = 0; bj < 2; ++bj)
#pragma unroll
                        for (int n = 0; n < 2; ++n) {
                            const int col = bj * 128 + wc * 32 + n * 16 + fq * 4;
                            *(u32x2*)(((bf16_t*)(F.ws + WS_P)) + (size_t)row * LDP + C_PR + d.head * 256 + col) = pk4(acc[ai][bj][m][n] * inv);
                        }
                }
            }
        __syncthreads();
        return;
    }
#pragma unroll
    for (int ai = 0; ai < 2; ++ai)
#pragma unroll
        for (int m = 0; m < 4; ++m) {
            const int row = d.orow + ai * 128 + wr * 64 + m * 16 + fr;
            float rs = 1.f, ss = 0.f;
            if (d.epi == EPI_PROJ || d.epi == EPI_UP || d.epi == EPI_Q) rs = row_rstd(((float*)(F.ws + WS_SSQ)), row);
            if (d.epi == EPI_Q) rs *= 0.0625f;
            if (d.epi == EPI_MEMK) rs = ((float*)(F.ws + WS_MRS))[row];
#pragma unroll
            for (int bj = 0; bj < 2; ++bj)
#pragma unroll
                for (int n = 0; n < 2; ++n) {
                    const int col = d.ocol + bj * 128 + wc * 32 + n * 16 + fq * 4;
                    f32x4 v = acc[ai][bj][m][n];
                    switch (d.epi) {
                    case EPI_PROJ: case EPI_UP: {
                        v = v * rs; const u32x2 w = pk4(v);
                        *(u32x2*)(((bf16_t*)(F.ws + WS_P)) + (size_t)row * LDP + col) = w;
                        const int nh = d.epi == EPI_PROJ ? 3 : 2, width = d.epi == EPI_PROJ ? 1536 : 5632;
                        if (m == 3 && fr >= 16 - nh && (d.epi == EPI_UP || col < 1536)) {
                            const int chunk = row >> 6, hr = fr - (16 - nh);
                            bf16_t* halo = d.epi == EPI_PROJ ? ((bf16_t*)(F.ws + WS_KV)) : ((bf16_t*)(F.ws + WS_KV));
                            *(u32x2*)(halo + ((size_t)chunk * nh + hr) * width + col) = w;
                            if (chunk >= 512 || (chunk & 31) == 31) {
                                float* o;
                                if (d.epi == EPI_PROJ) o = chunk < 512 ? F.out + O_GDNC_P + ((size_t)(l * 16 + (chunk >> 5)) * 3 + hr) * 1536 + col
                                                                       : F.out + O_GDNC_S + ((size_t)(l * 8 + (chunk - 512)) * 3 + hr) * 1536 + col;
                                else o = chunk < 512 ? F.out + O_FFNC_P + ((size_t)(l * 16 + (chunk >> 5)) * 2 + hr) * 5632 + col
                                                     : F.out + O_FFNC_S + ((size_t)(l * 8 + (chunk - 512)) * 2 + hr) * 5632 + col;
                                *(f32x4*)o = v;
                            }
                        }
                    } break;
                    case EPI_RESID: {
                        float* X = F.out + (size_t)row * 1024 + col;
                        f32x4 x = *(const f32x4*)X; x = x + v; *(f32x4*)X = x;
                        *(u32x2*)(((bf16_t*)(F.ws + WS_XB)) + (size_t)row * 1024 + col) = pk4(x);
                        ss += (x[0] * x[0] + x[1] * x[1]) + (x[2] * x[2] + x[3] * x[3]);
                    } break;
                    case EPI_Q: *(u32x2*)(((bf16_t*)(F.ws + WS_P)) + (size_t)row * LDP + C_Q + col) = pk4(v * rs); break;
                    case EPI_MEMK: {
                        v = v * rs;
                        *(f32x4*)(F.out + O_MEMK + ((size_t)l * 4096 + row) * 1024 + col) = v;
                        *(u32x2*)(((bf16_t*)(F.ws + WS_KV)) + (size_t)row * 1024 + col) = pk4(v);
                    } break;
                    case EPI_MEMV: {
                        const f32x4 r4 = *(const f32x4*)(((float*)(F.ws + WS_MRS)) + col);
                        v = v * r4;
                        float* o = F.out + O_MEMV + ((size_t)l * 4096 + col) * 1024 + row;
                        o[0] = v[0]; o[1024] = v[1]; o[2048] = v[2]; o[3072] = v[3];
                        const int b = col >> 8, h = row >> 8;
                        *(u32x2*)(((bf16_t*)(F.ws + WS_KV + 6144ull * 1024 * 2)) + ((size_t)(b * 4 + h) * 256 + (row & 255)) * 256 + (col & 255)) = pk4(v);
                    } break;
                    case EPI_OUTA: {
                        const f32x4 g = unpk4(*(const u32x2*)(((bf16_t*)(F.ws + WS_P)) + (size_t)row * LDP + C_GA + col));
                        f32x4 o; for (int j = 0; j < 4; ++j) o[j] = sigm(g[j]) * v[j];
                        *(u32x2*)(((bf16_t*)(F.ws + WS_P)) + (size_t)row * LDP + C_MRG + col) = pk4(o);
                    } break;
                    case EPI_OUTB: {
                        const f32x4 g = unpk4(*(const u32x2*)(((bf16_t*)(F.ws + WS_P)) + (size_t)row * LDP + C_GB + col));
                        f32x4 o = unpk4(*(const u32x2*)(((bf16_t*)(F.ws + WS_P)) + (size_t)row * LDP + C_MRG + col));
                        for (int j = 0; j < 4; ++j) o[j] += sigm(g[j]) * v[j];
                        *(u32x2*)(((bf16_t*)(F.ws + WS_P)) + (size_t)row * LDP + C_MRG + col) = pk4(o);
                    } break;
                    case EPI_ATTNO: {
                        const bool valid = d.vai < 0 || (d.vai == ai && d.vwr == wr);
                        if (valid) *(u32x2*)(((bf16_t*)(F.ws + WS_P)) + (size_t)row * LDP + C_O + d.head * 256 + col) = pk4(v);
                    } break;
                    default: break;
                    }
                }
            if (d.epi == EPI_RESID) {
                ss += __shfl_xor(ss, 16); ss += __shfl_xor(ss, 32);
                if (fq == 0) ((float*)(F.ws + WS_SSQ))[((size_t)(d.ocol >> 8) * TT + row) * 4 + wc] = ss;
            }
        }
}

enum { GP_IN = 0, GP_OUT, GP_WO, GP_MQ, GP_ATTN, GP_MO, GP_UP, GP_DOWN, GP_ATTN2, GP_OUT2 };
DEV void gemm_phase(const Frame& F0, int kind, int l) {
    REFRAME;
    int nunits = 0;
    switch (kind) { case GP_IN: case GP_UP: nunits = 130 * 22; break; case GP_OUT: nunits = 520 + 128; break; case GP_OUT2: nunits = 520; break; case GP_ATTN: case GP_ATTN2: nunits = 512 + 32; break; default: nunits = 520; }
    f32x4 acc[2][2][4][2];
    for (int u = F.bid; u < nunits; u += F.nb) {
        GDesc d;
        { const int sub = (kind == GP_ATTN2 || kind == GP_OUT2) ? 1 : 0;
            d.vai = -1; d.vwr = 0; d.head = 0;
            switch (kind) {
            case GP_IN: { const int pm = u / 22, pn = u % 22; d.A = ((bf16_t*)(F.ws + WS_XB)); d.lda = 1024; d.Bt = ((bf16_t*)(F.ws + WS_WMIX)) + WM_WIN; d.ldb = 1024; d.K = 1024; d.brow = pm * 256; d.bcol = pn * 256; d.epi = EPI_PROJ; d.orow = d.brow; d.ocol = d.bcol; } break;
            case GP_UP: { const int pm = u / 22, pn = u % 22; d.A = ((bf16_t*)(F.ws + WS_XB)); d.lda = 1024; d.Bt = ((bf16_t*)(F.ws + WS_WFFN)) + WF_UP; d.ldb = 1024; d.K = 1024; d.brow = pm * 256; d.bcol = pn * 256; d.epi = EPI_UP; d.orow = d.brow; d.ocol = d.bcol; } break;
            case GP_OUT: case GP_OUT2:
                if (u < 520) { const int pm = u >> 2, pn = u & 3; d.A = ((bf16_t*)(F.ws + WS_P)) + (sub == 0 ? C_ZA : C_ZB); d.lda = LDP; d.Bt = ((bf16_t*)(F.ws + WS_WMIX)) + (sub == 0 ? WM_WOA : WM_WOB); d.ldb = 512; d.K = 512;
                               d.brow = pm * 256; d.bcol = pn * 256; d.epi = sub == 0 ? EPI_OUTA : EPI_OUTB; d.orow = d.brow; d.ocol = d.bcol; }
                else if (u < 520 + 64) { const int v = u - 520, pm = v >> 2, pn = v & 3; d.A = ((bf16_t*)(F.ws + WS_MB)); d.lda = 1024; d.Bt = ((bf16_t*)(F.ws + WS_WMIX)) + WM_WMK; d.ldb = 1024; d.K = 1024; d.brow = pm * 256; d.bcol = pn * 256; d.epi = EPI_MEMK; d.orow = d.brow; d.ocol = d.bcol; }
                else { const int v = u - 584, pm = v & 3, pn = v >> 2; d.A = ((bf16_t*)(F.ws + WS_WMIX)) + WM_WMV; d.lda = 1024; d.Bt = ((bf16_t*)(F.ws + WS_MB)); d.ldb = 1024; d.K = 1024; d.brow = pm * 256; d.bcol = pn * 256; d.epi = EPI_MEMV; d.orow = d.brow; d.ocol = d.bcol; }
                break;
            case GP_WO: { const int pm = u >> 2, pn = u & 3; d.A = ((bf16_t*)(F.ws + WS_P)) + C_MRG; d.lda = LDP; d.Bt = ((bf16_t*)(F.ws + WS_WMIX)) + WM_WO; d.ldb = 1024; d.K = 1024; d.brow = pm * 256; d.bcol = pn * 256; d.epi = EPI_RESID; d.orow = d.brow; d.ocol = d.bcol; } break;
            case GP_MQ: { const int pm = u >> 2, pn = u & 3; d.A = ((bf16_t*)(F.ws + WS_XB)); d.lda = 1024; d.Bt = ((bf16_t*)(F.ws + WS_WMIX)) + WM_WMQ; d.ldb = 1024; d.K = 1024; d.brow = pm * 256; d.bcol = pn * 256; d.epi = EPI_Q; d.orow = d.brow; d.ocol = d.bcol; } break;
            case GP_MO: { const int pm = u >> 2, pn = u & 3; d.A = ((bf16_t*)(F.ws + WS_P)) + C_O; d.lda = LDP; d.Bt = ((bf16_t*)(F.ws + WS_WMIX)) + WM_WMO; d.ldb = 1024; d.K = 1024; d.brow = pm * 256; d.bcol = pn * 256; d.epi = EPI_RESID; d.orow = d.brow; d.ocol = d.bcol; } break;
            case GP_DOWN: { const int pm = u >> 2, pn = u & 3; d.A = ((bf16_t*)(F.ws + WS_P)); d.lda = LDP; d.Bt = ((bf16_t*)(F.ws + WS_WFFN)) + WF_DN; d.ldb = 2816; d.K = 2816; d.brow = pm * 256; d.bcol = pn * 256; d.epi = EPI_RESID; d.orow = d.brow; d.ocol = d.bcol; } break;
            case GP_ATTN: case GP_ATTN2: {
                int pm, h, b;
                if (u < 512) { pm = u >> 2; h = u & 3; b = pm >> 3; }
                else { const int v = u - 512; h = v & 3; const int bi = (v >> 2) & 3, t = v >> 4; pm = 128 + t; b = 16 + 4 * t + bi; d.vai = bi >> 1; d.vwr = bi & 1; }
                d.head = h; d.brow = pm * 256; d.orow = d.brow; d.ocol = 0; d.K = 256; d.bcol = 0;
                if (sub == 0) { d.A = ((bf16_t*)(F.ws + WS_P)) + C_Q + h * 256; d.lda = LDP; d.Bt = ((bf16_t*)(F.ws + WS_KV)) + (size_t)b * 256 * 1024 + h * 256; d.ldb = 1024; d.epi = EPI_SOFTMAX; }
                else { d.A = ((bf16_t*)(F.ws + WS_P)) + C_PR + h * 256; d.lda = LDP; d.Bt = ((bf16_t*)(F.ws + WS_KV + 6144ull * 1024 * 2)) + (size_t)(b * 4 + h) * 65536; d.ldb = 256; d.epi = EPI_ATTNO; }
            } break;
            }
        }
        gemm_core(d.A, d.lda, d.Bt, d.ldb, d.K, d.brow, d.bcol, acc, (bf16_t*)F.lds);
        gemm_epilogue(F, d, l, acc);
    }
}

DEV void sample_kv(const Frame& F0, int l) {
    REFRAME;
    const float* ck = F.in[6] + (size_t)l * 2097152; const float* cv = F.in[7] + (size_t)l * 2097152;
    for (int i = F.bid * 512 + F.tid; i < 262144; i += F.nb * 512) {
        const f32x4 a = *(const f32x4*)(ck + (size_t)i * 8), b = *(const f32x4*)(ck + (size_t)i * 8 + 4);
        u32x4 w; w.x = pk2(a[0], a[1]); w.y = pk2(a[2], a[3]); w.z = pk2(b[0], b[1]); w.w = pk2(b[2], b[3]);
        *(u32x4*)(((bf16_t*)(F.ws + WS_KV)) + 4096ull * 1024 + (size_t)i * 8) = w;
        const int dd = i & 255, m8 = (i >> 8) & 31, h = (i >> 13) & 3, bb = i >> 15;
        const float* s = cv + ((size_t)(bb * 256 + m8 * 8) * 4 + h) * 256 + dd;
        u32x4 x; x.x = pk2(s[0], s[1024]); x.y = pk2(s[2048], s[3072]); x.z = pk2(s[4096], s[5120]); x.w = pk2(s[6144], s[7168]);
        *(u32x4*)(((bf16_t*)(F.ws + WS_KV + 6144ull * 1024 * 2)) + ((size_t)((16 + bb) * 4 + h) * 256 + dd) * 256 + m8 * 8) = x;
    }
}

DEV void g1_gdn(const Frame& F0, int l, int c, int h) {
    REFRAME;
    float* Fq = (float*)F.lds;
    bf16_t* VS = (bf16_t*)(F.lds + 66560);
    bf16_t* QN = (bf16_t*)(F.lds + 82944);
    bf16_t* KN = (bf16_t*)(F.lds + 100352);
    float* AM = (float*)(F.lds + 117760);
    float* sB = (float*)(F.lds + 135168); float* sG = sB + 64; float* sRQ = sB + 128; float* sRK = sB + 192;
    const int tid = F.tid, lane = F.lane, t0 = c * 64;
    const bool first = c >= 512 || (c & 31) == 0; const bool sample = c >= 512;
    __syncthreads();
    if (F.wid == 0) {
        const int t = t0 + lane;
        const float braw = ((float*)(F.ws + WS_SC))[(size_t)t * 32 + h], araw = ((float*)(F.ws + WS_SC))[(size_t)t * 32 + 4 + h];
        const float beta = sigm(braw);
        float g = -__expf(F.in[12][l * 4 + h]) * softplus(araw + F.in[13][l * 4 + h]);
#pragma unroll
        for (int off = 1; off < 64; off <<= 1) { const float n = __shfl_up(g, off); if (lane >= off) g += n; }
        sB[lane] = beta; sG[lane] = g;
        if (!F.dry) ((float*)(F.ws + WS_BG))[((size_t)c * 4 + h) * 128 + lane] = beta; if (!F.dry) ((float*)(F.ws + WS_BG))[((size_t)c * 4 + h) * 128 + 64 + lane] = g;
    }
    __syncthreads();
    const float* cw = F.in[11] + (size_t)l * 4 * 1536;
    for (int idx = tid; idx < 64 * 192; idx += 512) {
        const int r = idx / 192, cp = idx % 192, which = cp >> 6, cc = (cp & 63) * 2, pcol = which * 512 + h * 128 + cc;
        float a0 = 0.f, a1 = 0.f;
#pragma unroll
        for (int i = 0; i < 4; ++i) {
            const int src = r - 3 + i; float x0 = 0.f, x1 = 0.f;
            if (src >= 0) { const unsigned u = *(const unsigned*)(((bf16_t*)(F.ws + WS_P)) + (size_t)(t0 + src) * LDP + pcol); x0 = bflo(u); x1 = bfhi(u); }
            else if (!first) { const unsigned u = *(const unsigned*)(((bf16_t*)(F.ws + WS_KV)) + ((size_t)(c - 1) * 3 + (src + 3)) * 1536 + pcol); x0 = bflo(u); x1 = bfhi(u); }
            else if (sample) { const f32x2 f = *(const f32x2*)(F.in[3] + ((size_t)(l * 8 + (c - 512)) * 3 + (src + 3)) * 1536 + pcol); x0 = f[0]; x1 = f[1]; }
            const f32x2 w = *(const f32x2*)(cw + i * 1536 + pcol);
            a0 += w[0] * x0; a1 += w[1] * x1;
        }
        a0 = silu(a0); a1 = silu(a1);
        if (which < 2) { *(f32x2*)(Fq + r * 260 + which * 128 + cc) = (f32x2){a0, a1}; }
        else { const float be = sB[r]; *(unsigned*)(VS + r * 128 + cc) = pk2(a0 * be, a1 * be); }
    }
    __syncthreads();
    {
        const int r = tid >> 3, j = tid & 7; const float* p = Fq + r * 260 + j * 32; float s = 0.f;
#pragma unroll
        for (int i = 0; i < 32; ++i) s += p[i] * p[i];
        s += __shfl_xor(s, 1); s += __shfl_xor(s, 2);
        if ((j & 3) == 0) { if (j == 0) sRQ[r] = rsqrtf(s + 1e-6f) * 0.08838834764831845f; else sRK[r] = rsqrtf(s + 1e-6f); }
    }
    __syncthreads();
    for (int idx = tid; idx < 64 * 64; idx += 512) {
        const int r = idx >> 6, c4 = (idx & 63) * 4; const bool isq = c4 < 128;
        f32x4 v = *(const f32x4*)(Fq + r * 260 + c4); v = v * (isq ? sRQ[r] : sRK[r]);
        const u32x2 w = pk4(v);
        if (isq) { *(u32x2*)(QN + r * 136 + c4) = w; if (!F.dry) *(u32x2*)(((bf16_t*)(F.ws + WS_P)) + (size_t)(t0 + r) * LDP + C_QA + h * 128 + c4) = w; }
        else { *(u32x2*)(KN + r * 136 + c4 - 128) = w; if (!F.dry) *(u32x2*)(((bf16_t*)(F.ws + WS_P)) + (size_t)(t0 + r) * LDP + C_KA + h * 128 + c4 - 128) = w; }
    }
    for (int idx = tid; idx < 64 * 32; idx += 512) {
        const int r = idx >> 5, c4 = (idx & 31) * 4;
        if (!F.dry) *(u32x2*)(((bf16_t*)(F.ws + WS_P)) + (size_t)(t0 + r) * LDP + C_VA + h * 128 + c4) = *(const u32x2*)(VS + r * 128 + c4);
    }
    __syncthreads();
    {
        const int fr = lane & 15, fq = lane >> 4, which = F.wid >> 2, it = F.wid & 3;
        const bf16_t* X = which ? QN : KN;
        const int crow = 16 * it + fr; const float gc = sG[crow], bc = sB[crow];
        for (int jt = 0; jt < 4; ++jt) {
            f32x4 a = {0.f, 0.f, 0.f, 0.f};
            if (jt <= it) {
#pragma unroll
                for (int ks = 0; ks < 4; ++ks) a = MFMA16(ldfrag(KN, 16 * jt + fr, 136, 32 * ks, fq), ldfrag(X, crow, 136, 32 * ks, fq), a);
            }
            f32x4 o;
#pragma unroll
            for (int j = 0; j < 4; ++j) {
                const int s = 16 * jt + 4 * fq + j;
                const bool keep = which ? (s <= crow) : (s < crow);
                const float dec = keep ? __expf(gc - sG[s]) : 0.f;
                o[j] = a[j] * dec * (which ? 1.f : bc);
            }
            if (which) { if (!F.dry) *(u32x2*)(((bf16_t*)(F.ws + WS_XB)) + (size_t)(t0 + crow) * LDE + h * 128 + 64 + 16 * jt + 4 * fq) = pk4(o); }
            else *(f32x4*)(AM + crow * 68 + 16 * jt + 4 * fq) = o;
        }
    }
    __syncthreads();
    if (F.wid == 0) {
        float Tc[64]; const float lanef = (float)lane;
        typedef __attribute__((address_space(3))) const f32x4 LDSF4;
        __attribute__((address_space(3))) const char* aml = (__attribute__((address_space(3))) const char*)AM; asm volatile("" : "+v"(aml));
#pragma unroll
        for (int i = 0; i < 64; ++i) {
            float a = fmaxf(0.f, 1.f - fabsf(lanef - (float)i));
#pragma unroll
            for (int j4 = 0; j4 < (i + 3) / 4; ++j4) {
                const f32x4 av = *(const LDSF4*)(aml + (i * 68 + j4 * 4) * 4);
#pragma unroll
                for (int jj = 0; jj < 4; ++jj) if (j4 * 4 + jj < i) a -= av[jj] * Tc[j4 * 4 + jj];
            }
            Tc[i] = a;
        }
#pragma unroll
        for (int i = 0; i < 64; i += 2) {
            const unsigned w = pk2(Tc[i], Tc[i + 1]);
            if (!F.dry) ((bf16_t*)(F.ws + WS_XB))[(size_t)(t0 + i) * LDE + h * 128 + lane] = (bf16_t)(w & 0xffff);
            if (!F.dry) ((bf16_t*)(F.ws + WS_XB))[(size_t)(t0 + i + 1) * LDE + h * 128 + lane] = (bf16_t)(w >> 16);
        }
    }
}

DEV void g1_gla(const Frame& F0, int l, int c, int h) {
    REFRAME;
    float* GL = (float*)F.lds;
    float* LA = (float*)(F.lds + 4096);
    bf16_t* QG = (bf16_t*)(F.lds + 20736);
    bf16_t* KI = (bf16_t*)(F.lds + 29952);
    const int tid = F.tid, lane = F.lane, t0 = c * 64;
    __syncthreads();
    if (tid < 256) { const int r = tid >> 2, q4 = (tid & 3) * 4; *(f32x4*)(GL + r * 16 + q4) = *(const f32x4*)(((float*)(F.ws + WS_SC)) + (size_t)(t0 + r) * 32 + 8 + q4); }
    __syncthreads();
    {
        const int dk = tid & 63, rb = tid >> 6;
        float w2[16];
#pragma unroll
        for (int i = 0; i < 16; ++i) w2[i] = F.in[15][(size_t)(l * 16 + i) * 256 + h * 64 + dk];
        const float bias = F.in[16][l * 256 + h * 64 + dk];
#pragma unroll
        for (int rr = 0; rr < 8; ++rr) {
            const int r = rb * 8 + rr; float x = bias;
#pragma unroll
            for (int i = 0; i < 16; ++i) x += GL[r * 16 + i] * w2[i];
            LA[r * 65 + dk] = logsigmoid(x) * 0.0625f;
        }
    }
    __syncthreads();
    if (tid < 64) {
        float g = 0.f;
#pragma unroll 8
        for (int r = 0; r < 64; ++r) { g += LA[r * 65 + tid]; LA[r * 65 + tid] = g; }
        if (!F.dry) ((float*)(F.ws + WS_DL))[((size_t)c * 4 + h) * 64 + tid] = __expf(g);
    }
    __syncthreads();
    for (int idx = tid; idx < 64 * 16; idx += 512) {
        const int r = idx >> 4, c4 = (idx & 15) * 4;
        bf16_t* qp = ((bf16_t*)(F.ws + WS_P)) + (size_t)(t0 + r) * LDP + C_QB + h * 64 + c4; bf16_t* kp = ((bf16_t*)(F.ws + WS_P)) + (size_t)(t0 + r) * LDP + C_KB + h * 64 + c4;
        const f32x4 q = unpk4(*(const u32x2*)qp), k = unpk4(*(const u32x2*)kp);
        f32x4 qg, ki, kg;
#pragma unroll
        for (int j = 0; j < 4; ++j) { const float g = LA[r * 65 + c4 + j], gl = LA[63 * 65 + c4 + j];
            qg[j] = q[j] * 0.125f * __expf(g); ki[j] = k[j] * __expf(-g); kg[j] = k[j] * __expf(gl - g); }
        const u32x2 wq = pk4(qg);
        *(u32x2*)(QG + r * 72 + c4) = wq; *(u32x2*)(KI + r * 72 + c4) = pk4(ki);
        if (!F.dry) *(u32x2*)qp = wq; if (!F.dry) *(u32x2*)kp = pk4(kg);
    }
    __syncthreads();
    {
        const int fr = lane & 15, fq = lane >> 4, it = F.wid >> 1; const int crow = 16 * it + fr;
#pragma unroll
        for (int q = 0; q < 2; ++q) {
            const int jt = (F.wid & 1) * 2 + q;
            f32x4 a = {0.f, 0.f, 0.f, 0.f};
            if (jt <= it) {
#pragma unroll
                for (int ks = 0; ks < 2; ++ks) a = MFMA16(ldfrag(KI, 16 * jt + fr, 72, 32 * ks, fq), ldfrag(QG, crow, 72, 32 * ks, fq), a);
            }
#pragma unroll
            for (int j = 0; j < 4; ++j) if (16 * jt + 4 * fq + j > crow) a[j] = 0.f;
            if (!F.dry) *(u32x2*)(((bf16_t*)(F.ws + WS_XB)) + (size_t)(t0 + crow) * LDE + 512 + h * 64 + 16 * jt + 4 * fq) = pk4(a);
        }
    }
}

DEV void g2_gdn(const Frame& F0, int l, int s, int h) {
    REFRAME;
    bf16_t* QN = (bf16_t*)F.lds;
    bf16_t* KN = (bf16_t*)(F.lds + 17408);
    bf16_t* KT = (bf16_t*)(F.lds + 34816);
    bf16_t* TM = (bf16_t*)(F.lds + 53248);
    bf16_t* AQ = (bf16_t*)(F.lds + 62464);
    float* sB = (float*)(F.lds + 71680); float* sG = sB + 64;
    float* RED = (float*)(F.lds + 72192);
    const int tid = F.tid, lane = F.lane, w = F.wid, fr = lane & 15, fq = lane >> 4;
    const bool sample = s >= 16; const int nchunk = sample ? 1 : 32; const int tbase = sample ? 32768 + (s - 16) * 64 : s * 2048;
    const int dvc = h * 128 + 16 * w + fr;
    f32x4 S[8];
#pragma unroll
    for (int mt = 0; mt < 8; ++mt) {
        if (sample) { const float* sp = F.in[2] + ((size_t)((l * 8 + (s - 16)) * 4 + h) * 128) * 128;
#pragma unroll
            for (int j = 0; j < 4; ++j) S[mt][j] = sp[(size_t)(16 * mt + 4 * fq + j) * 128 + 16 * w + fr]; }
        else S[mt] = (f32x4){0.f, 0.f, 0.f, 0.f};
    }
    const float gn = F.in[14][l * 128 + 16 * w + fr];
    for (int n = 0; n < nchunk; ++n) {
        const int t0 = tbase + n * 64;
        __syncthreads();
#pragma unroll
        for (int i = 0; i < 2; ++i) {
            const int p = tid + 512 * i, r = p >> 4, c8 = (p & 15) * 8;
            const u32x4 q = *(const u32x4*)(((bf16_t*)(F.ws + WS_P)) + (size_t)(t0 + r) * LDP + C_QA + h * 128 + c8);
            const u32x4 k = *(const u32x4*)(((bf16_t*)(F.ws + WS_P)) + (size_t)(t0 + r) * LDP + C_KA + h * 128 + c8);
            *(u32x4*)(QN + r * 136 + c8) = q; *(u32x4*)(KN + r * 136 + c8) = k;
            KT[(c8 + 0) * 72 + r] = (bf16_t)(k.x & 0xffff); KT[(c8 + 1) * 72 + r] = (bf16_t)(k.x >> 16);
            KT[(c8 + 2) * 72 + r] = (bf16_t)(k.y & 0xffff); KT[(c8 + 3) * 72 + r] = (bf16_t)(k.y >> 16);
            KT[(c8 + 4) * 72 + r] = (bf16_t)(k.z & 0xffff); KT[(c8 + 5) * 72 + r] = (bf16_t)(k.z >> 16);
            KT[(c8 + 6) * 72 + r] = (bf16_t)(k.w & 0xffff); KT[(c8 + 7) * 72 + r] = (bf16_t)(k.w >> 16);
        }
        {
            const int r = tid >> 3, c8 = (tid & 7) * 8;
            *(u32x4*)(TM + r * 72 + c8) = *(const u32x4*)(((bf16_t*)(F.ws + WS_XB)) + (size_t)(t0 + r) * LDE + h * 128 + c8);
            *(u32x4*)(AQ + r * 72 + c8) = *(const u32x4*)(((bf16_t*)(F.ws + WS_XB)) + (size_t)(t0 + r) * LDE + h * 128 + 64 + c8);
        }
        if (tid < 128) sB[tid] = ((float*)(F.ws + WS_BG))[((size_t)(t0 >> 6) * 4 + h) * 128 + tid];
        __syncthreads();
        f32x4 kS[4], qS[4], vn[4], o[4];
#pragma unroll
        for (int mt = 0; mt < 4; ++mt) { kS[mt] = (f32x4){0.f, 0.f, 0.f, 0.f}; qS[mt] = kS[mt]; vn[mt] = kS[mt]; }
#pragma unroll
        for (int ks = 0; ks < 4; ++ks) {
            const bf16x8 sf = mk8(pk4(S[2 * ks]), pk4(S[2 * ks + 1]));
#pragma unroll
            for (int mt = 0; mt < 4; ++mt) {
                kS[mt] = MFMA16(ldfragp(KN, 16 * mt + fr, 136, 32 * ks, fq), sf, kS[mt]);
                qS[mt] = MFMA16(ldfragp(QN, 16 * mt + fr, 136, 32 * ks, fq), sf, qS[mt]);
            }
        }
        const float glast = sG[63];
        f32x4 eg[4], tmp[4];
#pragma unroll
        for (int mt = 0; mt < 4; ++mt)
#pragma unroll
            for (int j = 0; j < 4; ++j) {
                const int row = 16 * mt + 4 * fq + j;
                const float e = __expf(sG[row]); eg[mt][j] = e;
                const float vv = bf2f(((bf16_t*)(F.ws + WS_P))[(size_t)(t0 + row) * LDP + C_VA + dvc]);
                tmp[mt][j] = vv - sB[row] * e * kS[mt][j];
            }
#pragma unroll
        for (int ks = 0; ks < 2; ++ks) {
            const bf16x8 tf = mk8(pk4(tmp[2 * ks]), pk4(tmp[2 * ks + 1]));
#pragma unroll
            for (int mt = 0; mt < 4; ++mt) vn[mt] = MFMA16(ldfragp(TM, 16 * mt + fr, 72, 32 * ks, fq), tf, vn[mt]);
        }
#pragma unroll
        for (int mt = 0; mt < 4; ++mt) o[mt] = eg[mt] * qS[mt];
#pragma unroll
        for (int ks = 0; ks < 2; ++ks) {
            const bf16x8 vf = mk8(pk4(vn[2 * ks]), pk4(vn[2 * ks + 1]));
#pragma unroll
            for (int mt = 0; mt < 4; ++mt) o[mt] = MFMA16(ldfragp(AQ, 16 * mt + fr, 72, 32 * ks, fq), vf, o[mt]);
        }
        const float dl = __expf(glast);
#pragma unroll
        for (int mt = 0; mt < 4; ++mt)
#pragma unroll
            for (int j = 0; j < 4; ++j) vn[mt][j] *= __expf(glast - sG[16 * mt + 4 * fq + j]);
#pragma unroll
        for (int mt = 0; mt < 8; ++mt) S[mt] = S[mt] * dl;
#pragma unroll
        for (int ks = 0; ks < 2; ++ks) {
            const bf16x8 vf = mk8(pk4(vn[2 * ks]), pk4(vn[2 * ks + 1]));
#pragma unroll
            for (int mt = 0; mt < 8; ++mt) S[mt] = MFMA16(ldfragp(KT, 16 * mt + fr, 72, 32 * ks, fq), vf, S[mt]);
        }
#pragma unroll
        for (int mt = 0; mt < 4; ++mt)
#pragma unroll
            for (int j = 0; j < 4; ++j) {
                float p = o[mt][j] * o[mt][j];
                p += __shfl_xor(p, 1); p += __shfl_xor(p, 2); p += __shfl_xor(p, 4); p += __shfl_xor(p, 8);
                if (fr == 0) RED[(16 * mt + 4 * fq + j) * 8 + w] = p;
            }
        __syncthreads();
#pragma unroll
        for (int mt = 0; mt < 4; ++mt)
#pragma unroll
            for (int j = 0; j < 4; ++j) {
                const int row = 16 * mt + 4 * fq + j;
                const f32x4 r0 = *(const f32x4*)(RED + row * 8), r1 = *(const f32x4*)(RED + row * 8 + 4);
                const float ssum = ((r0[0] + r0[1]) + (r0[2] + r0[3])) + ((r1[0] + r1[1]) + (r1[2] + r1[3]));
                const float rs = rsqrtf(ssum * (1.f / 128.f) + 1e-6f);
                bf16_t* zp = ((bf16_t*)(F.ws + WS_P)) + (size_t)(t0 + row) * LDP + C_ZA + dvc;
                const float z = bf2f(*zp);
                if (!F.dry) *zp = (bf16_t)(pk2(o[mt][j] * rs * gn * silu(z), 0.f) & 0xffff);
            }
    }
    float* so = sample ? F.out + O_GDN_S + ((size_t)((l * 8 + (s - 16)) * 4 + h) * 128) * 128 : F.out + O_GDN_P + ((size_t)((l * 16 + s) * 4 + h) * 128) * 128;
#pragma unroll
    for (int mt = 0; mt < 8; ++mt)
#pragma unroll
        for (int j = 0; j < 4; ++j) if (!F.dry) so[(size_t)(16 * mt + 4 * fq + j) * 128 + 16 * w + fr] = S[mt][j];
}

DEV void g2_gla(const Frame& F0, int l, int s, int h) {
    REFRAME;
    bf16_t* QG = (bf16_t*)F.lds;
    bf16_t* KGT = (bf16_t*)(F.lds + 9216);
    bf16_t* AQ = (bf16_t*)(F.lds + 18432);
    float* sDL = (float*)(F.lds + 27648);
    float* RED = (float*)(F.lds + 27904);
    const int tid = F.tid, lane = F.lane, w = F.wid, fr = lane & 15, fq = lane >> 4;
    const bool sample = s >= 16; const int nchunk = sample ? 1 : 32; const int tbase = sample ? 32768 + (s - 16) * 64 : s * 2048;
    const int dvc = h * 128 + 16 * w + fr;
    f32x4 S[4];
#pragma unroll
    for (int mt = 0; mt < 4; ++mt) {
        if (sample) { const float* sp = F.in[4] + ((size_t)((l * 8 + (s - 16)) * 4 + h) * 64) * 128;
#pragma unroll
            for (int j = 0; j < 4; ++j) S[mt][j] = sp[(size_t)(16 * mt + 4 * fq + j) * 128 + 16 * w + fr]; }
        else S[mt] = (f32x4){0.f, 0.f, 0.f, 0.f};
    }
    const float gn = F.in[17][l * 128 + 16 * w + fr];
    for (int n = 0; n < nchunk; ++n) {
        const int t0 = tbase + n * 64, chunk = t0 >> 6;
        __syncthreads();
        {
            const int r = tid >> 3, c8 = (tid & 7) * 8;
            *(u32x4*)(QG + r * 72 + c8) = *(const u32x4*)(((bf16_t*)(F.ws + WS_P)) + (size_t)(t0 + r) * LDP + C_QB + h * 64 + c8);
            const u32x4 k = *(const u32x4*)(((bf16_t*)(F.ws + WS_P)) + (size_t)(t0 + r) * LDP + C_KB + h * 64 + c8);
            KGT[(c8 + 0) * 72 + r] = (bf16_t)(k.x & 0xffff); KGT[(c8 + 1) * 72 + r] = (bf16_t)(k.x >> 16);
            KGT[(c8 + 2) * 72 + r] = (bf16_t)(k.y & 0xffff); KGT[(c8 + 3) * 72 + r] = (bf16_t)(k.y >> 16);
            KGT[(c8 + 4) * 72 + r] = (bf16_t)(k.z & 0xffff); KGT[(c8 + 5) * 72 + r] = (bf16_t)(k.z >> 16);
            KGT[(c8 + 6) * 72 + r] = (bf16_t)(k.w & 0xffff); KGT[(c8 + 7) * 72 + r] = (bf16_t)(k.w >> 16);
            *(u32x4*)(AQ + r * 72 + c8) = *(const u32x4*)(((bf16_t*)(F.ws + WS_XB)) + (size_t)(t0 + r) * LDE + 512 + h * 64 + c8);
        }
        if (tid < 64) sDL[tid] = ((float*)(F.ws + WS_DL))[((size_t)chunk * 4 + h) * 64 + tid];
        bf16x8 vf[2];
#pragma unroll
        for (int ks = 0; ks < 2; ++ks) {
            unsigned e[8];
#pragma unroll
            for (int j = 0; j < 8; ++j) { const int row = 32 * ks + (j < 4 ? 4 * fq + j : 16 + 4 * fq + (j - 4)); e[j] = ((bf16_t*)(F.ws + WS_P))[(size_t)(t0 + row) * LDP + C_VB + dvc]; }
            u32x4 t; t.x = e[0] | (e[1] << 16); t.y = e[2] | (e[3] << 16); t.z = e[4] | (e[5] << 16); t.w = e[6] | (e[7] << 16);
            vf[ks] = __builtin_bit_cast(bf16x8, t);
        }
        __syncthreads();
        f32x4 o[4];
#pragma unroll
        for (int mt = 0; mt < 4; ++mt) o[mt] = (f32x4){0.f, 0.f, 0.f, 0.f};
#pragma unroll
        for (int ks = 0; ks < 2; ++ks) {
            const bf16x8 sf = mk8(pk4(S[2 * ks]), pk4(S[2 * ks + 1]));
#pragma unroll
            for (int mt = 0; mt < 4; ++mt) {
                o[mt] = MFMA16(ldfragp(QG, 16 * mt + fr, 72, 32 * ks, fq), sf, o[mt]);
                o[mt] = MFMA16(ldfragp(AQ, 16 * mt + fr, 72, 32 * ks, fq), vf[ks], o[mt]);
            }
        }
#pragma unroll
        for (int mt = 0; mt < 4; ++mt) {
#pragma unroll
            for (int j = 0; j < 4; ++j) S[mt][j] *= sDL[16 * mt + 4 * fq + j];
#pragma unroll
            for (int ks = 0; ks < 2; ++ks) S[mt] = MFMA16(ldfragp(KGT, 16 * mt + fr, 72, 32 * ks, fq), vf[ks], S[mt]);
        }
#pragma unroll
        for (int mt = 0; mt < 4; ++mt)
#pragma unroll
            for (int j = 0; j < 4; ++j) {
                float p = o[mt][j] * o[mt][j];
                p += __shfl_xor(p, 1); p += __shfl_xor(p, 2); p += __shfl_xor(p, 4); p += __shfl_xor(p, 8);
                if (fr == 0) RED[(16 * mt + 4 * fq + j) * 8 + w] = p;
            }
        __syncthreads();
#pragma unroll
        for (int mt = 0; mt < 4; ++mt)
#pragma unroll
            for (int j = 0; j < 4; ++j) {
                const int row = 16 * mt + 4 * fq + j;
                const f32x4 r0 = *(const f32x4*)(RED + row * 8), r1 = *(const f32x4*)(RED + row * 8 + 4);
                const float ssum = ((r0[0] + r0[1]) + (r0[2] + r0[3])) + ((r1[0] + r1[1]) + (r1[2] + r1[3]));
                const float rs = rsqrtf(ssum * (1.f / 128.f) + 1e-6f);
                bf16_t* zp = ((bf16_t*)(F.ws + WS_P)) + (size_t)(t0 + row) * LDP + C_ZB + dvc;
                const float z = bf2f(*zp);
                if (!F.dry) *zp = (bf16_t)(pk2(o[mt][j] * rs * gn * silu(z), 0.f) & 0xffff);
            }
    }
    float* so = sample ? F.out + O_GLA_S + ((size_t)((l * 8 + (s - 16)) * 4 + h) * 64) * 128 : F.out + O_GLA_P + ((size_t)((l * 16 + s) * 4 + h) * 64) * 128;
#pragma unroll
    for (int mt = 0; mt < 4; ++mt)
#pragma unroll
        for (int j = 0; j < 4; ++j) if (!F.dry) so[(size_t)(16 * mt + 4 * fq + j) * 128 + 16 * w + fr] = S[mt][j];
}

DEV void ffn_mid(const Frame& F0, int l) {
    REFRAME;
    const float* cw = F.in[29] + (size_t)l * 3 * 5632; const float* cb = F.in[30] + (size_t)l * 5632;
    const int total = NCH * 1408;
    for (int idx = F.bid * 512 + F.tid; idx < total; idx += F.nb * 512) {
        const int c = idx / 1408, cp = idx % 1408, col = cp * 2;
        const bool first = c >= 512 || (c & 31) == 0, sample = c >= 512;
        float g2[2] = {0.f, 0.f}, g1[2] = {0.f, 0.f}, v2[2] = {0.f, 0.f}, v1[2] = {0.f, 0.f};
        if (!first) {
            const bf16_t* hp = ((bf16_t*)(F.ws + WS_KV)) + (size_t)(c - 1) * 2 * 5632;
            unsigned u = *(const unsigned*)(hp + col); g2[0] = bflo(u); g2[1] = bfhi(u);
            u = *(const unsigned*)(hp + 5632 + col); g1[0] = bflo(u); g1[1] = bfhi(u);
            u = *(const unsigned*)(hp + 2816 + col); v2[0] = bflo(u); v2[1] = bfhi(u);
            u = *(const unsigned*)(hp + 5632 + 2816 + col); v1[0] = bflo(u); v1[1] = bfhi(u);
        } else if (sample) {
            const float* sp = F.in[5] + (size_t)(l * 8 + (c - 512)) * 2 * 5632;
            g2[0] = sp[col]; g2[1] = sp[col + 1]; g1[0] = sp[5632 + col]; g1[1] = sp[5632 + col + 1];
            v2[0] = sp[2816 + col]; v2[1] = sp[2816 + col + 1]; v1[0] = sp[5632 + 2816 + col]; v1[1] = sp[5632 + 2816 + col + 1];
        }
        const f32x2 wg0 = *(const f32x2*)(cw + col), wg1 = *(const f32x2*)(cw + 5632 + col), wg2 = *(const f32x2*)(cw + 2 * 5632 + col), bg = *(const f32x2*)(cb + col);
        const f32x2 wv0 = *(const f32x2*)(cw + 2816 + col), wv1 = *(const f32x2*)(cw + 5632 + 2816 + col), wv2 = *(const f32x2*)(cw + 2 * 5632 + 2816 + col), bv = *(const f32x2*)(cb + 2816 + col);
        bf16_t* up = ((bf16_t*)(F.ws + WS_P)) + (size_t)c * 64 * LDP + col;
#pragma unroll 8
        for (int r = 0; r < 64; ++r) {
            const unsigned ug = *(const unsigned*)(up + (size_t)r * LDP), uv = *(const unsigned*)(up + (size_t)r * LDP + 2816);
            const float g0[2] = {bflo(ug), bfhi(ug)}, v0[2] = {bflo(uv), bfhi(uv)};
            const float yg0 = wg0[0] * g2[0] + wg1[0] * g1[0] + wg2[0] * g0[0] + bg[0], yg1 = wg0[1] * g2[1] + wg1[1] * g1[1] + wg2[1] * g0[1] + bg[1];
            const float yv0 = wv0[0] * v2[0] + wv1[0] * v1[0] + wv2[0] * v0[0] + bv[0], yv1 = wv0[1] * v2[1] + wv1[1] * v1[1] + wv2[1] * v0[1] + bv[1];
            if (!F.dry) *(unsigned*)(up + (size_t)r * LDP) = pk2(silu(yg0) * yv0, silu(yg1) * yv1);
            g2[0] = g1[0]; g2[1] = g1[1]; g1[0] = g0[0]; g1[1] = g0[1]; v2[0] = v1[0]; v2[1] = v1[1]; v1[0] = v0[0]; v1[1] = v0[1];
        }
    }
}

DEV void final_norm(const Frame& F0) {
    REFRAME;
    const int gw = F.bid * 8 + F.wid, nw = F.nb * 8, lane = F.lane;
    const float* g = F.in[32];
    for (int row = gw; row < TT; row += nw) {
        const float rs = row_rstd(((float*)(F.ws + WS_SSQ)), row);
        float* X = F.out + (size_t)row * 1024;
#pragma unroll
        for (int i = 0; i < 4; ++i) { const int cidx = i * 256 + lane * 4; f32x4 v = *(const f32x4*)(X + cidx); const f32x4 gg = *(const f32x4*)(g + cidx); *(f32x4*)(X + cidx) = v * rs * gg; }
    }
}

#ifdef DBG_COL
DEV void dbg_dump(const Frame& F0) {
    REFRAME;
    for (int i = F.bid * 512 + F.tid; i < TT * 256; i += F.nb * 512) {
        const int row = i >> 8, c = (i & 255) * 4;
        const f32x4 v = c < 512 ? unpk4(*(const u32x2*)(((bf16_t*)(F.ws + WS_P)) + (size_t)row * LDP + DBG_COL + c)) : (f32x4){0.f, 0.f, 0.f, 0.f};
        *(f32x4*)(F.out + (size_t)row * 1024 + c) = (row DBG_ROWSEL) ? v : (f32x4){0.f, 0.f, 0.f, 0.f};
    }
}
#endif
__global__ void __launch_bounds__(512, 2) fwd_kernel(Params p) {
    extern __shared__ __attribute__((aligned(16))) unsigned char lds[];
    cg::grid_group grid = cg::this_grid();
    Frame F;
    F.in = (InTab)__builtin_amdgcn_kernarg_segment_ptr(); F.out = p.out; F.ws = p.ws; F.lds = lds;
    F.tid = threadIdx.x; F.lane = threadIdx.x & 63; F.wid = __builtin_amdgcn_readfirstlane(threadIdx.x >> 6); F.nb = gridDim.x; F.bid = blockIdx.x; F.dry = 0;
    for (int ph = p.ph_lo; ph < p.ph_hi; ++ph) {
#ifndef PHM
#define PHM 0xffff
#endif
        if (ph == 0) { if (PHM & 0x1000) phase0(F); }
        else if (ph == NPH - 1) { if (PHM & 0x2000) final_norm(F); }
        else {
            const int l = (ph - 1) / 13, k = (ph - 1) % 13;
            int gk = -1;
            switch (k) { case 0: gk = GP_IN; break; case 3: gk = GP_OUT; break; case 4: gk = GP_OUT2; break; case 5: gk = GP_WO; break; case 6: gk = GP_MQ; break; case 7: gk = GP_ATTN; break; case 8: gk = GP_ATTN2; break;
                         case 9: gk = GP_MO; break; case 10: gk = GP_UP; break; case 12: gk = GP_DOWN; break; default: break; }
#ifndef REPMASK
#define REPMASK 0
#endif
            if (gk >= 0 && (PHM & 1)) { const int nrep = ((REPMASK >> k) & 1) ? 2 : 1; for (int rep = 0; rep < nrep; ++rep) gemm_phase(F, gk, l); }
            if (k == 0 && (PHM & 1)) small_proj(F);
            if (k == 3 && (PHM & 8)) sample_kv(F, l);
#ifndef DRYMASK
#define DRYMASK 0
#endif
            for (int dr = ((DRYMASK >> k) & 1); dr >= 0; --dr) {
            F.dry = dr;
            if (k == 1 && (PHM & 2)) {
                for (int it = F.bid; it < NCH * 8; it += F.nb) { const int c = it >> 3, h = it & 3; if (it & 4) g1_gla(F, l, c, h); else g1_gdn(F, l, c, h); }
                __syncthreads();
                if (l > 0 && !dr) cvt_ffn(F, l);
            }
            if (k == 2 && (PHM & 4)) {
                for (int it = F.bid; it < 192; it += F.nb) {
                    int s, h, br;
                    if (it < 128) { br = it & 1; h = (it >> 1) & 3; s = it >> 3; } else { const int v = it - 128; br = v & 1; h = (v >> 1) & 3; s = 16 + (v >> 3); }
                    if (br) g2_gla(F, l, s, h); else g2_gdn(F, l, s, h);
                    __syncthreads();
                }
            }
            if (k == 11 && (PHM & 0x200)) { ffn_mid(F, l); if (l < 3 && !dr) { __syncthreads(); cvt_mixer(F, l + 1); } }
            }
            F.dry = 0;
        }
#ifndef SYNCREP
#define SYNCREP 1
#endif
        if (ph + 1 < p.ph_hi) { for (int sr = 0; sr < SYNCREP; ++sr) { grid.sync(); } }
    }
#ifdef DBG_COL
    __threadfence(); grid.sync(); __threadfence();
    dbg_dump(F);
#endif
}

extern "C" void kernel_launch(void* const* d_in, const int* in_sizes, int n_in, void* d_out, int out_size, void* d_ws, size_t ws_size, hipStream_t stream) {
    static int grid_blocks = 0;
    if (grid_blocks == 0) {
        if (n_in != 33 || ws_size < WS_TOTAL) { fprintf(stderr, "kernel_launch: bad n_in %d or ws %zu < %zu\n", n_in, ws_size, (size_t)WS_TOTAL); grid_blocks = -1; return; }
        int dev = 0, cus = 0, per_cu = 0;
        hipGetDevice(&dev);
        hipDeviceGetAttribute(&cus, hipDeviceAttributeMultiprocessorCount, dev);
        if (hipFuncSetAttribute((const void*)fwd_kernel, hipFuncAttributeMaxDynamicSharedMemorySize, LDS_BYTES) != hipSuccess) { fprintf(stderr, "hipFuncSetAttribute failed\n"); grid_blocks = -1; return; }
        hipOccupancyMaxActiveBlocksPerMultiprocessor(&per_cu, (const void*)fwd_kernel, 512, LDS_BYTES);
        if (per_cu < 1) per_cu = 1;
        (void)hipGetLastError();
        grid_blocks = cus * 1;
        if (grid_blocks <= 0) grid_blocks = 256;
    }
    if (grid_blocks < 0) return;
    Params p{};
    for (int i = 0; i < 33; ++i) p.in[i] = (const float*)d_in[i];
    p.out = (float*)d_out; p.ws = (unsigned char*)d_ws; p.ph_lo = 0; p.ph_hi = PH_HI;
    void* args[] = {&p};
    hipError_t e = hipLaunchCooperativeKernel((const void*)fwd_kernel, dim3(grid_blocks), dim3(512), args, LDS_BYTES, stream);
    if (e != hipSuccess) fprintf(stderr, "cooperative launch failed: %s (grid %d)\n", hipGetErrorString(e), grid_blocks);
}
```

```cpp
#include <hip/hip_runtime.h>
#include <hip/hip_cooperative_groups.h>
#include <cstdint>
#include <cstdio>
namespace cg = cooperative_groups;

typedef unsigned short bf16_t;
typedef short bf16x8 __attribute__((ext_vector_type(8)));
typedef float f32x4 __attribute__((ext_vector_type(4)));
typedef float f32x2 __attribute__((ext_vector_type(2)));
typedef unsigned u32x2 __attribute__((ext_vector_type(2)));
typedef unsigned u32x4 __attribute__((ext_vector_type(4)));
#define DEV __device__ __forceinline__

constexpr int DM = 1024, TT = 33280, NCH = 520, LDP = 5632, LDE = 768;
constexpr int C_QA = 0, C_KA = 512, C_VA = 1024, C_ZA = 1536, C_QB = 2048, C_KB = 2304, C_VB = 2560, C_ZB = 3072, C_GA = 3584, C_GB = 4608;
constexpr int C_MRG = 0, C_PR = 1024, C_Q = 2048, C_O = 3072;
constexpr size_t O_Y = 0;
constexpr size_t O_GDN_P = 34078720ull;
constexpr size_t O_GDNC_P = O_GDN_P + 4194304ull;
constexpr size_t O_GLA_P = O_GDNC_P + 294912ull;
constexpr size_t O_FFNC_P = O_GLA_P + 2097152ull;
constexpr size_t O_MEMK = O_FFNC_P + 720896ull;
constexpr size_t O_MEMV = O_MEMK + 16777216ull;
constexpr size_t O_GDN_S = O_MEMV + 16777216ull;
constexpr size_t O_GDNC_S = O_GDN_S + 2097152ull;
constexpr size_t O_GLA_S = O_GDNC_S + 147456ull;
constexpr size_t O_FFNC_S = O_GLA_S + 1048576ull;
constexpr size_t al256(size_t x) { return (x + 255) & ~(size_t)255; }
constexpr size_t WS_WMIX = 0;
constexpr size_t WM_WIN = 0, WM_WSM = WM_WIN + 5632ull * 1024, WM_WOA = WM_WSM + 32 * 1024, WM_WOB = WM_WOA + 524288, WM_WO = WM_WOB + 524288,
                 WM_WMQ = WM_WO + 1048576, WM_WMK = WM_WMQ + 1048576, WM_WMV = WM_WMK + 1048576, WM_WMO = WM_WMV + 1048576, WM_END = WM_WMO + 1048576;
constexpr size_t WS_WFFN = al256(WS_WMIX + WM_END * 2);
constexpr size_t WF_UP = 0, WF_DN = 5632ull * 1024, WF_END = WF_DN + 1024ull * 2816;
constexpr size_t WS_XB = al256(WS_WFFN + WF_END * 2);
constexpr size_t WS_P = al256(WS_XB + (size_t)TT * 1024 * 2);
constexpr size_t WS_KV = al256(WS_P + (size_t)TT * LDP * 2);
constexpr size_t KV_BYTES = 2ull * 6144 * 1024 * 2;
constexpr size_t WS_MB = al256(WS_KV + KV_BYTES);
constexpr size_t WS_MRS = al256(WS_MB + 4096ull * 1024 * 2);
constexpr size_t WS_SSQ = al256(WS_MRS + 4096 * 4);
constexpr size_t WS_SC = al256(WS_SSQ + (size_t)TT * 16 * 4);
constexpr size_t WS_DL = al256(WS_SC + (size_t)TT * 32 * 4);
constexpr size_t WS_BG = al256(WS_DL + 520ull * 4 * 64 * 4);
constexpr size_t WS_TOTAL = al256(WS_BG + 520ull * 4 * 128 * 4);
constexpr int LDS_BYTES = 147456;
constexpr int NPH = 54;
#ifndef PH_HI
#define PH_HI NPH
#define REPMASK 0
#define SYNCREP 1
#define DRYMASK 0
#endif

struct Params { const float* in[33]; float* out; unsigned char* ws; int ph_lo, ph_hi; };

typedef __bf16 bf16x2_t __attribute__((ext_vector_type(2)));
DEV unsigned pk2(float lo, float hi) { f32x2 f = {lo, hi}; bf16x2_t v = __builtin_convertvector(f, bf16x2_t); return __builtin_bit_cast(unsigned, v); }
DEV float bf2f(bf16_t b) { return __uint_as_float(((unsigned)b) << 16); }
DEV float bflo(unsigned u) { return __uint_as_float(u << 16); }
DEV float bfhi(unsigned u) { return __uint_as_float(u & 0xffff0000u); }
DEV u32x2 pk4(f32x4 v) { u32x2 r; r.x = pk2(v[0], v[1]); r.y = pk2(v[2], v[3]); return r; }
DEV f32x4 unpk4(u32x2 u) { return (f32x4){bflo(u.x), bfhi(u.x), bflo(u.y), bfhi(u.y)}; }
DEV bf16x8 mk8(u32x2 a, u32x2 b) { u32x4 t = {a.x, a.y, b.x, b.y}; return __builtin_bit_cast(bf16x8, t); }
DEV float sigm(float x) { return 1.f / (1.f + __expf(-x)); }
DEV float silu(float x) { return x / (1.f + __expf(-x)); }
DEV float softplus(float x) { return x > 20.f ? x : __logf(1.f + __expf(x)); }
DEV float logsigmoid(float x) { return fminf(x, 0.f) - __logf(1.f + __expf(-fabsf(x))); }
DEV float row_rstd(const float* ssq, int row) {
    const f32x4 a = *(const f32x4*)(ssq + (size_t)row * 4), b = *(const f32x4*)(ssq + ((size_t)TT + row) * 4);
    const f32x4 c = *(const f32x4*)(ssq + ((size_t)2 * TT + row) * 4), d = *(const f32x4*)(ssq + ((size_t)3 * TT + row) * 4);
    float s = ((a[0] + a[1]) + (a[2] + a[3])) + ((b[0] + b[1]) + (b[2] + b[3])) + ((c[0] + c[1]) + (c[2] + c[3])) + ((d[0] + d[1]) + (d[2] + d[3]));
    return rsqrtf(s * (1.f / 1024.f) + 1e-6f);
}
DEV bf16x8 ldfragp(const bf16_t* base, int row, int stride, int k0, int fq) {
    const bf16_t* p = base + row * stride + k0 + 4 * fq;
    return mk8(*(const u32x2*)p, *(const u32x2*)(p + 16));
}
DEV bf16x8 ldfrag(const bf16_t* base, int row, int stride, int k0, int fq) {
    return *(const bf16x8*)(base + row * stride + k0 + 8 * fq);
}
#define MFMA16(a, b, c) __builtin_amdgcn_mfma_f32_16x16x32_bf16((a), (b), (c), 0, 0, 0)

constexpr int BM = 256, BK = 64, HALF = 128, HT = HALF * BK;
DEV int lds_byte(int r, int c) { int st = (r >> 4) * 2 + (c >> 5), rr = r & 15, cc = c & 31, ob = rr * 64 + cc * 2; return st * 1024 + (ob ^ (((ob >> 9) & 1) << 5)); }
DEV void stage_rc(int b, int& R, int& C) { int st = b / 1024, sb = b % 1024, swz = sb ^ (((sb >> 9) & 1) << 5); R = (st >> 1) * 16 + swz / 64; C = (st & 1) * 32 + (swz % 64) / 2; }

DEV void gemm_core(const bf16_t* __restrict__ A, int lda, const bf16_t* __restrict__ Bt, int ldb, int K, int brow, int bcol, f32x4 (&acc)[2][2][4][2], bf16_t* shm) {
#define SA(b, h) (shm + ((b) * 2 + (h)) * HT)
#define SB(b, h) (shm + (4 + (b) * 2 + (h)) * HT)
#define STAGE(P, BASE, LD, br, kt) do { const char* _gb = (const char*)((BASE) + (long)(br) * (LD) + (long)(kt) * BK); \
    const unsigned _vo = (unsigned)((sr0 * (int)(LD) + sc0) * 2); \
    for (int _i = 0; _i < 2; ++_i) { \
      __builtin_amdgcn_global_load_lds((const unsigned*)(_gb + (long)(_i * 128) * (LD) + _vo), (unsigned*)((char*)(P) + wbase + _i * 8192), 16, 0, 0); } } while (0)
#define LDA(dst, b, h) for (int m = 0; m < 4; ++m) for (int k = 0; k < 2; ++k) \
    dst[m][k] = *reinterpret_cast<const bf16x8*>((char*)SA(b, h) + lds_byte(wr * 64 + m * 16 + fr, k * 32 + fq * 8))
#define LDB(dst, b, h) for (int n = 0; n < 2; ++n) for (int k = 0; k < 2; ++k) \
    dst[n][k] = *reinterpret_cast<const bf16x8*>((char*)SB(b, h) + lds_byte(wc * 32 + n * 16 + fr, k * 32 + fq * 8))
#define MMA(ai, bj, At_, Bt_) do { __builtin_amdgcn_s_setprio(1); \
    for (int m = 0; m < 4; ++m) for (int n = 0; n < 2; ++n) for (int k = 0; k < 2; ++k) \
      acc[ai][bj][m][n] = __builtin_amdgcn_mfma_f32_16x16x32_bf16(Bt_[n][k], At_[m][k], acc[ai][bj][m][n], 0, 0, 0); \
    __builtin_amdgcn_s_setprio(0); } while (0)
#define WAIT_V(n) asm volatile("s_waitcnt vmcnt(" #n ")" ::: "memory")
#define WAIT_L(n) asm volatile("s_waitcnt lgkmcnt(" #n ")" ::: "memory")
#define BAR __builtin_amdgcn_s_barrier()
#define SCHED __builtin_amdgcn_sched_barrier(0)
    int tidx = threadIdx.x; asm volatile("" : "+v"(tidx));
    const int wid = __builtin_amdgcn_readfirstlane(tidx >> 6), lane = tidx & 63, wr = wid >> 2, wc = wid & 3, fr = lane & 15, fq = lane >> 4;
    const int wbase = wid * 1024;
    int sr0, sc0; stage_rc(tidx * 16, sr0, sc0);
#pragma unroll
    for (int a = 0; a < 2; ++a)
#pragma unroll
        for (int b = 0; b < 2; ++b)
#pragma unroll
            for (int m = 0; m < 4; ++m)
#pragma unroll
                for (int n = 0; n < 2; ++n) acc[a][b][m][n] = (f32x4){0.f, 0.f, 0.f, 0.f};
    bf16x8 At[4][2], B0[2][2], B1[2][2];
    const int nt = K / BK;
    STAGE(SB(0, 0), Bt, ldb, bcol, 0); STAGE(SA(0, 0), A, lda, brow, 0);
    STAGE(SB(0, 1), Bt, ldb, bcol + HALF, 0); STAGE(SA(0, 1), A, lda, brow + HALF, 0);
    if (wr == 1) BAR;
    WAIT_V(4); BAR;
    STAGE(SB(1, 0), Bt, ldb, bcol, 1); STAGE(SA(1, 0), A, lda, brow, 1); STAGE(SB(1, 1), Bt, ldb, bcol + HALF, 1);
    WAIT_V(6); BAR;
    for (int t = 0; t < nt - 2; t += 2) {
        LDB(B0, 0, 0); SCHED; LDA(At, 0, 0); STAGE(SA(1, 1), A, lda, brow + HALF, t + 1);
        WAIT_L(8); BAR; WAIT_L(0); MMA(0, 0, At, B0); BAR; SCHED;
        LDB(B1, 0, 1); STAGE(SB(0, 0), Bt, ldb, bcol, t + 2);
        BAR; WAIT_L(0); MMA(0, 1, At, B1); BAR;
        LDA(At, 0, 1); STAGE(SA(0, 0), A, lda, brow, t + 2);
        BAR; WAIT_L(0); MMA(1, 0, At, B0); BAR; SCHED;
        STAGE(SB(0, 1), Bt, ldb, bcol + HALF, t + 2);
        WAIT_V(6); BAR; MMA(1, 1, At, B1); BAR;
        LDB(B0, 1, 0); SCHED; LDA(At, 1, 0); STAGE(SA(0, 1), A, lda, brow + HALF, t + 2);
        WAIT_L(8); BAR; WAIT_L(0); MMA(0, 0, At, B0); BAR; SCHED;
        LDB(B1, 1, 1); STAGE(SB(1, 0), Bt, ldb, bcol, t + 3);
        BAR; WAIT_L(0); MMA(0, 1, At, B1); BAR;
        LDA(At, 1, 1); STAGE(SA(1, 0), A, lda, brow, t + 3);
        BAR; WAIT_L(0); MMA(1, 0, At, B0); BAR; SCHED;
        STAGE(SB(1, 1), Bt, ldb, bcol + HALF, t + 3);
        WAIT_V(6); BAR; MMA(1, 1, At, B1); BAR;
    }
    { LDB(B0, 0, 0); LDA(At, 0, 0); STAGE(SA(1, 1), A, lda, brow + HALF, nt - 1);
      BAR; WAIT_L(0); MMA(0, 0, At, B0); BAR;
      LDB(B1, 0, 1); BAR; WAIT_L(0); MMA(0, 1, At, B1); BAR;
      LDA(At, 0, 1); WAIT_V(4); BAR; WAIT_L(0); MMA(1, 0, At, B0); MMA(1, 1, At, B1); BAR; }
    { LDB(B0, 1, 0); LDA(At, 1, 0); WAIT_V(2); BAR; WAIT_L(0); MMA(0, 0, At, B0); BAR;
      LDB(B1, 1, 1); WAIT_V(0); BAR; WAIT_L(0); MMA(0, 1, At, B1); BAR;
      LDA(At, 1, 1); BAR; WAIT_L(0); MMA(1, 0, At, B0); MMA(1, 1, At, B1); BAR; }
    if (wr == 0) BAR;
#undef SA
#undef SB
}

typedef const float* const __attribute__((address_space(4)))* InTab;
struct Frame {
    InTab in; float* out; unsigned char* ws; unsigned char* lds;
    int tid, lane, wid, nb, bid, dry;
};
#define REFRAME Frame F = F0; { int t_ = threadIdx.x; asm volatile("" : "+v"(t_)); F.tid = t_; F.lane = t_ & 63; unsigned char* w_ = F.ws; asm volatile("" : "+s"(w_)); F.ws = w_; float* o_ = F.out; asm volatile("" : "+s"(o_)); F.out = o_; InTab i_ = (InTab)__builtin_amdgcn_kernarg_segment_ptr(); asm volatile("" : "+s"(i_)); F.in = i_; int a_ = F.wid, b_ = F.bid, c_ = F.nb; asm volatile("" : "+s"(a_), "+s"(b_), "+s"(c_)); F.wid = a_; F.bid = b_; F.nb = c_; }

enum { EPI_PROJ = 0, EPI_UP, EPI_RESID, EPI_Q, EPI_MEMK, EPI_MEMV, EPI_OUTA, EPI_OUTB, EPI_SOFTMAX, EPI_ATTNO };
struct GDesc { const bf16_t* A; int lda; const bf16_t* Bt; int ldb; int K, brow, bcol, epi, orow, ocol, head, vai, vwr; };

DEV void cvt_mat(const Frame& F0, const float* src, int ldsrc, int K, int N, int wincols, const float* gain, bf16_t* dst) {
    REFRAME;
    float* T = (float*)F.lds;
    const int nkt = K / 64, nnt = N / 64, ntile = nkt * nnt;
    for (int t = F.bid; t < ntile; t += F.nb) {
        const int kt = t / nnt, ntl = t % nnt, k0 = kt * 64, n0 = ntl * 64;
        int coff = 0; if (wincols) coff = (n0 < 1536) ? 0 : (n0 < 3072 ? 8 : 24);
        __syncthreads();
#pragma unroll
        for (int i = 0; i < 2; ++i) {
            const int kr = (F.tid >> 4) + 32 * i, nc = (F.tid & 15) * 4;
            f32x4 v = *(const f32x4*)(src + (size_t)(k0 + kr) * ldsrc + n0 + coff + nc);
            const float g = gain ? gain[k0 + kr] : 1.f;
            T[kr * 65 + nc + 0] = v[0] * g; T[kr * 65 + nc + 1] = v[1] * g; T[kr * 65 + nc + 2] = v[2] * g; T[kr * 65 + nc + 3] = v[3] * g;
        }
        __syncthreads();
        const int n = F.tid >> 3, kc = (F.tid & 7) * 8;
        u32x4 w;
        w.x = pk2(T[(kc + 0) * 65 + n], T[(kc + 1) * 65 + n]); w.y = pk2(T[(kc + 2) * 65 + n], T[(kc + 3) * 65 + n]);
        w.z = pk2(T[(kc + 4) * 65 + n], T[(kc + 5) * 65 + n]); w.w = pk2(T[(kc + 6) * 65 + n], T[(kc + 7) * 65 + n]);
        *(u32x4*)(dst + (size_t)(n0 + n) * K + k0 + kc) = w;
    }
    __syncthreads();
}
DEV void cvt_mixer(const Frame& F0, int l) {
    REFRAME;
    InTab in = F.in;
    cvt_mat(F, in[10] + (size_t)l * 1024 * 5656, 5656, 1024, 5632, 1, in[9] + l * 1024, ((bf16_t*)(F.ws + WS_WMIX)) + WM_WIN);
    cvt_mat(F, in[18] + (size_t)l * 512 * 1024, 1024, 512, 1024, 0, nullptr, ((bf16_t*)(F.ws + WS_WMIX)) + WM_WOA);
    cvt_mat(F, in[19] + (size_t)l * 512 * 1024, 1024, 512, 1024, 0, nullptr, ((bf16_t*)(F.ws + WS_WMIX)) + WM_WOB);
    cvt_mat(F, in[20] + (size_t)l * 1048576, 1024, 1024, 1024, 0, nullptr, ((bf16_t*)(F.ws + WS_WMIX)) + WM_WO);
    cvt_mat(F, in[23] + (size_t)l * 1048576, 1024, 1024, 1024, 0, in[21] + l * 1024, ((bf16_t*)(F.ws + WS_WMIX)) + WM_WMQ);
    cvt_mat(F, in[24] + (size_t)l * 1048576, 1024, 1024, 1024, 0, in[22] + l * 1024, ((bf16_t*)(F.ws + WS_WMIX)) + WM_WMK);
    cvt_mat(F, in[25] + (size_t)l * 1048576, 1024, 1024, 1024, 0, in[22] + l * 1024, ((bf16_t*)(F.ws + WS_WMIX)) + WM_WMV);
    cvt_mat(F, in[26] + (size_t)l * 1048576, 1024, 1024, 1024, 0, nullptr, ((bf16_t*)(F.ws + WS_WMIX)) + WM_WMO);
    const float* win = in[10] + (size_t)l * 1024 * 5656; const float* g = in[9] + l * 1024;
    for (int i = F.bid * 512 + F.tid; i < 32 * 1024; i += F.nb * 512) {
        const int n = i >> 10, k = i & 1023;
        float v = 0.f;
        if (n < 8) v = win[(size_t)k * 5656 + 1536 + n] * g[k]; else if (n < 24) v = win[(size_t)k * 5656 + 3080 + (n - 8)] * g[k];
        ((bf16_t*)(F.ws + WS_WMIX))[WM_WSM + i] = (bf16_t)(pk2(v, 0.f) & 0xffff);
    }
}
DEV void cvt_ffn(const Frame& F, int l) {
    cvt_mat(F, F.in[28] + (size_t)l * 1024 * 5632, 5632, 1024, 5632, 0, F.in[27] + l * 1024, ((bf16_t*)(F.ws + WS_WFFN)) + WF_UP);
    cvt_mat(F, F.in[31] + (size_t)l * 2816 * 1024, 1024, 2816, 1024, 0, nullptr, ((bf16_t*)(F.ws + WS_WFFN)) + WF_DN);
}

DEV void phase0(const Frame& F0) {
    REFRAME;
    const int gw = F.bid * 8 + F.wid, nw = F.nb * 8, lane = F.lane;
    for (int row = gw; row < TT + 4096; row += nw) {
        const bool ismem = row >= TT;
        const float* src = ismem ? F.in[8] + (size_t)(row - TT) * 1024 : (row < 32768 ? F.in[0] + (size_t)row * 1024 : F.in[1] + (size_t)(row - 32768) * 1024);
        f32x4 v[4]; float s = 0.f;
#pragma unroll
        for (int i = 0; i < 4; ++i) { v[i] = *(const f32x4*)(src + lane * 16 + i * 4); s += v[i][0] * v[i][0] + v[i][1] * v[i][1] + v[i][2] * v[i][2] + v[i][3] * v[i][3]; }
        u32x4 w0, w1;
        w0.x = pk2(v[0][0], v[0][1]); w0.y = pk2(v[0][2], v[0][3]); w0.z = pk2(v[1][0], v[1][1]); w0.w = pk2(v[1][2], v[1][3]);
        w1.x = pk2(v[2][0], v[2][1]); w1.y = pk2(v[2][2], v[2][3]); w1.z = pk2(v[3][0], v[3][1]); w1.w = pk2(v[3][2], v[3][3]);
        s += __shfl_xor(s, 1); s += __shfl_xor(s, 2);
        if (!ismem) {
            float* X = F.out + (size_t)row * 1024 + lane * 16;
#pragma unroll
            for (int i = 0; i < 4; ++i) *(f32x4*)(X + i * 4) = v[i];
            bf16_t* xb = ((bf16_t*)(F.ws + WS_XB)) + (size_t)row * 1024 + lane * 16;
            *(u32x4*)xb = w0; *(u32x4*)(xb + 8) = w1;
            if ((lane & 3) == 0) ((float*)(F.ws + WS_SSQ))[((size_t)(lane >> 4) * TT + row) * 4 + ((lane >> 2) & 3)] = s;
        } else {
            const int mr = row - TT;
            bf16_t* mb = ((bf16_t*)(F.ws + WS_MB)) + (size_t)mr * 1024 + lane * 16;
            *(u32x4*)mb = w0; *(u32x4*)(mb + 8) = w1;
            s += __shfl_xor(s, 4); s += __shfl_xor(s, 8); s += __shfl_xor(s, 16); s += __shfl_xor(s, 32);
            if (lane == 0) ((float*)(F.ws + WS_MRS))[mr] = rsqrtf(s * (1.f / 1024.f) + 1e-6f);
        }
    }
    cvt_mixer(F, 0);
    cvt_ffn(F, 0);
}

DEV void small_proj(const Frame& F0) {
    REFRAME;
    const int lane = F.lane, fr = lane & 15, fq = lane >> 4, mt = F.wid & 3, nt = F.wid >> 2;
    for (int c = F.bid; c < NCH; c += F.nb) {
        const int row = c * 64 + mt * 16 + fr;
        const bf16_t* a = ((bf16_t*)(F.ws + WS_XB)) + (size_t)row * 1024 + 8 * fq;
        const bf16_t* b = ((bf16_t*)(F.ws + WS_WMIX)) + WM_WSM + (size_t)(nt * 16 + fr) * 1024 + 8 * fq;
        f32x4 acc = {0.f, 0.f, 0.f, 0.f};
#pragma unroll 4
        for (int k = 0; k < 32; ++k) acc = MFMA16(*(const bf16x8*)(b + k * 32), *(const bf16x8*)(a + k * 32), acc);
        const float rs = row_rstd(((float*)(F.ws + WS_SSQ)), row);
        *(f32x4*)(((float*)(F.ws + WS_SC)) + (size_t)row * 32 + nt * 16 + 4 * fq) = acc * rs;
    }
}

DEV void gemm_epilogue(const Frame& F0, const GDesc& d, int l, f32x4 (&acc)[2][2][4][2]) {
    REFRAME;
    int lane_ = F.lane; asm volatile("" : "+v"(lane_));
    const int wr = F.wid >> 2, wc = F.wid & 3, fr = lane_ & 15, fq = lane_ >> 4;
    float* red = (float*)(F.lds + 131072);
    if (d.epi == EPI_SOFTMAX) {
        float mx[2][4];
#pragma unroll
        for (int ai = 0; ai < 2; ++ai)
#pragma unroll
            for (int m = 0; m < 4; ++m) {
                float v = -3.0e38f;
#pragma unroll
                for (int bj = 0; bj < 2; ++bj)
#pragma unroll
                    for (int n = 0; n < 2; ++n) { const f32x4 x = acc[ai][bj][m][n]; v = fmaxf(v, fmaxf(fmaxf(x[0], x[1]), fmaxf(x[2], x[3]))); }
                v = fmaxf(v, __shfl_xor(v, 16)); v = fmaxf(v, __shfl_xor(v, 32));
                if (fq == 0) red[(ai * 128 + wr * 64 + m * 16 + fr) * 4 + wc] = v;
            }
        __syncthreads();
#pragma unroll
        for (int ai = 0; ai < 2; ++ai)
#pragma unroll
            for (int m = 0; m < 4; ++m) {
                const f32x4 r4 = *(const f32x4*)(red + (ai * 128 + wr * 64 + m * 16 + fr) * 4);
                const float rm = fmaxf(fmaxf(r4[0], r4[1]), fmaxf(r4[2], r4[3]));
                mx[ai][m] = rm; float s = 0.f;
#pragma unroll
                for (int bj = 0; bj < 2; ++bj)
#pragma unroll
                    for (int n = 0; n < 2; ++n) { f32x4 x = acc[ai][bj][m][n];
#pragma unroll
                        for (int j = 0; j < 4; ++j) { x[j] = __expf(x[j] - rm); s += x[j]; }
                        acc[ai][bj][m][n] = x; }
                s += __shfl_xor(s, 16); s += __shfl_xor(s, 32);
                if (fq == 0) red[1024 + (ai * 128 + wr * 64 + m * 16 + fr) * 4 + wc] = s;
            }
        (void)mx;
        __syncthreads();
#pragma unroll
        for (int ai = 0; ai < 2; ++ai)
#pragma unroll
            for (int m = 0; m < 4; ++m) {
                const f32x4 r4 = *(const f32x4*)(red + 1024 + (ai * 128 + wr * 64 + m * 16 + fr) * 4);
                const float inv = 1.f / ((r4[0] + r4[1]) + (r4[2] + r4[3]));
                const bool valid = d.vai < 0 || (d.vai == ai && d.vwr == wr);
                const int row = d.orow + ai * 128 + wr * 64 + m * 16 + fr;
                if (valid) {
#pragma unroll
                    for (int bj = 0; bj < 2; ++bj)
#pragma unroll
                        for (int n = 0; n < 2; ++n) {
                            const int col = bj * 128 + wc * 32 + n * 16 + fq * 4;
                            *(u32x2*)(((bf16_t*)(F.ws + WS_P)) + (size_t)row * LDP + C_PR + d.head * 256 + col) = pk4(acc[ai][bj][m][n] * inv);
                        }
                }
            }
        __syncthreads();
        return;
    }
#pragma unroll
    for (int ai = 0; ai < 2; ++ai)
#pragma unroll
        for (int m = 0; m < 4; ++m) {
            const int row = d.orow + ai * 128 + wr * 64 + m * 16 + fr;
            float rs = 1.f, ss = 0.f;
            if (d.epi == EPI_PROJ || d.epi == EPI_UP || d.epi == EPI_Q) rs = row_rstd(((float*)(F.ws + WS_SSQ)), row);
            if (d.epi == EPI_Q) rs *= 0.0625f;
            if (d.epi == EPI_MEMK) rs = ((float*)(F.ws + WS_MRS))[row];
#pragma unroll
            for (int bj = 0; bj < 2; ++bj)
#pragma unroll
                for (int n = 0; n < 2; ++n) {
                    const int col = d.ocol + bj * 128 + wc * 32 + n * 16 + fq * 4;
                    f32x4 v = acc[ai][bj][m][n];
                    switch (d.epi) {
                    case EPI_PROJ: case EPI_UP: {
                        v = v * rs; const u32x2 w = pk4(v);
                        *(u32x2*)(((bf16_t*)(F.ws + WS_P)) + (size_t)row * LDP + col) = w;
                        const int nh = d.epi == EPI_PROJ ? 3 : 2, width = d.epi == EPI_PROJ ? 1536 : 5632;
                        if (m == 3 && fr >= 16 - nh && (d.epi == EPI_UP || col < 1536)) {
                            const int chunk = row >> 6, hr = fr - (16 - nh);
                            bf16_t* halo = d.epi == EPI_PROJ ? ((bf16_t*)(F.ws + WS_KV)) : ((bf16_t*)(F.ws + WS_KV));
                            *(u32x2*)(halo + ((size_t)chunk * nh + hr) * width + col) = w;
                            if (chunk >= 512 || (chunk & 31) == 31) {
                                float* o;
                                if (d.epi == EPI_PROJ) o = chunk < 512 ? F.out + O_GDNC_P + ((size_t)(l * 16 + (chunk >> 5)) * 3 + hr) * 1536 + col
                                                                       : F.out + O_GDNC_S + ((size_t)(l * 8 + (chunk - 512)) * 3 + hr) * 1536 + col;
                                else o = chunk < 512 ? F.out + O_FFNC_P + ((size_t)(l * 16 + (chunk >> 5)) * 2 + hr) * 5632 + col
                                                     : F.out + O_FFNC_S + ((size_t)(l * 8 + (chunk - 512)) * 2 + hr) * 5632 + col;
                                *(f32x4*)o = v;
                            }
                        }
                    } break;
                    case EPI_RESID: {
                        float* X = F.out + (size_t)row * 1024 + col;
                        f32x4 x = *(const f32x4*)X; x = x + v; *(f32x4*)X = x;
                        *(u32x2*)(((bf16_t*)(F.ws + WS_XB)) + (size_t)row * 1024 + col) = pk4(x);
                        ss += (x[0] * x[0] + x[1] * x[1]) + (x[2] * x[2] + x[3] * x[3]);
                    } break;
                    case EPI_Q: *(u32x2*)(((bf16_t*)(F.ws + WS_P)) + (size_t)row * LDP + C_Q + col) = pk4(v * rs); break;
                    case EPI_MEMK: {
                        v = v * rs;
                        *(f32x4*)(F.out + O_MEMK + ((size_t)l * 4096 + row) * 1024 + col) = v;
                        *(u32x2*)(((bf16_t*)(F.ws + WS_KV)) + (size_t)row * 1024 + col) = pk4(v);
                    } break;
                    case EPI_MEMV: {
                        const f32x4 r4 = *(const f32x4*)(((float*)(F.ws + WS_MRS)) + col);
                        v = v * r4;
                        float* o = F.out + O_MEMV + ((size_t)l * 4096 + col) * 1024 + row;
                        o[0] = v[0]; o[1024] = v[1]; o[2048] = v[2]; o[3072] = v[3];
                        const int b = col >> 8, h = row >> 8;
                        *(u32x2*)(((bf16_t*)(F.ws + WS_KV + 6144ull * 1024 * 2)) + ((size_t)(b * 4 + h) * 256 + (row & 255)) * 256 + (col & 255)) = pk4(v);
                    } break;
                    case EPI_OUTA: {
                        const f32x4 g = unpk4(*(const u32x2*)(((bf16_t*)(F.ws + WS_P)) + (size_t)row * LDP + C_GA + col));
                        f32x4 o; for (int j = 0; j < 4; ++j) o[j] = sigm(g[j]) * v[j];
                        *(u32x2*)(((bf16_t*)(F.ws + WS_P)) + (size_t)row * LDP + C_MRG + col) = pk4(o);
                    } break;
                    case EPI_OUTB: {
                        const f32x4 g = unpk4(*(const u32x2*)(((bf16_t*)(F.ws + WS_P)) + (size_t)row * LDP + C_GB + col));
                        f32x4 o = unpk4(*(const u32x2*)(((bf16_t*)(F.ws + WS_P)) + (size_t)row * LDP + C_MRG + col));
                        for (int j = 0; j < 4; ++j) o[j] += sigm(g[j]) * v[j];
                        *(u32x2*)(((bf16_t*)(F.ws + WS_P)) + (size_t)row * LDP + C_MRG + col) = pk4(o);
                    } break;
                    case EPI_ATTNO: {
                        const bool valid = d.vai < 0 || (d.vai == ai && d.vwr == wr);
                        if (valid) *(u32x2*)(((bf16_t*)(F.ws + WS_P)) + (size_t)row * LDP + C_O + d.head * 256 + col) = pk4(v);
                    } break;
                    default: break;
                    }
                }
            if (d.epi == EPI_RESID) {
                ss += __shfl_xor(ss, 16); ss += __shfl_xor(ss, 32);
                if (fq == 0) ((float*)(F.ws + WS_SSQ))[((size_t)(d.ocol >> 8) * TT + row) * 4 + wc] = ss;
            }
        }
}

enum { GP_IN = 0, GP_OUT, GP_WO, GP_MQ, GP_ATTN, GP_MO, GP_UP, GP_DOWN, GP_ATTN2, GP_OUT2 };
DEV void gemm_phase(const Frame& F0, int kind, int l) {
    REFRAME;
    int nunits = 0;
    switch (kind) { case GP_IN: case GP_UP: nunits = 130 * 22; break; case GP_OUT: nunits = 520 + 128; break; case GP_OUT2: nunits = 520; break; case GP_ATTN: case GP_ATTN2: nunits = 512 + 32; break; default: nunits = 520; }
    f32x4 acc[2][2][4][2];
    const bool xmap = (F.nb == 256) && (kind == GP_IN || kind == GP_UP || kind == GP_WO || kind == GP_MQ || kind == GP_MO || kind == GP_DOWN || kind == GP_OUT2);
    const int xcd = F.bid & 7, slot = F.bid >> 3, w_lo = (int)(((long)nunits * xcd) >> 3), w_hi = (int)(((long)nunits * (xcd + 1)) >> 3);
    for (int u0 = xmap ? w_lo + slot : F.bid; u0 < (xmap ? w_hi : nunits); u0 += xmap ? 32 : F.nb) {
        int u = u0;
        if (xmap) { const int nn = (kind == GP_IN || kind == GP_UP) ? 22 : 4; const int pn_ = u0 / 130, pm_ = u0 % 130; u = pm_ * nn + pn_; }
        GDesc d;
        { const int sub = (kind == GP_ATTN2 || kind == GP_OUT2) ? 1 : 0;
            d.vai = -1; d.vwr = 0; d.head = 0;
            switch (kind) {
            case GP_IN: { const int pm = u / 22, pn = u % 22; d.A = ((bf16_t*)(F.ws + WS_XB)); d.lda = 1024; d.Bt = ((bf16_t*)(F.ws + WS_WMIX)) + WM_WIN; d.ldb = 1024; d.K = 1024; d.brow = pm * 256; d.bcol = pn * 256; d.epi = EPI_PROJ; d.orow = d.brow; d.ocol = d.bcol; } break;
            case GP_UP: { const int pm = u / 22, pn = u % 22; d.A = ((bf16_t*)(F.ws + WS_XB)); d.lda = 1024; d.Bt = ((bf16_t*)(F.ws + WS_WFFN)) + WF_UP; d.ldb = 1024; d.K = 1024; d.brow = pm * 256; d.bcol = pn * 256; d.epi = EPI_UP; d.orow = d.brow; d.ocol = d.bcol; } break;
            case GP_OUT: case GP_OUT2:
                if (u < 520) { const int pm = u >> 2, pn = u & 3; d.A = ((bf16_t*)(F.ws + WS_P)) + (sub == 0 ? C_ZA : C_ZB); d.lda = LDP; d.Bt = ((bf16_t*)(F.ws + WS_WMIX)) + (sub == 0 ? WM_WOA : WM_WOB); d.ldb = 512; d.K = 512;
                               d.brow = pm * 256; d.bcol = pn * 256; d.epi = sub == 0 ? EPI_OUTA : EPI_OUTB; d.orow = d.brow; d.ocol = d.bcol; }
                else if (u < 520 + 64) { const int v = u - 520, pm = v >> 2, pn = v & 3; d.A = ((bf16_t*)(F.ws + WS_MB)); d.lda = 1024; d.Bt = ((bf16_t*)(F.ws + WS_WMIX)) + WM_WMK; d.ldb = 1024; d.K = 1024; d.brow = pm * 256; d.bcol = pn * 256; d.epi = EPI_MEMK; d.orow = d.brow; d.ocol = d.bcol; }
                else { const int v = u - 584, pm = v & 3, pn = v >> 2; d.A = ((bf16_t*)(F.ws + WS_WMIX)) + WM_WMV; d.lda = 1024; d.Bt = ((bf16_t*)(F.ws + WS_MB)); d.ldb = 1024; d.K = 1024; d.brow = pm * 256; d.bcol = pn * 256; d.epi = EPI_MEMV; d.orow = d.brow; d.ocol = d.bcol; }
                break;
            case GP_WO: { const int pm = u >> 2, pn = u & 3; d.A = ((bf16_t*)(F.ws + WS_P)) + C_MRG; d.lda = LDP; d.Bt = ((bf16_t*)(F.ws + WS_WMIX)) + WM_WO; d.ldb = 1024; d.K = 1024; d.brow = pm * 256; d.bcol = pn * 256; d.epi = EPI_RESID; d.orow = d.brow; d.ocol = d.bcol; } break;
            case GP_MQ: { const int pm = u >> 2, pn = u & 3; d.A = ((bf16_t*)(F.ws + WS_XB)); d.lda = 1024; d.Bt = ((bf16_t*)(F.ws + WS_WMIX)) + WM_WMQ; d.ldb = 1024; d.K = 1024; d.brow = pm * 256; d.bcol = pn * 256; d.epi = EPI_Q; d.orow = d.brow; d.ocol = d.bcol; } break;
            case GP_MO: { const int pm = u >> 2, pn = u & 3; d.A = ((bf16_t*)(F.ws + WS_P)) + C_O; d.lda = LDP; d.Bt = ((bf16_t*)(F.ws + WS_WMIX)) + WM_WMO; d.ldb = 1024; d.K = 1024; d.brow = pm * 256; d.bcol = pn * 256; d.epi = EPI_RESID; d.orow = d.brow; d.ocol = d.bcol; } break;
            case GP_DOWN: { const int pm = u >> 2, pn = u & 3; d.A = ((bf16_t*)(F.ws + WS_P)); d.lda = LDP; d.Bt = ((bf16_t*)(F.ws + WS_WFFN)) + WF_DN; d.ldb = 2816; d.K = 2816; d.brow = pm * 256; d.bcol = pn * 256; d.epi = EPI_RESID; d.orow = d.brow; d.ocol = d.bcol; } break;
            case GP_ATTN: case GP_ATTN2: {
                int pm, h, b;
                if (u < 512) { pm = u >> 2; h = u & 3; b = pm >> 3; }
                else { const int v = u - 512; h = v & 3; const int bi = (v >> 2) & 3, t = v >> 4; pm = 128 + t; b = 16 + 4 * t + bi; d.vai = bi >> 1; d.vwr = bi & 1; }
                d.head = h; d.brow = pm * 256; d.orow = d.brow; d.ocol = 0; d.K = 256; d.bcol = 0;
                if (sub == 0) { d.A = ((bf16_t*)(F.ws + WS_P)) + C_Q + h * 256; d.lda = LDP; d.Bt = ((bf16_t*)(F.ws + WS_KV)) + (size_t)b * 256 * 1024 + h * 256; d.ldb = 1024; d.epi = EPI_SOFTMAX; }
                else { d.A = ((bf16_t*)(F.ws + WS_P)) + C_PR + h * 256; d.lda = LDP; d.Bt = ((bf16_t*)(F.ws + WS_KV + 6144ull * 1024 * 2)) + (size_t)(b * 4 + h) * 65536; d.ldb = 256; d.epi = EPI_ATTNO; }
            } break;
            }
        }
        gemm_core(d.A, d.lda, d.Bt, d.ldb, d.K, d.brow, d.bcol, acc, (bf16_t*)F.lds);
        gemm_epilogue(F, d, l, acc);
    }
}

DEV void sample_kv(const Frame& F0, int l) {
    REFRAME;
    const float* ck = F.in[6] + (size_t)l * 2097152; const float* cv = F.in[7] + (size_t)l * 2097152;
    for (int i = F.bid * 512 + F.tid; i < 262144; i += F.nb * 512) {
        const f32x4 a = *(const f32x4*)(ck + (size_t)i * 8), b = *(const f32x4*)(ck + (size_t)i * 8 + 4);
        u32x4 w; w.x = pk2(a[0], a[1]); w.y = pk2(a[2], a[3]); w.z = pk2(b[0], b[1]); w.w = pk2(b[2], b[3]);
        *(u32x4*)(((bf16_t*)(F.ws + WS_KV)) + 4096ull * 1024 + (size_t)i * 8) = w;
        const int dd = i & 255, m8 = (i >> 8) & 31, h = (i >> 13) & 3, bb = i >> 15;
        const float* s = cv + ((size_t)(bb * 256 + m8 * 8) * 4 + h) * 256 + dd;
        u32x4 x; x.x = pk2(s[0], s[1024]); x.y = pk2(s[2048], s[3072]); x.z = pk2(s[4096], s[5120]); x.w = pk2(s[6144], s[7168]);
        *(u32x4*)(((bf16_t*)(F.ws + WS_KV + 6144ull * 1024 * 2)) + ((size_t)((16 + bb) * 4 + h) * 256 + dd) * 256 + m8 * 8) = x;
    }
}

DEV void g1_gdn(const Frame& F0, int l, int c, int h) {
    REFRAME;
    float* Fq = (float*)F.lds;
    bf16_t* VS = (bf16_t*)(F.lds + 66560);
    bf16_t* QN = (bf16_t*)(F.lds + 82944);
    bf16_t* KN = (bf16_t*)(F.lds + 100352);
    float* AM = (float*)(F.lds + 117760);
    float* sB = (float*)(F.lds + 135168); float* sG = sB + 64; float* sRQ = sB + 128; float* sRK = sB + 192;
    const int tid = F.tid, lane = F.lane, t0 = c * 64;
    const bool first = c >= 512 || (c & 31) == 0; const bool sample = c >= 512;
    __syncthreads();
    if (F.wid == 0) {
        const int t = t0 + lane;
        const float braw = ((float*)(F.ws + WS_SC))[(size_t)t * 32 + h], araw = ((float*)(F.ws + WS_SC))[(size_t)t * 32 + 4 + h];
        const float beta = sigm(braw);
        float g = -__expf(F.in[12][l * 4 + h]) * softplus(araw + F.in[13][l * 4 + h]);
#pragma unroll
        for (int off = 1; off < 64; off <<= 1) { const float n = __shfl_up(g, off); if (lane >= off) g += n; }
        sB[lane] = beta; sG[lane] = g;
        if (!F.dry) ((float*)(F.ws + WS_BG))[((size_t)c * 4 + h) * 128 + lane] = beta; if (!F.dry) ((float*)(F.ws + WS_BG))[((size_t)c * 4 + h) * 128 + 64 + lane] = g;
    }
    __syncthreads();
    const float* cw = F.in[11] + (size_t)l * 4 * 1536;
    if (tid < 384) {
        const int cp = tid % 192, rh = tid / 192, which = cp >> 6, cc = (cp & 63) * 2, pcol = which * 512 + h * 128 + cc;
        const f32x2 w0 = *(const f32x2*)(cw + pcol), w1 = *(const f32x2*)(cw + 1536 + pcol), w2 = *(const f32x2*)(cw + 2 * 1536 + pcol), w3 = *(const f32x2*)(cw + 3 * 1536 + pcol);
        float x0[35], x1[35];
#pragma unroll
        for (int i = 0; i < 3; ++i) {
            x0[i] = 0.f; x1[i] = 0.f;
            if (rh == 1) { const unsigned u = *(const unsigned*)(((bf16_t*)(F.ws + WS_P)) + (size_t)(t0 + 29 + i) * LDP + pcol); x0[i] = bflo(u); x1[i] = bfhi(u); }
            else if (!first) { const unsigned u = *(const unsigned*)(((bf16_t*)(F.ws + WS_KV)) + ((size_t)(c - 1) * 3 + i) * 1536 + pcol); x0[i] = bflo(u); x1[i] = bfhi(u); }
            else if (sample) { const f32x2 f = *(const f32x2*)(F.in[3] + ((size_t)(l * 8 + (c - 512)) * 3 + i) * 1536 + pcol); x0[i] = f[0]; x1[i] = f[1]; }
        }
#pragma unroll
        for (int i = 0; i < 32; ++i) { const unsigned u = *(const unsigned*)(((bf16_t*)(F.ws + WS_P)) + (size_t)(t0 + 32 * rh + i) * LDP + pcol); x0[3 + i] = bflo(u); x1[3 + i] = bfhi(u); }
#pragma unroll
        for (int r = 0; r < 32; ++r) {
            float a0 = w0[0] * x0[r] + w1[0] * x0[r + 1] + w2[0] * x0[r + 2] + w3[0] * x0[r + 3];
            float a1 = w0[1] * x1[r] + w1[1] * x1[r + 1] + w2[1] * x1[r + 2] + w3[1] * x1[r + 3];
            a0 = silu(a0); a1 = silu(a1);
            const int rr = 32 * rh + r;
            if (which < 2) { *(f32x2*)(Fq + rr * 260 + which * 128 + cc) = (f32x2){a0, a1}; }
            else { const float be = sB[rr]; *(unsigned*)(VS + rr * 128 + cc) = pk2(a0 * be, a1 * be); }
        }
    }
    __syncthreads();
    {
        const int r = tid >> 3, j = tid & 7; const float* p = Fq + r * 260 + j * 32; float s = 0.f;
#pragma unroll
        for (int i = 0; i < 32; ++i) s += p[i] * p[i];
        s += __shfl_xor(s, 1); s += __shfl_xor(s, 2);
        if ((j & 3) == 0) { if (j == 0) sRQ[r] = rsqrtf(s + 1e-6f) * 0.08838834764831845f; else sRK[r] = rsqrtf(s + 1e-6f); }
    }
    __syncthreads();
    for (int idx = tid; idx < 64 * 64; idx += 512) {
        const int r = idx >> 6, c4 = (idx & 63) * 4; const bool isq = c4 < 128;
        f32x4 v = *(const f32x4*)(Fq + r * 260 + c4); v = v * (isq ? sRQ[r] : sRK[r]);
        const u32x2 w = pk4(v);
        if (isq) { *(u32x2*)(QN + r * 136 + c4) = w; if (!F.dry) *(u32x2*)(((bf16_t*)(F.ws + WS_P)) + (size_t)(t0 + r) * LDP + C_QA + h * 128 + c4) = w; }
        else { *(u32x2*)(KN + r * 136 + c4 - 128) = w; if (!F.dry) *(u32x2*)(((bf16_t*)(F.ws + WS_P)) + (size_t)(t0 + r) * LDP + C_KA + h * 128 + c4 - 128) = w; }
    }
    for (int idx = tid; idx < 64 * 32; idx += 512) {
        const int r = idx >> 5, c4 = (idx & 31) * 4;
        if (!F.dry) *(u32x2*)(((bf16_t*)(F.ws + WS_P)) + (size_t)(t0 + r) * LDP + C_VA + h * 128 + c4) = *(const u32x2*)(VS + r * 128 + c4);
    }
    __syncthreads();
    {
        const int fr = lane & 15, fq = lane >> 4, which = F.wid >> 2, it = F.wid & 3;
        const bf16_t* X = which ? QN : KN;
        const int crow = 16 * it + fr; const float gc = sG[crow], bc = sB[crow];
        for (int jt = 0; jt < 4; ++jt) {
            f32x4 a = {0.f, 0.f, 0.f, 0.f};
            if (jt <= it) {
#pragma unroll
                for (int ks = 0; ks < 4; ++ks) a = MFMA16(ldfrag(KN, 16 * jt + fr, 136, 32 * ks, fq), ldfrag(X, crow, 136, 32 * ks, fq), a);
            }
            f32x4 o;
#pragma unroll
            for (int j = 0; j < 4; ++j) {
                const int s = 16 * jt + 4 * fq + j;
                const bool keep = which ? (s <= crow) : (s < crow);
                const float dec = keep ? __expf(gc - sG[s]) : 0.f;
                o[j] = a[j] * dec * (which ? 1.f : bc);
            }
            if (which) { if (!F.dry) *(u32x2*)(((bf16_t*)(F.ws + WS_XB)) + (size_t)(t0 + crow) * LDE + h * 128 + 64 + 16 * jt + 4 * fq) = pk4(o); }
            else *(f32x4*)(AM + crow * 68 + 16 * jt + 4 * fq) = o;
        }
    }
    __syncthreads();
    if (F.wid == 0) {
        float Tc[64]; const float lanef = (float)lane;
        typedef __attribute__((address_space(3))) const f32x4 LDSF4;
        __attribute__((address_space(3))) const char* aml = (__attribute__((address_space(3))) const char*)AM; asm volatile("" : "+v"(aml));
#pragma unroll
        for (int i = 0; i < 64; ++i) {
            float a = fmaxf(0.f, 1.f - fabsf(lanef - (float)i));
#pragma unroll
            for (int j4 = 0; j4 < (i + 3) / 4; ++j4) {
                const f32x4 av = *(const LDSF4*)(aml + (i * 68 + j4 * 4) * 4);
#pragma unroll
                for (int jj = 0; jj < 4; ++jj) if (j4 * 4 + jj < i) a -= av[jj] * Tc[j4 * 4 + jj];
            }
            Tc[i] = a;
        }
#pragma unroll
        for (int i = 0; i < 64; i += 2) {
            const unsigned w = pk2(Tc[i], Tc[i + 1]);
            if (!F.dry) ((bf16_t*)(F.ws + WS_XB))[(size_t)(t0 + i) * LDE + h * 128 + lane] = (bf16_t)(w & 0xffff);
            if (!F.dry) ((bf16_t*)(F.ws + WS_XB))[(size_t)(t0 + i + 1) * LDE + h * 128 + lane] = (bf16_t)(w >> 16);
        }
    }
}

DEV void g1_gla(const Frame& F0, int l, int c, int h) {
    REFRAME;
    float* GL = (float*)F.lds;
    float* LA = (float*)(F.lds + 4096);
    bf16_t* QG = (bf16_t*)(F.lds + 20736);
    bf16_t* KI = (bf16_t*)(F.lds + 29952);
    const int tid = F.tid, lane = F.lane, t0 = c * 64;
    __syncthreads();
    if (tid < 256) { const int r = tid >> 2, q4 = (tid & 3) * 4; *(f32x4*)(GL + r * 16 + q4) = *(const f32x4*)(((float*)(F.ws + WS_SC)) + (size_t)(t0 + r) * 32 + 8 + q4); }
    __syncthreads();
    {
        const int dk = tid & 63, rb = tid >> 6;
        float w2[16];
#pragma unroll
        for (int i = 0; i < 16; ++i) w2[i] = F.in[15][(size_t)(l * 16 + i) * 256 + h * 64 + dk];
        const float bias = F.in[16][l * 256 + h * 64 + dk];
#pragma unroll
        for (int rr = 0; rr < 8; ++rr) {
            const int r = rb * 8 + rr; float x = bias;
#pragma unroll
            for (int i = 0; i < 16; ++i) x += GL[r * 16 + i] * w2[i];
            LA[r * 65 + dk] = logsigmoid(x) * 0.0625f;
        }
    }
    __syncthreads();
    if (tid < 64) {
        float g = 0.f;
#pragma unroll 8
        for (int r = 0; r < 64; ++r) { g += LA[r * 65 + tid]; LA[r * 65 + tid] = g; }
        if (!F.dry) ((float*)(F.ws + WS_DL))[((size_t)c * 4 + h) * 64 + tid] = __expf(g);
    }
    __syncthreads();
    for (int idx = tid; idx < 64 * 16; idx += 512) {
        const int r = idx >> 4, c4 = (idx & 15) * 4;
        bf16_t* qp = ((bf16_t*)(F.ws + WS_P)) + (size_t)(t0 + r) * LDP + C_QB + h * 64 + c4; bf16_t* kp = ((bf16_t*)(F.ws + WS_P)) + (size_t)(t0 + r) * LDP + C_KB + h * 64 + c4;
        const f32x4 q = unpk4(*(const u32x2*)qp), k = unpk4(*(const u32x2*)kp);
        f32x4 qg, ki, kg;
#pragma unroll
        for (int j = 0; j < 4; ++j) { const float g = LA[r * 65 + c4 + j], gl = LA[63 * 65 + c4 + j];
            qg[j] = q[j] * 0.125f * __expf(g); ki[j] = k[j] * __expf(-g); kg[j] = k[j] * __expf(gl - g); }
        const u32x2 wq = pk4(qg);
        *(u32x2*)(QG + r * 72 + c4) = wq; *(u32x2*)(KI + r * 72 + c4) = pk4(ki);
        if (!F.dry) *(u32x2*)qp = wq; if (!F.dry) *(u32x2*)kp = pk4(kg);
    }
    __syncthreads();
    {
        const int fr = lane & 15, fq = lane >> 4, it = F.wid >> 1; const int crow = 16 * it + fr;
#pragma unroll
        for (int q = 0; q < 2; ++q) {
            const int jt = (F.wid & 1) * 2 + q;
            f32x4 a = {0.f, 0.f, 0.f, 0.f};
            if (jt <= it) {
#pragma unroll
                for (int ks = 0; ks < 2; ++ks) a = MFMA16(ldfrag(KI, 16 * jt + fr, 72, 32 * ks, fq), ldfrag(QG, crow, 72, 32 * ks, fq), a);
            }
#pragma unroll
            for (int j = 0; j < 4; ++j) if (16 * jt + 4 * fq + j > crow) a[j] = 0.f;
            if (!F.dry) *(u32x2*)(((bf16_t*)(F.ws + WS_XB)) + (size_t)(t0 + crow) * LDE + 512 + h * 64 + 16 * jt + 4 * fq) = pk4(a);
        }
    }
}

DEV void g2_gdn(const Frame& F0, int l, int s, int h) {
    REFRAME;
    bf16_t* QN = (bf16_t*)F.lds;
    bf16_t* KN = (bf16_t*)(F.lds + 17408);
    bf16_t* KT = (bf16_t*)(F.lds + 34816);
    bf16_t* TM = (bf16_t*)(F.lds + 53248);
    bf16_t* AQ = (bf16_t*)(F.lds + 62464);
    float* sB = (float*)(F.lds + 71680); float* sG = sB + 64;
    float* RED = (float*)(F.lds + 72192);
    const int tid = F.tid, lane = F.lane, w = F.wid, fr = lane & 15, fq = lane >> 4;
    const bool sample = s >= 16; const int nchunk = sample ? 1 : 32; const int tbase = sample ? 32768 + (s - 16) * 64 : s * 2048;
    const int dvc = h * 128 + 16 * w + fr;
    f32x4 S[8];
#pragma unroll
    for (int mt = 0; mt < 8; ++mt) {
        if (sample) { const float* sp = F.in[2] + ((size_t)((l * 8 + (s - 16)) * 4 + h) * 128) * 128;
#pragma unroll
            for (int j = 0; j < 4; ++j) S[mt][j] = sp[(size_t)(16 * mt + 4 * fq + j) * 128 + 16 * w + fr]; }
        else S[mt] = (f32x4){0.f, 0.f, 0.f, 0.f};
    }
    const float gn = F.in[14][l * 128 + 16 * w + fr];
    for (int n = 0; n < nchunk; ++n) {
        const int t0 = tbase + n * 64;
        __syncthreads();
#pragma unroll
        for (int i = 0; i < 2; ++i) {
            const int p = tid + 512 * i, r = p >> 4, c8 = (p & 15) * 8;
            const u32x4 q = *(const u32x4*)(((bf16_t*)(F.ws + WS_P)) + (size_t)(t0 + r) * LDP + C_QA + h * 128 + c8);
            const u32x4 k = *(const u32x4*)(((bf16_t*)(F.ws + WS_P)) + (size_t)(t0 + r) * LDP + C_KA + h * 128 + c8);
            *(u32x4*)(QN + r * 136 + c8) = q; *(u32x4*)(KN + r * 136 + c8) = k;
            KT[(c8 + 0) * 72 + r] = (bf16_t)(k.x & 0xffff); KT[(c8 + 1) * 72 + r] = (bf16_t)(k.x >> 16);
            KT[(c8 + 2) * 72 + r] = (bf16_t)(k.y & 0xffff); KT[(c8 + 3) * 72 + r] = (bf16_t)(k.y >> 16);
            KT[(c8 + 4) * 72 + r] = (bf16_t)(k.z & 0xffff); KT[(c8 + 5) * 72 + r] = (bf16_t)(k.z >> 16);
            KT[(c8 + 6) * 72 + r] = (bf16_t)(k.w & 0xffff); KT[(c8 + 7) * 72 + r] = (bf16_t)(k.w >> 16);
        }
        {
            const int r = tid >> 3, c8 = (tid & 7) * 8;
            *(u32x4*)(TM + r * 72 + c8) = *(const u32x4*)(((bf16_t*)(F.ws + WS_XB)) + (size_t)(t0 + r) * LDE + h * 128 + c8);
            *(u32x4*)(AQ + r * 72 + c8) = *(const u32x4*)(((bf16_t*)(F.ws + WS_XB)) + (size_t)(t0 + r) * LDE + h * 128 + 64 + c8);
        }
        if (tid < 128) sB[tid] = ((float*)(F.ws + WS_BG))[((size_t)(t0 >> 6) * 4 + h) * 128 + tid];
        __syncthreads();
        f32x4 kS[4], qS[4], vn[4], o[4];
#pragma unroll
        for (int mt = 0; mt < 4; ++mt) { kS[mt] = (f32x4){0.f, 0.f, 0.f, 0.f}; qS[mt] = kS[mt]; vn[mt] = kS[mt]; }
#pragma unroll
        for (int ks = 0; ks < 4; ++ks) {
            const bf16x8 sf = mk8(pk4(S[2 * ks]), pk4(S[2 * ks + 1]));
#pragma unroll
            for (int mt = 0; mt < 4; ++mt) {
                kS[mt] = MFMA16(ldfragp(KN, 16 * mt + fr, 136, 32 * ks, fq), sf, kS[mt]);
                qS[mt] = MFMA16(ldfragp(QN, 16 * mt + fr, 136, 32 * ks, fq), sf, qS[mt]);
            }
        }
        const float glast = sG[63];
        f32x4 eg[4], tmp[4];
#pragma unroll
        for (int mt = 0; mt < 4; ++mt)
#pragma unroll
            for (int j = 0; j < 4; ++j) {
                const int row = 16 * mt + 4 * fq + j;
                const float e = __expf(sG[row]); eg[mt][j] = e;
                const float vv = bf2f(((bf16_t*)(F.ws + WS_P))[(size_t)(t0 + row) * LDP + C_VA + dvc]);
                tmp[mt][j] = vv - sB[row] * e * kS[mt][j];
            }
#pragma unroll
        for (int ks = 0; ks < 2; ++ks) {
            const bf16x8 tf = mk8(pk4(tmp[2 * ks]), pk4(tmp[2 * ks + 1]));
#pragma unroll
            for (int mt = 0; mt < 4; ++mt) vn[mt] = MFMA16(ldfragp(TM, 16 * mt + fr, 72, 32 * ks, fq), tf, vn[mt]);
        }
#pragma unroll
        for (int mt = 0; mt < 4; ++mt) o[mt] = eg[mt] * qS[mt];
#pragma unroll
        for (int ks = 0; ks < 2; ++ks) {
            const bf16x8 vf = mk8(pk4(vn[2 * ks]), pk4(vn[2 * ks + 1]));
#pragma unroll
            for (int mt = 0; mt < 4; ++mt) o[mt] = MFMA16(ldfragp(AQ, 16 * mt + fr, 72, 32 * ks, fq), vf, o[mt]);
        }
        const float dl = __expf(glast);
#pragma unroll
        for (int mt = 0; mt < 4; ++mt)
#pragma unroll
            for (int j = 0; j < 4; ++j) vn[mt][j] *= __expf(glast - sG[16 * mt + 4 * fq + j]);
#pragma unroll
        for (int mt = 0; mt < 8; ++mt) S[mt] = S[mt] * dl;
#pragma unroll
        for (int ks = 0; ks < 2; ++ks) {
            const bf16x8 vf = mk8(pk4(vn[2 * ks]), pk4(vn[2 * ks + 1]));
#pragma unroll
            for (int mt = 0; mt < 8; ++mt) S[mt] = MFMA16(ldfragp(KT, 16 * mt + fr, 72, 32 * ks, fq), vf, S[mt]);
        }
#pragma unroll
        for (int mt = 0; mt < 4; ++mt)
#pragma unroll
            for (int j = 0; j < 4; ++j) {
                float p = o[mt][j] * o[mt][j];
                p += __shfl_xor(p, 1); p += __shfl_xor(p, 2); p += __shfl_xor(p, 4); p += __shfl_xor(p, 8);
                if (fr == 0) RED[(16 * mt + 4 * fq + j) * 8 + w] = p;
            }
        __syncthreads();
#pragma unroll
        for (int mt = 0; mt < 4; ++mt)
#pragma unroll
            for (int j = 0; j < 4; ++j) {
                const int row = 16 * mt + 4 * fq + j;
                const f32x4 r0 = *(const f32x4*)(RED + row * 8), r1 = *(const f32x4*)(RED + row * 8 + 4);
                const float ssum = ((r0[0] + r0[1]) + (r0[2] + r0[3])) + ((r1[0] + r1[1]) + (r1[2] + r1[3]));
                const float rs = rsqrtf(ssum * (1.f / 128.f) + 1e-6f);
                bf16_t* zp = ((bf16_t*)(F.ws + WS_P)) + (size_t)(t0 + row) * LDP + C_ZA + dvc;
                const float z = bf2f(*zp);
                if (!F.dry) *zp = (bf16_t)(pk2(o[mt][j] * rs * gn * silu(z), 0.f) & 0xffff);
            }
    }
    float* so = sample ? F.out + O_GDN_S + ((size_t)((l * 8 + (s - 16)) * 4 + h) * 128) * 128 : F.out + O_GDN_P + ((size_t)((l * 16 + s) * 4 + h) * 128) * 128;
#pragma unroll
    for (int mt = 0; mt < 8; ++mt)
#pragma unroll
        for (int j = 0; j < 4; ++j) if (!F.dry) so[(size_t)(16 * mt + 4 * fq + j) * 128 + 16 * w + fr] = S[mt][j];
}

DEV void g2_gla(const Frame& F0, int l, int s, int h) {
    REFRAME;
    bf16_t* QG = (bf16_t*)F.lds;
    bf16_t* KGT = (bf16_t*)(F.lds + 9216);
    bf16_t* AQ = (bf16_t*)(F.lds + 18432);
    float* sDL = (float*)(F.lds + 27648);
    float* RED = (float*)(F.lds + 27904);
    const int tid = F.tid, lane = F.lane, w = F.wid, fr = lane & 15, fq = lane >> 4;
    const bool sample = s >= 16; const int nchunk = sample ? 1 : 32; const int tbase = sample ? 32768 + (s - 16) * 64 : s * 2048;
    const int dvc = h * 128 + 16 * w + fr;
    f32x4 S[4];
#pragma unroll
    for (int mt = 0; mt < 4; ++mt) {
        if (sample) { const float* sp = F.in[4] + ((size_t)((l * 8 + (s - 16)) * 4 + h) * 64) * 128;
#pragma unroll
            for (int j = 0; j < 4; ++j) S[mt][j] = sp[(size_t)(16 * mt + 4 * fq + j) * 128 + 16 * w + fr]; }
        else S[mt] = (f32x4){0.f, 0.f, 0.f, 0.f};
    }
    const float gn = F.in[17][l * 128 + 16 * w + fr];
    for (int n = 0; n < nchunk; ++n) {
        const int t0 = tbase + n * 64, chunk = t0 >> 6;
        __syncthreads();
        {
            const int r = tid >> 3, c8 = (tid & 7) * 8;
            *(u32x4*)(QG + r * 72 + c8) = *(const u32x4*)(((bf16_t*)(F.ws + WS_P)) + (size_t)(t0 + r) * LDP + C_QB + h * 64 + c8);
            const u32x4 k = *(const u32x4*)(((bf16_t*)(F.ws + WS_P)) + (size_t)(t0 + r) * LDP + C_KB + h * 64 + c8);
            KGT[(c8 + 0) * 72 + r] = (bf16_t)(k.x & 0xffff); KGT[(c8 + 1) * 72 + r] = (bf16_t)(k.x >> 16);
            KGT[(c8 + 2) * 72 + r] = (bf16_t)(k.y & 0xffff); KGT[(c8 + 3) * 72 + r] = (bf16_t)(k.y >> 16);
            KGT[(c8 + 4) * 72 + r] = (bf16_t)(k.z & 0xffff); KGT[(c8 + 5) * 72 + r] = (bf16_t)(k.z >> 16);
            KGT[(c8 + 6) * 72 + r] = (bf16_t)(k.w & 0xffff); KGT[(c8 + 7) * 72 + r] = (bf16_t)(k.w >> 16);
            *(u32x4*)(AQ + r * 72 + c8) = *(const u32x4*)(((bf16_t*)(F.ws + WS_XB)) + (size_t)(t0 + r) * LDE + 512 + h * 64 + c8);
        }
        if (tid < 64) sDL[tid] = ((float*)(F.ws + WS_DL))[((size_t)chunk * 4 + h) * 64 + tid];
        bf16x8 vf[2];
#pragma unroll
        for (int ks = 0; ks < 2; ++ks) {
            unsigned e[8];
#pragma unroll
            for (int j = 0; j < 8; ++j) { const int row = 32 * ks + (j < 4 ? 4 * fq + j : 16 + 4 * fq + (j - 4)); e[j] = ((bf16_t*)(F.ws + WS_P))[(size_t)(t0 + row) * LDP + C_VB + dvc]; }
            u32x4 t; t.x = e[0] | (e[1] << 16); t.y = e[2] | (e[3] << 16); t.z = e[4] | (e[5] << 16); t.w = e[6] | (e[7] << 16);
            vf[ks] = __builtin_bit_cast(bf16x8, t);
        }
        __syncthreads();
        f32x4 o[4];
#pragma unroll
        for (int mt = 0; mt < 4; ++mt) o[mt] = (f32x4){0.f, 0.f, 0.f, 0.f};
#pragma unroll
        for (int ks = 0; ks < 2; ++ks) {
            const bf16x8 sf = mk8(pk4(S[2 * ks]), pk4(S[2 * ks + 1]));
#pragma unroll
            for (int mt = 0; mt < 4; ++mt) {
                o[mt] = MFMA16(ldfragp(QG, 16 * mt + fr, 72, 32 * ks, fq), sf, o[mt]);
                o[mt] = MFMA16(ldfragp(AQ, 16 * mt + fr, 72, 32 * ks, fq), vf[ks], o[mt]);
            }
        }
#pragma unroll
        for (int mt = 0; mt < 4; ++mt) {
#pragma unroll
            for (int j = 0; j < 4; ++j) S[mt][j] *= sDL[16 * mt + 4 * fq + j];
#pragma unroll
            for (int ks = 0; ks < 2; ++ks) S[mt] = MFMA16(ldfragp(KGT, 16 * mt + fr, 72, 32 * ks, fq), vf[ks], S[mt]);
        }
#pragma unroll
        for (int mt = 0; mt < 4; ++mt)
#pragma unroll
            for (int j = 0; j < 4; ++j) {
                float p = o[mt][j] * o[mt][j];
                p += __shfl_xor(p, 1); p += __shfl_xor(p, 2); p += __shfl_xor(p, 4); p += __shfl_xor(p, 8);
                if (fr == 0) RED[(16 * mt + 4 * fq + j) * 8 + w] = p;
            }
        __syncthreads();
#pragma unroll
        for (int mt = 0; mt < 4; ++mt)
#pragma unroll
            for (int j = 0; j < 4; ++j) {
                const int row = 16 * mt + 4 * fq + j;
                const f32x4 r0 = *(const f32x4*)(RED + row * 8), r1 = *(const f32x4*)(RED + row * 8 + 4);
                const float ssum = ((r0[0] + r0[1]) + (r0[2] + r0[3])) + ((r1[0] + r1[1]) + (r1[2] + r1[3]));
                const float rs = rsqrtf(ssum * (1.f / 128.f) + 1e-6f);
                bf16_t* zp = ((bf16_t*)(F.ws + WS_P)) + (size_t)(t0 + row) * LDP + C_ZB + dvc;
                const float z = bf2f(*zp);
                if (!F.dry) *zp = (bf16_t)(pk2(o[mt][j] * rs * gn * silu(z), 0.f) & 0xffff);
            }
    }
    float* so = sample ? F.out + O_GLA_S + ((size_t)((l * 8 + (s - 16)) * 4 + h) * 64) * 128 : F.out + O_GLA_P + ((size_t)((l * 16 + s) * 4 + h) * 64) * 128;
#pragma unroll
    for (int mt = 0; mt < 4; ++mt)
#pragma unroll
        for (int j = 0; j < 4; ++j) if (!F.dry) so[(size_t)(16 * mt + 4 * fq + j) * 128 + 16 * w + fr] = S[mt][j];
}

DEV void unpack8(u32x4 u, float (&f)[8]) { f[0] = bflo(u.x); f[1] = bfhi(u.x); f[2] = bflo(u.y); f[3] = bfhi(u.y); f[4] = bflo(u.z); f[5] = bfhi(u.z); f[6] = bflo(u.w); f[7] = bfhi(u.w); }
DEV void load8f(const float* p, float (&f)[8]) { const f32x4 a = *(const f32x4*)p, b = *(const f32x4*)(p + 4); f[0] = a[0]; f[1] = a[1]; f[2] = a[2]; f[3] = a[3]; f[4] = b[0]; f[5] = b[1]; f[6] = b[2]; f[7] = b[3]; }
DEV void ffn_mid(const Frame& F0, int l) {
    REFRAME;
    const float* cw = F.in[29] + (size_t)l * 3 * 5632; const float* cb = F.in[30] + (size_t)l * 5632;
    const int total = NCH * 352;
    for (int idx = F.bid * 512 + F.tid; idx < total; idx += F.nb * 512) {
        const int c = idx / 352, col = (idx % 352) * 8;
        const bool first = c >= 512 || (c & 31) == 0, sample = c >= 512;
        float g2[8], g1[8], v2[8], v1[8];
#pragma unroll
        for (int j = 0; j < 8; ++j) { g2[j] = 0.f; g1[j] = 0.f; v2[j] = 0.f; v1[j] = 0.f; }
        if (!first) {
            const bf16_t* hp = ((bf16_t*)(F.ws + WS_KV)) + (size_t)(c - 1) * 2 * 5632;
            unpack8(*(const u32x4*)(hp + col), g2); unpack8(*(const u32x4*)(hp + 5632 + col), g1);
            unpack8(*(const u32x4*)(hp + 2816 + col), v2); unpack8(*(const u32x4*)(hp + 5632 + 2816 + col), v1);
        } else if (sample) {
            const float* sp = F.in[5] + (size_t)(l * 8 + (c - 512)) * 2 * 5632;
            load8f(sp + col, g2); load8f(sp + 5632 + col, g1); load8f(sp + 2816 + col, v2); load8f(sp + 5632 + 2816 + col, v1);
        }
        float wg0[8], wg1[8], wg2[8], bg[8], wv0[8], wv1[8], wv2[8], bv[8];
        load8f(cw + col, wg0); load8f(cw + 5632 + col, wg1); load8f(cw + 2 * 5632 + col, wg2); load8f(cb + col, bg);
        load8f(cw + 2816 + col, wv0); load8f(cw + 5632 + 2816 + col, wv1); load8f(cw + 2 * 5632 + 2816 + col, wv2); load8f(cb + 2816 + col, bv);
        bf16_t* up = ((bf16_t*)(F.ws + WS_P)) + (size_t)c * 64 * LDP + col;
#pragma unroll 4
        for (int r = 0; r < 64; ++r) {
            float g0[8], v0[8], o[8];
            unpack8(*(const u32x4*)(up + (size_t)r * LDP), g0); unpack8(*(const u32x4*)(up + (size_t)r * LDP + 2816), v0);
#pragma unroll
            for (int j = 0; j < 8; ++j) {
                const float yg = wg0[j] * g2[j] + wg1[j] * g1[j] + wg2[j] * g0[j] + bg[j];
                const float yv = wv0[j] * v2[j] + wv1[j] * v1[j] + wv2[j] * v0[j] + bv[j];
                o[j] = silu(yg) * yv;
                g2[j] = g1[j]; g1[j] = g0[j]; v2[j] = v1[j]; v1[j] = v0[j];
            }
            u32x4 w; w.x = pk2(o[0], o[1]); w.y = pk2(o[2], o[3]); w.z = pk2(o[4], o[5]); w.w = pk2(o[6], o[7]);
            if (!F.dry) *(u32x4*)(up + (size_t)r * LDP) = w;
        }
    }
}

DEV void final_norm(const Frame& F0) {
    REFRAME;
    const int gw = F.bid * 8 + F.wid, nw = F.nb * 8, lane = F.lane;
    const float* g = F.in[32];
    for (int row = gw; row < TT; row += nw) {
        const float rs = row_rstd(((float*)(F.ws + WS_SSQ)), row);
        float* X = F.out + (size_t)row * 1024;
#pragma unroll
        for (int i = 0; i < 4; ++i) { const int cidx = i * 256 + lane * 4; f32x4 v = *(const f32x4*)(X + cidx); const f32x4 gg = *(const f32x4*)(g + cidx); *(f32x4*)(X + cidx) = v * rs * gg; }
    }
}

#ifdef DBG_COL
DEV void dbg_dump(const Frame& F0) {
    REFRAME;
    for (int i = F.bid * 512 + F.tid; i < TT * 256; i += F.nb * 512) {
        const int row = i >> 8, c = (i & 255) * 4;
        const f32x4 v = c < 512 ? unpk4(*(const u32x2*)(((bf16_t*)(F.ws + WS_P)) + (size_t)row * LDP + DBG_COL + c)) : (f32x4){0.f, 0.f, 0.f, 0.f};
        *(f32x4*)(F.out + (size_t)row * 1024 + c) = (row DBG_ROWSEL) ? v : (f32x4){0.f, 0.f, 0.f, 0.f};
    }
}
#endif
__global__ void __launch_bounds__(512, 2) fwd_kernel(Params p) {
    extern __shared__ __attribute__((aligned(16))) unsigned char lds[];
    cg::grid_group grid = cg::this_grid();
    Frame F;
    F.in = (InTab)__builtin_amdgcn_kernarg_segment_ptr(); F.out = p.out; F.ws = p.ws; F.lds = lds;
    F.tid = threadIdx.x; F.lane = threadIdx.x & 63; F.wid = __builtin_amdgcn_readfirstlane(threadIdx.x >> 6); F.nb = gridDim.x; F.bid = blockIdx.x; F.dry = 0;
    for (int ph = p.ph_lo; ph < p.ph_hi; ++ph) {
#ifndef PHM
#define PHM 0xffff
#endif
        if (ph == 0) { if (PHM & 0x1000) phase0(F); }
        else if (ph == NPH - 1) { if (PHM & 0x2000) final_norm(F); }
        else {
            const int l = (ph - 1) / 13, k = (ph - 1) % 13;
            int gk = -1;
            switch (k) { case 0: gk = GP_IN; break; case 3: gk = GP_OUT; break; case 4: gk = GP_OUT2; break; case 5: gk = GP_WO; break; case 6: gk = GP_MQ; break; case 7: gk = GP_ATTN; break; case 8: gk = GP_ATTN2; break;
                         case 9: gk = GP_MO; break; case 10: gk = GP_UP; break; case 12: gk = GP_DOWN; break; default: break; }
#ifndef REPMASK
#define REPMASK 0
#endif
            if (gk >= 0 && (PHM & 1)) { const int nrep = ((REPMASK >> k) & 1) ? 2 : 1; for (int rep = 0; rep < nrep; ++rep) gemm_phase(F, gk, l); }
            if (k == 0 && (PHM & 1)) small_proj(F);
            if (k == 3 && (PHM & 8)) sample_kv(F, l);
#ifndef DRYMASK
#define DRYMASK 0
#endif
            for (int dr = ((DRYMASK >> k) & 1); dr >= 0; --dr) {
            F.dry = dr;
            if (k == 1 && (PHM & 2)) {
                for (int it = F.bid; it < NCH * 8; it += F.nb) { const int c = it >> 3, h = it & 3; if (it & 4) g1_gla(F, l, c, h); else g1_gdn(F, l, c, h); }
                __syncthreads();
                if (l > 0 && !dr) cvt_ffn(F, l);
            }
            if (k == 2 && (PHM & 4)) {
                for (int it = F.bid; it < 192; it += F.nb) {
                    int s, h, br;
                    if (it < 128) { br = it & 1; h = (it >> 1) & 3; s = it >> 3; } else { const int v = it - 128; br = v & 1; h = (v >> 1) & 3; s = 16 + (v >> 3); }
                    if (br) g2_gla(F, l, s, h); else g2_gdn(F, l, s, h);
                    __syncthreads();
                }
            }
            if (k == 11 && (PHM & 0x200)) { ffn_mid(F, l); if (l < 3 && !dr) { __syncthreads(); cvt_mixer(F, l + 1); } }
            }
            F.dry = 0;
        }
#ifndef SYNCREP
#define SYNCREP 1
#endif
        if (ph + 1 < p.ph_hi) { for (int sr = 0; sr < SYNCREP; ++sr) { grid.sync(); } }
    }
#ifdef DBG_COL
    __threadfence(); grid.sync(); __threadfence();
    dbg_dump(F);
#endif
}

extern "C" void kernel_launch(void* const* d_in, const int* in_sizes, int n_in, void* d_out, int out_size, void* d_ws, size_t ws_size, hipStream_t stream) {
    static int grid_blocks = 0;
    if (grid_blocks == 0) {
        if (n_in != 33 || ws_size < WS_TOTAL) { fprintf(stderr, "kernel_launch: bad n_in %d or ws %zu < %zu\n", n_in, ws_size, (size_t)WS_TOTAL); grid_blocks = -1; return; }
        int dev = 0, cus = 0, per_cu = 0;
        hipGetDevice(&dev);
        hipDeviceGetAttribute(&cus, hipDeviceAttributeMultiprocessorCount, dev);
        if (hipFuncSetAttribute((const void*)fwd_kernel, hipFuncAttributeMaxDynamicSharedMemorySize, LDS_BYTES) != hipSuccess) { fprintf(stderr, "hipFuncSetAttribute failed\n"); grid_blocks = -1; return; }
        hipOccupancyMaxActiveBlocksPerMultiprocessor(&per_cu, (const void*)fwd_kernel, 512, LDS_BYTES);
        if (per_cu < 1) per_cu = 1;
        (void)hipGetLastError();
        grid_blocks = cus * 1;
        if (grid_blocks <= 0) grid_blocks = 256;
    }
    if (grid_blocks < 0) return;
    Params p{};
    for (int i = 0; i < 33; ++i) p.in[i] = (const float*)d_in[i];
    p.out = (float*)d_out; p.ws = (unsigned char*)d_ws; p.ph_lo = 0; p.ph_hi = PH_HI;
    void* args[] = {&p};
    hipError_t e = hipLaunchCooperativeKernel((const void*)fwd_kernel, dim3(grid_blocks), dim3(512), args, LDS_BYTES, stream);
    if (e != hipSuccess) fprintf(stderr, "cooperative launch failed: %s (grid %d)\n", hipGetErrorString(e), grid_blocks);
}
```

```cpp
#include <hip/hip_runtime.h>
#include <hip/hip_cooperative_groups.h>
#include <cstdint>
#include <cstdio>
namespace cg = cooperative_groups;

typedef unsigned short bf16_t;
typedef short bf16x8 __attribute__((ext_vector_type(8)));
typedef float f32x4 __attribute__((ext_vector_type(4)));
typedef float f32x2 __attribute__((ext_vector_type(2)));
typedef unsigned u32x2 __attribute__((ext_vector_type(2)));
typedef unsigned u32x4 __attribute__((ext_vector_type(4)));
#define DEV __device__ __forceinline__

constexpr int DM = 1024, TT = 33280, NCH = 520, LDP = 5632, LDE = 768;
constexpr int C_QA = 0, C_KA = 512, C_VA = 1024, C_ZA = 1536, C_QB = 2048, C_KB = 2304, C_VB = 2560, C_ZB = 3072, C_GA = 3584, C_GB = 4608;
constexpr int C_MRG = 0, C_PR = 1024, C_Q = 2048, C_O = 3072;
constexpr size_t O_Y = 0;
constexpr size_t O_GDN_P = 34078720ull;
constexpr size_t O_GDNC_P = O_GDN_P + 4194304ull;
constexpr size_t O_GLA_P = O_GDNC_P + 294912ull;
constexpr size_t O_FFNC_P = O_GLA_P + 2097152ull;
constexpr size_t O_MEMK = O_FFNC_P + 720896ull;
constexpr size_t O_MEMV = O_MEMK + 16777216ull;
constexpr size_t O_GDN_S = O_MEMV + 16777216ull;
constexpr size_t O_GDNC_S = O_GDN_S + 2097152ull;
constexpr size_t O_GLA_S = O_GDNC_S + 147456ull;
constexpr size_t O_FFNC_S = O_GLA_S + 1048576ull;
constexpr size_t al256(size_t x) { return (x + 255) & ~(size_t)255; }
constexpr size_t WS_WMIX = 0;
constexpr size_t WM_WIN = 0, WM_WSM = WM_WIN + 5632ull * 1024, WM_WOA = WM_WSM + 32 * 1024, WM_WOB = WM_WOA + 524288, WM_WO = WM_WOB + 524288,
                 WM_WMQ = WM_WO + 1048576, WM_WMK = WM_WMQ + 1048576, WM_WMV = WM_WMK + 1048576, WM_WMO = WM_WMV + 1048576, WM_END = WM_WMO + 1048576;
constexpr size_t WS_WFFN = al256(WS_WMIX + WM_END * 2);
constexpr size_t WF_UP = 0, WF_DN = 5632ull * 1024, WF_END = WF_DN + 1024ull * 2816;
constexpr size_t WS_XB = al256(WS_WFFN + WF_END * 2);
constexpr size_t WS_P = al256(WS_XB + (size_t)TT * 1024 * 2);
constexpr size_t WS_KV = al256(WS_P + (size_t)TT * LDP * 2);
constexpr size_t KV_BYTES = 2ull * 6144 * 1024 * 2;
constexpr size_t WS_MB = al256(WS_KV + KV_BYTES);
constexpr size_t WS_MRS = al256(WS_MB + 4096ull * 1024 * 2);
constexpr size_t WS_SSQ = al256(WS_MRS + 4096 * 4);
constexpr size_t WS_SC = al256(WS_SSQ + (size_t)TT * 16 * 4);
constexpr size_t WS_DL = al256(WS_SC + (size_t)TT * 32 * 4);
constexpr size_t WS_BG = al256(WS_DL + 520ull * 4 * 64 * 4);
constexpr size_t WS_BAR = al256(WS_BG + 520ull * 4 * 128 * 4);
constexpr size_t WS_TOTAL = al256(WS_BAR + 4096);
constexpr int LDS_BYTES = 147456;
constexpr int NPH = 54;
#ifndef PH_HI
#define PH_HI NPH
#define REPMASK 0
#define SYNCREP 1
#define DRYMASK 0
#endif

struct Params { const float* in[33]; float* out; unsigned char* ws; int ph_lo, ph_hi; };

typedef __bf16 bf16x2_t __attribute__((ext_vector_type(2)));
DEV unsigned pk2(float lo, float hi) { f32x2 f = {lo, hi}; bf16x2_t v = __builtin_convertvector(f, bf16x2_t); return __builtin_bit_cast(unsigned, v); }
DEV float bf2f(bf16_t b) { return __uint_as_float(((unsigned)b) << 16); }
DEV float bflo(unsigned u) { return __uint_as_float(u << 16); }
DEV float bfhi(unsigned u) { return __uint_as_float(u & 0xffff0000u); }
DEV u32x2 pk4(f32x4 v) { u32x2 r; r.x = pk2(v[0], v[1]); r.y = pk2(v[2], v[3]); return r; }
DEV f32x4 unpk4(u32x2 u) { return (f32x4){bflo(u.x), bfhi(u.x), bflo(u.y), bfhi(u.y)}; }
DEV bf16x8 mk8(u32x2 a, u32x2 b) { u32x4 t = {a.x, a.y, b.x, b.y}; return __builtin_bit_cast(bf16x8, t); }
DEV float sigm(float x) { return 1.f / (1.f + __expf(-x)); }
DEV float silu(float x) { return x / (1.f + __expf(-x)); }
DEV float softplus(float x) { return x > 20.f ? x : __logf(1.f + __expf(x)); }
DEV float logsigmoid(float x) { return fminf(x, 0.f) - __logf(1.f + __expf(-fabsf(x))); }
DEV float row_rstd(const float* ssq, int row) {
    const f32x4 a = *(const f32x4*)(ssq + (size_t)row * 4), b = *(const f32x4*)(ssq + ((size_t)TT + row) * 4);
    const f32x4 c = *(const f32x4*)(ssq + ((size_t)2 * TT + row) * 4), d = *(const f32x4*)(ssq + ((size_t)3 * TT + row) * 4);
    float s = ((a[0] + a[1]) + (a[2] + a[3])) + ((b[0] + b[1]) + (b[2] + b[3])) + ((c[0] + c[1]) + (c[2] + c[3])) + ((d[0] + d[1]) + (d[2] + d[3]));
    return rsqrtf(s * (1.f / 1024.f) + 1e-6f);
}
DEV bf16x8 ldfragp(const bf16_t* base, int row, int stride, int k0, int fq) {
    const bf16_t* p = base + row * stride + k0 + 4 * fq;
    return mk8(*(const u32x2*)p, *(const u32x2*)(p + 16));
}
DEV bf16x8 ldfrag(const bf16_t* base, int row, int stride, int k0, int fq) {
    return *(const bf16x8*)(base + row * stride + k0 + 8 * fq);
}
#define MFMA16(a, b, c) __builtin_amdgcn_mfma_f32_16x16x32_bf16((a), (b), (c), 0, 0, 0)

constexpr int BM = 256, BK = 64, HALF = 128, HT = HALF * BK;
DEV int lds_byte(int r, int c) { int st = (r >> 4) * 2 + (c >> 5), rr = r & 15, cc = c & 31, ob = rr * 64 + cc * 2; return st * 1024 + (ob ^ (((ob >> 9) & 1) << 5)); }
DEV void stage_rc(int b, int& R, int& C) { int st = b / 1024, sb = b % 1024, swz = sb ^ (((sb >> 9) & 1) << 5); R = (st >> 1) * 16 + swz / 64; C = (st & 1) * 32 + (swz % 64) / 2; }

DEV void gemm_core(const bf16_t* __restrict__ A, int lda, const bf16_t* __restrict__ Bt, int ldb, int K, int brow, int bcol, f32x4 (&acc)[2][2][4][2], bf16_t* shm) {
#define SA(b, h) (shm + ((b) * 2 + (h)) * HT)
#define SB(b, h) (shm + (4 + (b) * 2 + (h)) * HT)
#define STAGE(P, BASE, LD, br, kt) do { const char* _gb = (const char*)((BASE) + (long)(br) * (LD) + (long)(kt) * BK); \
    const unsigned _vo = (unsigned)((sr0 * (int)(LD) + sc0) * 2); \
    for (int _i = 0; _i < 2; ++_i) { \
      __builtin_amdgcn_global_load_lds((const unsigned*)(_gb + (long)(_i * 128) * (LD) + _vo), (unsigned*)((char*)(P) + wbase + _i * 8192), 16, 0, 0); } } while (0)
#define LDA(dst, b, h) for (int m = 0; m < 4; ++m) for (int k = 0; k < 2; ++k) \
    dst[m][k] = *reinterpret_cast<const bf16x8*>((char*)SA(b, h) + lds_byte(wr * 64 + m * 16 + fr, k * 32 + fq * 8))
#define LDB(dst, b, h) for (int n = 0; n < 2; ++n) for (int k = 0; k < 2; ++k) \
    dst[n][k] = *reinterpret_cast<const bf16x8*>((char*)SB(b, h) + lds_byte(wc * 32 + n * 16 + fr, k * 32 + fq * 8))
#define MMA(ai, bj, At_, Bt_) do { __builtin_amdgcn_s_setprio(1); \
    for (int m = 0; m < 4; ++m) for (int n = 0; n < 2; ++n) for (int k = 0; k < 2; ++k) \
      acc[ai][bj][m][n] = __builtin_amdgcn_mfma_f32_16x16x32_bf16(Bt_[n][k], At_[m][k], acc[ai][bj][m][n], 0, 0, 0); \
    __builtin_amdgcn_s_setprio(0); } while (0)
#define WAIT_V(n) asm volatile("s_waitcnt vmcnt(" #n ")" ::: "memory")
#define WAIT_L(n) asm volatile("s_waitcnt lgkmcnt(" #n ")" ::: "memory")
#define BAR __builtin_amdgcn_s_barrier()
#define SCHED __builtin_amdgcn_sched_barrier(0)
    int tidx = threadIdx.x; asm volatile("" : "+v"(tidx));
    const int wid = __builtin_amdgcn_readfirstlane(tidx >> 6), lane = tidx & 63, wr = wid >> 2, wc = wid & 3, fr = lane & 15, fq = lane >> 4;
    const int wbase = wid * 1024;
    int sr0, sc0; stage_rc(tidx * 16, sr0, sc0);
#pragma unroll
    for (int a = 0; a < 2; ++a)
#pragma unroll
        for (int b = 0; b < 2; ++b)
#pragma unroll
            for (int m = 0; m < 4; ++m)
#pragma unroll
                for (int n = 0; n < 2; ++n) acc[a][b][m][n] = (f32x4){0.f, 0.f, 0.f, 0.f};
    bf16x8 At[4][2], B0[2][2], B1[2][2];
    const int nt = K / BK;
    STAGE(SB(0, 0), Bt, ldb, bcol, 0); STAGE(SA(0, 0), A, lda, brow, 0);
    STAGE(SB(0, 1), Bt, ldb, bcol + HALF, 0); STAGE(SA(0, 1), A, lda, brow + HALF, 0);
    if (wr == 1) BAR;
    WAIT_V(4); BAR;
    STAGE(SB(1, 0), Bt, ldb, bcol, 1); STAGE(SA(1, 0), A, lda, brow, 1); STAGE(SB(1, 1), Bt, ldb, bcol + HALF, 1);
    WAIT_V(6); BAR;
    for (int t = 0; t < nt - 2; t += 2) {
        LDB(B0, 0, 0); SCHED; LDA(At, 0, 0); STAGE(SA(1, 1), A, lda, brow + HALF, t + 1);
        WAIT_L(8); BAR; WAIT_L(0); MMA(0, 0, At, B0); BAR; SCHED;
        LDB(B1, 0, 1); STAGE(SB(0, 0), Bt, ldb, bcol, t + 2);
        BAR; WAIT_L(0); MMA(0, 1, At, B1); BAR;
        LDA(At, 0, 1); STAGE(SA(0, 0), A, lda, brow, t + 2);
        BAR; WAIT_L(0); MMA(1, 0, At, B0); BAR; SCHED;
        STAGE(SB(0, 1), Bt, ldb, bcol + HALF, t + 2);
        WAIT_V(6); BAR; MMA(1, 1, At, B1); BAR;
        LDB(B0, 1, 0); SCHED; LDA(At, 1, 0); STAGE(SA(0, 1), A, lda, brow + HALF, t + 2);
        WAIT_L(8); BAR; WAIT_L(0); MMA(0, 0, At, B0); BAR; SCHED;
        LDB(B1, 1, 1); STAGE(SB(1, 0), Bt, ldb, bcol, t + 3);
        BAR; WAIT_L(0); MMA(0, 1, At, B1); BAR;
        LDA(At, 1, 1); STAGE(SA(1, 0), A, lda, brow, t + 3);
        BAR; WAIT_L(0); MMA(1, 0, At, B0); BAR; SCHED;
        STAGE(SB(1, 1), Bt, ldb, bcol + HALF, t + 3);
        WAIT_V(6); BAR; MMA(1, 1, At, B1); BAR;
    }
    { LDB(B0, 0, 0); LDA(At, 0, 0); STAGE(SA(1, 1), A, lda, brow + HALF, nt - 1);
      BAR; WAIT_L(0); MMA(0, 0, At, B0); BAR;
      LDB(B1, 0, 1); BAR; WAIT_L(0); MMA(0, 1, At, B1); BAR;
      LDA(At, 0, 1); WAIT_V(4); BAR; WAIT_L(0); MMA(1, 0, At, B0); MMA(1, 1, At, B1); BAR; }
    { LDB(B0, 1, 0); LDA(At, 1, 0); WAIT_V(2); BAR; WAIT_L(0); MMA(0, 0, At, B0); BAR;
      LDB(B1, 1, 1); WAIT_V(0); BAR; WAIT_L(0); MMA(0, 1, At, B1); BAR;
      LDA(At, 1, 1); BAR; WAIT_L(0); MMA(1, 0, At, B0); MMA(1, 1, At, B1); BAR; }
    if (wr == 0) BAR;
#undef SA
#undef SB
}

typedef const float* const __attribute__((address_space(4)))* InTab;
struct Frame {
    InTab in; float* out; unsigned char* ws; unsigned char* lds;
    int tid, lane, wid, nb, bid, dry;
};
#define REFRAME Frame F = F0; { int t_ = threadIdx.x; asm volatile("" : "+v"(t_)); F.tid = t_; F.lane = t_ & 63; unsigned char* w_ = F.ws; asm volatile("" : "+s"(w_)); F.ws = w_; float* o_ = F.out; asm volatile("" : "+s"(o_)); F.out = o_; InTab i_ = (InTab)__builtin_amdgcn_kernarg_segment_ptr(); asm volatile("" : "+s"(i_)); F.in = i_; int a_ = F.wid, b_ = F.bid, c_ = F.nb; asm volatile("" : "+s"(a_), "+s"(b_), "+s"(c_)); F.wid = a_; F.bid = b_; F.nb = c_; }

enum { EPI_PROJ = 0, EPI_UP, EPI_RESID, EPI_Q, EPI_MEMK, EPI_MEMV, EPI_OUTA, EPI_OUTB, EPI_SOFTMAX, EPI_ATTNO };
struct GDesc { const bf16_t* A; int lda; const bf16_t* Bt; int ldb; int K, brow, bcol, epi, orow, ocol, head, vai, vwr; };

DEV void cvt_mat(const Frame& F0, const float* src, int ldsrc, int K, int N, int wincols, const float* gain, bf16_t* dst) {
    REFRAME;
    float* T = (float*)F.lds;
    const int nkt = K / 64, nnt = N / 64, ntile = nkt * nnt;
    for (int t = F.bid; t < ntile; t += F.nb) {
        const int kt = t / nnt, ntl = t % nnt, k0 = kt * 64, n0 = ntl * 64;
        int coff = 0; if (wincols) coff = (n0 < 1536) ? 0 : (n0 < 3072 ? 8 : 24);
        __syncthreads();
#pragma unroll
        for (int i = 0; i < 2; ++i) {
            const int kr = (F.tid >> 4) + 32 * i, nc = (F.tid & 15) * 4;
            f32x4 v = *(const f32x4*)(src + (size_t)(k0 + kr) * ldsrc + n0 + coff + nc);
            const float g = gain ? gain[k0 + kr] : 1.f;
            T[kr * 65 + nc + 0] = v[0] * g; T[kr * 65 + nc + 1] = v[1] * g; T[kr * 65 + nc + 2] = v[2] * g; T[kr * 65 + nc + 3] = v[3] * g;
        }
        __syncthreads();
        const int n = F.tid >> 3, kc = (F.tid & 7) * 8;
        u32x4 w;
        w.x = pk2(T[(kc + 0) * 65 + n], T[(kc + 1) * 65 + n]); w.y = pk2(T[(kc + 2) * 65 + n], T[(kc + 3) * 65 + n]);
        w.z = pk2(T[(kc + 4) * 65 + n], T[(kc + 5) * 65 + n]); w.w = pk2(T[(kc + 6) * 65 + n], T[(kc + 7) * 65 + n]);
        *(u32x4*)(dst + (size_t)(n0 + n) * K + k0 + kc) = w;
    }
    __syncthreads();
}
DEV void cvt_mixer(const Frame& F0, int l) {
    REFRAME;
    InTab in = F.in;
    cvt_mat(F, in[10] + (size_t)l * 1024 * 5656, 5656, 1024, 5632, 1, in[9] + l * 1024, ((bf16_t*)(F.ws + WS_WMIX)) + WM_WIN);
    cvt_mat(F, in[18] + (size_t)l * 512 * 1024, 1024, 512, 1024, 0, nullptr, ((bf16_t*)(F.ws + WS_WMIX)) + WM_WOA);
    cvt_mat(F, in[19] + (size_t)l * 512 * 1024, 1024, 512, 1024, 0, nullptr, ((bf16_t*)(F.ws + WS_WMIX)) + WM_WOB);
    cvt_mat(F, in[20] + (size_t)l * 1048576, 1024, 1024, 1024, 0, nullptr, ((bf16_t*)(F.ws + WS_WMIX)) + WM_WO);
    cvt_mat(F, in[23] + (size_t)l * 1048576, 1024, 1024, 1024, 0, in[21] + l * 1024, ((bf16_t*)(F.ws + WS_WMIX)) + WM_WMQ);
    cvt_mat(F, in[24] + (size_t)l * 1048576, 1024, 1024, 1024, 0, in[22] + l * 1024, ((bf16_t*)(F.ws + WS_WMIX)) + WM_WMK);
    cvt_mat(F, in[25] + (size_t)l * 1048576, 1024, 1024, 1024, 0, in[22] + l * 1024, ((bf16_t*)(F.ws + WS_WMIX)) + WM_WMV);
    cvt_mat(F, in[26] + (size_t)l * 1048576, 1024, 1024, 1024, 0, nullptr, ((bf16_t*)(F.ws + WS_WMIX)) + WM_WMO);
    const float* win = in[10] + (size_t)l * 1024 * 5656; const float* g = in[9] + l * 1024;
    for (int i = F.bid * 512 + F.tid; i < 32 * 1024; i += F.nb * 512) {
        const int n = i >> 10, k = i & 1023;
        float v = 0.f;
        if (n < 8) v = win[(size_t)k * 5656 + 1536 + n] * g[k]; else if (n < 24) v = win[(size_t)k * 5656 + 3080 + (n - 8)] * g[k];
        ((bf16_t*)(F.ws + WS_WMIX))[WM_WSM + i] = (bf16_t)(pk2(v, 0.f) & 0xffff);
    }
}
DEV void cvt_ffn(const Frame& F, int l) {
    cvt_mat(F, F.in[28] + (size_t)l * 1024 * 5632, 5632, 1024, 5632, 0, F.in[27] + l * 1024, ((bf16_t*)(F.ws + WS_WFFN)) + WF_UP);
    cvt_mat(F, F.in[31] + (size_t)l * 2816 * 1024, 1024, 2816, 1024, 0, nullptr, ((bf16_t*)(F.ws + WS_WFFN)) + WF_DN);
}

DEV void phase0(const Frame& F0) {
    REFRAME;
    const int gw = F.bid * 8 + F.wid, nw = F.nb * 8, lane = F.lane;
    for (int row = gw; row < TT + 4096; row += nw) {
        const bool ismem = row >= TT;
        const float* src = ismem ? F.in[8] + (size_t)(row - TT) * 1024 : (row < 32768 ? F.in[0] + (size_t)row * 1024 : F.in[1] + (size_t)(row - 32768) * 1024);
        f32x4 v[4]; float s = 0.f;
#pragma unroll
        for (int i = 0; i < 4; ++i) { v[i] = *(const f32x4*)(src + lane * 16 + i * 4); s += v[i][0] * v[i][0] + v[i][1] * v[i][1] + v[i][2] * v[i][2] + v[i][3] * v[i][3]; }
        u32x4 w0, w1;
        w0.x = pk2(v[0][0], v[0][1]); w0.y = pk2(v[0][2], v[0][3]); w0.z = pk2(v[1][0], v[1][1]); w0.w = pk2(v[1][2], v[1][3]);
        w1.x = pk2(v[2][0], v[2][1]); w1.y = pk2(v[2][2], v[2][3]); w1.z = pk2(v[3][0], v[3][1]); w1.w = pk2(v[3][2], v[3][3]);
        s += __shfl_xor(s, 1); s += __shfl_xor(s, 2);
        if (!ismem) {
            float* X = F.out + (size_t)row * 1024 + lane * 16;
#pragma unroll
            for (int i = 0; i < 4; ++i) *(f32x4*)(X + i * 4) = v[i];
            bf16_t* xb = ((bf16_t*)(F.ws + WS_XB)) + (size_t)row * 1024 + lane * 16;
            *(u32x4*)xb = w0; *(u32x4*)(xb + 8) = w1;
            if ((lane & 3) == 0) ((float*)(F.ws + WS_SSQ))[((size_t)(lane >> 4) * TT + row) * 4 + ((lane >> 2) & 3)] = s;
        } else {
            const int mr = row - TT;
            bf16_t* mb = ((bf16_t*)(F.ws + WS_MB)) + (size_t)mr * 1024 + lane * 16;
            *(u32x4*)mb = w0; *(u32x4*)(mb + 8) = w1;
            s += __shfl_xor(s, 4); s += __shfl_xor(s, 8); s += __shfl_xor(s, 16); s += __shfl_xor(s, 32);
            if (lane == 0) ((float*)(F.ws + WS_MRS))[mr] = rsqrtf(s * (1.f / 1024.f) + 1e-6f);
        }
    }
    cvt_mixer(F, 0);
    cvt_ffn(F, 0);
}

DEV void small_proj(const Frame& F0) {
    REFRAME;
    const int lane = F.lane, fr = lane & 15, fq = lane >> 4, mt = F.wid & 3, nt = F.wid >> 2;
    for (int c = F.bid; c < NCH; c += F.nb) {
        const int row = c * 64 + mt * 16 + fr;
        const bf16_t* a = ((bf16_t*)(F.ws + WS_XB)) + (size_t)row * 1024 + 8 * fq;
        const bf16_t* b = ((bf16_t*)(F.ws + WS_WMIX)) + WM_WSM + (size_t)(nt * 16 + fr) * 1024 + 8 * fq;
        f32x4 acc = {0.f, 0.f, 0.f, 0.f};
#pragma unroll 4
        for (int k = 0; k < 32; ++k) acc = MFMA16(*(const bf16x8*)(b + k * 32), *(const bf16x8*)(a + k * 32), acc);
        const float rs = row_rstd(((float*)(F.ws + WS_SSQ)), row);
        *(f32x4*)(((float*)(F.ws + WS_SC)) + (size_t)row * 32 + nt * 16 + 4 * fq) = acc * rs;
    }
}

DEV void gemm_epilogue(const Frame& F0, const GDesc& d, int l, f32x4 (&acc)[2][2][4][2]) {
    REFRAME;
    int lane_ = F.lane; asm volatile("" : "+v"(lane_));
    const int wr = F.wid >> 2, wc = F.wid & 3, fr = lane_ & 15, fq = lane_ >> 4;
    float* red = (float*)(F.lds + 131072);
    if (d.epi == EPI_SOFTMAX) {
        float mx[2][4];
#pragma unroll
        for (int ai = 0; ai < 2; ++ai)
#pragma unroll
            for (int m = 0; m < 4; ++m) {
                float v = -3.0e38f;
#pragma unroll
                for (int bj = 0; bj < 2; ++bj)
#pragma unroll
                    for (int n = 0; n < 2; ++n) { const f32x4 x = acc[ai][bj][m][n]; v = fmaxf(v, fmaxf(fmaxf(x[0], x[1]), fmaxf(x[2], x[3]))); }
                v = fmaxf(v, __shfl_xor(v, 16)); v = fmaxf(v, __shfl_xor(v, 32));
                if (fq == 0) red[(ai * 128 + wr * 64 + m * 16 + fr) * 4 + wc] = v;
            }
        __syncthreads();
#pragma unroll
        for (int ai = 0; ai < 2; ++ai)
#pragma unroll
            for (int m = 0; m < 4; ++m) {
                const f32x4 r4 = *(const f32x4*)(red + (ai * 128 + wr * 64 + m * 16 + fr) * 4);
                const float rm = fmaxf(fmaxf(r4[0], r4[1]), fmaxf(r4[2], r4[3]));
                mx[ai][m] = rm; float s = 0.f;
#pragma unroll
                for (int bj = 0; bj < 2; ++bj)
#pragma unroll
                    for (int n = 0; n < 2; ++n) { f32x4 x = acc[ai][bj][m][n];
#pragma unroll
                        for (int j = 0; j < 4; ++j) { x[j] = __expf(x[j] - rm); s += x[j]; }
                        acc[ai][bj][m][n] = x; }
                s += __shfl_xor(s, 16); s += __shfl_xor(s, 32);
                if (fq == 0) red[1024 + (ai * 128 + wr * 64 + m * 16 + fr) * 4 + wc] = s;
            }
        (void)mx;
        __syncthreads();
#pragma unroll
        for (int ai = 0; ai < 2; ++ai)
#pragma unroll
            for (int m = 0; m < 4; ++m) {
                const f32x4 r4 = *(const f32x4*)(red + 1024 + (ai * 128 + wr * 64 + m * 16 + fr) * 4);
                const float inv = 1.f / ((r4[0] + r4[1]) + (r4[2] + r4[3]));
                const bool valid = d.vai < 0 || (d.vai == ai && d.vwr == wr);
                const int row = d.orow + ai * 128 + wr * 64 + m * 16 + fr;
                if (valid) {
#pragma unroll
                    for (int bj = 0; bj < 2; ++bj)
#pragma unroll
                        for (int n = 0; n < 2; ++n) {
                            const int col = bj * 128 + wc * 32 + n * 16 + fq * 4;
                            *(u32x2*)(((bf16_t*)(F.ws + WS_P)) + (size_t)row * LDP + C_PR + d.head * 256 + col) = pk4(acc[ai][bj][m][n] * inv);
                        }
                }
            }
        __syncthreads();
        return;
    }
#pragma unroll
    for (int ai = 0; ai < 2; ++ai)
#pragma unroll
        for (int m = 0; m < 4; ++m) {
            const int row = d.orow + ai * 128 + wr * 64 + m * 16 + fr;
            float rs = 1.f, ss = 0.f;
            if (d.epi == EPI_PROJ || d.epi == EPI_UP || d.epi == EPI_Q) rs = row_rstd(((float*)(F.ws + WS_SSQ)), row);
            if (d.epi == EPI_Q) rs *= 0.0625f;
            if (d.epi == EPI_MEMK) rs = ((float*)(F.ws + WS_MRS))[row];
#pragma unroll
            for (int bj = 0; bj < 2; ++bj)
#pragma unroll
                for (int n = 0; n < 2; ++n) {
                    const int col = d.ocol + bj * 128 + wc * 32 + n * 16 + fq * 4;
                    f32x4 v = acc[ai][bj][m][n];
                    switch (d.epi) {
                    case EPI_PROJ: case EPI_UP: {
                        v = v * rs; const u32x2 w = pk4(v);
                        *(u32x2*)(((bf16_t*)(F.ws + WS_P)) + (size_t)row * LDP + col) = w;
                        const int nh = d.epi == EPI_PROJ ? 3 : 2, width = d.epi == EPI_PROJ ? 1536 : 5632;
                        if (m == 3 && fr >= 16 - nh && (d.epi == EPI_UP || col < 1536)) {
                            const int chunk = row >> 6, hr = fr - (16 - nh);
                            bf16_t* halo = d.epi == EPI_PROJ ? ((bf16_t*)(F.ws + WS_KV)) : ((bf16_t*)(F.ws + WS_KV));
                            *(u32x2*)(halo + ((size_t)chunk * nh + hr) * width + col) = w;
                            if (chunk >= 512 || (chunk & 31) == 31) {
                                float* o;
                                if (d.epi == EPI_PROJ) o = chunk < 512 ? F.out + O_GDNC_P + ((size_t)(l * 16 + (chunk >> 5)) * 3 + hr) * 1536 + col
                                                                       : F.out + O_GDNC_S + ((size_t)(l * 8 + (chunk - 512)) * 3 + hr) * 1536 + col;
                                else o = chunk < 512 ? F.out + O_FFNC_P + ((size_t)(l * 16 + (chunk >> 5)) * 2 + hr) * 5632 + col
                                                     : F.out + O_FFNC_S + ((size_t)(l * 8 + (chunk - 512)) * 2 + hr) * 5632 + col;
                                *(f32x4*)o = v;
                            }
                        }
                    } break;
                    case EPI_RESID: {
                        float* X = F.out + (size_t)row * 1024 + col;
                        f32x4 x = *(const f32x4*)X; x = x + v; *(f32x4*)X = x;
                        *(u32x2*)(((bf16_t*)(F.ws + WS_XB)) + (size_t)row * 1024 + col) = pk4(x);
                        ss += (x[0] * x[0] + x[1] * x[1]) + (x[2] * x[2] + x[3] * x[3]);
                    } break;
                    case EPI_Q: *(u32x2*)(((bf16_t*)(F.ws + WS_P)) + (size_t)row * LDP + C_Q + col) = pk4(v * rs); break;
                    case EPI_MEMK: {
                        v = v * rs;
                        *(f32x4*)(F.out + O_MEMK + ((size_t)l * 4096 + row) * 1024 + col) = v;
                        *(u32x2*)(((bf16_t*)(F.ws + WS_KV)) + (size_t)row * 1024 + col) = pk4(v);
                    } break;
                    case EPI_MEMV: {
                        const f32x4 r4 = *(const f32x4*)(((float*)(F.ws + WS_MRS)) + col);
                        v = v * r4;
                        float* o = F.out + O_MEMV + ((size_t)l * 4096 + col) * 1024 + row;
                        o[0] = v[0]; o[1024] = v[1]; o[2048] = v[2]; o[3072] = v[3];
                        const int b = col >> 8, h = row >> 8;
                        *(u32x2*)(((bf16_t*)(F.ws + WS_KV + 6144ull * 1024 * 2)) + ((size_t)(b * 4 + h) * 256 + (row & 255)) * 256 + (col & 255)) = pk4(v);
                    } break;
                    case EPI_OUTA: {
                        const f32x4 g = unpk4(*(const u32x2*)(((bf16_t*)(F.ws + WS_P)) + (size_t)row * LDP + C_GA + col));
                        f32x4 o; for (int j = 0; j < 4; ++j) o[j] = sigm(g[j]) * v[j];
                        *(u32x2*)(((bf16_t*)(F.ws + WS_P)) + (size_t)row * LDP + C_MRG + col) = pk4(o);
                    } break;
                    case EPI_OUTB: {
                        const f32x4 g = unpk4(*(const u32x2*)(((bf16_t*)(F.ws + WS_P)) + (size_t)row * LDP + C_GB + col));
                        f32x4 o = unpk4(*(const u32x2*)(((bf16_t*)(F.ws + WS_P)) + (size_t)row * LDP + C_MRG + col));
                        for (int j = 0; j < 4; ++j) o[j] += sigm(g[j]) * v[j];
                        *(u32x2*)(((bf16_t*)(F.ws + WS_P)) + (size_t)row * LDP + C_MRG + col) = pk4(o);
                    } break;
                    case EPI_ATTNO: {
                        const bool valid = d.vai < 0 || (d.vai == ai && d.vwr == wr);
                        if (valid) *(u32x2*)(((bf16_t*)(F.ws + WS_P)) + (size_t)row * LDP + C_O + d.head * 256 + col) = pk4(v);
                    } break;
                    default: break;
                    }
                }
            if (d.epi == EPI_RESID) {
                ss += __shfl_xor(ss, 16); ss += __shfl_xor(ss, 32);
                if (fq == 0) ((float*)(F.ws + WS_SSQ))[((size_t)(d.ocol >> 8) * TT + row) * 4 + wc] = ss;
            }
        }
}

enum { GP_IN = 0, GP_OUT, GP_WO, GP_MQ, GP_ATTN, GP_MO, GP_UP, GP_DOWN, GP_ATTN2, GP_OUT2 };
DEV void gemm_phase(const Frame& F0, int kind, int l) {
    REFRAME;
    int nunits = 0;
    switch (kind) { case GP_IN: case GP_UP: nunits = 130 * 22; break; case GP_OUT: nunits = 520 + 128; break; case GP_OUT2: nunits = 520; break; case GP_ATTN: case GP_ATTN2: nunits = 512 + 32; break; default: nunits = 520; }
    f32x4 acc[2][2][4][2];
    const bool xmap = (F.nb == 256) && (kind == GP_IN || kind == GP_UP || kind == GP_WO || kind == GP_MQ || kind == GP_MO || kind == GP_DOWN || kind == GP_OUT2);
    const int xcd = F.bid & 7, slot = F.bid >> 3, w_lo = (int)(((long)nunits * xcd) >> 3), w_hi = (int)(((long)nunits * (xcd + 1)) >> 3);
    for (int u0 = xmap ? w_lo + slot : F.bid; u0 < (xmap ? w_hi : nunits); u0 += xmap ? 32 : F.nb) {
        int u = u0;
        if (xmap) { const int nn = (kind == GP_IN || kind == GP_UP) ? 22 : 4; const int pn_ = u0 / 130, pm_ = u0 % 130; u = pm_ * nn + pn_; }
        GDesc d;
        { const int sub = (kind == GP_ATTN2 || kind == GP_OUT2) ? 1 : 0;
            d.vai = -1; d.vwr = 0; d.head = 0;
            switch (kind) {
            case GP_IN: { const int pm = u / 22, pn = u % 22; d.A = ((bf16_t*)(F.ws + WS_XB)); d.lda = 1024; d.Bt = ((bf16_t*)(F.ws + WS_WMIX)) + WM_WIN; d.ldb = 1024; d.K = 1024; d.brow = pm * 256; d.bcol = pn * 256; d.epi = EPI_PROJ; d.orow = d.brow; d.ocol = d.bcol; } break;
            case GP_UP: { const int pm = u / 22, pn = u % 22; d.A = ((bf16_t*)(F.ws + WS_XB)); d.lda = 1024; d.Bt = ((bf16_t*)(F.ws + WS_WFFN)) + WF_UP; d.ldb = 1024; d.K = 1024; d.brow = pm * 256; d.bcol = pn * 256; d.epi = EPI_UP; d.orow = d.brow; d.ocol = d.bcol; } break;
            case GP_OUT: case GP_OUT2:
                if (u < 520) { const int pm = u >> 2, pn = u & 3; d.A = ((bf16_t*)(F.ws + WS_P)) + (sub == 0 ? C_ZA : C_ZB); d.lda = LDP; d.Bt = ((bf16_t*)(F.ws + WS_WMIX)) + (sub == 0 ? WM_WOA : WM_WOB); d.ldb = 512; d.K = 512;
                               d.brow = pm * 256; d.bcol = pn * 256; d.epi = sub == 0 ? EPI_OUTA : EPI_OUTB; d.orow = d.brow; d.ocol = d.bcol; }
                else if (u < 520 + 64) { const int v = u - 520, pm = v >> 2, pn = v & 3; d.A = ((bf16_t*)(F.ws + WS_MB)); d.lda = 1024; d.Bt = ((bf16_t*)(F.ws + WS_WMIX)) + WM_WMK; d.ldb = 1024; d.K = 1024; d.brow = pm * 256; d.bcol = pn * 256; d.epi = EPI_MEMK; d.orow = d.brow; d.ocol = d.bcol; }
                else { const int v = u - 584, pm = v & 3, pn = v >> 2; d.A = ((bf16_t*)(F.ws + WS_WMIX)) + WM_WMV; d.lda = 1024; d.Bt = ((bf16_t*)(F.ws + WS_MB)); d.ldb = 1024; d.K = 1024; d.brow = pm * 256; d.bcol = pn * 256; d.epi = EPI_MEMV; d.orow = d.brow; d.ocol = d.bcol; }
                break;
            case GP_WO: { const int pm = u >> 2, pn = u & 3; d.A = ((bf16_t*)(F.ws + WS_P)) + C_MRG; d.lda = LDP; d.Bt = ((bf16_t*)(F.ws + WS_WMIX)) + WM_WO; d.ldb = 1024; d.K = 1024; d.brow = pm * 256; d.bcol = pn * 256; d.epi = EPI_RESID; d.orow = d.brow; d.ocol = d.bcol; } break;
            case GP_MQ: { const int pm = u >> 2, pn = u & 3; d.A = ((bf16_t*)(F.ws + WS_XB)); d.lda = 1024; d.Bt = ((bf16_t*)(F.ws + WS_WMIX)) + WM_WMQ; d.ldb = 1024; d.K = 1024; d.brow = pm * 256; d.bcol = pn * 256; d.epi = EPI_Q; d.orow = d.brow; d.ocol = d.bcol; } break;
            case GP_MO: { const int pm = u >> 2, pn = u & 3; d.A = ((bf16_t*)(F.ws + WS_P)) + C_O; d.lda = LDP; d.Bt = ((bf16_t*)(F.ws + WS_WMIX)) + WM_WMO; d.ldb = 1024; d.K = 1024; d.brow = pm * 256; d.bcol = pn * 256; d.epi = EPI_RESID; d.orow = d.brow; d.ocol = d.bcol; } break;
            case GP_DOWN: { const int pm = u >> 2, pn = u & 3; d.A = ((bf16_t*)(F.ws + WS_P)); d.lda = LDP; d.Bt = ((bf16_t*)(F.ws + WS_WFFN)) + WF_DN; d.ldb = 2816; d.K = 2816; d.brow = pm * 256; d.bcol = pn * 256; d.epi = EPI_RESID; d.orow = d.brow; d.ocol = d.bcol; } break;
            case GP_ATTN: case GP_ATTN2: {
                int pm, h, b;
                if (u < 512) { pm = u >> 2; h = u & 3; b = pm >> 3; }
                else { const int v = u - 512; h = v & 3; const int bi = (v >> 2) & 3, t = v >> 4; pm = 128 + t; b = 16 + 4 * t + bi; d.vai = bi >> 1; d.vwr = bi & 1; }
                d.head = h; d.brow = pm * 256; d.orow = d.brow; d.ocol = 0; d.K = 256; d.bcol = 0;
                if (sub == 0) { d.A = ((bf16_t*)(F.ws + WS_P)) + C_Q + h * 256; d.lda = LDP; d.Bt = ((bf16_t*)(F.ws + WS_KV)) + (size_t)b * 256 * 1024 + h * 256; d.ldb = 1024; d.epi = EPI_SOFTMAX; }
                else { d.A = ((bf16_t*)(F.ws + WS_P)) + C_PR + h * 256; d.lda = LDP; d.Bt = ((bf16_t*)(F.ws + WS_KV + 6144ull * 1024 * 2)) + (size_t)(b * 4 + h) * 65536; d.ldb = 256; d.epi = EPI_ATTNO; }
            } break;
            }
        }
        gemm_core(d.A, d.lda, d.Bt, d.ldb, d.K, d.brow, d.bcol, acc, (bf16_t*)F.lds);
        gemm_epilogue(F, d, l, acc);
    }
}

DEV void sample_kv(const Frame& F0, int l) {
    REFRAME;
    const float* ck = F.in[6] + (size_t)l * 2097152; const float* cv = F.in[7] + (size_t)l * 2097152;
    for (int i = F.bid * 512 + F.tid; i < 262144; i += F.nb * 512) {
        const f32x4 a = *(const f32x4*)(ck + (size_t)i * 8), b = *(const f32x4*)(ck + (size_t)i * 8 + 4);
        u32x4 w; w.x = pk2(a[0], a[1]); w.y = pk2(a[2], a[3]); w.z = pk2(b[0], b[1]); w.w = pk2(b[2], b[3]);
        *(u32x4*)(((bf16_t*)(F.ws + WS_KV)) + 4096ull * 1024 + (size_t)i * 8) = w;
        const int dd = i & 255, m8 = (i >> 8) & 31, h = (i >> 13) & 3, bb = i >> 15;
        const float* s = cv + ((size_t)(bb * 256 + m8 * 8) * 4 + h) * 256 + dd;
        u32x4 x; x.x = pk2(s[0], s[1024]); x.y = pk2(s[2048], s[3072]); x.z = pk2(s[4096], s[5120]); x.w = pk2(s[6144], s[7168]);
        *(u32x4*)(((bf16_t*)(F.ws + WS_KV + 6144ull * 1024 * 2)) + ((size_t)((16 + bb) * 4 + h) * 256 + dd) * 256 + m8 * 8) = x;
    }
}

DEV void g1_gdn(const Frame& F0, int l, int c, int h) {
    REFRAME;
    float* Fq = (float*)F.lds;
    bf16_t* VS = (bf16_t*)(F.lds + 66560);
    bf16_t* QN = (bf16_t*)(F.lds + 82944);
    bf16_t* KN = (bf16_t*)(F.lds + 100352);
    float* AM = (float*)(F.lds + 117760);
    float* sB = (float*)(F.lds + 135168); float* sG = sB + 64; float* sRQ = sB + 128; float* sRK = sB + 192;
    const int tid = F.tid, lane = F.lane, t0 = c * 64;
    const bool first = c >= 512 || (c & 31) == 0; const bool sample = c >= 512;
    __syncthreads();
    if (F.wid == 0) {
        const int t = t0 + lane;
        const float braw = ((float*)(F.ws + WS_SC))[(size_t)t * 32 + h], araw = ((float*)(F.ws + WS_SC))[(size_t)t * 32 + 4 + h];
        const float beta = sigm(braw);
        float g = -__expf(F.in[12][l * 4 + h]) * softplus(araw + F.in[13][l * 4 + h]);
#pragma unroll
        for (int off = 1; off < 64; off <<= 1) { const float n = __shfl_up(g, off); if (lane >= off) g += n; }
        sB[lane] = beta; sG[lane] = g;
        if (!F.dry) ((float*)(F.ws + WS_BG))[((size_t)c * 4 + h) * 128 + lane] = beta; if (!F.dry) ((float*)(F.ws + WS_BG))[((size_t)c * 4 + h) * 128 + 64 + lane] = g;
    }
    __syncthreads();
    const float* cw = F.in[11] + (size_t)l * 4 * 1536;
    if (tid < 384) {
        const int cp = tid % 192, rh = tid / 192, which = cp >> 6, cc = (cp & 63) * 2, pcol = which * 512 + h * 128 + cc;
        const f32x2 w0 = *(const f32x2*)(cw + pcol), w1 = *(const f32x2*)(cw + 1536 + pcol), w2 = *(const f32x2*)(cw + 2 * 1536 + pcol), w3 = *(const f32x2*)(cw + 3 * 1536 + pcol);
        float x0[35], x1[35];
#pragma unroll
        for (int i = 0; i < 3; ++i) {
            x0[i] = 0.f; x1[i] = 0.f;
            if (rh == 1) { const unsigned u = *(const unsigned*)(((bf16_t*)(F.ws + WS_P)) + (size_t)(t0 + 29 + i) * LDP + pcol); x0[i] = bflo(u); x1[i] = bfhi(u); }
            else if (!first) { const unsigned u = *(const unsigned*)(((bf16_t*)(F.ws + WS_KV)) + ((size_t)(c - 1) * 3 + i) * 1536 + pcol); x0[i] = bflo(u); x1[i] = bfhi(u); }
            else if (sample) { const f32x2 f = *(const f32x2*)(F.in[3] + ((size_t)(l * 8 + (c - 512)) * 3 + i) * 1536 + pcol); x0[i] = f[0]; x1[i] = f[1]; }
        }
#pragma unroll
        for (int i = 0; i < 32; ++i) { const unsigned u = *(const unsigned*)(((bf16_t*)(F.ws + WS_P)) + (size_t)(t0 + 32 * rh + i) * LDP + pcol); x0[3 + i] = bflo(u); x1[3 + i] = bfhi(u); }
#pragma unroll
        for (int r = 0; r < 32; ++r) {
            float a0 = w0[0] * x0[r] + w1[0] * x0[r + 1] + w2[0] * x0[r + 2] + w3[0] * x0[r + 3];
            float a1 = w0[1] * x1[r] + w1[1] * x1[r + 1] + w2[1] * x1[r + 2] + w3[1] * x1[r + 3];
            a0 = silu(a0); a1 = silu(a1);
            const int rr = 32 * rh + r;
            if (which < 2) { *(f32x2*)(Fq + rr * 260 + which * 128 + cc) = (f32x2){a0, a1}; }
            else { const float be = sB[rr]; *(unsigned*)(VS + rr * 128 + cc) = pk2(a0 * be, a1 * be); }
        }
    }
    __syncthreads();
    {
        const int r = tid >> 3, j = tid & 7; const float* p = Fq + r * 260 + j * 32; float s = 0.f;
#pragma unroll
        for (int i = 0; i < 32; ++i) s += p[i] * p[i];
        s += __shfl_xor(s, 1); s += __shfl_xor(s, 2);
        if ((j & 3) == 0) { if (j == 0) sRQ[r] = rsqrtf(s + 1e-6f) * 0.08838834764831845f; else sRK[r] = rsqrtf(s + 1e-6f); }
    }
    __syncthreads();
    for (int idx = tid; idx < 64 * 64; idx += 512) {
        const int r = idx >> 6, c4 = (idx & 63) * 4; const bool isq = c4 < 128;
        f32x4 v = *(const f32x4*)(Fq + r * 260 + c4); v = v * (isq ? sRQ[r] : sRK[r]);
        const u32x2 w = pk4(v);
        if (isq) { *(u32x2*)(QN + r * 136 + c4) = w; if (!F.dry) *(u32x2*)(((bf16_t*)(F.ws + WS_P)) + (size_t)(t0 + r) * LDP + C_QA + h * 128 + c4) = w; }
        else { *(u32x2*)(KN + r * 136 + c4 - 128) = w; if (!F.dry) *(u32x2*)(((bf16_t*)(F.ws + WS_P)) + (size_t)(t0 + r) * LDP + C_KA + h * 128 + c4 - 128) = w; }
    }
    for (int idx = tid; idx < 64 * 32; idx += 512) {
        const int r = idx >> 5, c4 = (idx & 31) * 4;
        if (!F.dry) *(u32x2*)(((bf16_t*)(F.ws + WS_P)) + (size_t)(t0 + r) * LDP + C_VA + h * 128 + c4) = *(const u32x2*)(VS + r * 128 + c4);
    }
    __syncthreads();
    {
        const int fr = lane & 15, fq = lane >> 4, which = F.wid >> 2, it = F.wid & 3;
        const bf16_t* X = which ? QN : KN;
        const int crow = 16 * it + fr; const float gc = sG[crow], bc = sB[crow];
        for (int jt = 0; jt < 4; ++jt) {
            f32x4 a = {0.f, 0.f, 0.f, 0.f};
            if (jt <= it) {
#pragma unroll
                for (int ks = 0; ks < 4; ++ks) a = MFMA16(ldfrag(KN, 16 * jt + fr, 136, 32 * ks, fq), ldfrag(X, crow, 136, 32 * ks, fq), a);
            }
            f32x4 o;
#pragma unroll
            for (int j = 0; j < 4; ++j) {
                const int s = 16 * jt + 4 * fq + j;
                const bool keep = which ? (s <= crow) : (s < crow);
                const float dec = keep ? __expf(gc - sG[s]) : 0.f;
                o[j] = a[j] * dec * (which ? 1.f : bc);
            }
            if (which) { if (!F.dry) *(u32x2*)(((bf16_t*)(F.ws + WS_XB)) + (size_t)(t0 + crow) * LDE + h * 128 + 64 + 16 * jt + 4 * fq) = pk4(o); }
            else *(f32x4*)(AM + crow * 68 + 16 * jt + 4 * fq) = o;
        }
    }
    __syncthreads();
    if (F.wid == 0) {
        float Tc[64]; const float lanef = (float)lane;
        typedef __attribute__((address_space(3))) const f32x4 LDSF4;
        __attribute__((address_space(3))) const char* aml = (__attribute__((address_space(3))) const char*)AM; asm volatile("" : "+v"(aml));
#pragma unroll
        for (int i = 0; i < 64; ++i) {
            float a = fmaxf(0.f, 1.f - fabsf(lanef - (float)i));
#pragma unroll
            for (int j4 = 0; j4 < (i + 3) / 4; ++j4) {
                const f32x4 av = *(const LDSF4*)(aml + (i * 68 + j4 * 4) * 4);
#pragma unroll
                for (int jj = 0; jj < 4; ++jj) if (j4 * 4 + jj < i) a -= av[jj] * Tc[j4 * 4 + jj];
            }
            Tc[i] = a;
        }
#pragma unroll
        for (int i = 0; i < 64; i += 2) {
            const unsigned w = pk2(Tc[i], Tc[i + 1]);
            if (!F.dry) ((bf16_t*)(F.ws + WS_XB))[(size_t)(t0 + i) * LDE + h * 128 + lane] = (bf16_t)(w & 0xffff);
            if (!F.dry) ((bf16_t*)(F.ws + WS_XB))[(size_t)(t0 + i + 1) * LDE + h * 128 + lane] = (bf16_t)(w >> 16);
        }
    }
}

DEV void g1_gla(const Frame& F0, int l, int c, int h) {
    REFRAME;
    float* GL = (float*)F.lds;
    float* LA = (float*)(F.lds + 4096);
    bf16_t* QG = (bf16_t*)(F.lds + 20736);
    bf16_t* KI = (bf16_t*)(F.lds + 29952);
    const int tid = F.tid, lane = F.lane, t0 = c * 64;
    __syncthreads();
    if (tid < 256) { const int r = tid >> 2, q4 = (tid & 3) * 4; *(f32x4*)(GL + r * 16 + q4) = *(const f32x4*)(((float*)(F.ws + WS_SC)) + (size_t)(t0 + r) * 32 + 8 + q4); }
    __syncthreads();
    {
        const int dk = tid & 63, rb = tid >> 6;
        float w2[16];
#pragma unroll
        for (int i = 0; i < 16; ++i) w2[i] = F.in[15][(size_t)(l * 16 + i) * 256 + h * 64 + dk];
        const float bias = F.in[16][l * 256 + h * 64 + dk];
#pragma unroll
        for (int rr = 0; rr < 8; ++rr) {
            const int r = rb * 8 + rr; float x = bias;
#pragma unroll
            for (int i = 0; i < 16; ++i) x += GL[r * 16 + i] * w2[i];
            LA[r * 65 + dk] = logsigmoid(x) * 0.0625f;
        }
    }
    __syncthreads();
    if (tid < 64) {
        float g = 0.f;
#pragma unroll 8
        for (int r = 0; r < 64; ++r) { g += LA[r * 65 + tid]; LA[r * 65 + tid] = g; }
        if (!F.dry) ((float*)(F.ws + WS_DL))[((size_t)c * 4 + h) * 64 + tid] = __expf(g);
    }
    __syncthreads();
    for (int idx = tid; idx < 64 * 16; idx += 512) {
        const int r = idx >> 4, c4 = (idx & 15) * 4;
        bf16_t* qp = ((bf16_t*)(F.ws + WS_P)) + (size_t)(t0 + r) * LDP + C_QB + h * 64 + c4; bf16_t* kp = ((bf16_t*)(F.ws + WS_P)) + (size_t)(t0 + r) * LDP + C_KB + h * 64 + c4;
        const f32x4 q = unpk4(*(const u32x2*)qp), k = unpk4(*(const u32x2*)kp);
        f32x4 qg, ki, kg;
#pragma unroll
        for (int j = 0; j < 4; ++j) { const float g = LA[r * 65 + c4 + j], gl = LA[63 * 65 + c4 + j];
            qg[j] = q[j] * 0.125f * __expf(g); ki[j] = k[j] * __expf(-g); kg[j] = k[j] * __expf(gl - g); }
        const u32x2 wq = pk4(qg);
        *(u32x2*)(QG + r * 72 + c4) = wq; *(u32x2*)(KI + r * 72 + c4) = pk4(ki);
        if (!F.dry) *(u32x2*)qp = wq; if (!F.dry) *(u32x2*)kp = pk4(kg);
    }
    __syncthreads();
    {
        const int fr = lane & 15, fq = lane >> 4, it = F.wid >> 1; const int crow = 16 * it + fr;
#pragma unroll
        for (int q = 0; q < 2; ++q) {
            const int jt = (F.wid & 1) * 2 + q;
            f32x4 a = {0.f, 0.f, 0.f, 0.f};
            if (jt <= it) {
#pragma unroll
                for (int ks = 0; ks < 2; ++ks) a = MFMA16(ldfrag(KI, 16 * jt + fr, 72, 32 * ks, fq), ldfrag(QG, crow, 72, 32 * ks, fq), a);
            }
#pragma unroll
            for (int j = 0; j < 4; ++j) if (16 * jt + 4 * fq + j > crow) a[j] = 0.f;
            if (!F.dry) *(u32x2*)(((bf16_t*)(F.ws + WS_XB)) + (size_t)(t0 + crow) * LDE + 512 + h * 64 + 16 * jt + 4 * fq) = pk4(a);
        }
    }
}

DEV void g2_gdn(const Frame& F0, int l, int s, int h) {
    REFRAME;
    bf16_t* QN = (bf16_t*)F.lds;
    bf16_t* KN = (bf16_t*)(F.lds + 17408);
    bf16_t* KT = (bf16_t*)(F.lds + 34816);
    bf16_t* TM = (bf16_t*)(F.lds + 53248);
    bf16_t* AQ = (bf16_t*)(F.lds + 62464);
    float* sB = (float*)(F.lds + 71680); float* sG = sB + 64;
    float* RED = (float*)(F.lds + 72192);
    bf16_t* VV = (bf16_t*)(F.lds + 74240);
    bf16_t* ZZ = (bf16_t*)(F.lds + 91648);
    const int tid = F.tid, lane = F.lane, w = F.wid, fr = lane & 15, fq = lane >> 4;
    const bool sample = s >= 16; const int nchunk = sample ? 1 : 32; const int tbase = sample ? 32768 + (s - 16) * 64 : s * 2048;
    const int dvc = h * 128 + 16 * w + fr;
    f32x4 S[8];
#pragma unroll
    for (int mt = 0; mt < 8; ++mt) {
        if (sample) { const float* sp = F.in[2] + ((size_t)((l * 8 + (s - 16)) * 4 + h) * 128) * 128;
#pragma unroll
            for (int j = 0; j < 4; ++j) S[mt][j] = sp[(size_t)(16 * mt + 4 * fq + j) * 128 + 16 * w + fr]; }
        else S[mt] = (f32x4){0.f, 0.f, 0.f, 0.f};
    }
    const float gn = F.in[14][l * 128 + 16 * w + fr];
    for (int n = 0; n < nchunk; ++n) {
        const int t0 = tbase + n * 64;
        __syncthreads();
#pragma unroll
        for (int i = 0; i < 2; ++i) {
            const int p = tid + 512 * i, r = p >> 4, c8 = (p & 15) * 8;
            const u32x4 q = *(const u32x4*)(((bf16_t*)(F.ws + WS_P)) + (size_t)(t0 + r) * LDP + C_QA + h * 128 + c8);
            const u32x4 k = *(const u32x4*)(((bf16_t*)(F.ws + WS_P)) + (size_t)(t0 + r) * LDP + C_KA + h * 128 + c8);
            *(u32x4*)(QN + r * 136 + c8) = q; *(u32x4*)(KN + r * 136 + c8) = k;
            *(u32x4*)(VV + r * 136 + c8) = *(const u32x4*)(((bf16_t*)(F.ws + WS_P)) + (size_t)(t0 + r) * LDP + C_VA + h * 128 + c8);
            *(u32x4*)(ZZ + r * 136 + c8) = *(const u32x4*)(((bf16_t*)(F.ws + WS_P)) + (size_t)(t0 + r) * LDP + C_ZA + h * 128 + c8);
            KT[(c8 + 0) * 72 + r] = (bf16_t)(k.x & 0xffff); KT[(c8 + 1) * 72 + r] = (bf16_t)(k.x >> 16);
            KT[(c8 + 2) * 72 + r] = (bf16_t)(k.y & 0xffff); KT[(c8 + 3) * 72 + r] = (bf16_t)(k.y >> 16);
            KT[(c8 + 4) * 72 + r] = (bf16_t)(k.z & 0xffff); KT[(c8 + 5) * 72 + r] = (bf16_t)(k.z >> 16);
            KT[(c8 + 6) * 72 + r] = (bf16_t)(k.w & 0xffff); KT[(c8 + 7) * 72 + r] = (bf16_t)(k.w >> 16);
        }
        {
            const int r = tid >> 3, c8 = (tid & 7) * 8;
            *(u32x4*)(TM + r * 72 + c8) = *(const u32x4*)(((bf16_t*)(F.ws + WS_XB)) + (size_t)(t0 + r) * LDE + h * 128 + c8);
            *(u32x4*)(AQ + r * 72 + c8) = *(const u32x4*)(((bf16_t*)(F.ws + WS_XB)) + (size_t)(t0 + r) * LDE + h * 128 + 64 + c8);
        }
        if (tid < 128) sB[tid] = ((float*)(F.ws + WS_BG))[((size_t)(t0 >> 6) * 4 + h) * 128 + tid];
        __syncthreads();
        f32x4 kS[4], qS[4], vn[4], o[4];
#pragma unroll
        for (int mt = 0; mt < 4; ++mt) { kS[mt] = (f32x4){0.f, 0.f, 0.f, 0.f}; qS[mt] = kS[mt]; vn[mt] = kS[mt]; }
#pragma unroll
        for (int ks = 0; ks < 4; ++ks) {
            const bf16x8 sf = mk8(pk4(S[2 * ks]), pk4(S[2 * ks + 1]));
#pragma unroll
            for (int mt = 0; mt < 4; ++mt) {
                kS[mt] = MFMA16(ldfragp(KN, 16 * mt + fr, 136, 32 * ks, fq), sf, kS[mt]);
                qS[mt] = MFMA16(ldfragp(QN, 16 * mt + fr, 136, 32 * ks, fq), sf, qS[mt]);
            }
        }
        const float glast = sG[63];
        f32x4 eg[4], tmp[4];
#pragma unroll
        for (int mt = 0; mt < 4; ++mt)
#pragma unroll
            for (int j = 0; j < 4; ++j) {
                const int row = 16 * mt + 4 * fq + j;
                const float e = __expf(sG[row]); eg[mt][j] = e;
                const float vv = bf2f(VV[row * 136 + 16 * w + fr]);
                tmp[mt][j] = vv - sB[row] * e * kS[mt][j];
            }
#pragma unroll
        for (int ks = 0; ks < 2; ++ks) {
            const bf16x8 tf = mk8(pk4(tmp[2 * ks]), pk4(tmp[2 * ks + 1]));
#pragma unroll
            for (int mt = 0; mt < 4; ++mt) vn[mt] = MFMA16(ldfragp(TM, 16 * mt + fr, 72, 32 * ks, fq), tf, vn[mt]);
        }
#pragma unroll
        for (int mt = 0; mt < 4; ++mt) o[mt] = eg[mt] * qS[mt];
#pragma unroll
        for (int ks = 0; ks < 2; ++ks) {
            const bf16x8 vf = mk8(pk4(vn[2 * ks]), pk4(vn[2 * ks + 1]));
#pragma unroll
            for (int mt = 0; mt < 4; ++mt) o[mt] = MFMA16(ldfragp(AQ, 16 * mt + fr, 72, 32 * ks, fq), vf, o[mt]);
        }
        const float dl = __expf(glast);
#pragma unroll
        for (int mt = 0; mt < 4; ++mt)
#pragma unroll
            for (int j = 0; j < 4; ++j) vn[mt][j] *= __expf(glast - sG[16 * mt + 4 * fq + j]);
#pragma unroll
        for (int mt = 0; mt < 8; ++mt) S[mt] = S[mt] * dl;
#pragma unroll
        for (int ks = 0; ks < 2; ++ks) {
            const bf16x8 vf = mk8(pk4(vn[2 * ks]), pk4(vn[2 * ks + 1]));
#pragma unroll
            for (int mt = 0; mt < 8; ++mt) S[mt] = MFMA16(ldfragp(KT, 16 * mt + fr, 72, 32 * ks, fq), vf, S[mt]);
        }
#pragma unroll
        for (int mt = 0; mt < 4; ++mt)
#pragma unroll
            for (int j = 0; j < 4; ++j) {
                float p = o[mt][j] * o[mt][j];
                p += __shfl_xor(p, 1); p += __shfl_xor(p, 2); p += __shfl_xor(p, 4); p += __shfl_xor(p, 8);
                if (fr == 0) RED[(16 * mt + 4 * fq + j) * 8 + w] = p;
            }
        __syncthreads();
#pragma unroll
        for (int mt = 0; mt < 4; ++mt)
#pragma unroll
            for (int j = 0; j < 4; ++j) {
                const int row = 16 * mt + 4 * fq + j;
                const f32x4 r0 = *(const f32x4*)(RED + row * 8), r1 = *(const f32x4*)(RED + row * 8 + 4);
                const float ssum = ((r0[0] + r0[1]) + (r0[2] + r0[3])) + ((r1[0] + r1[1]) + (r1[2] + r1[3]));
                const float rs = rsqrtf(ssum * (1.f / 128.f) + 1e-6f);
                bf16_t* zp = ((bf16_t*)(F.ws + WS_P)) + (size_t)(t0 + row) * LDP + C_ZA + dvc;
                const float z = bf2f(ZZ[row * 136 + 16 * w + fr]);
                if (!F.dry) *zp = (bf16_t)(pk2(o[mt][j] * rs * gn * silu(z), 0.f) & 0xffff);
            }
    }
    float* so = sample ? F.out + O_GDN_S + ((size_t)((l * 8 + (s - 16)) * 4 + h) * 128) * 128 : F.out + O_GDN_P + ((size_t)((l * 16 + s) * 4 + h) * 128) * 128;
#pragma unroll
    for (int mt = 0; mt < 8; ++mt)
#pragma unroll
        for (int j = 0; j < 4; ++j) if (!F.dry) so[(size_t)(16 * mt + 4 * fq + j) * 128 + 16 * w + fr] = S[mt][j];
}

DEV void g2_gla(const Frame& F0, int l, int s, int h) {
    REFRAME;
    bf16_t* QG = (bf16_t*)F.lds;
    bf16_t* KGT = (bf16_t*)(F.lds + 9216);
    bf16_t* AQ = (bf16_t*)(F.lds + 18432);
    float* sDL = (float*)(F.lds + 27648);
    float* RED = (float*)(F.lds + 27904);
    bf16_t* ZZ = (bf16_t*)(F.lds + 29952);
    const int tid = F.tid, lane = F.lane, w = F.wid, fr = lane & 15, fq = lane >> 4;
    const bool sample = s >= 16; const int nchunk = sample ? 1 : 32; const int tbase = sample ? 32768 + (s - 16) * 64 : s * 2048;
    const int dvc = h * 128 + 16 * w + fr;
    f32x4 S[4];
#pragma unroll
    for (int mt = 0; mt < 4; ++mt) {
        if (sample) { const float* sp = F.in[4] + ((size_t)((l * 8 + (s - 16)) * 4 + h) * 64) * 128;
#pragma unroll
            for (int j = 0; j < 4; ++j) S[mt][j] = sp[(size_t)(16 * mt + 4 * fq + j) * 128 + 16 * w + fr]; }
        else S[mt] = (f32x4){0.f, 0.f, 0.f, 0.f};
    }
    const float gn = F.in[17][l * 128 + 16 * w + fr];
    for (int n = 0; n < nchunk; ++n) {
        const int t0 = tbase + n * 64, chunk = t0 >> 6;
        __syncthreads();
        {
            const int r = tid >> 3, c8 = (tid & 7) * 8;
            *(u32x4*)(QG + r * 72 + c8) = *(const u32x4*)(((bf16_t*)(F.ws + WS_P)) + (size_t)(t0 + r) * LDP + C_QB + h * 64 + c8);
            const u32x4 k = *(const u32x4*)(((bf16_t*)(F.ws + WS_P)) + (size_t)(t0 + r) * LDP + C_KB + h * 64 + c8);
            KGT[(c8 + 0) * 72 + r] = (bf16_t)(k.x & 0xffff); KGT[(c8 + 1) * 72 + r] = (bf16_t)(k.x >> 16);
            KGT[(c8 + 2) * 72 + r] = (bf16_t)(k.y & 0xffff); KGT[(c8 + 3) * 72 + r] = (bf16_t)(k.y >> 16);
            KGT[(c8 + 4) * 72 + r] = (bf16_t)(k.z & 0xffff); KGT[(c8 + 5) * 72 + r] = (bf16_t)(k.z >> 16);
            KGT[(c8 + 6) * 72 + r] = (bf16_t)(k.w & 0xffff); KGT[(c8 + 7) * 72 + r] = (bf16_t)(k.w >> 16);
            *(u32x4*)(AQ + r * 72 + c8) = *(const u32x4*)(((bf16_t*)(F.ws + WS_XB)) + (size_t)(t0 + r) * LDE + 512 + h * 64 + c8);
        }
#pragma unroll
        for (int i = 0; i < 2; ++i) { const int p = tid + 512 * i, r = p >> 4, c8 = (p & 15) * 8;
            *(u32x4*)(ZZ + r * 136 + c8) = *(const u32x4*)(((bf16_t*)(F.ws + WS_P)) + (size_t)(t0 + r) * LDP + C_ZB + h * 128 + c8); }
        if (tid < 64) sDL[tid] = ((float*)(F.ws + WS_DL))[((size_t)chunk * 4 + h) * 64 + tid];
        bf16x8 vf[2];
#pragma unroll
        for (int ks = 0; ks < 2; ++ks) {
            unsigned e[8];
#pragma unroll
            for (int j = 0; j < 8; ++j) { const int row = 32 * ks + (j < 4 ? 4 * fq + j : 16 + 4 * fq + (j - 4)); e[j] = ((bf16_t*)(F.ws + WS_P))[(size_t)(t0 + row) * LDP + C_VB + dvc]; }
            u32x4 t; t.x = e[0] | (e[1] << 16); t.y = e[2] | (e[3] << 16); t.z = e[4] | (e[5] << 16); t.w = e[6] | (e[7] << 16);
            vf[ks] = __builtin_bit_cast(bf16x8, t);
        }
        __syncthreads();
        f32x4 o[4];
#pragma unroll
        for (int mt = 0; mt < 4; ++mt) o[mt] = (f32x4){0.f, 0.f, 0.f, 0.f};
#pragma unroll
        for (int ks = 0; ks < 2; ++ks) {
            const bf16x8 sf = mk8(pk4(S[2 * ks]), pk4(S[2 * ks + 1]));
#pragma unroll
            for (int mt = 0; mt < 4; ++mt) {
                o[mt] = MFMA16(ldfragp(QG, 16 * mt + fr, 72, 32 * ks, fq), sf, o[mt]);
                o[mt] = MFMA16(ldfragp(AQ, 16 * mt + fr, 72, 32 * ks, fq), vf[ks], o[mt]);
            }
        }
#pragma unroll
        for (int mt = 0; mt < 4; ++mt) {
#pragma unroll
            for (int j = 0; j < 4; ++j) S[mt][j] *= sDL[16 * mt + 4 * fq + j];
#pragma unroll
            for (int ks = 0; ks < 2; ++ks) S[mt] = MFMA16(ldfragp(KGT, 16 * mt + fr, 72, 32 * ks, fq), vf[ks], S[mt]);
        }
#pragma unroll
        for (int mt = 0; mt < 4; ++mt)
#pragma unroll
            for (int j = 0; j < 4; ++j) {
                float p = o[mt][j] * o[mt][j];
                p += __shfl_xor(p, 1); p += __shfl_xor(p, 2); p += __shfl_xor(p, 4); p += __shfl_xor(p, 8);
                if (fr == 0) RED[(16 * mt + 4 * fq + j) * 8 + w] = p;
            }
        __syncthreads();
#pragma unroll
        for (int mt = 0; mt < 4; ++mt)
#pragma unroll
            for (int j = 0; j < 4; ++j) {
                const int row = 16 * mt + 4 * fq + j;
                const f32x4 r0 = *(const f32x4*)(RED + row * 8), r1 = *(const f32x4*)(RED + row * 8 + 4);
                const float ssum = ((r0[0] + r0[1]) + (r0[2] + r0[3])) + ((r1[0] + r1[1]) + (r1[2] + r1[3]));
                const float rs = rsqrtf(ssum * (1.f / 128.f) + 1e-6f);
                bf16_t* zp = ((bf16_t*)(F.ws + WS_P)) + (size_t)(t0 + row) * LDP + C_ZB + dvc;
                const float z = bf2f(ZZ[row * 136 + 16 * w + fr]);
                if (!F.dry) *zp = (bf16_t)(pk2(o[mt][j] * rs * gn * silu(z), 0.f) & 0xffff);
            }
    }
    float* so = sample ? F.out + O_GLA_S + ((size_t)((l * 8 + (s - 16)) * 4 + h) * 64) * 128 : F.out + O_GLA_P + ((size_t)((l * 16 + s) * 4 + h) * 64) * 128;
#pragma unroll
    for (int mt = 0; mt < 4; ++mt)
#pragma unroll
        for (int j = 0; j < 4; ++j) if (!F.dry) so[(size_t)(16 * mt + 4 * fq + j) * 128 + 16 * w + fr] = S[mt][j];
}

DEV void unpack8(u32x4 u, float (&f)[8]) { f[0] = bflo(u.x); f[1] = bfhi(u.x); f[2] = bflo(u.y); f[3] = bfhi(u.y); f[4] = bflo(u.z); f[5] = bfhi(u.z); f[6] = bflo(u.w); f[7] = bfhi(u.w); }
DEV void load8f(const float* p, float (&f)[8]) { const f32x4 a = *(const f32x4*)p, b = *(const f32x4*)(p + 4); f[0] = a[0]; f[1] = a[1]; f[2] = a[2]; f[3] = a[3]; f[4] = b[0]; f[5] = b[1]; f[6] = b[2]; f[7] = b[3]; }
DEV void ffn_mid(const Frame& F0, int l) {
    REFRAME;
    const float* cw = F.in[29] + (size_t)l * 3 * 5632; const float* cb = F.in[30] + (size_t)l * 5632;
    const int total = NCH * 352;
    for (int idx = F.bid * 512 + F.tid; idx < total; idx += F.nb * 512) {
        const int c = idx / 352, col = (idx % 352) * 8;
        const bool first = c >= 512 || (c & 31) == 0, sample = c >= 512;
        float g2[8], g1[8], v2[8], v1[8];
#pragma unroll
        for (int j = 0; j < 8; ++j) { g2[j] = 0.f; g1[j] = 0.f; v2[j] = 0.f; v1[j] = 0.f; }
        if (!first) {
            const bf16_t* hp = ((bf16_t*)(F.ws + WS_KV)) + (size_t)(c - 1) * 2 * 5632;
            unpack8(*(const u32x4*)(hp + col), g2); unpack8(*(const u32x4*)(hp + 5632 + col), g1);
            unpack8(*(const u32x4*)(hp + 2816 + col), v2); unpack8(*(const u32x4*)(hp + 5632 + 2816 + col), v1);
        } else if (sample) {
            const float* sp = F.in[5] + (size_t)(l * 8 + (c - 512)) * 2 * 5632;
            load8f(sp + col, g2); load8f(sp + 5632 + col, g1); load8f(sp + 2816 + col, v2); load8f(sp + 5632 + 2816 + col, v1);
        }
        float wg0[8], wg1[8], wg2[8], bg[8], wv0[8], wv1[8], wv2[8], bv[8];
        load8f(cw + col, wg0); load8f(cw + 5632 + col, wg1); load8f(cw + 2 * 5632 + col, wg2); load8f(cb + col, bg);
        load8f(cw + 2816 + col, wv0); load8f(cw + 5632 + 2816 + col, wv1); load8f(cw + 2 * 5632 + 2816 + col, wv2); load8f(cb + 2816 + col, bv);
        bf16_t* up = ((bf16_t*)(F.ws + WS_P)) + (size_t)c * 64 * LDP + col;
#pragma unroll 4
        for (int r = 0; r < 64; ++r) {
            float g0[8], v0[8], o[8];
            unpack8(*(const u32x4*)(up + (size_t)r * LDP), g0); unpack8(*(const u32x4*)(up + (size_t)r * LDP + 2816), v0);
#pragma unroll
            for (int j = 0; j < 8; ++j) {
                const float yg = wg0[j] * g2[j] + wg1[j] * g1[j] + wg2[j] * g0[j] + bg[j];
                const float yv = wv0[j] * v2[j] + wv1[j] * v1[j] + wv2[j] * v0[j] + bv[j];
                o[j] = silu(yg) * yv;
                g2[j] = g1[j]; g1[j] = g0[j]; v2[j] = v1[j]; v1[j] = v0[j];
            }
            u32x4 w; w.x = pk2(o[0], o[1]); w.y = pk2(o[2], o[3]); w.z = pk2(o[4], o[5]); w.w = pk2(o[6], o[7]);
            if (!F.dry) *(u32x4*)(up + (size_t)r * LDP) = w;
        }
    }
}

DEV void final_norm(const Frame& F0) {
    REFRAME;
    const int gw = F.bid * 8 + F.wid, nw = F.nb * 8, lane = F.lane;
    const float* g = F.in[32];
    for (int row = gw; row < TT; row += nw) {
        const float rs = row_rstd(((float*)(F.ws + WS_SSQ)), row);
        float* X = F.out + (size_t)row * 1024;
#pragma unroll
        for (int i = 0; i < 4; ++i) { const int cidx = i * 256 + lane * 4; f32x4 v = *(const f32x4*)(X + cidx); const f32x4 gg = *(const f32x4*)(g + cidx); *(f32x4*)(X + cidx) = v * rs * gg; }
    }
}

#ifdef DBG_COL
DEV void dbg_dump(const Frame& F0) {
    REFRAME;
    for (int i = F.bid * 512 + F.tid; i < TT * 256; i += F.nb * 512) {
        const int row = i >> 8, c = (i & 255) * 4;
        const f32x4 v = c < 512 ? unpk4(*(const u32x2*)(((bf16_t*)(F.ws + WS_P)) + (size_t)row * LDP + DBG_COL + c)) : (f32x4){0.f, 0.f, 0.f, 0.f};
        *(f32x4*)(F.out + (size_t)row * 1024 + c) = (row DBG_ROWSEL) ? v : (f32x4){0.f, 0.f, 0.f, 0.f};
    }
}
#endif
DEV void gbar(unsigned* bar, unsigned epoch, int bid, int nb, int tid) {
    asm volatile("s_waitcnt vmcnt(0) lgkmcnt(0)" ::: "memory");
    __syncthreads();
    if (tid == 0) {
        __builtin_amdgcn_fence(__ATOMIC_RELEASE, "agent");
        const unsigned gsz = (unsigned)nb >> 3;
        const unsigned old = __hip_atomic_fetch_add(bar + 64 * (1 + (bid & 7)), 1u, __ATOMIC_RELAXED, __HIP_MEMORY_SCOPE_AGENT);
        if (old == gsz * epoch - 1u) __hip_atomic_fetch_add(bar, 1u, __ATOMIC_RELAXED, __HIP_MEMORY_SCOPE_AGENT);
        while (__hip_atomic_load(bar, __ATOMIC_RELAXED, __HIP_MEMORY_SCOPE_AGENT) < 8u * epoch) __builtin_amdgcn_s_sleep(1);
        __builtin_amdgcn_fence(__ATOMIC_ACQUIRE, "agent");
    }
    __syncthreads();
}
__global__ void __launch_bounds__(512, 2) fwd_kernel(Params p) {
    extern __shared__ __attribute__((aligned(16))) unsigned char lds[];
    cg::grid_group grid = cg::this_grid();
    Frame F;
    F.in = (InTab)__builtin_amdgcn_kernarg_segment_ptr(); F.out = p.out; F.ws = p.ws; F.lds = lds;
    F.tid = threadIdx.x; F.lane = threadIdx.x & 63; F.wid = __builtin_amdgcn_readfirstlane(threadIdx.x >> 6); F.nb = gridDim.x; F.bid = blockIdx.x; F.dry = 0;
    for (int ph = p.ph_lo; ph < p.ph_hi; ++ph) {
#ifndef PHM
#define PHM 0xffff
#endif
        if (ph == 0) { if (PHM & 0x1000) phase0(F); }
        else if (ph == NPH - 1) { if (PHM & 0x2000) final_norm(F); }
        else {
            const int l = (ph - 1) / 13, k = (ph - 1) % 13;
            int gk = -1;
            switch (k) { case 0: gk = GP_IN; break; case 3: gk = GP_OUT; break; case 4: gk = GP_OUT2; break; case 5: gk = GP_WO; break; case 6: gk = GP_MQ; break; case 7: gk = GP_ATTN; break; case 8: gk = GP_ATTN2; break;
                         case 9: gk = GP_MO; break; case 10: gk = GP_UP; break; case 12: gk = GP_DOWN; break; default: break; }
#ifndef REPMASK
#define REPMASK 0
#endif
            if (gk >= 0 && (PHM & 1)) { const int nrep = ((REPMASK >> k) & 1) ? 2 : 1; for (int rep = 0; rep < nrep; ++rep) gemm_phase(F, gk, l); }
            if (k == 0 && (PHM & 1)) small_proj(F);
            if (k == 3 && (PHM & 8)) sample_kv(F, l);
#ifndef DRYMASK
#define DRYMASK 0
#endif
            for (int dr = ((DRYMASK >> k) & 1); dr >= 0; --dr) {
            F.dry = dr;
            if (k == 1 && (PHM & 2)) {
                for (int it = F.bid; it < NCH * 8; it += F.nb) { const int c = it >> 3, h = it & 3; if (it & 4) g1_gla(F, l, c, h); else g1_gdn(F, l, c, h); }
                __syncthreads();
                if (l > 0 && !dr) cvt_ffn(F, l);
            }
            if (k == 2 && (PHM & 4)) {
                for (int it = F.bid; it < 192; it += F.nb) {
                    int s, h, br;
                    if (it < 128) { br = it & 1; h = (it >> 1) & 3; s = it >> 3; } else { const int v = it - 128; br = v & 1; h = (v >> 1) & 3; s = 16 + (v >> 3); }
                    if (br) g2_gla(F, l, s, h); else g2_gdn(F, l, s, h);
                    __syncthreads();
                }
            }
            if (k == 11 && (PHM & 0x200)) { ffn_mid(F, l); if (l < 3 && !dr) { __syncthreads(); cvt_mixer(F, l + 1); } }
            }
            F.dry = 0;
        }
#ifndef SYNCREP
#define SYNCREP 1
#endif
        if (ph + 1 < p.ph_hi) {
            if (ph == 0 || (gridDim.x & 7)) grid.sync();
            else gbar((unsigned*)(p.ws + WS_BAR), (unsigned)ph, (int)blockIdx.x, (int)gridDim.x, (int)threadIdx.x);
        }
    }
#ifdef DBG_COL
    __threadfence(); grid.sync(); __threadfence();
    dbg_dump(F);
#endif
}

extern "C" void kernel_launch(void* const* d_in, const int* in_sizes, int n_in, void* d_out, int out_size, void* d_ws, size_t ws_size, hipStream_t stream) {
    static int grid_blocks = 0;
    if (grid_blocks == 0) {
        if (n_in != 33 || ws_size < WS_TOTAL) { fprintf(stderr, "kernel_launch: bad n_in %d or ws %zu < %zu\n", n_in, ws_size, (size_t)WS_TOTAL); grid_blocks = -1; return; }
        int dev = 0, cus = 0, per_cu = 0;
        hipGetDevice(&dev);
        hipDeviceGetAttribute(&cus, hipDeviceAttributeMultiprocessorCount, dev);
        if (hipFuncSetAttribute((const void*)fwd_kernel, hipFuncAttributeMaxDynamicSharedMemorySize, LDS_BYTES) != hipSuccess) { fprintf(stderr, "hipFuncSetAttribute failed\n"); grid_blocks = -1; return; }
        hipOccupancyMaxActiveBlocksPerMultiprocessor(&per_cu, (const void*)fwd_kernel, 512, LDS_BYTES);
        if (per_cu < 1) per_cu = 1;
        (void)hipGetLastError();
        grid_blocks = cus * 1;
        if (grid_blocks <= 0) grid_blocks = 256;
    }
    if (grid_blocks < 0) return;
    Params p{};
    for (int i = 0; i < 33; ++i) p.in[i] = (const float*)d_in[i];
    p.out = (float*)d_out; p.ws = (unsigned char*)d_ws; p.ph_lo = 0; p.ph_hi = PH_HI;
    (void)hipMemsetAsync((unsigned char*)d_ws + WS_BAR, 0, 4096, stream);
    void* args[] = {&p};
    hipError_t e = hipLaunchCooperativeKernel((const void*)fwd_kernel, dim3(grid_blocks), dim3(512), args, LDS_BYTES, stream);
    if (e != hipSuccess) fprintf(stderr, "cooperative launch failed: %s (grid %d)\n", hipGetErrorString(e), grid_blocks);
}
```

```cpp
#include <hip/hip_runtime.h>
#include <hip/hip_cooperative_groups.h>
#include <cstdint>
#include <cstdio>
namespace cg = cooperative_groups;

typedef unsigned short bf16_t;
typedef short bf16x8 __attribute__((ext_vector_type(8)));
typedef float f32x4 __attribute__((ext_vector_type(4)));
typedef float f32x2 __attribute__((ext_vector_type(2)));
typedef unsigned u32x2 __attribute__((ext_vector_type(2)));
typedef unsigned u32x4 __attribute__((ext_vector_type(4)));
#define DEV __device__ __forceinline__

constexpr int DM = 1024, TT = 33280, NCH = 520, LDP = 5632, LDE = 768;
constexpr int C_QA = 0, C_KA = 512, C_VA = 1024, C_ZA = 1536, C_QB = 2048, C_KB = 2304, C_VB = 2560, C_ZB = 3072, C_GA = 3584, C_GB = 4608;
constexpr int C_MRG = 0, C_PR = 1024, C_Q = 2048, C_O = 3072;
constexpr size_t O_Y = 0;
constexpr size_t O_GDN_P = 34078720ull;
constexpr size_t O_GDNC_P = O_GDN_P + 4194304ull;
constexpr size_t O_GLA_P = O_GDNC_P + 294912ull;
constexpr size_t O_FFNC_P = O_GLA_P + 2097152ull;
constexpr size_t O_MEMK = O_FFNC_P + 720896ull;
constexpr size_t O_MEMV = O_MEMK + 16777216ull;
constexpr size_t O_GDN_S = O_MEMV + 16777216ull;
constexpr size_t O_GDNC_S = O_GDN_S + 2097152ull;
constexpr size_t O_GLA_S = O_GDNC_S + 147456ull;
constexpr size_t O_FFNC_S = O_GLA_S + 1048576ull;
constexpr size_t al256(size_t x) { return (x + 255) & ~(size_t)255; }
constexpr size_t WS_WMIX = 0;
constexpr size_t WM_WIN = 0, WM_WSM = WM_WIN + 5632ull * 1024, WM_WOA = WM_WSM + 32 * 1024, WM_WOB = WM_WOA + 524288, WM_WO = WM_WOB + 524288,
                 WM_WMQ = WM_WO + 1048576, WM_WMK = WM_WMQ + 1048576, WM_WMV = WM_WMK + 1048576, WM_WMO = WM_WMV + 1048576, WM_END = WM_WMO + 1048576;
constexpr size_t WS_WFFN = al256(WS_WMIX + WM_END * 2);
constexpr size_t WF_UP = 0, WF_DN = 5632ull * 1024, WF_END = WF_DN + 1024ull * 2816;
constexpr size_t WS_XB = al256(WS_WFFN + WF_END * 2);
constexpr size_t WS_P = al256(WS_XB + (size_t)TT * 1024 * 2);
constexpr size_t WS_KV = al256(WS_P + (size_t)TT * LDP * 2);
constexpr size_t KV_BYTES = 2ull * 6144 * 1024 * 2;
constexpr size_t WS_MB = al256(WS_KV + KV_BYTES);
constexpr size_t WS_MRS = al256(WS_MB + 4096ull * 1024 * 2);
constexpr size_t WS_SSQ = al256(WS_MRS + 4096 * 4);
constexpr size_t WS_SC = al256(WS_SSQ + (size_t)TT * 16 * 4);
constexpr size_t WS_DL = al256(WS_SC + (size_t)TT * 32 * 4);
constexpr size_t WS_BG = al256(WS_DL + 520ull * 4 * 64 * 4);
constexpr size_t WS_BAR = al256(WS_BG + 520ull * 4 * 128 * 4);
constexpr size_t WS_TOTAL = al256(WS_BAR + 16384);
constexpr int LDS_BYTES = 147456;
constexpr int NPH = 54;
#ifndef PH_HI
#define PH_HI NPH
#define REPMASK 0
#define SYNCREP 1
#define DRYMASK 0
#endif

struct Params { const float* in[33]; float* out; unsigned char* ws; int ph_lo, ph_hi; };

typedef __bf16 bf16x2_t __attribute__((ext_vector_type(2)));
DEV unsigned pk2(float lo, float hi) { f32x2 f = {lo, hi}; bf16x2_t v = __builtin_convertvector(f, bf16x2_t); return __builtin_bit_cast(unsigned, v); }
DEV float bf2f(bf16_t b) { return __uint_as_float(((unsigned)b) << 16); }
DEV float bflo(unsigned u) { return __uint_as_float(u << 16); }
DEV float bfhi(unsigned u) { return __uint_as_float(u & 0xffff0000u); }
DEV u32x2 pk4(f32x4 v) { u32x2 r; r.x = pk2(v[0], v[1]); r.y = pk2(v[2], v[3]); return r; }
DEV f32x4 unpk4(u32x2 u) { return (f32x4){bflo(u.x), bfhi(u.x), bflo(u.y), bfhi(u.y)}; }
DEV bf16x8 mk8(u32x2 a, u32x2 b) { u32x4 t = {a.x, a.y, b.x, b.y}; return __builtin_bit_cast(bf16x8, t); }
DEV float sigm(float x) { return 1.f / (1.f + __expf(-x)); }
DEV float silu(float x) { return x / (1.f + __expf(-x)); }
DEV float softplus(float x) { return x > 20.f ? x : __logf(1.f + __expf(x)); }
DEV float logsigmoid(float x) { return fminf(x, 0.f) - __logf(1.f + __expf(-fabsf(x))); }
DEV float row_rstd(const float* ssq, int row) {
    const f32x4 a = *(const f32x4*)(ssq + (size_t)row * 4), b = *(const f32x4*)(ssq + ((size_t)TT + row) * 4);
    const f32x4 c = *(const f32x4*)(ssq + ((size_t)2 * TT + row) * 4), d = *(const f32x4*)(ssq + ((size_t)3 * TT + row) * 4);
    float s = ((a[0] + a[1]) + (a[2] + a[3])) + ((b[0] + b[1]) + (b[2] + b[3])) + ((c[0] + c[1]) + (c[2] + c[3])) + ((d[0] + d[1]) + (d[2] + d[3]));
    return rsqrtf(s * (1.f / 1024.f) + 1e-6f);
}
DEV bf16x8 ldfragp(const bf16_t* base, int row, int stride, int k0, int fq) {
    const bf16_t* p = base + row * stride + k0 + 4 * fq;
    return mk8(*(const u32x2*)p, *(const u32x2*)(p + 16));
}
DEV bf16x8 ldfrag(const bf16_t* base, int row, int stride, int k0, int fq) {
    return *(const bf16x8*)(base + row * stride + k0 + 8 * fq);
}
#define MFMA16(a, b, c) __builtin_amdgcn_mfma_f32_16x16x32_bf16((a), (b), (c), 0, 0, 0)

constexpr int BM = 256, BK = 64, HALF = 128, HT = HALF * BK;
DEV int lds_byte(int r, int c) { int st = (r >> 4) * 2 + (c >> 5), rr = r & 15, cc = c & 31, ob = rr * 64 + cc * 2; return st * 1024 + (ob ^ (((ob >> 9) & 1) << 5)); }
DEV void stage_rc(int b, int& R, int& C) { int st = b / 1024, sb = b % 1024, swz = sb ^ (((sb >> 9) & 1) << 5); R = (st >> 1) * 16 + swz / 64; C = (st & 1) * 32 + (swz % 64) / 2; }

DEV void gemm_core(const bf16_t* __restrict__ A, int lda, const bf16_t* __restrict__ Bt, int ldb, int K, int brow, int bcol, f32x4 (&acc)[2][2][4][2], bf16_t* shm) {
#define SA(b, h) (shm + ((b) * 2 + (h)) * HT)
#define SB(b, h) (shm + (4 + (b) * 2 + (h)) * HT)
#define STAGE(P, BASE, LD, br, kt) do { const char* _gb = (const char*)((BASE) + (long)(br) * (LD) + (long)(kt) * BK); \
    const unsigned _vo = (unsigned)((sr0 * (int)(LD) + sc0) * 2); \
    for (int _i = 0; _i < 2; ++_i) { \
      __builtin_amdgcn_global_load_lds((const unsigned*)(_gb + (long)(_i * 128) * (LD) + _vo), (unsigned*)((char*)(P) + wbase + _i * 8192), 16, 0, 0); } } while (0)
#define LDA(dst, b, h) for (int m = 0; m < 4; ++m) for (int k = 0; k < 2; ++k) \
    dst[m][k] = *reinterpret_cast<const bf16x8*>((char*)SA(b, h) + lds_byte(wr * 64 + m * 16 + fr, k * 32 + fq * 8))
#define LDB(dst, b, h) for (int n = 0; n < 2; ++n) for (int k = 0; k < 2; ++k) \
    dst[n][k] = *reinterpret_cast<const bf16x8*>((char*)SB(b, h) + lds_byte(wc * 32 + n * 16 + fr, k * 32 + fq * 8))
#define MMA(ai, bj, At_, Bt_) do { __builtin_amdgcn_s_setprio(1); \
    for (int m = 0; m < 4; ++m) for (int n = 0; n < 2; ++n) for (int k = 0; k < 2; ++k) \
      acc[ai][bj][m][n] = __builtin_amdgcn_mfma_f32_16x16x32_bf16(Bt_[n][k], At_[m][k], acc[ai][bj][m][n], 0, 0, 0); \
    __builtin_amdgcn_s_setprio(0); } while (0)
#define WAIT_V(n) asm volatile("s_waitcnt vmcnt(" #n ")" ::: "memory")
#define WAIT_L(n) asm volatile("s_waitcnt lgkmcnt(" #n ")" ::: "memory")
#define BAR __builtin_amdgcn_s_barrier()
#define SCHED __builtin_amdgcn_sched_barrier(0)
    int tidx = threadIdx.x; asm volatile("" : "+v"(tidx));
    const int wid = __builtin_amdgcn_readfirstlane(tidx >> 6), lane = tidx & 63, wr = wid >> 2, wc = wid & 3, fr = lane & 15, fq = lane >> 4;
    const int wbase = wid * 1024;
    int sr0, sc0; stage_rc(tidx * 16, sr0, sc0);
#pragma unroll
    for (int a = 0; a < 2; ++a)
#pragma unroll
        for (int b = 0; b < 2; ++b)
#pragma unroll
            for (int m = 0; m < 4; ++m)
#pragma unroll
                for (int n = 0; n < 2; ++n) acc[a][b][m][n] = (f32x4){0.f, 0.f, 0.f, 0.f};
    bf16x8 At[4][2], B0[2][2], B1[2][2];
    const int nt = K / BK;
    STAGE(SB(0, 0), Bt, ldb, bcol, 0); STAGE(SA(0, 0), A, lda, brow, 0);
    STAGE(SB(0, 1), Bt, ldb, bcol + HALF, 0); STAGE(SA(0, 1), A, lda, brow + HALF, 0);
    if (wr == 1) BAR;
    WAIT_V(4); BAR;
    STAGE(SB(1, 0), Bt, ldb, bcol, 1); STAGE(SA(1, 0), A, lda, brow, 1); STAGE(SB(1, 1), Bt, ldb, bcol + HALF, 1);
    WAIT_V(6); BAR;
    for (int t = 0; t < nt - 2; t += 2) {
        LDB(B0, 0, 0); SCHED; LDA(At, 0, 0); STAGE(SA(1, 1), A, lda, brow + HALF, t + 1);
        WAIT_L(8); BAR; WAIT_L(0); MMA(0, 0, At, B0); BAR; SCHED;
        LDB(B1, 0, 1); STAGE(SB(0, 0), Bt, ldb, bcol, t + 2);
        BAR; WAIT_L(0); MMA(0, 1, At, B1); BAR;
        LDA(At, 0, 1); STAGE(SA(0, 0), A, lda, brow, t + 2);
        BAR; WAIT_L(0); MMA(1, 0, At, B0); BAR; SCHED;
        STAGE(SB(0, 1), Bt, ldb, bcol + HALF, t + 2);
        WAIT_V(6); BAR; MMA(1, 1, At, B1); BAR;
        LDB(B0, 1, 0); SCHED; LDA(At, 1, 0); STAGE(SA(0, 1), A, lda, brow + HALF, t + 2);
        WAIT_L(8); BAR; WAIT_L(0); MMA(0, 0, At, B0); BAR; SCHED;
        LDB(B1, 1, 1); STAGE(SB(1, 0), Bt, ldb, bcol, t + 3);
        BAR; WAIT_L(0); MMA(0, 1, At, B1); BAR;
        LDA(At, 1, 1); STAGE(SA(1, 0), A, lda, brow, t + 3);
        BAR; WAIT_L(0); MMA(1, 0, At, B0); BAR; SCHED;
        STAGE(SB(1, 1), Bt, ldb, bcol + HALF, t + 3);
        WAIT_V(6); BAR; MMA(1, 1, At, B1); BAR;
    }
    { LDB(B0, 0, 0); LDA(At, 0, 0); STAGE(SA(1, 1), A, lda, brow + HALF, nt - 1);
      BAR; WAIT_L(0); MMA(0, 0, At, B0); BAR;
      LDB(B1, 0, 1); BAR; WAIT_L(0); MMA(0, 1, At, B1); BAR;
      LDA(At, 0, 1); WAIT_V(4); BAR; WAIT_L(0); MMA(1, 0, At, B0); MMA(1, 1, At, B1); BAR; }
    { LDB(B0, 1, 0); LDA(At, 1, 0); WAIT_V(2); BAR; WAIT_L(0); MMA(0, 0, At, B0); BAR;
      LDB(B1, 1, 1); WAIT_V(0); BAR; WAIT_L(0); MMA(0, 1, At, B1); BAR;
      LDA(At, 1, 1); BAR; WAIT_L(0); MMA(1, 0, At, B0); MMA(1, 1, At, B1); BAR; }
    if (wr == 0) BAR;
#undef SA
#undef SB
}

typedef const float* const __attribute__((address_space(4)))* InTab;
struct Frame {
    InTab in; float* out; unsigned char* ws; unsigned char* lds;
    int tid, lane, wid, nb, bid, dry;
};
#define REFRAME Frame F = F0; { int t_ = threadIdx.x; asm volatile("" : "+v"(t_)); F.tid = t_; F.lane = t_ & 63; unsigned char* w_ = F.ws; asm volatile("" : "+s"(w_)); F.ws = w_; float* o_ = F.out; asm volatile("" : "+s"(o_)); F.out = o_; InTab i_ = (InTab)__builtin_amdgcn_kernarg_segment_ptr(); asm volatile("" : "+s"(i_)); F.in = i_; int a_ = F.wid, b_ = F.bid, c_ = F.nb; asm volatile("" : "+s"(a_), "+s"(b_), "+s"(c_)); F.wid = a_; F.bid = b_; F.nb = c_; }

enum { EPI_PROJ = 0, EPI_UP, EPI_RESID, EPI_Q, EPI_MEMK, EPI_MEMV, EPI_OUTA, EPI_OUTB, EPI_SOFTMAX, EPI_ATTNO };
struct GDesc { const bf16_t* A; int lda; const bf16_t* Bt; int ldb; int K, brow, bcol, epi, orow, ocol, head, vai, vwr; };

DEV void cvt_mat(const Frame& F0, const float* src, int ldsrc, int K, int N, int wincols, const float* gain, bf16_t* dst) {
    REFRAME;
    float* T = (float*)F.lds;
    const int nkt = K / 64, nnt = N / 64, ntile = nkt * nnt;
    for (int t = F.bid; t < ntile; t += F.nb) {
        const int kt = t / nnt, ntl = t % nnt, k0 = kt * 64, n0 = ntl * 64;
        int coff = 0; if (wincols) coff = (n0 < 1536) ? 0 : (n0 < 3072 ? 8 : 24);
        __syncthreads();
#pragma unroll
        for (int i = 0; i < 2; ++i) {
            const int kr = (F.tid >> 4) + 32 * i, nc = (F.tid & 15) * 4;
            f32x4 v = *(const f32x4*)(src + (size_t)(k0 + kr) * ldsrc + n0 + coff + nc);
            const float g = gain ? gain[k0 + kr] : 1.f;
            T[kr * 65 + nc + 0] = v[0] * g; T[kr * 65 + nc + 1] = v[1] * g; T[kr * 65 + nc + 2] = v[2] * g; T[kr * 65 + nc + 3] = v[3] * g;
        }
        __syncthreads();
        const int n = F.tid >> 3, kc = (F.tid & 7) * 8;
        u32x4 w;
        w.x = pk2(T[(kc + 0) * 65 + n], T[(kc + 1) * 65 + n]); w.y = pk2(T[(kc + 2) * 65 + n], T[(kc + 3) * 65 + n]);
        w.z = pk2(T[(kc + 4) * 65 + n], T[(kc + 5) * 65 + n]); w.w = pk2(T[(kc + 6) * 65 + n], T[(kc + 7) * 65 + n]);
        *(u32x4*)(dst + (size_t)(n0 + n) * K + k0 + kc) = w;
    }
    __syncthreads();
}
DEV void cvt_mixer(const Frame& F0, int l) {
    REFRAME;
    InTab in = F.in;
    cvt_mat(F, in[10] + (size_t)l * 1024 * 5656, 5656, 1024, 5632, 1, in[9] + l * 1024, ((bf16_t*)(F.ws + WS_WMIX)) + WM_WIN);
    cvt_mat(F, in[18] + (size_t)l * 512 * 1024, 1024, 512, 1024, 0, nullptr, ((bf16_t*)(F.ws + WS_WMIX)) + WM_WOA);
    cvt_mat(F, in[19] + (size_t)l * 512 * 1024, 1024, 512, 1024, 0, nullptr, ((bf16_t*)(F.ws + WS_WMIX)) + WM_WOB);
    cvt_mat(F, in[20] + (size_t)l * 1048576, 1024, 1024, 1024, 0, nullptr, ((bf16_t*)(F.ws + WS_WMIX)) + WM_WO);
    cvt_mat(F, in[23] + (size_t)l * 1048576, 1024, 1024, 1024, 0, in[21] + l * 1024, ((bf16_t*)(F.ws + WS_WMIX)) + WM_WMQ);
    cvt_mat(F, in[24] + (size_t)l * 1048576, 1024, 1024, 1024, 0, in[22] + l * 1024, ((bf16_t*)(F.ws + WS_WMIX)) + WM_WMK);
    cvt_mat(F, in[25] + (size_t)l * 1048576, 1024, 1024, 1024, 0, in[22] + l * 1024, ((bf16_t*)(F.ws + WS_WMIX)) + WM_WMV);
    cvt_mat(F, in[26] + (size_t)l * 1048576, 1024, 1024, 1024, 0, nullptr, ((bf16_t*)(F.ws + WS_WMIX)) + WM_WMO);
    const float* win = in[10] + (size_t)l * 1024 * 5656; const float* g = in[9] + l * 1024;
    for (int i = F.bid * 512 + F.tid; i < 32 * 1024; i += F.nb * 512) {
        const int n = i >> 10, k = i & 1023;
        float v = 0.f;
        if (n < 8) v = win[(size_t)k * 5656 + 1536 + n] * g[k]; else if (n < 24) v = win[(size_t)k * 5656 + 3080 + (n - 8)] * g[k];
        ((bf16_t*)(F.ws + WS_WMIX))[WM_WSM + i] = (bf16_t)(pk2(v, 0.f) & 0xffff);
    }
}
DEV void cvt_ffn(const Frame& F, int l) {
    cvt_mat(F, F.in[28] + (size_t)l * 1024 * 5632, 5632, 1024, 5632, 0, F.in[27] + l * 1024, ((bf16_t*)(F.ws + WS_WFFN)) + WF_UP);
    cvt_mat(F, F.in[31] + (size_t)l * 2816 * 1024, 1024, 2816, 1024, 0, nullptr, ((bf16_t*)(F.ws + WS_WFFN)) + WF_DN);
}

DEV void phase0(const Frame& F0) {
    REFRAME;
    const int gw = F.bid * 8 + F.wid, nw = F.nb * 8, lane = F.lane;
    for (int row = gw; row < TT + 4096; row += nw) {
        const bool ismem = row >= TT;
        const float* src = ismem ? F.in[8] + (size_t)(row - TT) * 1024 : (row < 32768 ? F.in[0] + (size_t)row * 1024 : F.in[1] + (size_t)(row - 32768) * 1024);
        f32x4 v[4]; float s = 0.f;
#pragma unroll
        for (int i = 0; i < 4; ++i) { v[i] = *(const f32x4*)(src + lane * 16 + i * 4); s += v[i][0] * v[i][0] + v[i][1] * v[i][1] + v[i][2] * v[i][2] + v[i][3] * v[i][3]; }
        u32x4 w0, w1;
        w0.x = pk2(v[0][0], v[0][1]); w0.y = pk2(v[0][2], v[0][3]); w0.z = pk2(v[1][0], v[1][1]); w0.w = pk2(v[1][2], v[1][3]);
        w1.x = pk2(v[2][0], v[2][1]); w1.y = pk2(v[2][2], v[2][3]); w1.z = pk2(v[3][0], v[3][1]); w1.w = pk2(v[3][2], v[3][3]);
        s += __shfl_xor(s, 1); s += __shfl_xor(s, 2);
        if (!ismem) {
            float* X = F.out + (size_t)row * 1024 + lane * 16;
#pragma unroll
            for (int i = 0; i < 4; ++i) *(f32x4*)(X + i * 4) = v[i];
            bf16_t* xb = ((bf16_t*)(F.ws + WS_XB)) + (size_t)row * 1024 + lane * 16;
            *(u32x4*)xb = w0; *(u32x4*)(xb + 8) = w1;
            if ((lane & 3) == 0) ((float*)(F.ws + WS_SSQ))[((size_t)(lane >> 4) * TT + row) * 4 + ((lane >> 2) & 3)] = s;
        } else {
            const int mr = row - TT;
            bf16_t* mb = ((bf16_t*)(F.ws + WS_MB)) + (size_t)mr * 1024 + lane * 16;
            *(u32x4*)mb = w0; *(u32x4*)(mb + 8) = w1;
            s += __shfl_xor(s, 4); s += __shfl_xor(s, 8); s += __shfl_xor(s, 16); s += __shfl_xor(s, 32);
            if (lane == 0) ((float*)(F.ws + WS_MRS))[mr] = rsqrtf(s * (1.f / 1024.f) + 1e-6f);
        }
    }
    cvt_mixer(F, 0);
    cvt_ffn(F, 0);
}

DEV void small_proj(const Frame& F0) {
    REFRAME;
    const int lane = F.lane, fr = lane & 15, fq = lane >> 4, mt = F.wid & 3, nt = F.wid >> 2;
    for (int c = F.bid; c < NCH; c += F.nb) {
        const int row = c * 64 + mt * 16 + fr;
        const bf16_t* a = ((bf16_t*)(F.ws + WS_XB)) + (size_t)row * 1024 + 8 * fq;
        const bf16_t* b = ((bf16_t*)(F.ws + WS_WMIX)) + WM_WSM + (size_t)(nt * 16 + fr) * 1024 + 8 * fq;
        f32x4 acc = {0.f, 0.f, 0.f, 0.f};
#pragma unroll 4
        for (int k = 0; k < 32; ++k) acc = MFMA16(*(const bf16x8*)(b + k * 32), *(const bf16x8*)(a + k * 32), acc);
        const float rs = row_rstd(((float*)(F.ws + WS_SSQ)), row);
        *(f32x4*)(((float*)(F.ws + WS_SC)) + (size_t)row * 32 + nt * 16 + 4 * fq) = acc * rs;
    }
}

DEV void gemm_epilogue(const Frame& F0, const GDesc& d, int l, f32x4 (&acc)[2][2][4][2]) {
    REFRAME;
    int lane_ = F.lane; asm volatile("" : "+v"(lane_));
    const int wr = F.wid >> 2, wc = F.wid & 3, fr = lane_ & 15, fq = lane_ >> 4;
    float* red = (float*)(F.lds + 131072);
    if (d.epi == EPI_SOFTMAX) {
        float mx[2][4];
#pragma unroll
        for (int ai = 0; ai < 2; ++ai)
#pragma unroll
            for (int m = 0; m < 4; ++m) {
                float v = -3.0e38f;
#pragma unroll
                for (int bj = 0; bj < 2; ++bj)
#pragma unroll
                    for (int n = 0; n < 2; ++n) { const f32x4 x = acc[ai][bj][m][n]; v = fmaxf(v, fmaxf(fmaxf(x[0], x[1]), fmaxf(x[2], x[3]))); }
                v = fmaxf(v, __shfl_xor(v, 16)); v = fmaxf(v, __shfl_xor(v, 32));
                if (fq == 0) red[(ai * 128 + wr * 64 + m * 16 + fr) * 4 + wc] = v;
            }
        __syncthreads();
#pragma unroll
        for (int ai = 0; ai < 2; ++ai)
#pragma unroll
            for (int m = 0; m < 4; ++m) {
                const f32x4 r4 = *(const f32x4*)(red + (ai * 128 + wr * 64 + m * 16 + fr) * 4);
                const float rm = fmaxf(fmaxf(r4[0], r4[1]), fmaxf(r4[2], r4[3]));
                mx[ai][m] = rm; float s = 0.f;
#pragma unroll
                for (int bj = 0; bj < 2; ++bj)
#pragma unroll
                    for (int n = 0; n < 2; ++n) { f32x4 x = acc[ai][bj][m][n];
#pragma unroll
                        for (int j = 0; j < 4; ++j) { x[j] = __expf(x[j] - rm); s += x[j]; }
                        acc[ai][bj][m][n] = x; }
                s += __shfl_xor(s, 16); s += __shfl_xor(s, 32);
                if (fq == 0) red[1024 + (ai * 128 + wr * 64 + m * 16 + fr) * 4 + wc] = s;
            }
        (void)mx;
        __syncthreads();
#pragma unroll
        for (int ai = 0; ai < 2; ++ai)
#pragma unroll
            for (int m = 0; m < 4; ++m) {
                const f32x4 r4 = *(const f32x4*)(red + 1024 + (ai * 128 + wr * 64 + m * 16 + fr) * 4);
                const float inv = 1.f / ((r4[0] + r4[1]) + (r4[2] + r4[3]));
                const bool valid = d.vai < 0 || (d.vai == ai && d.vwr == wr);
                const int row = d.orow + ai * 128 + wr * 64 + m * 16 + fr;
                if (valid) {
#pragma unroll
                    for (int bj = 0; bj < 2; ++bj)
#pragma unroll
                        for (int n = 0; n < 2; ++n) {
                            const int col = bj * 128 + wc * 32 + n * 16 + fq * 4;
                            *(u32x2*)(((bf16_t*)(F.ws + WS_P)) + (size_t)row * LDP + C_PR + d.head * 256 + col) = pk4(acc[ai][bj][m][n] * inv);
                        }
                }
            }
        __syncthreads();
        return;
    }
#pragma unroll
    for (int ai = 0; ai < 2; ++ai)
#pragma unroll
        for (int m = 0; m < 4; ++m) {
            const int row = d.orow + ai * 128 + wr * 64 + m * 16 + fr;
            float rs = 1.f, ss = 0.f;
            if (d.epi == EPI_PROJ || d.epi == EPI_UP || d.epi == EPI_Q) rs = row_rstd(((float*)(F.ws + WS_SSQ)), row);
            if (d.epi == EPI_Q) rs *= 0.0625f;
            if (d.epi == EPI_MEMK) rs = ((float*)(F.ws + WS_MRS))[row];
#pragma unroll
            for (int bj = 0; bj < 2; ++bj)
#pragma unroll
                for (int n = 0; n < 2; ++n) {
                    const int col = d.ocol + bj * 128 + wc * 32 + n * 16 + fq * 4;
                    f32x4 v = acc[ai][bj][m][n];
                    switch (d.epi) {
                    case EPI_PROJ: case EPI_UP: {
                        v = v * rs; const u32x2 w = pk4(v);
                        *(u32x2*)(((bf16_t*)(F.ws + WS_P)) + (size_t)row * LDP + col) = w;
                        const int nh = d.epi == EPI_PROJ ? 3 : 2, width = d.epi == EPI_PROJ ? 1536 : 5632;
                        if (m == 3 && fr >= 16 - nh && (d.epi == EPI_UP || col < 1536)) {
                            const int chunk = row >> 6, hr = fr - (16 - nh);
                            bf16_t* halo = d.epi == EPI_PROJ ? ((bf16_t*)(F.ws + WS_KV)) : ((bf16_t*)(F.ws + WS_KV));
                            *(u32x2*)(halo + ((size_t)chunk * nh + hr) * width + col) = w;
                            if (chunk >= 512 || (chunk & 31) == 31) {
                                float* o;
                                if (d.epi == EPI_PROJ) o = chunk < 512 ? F.out + O_GDNC_P + ((size_t)(l * 16 + (chunk >> 5)) * 3 + hr) * 1536 + col
                                                                       : F.out + O_GDNC_S + ((size_t)(l * 8 + (chunk - 512)) * 3 + hr) * 1536 + col;
                                else o = chunk < 512 ? F.out + O_FFNC_P + ((size_t)(l * 16 + (chunk >> 5)) * 2 + hr) * 5632 + col
                                                     : F.out + O_FFNC_S + ((size_t)(l * 8 + (chunk - 512)) * 2 + hr) * 5632 + col;
                                *(f32x4*)o = v;
                            }
                        }
                    } break;
                    case EPI_RESID: {
                        float* X = F.out + (size_t)row * 1024 + col;
                        f32x4 x = *(const f32x4*)X; x = x + v; *(f32x4*)X = x;
                        *(u32x2*)(((bf16_t*)(F.ws + WS_XB)) + (size_t)row * 1024 + col) = pk4(x);
                        ss += (x[0] * x[0] + x[1] * x[1]) + (x[2] * x[2] + x[3] * x[3]);
                    } break;
                    case EPI_Q: *(u32x2*)(((bf16_t*)(F.ws + WS_P)) + (size_t)row * LDP + C_Q + col) = pk4(v * rs); break;
                    case EPI_MEMK: {
                        v = v * rs;
                        *(f32x4*)(F.out + O_MEMK + ((size_t)l * 4096 + row) * 1024 + col) = v;
                        *(u32x2*)(((bf16_t*)(F.ws + WS_KV)) + (size_t)row * 1024 + col) = pk4(v);
                    } break;
                    case EPI_MEMV: {
                        const f32x4 r4 = *(const f32x4*)(((float*)(F.ws + WS_MRS)) + col);
                        v = v * r4;
                        float* o = F.out + O_MEMV + ((size_t)l * 4096 + col) * 1024 + row;
                        o[0] = v[0]; o[1024] = v[1]; o[2048] = v[2]; o[3072] = v[3];
                        const int b = col >> 8, h = row >> 8;
                        *(u32x2*)(((bf16_t*)(F.ws + WS_KV + 6144ull * 1024 * 2)) + ((size_t)(b * 4 + h) * 256 + (row & 255)) * 256 + (col & 255)) = pk4(v);
                    } break;
                    case EPI_OUTA: {
                        const f32x4 g = unpk4(*(const u32x2*)(((bf16_t*)(F.ws + WS_P)) + (size_t)row * LDP + C_GA + col));
                        f32x4 o; for (int j = 0; j < 4; ++j) o[j] = sigm(g[j]) * v[j];
                        *(u32x2*)(((bf16_t*)(F.ws + WS_P)) + (size_t)row * LDP + C_MRG + col) = pk4(o);
                    } break;
                    case EPI_OUTB: {
                        const f32x4 g = unpk4(*(const u32x2*)(((bf16_t*)(F.ws + WS_P)) + (size_t)row * LDP + C_GB + col));
                        f32x4 o = unpk4(*(const u32x2*)(((bf16_t*)(F.ws + WS_P)) + (size_t)row * LDP + C_MRG + col));
                        for (int j = 0; j < 4; ++j) o[j] += sigm(g[j]) * v[j];
                        *(u32x2*)(((bf16_t*)(F.ws + WS_P)) + (size_t)row * LDP + C_MRG + col) = pk4(o);
                    } break;
                    case EPI_ATTNO: {
                        const bool valid = d.vai < 0 || (d.vai == ai && d.vwr == wr);
                        if (valid) *(u32x2*)(((bf16_t*)(F.ws + WS_P)) + (size_t)row * LDP + C_O + d.head * 256 + col) = pk4(v);
                    } break;
                    default: break;
                    }
                }
            if (d.epi == EPI_RESID) {
                ss += __shfl_xor(ss, 16); ss += __shfl_xor(ss, 32);
                if (fq == 0) ((float*)(F.ws + WS_SSQ))[((size_t)(d.ocol >> 8) * TT + row) * 4 + wc] = ss;
            }
        }
}

enum { GP_IN = 0, GP_OUT, GP_WO, GP_MQ, GP_ATTN, GP_MO, GP_UP, GP_DOWN, GP_ATTN2, GP_OUT2 };
DEV void gemm_phase(const Frame& F0, int kind, int l) {
    REFRAME;
    int nunits = 0;
    switch (kind) { case GP_IN: case GP_UP: nunits = 130 * 22; break; case GP_OUT: nunits = 520 + 128; break; case GP_OUT2: nunits = 520; break; case GP_ATTN: case GP_ATTN2: nunits = 512 + 32; break; default: nunits = 520; }
    f32x4 acc[2][2][4][2];
    const bool xmap = (F.nb == 256) && (kind == GP_IN || kind == GP_UP || kind == GP_WO || kind == GP_MQ || kind == GP_MO || kind == GP_DOWN || kind == GP_OUT2);
    const int xcd = F.bid & 7, slot = F.bid >> 3, w_lo = (int)(((long)nunits * xcd) >> 3), w_hi = (int)(((long)nunits * (xcd + 1)) >> 3);
    for (int u0 = xmap ? w_lo + slot : F.bid; u0 < (xmap ? w_hi : nunits); u0 += xmap ? 32 : F.nb) {
        int u = u0;
        if (xmap) { const int nn = (kind == GP_IN || kind == GP_UP) ? 22 : 4; const int pn_ = u0 / 130, pm_ = u0 % 130; u = pm_ * nn + pn_; }
        GDesc d;
        { const int sub = (kind == GP_ATTN2 || kind == GP_OUT2) ? 1 : 0;
            d.vai = -1; d.vwr = 0; d.head = 0;
            switch (kind) {
            case GP_IN: { const int pm = u / 22, pn = u % 22; d.A = ((bf16_t*)(F.ws + WS_XB)); d.lda = 1024; d.Bt = ((bf16_t*)(F.ws + WS_WMIX)) + WM_WIN; d.ldb = 1024; d.K = 1024; d.brow = pm * 256; d.bcol = pn * 256; d.epi = EPI_PROJ; d.orow = d.brow; d.ocol = d.bcol; } break;
            case GP_UP: { const int pm = u / 22, pn = u % 22; d.A = ((bf16_t*)(F.ws + WS_XB)); d.lda = 1024; d.Bt = ((bf16_t*)(F.ws + WS_WFFN)) + WF_UP; d.ldb = 1024; d.K = 1024; d.brow = pm * 256; d.bcol = pn * 256; d.epi = EPI_UP; d.orow = d.brow; d.ocol = d.bcol; } break;
            case GP_OUT: case GP_OUT2:
                if (u < 520) { const int pm = u >> 2, pn = u & 3; d.A = ((bf16_t*)(F.ws + WS_P)) + (sub == 0 ? C_ZA : C_ZB); d.lda = LDP; d.Bt = ((bf16_t*)(F.ws + WS_WMIX)) + (sub == 0 ? WM_WOA : WM_WOB); d.ldb = 512; d.K = 512;
                               d.brow = pm * 256; d.bcol = pn * 256; d.epi = sub == 0 ? EPI_OUTA : EPI_OUTB; d.orow = d.brow; d.ocol = d.bcol; }
                else if (u < 520 + 64) { const int v = u - 520, pm = v >> 2, pn = v & 3; d.A = ((bf16_t*)(F.ws + WS_MB)); d.lda = 1024; d.Bt = ((bf16_t*)(F.ws + WS_WMIX)) + WM_WMK; d.ldb = 1024; d.K = 1024; d.brow = pm * 256; d.bcol = pn * 256; d.epi = EPI_MEMK; d.orow = d.brow; d.ocol = d.bcol; }
                else { const int v = u - 584, pm = v & 3, pn = v >> 2; d.A = ((bf16_t*)(F.ws + WS_WMIX)) + WM_WMV; d.lda = 1024; d.Bt = ((bf16_t*)(F.ws + WS_MB)); d.ldb = 1024; d.K = 1024; d.brow = pm * 256; d.bcol = pn * 256; d.epi = EPI_MEMV; d.orow = d.brow; d.ocol = d.bcol; }
                break;
            case GP_WO: { const int pm = u >> 2, pn = u & 3; d.A = ((bf16_t*)(F.ws + WS_P)) + C_MRG; d.lda = LDP; d.Bt = ((bf16_t*)(F.ws + WS_WMIX)) + WM_WO; d.ldb = 1024; d.K = 1024; d.brow = pm * 256; d.bcol = pn * 256; d.epi = EPI_RESID; d.orow = d.brow; d.ocol = d.bcol; } break;
            case GP_MQ: { const int pm = u >> 2, pn = u & 3; d.A = ((bf16_t*)(F.ws + WS_XB)); d.lda = 1024; d.Bt = ((bf16_t*)(F.ws + WS_WMIX)) + WM_WMQ; d.ldb = 1024; d.K = 1024; d.brow = pm * 256; d.bcol = pn * 256; d.epi = EPI_Q; d.orow = d.brow; d.ocol = d.bcol; } break;
            case GP_MO: { const int pm = u >> 2, pn = u & 3; d.A = ((bf16_t*)(F.ws + WS_P)) + C_O; d.lda = LDP; d.Bt = ((bf16_t*)(F.ws + WS_WMIX)) + WM_WMO; d.ldb = 1024; d.K = 1024; d.brow = pm * 256; d.bcol = pn * 256; d.epi = EPI_RESID; d.orow = d.brow; d.ocol = d.bcol; } break;
            case GP_DOWN: { const int pm = u >> 2, pn = u & 3; d.A = ((bf16_t*)(F.ws + WS_P)); d.lda = LDP; d.Bt = ((bf16_t*)(F.ws + WS_WFFN)) + WF_DN; d.ldb = 2816; d.K = 2816; d.brow = pm * 256; d.bcol = pn * 256; d.epi = EPI_RESID; d.orow = d.brow; d.ocol = d.bcol; } break;
            case GP_ATTN: case GP_ATTN2: {
                int pm, h, b;
                if (u < 512) { pm = u >> 2; h = u & 3; b = pm >> 3; }
                else { const int v = u - 512; h = v & 3; const int bi = (v >> 2) & 3, t = v >> 4; pm = 128 + t; b = 16 + 4 * t + bi; d.vai = bi >> 1; d.vwr = bi & 1; }
                d.head = h; d.brow = pm * 256; d.orow = d.brow; d.ocol = 0; d.K = 256; d.bcol = 0;
                if (sub == 0) { d.A = ((bf16_t*)(F.ws + WS_P)) + C_Q + h * 256; d.lda = LDP; d.Bt = ((bf16_t*)(F.ws + WS_KV)) + (size_t)b * 256 * 1024 + h * 256; d.ldb = 1024; d.epi = EPI_SOFTMAX; }
                else { d.A = ((bf16_t*)(F.ws + WS_P)) + C_PR + h * 256; d.lda = LDP; d.Bt = ((bf16_t*)(F.ws + WS_KV + 6144ull * 1024 * 2)) + (size_t)(b * 4 + h) * 65536; d.ldb = 256; d.epi = EPI_ATTNO; }
            } break;
            }
        }
        gemm_core(d.A, d.lda, d.Bt, d.ldb, d.K, d.brow, d.bcol, acc, (bf16_t*)F.lds);
        gemm_epilogue(F, d, l, acc);
    }
}

DEV void sample_kv(const Frame& F0, int l) {
    REFRAME;
    const float* ck = F.in[6] + (size_t)l * 2097152; const float* cv = F.in[7] + (size_t)l * 2097152;
    for (int i = F.bid * 512 + F.tid; i < 262144; i += F.nb * 512) {
        const f32x4 a = *(const f32x4*)(ck + (size_t)i * 8), b = *(const f32x4*)(ck + (size_t)i * 8 + 4);
        u32x4 w; w.x = pk2(a[0], a[1]); w.y = pk2(a[2], a[3]); w.z = pk2(b[0], b[1]); w.w = pk2(b[2], b[3]);
        *(u32x4*)(((bf16_t*)(F.ws + WS_KV)) + 4096ull * 1024 + (size_t)i * 8) = w;
        const int dd = i & 255, m8 = (i >> 8) & 31, h = (i >> 13) & 3, bb = i >> 15;
        const float* s = cv + ((size_t)(bb * 256 + m8 * 8) * 4 + h) * 256 + dd;
        u32x4 x; x.x = pk2(s[0], s[1024]); x.y = pk2(s[2048], s[3072]); x.z = pk2(s[4096], s[5120]); x.w = pk2(s[6144], s[7168]);
        *(u32x4*)(((bf16_t*)(F.ws + WS_KV + 6144ull * 1024 * 2)) + ((size_t)((16 + bb) * 4 + h) * 256 + dd) * 256 + m8 * 8) = x;
    }
}

DEV void g1_gdn(const Frame& F0, int l, int c, int h) {
    REFRAME;
    float* Fq = (float*)F.lds;
    bf16_t* VS = (bf16_t*)(F.lds + 66560);
    bf16_t* QN = (bf16_t*)(F.lds + 82944);
    bf16_t* KN = (bf16_t*)(F.lds + 100352);
    float* AM = (float*)(F.lds + 117760);
    float* sB = (float*)(F.lds + 135168); float* sG = sB + 64; float* sRQ = sB + 128; float* sRK = sB + 192;
    const int tid = F.tid, lane = F.lane, t0 = c * 64;
    const bool first = c >= 512 || (c & 31) == 0; const bool sample = c >= 512;
    __syncthreads();
    if (F.wid == 0) {
        const int t = t0 + lane;
        const float braw = ((float*)(F.ws + WS_SC))[(size_t)t * 32 + h], araw = ((float*)(F.ws + WS_SC))[(size_t)t * 32 + 4 + h];
        const float beta = sigm(braw);
        float g = -__expf(F.in[12][l * 4 + h]) * softplus(araw + F.in[13][l * 4 + h]);
#pragma unroll
        for (int off = 1; off < 64; off <<= 1) { const float n = __shfl_up(g, off); if (lane >= off) g += n; }
        sB[lane] = beta; sG[lane] = g;
        if (!F.dry) ((float*)(F.ws + WS_BG))[((size_t)c * 4 + h) * 128 + lane] = beta; if (!F.dry) ((float*)(F.ws + WS_BG))[((size_t)c * 4 + h) * 128 + 64 + lane] = g;
    }
    __syncthreads();
    const float* cw = F.in[11] + (size_t)l * 4 * 1536;
    if (tid < 384) {
        const int cp = tid % 192, rh = tid / 192, which = cp >> 6, cc = (cp & 63) * 2, pcol = which * 512 + h * 128 + cc;
        const f32x2 w0 = *(const f32x2*)(cw + pcol), w1 = *(const f32x2*)(cw + 1536 + pcol), w2 = *(const f32x2*)(cw + 2 * 1536 + pcol), w3 = *(const f32x2*)(cw + 3 * 1536 + pcol);
        float x0[35], x1[35];
#pragma unroll
        for (int i = 0; i < 3; ++i) {
            x0[i] = 0.f; x1[i] = 0.f;
            if (rh == 1) { const unsigned u = *(const unsigned*)(((bf16_t*)(F.ws + WS_P)) + (size_t)(t0 + 29 + i) * LDP + pcol); x0[i] = bflo(u); x1[i] = bfhi(u); }
            else if (!first) { const unsigned u = *(const unsigned*)(((bf16_t*)(F.ws + WS_KV)) + ((size_t)(c - 1) * 3 + i) * 1536 + pcol); x0[i] = bflo(u); x1[i] = bfhi(u); }
            else if (sample) { const f32x2 f = *(const f32x2*)(F.in[3] + ((size_t)(l * 8 + (c - 512)) * 3 + i) * 1536 + pcol); x0[i] = f[0]; x1[i] = f[1]; }
        }
#pragma unroll
        for (int i = 0; i < 32; ++i) { const unsigned u = *(const unsigned*)(((bf16_t*)(F.ws + WS_P)) + (size_t)(t0 + 32 * rh + i) * LDP + pcol); x0[3 + i] = bflo(u); x1[3 + i] = bfhi(u); }
#pragma unroll
        for (int r = 0; r < 32; ++r) {
            float a0 = w0[0] * x0[r] + w1[0] * x0[r + 1] + w2[0] * x0[r + 2] + w3[0] * x0[r + 3];
            float a1 = w0[1] * x1[r] + w1[1] * x1[r + 1] + w2[1] * x1[r + 2] + w3[1] * x1[r + 3];
            a0 = silu(a0); a1 = silu(a1);
            const int rr = 32 * rh + r;
            if (which < 2) { *(f32x2*)(Fq + rr * 260 + which * 128 + cc) = (f32x2){a0, a1}; }
            else { const float be = sB[rr]; *(unsigned*)(VS + rr * 128 + cc) = pk2(a0 * be, a1 * be); }
        }
    }
    __syncthreads();
    {
        const int r = tid >> 3, j = tid & 7; const float* p = Fq + r * 260 + j * 32; float s = 0.f;
#pragma unroll
        for (int i = 0; i < 32; ++i) s += p[i] * p[i];
        s += __shfl_xor(s, 1); s += __shfl_xor(s, 2);
        if ((j & 3) == 0) { if (j == 0) sRQ[r] = rsqrtf(s + 1e-6f) * 0.08838834764831845f; else sRK[r] = rsqrtf(s + 1e-6f); }
    }
    __syncthreads();
    for (int idx = tid; idx < 64 * 64; idx += 512) {
        const int r = idx >> 6, c4 = (idx & 63) * 4; const bool isq = c4 < 128;
        f32x4 v = *(const f32x4*)(Fq + r * 260 + c4); v = v * (isq ? sRQ[r] : sRK[r]);
        const u32x2 w = pk4(v);
        if (isq) { *(u32x2*)(QN + r * 136 + c4) = w; if (!F.dry) *(u32x2*)(((bf16_t*)(F.ws + WS_P)) + (size_t)(t0 + r) * LDP + C_QA + h * 128 + c4) = w; }
        else { *(u32x2*)(KN + r * 136 + c4 - 128) = w; if (!F.dry) *(u32x2*)(((bf16_t*)(F.ws + WS_P)) + (size_t)(t0 + r) * LDP + C_KA + h * 128 + c4 - 128) = w; }
    }
    for (int idx = tid; idx < 64 * 32; idx += 512) {
        const int r = idx >> 5, c4 = (idx & 31) * 4;
        if (!F.dry) *(u32x2*)(((bf16_t*)(F.ws + WS_P)) + (size_t)(t0 + r) * LDP + C_VA + h * 128 + c4) = *(const u32x2*)(VS + r * 128 + c4);
    }
    __syncthreads();
    {
        const int fr = lane & 15, fq = lane >> 4, which = F.wid >> 2, it = F.wid & 3;
        const bf16_t* X = which ? QN : KN;
        const int crow = 16 * it + fr; const float gc = sG[crow], bc = sB[crow];
        for (int jt = 0; jt < 4; ++jt) {
            f32x4 a = {0.f, 0.f, 0.f, 0.f};
            if (jt <= it) {
#pragma unroll
                for (int ks = 0; ks < 4; ++ks) a = MFMA16(ldfrag(KN, 16 * jt + fr, 136, 32 * ks, fq), ldfrag(X, crow, 136, 32 * ks, fq), a);
            }
            f32x4 o;
#pragma unroll
            for (int j = 0; j < 4; ++j) {
                const int s = 16 * jt + 4 * fq + j;
                const bool keep = which ? (s <= crow) : (s < crow);
                const float dec = keep ? __expf(gc - sG[s]) : 0.f;
                o[j] = a[j] * dec * (which ? 1.f : bc);
            }
            if (which) { if (!F.dry) *(u32x2*)(((bf16_t*)(F.ws + WS_XB)) + (size_t)(t0 + crow) * LDE + h * 128 + 64 + 16 * jt + 4 * fq) = pk4(o); }
            else *(f32x4*)(AM + crow * 68 + 16 * jt + 4 * fq) = o;
        }
    }
    __syncthreads();
    if (F.wid == 0) {
        float Tc[64]; const float lanef = (float)lane;
        typedef __attribute__((address_space(3))) const f32x4 LDSF4;
        __attribute__((address_space(3))) const char* aml = (__attribute__((address_space(3))) const char*)AM; asm volatile("" : "+v"(aml));
#pragma unroll
        for (int i = 0; i < 64; ++i) {
            float a = fmaxf(0.f, 1.f - fabsf(lanef - (float)i));
#pragma unroll
            for (int j4 = 0; j4 < (i + 3) / 4; ++j4) {
                const f32x4 av = *(const LDSF4*)(aml + (i * 68 + j4 * 4) * 4);
#pragma unroll
                for (int jj = 0; jj < 4; ++jj) if (j4 * 4 + jj < i) a -= av[jj] * Tc[j4 * 4 + jj];
            }
            Tc[i] = a;
        }
#pragma unroll
        for (int i = 0; i < 64; i += 2) {
            const unsigned w = pk2(Tc[i], Tc[i + 1]);
            if (!F.dry) ((bf16_t*)(F.ws + WS_XB))[(size_t)(t0 + i) * LDE + h * 128 + lane] = (bf16_t)(w & 0xffff);
            if (!F.dry) ((bf16_t*)(F.ws + WS_XB))[(size_t)(t0 + i + 1) * LDE + h * 128 + lane] = (bf16_t)(w >> 16);
        }
    }
}

DEV void g1_gla(const Frame& F0, int l, int c, int h) {
    REFRAME;
    float* GL = (float*)F.lds;
    float* LA = (float*)(F.lds + 4096);
    bf16_t* QG = (bf16_t*)(F.lds + 20736);
    bf16_t* KI = (bf16_t*)(F.lds + 29952);
    const int tid = F.tid, lane = F.lane, t0 = c * 64;
    __syncthreads();
    if (tid < 256) { const int r = tid >> 2, q4 = (tid & 3) * 4; *(f32x4*)(GL + r * 16 + q4) = *(const f32x4*)(((float*)(F.ws + WS_SC)) + (size_t)(t0 + r) * 32 + 8 + q4); }
    __syncthreads();
    {
        const int dk = tid & 63, rb = tid >> 6;
        float w2[16];
#pragma unroll
        for (int i = 0; i < 16; ++i) w2[i] = F.in[15][(size_t)(l * 16 + i) * 256 + h * 64 + dk];
        const float bias = F.in[16][l * 256 + h * 64 + dk];
#pragma unroll
        for (int rr = 0; rr < 8; ++rr) {
            const int r = rb * 8 + rr; float x = bias;
#pragma unroll
            for (int i = 0; i < 16; ++i) x += GL[r * 16 + i] * w2[i];
            LA[r * 65 + dk] = logsigmoid(x) * 0.0625f;
        }
    }
    __syncthreads();
    if (tid < 64) {
        float g = 0.f;
#pragma unroll 8
        for (int r = 0; r < 64; ++r) { g += LA[r * 65 + tid]; LA[r * 65 + tid] = g; }
        if (!F.dry) ((float*)(F.ws + WS_DL))[((size_t)c * 4 + h) * 64 + tid] = __expf(g);
    }
    __syncthreads();
    for (int idx = tid; idx < 64 * 16; idx += 512) {
        const int r = idx >> 4, c4 = (idx & 15) * 4;
        bf16_t* qp = ((bf16_t*)(F.ws + WS_P)) + (size_t)(t0 + r) * LDP + C_QB + h * 64 + c4; bf16_t* kp = ((bf16_t*)(F.ws + WS_P)) + (size_t)(t0 + r) * LDP + C_KB + h * 64 + c4;
        const f32x4 q = unpk4(*(const u32x2*)qp), k = unpk4(*(const u32x2*)kp);
        f32x4 qg, ki, kg;
#pragma unroll
        for (int j = 0; j < 4; ++j) { const float g = LA[r * 65 + c4 + j], gl = LA[63 * 65 + c4 + j];
            qg[j] = q[j] * 0.125f * __expf(g); ki[j] = k[j] * __expf(-g); kg[j] = k[j] * __expf(gl - g); }
        const u32x2 wq = pk4(qg);
        *(u32x2*)(QG + r * 72 + c4) = wq; *(u32x2*)(KI + r * 72 + c4) = pk4(ki);
        if (!F.dry) *(u32x2*)qp = wq; if (!F.dry) *(u32x2*)kp = pk4(kg);
    }
    __syncthreads();
    {
        const int fr = lane & 15, fq = lane >> 4, it = F.wid >> 1; const int crow = 16 * it + fr;
#pragma unroll
        for (int q = 0; q < 2; ++q) {
            const int jt = (F.wid & 1) * 2 + q;
            f32x4 a = {0.f, 0.f, 0.f, 0.f};
            if (jt <= it) {
#pragma unroll
                for (int ks = 0; ks < 2; ++ks) a = MFMA16(ldfrag(KI, 16 * jt + fr, 72, 32 * ks, fq), ldfrag(QG, crow, 72, 32 * ks, fq), a);
            }
#pragma unroll
            for (int j = 0; j < 4; ++j) if (16 * jt + 4 * fq + j > crow) a[j] = 0.f;
            if (!F.dry) *(u32x2*)(((bf16_t*)(F.ws + WS_XB)) + (size_t)(t0 + crow) * LDE + 512 + h * 64 + 16 * jt + 4 * fq) = pk4(a);
        }
    }
}

DEV void g2_gdn(const Frame& F0, int l, int s, int h) {
    REFRAME;
    bf16_t* QN = (bf16_t*)F.lds;
    bf16_t* KN = (bf16_t*)(F.lds + 17408);
    bf16_t* KT = (bf16_t*)(F.lds + 34816);
    bf16_t* TM = (bf16_t*)(F.lds + 53248);
    bf16_t* AQ = (bf16_t*)(F.lds + 62464);
    float* sB = (float*)(F.lds + 71680); float* sG = sB + 64;
    float* RED = (float*)(F.lds + 72192);
    bf16_t* VV = (bf16_t*)(F.lds + 74240);
    bf16_t* ZZ = (bf16_t*)(F.lds + 91648);
    const int tid = F.tid, lane = F.lane, w = F.wid, fr = lane & 15, fq = lane >> 4;
    const bool sample = s >= 16; const int nchunk = sample ? 1 : 32; const int tbase = sample ? 32768 + (s - 16) * 64 : s * 2048;
    const int dvc = h * 128 + 16 * w + fr;
    f32x4 S[8];
#pragma unroll
    for (int mt = 0; mt < 8; ++mt) {
        if (sample) { const float* sp = F.in[2] + ((size_t)((l * 8 + (s - 16)) * 4 + h) * 128) * 128;
#pragma unroll
            for (int j = 0; j < 4; ++j) S[mt][j] = sp[(size_t)(16 * mt + 4 * fq + j) * 128 + 16 * w + fr]; }
        else S[mt] = (f32x4){0.f, 0.f, 0.f, 0.f};
    }
    const float gn = F.in[14][l * 128 + 16 * w + fr];
    for (int n = 0; n < nchunk; ++n) {
        const int t0 = tbase + n * 64;
        __syncthreads();
#pragma unroll
        for (int i = 0; i < 2; ++i) {
            const int p = tid + 512 * i, r = p >> 4, c8 = (p & 15) * 8;
            const u32x4 q = *(const u32x4*)(((bf16_t*)(F.ws + WS_P)) + (size_t)(t0 + r) * LDP + C_QA + h * 128 + c8);
            const u32x4 k = *(const u32x4*)(((bf16_t*)(F.ws + WS_P)) + (size_t)(t0 + r) * LDP + C_KA + h * 128 + c8);
            *(u32x4*)(QN + r * 136 + c8) = q; *(u32x4*)(KN + r * 136 + c8) = k;
            *(u32x4*)(VV + r * 136 + c8) = *(const u32x4*)(((bf16_t*)(F.ws + WS_P)) + (size_t)(t0 + r) * LDP + C_VA + h * 128 + c8);
            *(u32x4*)(ZZ + r * 136 + c8) = *(const u32x4*)(((bf16_t*)(F.ws + WS_P)) + (size_t)(t0 + r) * LDP + C_ZA + h * 128 + c8);
            KT[(c8 + 0) * 72 + r] = (bf16_t)(k.x & 0xffff); KT[(c8 + 1) * 72 + r] = (bf16_t)(k.x >> 16);
            KT[(c8 + 2) * 72 + r] = (bf16_t)(k.y & 0xffff); KT[(c8 + 3) * 72 + r] = (bf16_t)(k.y >> 16);
            KT[(c8 + 4) * 72 + r] = (bf16_t)(k.z & 0xffff); KT[(c8 + 5) * 72 + r] = (bf16_t)(k.z >> 16);
            KT[(c8 + 6) * 72 + r] = (bf16_t)(k.w & 0xffff); KT[(c8 + 7) * 72 + r] = (bf16_t)(k.w >> 16);
        }
        {
            const int r = tid >> 3, c8 = (tid & 7) * 8;
            *(u32x4*)(TM + r * 72 + c8) = *(const u32x4*)(((bf16_t*)(F.ws + WS_XB)) + (size_t)(t0 + r) * LDE + h * 128 + c8);
            *(u32x4*)(AQ + r * 72 + c8) = *(const u32x4*)(((bf16_t*)(F.ws + WS_XB)) + (size_t)(t0 + r) * LDE + h * 128 + 64 + c8);
        }
        if (tid < 128) sB[tid] = ((float*)(F.ws + WS_BG))[((size_t)(t0 >> 6) * 4 + h) * 128 + tid];
        __syncthreads();
        f32x4 kS[4], qS[4], vn[4], o[4];
#pragma unroll
        for (int mt = 0; mt < 4; ++mt) { kS[mt] = (f32x4){0.f, 0.f, 0.f, 0.f}; qS[mt] = kS[mt]; vn[mt] = kS[mt]; }
#pragma unroll
        for (int ks = 0; ks < 4; ++ks) {
            const bf16x8 sf = mk8(pk4(S[2 * ks]), pk4(S[2 * ks + 1]));
#pragma unroll
            for (int mt = 0; mt < 4; ++mt) {
                kS[mt] = MFMA16(ldfragp(KN, 16 * mt + fr, 136, 32 * ks, fq), sf, kS[mt]);
                qS[mt] = MFMA16(ldfragp(QN, 16 * mt + fr, 136, 32 * ks, fq), sf, qS[mt]);
            }
        }
        const float glast = sG[63];
        f32x4 eg[4], tmp[4];
#pragma unroll
        for (int mt = 0; mt < 4; ++mt)
#pragma unroll
            for (int j = 0; j < 4; ++j) {
                const int row = 16 * mt + 4 * fq + j;
                const float e = __expf(sG[row]); eg[mt][j] = e;
                const float vv = bf2f(VV[row * 136 + 16 * w + fr]);
                tmp[mt][j] = vv - sB[row] * e * kS[mt][j];
            }
#pragma unroll
        for (int ks = 0; ks < 2; ++ks) {
            const bf16x8 tf = mk8(pk4(tmp[2 * ks]), pk4(tmp[2 * ks + 1]));
#pragma unroll
            for (int mt = 0; mt < 4; ++mt) vn[mt] = MFMA16(ldfragp(TM, 16 * mt + fr, 72, 32 * ks, fq), tf, vn[mt]);
        }
#pragma unroll
        for (int mt = 0; mt < 4; ++mt) o[mt] = eg[mt] * qS[mt];
#pragma unroll
        for (int ks = 0; ks < 2; ++ks) {
            const bf16x8 vf = mk8(pk4(vn[2 * ks]), pk4(vn[2 * ks + 1]));
#pragma unroll
            for (int mt = 0; mt < 4; ++mt) o[mt] = MFMA16(ldfragp(AQ, 16 * mt + fr, 72, 32 * ks, fq), vf, o[mt]);
        }
        const float dl = __expf(glast);
#pragma unroll
        for (int mt = 0; mt < 4; ++mt)
#pragma unroll
            for (int j = 0; j < 4; ++j) vn[mt][j] *= __expf(glast - sG[16 * mt + 4 * fq + j]);
#pragma unroll
        for (int mt = 0; mt < 8; ++mt) S[mt] = S[mt] * dl;
#pragma unroll
        for (int ks = 0; ks < 2; ++ks) {
            const bf16x8 vf = mk8(pk4(vn[2 * ks]), pk4(vn[2 * ks + 1]));
#pragma unroll
            for (int mt = 0; mt < 8; ++mt) S[mt] = MFMA16(ldfragp(KT, 16 * mt + fr, 72, 32 * ks, fq), vf, S[mt]);
        }
#pragma unroll
        for (int mt = 0; mt < 4; ++mt)
#pragma unroll
            for (int j = 0; j < 4; ++j) {
                float p = o[mt][j] * o[mt][j];
                p += __shfl_xor(p, 1); p += __shfl_xor(p, 2); p += __shfl_xor(p, 4); p += __shfl_xor(p, 8);
                if (fr == 0) RED[(16 * mt + 4 * fq + j) * 8 + w] = p;
            }
        __syncthreads();
#pragma unroll
        for (int mt = 0; mt < 4; ++mt)
#pragma unroll
            for (int j = 0; j < 4; ++j) {
                const int row = 16 * mt + 4 * fq + j;
                const f32x4 r0 = *(const f32x4*)(RED + row * 8), r1 = *(const f32x4*)(RED + row * 8 + 4);
                const float ssum = ((r0[0] + r0[1]) + (r0[2] + r0[3])) + ((r1[0] + r1[1]) + (r1[2] + r1[3]));
                const float rs = rsqrtf(ssum * (1.f / 128.f) + 1e-6f);
                bf16_t* zp = ((bf16_t*)(F.ws + WS_P)) + (size_t)(t0 + row) * LDP + C_ZA + dvc;
                const float z = bf2f(ZZ[row * 136 + 16 * w + fr]);
                if (!F.dry) *zp = (bf16_t)(pk2(o[mt][j] * rs * gn * silu(z), 0.f) & 0xffff);
            }
    }
    float* so = sample ? F.out + O_GDN_S + ((size_t)((l * 8 + (s - 16)) * 4 + h) * 128) * 128 : F.out + O_GDN_P + ((size_t)((l * 16 + s) * 4 + h) * 128) * 128;
#pragma unroll
    for (int mt = 0; mt < 8; ++mt)
#pragma unroll
        for (int j = 0; j < 4; ++j) if (!F.dry) so[(size_t)(16 * mt + 4 * fq + j) * 128 + 16 * w + fr] = S[mt][j];
}

DEV void g2_gla(const Frame& F0, int l, int s, int h) {
    REFRAME;
    bf16_t* QG = (bf16_t*)F.lds;
    bf16_t* KGT = (bf16_t*)(F.lds + 9216);
    bf16_t* AQ = (bf16_t*)(F.lds + 18432);
    float* sDL = (float*)(F.lds + 27648);
    float* RED = (float*)(F.lds + 27904);
    bf16_t* ZZ = (bf16_t*)(F.lds + 29952);
    const int tid = F.tid, lane = F.lane, w = F.wid, fr = lane & 15, fq = lane >> 4;
    const bool sample = s >= 16; const int nchunk = sample ? 1 : 32; const int tbase = sample ? 32768 + (s - 16) * 64 : s * 2048;
    const int dvc = h * 128 + 16 * w + fr;
    f32x4 S[4];
#pragma unroll
    for (int mt = 0; mt < 4; ++mt) {
        if (sample) { const float* sp = F.in[4] + ((size_t)((l * 8 + (s - 16)) * 4 + h) * 64) * 128;
#pragma unroll
            for (int j = 0; j < 4; ++j) S[mt][j] = sp[(size_t)(16 * mt + 4 * fq + j) * 128 + 16 * w + fr]; }
        else S[mt] = (f32x4){0.f, 0.f, 0.f, 0.f};
    }
    const float gn = F.in[17][l * 128 + 16 * w + fr];
    for (int n = 0; n < nchunk; ++n) {
        const int t0 = tbase + n * 64, chunk = t0 >> 6;
        __syncthreads();
        {
            const int r = tid >> 3, c8 = (tid & 7) * 8;
            *(u32x4*)(QG + r * 72 + c8) = *(const u32x4*)(((bf16_t*)(F.ws + WS_P)) + (size_t)(t0 + r) * LDP + C_QB + h * 64 + c8);
            const u32x4 k = *(const u32x4*)(((bf16_t*)(F.ws + WS_P)) + (size_t)(t0 + r) * LDP + C_KB + h * 64 + c8);
            KGT[(c8 + 0) * 72 + r] = (bf16_t)(k.x & 0xffff); KGT[(c8 + 1) * 72 + r] = (bf16_t)(k.x >> 16);
            KGT[(c8 + 2) * 72 + r] = (bf16_t)(k.y & 0xffff); KGT[(c8 + 3) * 72 + r] = (bf16_t)(k.y >> 16);
            KGT[(c8 + 4) * 72 + r] = (bf16_t)(k.z & 0xffff); KGT[(c8 + 5) * 72 + r] = (bf16_t)(k.z >> 16);
            KGT[(c8 + 6) * 72 + r] = (bf16_t)(k.w & 0xffff); KGT[(c8 + 7) * 72 + r] = (bf16_t)(k.w >> 16);
            *(u32x4*)(AQ + r * 72 + c8) = *(const u32x4*)(((bf16_t*)(F.ws + WS_XB)) + (size_t)(t0 + r) * LDE + 512 + h * 64 + c8);
        }
#pragma unroll
        for (int i = 0; i < 2; ++i) { const int p = tid + 512 * i, r = p >> 4, c8 = (p & 15) * 8;
            *(u32x4*)(ZZ + r * 136 + c8) = *(const u32x4*)(((bf16_t*)(F.ws + WS_P)) + (size_t)(t0 + r) * LDP + C_ZB + h * 128 + c8); }
        if (tid < 64) sDL[tid] = ((float*)(F.ws + WS_DL))[((size_t)chunk * 4 + h) * 64 + tid];
        bf16x8 vf[2];
#pragma unroll
        for (int ks = 0; ks < 2; ++ks) {
            unsigned e[8];
#pragma unroll
            for (int j = 0; j < 8; ++j) { const int row = 32 * ks + (j < 4 ? 4 * fq + j : 16 + 4 * fq + (j - 4)); e[j] = ((bf16_t*)(F.ws + WS_P))[(size_t)(t0 + row) * LDP + C_VB + dvc]; }
            u32x4 t; t.x = e[0] | (e[1] << 16); t.y = e[2] | (e[3] << 16); t.z = e[4] | (e[5] << 16); t.w = e[6] | (e[7] << 16);
            vf[ks] = __builtin_bit_cast(bf16x8, t);
        }
        __syncthreads();
        f32x4 o[4];
#pragma unroll
        for (int mt = 0; mt < 4; ++mt) o[mt] = (f32x4){0.f, 0.f, 0.f, 0.f};
#pragma unroll
        for (int ks = 0; ks < 2; ++ks) {
            const bf16x8 sf = mk8(pk4(S[2 * ks]), pk4(S[2 * ks + 1]));
#pragma unroll
            for (int mt = 0; mt < 4; ++mt) {
                o[mt] = MFMA16(ldfragp(QG, 16 * mt + fr, 72, 32 * ks, fq), sf, o[mt]);
                o[mt] = MFMA16(ldfragp(AQ, 16 * mt + fr, 72, 32 * ks, fq), vf[ks], o[mt]);
            }
        }
#pragma unroll
        for (int mt = 0; mt < 4; ++mt) {
#pragma unroll
            for (int j = 0; j < 4; ++j) S[mt][j] *= sDL[16 * mt + 4 * fq + j];
#pragma unroll
            for (int ks = 0; ks < 2; ++ks) S[mt] = MFMA16(ldfragp(KGT, 16 * mt + fr, 72, 32 * ks, fq), vf[ks], S[mt]);
        }
#pragma unroll
        for (int mt = 0; mt < 4; ++mt)
#pragma unroll
            for (int j = 0; j < 4; ++j) {
                float p = o[mt][j] * o[mt][j];
                p += __shfl_xor(p, 1); p += __shfl_xor(p, 2); p += __shfl_xor(p, 4); p += __shfl_xor(p, 8);
                if (fr == 0) RED[(16 * mt + 4 * fq + j) * 8 + w] = p;
            }
        __syncthreads();
#pragma unroll
        for (int mt = 0; mt < 4; ++mt)
#pragma unroll
            for (int j = 0; j < 4; ++j) {
                const int row = 16 * mt + 4 * fq + j;
                const f32x4 r0 = *(const f32x4*)(RED + row * 8), r1 = *(const f32x4*)(RED + row * 8 + 4);
                const float ssum = ((r0[0] + r0[1]) + (r0[2] + r0[3])) + ((r1[0] + r1[1]) + (r1[2] + r1[3]));
                const float rs = rsqrtf(ssum * (1.f / 128.f) + 1e-6f);
                bf16_t* zp = ((bf16_t*)(F.ws + WS_P)) + (size_t)(t0 + row) * LDP + C_ZB + dvc;
                const float z = bf2f(ZZ[row * 136 + 16 * w + fr]);
                if (!F.dry) *zp = (bf16_t)(pk2(o[mt][j] * rs * gn * silu(z), 0.f) & 0xffff);
            }
    }
    float* so = sample ? F.out + O_GLA_S + ((size_t)((l * 8 + (s - 16)) * 4 + h) * 64) * 128 : F.out + O_GLA_P + ((size_t)((l * 16 + s) * 4 + h) * 64) * 128;
#pragma unroll
    for (int mt = 0; mt < 4; ++mt)
#pragma unroll
        for (int j = 0; j < 4; ++j) if (!F.dry) so[(size_t)(16 * mt + 4 * fq + j) * 128 + 16 * w + fr] = S[mt][j];
}

DEV void unpack8(u32x4 u, float (&f)[8]) { f[0] = bflo(u.x); f[1] = bfhi(u.x); f[2] = bflo(u.y); f[3] = bfhi(u.y); f[4] = bflo(u.z); f[5] = bfhi(u.z); f[6] = bflo(u.w); f[7] = bfhi(u.w); }
DEV void load8f(const float* p, float (&f)[8]) { const f32x4 a = *(const f32x4*)p, b = *(const f32x4*)(p + 4); f[0] = a[0]; f[1] = a[1]; f[2] = a[2]; f[3] = a[3]; f[4] = b[0]; f[5] = b[1]; f[6] = b[2]; f[7] = b[3]; }
DEV void ffn_mid(const Frame& F0, int l) {
    REFRAME;
    const float* cw = F.in[29] + (size_t)l * 3 * 5632; const float* cb = F.in[30] + (size_t)l * 5632;
    const int total = NCH * 352;
    for (int idx = F.bid * 512 + F.tid; idx < total; idx += F.nb * 512) {
        const int c = idx / 352, col = (idx % 352) * 8;
        const bool first = c >= 512 || (c & 31) == 0, sample = c >= 512;
        float g2[8], g1[8], v2[8], v1[8];
#pragma unroll
        for (int j = 0; j < 8; ++j) { g2[j] = 0.f; g1[j] = 0.f; v2[j] = 0.f; v1[j] = 0.f; }
        if (!first) {
            const bf16_t* hp = ((bf16_t*)(F.ws + WS_KV)) + (size_t)(c - 1) * 2 * 5632;
            unpack8(*(const u32x4*)(hp + col), g2); unpack8(*(const u32x4*)(hp + 5632 + col), g1);
            unpack8(*(const u32x4*)(hp + 2816 + col), v2); unpack8(*(const u32x4*)(hp + 5632 + 2816 + col), v1);
        } else if (sample) {
            const float* sp = F.in[5] + (size_t)(l * 8 + (c - 512)) * 2 * 5632;
            load8f(sp + col, g2); load8f(sp + 5632 + col, g1); load8f(sp + 2816 + col, v2); load8f(sp + 5632 + 2816 + col, v1);
        }
        float wg0[8], wg1[8], wg2[8], bg[8], wv0[8], wv1[8], wv2[8], bv[8];
        load8f(cw + col, wg0); load8f(cw + 5632 + col, wg1); load8f(cw + 2 * 5632 + col, wg2); load8f(cb + col, bg);
        load8f(cw + 2816 + col, wv0); load8f(cw + 5632 + 2816 + col, wv1); load8f(cw + 2 * 5632 + 2816 + col, wv2); load8f(cb + 2816 + col, bv);
        bf16_t* up = ((bf16_t*)(F.ws + WS_P)) + (size_t)c * 64 * LDP + col;
#pragma unroll 4
        for (int r = 0; r < 64; ++r) {
            float g0[8], v0[8], o[8];
            unpack8(*(const u32x4*)(up + (size_t)r * LDP), g0); unpack8(*(const u32x4*)(up + (size_t)r * LDP + 2816), v0);
#pragma unroll
            for (int j = 0; j < 8; ++j) {
                const float yg = wg0[j] * g2[j] + wg1[j] * g1[j] + wg2[j] * g0[j] + bg[j];
                const float yv = wv0[j] * v2[j] + wv1[j] * v1[j] + wv2[j] * v0[j] + bv[j];
                o[j] = silu(yg) * yv;
                g2[j] = g1[j]; g1[j] = g0[j]; v2[j] = v1[j]; v1[j] = v0[j];
            }
            u32x4 w; w.x = pk2(o[0], o[1]); w.y = pk2(o[2], o[3]); w.z = pk2(o[4], o[5]); w.w = pk2(o[6], o[7]);
            if (!F.dry) *(u32x4*)(up + (size_t)r * LDP) = w;
        }
    }
}

DEV void final_norm(const Frame& F0) {
    REFRAME;
    const int gw = F.bid * 8 + F.wid, nw = F.nb * 8, lane = F.lane;
    const float* g = F.in[32];
    for (int row = gw; row < TT; row += nw) {
        const float rs = row_rstd(((float*)(F.ws + WS_SSQ)), row);
        float* X = F.out + (size_t)row * 1024;
#pragma unroll
        for (int i = 0; i < 4; ++i) { const int cidx = i * 256 + lane * 4; f32x4 v = *(const f32x4*)(X + cidx); const f32x4 gg = *(const f32x4*)(g + cidx); *(f32x4*)(X + cidx) = v * rs * gg; }
    }
}

#ifdef DBG_COL
DEV void dbg_dump(const Frame& F0) {
    REFRAME;
    for (int i = F.bid * 512 + F.tid; i < TT * 256; i += F.nb * 512) {
        const int row = i >> 8, c = (i & 255) * 4;
        const f32x4 v = c < 512 ? unpk4(*(const u32x2*)(((bf16_t*)(F.ws + WS_P)) + (size_t)row * LDP + DBG_COL + c)) : (f32x4){0.f, 0.f, 0.f, 0.f};
        *(f32x4*)(F.out + (size_t)row * 1024 + c) = (row DBG_ROWSEL) ? v : (f32x4){0.f, 0.f, 0.f, 0.f};
    }
}
#endif
#define XB_TMO      128
#define XB_XCNT(j)  (256  + 64 * (j))
#define XB_XSUB(j)  (1280 + 64 * (j))
#define XB_XGEN(j)  (2304 + 64 * (j))
#define XB_TOP      3328
#define XB_TOPGEN   3392
#define XCD_BAR_WORDS 3456
#define XB_SPIN_CAP (1u << 18)
#define LAS __attribute__((address_space(3)))

__device__ __forceinline__ unsigned xb_ld(unsigned* p)              { return __hip_atomic_load(p, __ATOMIC_RELAXED, __HIP_MEMORY_SCOPE_AGENT); }
__device__ __forceinline__ unsigned xb_add(unsigned* p, unsigned v) { return __hip_atomic_fetch_add(p, v, __ATOMIC_RELAXED, __HIP_MEMORY_SCOPE_AGENT); }
__device__ __forceinline__ unsigned xb_xcc_id() { return (unsigned)__builtin_amdgcn_s_getreg((3 << 11) | 20) & 0xFu; }
#define XB_SPIN(cond, bar) do { unsigned _sp = 0; while (cond) { __builtin_amdgcn_s_sleep(1); \
    if ((++_sp & 255u) == 0u) { if (xb_ld(&(bar)[XB_TMO])) break; if (_sp > XB_SPIN_CAP) { atomicAdd(&(bar)[XB_TMO], 1u); break; } } } } while (0)

struct XcdBarrier {
    unsigned* bar; unsigned x;
    volatile LAS unsigned* st;
};

__device__ __forceinline__ XcdBarrier xcd_barrier_post(unsigned* bar, volatile LAS unsigned* st) {
    XcdBarrier b; b.bar = bar; b.x = xb_xcc_id(); b.st = st;
    if (threadIdx.x == 0) (void)xb_add(&bar[XB_XCNT(b.x)], 1u);
    return b;
}
__device__ __forceinline__ void xcd_barrier_complete(unsigned* bar, unsigned x, unsigned& nloc, unsigned& nx) {
    const unsigned G = gridDim.x * gridDim.y * gridDim.z;
    unsigned sum, cnt, mine, sp = 0u;
    for (;;) {
        sum = 0u; cnt = 0u; mine = 0u;
#pragma unroll
        for (unsigned j = 0; j < 16; ++j) { const unsigned c = xb_ld(&bar[XB_XCNT(j)]); sum += c; cnt += (c > 0u) ? 1u : 0u; mine = (j == x) ? c : mine; }
        if (sum == G) break;
        __builtin_amdgcn_s_sleep(1);
        if ((++sp & 255u) == 0u) { if (xb_ld(&bar[XB_TMO])) break; if (sp > XB_SPIN_CAP) { atomicAdd(&bar[XB_TMO], 1u); break; } }
    }
    nloc = mine > 0u ? mine : 1u; nx = cnt > 0u ? cnt : 1u;
}

__device__ __forceinline__ void xcd_barrier(const XcdBarrier& b) {
    asm volatile("s_waitcnt vmcnt(0)" ::: "memory");
    __syncthreads();
    if (threadIdx.x == 0) {
        unsigned* bar = b.bar;
        __builtin_amdgcn_s_waitcnt(0);
        unsigned nloc = b.st[0], nx = b.st[1];
        if (nloc == 0u) { xcd_barrier_complete(bar, b.x, nloc, nx); b.st[0] = nloc; b.st[1] = nx; }
        const unsigned old = xb_add(&bar[XB_XSUB(b.x)], 1u);
        const unsigned gen = old / nloc;
        if (old + 1u == (gen + 1u) * nloc) {
            __builtin_amdgcn_fence(__ATOMIC_RELEASE, "agent");
            asm volatile("s_waitcnt vmcnt(0)" ::: "memory");
            const unsigned og = xb_add(&bar[XB_TOP], 1u);
            const unsigned tg = og / nx;
            if (og + 1u == (tg + 1u) * nx) xb_add(&bar[XB_TOPGEN], 1u);
            else XB_SPIN(xb_ld(&bar[XB_TOPGEN]) == tg, bar);
            __builtin_amdgcn_fence(__ATOMIC_ACQUIRE, "agent");
            xb_add(&bar[XB_XGEN(b.x)], 1u);
            asm volatile("s_waitcnt vmcnt(0)" ::: "memory");
        } else {
            XB_SPIN(xb_ld(&bar[XB_XGEN(b.x)]) == gen, bar);
            __builtin_amdgcn_fence(__ATOMIC_ACQUIRE, "agent");
            asm volatile("s_waitcnt vmcnt(0)" ::: "memory");
        }
    }
    __syncthreads();
}

__global__ void __launch_bounds__(512, 2) fwd_kernel(Params p) {
    extern __shared__ __attribute__((aligned(16))) unsigned char lds[];
    cg::grid_group grid = cg::this_grid();
    Frame F;
    F.in = (InTab)__builtin_amdgcn_kernarg_segment_ptr(); F.out = p.out; F.ws = p.ws; F.lds = lds;
    F.tid = threadIdx.x; F.lane = threadIdx.x & 63; F.wid = __builtin_amdgcn_readfirstlane(threadIdx.x >> 6); F.nb = gridDim.x; F.bid = blockIdx.x; F.dry = 0;
    volatile LAS unsigned* xst = (volatile LAS unsigned*)(lds + LDS_BYTES - 16);
    if (threadIdx.x == 0) { xst[0] = 0u; xst[1] = 0u; }
    __syncthreads();
    const XcdBarrier xbar = xcd_barrier_post((unsigned*)(p.ws + WS_BAR), xst);
    for (int ph = p.ph_lo; ph < p.ph_hi; ++ph) {
#ifndef PHM
#define PHM 0xffff
#endif
        if (ph == 0) { if (PHM & 0x1000) phase0(F); }
        else if (ph == NPH - 1) { if (PHM & 0x2000) final_norm(F); }
        else {
            const int l = (ph - 1) / 13, k = (ph - 1) % 13;
            int gk = -1;
            switch (k) { case 0: gk = GP_IN; break; case 3: gk = GP_OUT; break; case 4: gk = GP_OUT2; break; case 5: gk = GP_WO; break; case 6: gk = GP_MQ; break; case 7: gk = GP_ATTN; break; case 8: gk = GP_ATTN2; break;
                         case 9: gk = GP_MO; break; case 10: gk = GP_UP; break; case 12: gk = GP_DOWN; break; default: break; }
#ifndef REPMASK
#define REPMASK 0
#endif
            if (gk >= 0 && (PHM & 1)) { const int nrep = ((REPMASK >> k) & 1) ? 2 : 1; for (int rep = 0; rep < nrep; ++rep) gemm_phase(F, gk, l); }
            if (k == 0 && (PHM & 1)) small_proj(F);
            if (k == 3 && (PHM & 8)) sample_kv(F, l);
#ifndef DRYMASK
#define DRYMASK 0
#endif
            for (int dr = ((DRYMASK >> k) & 1); dr >= 0; --dr) {
            F.dry = dr;
            if (k == 1 && (PHM & 2)) {
                for (int it = F.bid; it < NCH * 8; it += F.nb) { const int c = it >> 3, h = it & 3; if (it & 4) g1_gla(F, l, c, h); else g1_gdn(F, l, c, h); }
                __syncthreads();
                if (l > 0 && !dr) cvt_ffn(F, l);
            }
            if (k == 2 && (PHM & 4)) {
                for (int it = F.bid; it < 192; it += F.nb) {
                    int s, h, br;
                    if (it < 128) { br = it & 1; h = (it >> 1) & 3; s = it >> 3; } else { const int v = it - 128; br = v & 1; h = (v >> 1) & 3; s = 16 + (v >> 3); }
                    if (br) g2_gla(F, l, s, h); else g2_gdn(F, l, s, h);
                    __syncthreads();
                }
            }
            if (k == 11 && (PHM & 0x200)) { ffn_mid(F, l); if (l < 3 && !dr) { __syncthreads(); cvt_mixer(F, l + 1); } }
            }
            F.dry = 0;
        }
#ifndef SYNCREP
#define SYNCREP 1
#endif
        if (ph + 1 < p.ph_hi) {
            if (ph == 0) grid.sync();
            else xcd_barrier(xbar);
        }
    }
#ifdef DBG_COL
    __threadfence(); grid.sync(); __threadfence();
    dbg_dump(F);
#endif
}

extern "C" void kernel_launch(void* const* d_in, const int* in_sizes, int n_in, void* d_out, int out_size, void* d_ws, size_t ws_size, hipStream_t stream) {
    static int grid_blocks = 0;
    if (grid_blocks == 0) {
        if (n_in != 33 || ws_size < WS_TOTAL) { fprintf(stderr, "kernel_launch: bad n_in %d or ws %zu < %zu\n", n_in, ws_size, (size_t)WS_TOTAL); grid_blocks = -1; return; }
        int dev = 0, cus = 0, per_cu = 0;
        hipGetDevice(&dev);
        hipDeviceGetAttribute(&cus, hipDeviceAttributeMultiprocessorCount, dev);
        if (hipFuncSetAttribute((const void*)fwd_kernel, hipFuncAttributeMaxDynamicSharedMemorySize, LDS_BYTES) != hipSuccess) { fprintf(stderr, "hipFuncSetAttribute failed\n"); grid_blocks = -1; return; }
        hipOccupancyMaxActiveBlocksPerMultiprocessor(&per_cu, (const void*)fwd_kernel, 512, LDS_BYTES);
        if (per_cu < 1) per_cu = 1;
        (void)hipGetLastError();
        grid_blocks = cus * 1;
        if (grid_blocks <= 0) grid_blocks = 256;
    }
    if (grid_blocks < 0) return;
    Params p{};
    for (int i = 0; i < 33; ++i) p.in[i] = (const float*)d_in[i];
    p.out = (float*)d_out; p.ws = (unsigned char*)d_ws; p.ph_lo = 0; p.ph_hi = PH_HI;
    (void)hipMemsetAsync((unsigned char*)d_ws + WS_BAR, 0, 16384, stream);
    void* args[] = {&p};
    hipError_t e = hipLaunchCooperativeKernel((const void*)fwd_kernel, dim3(grid_blocks), dim3(512), args, LDS_BYTES, stream);
    if (e != hipSuccess) fprintf(stderr, "cooperative launch failed: %s (grid %d)\n", hipGetErrorString(e), grid_blocks);
}
```

```cpp
#include <hip/hip_runtime.h>
#include <hip/hip_cooperative_groups.h>
#include <cstdint>
#include <cstdio>
namespace cg = cooperative_groups;

typedef unsigned short bf16_t;
typedef short bf16x8 __attribute__((ext_vector_type(8)));
typedef float f32x4 __attribute__((ext_vector_type(4)));
typedef float f32x2 __attribute__((ext_vector_type(2)));
typedef unsigned u32x2 __attribute__((ext_vector_type(2)));
typedef unsigned u32x4 __attribute__((ext_vector_type(4)));
#define DEV __device__ __forceinline__

constexpr int DM = 1024, TT = 33280, NCH = 520, LDP = 5632, LDE = 768;
constexpr int C_QA = 0, C_KA = 512, C_VA = 1024, C_ZA = 1536, C_QB = 2048, C_KB = 2304, C_VB = 2560, C_ZB = 3072, C_GA = 3584, C_GB = 4608;
constexpr int C_MRG = 0, C_PR = 1024, C_Q = 2048, C_O = 3072;
constexpr size_t O_Y = 0;
constexpr size_t O_GDN_P = 34078720ull;
constexpr size_t O_GDNC_P = O_GDN_P + 4194304ull;
constexpr size_t O_GLA_P = O_GDNC_P + 294912ull;
constexpr size_t O_FFNC_P = O_GLA_P + 2097152ull;
constexpr size_t O_MEMK = O_FFNC_P + 720896ull;
constexpr size_t O_MEMV = O_MEMK + 16777216ull;
constexpr size_t O_GDN_S = O_MEMV + 16777216ull;
constexpr size_t O_GDNC_S = O_GDN_S + 2097152ull;
constexpr size_t O_GLA_S = O_GDNC_S + 147456ull;
constexpr size_t O_FFNC_S = O_GLA_S + 1048576ull;
constexpr size_t al256(size_t x) { return (x + 255) & ~(size_t)255; }
constexpr size_t WS_WMIX = 0;
constexpr size_t WM_WIN = 0, WM_WSM = WM_WIN + 5632ull * 1024, WM_WOA = WM_WSM + 32 * 1024, WM_WOB = WM_WOA + 524288, WM_WO = WM_WOB + 524288,
                 WM_WMQ = WM_WO + 1048576, WM_WMK = WM_WMQ + 1048576, WM_WMV = WM_WMK + 1048576, WM_WMO = WM_WMV + 1048576, WM_END = WM_WMO + 1048576;
constexpr size_t WS_WFFN = al256(WS_WMIX + WM_END * 2);
constexpr size_t WF_UP = 0, WF_DN = 5632ull * 1024, WF_END = WF_DN + 1024ull * 2816;
constexpr size_t WS_XB = al256(WS_WFFN + WF_END * 2);
constexpr size_t WS_P = al256(WS_XB + (size_t)TT * 1024 * 2);
constexpr size_t WS_KV = al256(WS_P + (size_t)TT * LDP * 2);
constexpr size_t KV_BYTES = 2ull * 6144 * 1024 * 2;
constexpr size_t WS_MB = al256(WS_KV + KV_BYTES);
constexpr size_t WS_MRS = al256(WS_MB + 4096ull * 1024 * 2);
constexpr size_t WS_SSQ = al256(WS_MRS + 4096 * 4);
constexpr size_t WS_SC = al256(WS_SSQ + (size_t)TT * 16 * 4);
constexpr size_t WS_DL = al256(WS_SC + (size_t)TT * 32 * 4);
constexpr size_t WS_BG = al256(WS_DL + 520ull * 4 * 64 * 4);
constexpr size_t WS_BAR = al256(WS_BG + 520ull * 4 * 128 * 4);
constexpr size_t WS_TOTAL = al256(WS_BAR + 16384);
constexpr int LDS_BYTES = 147456;
constexpr int NPH = 54;
#ifndef PH_HI
#define PH_HI NPH
#define REPMASK 0
#define SYNCREP 1
#define DRYMASK 0
#endif

struct Params { const float* in[33]; float* out; unsigned char* ws; int ph_lo, ph_hi; };

typedef __bf16 bf16x2_t __attribute__((ext_vector_type(2)));
DEV unsigned pk2(float lo, float hi) { f32x2 f = {lo, hi}; bf16x2_t v = __builtin_convertvector(f, bf16x2_t); return __builtin_bit_cast(unsigned, v); }
DEV float bf2f(bf16_t b) { return __uint_as_float(((unsigned)b) << 16); }
DEV float bflo(unsigned u) { return __uint_as_float(u << 16); }
DEV float bfhi(unsigned u) { return __uint_as_float(u & 0xffff0000u); }
DEV u32x2 pk4(f32x4 v) { u32x2 r; r.x = pk2(v[0], v[1]); r.y = pk2(v[2], v[3]); return r; }
DEV f32x4 unpk4(u32x2 u) { return (f32x4){bflo(u.x), bfhi(u.x), bflo(u.y), bfhi(u.y)}; }
DEV bf16x8 mk8(u32x2 a, u32x2 b) { u32x4 t = {a.x, a.y, b.x, b.y}; return __builtin_bit_cast(bf16x8, t); }
DEV float sigm(float x) { return 1.f / (1.f + __expf(-x)); }
DEV float silu(float x) { return x / (1.f + __expf(-x)); }
DEV float softplus(float x) { return x > 20.f ? x : __logf(1.f + __expf(x)); }
DEV float logsigmoid(float x) { return fminf(x, 0.f) - __logf(1.f + __expf(-fabsf(x))); }
DEV float row_rstd(const float* ssq, int row) {
    const f32x4 a = *(const f32x4*)(ssq + (size_t)row * 4), b = *(const f32x4*)(ssq + ((size_t)TT + row) * 4);
    const f32x4 c = *(const f32x4*)(ssq + ((size_t)2 * TT + row) * 4), d = *(const f32x4*)(ssq + ((size_t)3 * TT + row) * 4);
    float s = ((a[0] + a[1]) + (a[2] + a[3])) + ((b[0] + b[1]) + (b[2] + b[3])) + ((c[0] + c[1]) + (c[2] + c[3])) + ((d[0] + d[1]) + (d[2] + d[3]));
    return rsqrtf(s * (1.f / 1024.f) + 1e-6f);
}
DEV bf16x8 ldfragp(const bf16_t* base, int row, int stride, int k0, int fq) {
    const bf16_t* p = base + row * stride + k0 + 4 * fq;
    return mk8(*(const u32x2*)p, *(const u32x2*)(p + 16));
}
DEV bf16x8 ldfrag(const bf16_t* base, int row, int stride, int k0, int fq) {
    return *(const bf16x8*)(base + row * stride + k0 + 8 * fq);
}
#define MFMA16(a, b, c) __builtin_amdgcn_mfma_f32_16x16x32_bf16((a), (b), (c), 0, 0, 0)

constexpr int BM = 256, BK = 64, HALF = 128, HT = HALF * BK;
DEV int lds_byte(int r, int c) { int st = (r >> 4) * 2 + (c >> 5), rr = r & 15, cc = c & 31, ob = rr * 64 + cc * 2; return st * 1024 + (ob ^ (((ob >> 9) & 1) << 5)); }
DEV void stage_rc(int b, int& R, int& C) { int st = b / 1024, sb = b % 1024, swz = sb ^ (((sb >> 9) & 1) << 5); R = (st >> 1) * 16 + swz / 64; C = (st & 1) * 32 + (swz % 64) / 2; }

DEV void gemm_core(const bf16_t* __restrict__ A, int lda, const bf16_t* __restrict__ Bt, int ldb, int K, int brow, int bcol, f32x4 (&acc)[2][2][4][2], bf16_t* shm) {
#define SA(b, h) (shm + ((b) * 2 + (h)) * HT)
#define SB(b, h) (shm + (4 + (b) * 2 + (h)) * HT)
#define STAGE(P, BASE, LD, br, kt) do { const char* _gb = (const char*)((BASE) + (long)(br) * (LD) + (long)(kt) * BK); \
    const unsigned _vo = (unsigned)((sr0 * (int)(LD) + sc0) * 2); \
    for (int _i = 0; _i < 2; ++_i) { \
      __builtin_amdgcn_global_load_lds((const unsigned*)(_gb + (long)(_i * 128) * (LD) + _vo), (unsigned*)((char*)(P) + wbase + _i * 8192), 16, 0, 0); } } while (0)
#define LDA(dst, b, h) for (int m = 0; m < 4; ++m) for (int k = 0; k < 2; ++k) \
    dst[m][k] = *reinterpret_cast<const bf16x8*>((char*)SA(b, h) + lds_byte(wr * 64 + m * 16 + fr, k * 32 + fq * 8))
#define LDB(dst, b, h) for (int n = 0; n < 2; ++n) for (int k = 0; k < 2; ++k) \
    dst[n][k] = *reinterpret_cast<const bf16x8*>((char*)SB(b, h) + lds_byte(wc * 32 + n * 16 + fr, k * 32 + fq * 8))
#define MMA(ai, bj, At_, Bt_) do { __builtin_amdgcn_s_setprio(1); \
    for (int m = 0; m < 4; ++m) for (int n = 0; n < 2; ++n) for (int k = 0; k < 2; ++k) \
      acc[ai][bj][m][n] = __builtin_amdgcn_mfma_f32_16x16x32_bf16(Bt_[n][k], At_[m][k], acc[ai][bj][m][n], 0, 0, 0); \
    __builtin_amdgcn_s_setprio(0); } while (0)
#define WAIT_V(n) asm volatile("s_waitcnt vmcnt(" #n ")" ::: "memory")
#define WAIT_L(n) asm volatile("s_waitcnt lgkmcnt(" #n ")" ::: "memory")
#define BAR __builtin_amdgcn_s_barrier()
#define SCHED __builtin_amdgcn_sched_barrier(0)
    int tidx = threadIdx.x; asm volatile("" : "+v"(tidx));
    const int wid = __builtin_amdgcn_readfirstlane(tidx >> 6), lane = tidx & 63, wr = wid >> 2, wc = wid & 3, fr = lane & 15, fq = lane >> 4;
    const int wbase = wid * 1024;
    int sr0, sc0; stage_rc(tidx * 16, sr0, sc0);
#pragma unroll
    for (int a = 0; a < 2; ++a)
#pragma unroll
        for (int b = 0; b < 2; ++b)
#pragma unroll
            for (int m = 0; m < 4; ++m)
#pragma unroll
                for (int n = 0; n < 2; ++n) acc[a][b][m][n] = (f32x4){0.f, 0.f, 0.f, 0.f};
    bf16x8 At[4][2], B0[2][2], B1[2][2];
    const int nt = K / BK;
    STAGE(SB(0, 0), Bt, ldb, bcol, 0); STAGE(SA(0, 0), A, lda, brow, 0);
    STAGE(SB(0, 1), Bt, ldb, bcol + HALF, 0); STAGE(SA(0, 1), A, lda, brow + HALF, 0);
    if (wr == 1) BAR;
    WAIT_V(4); BAR;
    STAGE(SB(1, 0), Bt, ldb, bcol, 1); STAGE(SA(1, 0), A, lda, brow, 1); STAGE(SB(1, 1), Bt, ldb, bcol + HALF, 1);
    WAIT_V(6); BAR;
    for (int t = 0; t < nt - 2; t += 2) {
        LDB(B0, 0, 0); SCHED; LDA(At, 0, 0); STAGE(SA(1, 1), A, lda, brow + HALF, t + 1);
        WAIT_L(8); BAR; WAIT_L(0); MMA(0, 0, At, B0); BAR; SCHED;
        LDB(B1, 0, 1); STAGE(SB(0, 0), Bt, ldb, bcol, t + 2);
        BAR; WAIT_L(0); MMA(0, 1, At, B1); BAR;
        LDA(At, 0, 1); STAGE(SA(0, 0), A, lda, brow, t + 2);
        BAR; WAIT_L(0); MMA(1, 0, At, B0); BAR; SCHED;
        STAGE(SB(0, 1), Bt, ldb, bcol + HALF, t + 2);
        WAIT_V(6); BAR; MMA(1, 1, At, B1); BAR;
        LDB(B0, 1, 0); SCHED; LDA(At, 1, 0); STAGE(SA(0, 1), A, lda, brow + HALF, t + 2);
        WAIT_L(8); BAR; WAIT_L(0); MMA(0, 0, At, B0); BAR; SCHED;
        LDB(B1, 1, 1); STAGE(SB(1, 0), Bt, ldb, bcol, t + 3);
        BAR; WAIT_L(0); MMA(0, 1, At, B1); BAR;
        LDA(At, 1, 1); STAGE(SA(1, 0), A, lda, brow, t + 3);
        BAR; WAIT_L(0); MMA(1, 0, At, B0); BAR; SCHED;
        STAGE(SB(1, 1), Bt, ldb, bcol + HALF, t + 3);
        WAIT_V(6); BAR; MMA(1, 1, At, B1); BAR;
    }
    { LDB(B0, 0, 0); LDA(At, 0, 0); STAGE(SA(1, 1), A, lda, brow + HALF, nt - 1);
      BAR; WAIT_L(0); MMA(0, 0, At, B0); BAR;
      LDB(B1, 0, 1); BAR; WAIT_L(0); MMA(0, 1, At, B1); BAR;
      LDA(At, 0, 1); WAIT_V(4); BAR; WAIT_L(0); MMA(1, 0, At, B0); MMA(1, 1, At, B1); BAR; }
    { LDB(B0, 1, 0); LDA(At, 1, 0); WAIT_V(2); BAR; WAIT_L(0); MMA(0, 0, At, B0); BAR;
      LDB(B1, 1, 1); WAIT_V(0); BAR; WAIT_L(0); MMA(0, 1, At, B1); BAR;
      LDA(At, 1, 1); BAR; WAIT_L(0); MMA(1, 0, At, B0); MMA(1, 1, At, B1); BAR; }
    if (wr == 0) BAR;
    SCHED;
#undef SA
#undef SB
}

typedef const float* const __attribute__((address_space(4)))* InTab;
struct Frame {
    InTab in; float* out; unsigned char* ws; unsigned char* lds;
    int tid, lane, wid, nb, bid, dry;
};
#define REFRAME Frame F = F0; { int t_ = threadIdx.x; asm volatile("" : "+v"(t_)); F.tid = t_; F.lane = t_ & 63; unsigned char* w_ = F.ws; asm volatile("" : "+s"(w_)); F.ws = w_; float* o_ = F.out; asm volatile("" : "+s"(o_)); F.out = o_; InTab i_ = (InTab)__builtin_amdgcn_kernarg_segment_ptr(); asm volatile("" : "+s"(i_)); F.in = i_; int a_ = F.wid, b_ = F.bid, c_ = F.nb; asm volatile("" : "+s"(a_), "+s"(b_), "+s"(c_)); F.wid = a_; F.bid = b_; F.nb = c_; }

enum { EPI_PROJ = 0, EPI_UP, EPI_RESID, EPI_Q, EPI_MEMK, EPI_MEMV, EPI_OUTA, EPI_OUTB, EPI_SOFTMAX, EPI_ATTNO };
struct GDesc { const bf16_t* A; int lda; const bf16_t* Bt; int ldb; int K, brow, bcol, epi, orow, ocol, head, vai, vwr; };

DEV void cvt_mat(const Frame& F0, const float* src, int ldsrc, int K, int N, int wincols, const float* gain, bf16_t* dst) {
    REFRAME;
    float* T = (float*)F.lds;
    const int nkt = K / 64, nnt = N / 64, ntile = nkt * nnt;
    for (int t = F.bid; t < ntile; t += F.nb) {
        const int kt = t / nnt, ntl = t % nnt, k0 = kt * 64, n0 = ntl * 64;
        int coff = 0; if (wincols == 1) coff = (n0 < 1536) ? 0 : (n0 < 3072 ? 8 : 24);
        if (wincols == 2) { const int tl = n0 >> 8, w = n0 & 255; coff = (w < 128 ? 128 * tl + w : 2816 + 128 * tl + (w - 128)) - n0; }
        __syncthreads();
#pragma unroll
        for (int i = 0; i < 2; ++i) {
            const int kr = (F.tid >> 4) + 32 * i, nc = (F.tid & 15) * 4;
            f32x4 v = *(const f32x4*)(src + (size_t)(k0 + kr) * ldsrc + n0 + coff + nc);
            const float g = gain ? gain[k0 + kr] : 1.f;
            T[kr * 65 + nc + 0] = v[0] * g; T[kr * 65 + nc + 1] = v[1] * g; T[kr * 65 + nc + 2] = v[2] * g; T[kr * 65 + nc + 3] = v[3] * g;
        }
        __syncthreads();
        const int n = F.tid >> 3, kc = (F.tid & 7) * 8;
        u32x4 w;
        w.x = pk2(T[(kc + 0) * 65 + n], T[(kc + 1) * 65 + n]); w.y = pk2(T[(kc + 2) * 65 + n], T[(kc + 3) * 65 + n]);
        w.z = pk2(T[(kc + 4) * 65 + n], T[(kc + 5) * 65 + n]); w.w = pk2(T[(kc + 6) * 65 + n], T[(kc + 7) * 65 + n]);
        *(u32x4*)(dst + (size_t)(n0 + n) * K + k0 + kc) = w;
    }
    __syncthreads();
}
DEV void cvt_mixer(const Frame& F0, int l) {
    REFRAME;
    InTab in = F.in;
    cvt_mat(F, in[10] + (size_t)l * 1024 * 5656, 5656, 1024, 5632, 1, in[9] + l * 1024, ((bf16_t*)(F.ws + WS_WMIX)) + WM_WIN);
    cvt_mat(F, in[18] + (size_t)l * 512 * 1024, 1024, 512, 1024, 0, nullptr, ((bf16_t*)(F.ws + WS_WMIX)) + WM_WOA);
    cvt_mat(F, in[19] + (size_t)l * 512 * 1024, 1024, 512, 1024, 0, nullptr, ((bf16_t*)(F.ws + WS_WMIX)) + WM_WOB);
    cvt_mat(F, in[20] + (size_t)l * 1048576, 1024, 1024, 1024, 0, nullptr, ((bf16_t*)(F.ws + WS_WMIX)) + WM_WO);
    cvt_mat(F, in[23] + (size_t)l * 1048576, 1024, 1024, 1024, 0, in[21] + l * 1024, ((bf16_t*)(F.ws + WS_WMIX)) + WM_WMQ);
    cvt_mat(F, in[24] + (size_t)l * 1048576, 1024, 1024, 1024, 0, in[22] + l * 1024, ((bf16_t*)(F.ws + WS_WMIX)) + WM_WMK);
    cvt_mat(F, in[25] + (size_t)l * 1048576, 1024, 1024, 1024, 0, in[22] + l * 1024, ((bf16_t*)(F.ws + WS_WMIX)) + WM_WMV);
    cvt_mat(F, in[26] + (size_t)l * 1048576, 1024, 1024, 1024, 0, nullptr, ((bf16_t*)(F.ws + WS_WMIX)) + WM_WMO);
    const float* win = in[10] + (size_t)l * 1024 * 5656; const float* g = in[9] + l * 1024;
    for (int i = F.bid * 512 + F.tid; i < 32 * 1024; i += F.nb * 512) {
        const int n = i >> 10, k = i & 1023;
        float v = 0.f;
        if (n < 8) v = win[(size_t)k * 5656 + 1536 + n] * g[k]; else if (n < 24) v = win[(size_t)k * 5656 + 3080 + (n - 8)] * g[k];
        ((bf16_t*)(F.ws + WS_WMIX))[WM_WSM + i] = (bf16_t)(pk2(v, 0.f) & 0xffff);
    }
}
DEV void cvt_ffn(const Frame& F, int l) {
    cvt_mat(F, F.in[28] + (size_t)l * 1024 * 5632, 5632, 1024, 5632, 2, F.in[27] + l * 1024, ((bf16_t*)(F.ws + WS_WFFN)) + WF_UP);
    cvt_mat(F, F.in[31] + (size_t)l * 2816 * 1024, 1024, 2816, 1024, 0, nullptr, ((bf16_t*)(F.ws + WS_WFFN)) + WF_DN);
}

DEV void phase0(const Frame& F0) {
    REFRAME;
    const int gw = F.bid * 8 + F.wid, nw = F.nb * 8, lane = F.lane;
    for (int row = gw; row < TT + 4096; row += nw) {
        const bool ismem = row >= TT;
        const float* src = ismem ? F.in[8] + (size_t)(row - TT) * 1024 : (row < 32768 ? F.in[0] + (size_t)row * 1024 : F.in[1] + (size_t)(row - 32768) * 1024);
        f32x4 v[4]; float s = 0.f;
#pragma unroll
        for (int i = 0; i < 4; ++i) { v[i] = *(const f32x4*)(src + lane * 16 + i * 4); s += v[i][0] * v[i][0] + v[i][1] * v[i][1] + v[i][2] * v[i][2] + v[i][3] * v[i][3]; }
        u32x4 w0, w1;
        w0.x = pk2(v[0][0], v[0][1]); w0.y = pk2(v[0][2], v[0][3]); w0.z = pk2(v[1][0], v[1][1]); w0.w = pk2(v[1][2], v[1][3]);
        w1.x = pk2(v[2][0], v[2][1]); w1.y = pk2(v[2][2], v[2][3]); w1.z = pk2(v[3][0], v[3][1]); w1.w = pk2(v[3][2], v[3][3]);
        s += __shfl_xor(s, 1); s += __shfl_xor(s, 2);
        if (!ismem) {
            float* X = F.out + (size_t)row * 1024 + lane * 16;
#pragma unroll
            for (int i = 0; i < 4; ++i) *(f32x4*)(X + i * 4) = v[i];
            bf16_t* xb = ((bf16_t*)(F.ws + WS_XB)) + (size_t)row * 1024 + lane * 16;
            *(u32x4*)xb = w0; *(u32x4*)(xb + 8) = w1;
            if ((lane & 3) == 0) ((float*)(F.ws + WS_SSQ))[((size_t)(lane >> 4) * TT + row) * 4 + ((lane >> 2) & 3)] = s;
        } else {
            const int mr = row - TT;
            bf16_t* mb = ((bf16_t*)(F.ws + WS_MB)) + (size_t)mr * 1024 + lane * 16;
            *(u32x4*)mb = w0; *(u32x4*)(mb + 8) = w1;
            s += __shfl_xor(s, 4); s += __shfl_xor(s, 8); s += __shfl_xor(s, 16); s += __shfl_xor(s, 32);
            if (lane == 0) ((float*)(F.ws + WS_MRS))[mr] = rsqrtf(s * (1.f / 1024.f) + 1e-6f);
        }
    }
    cvt_mixer(F, 0);
    cvt_ffn(F, 0);
}

DEV void small_proj(const Frame& F0) {
    REFRAME;
    const int lane = F.lane, fr = lane & 15, fq = lane >> 4, mt = F.wid & 3, nt = F.wid >> 2;
    for (int c = F.bid; c < NCH; c += F.nb) {
        const int row = c * 64 + mt * 16 + fr;
        const bf16_t* a = ((bf16_t*)(F.ws + WS_XB)) + (size_t)row * 1024 + 8 * fq;
        const bf16_t* b = ((bf16_t*)(F.ws + WS_WMIX)) + WM_WSM + (size_t)(nt * 16 + fr) * 1024 + 8 * fq;
        f32x4 acc = {0.f, 0.f, 0.f, 0.f};
#pragma unroll 4
        for (int k = 0; k < 32; ++k) acc = MFMA16(*(const bf16x8*)(b + k * 32), *(const bf16x8*)(a + k * 32), acc);
        const float rs = row_rstd(((float*)(F.ws + WS_SSQ)), row);
        *(f32x4*)(((float*)(F.ws + WS_SC)) + (size_t)row * 32 + nt * 16 + 4 * fq) = acc * rs;
    }
}

DEV void gemm_epilogue(const Frame& F0, const GDesc& d, int l, f32x4 (&acc)[2][2][4][2]) {
    REFRAME;
    int lane_ = F.lane; asm volatile("" : "+v"(lane_));
    const int wr = F.wid >> 2, wc = F.wid & 3, fr = lane_ & 15, fq = lane_ >> 4;
    float* red = (float*)(F.lds + 131072);
    if (d.epi == EPI_SOFTMAX) {
        float mx[2][4];
#pragma unroll
        for (int ai = 0; ai < 2; ++ai)
#pragma unroll
            for (int m = 0; m < 4; ++m) {
                float v = -3.0e38f;
#pragma unroll
                for (int bj = 0; bj < 2; ++bj)
#pragma unroll
                    for (int n = 0; n < 2; ++n) { const f32x4 x = acc[ai][bj][m][n]; v = fmaxf(v, fmaxf(fmaxf(x[0], x[1]), fmaxf(x[2], x[3]))); }
                v = fmaxf(v, __shfl_xor(v, 16)); v = fmaxf(v, __shfl_xor(v, 32));
                if (fq == 0) red[(ai * 128 + wr * 64 + m * 16 + fr) * 4 + wc] = v;
            }
        __syncthreads();
#pragma unroll
        for (int ai = 0; ai < 2; ++ai)
#pragma unroll
            for (int m = 0; m < 4; ++m) {
                const f32x4 r4 = *(const f32x4*)(red + (ai * 128 + wr * 64 + m * 16 + fr) * 4);
                const float rm = fmaxf(fmaxf(r4[0], r4[1]), fmaxf(r4[2], r4[3]));
                mx[ai][m] = rm; float s = 0.f;
#pragma unroll
                for (int bj = 0; bj < 2; ++bj)
#pragma unroll
                    for (int n = 0; n < 2; ++n) { f32x4 x = acc[ai][bj][m][n];
#pragma unroll
                        for (int j = 0; j < 4; ++j) { x[j] = __expf(x[j] - rm); s += x[j]; }
                        acc[ai][bj][m][n] = x; }
                s += __shfl_xor(s, 16); s += __shfl_xor(s, 32);
                if (fq == 0) red[1024 + (ai * 128 + wr * 64 + m * 16 + fr) * 4 + wc] = s;
            }
        (void)mx;
        __syncthreads();
#pragma unroll
        for (int ai = 0; ai < 2; ++ai)
#pragma unroll
            for (int m = 0; m < 4; ++m) {
                const f32x4 r4 = *(const f32x4*)(red + 1024 + (ai * 128 + wr * 64 + m * 16 + fr) * 4);
                const float inv = 1.f / ((r4[0] + r4[1]) + (r4[2] + r4[3]));
                const bool valid = d.vai < 0 || (d.vai == ai && d.vwr == wr);
                const int row = d.orow + ai * 128 + wr * 64 + m * 16 + fr;
                if (valid) {
#pragma unroll
                    for (int bj = 0; bj < 2; ++bj)
#pragma unroll
                        for (int n = 0; n < 2; ++n) {
                            const int col = bj * 128 + wc * 32 + n * 16 + fq * 4;
                            *(u32x2*)(((bf16_t*)(F.ws + WS_P)) + (size_t)row * LDP + C_PR + d.head * 256 + col) = pk4(acc[ai][bj][m][n] * inv);
                        }
                }
            }
        __syncthreads();
        return;
    }
#pragma unroll
    for (int ai = 0; ai < 2; ++ai)
#pragma unroll
        for (int m = 0; m < 4; ++m) {
            const int row = d.orow + ai * 128 + wr * 64 + m * 16 + fr;
            float rs = 1.f, ss = 0.f;
            if (d.epi == EPI_PROJ || d.epi == EPI_UP || d.epi == EPI_Q) rs = row_rstd(((float*)(F.ws + WS_SSQ)), row);
            if (d.epi == EPI_Q) rs *= 0.0625f;
            if (d.epi == EPI_MEMK) rs = ((float*)(F.ws + WS_MRS))[row];
#pragma unroll
            for (int bj = 0; bj < 2; ++bj)
#pragma unroll
                for (int n = 0; n < 2; ++n) {
                    const int col = d.ocol + bj * 128 + wc * 32 + n * 16 + fq * 4;
                    f32x4 v = acc[ai][bj][m][n];
                    switch (d.epi) {
                    case EPI_UP: {
                        const int row_l = ai * 128 + wr * 64 + m * 16 + fr, cl = bj * 128 + wc * 32 + n * 16 + fq * 4;
                        *(u32x2*)((bf16_t*)F.lds + row_l * 264 + cl) = pk4(v * rs);
                    } break;
                    case EPI_PROJ: {
                        v = v * rs; const u32x2 w = pk4(v);
                        *(u32x2*)(((bf16_t*)(F.ws + WS_P)) + (size_t)row * LDP + col) = w;
                        if (m == 3 && fr >= 13 && col < 1536) {
                            const int chunk = row >> 6, hr = fr - 13;
                            *(u32x2*)(((bf16_t*)(F.ws + WS_KV)) + ((size_t)chunk * 3 + hr) * 1536 + col) = w;
                            if (chunk >= 512 || (chunk & 31) == 31) {
                                float* o = chunk < 512 ? F.out + O_GDNC_P + ((size_t)(l * 16 + (chunk >> 5)) * 3 + hr) * 1536 + col
                                                       : F.out + O_GDNC_S + ((size_t)(l * 8 + (chunk - 512)) * 3 + hr) * 1536 + col;
                                *(f32x4*)o = v;
                            }
                        }
                    } break;
                    case EPI_RESID: {
                        float* X = F.out + (size_t)row * 1024 + col;
                        f32x4 x = *(const f32x4*)X; x = x + v; *(f32x4*)X = x;
                        *(u32x2*)(((bf16_t*)(F.ws + WS_XB)) + (size_t)row * 1024 + col) = pk4(x);
                        ss += (x[0] * x[0] + x[1] * x[1]) + (x[2] * x[2] + x[3] * x[3]);
                    } break;
                    case EPI_Q: *(u32x2*)(((bf16_t*)(F.ws + WS_P)) + (size_t)row * LDP + C_Q + col) = pk4(v * rs); break;
                    case EPI_MEMK: {
                        v = v * rs;
                        *(f32x4*)(F.out + O_MEMK + ((size_t)l * 4096 + row) * 1024 + col) = v;
                        *(u32x2*)(((bf16_t*)(F.ws + WS_KV)) + (size_t)row * 1024 + col) = pk4(v);
                    } break;
                    case EPI_MEMV: {
                        const f32x4 r4 = *(const f32x4*)(((float*)(F.ws + WS_MRS)) + col);
                        v = v * r4;
                        float* o = F.out + O_MEMV + ((size_t)l * 4096 + col) * 1024 + row;
                        o[0] = v[0]; o[1024] = v[1]; o[2048] = v[2]; o[3072] = v[3];
                        const int b = col >> 8, h = row >> 8;
                        *(u32x2*)(((bf16_t*)(F.ws + WS_KV + 6144ull * 1024 * 2)) + ((size_t)(b * 4 + h) * 256 + (row & 255)) * 256 + (col & 255)) = pk4(v);
                    } break;
                    case EPI_OUTA: {
                        const f32x4 g = unpk4(*(const u32x2*)(((bf16_t*)(F.ws + WS_P)) + (size_t)row * LDP + C_GA + col));
                        f32x4 o; for (int j = 0; j < 4; ++j) o[j] = sigm(g[j]) * v[j];
                        *(u32x2*)(((bf16_t*)(F.ws + WS_P)) + (size_t)row * LDP + C_MRG + col) = pk4(o);
                    } break;
                    case EPI_OUTB: {
                        const f32x4 g = unpk4(*(const u32x2*)(((bf16_t*)(F.ws + WS_P)) + (size_t)row * LDP + C_GB + col));
                        f32x4 o = unpk4(*(const u32x2*)(((bf16_t*)(F.ws + WS_P)) + (size_t)row * LDP + C_MRG + col));
                        for (int j = 0; j < 4; ++j) o[j] += sigm(g[j]) * v[j];
                        *(u32x2*)(((bf16_t*)(F.ws + WS_P)) + (size_t)row * LDP + C_MRG + col) = pk4(o);
                    } break;
                    case EPI_ATTNO: {
                        const bool valid = d.vai < 0 || (d.vai == ai && d.vwr == wr);
                        if (valid) *(u32x2*)(((bf16_t*)(F.ws + WS_P)) + (size_t)row * LDP + C_O + d.head * 256 + col) = pk4(v);
                    } break;
                    default: break;
                    }
                }
            if (d.epi == EPI_RESID) {
                ss += __shfl_xor(ss, 16); ss += __shfl_xor(ss, 32);
                if (fq == 0) ((float*)(F.ws + WS_SSQ))[((size_t)(d.ocol >> 8) * TT + row) * 4 + wc] = ss;
            }
        }
    if (d.epi == EPI_UP) {
        bf16_t* ST = (bf16_t*)F.lds;
        const int pm = d.brow >> 8, pn = d.bcol >> 8;
        const bool samp = pm >= 128, needfix = !samp && (pm & 7) != 0;
        bf16_t* halo = ((bf16_t*)(F.ws + WS_KV)); bf16_t* raw01 = ((bf16_t*)(F.ws + WS_KV + 11714560ull));
        __syncthreads();
        {
            const int hsel = F.tid >> 6, cl4 = (F.tid & 63) * 4, ocol = ((cl4 >> 7) ? 2816 : 0) + 128 * pn + (cl4 & 127);
            const int row_l = (hsel >> 1) * 64 + 62 + (hsel & 1), chunk = (d.brow + row_l) >> 6, hr = hsel & 1;
            const u32x2 w = *(const u32x2*)(ST + row_l * 264 + cl4);
            *(u32x2*)(halo + ((size_t)chunk * 2 + hr) * 5632 + ocol) = w;
            if (chunk >= 512 || (chunk & 31) == 31) {
                float* o = chunk < 512 ? F.out + O_FFNC_P + ((size_t)(l * 16 + (chunk >> 5)) * 2 + hr) * 5632 + ocol
                                       : F.out + O_FFNC_S + ((size_t)(l * 8 + (chunk - 512)) * 2 + hr) * 5632 + ocol;
                *(f32x4*)o = unpk4(w);
            }
            if (needfix && hsel < 2) *(u32x2*)(raw01 + ((size_t)pm * 2 + hsel) * 5632 + ocol) = *(const u32x2*)(ST + hsel * 264 + cl4);
        }
        {
            const int cq = F.tid & 31, rg = F.tid >> 5, c4 = cq * 4, gcol = 128 * pn + c4, r0 = rg * 16;
            const float* cw = F.in[29] + (size_t)l * 3 * 5632; const float* cb = F.in[30] + (size_t)l * 5632;
            const f32x4 wg0 = *(const f32x4*)(cw + gcol), wg1 = *(const f32x4*)(cw + 5632 + gcol), wg2 = *(const f32x4*)(cw + 2 * 5632 + gcol), bg = *(const f32x4*)(cb + gcol);
            const f32x4 wv0 = *(const f32x4*)(cw + 2816 + gcol), wv1 = *(const f32x4*)(cw + 5632 + 2816 + gcol), wv2 = *(const f32x4*)(cw + 2 * 5632 + 2816 + gcol), bv = *(const f32x4*)(cb + 2816 + gcol);
            f32x4 g2 = {0.f, 0.f, 0.f, 0.f}, g1 = g2, v2 = g2, v1 = g2; bool skip2 = false;
            if ((samp ? (r0 & 63) : r0) != 0) {
                g2 = unpk4(*(const u32x2*)(ST + (r0 - 2) * 264 + c4)); g1 = unpk4(*(const u32x2*)(ST + (r0 - 1) * 264 + c4));
                v2 = unpk4(*(const u32x2*)(ST + (r0 - 2) * 264 + 128 + c4)); v1 = unpk4(*(const u32x2*)(ST + (r0 - 1) * 264 + 128 + c4));
            } else if (samp) {
                const float* sp = F.in[5] + (size_t)(l * 8 + (((d.brow + r0) >> 6) - 512)) * 2 * 5632;
                g2 = *(const f32x4*)(sp + gcol); g1 = *(const f32x4*)(sp + 5632 + gcol); v2 = *(const f32x4*)(sp + 2816 + gcol); v1 = *(const f32x4*)(sp + 5632 + 2816 + gcol);
            } else skip2 = needfix;
#pragma unroll 4
            for (int i = 0; i < 16; ++i) {
                const int row_l = r0 + i;
                const f32x4 g0 = unpk4(*(const u32x2*)(ST + row_l * 264 + c4)), v0 = unpk4(*(const u32x2*)(ST + row_l * 264 + 128 + c4));
                f32x4 o;
#pragma unroll
                for (int j = 0; j < 4; ++j) { const float yg = wg0[j] * g2[j] + wg1[j] * g1[j] + wg2[j] * g0[j] + bg[j], yv = wv0[j] * v2[j] + wv1[j] * v1[j] + wv2[j] * v0[j] + bv[j]; o[j] = silu(yg) * yv; }
                if (!(skip2 && i < 2)) *(u32x2*)(((bf16_t*)(F.ws + WS_P)) + (size_t)(d.brow + row_l) * LDP + gcol) = pk4(o);
                g2 = g1; g1 = g0; v2 = v1; v1 = v0;
            }
        }
        __syncthreads();
    }
}

enum { GP_IN = 0, GP_OUT, GP_WO, GP_MQ, GP_ATTN, GP_MO, GP_UP, GP_DOWN, GP_ATTN2, GP_OUT2 };
DEV void gemm_phase(const Frame& F0, int kind, int l) {
    REFRAME;
    int nunits = 0;
    switch (kind) { case GP_IN: case GP_UP: nunits = 130 * 22; break; case GP_OUT: nunits = 520 + 128; break; case GP_OUT2: nunits = 520; break; case GP_ATTN: case GP_ATTN2: nunits = 512 + 32; break; default: nunits = 520; }
    f32x4 acc[2][2][4][2];
    const bool xmap = (F.nb == 256) && (kind == GP_IN || kind == GP_UP || kind == GP_WO || kind == GP_MQ || kind == GP_MO || kind == GP_DOWN || kind == GP_OUT2);
    const int xcd = F.bid & 7, slot = F.bid >> 3, w_lo = (int)(((long)nunits * xcd) >> 3), w_hi = (int)(((long)nunits * (xcd + 1)) >> 3);
    for (int u0 = xmap ? w_lo + slot : F.bid; u0 < (xmap ? w_hi : nunits); u0 += xmap ? 32 : F.nb) {
        int u = u0;
        if (xmap) { const int nn = (kind == GP_IN || kind == GP_UP) ? 22 : 4; const int pn_ = u0 / 130, pm_ = u0 % 130; u = pm_ * nn + pn_; }
        GDesc d;
        { const int sub = (kind == GP_ATTN2 || kind == GP_OUT2) ? 1 : 0;
            d.vai = -1; d.vwr = 0; d.head = 0;
            switch (kind) {
            case GP_IN: { const int pm = u / 22, pn = u % 22; d.A = ((bf16_t*)(F.ws + WS_XB)); d.lda = 1024; d.Bt = ((bf16_t*)(F.ws + WS_WMIX)) + WM_WIN; d.ldb = 1024; d.K = 1024; d.brow = pm * 256; d.bcol = pn * 256; d.epi = EPI_PROJ; d.orow = d.brow; d.ocol = d.bcol; } break;
            case GP_UP: { const int pm = u / 22, pn = u % 22; d.A = ((bf16_t*)(F.ws + WS_XB)); d.lda = 1024; d.Bt = ((bf16_t*)(F.ws + WS_WFFN)) + WF_UP; d.ldb = 1024; d.K = 1024; d.brow = pm * 256; d.bcol = pn * 256; d.epi = EPI_UP; d.orow = d.brow; d.ocol = d.bcol; } break;
            case GP_OUT: case GP_OUT2:
                if (u < 520) { const int pm = u >> 2, pn = u & 3; d.A = ((bf16_t*)(F.ws + WS_P)) + (sub == 0 ? C_ZA : C_ZB); d.lda = LDP; d.Bt = ((bf16_t*)(F.ws + WS_WMIX)) + (sub == 0 ? WM_WOA : WM_WOB); d.ldb = 512; d.K = 512;
                               d.brow = pm * 256; d.bcol = pn * 256; d.epi = sub == 0 ? EPI_OUTA : EPI_OUTB; d.orow = d.brow; d.ocol = d.bcol; }
                else if (u < 520 + 64) { const int v = u - 520, pm = v >> 2, pn = v & 3; d.A = ((bf16_t*)(F.ws + WS_MB)); d.lda = 1024; d.Bt = ((bf16_t*)(F.ws + WS_WMIX)) + WM_WMK; d.ldb = 1024; d.K = 1024; d.brow = pm * 256; d.bcol = pn * 256; d.epi = EPI_MEMK; d.orow = d.brow; d.ocol = d.bcol; }
                else { const int v = u - 584, pm = v & 3, pn = v >> 2; d.A = ((bf16_t*)(F.ws + WS_WMIX)) + WM_WMV; d.lda = 1024; d.Bt = ((bf16_t*)(F.ws + WS_MB)); d.ldb = 1024; d.K = 1024; d.brow = pm * 256; d.bcol = pn * 256; d.epi = EPI_MEMV; d.orow = d.brow; d.ocol = d.bcol; }
                break;
            case GP_WO: { const int pm = u >> 2, pn = u & 3; d.A = ((bf16_t*)(F.ws + WS_P)) + C_MRG; d.lda = LDP; d.Bt = ((bf16_t*)(F.ws + WS_WMIX)) + WM_WO; d.ldb = 1024; d.K = 1024; d.brow = pm * 256; d.bcol = pn * 256; d.epi = EPI_RESID; d.orow = d.brow; d.ocol = d.bcol; } break;
            case GP_MQ: { const int pm = u >> 2, pn = u & 3; d.A = ((bf16_t*)(F.ws + WS_XB)); d.lda = 1024; d.Bt = ((bf16_t*)(F.ws + WS_WMIX)) + WM_WMQ; d.ldb = 1024; d.K = 1024; d.brow = pm * 256; d.bcol = pn * 256; d.epi = EPI_Q; d.orow = d.brow; d.ocol = d.bcol; } break;
            case GP_MO: { const int pm = u >> 2, pn = u & 3; d.A = ((bf16_t*)(F.ws + WS_P)) + C_O; d.lda = LDP; d.Bt = ((bf16_t*)(F.ws + WS_WMIX)) + WM_WMO; d.ldb = 1024; d.K = 1024; d.brow = pm * 256; d.bcol = pn * 256; d.epi = EPI_RESID; d.orow = d.brow; d.ocol = d.bcol; } break;
            case GP_DOWN: { const int pm = u >> 2, pn = u & 3; d.A = ((bf16_t*)(F.ws + WS_P)); d.lda = LDP; d.Bt = ((bf16_t*)(F.ws + WS_WFFN)) + WF_DN; d.ldb = 2816; d.K = 2816; d.brow = pm * 256; d.bcol = pn * 256; d.epi = EPI_RESID; d.orow = d.brow; d.ocol = d.bcol; } break;
            case GP_ATTN: case GP_ATTN2: {
                int pm, h, b;
                if (u < 512) { pm = u >> 2; h = u & 3; b = pm >> 3; }
                else { const int v = u - 512; h = v & 3; const int bi = (v >> 2) & 3, t = v >> 4; pm = 128 + t; b = 16 + 4 * t + bi; d.vai = bi >> 1; d.vwr = bi & 1; }
                d.head = h; d.brow = pm * 256; d.orow = d.brow; d.ocol = 0; d.K = 256; d.bcol = 0;
                if (sub == 0) { d.A = ((bf16_t*)(F.ws + WS_P)) + C_Q + h * 256; d.lda = LDP; d.Bt = ((bf16_t*)(F.ws + WS_KV)) + (size_t)b * 256 * 1024 + h * 256; d.ldb = 1024; d.epi = EPI_SOFTMAX; }
                else { d.A = ((bf16_t*)(F.ws + WS_P)) + C_PR + h * 256; d.lda = LDP; d.Bt = ((bf16_t*)(F.ws + WS_KV + 6144ull * 1024 * 2)) + (size_t)(b * 4 + h) * 65536; d.ldb = 256; d.epi = EPI_ATTNO; }
            } break;
            }
        }
        gemm_core(d.A, d.lda, d.Bt, d.ldb, d.K, d.brow, d.bcol, acc, (bf16_t*)F.lds);
        gemm_epilogue(F, d, l, acc);
    }
}

DEV void sample_kv(const Frame& F0, int l) {
    REFRAME;
    const float* ck = F.in[6] + (size_t)l * 2097152; const float* cv = F.in[7] + (size_t)l * 2097152;
    for (int i = F.bid * 512 + F.tid; i < 262144; i += F.nb * 512) {
        const f32x4 a = *(const f32x4*)(ck + (size_t)i * 8), b = *(const f32x4*)(ck + (size_t)i * 8 + 4);
        u32x4 w; w.x = pk2(a[0], a[1]); w.y = pk2(a[2], a[3]); w.z = pk2(b[0], b[1]); w.w = pk2(b[2], b[3]);
        *(u32x4*)(((bf16_t*)(F.ws + WS_KV)) + 4096ull * 1024 + (size_t)i * 8) = w;
        const int dd = i & 255, m8 = (i >> 8) & 31, h = (i >> 13) & 3, bb = i >> 15;
        const float* s = cv + ((size_t)(bb * 256 + m8 * 8) * 4 + h) * 256 + dd;
        u32x4 x; x.x = pk2(s[0], s[1024]); x.y = pk2(s[2048], s[3072]); x.z = pk2(s[4096], s[5120]); x.w = pk2(s[6144], s[7168]);
        *(u32x4*)(((bf16_t*)(F.ws + WS_KV + 6144ull * 1024 * 2)) + ((size_t)((16 + bb) * 4 + h) * 256 + dd) * 256 + m8 * 8) = x;
    }
}

DEV void g1_gdn(const Frame& F0, int l, int c, int h) {
    REFRAME;
    float* Fq = (float*)F.lds;
    bf16_t* VS = (bf16_t*)(F.lds + 66560);
    bf16_t* QN = (bf16_t*)(F.lds + 82944);
    bf16_t* KN = (bf16_t*)(F.lds + 100352);
    float* AM = (float*)(F.lds + 117760);
    float* sB = (float*)(F.lds + 135168); float* sG = sB + 64; float* sRQ = sB + 128; float* sRK = sB + 192;
    const int tid = F.tid, lane = F.lane, t0 = c * 64;
    const bool first = c >= 512 || (c & 31) == 0; const bool sample = c >= 512;
    __syncthreads();
    if (F.wid == 0) {
        const int t = t0 + lane;
        const float braw = ((float*)(F.ws + WS_SC))[(size_t)t * 32 + h], araw = ((float*)(F.ws + WS_SC))[(size_t)t * 32 + 4 + h];
        const float beta = sigm(braw);
        float g = -__expf(F.in[12][l * 4 + h]) * softplus(araw + F.in[13][l * 4 + h]);
#pragma unroll
        for (int off = 1; off < 64; off <<= 1) { const float n = __shfl_up(g, off); if (lane >= off) g += n; }
        sB[lane] = beta; sG[lane] = g;
        if (!F.dry) ((float*)(F.ws + WS_BG))[((size_t)c * 4 + h) * 128 + lane] = beta; if (!F.dry) ((float*)(F.ws + WS_BG))[((size_t)c * 4 + h) * 128 + 64 + lane] = g;
    }
    __syncthreads();
    const float* cw = F.in[11] + (size_t)l * 4 * 1536;
    if (tid < 384) {
        const int cp = tid % 192, rh = tid / 192, which = cp >> 6, cc = (cp & 63) * 2, pcol = which * 512 + h * 128 + cc;
        const f32x2 w0 = *(const f32x2*)(cw + pcol), w1 = *(const f32x2*)(cw + 1536 + pcol), w2 = *(const f32x2*)(cw + 2 * 1536 + pcol), w3 = *(const f32x2*)(cw + 3 * 1536 + pcol);
        float x0[35], x1[35];
#pragma unroll
        for (int i = 0; i < 3; ++i) {
            x0[i] = 0.f; x1[i] = 0.f;
            if (rh == 1) { const unsigned u = *(const unsigned*)(((bf16_t*)(F.ws + WS_P)) + (size_t)(t0 + 29 + i) * LDP + pcol); x0[i] = bflo(u); x1[i] = bfhi(u); }
            else if (!first) { const unsigned u = *(const unsigned*)(((bf16_t*)(F.ws + WS_KV)) + ((size_t)(c - 1) * 3 + i) * 1536 + pcol); x0[i] = bflo(u); x1[i] = bfhi(u); }
            else if (sample) { const f32x2 f = *(const f32x2*)(F.in[3] + ((size_t)(l * 8 + (c - 512)) * 3 + i) * 1536 + pcol); x0[i] = f[0]; x1[i] = f[1]; }
        }
#pragma unroll
        for (int i = 0; i < 32; ++i) { const unsigned u = *(const unsigned*)(((bf16_t*)(F.ws + WS_P)) + (size_t)(t0 + 32 * rh + i) * LDP + pcol); x0[3 + i] = bflo(u); x1[3 + i] = bfhi(u); }
#pragma unroll
        for (int r = 0; r < 32; ++r) {
            float a0 = w0[0] * x0[r] + w1[0] * x0[r + 1] + w2[0] * x0[r + 2] + w3[0] * x0[r + 3];
            float a1 = w0[1] * x1[r] + w1[1] * x1[r + 1] + w2[1] * x1[r + 2] + w3[1] * x1[r + 3];
            a0 = silu(a0); a1 = silu(a1);
            const int rr = 32 * rh + r;
            if (which < 2) { *(f32x2*)(Fq + rr * 260 + which * 128 + cc) = (f32x2){a0, a1}; }
            else { const float be = sB[rr]; *(unsigned*)(VS + rr * 128 + cc) = pk2(a0 * be, a1 * be); }
        }
    }
    __syncthreads();
    {
        const int r = tid >> 3, j = tid & 7; const float* p = Fq + r * 260 + j * 32; float s = 0.f;
#pragma unroll
        for (int i = 0; i < 32; ++i) s += p[i] * p[i];
        s += __shfl_xor(s, 1); s += __shfl_xor(s, 2);
        if ((j & 3) == 0) { if (j == 0) sRQ[r] = rsqrtf(s + 1e-6f) * 0.08838834764831845f; else sRK[r] = rsqrtf(s + 1e-6f); }
    }
    __syncthreads();
    for (int idx = tid; idx < 64 * 64; idx += 512) {
        const int r = idx >> 6, c4 = (idx & 63) * 4; const bool isq = c4 < 128;
        f32x4 v = *(const f32x4*)(Fq + r * 260 + c4); v = v * (isq ? sRQ[r] : sRK[r]);
        const u32x2 w = pk4(v);
        if (isq) { *(u32x2*)(QN + r * 136 + c4) = w; if (!F.dry) *(u32x2*)(((bf16_t*)(F.ws + WS_P)) + (size_t)(t0 + r) * LDP + C_QA + h * 128 + c4) = w; }
        else { *(u32x2*)(KN + r * 136 + c4 - 128) = w; if (!F.dry) *(u32x2*)(((bf16_t*)(F.ws + WS_P)) + (size_t)(t0 + r) * LDP + C_KA + h * 128 + c4 - 128) = w; }
    }
    for (int idx = tid; idx < 64 * 32; idx += 512) {
        const int r = idx >> 5, c4 = (idx & 31) * 4;
        if (!F.dry) *(u32x2*)(((bf16_t*)(F.ws + WS_P)) + (size_t)(t0 + r) * LDP + C_VA + h * 128 + c4) = *(const u32x2*)(VS + r * 128 + c4);
    }
    __syncthreads();
    {
        const int fr = lane & 15, fq = lane >> 4, which = F.wid >> 2, it = F.wid & 3;
        const bf16_t* X = which ? QN : KN;
        const int crow = 16 * it + fr; const float gc = sG[crow], bc = sB[crow];
        for (int jt = 0; jt < 4; ++jt) {
            f32x4 a = {0.f, 0.f, 0.f, 0.f};
            if (jt <= it) {
#pragma unroll
                for (int ks = 0; ks < 4; ++ks) a = MFMA16(ldfrag(KN, 16 * jt + fr, 136, 32 * ks, fq), ldfrag(X, crow, 136, 32 * ks, fq), a);
            }
            f32x4 o;
#pragma unroll
            for (int j = 0; j < 4; ++j) {
                const int s = 16 * jt + 4 * fq + j;
                const bool keep = which ? (s <= crow) : (s < crow);
                const float dec = keep ? __expf(gc - sG[s]) : 0.f;
                o[j] = a[j] * dec * (which ? 1.f : bc);
            }
            if (which) { if (!F.dry) *(u32x2*)(((bf16_t*)(F.ws + WS_XB)) + (size_t)(t0 + crow) * LDE + h * 128 + 64 + 16 * jt + 4 * fq) = pk4(o); }
            else *(f32x4*)(AM + crow * 68 + 16 * jt + 4 * fq) = o;
        }
    }
    __syncthreads();
    if (F.wid == 0) {
        float Tc[64]; const float lanef = (float)lane;
        typedef __attribute__((address_space(3))) const f32x4 LDSF4;
        __attribute__((address_space(3))) const char* aml = (__attribute__((address_space(3))) const char*)AM; asm volatile("" : "+v"(aml));
#pragma unroll
        for (int i = 0; i < 64; ++i) {
            float a = fmaxf(0.f, 1.f - fabsf(lanef - (float)i));
#pragma unroll
            for (int j4 = 0; j4 < (i + 3) / 4; ++j4) {
                const f32x4 av = *(const LDSF4*)(aml + (i * 68 + j4 * 4) * 4);
#pragma unroll
                for (int jj = 0; jj < 4; ++jj) if (j4 * 4 + jj < i) a -= av[jj] * Tc[j4 * 4 + jj];
            }
            Tc[i] = a;
        }
#pragma unroll
        for (int i = 0; i < 64; i += 2) {
            const unsigned w = pk2(Tc[i], Tc[i + 1]);
            if (!F.dry) ((bf16_t*)(F.ws + WS_XB))[(size_t)(t0 + i) * LDE + h * 128 + lane] = (bf16_t)(w & 0xffff);
            if (!F.dry) ((bf16_t*)(F.ws + WS_XB))[(size_t)(t0 + i + 1) * LDE + h * 128 + lane] = (bf16_t)(w >> 16);
        }
    }
}

DEV void g1_gla(const Frame& F0, int l, int c, int h) {
    REFRAME;
    float* GL = (float*)F.lds;
    float* LA = (float*)(F.lds + 4096);
    bf16_t* QG = (bf16_t*)(F.lds + 20736);
    bf16_t* KI = (bf16_t*)(F.lds + 29952);
    const int tid = F.tid, lane = F.lane, t0 = c * 64;
    __syncthreads();
    if (tid < 256) { const int r = tid >> 2, q4 = (tid & 3) * 4; *(f32x4*)(GL + r * 16 + q4) = *(const f32x4*)(((float*)(F.ws + WS_SC)) + (size_t)(t0 + r) * 32 + 8 + q4); }
    __syncthreads();
    {
        const int dk = tid & 63, rb = tid >> 6;
        float w2[16];
#pragma unroll
        for (int i = 0; i < 16; ++i) w2[i] = F.in[15][(size_t)(l * 16 + i) * 256 + h * 64 + dk];
        const float bias = F.in[16][l * 256 + h * 64 + dk];
#pragma unroll
        for (int rr = 0; rr < 8; ++rr) {
            const int r = rb * 8 + rr; float x = bias;
#pragma unroll
            for (int i = 0; i < 16; ++i) x += GL[r * 16 + i] * w2[i];
            LA[r * 65 + dk] = logsigmoid(x) * 0.0625f;
        }
    }
    __syncthreads();
    if (tid < 64) {
        float g = 0.f;
#pragma unroll 8
        for (int r = 0; r < 64; ++r) { g += LA[r * 65 + tid]; LA[r * 65 + tid] = g; }
        if (!F.dry) ((float*)(F.ws + WS_DL))[((size_t)c * 4 + h) * 64 + tid] = __expf(g);
    }
    __syncthreads();
    for (int idx = tid; idx < 64 * 16; idx += 512) {
        const int r = idx >> 4, c4 = (idx & 15) * 4;
        bf16_t* qp = ((bf16_t*)(F.ws + WS_P)) + (size_t)(t0 + r) * LDP + C_QB + h * 64 + c4; bf16_t* kp = ((bf16_t*)(F.ws + WS_P)) + (size_t)(t0 + r) * LDP + C_KB + h * 64 + c4;
        const f32x4 q = unpk4(*(const u32x2*)qp), k = unpk4(*(const u32x2*)kp);
        f32x4 qg, ki, kg;
#pragma unroll
        for (int j = 0; j < 4; ++j) { const float g = LA[r * 65 + c4 + j], gl = LA[63 * 65 + c4 + j];
            qg[j] = q[j] * 0.125f * __expf(g); ki[j] = k[j] * __expf(-g); kg[j] = k[j] * __expf(gl - g); }
        const u32x2 wq = pk4(qg);
        *(u32x2*)(QG + r * 72 + c4) = wq; *(u32x2*)(KI + r * 72 + c4) = pk4(ki);
        if (!F.dry) *(u32x2*)qp = wq; if (!F.dry) *(u32x2*)kp = pk4(kg);
    }
    __syncthreads();
    {
        const int fr = lane & 15, fq = lane >> 4, it = F.wid >> 1; const int crow = 16 * it + fr;
#pragma unroll
        for (int q = 0; q < 2; ++q) {
            const int jt = (F.wid & 1) * 2 + q;
            f32x4 a = {0.f, 0.f, 0.f, 0.f};
            if (jt <= it) {
#pragma unroll
                for (int ks = 0; ks < 2; ++ks) a = MFMA16(ldfrag(KI, 16 * jt + fr, 72, 32 * ks, fq), ldfrag(QG, crow, 72, 32 * ks, fq), a);
            }
#pragma unroll
            for (int j = 0; j < 4; ++j) if (16 * jt + 4 * fq + j > crow) a[j] = 0.f;
            if (!F.dry) *(u32x2*)(((bf16_t*)(F.ws + WS_XB)) + (size_t)(t0 + crow) * LDE + 512 + h * 64 + 16 * jt + 4 * fq) = pk4(a);
        }
    }
}

DEV void g2_gdn(const Frame& F0, int l, int s, int h) {
    REFRAME;
    bf16_t* QN = (bf16_t*)F.lds;
    bf16_t* KN = (bf16_t*)(F.lds + 17408);
    bf16_t* KT = (bf16_t*)(F.lds + 34816);
    bf16_t* TM = (bf16_t*)(F.lds + 53248);
    bf16_t* AQ = (bf16_t*)(F.lds + 62464);
    float* sB = (float*)(F.lds + 71680); float* sG = sB + 64;
    float* RED = (float*)(F.lds + 72192);
    bf16_t* VV = (bf16_t*)(F.lds + 74240);
    bf16_t* ZZ = (bf16_t*)(F.lds + 91648);
    const int tid = F.tid, lane = F.lane, w = F.wid, fr = lane & 15, fq = lane >> 4;
    const bool sample = s >= 16; const int nchunk = sample ? 1 : 32; const int tbase = sample ? 32768 + (s - 16) * 64 : s * 2048;
    const int dvc = h * 128 + 16 * w + fr;
    f32x4 S[8];
#pragma unroll
    for (int mt = 0; mt < 8; ++mt) {
        if (sample) { const float* sp = F.in[2] + ((size_t)((l * 8 + (s - 16)) * 4 + h) * 128) * 128;
#pragma unroll
            for (int j = 0; j < 4; ++j) S[mt][j] = sp[(size_t)(16 * mt + 4 * fq + j) * 128 + 16 * w + fr]; }
        else S[mt] = (f32x4){0.f, 0.f, 0.f, 0.f};
    }
    const float gn = F.in[14][l * 128 + 16 * w + fr];
    for (int n = 0; n < nchunk; ++n) {
        const int t0 = tbase + n * 64;
        __syncthreads();
#pragma unroll
        for (int i = 0; i < 2; ++i) {
            const int p = tid + 512 * i, r = p >> 4, c8 = (p & 15) * 8;
            const u32x4 q = *(const u32x4*)(((bf16_t*)(F.ws + WS_P)) + (size_t)(t0 + r) * LDP + C_QA + h * 128 + c8);
            const u32x4 k = *(const u32x4*)(((bf16_t*)(F.ws + WS_P)) + (size_t)(t0 + r) * LDP + C_KA + h * 128 + c8);
            *(u32x4*)(QN + r * 136 + c8) = q; *(u32x4*)(KN + r * 136 + c8) = k;
            *(u32x4*)(VV + r * 136 + c8) = *(const u32x4*)(((bf16_t*)(F.ws + WS_P)) + (size_t)(t0 + r) * LDP + C_VA + h * 128 + c8);
            *(u32x4*)(ZZ + r * 136 + c8) = *(const u32x4*)(((bf16_t*)(F.ws + WS_P)) + (size_t)(t0 + r) * LDP + C_ZA + h * 128 + c8);
            KT[(c8 + 0) * 72 + r] = (bf16_t)(k.x & 0xffff); KT[(c8 + 1) * 72 + r] = (bf16_t)(k.x >> 16);
            KT[(c8 + 2) * 72 + r] = (bf16_t)(k.y & 0xffff); KT[(c8 + 3) * 72 + r] = (bf16_t)(k.y >> 16);
            KT[(c8 + 4) * 72 + r] = (bf16_t)(k.z & 0xffff); KT[(c8 + 5) * 72 + r] = (bf16_t)(k.z >> 16);
            KT[(c8 + 6) * 72 + r] = (bf16_t)(k.w & 0xffff); KT[(c8 + 7) * 72 + r] = (bf16_t)(k.w >> 16);
        }
        {
            const int r = tid >> 3, c8 = (tid & 7) * 8;
            *(u32x4*)(TM + r * 72 + c8) = *(const u32x4*)(((bf16_t*)(F.ws + WS_XB)) + (size_t)(t0 + r) * LDE + h * 128 + c8);
            *(u32x4*)(AQ + r * 72 + c8) = *(const u32x4*)(((bf16_t*)(F.ws + WS_XB)) + (size_t)(t0 + r) * LDE + h * 128 + 64 + c8);
        }
        if (tid < 128) sB[tid] = ((float*)(F.ws + WS_BG))[((size_t)(t0 >> 6) * 4 + h) * 128 + tid];
        __syncthreads();
        f32x4 kS[4], qS[4], vn[4], o[4];
#pragma unroll
        for (int mt = 0; mt < 4; ++mt) { kS[mt] = (f32x4){0.f, 0.f, 0.f, 0.f}; qS[mt] = kS[mt]; vn[mt] = kS[mt]; }
#pragma unroll
        for (int ks = 0; ks < 4; ++ks) {
            const bf16x8 sf = mk8(pk4(S[2 * ks]), pk4(S[2 * ks + 1]));
#pragma unroll
            for (int mt = 0; mt < 4; ++mt) {
                kS[mt] = MFMA16(ldfragp(KN, 16 * mt + fr, 136, 32 * ks, fq), sf, kS[mt]);
                qS[mt] = MFMA16(ldfragp(QN, 16 * mt + fr, 136, 32 * ks, fq), sf, qS[mt]);
            }
        }
        const float glast = sG[63];
        f32x4 eg[4], tmp[4];
#pragma unroll
        for (int mt = 0; mt < 4; ++mt)
#pragma unroll
            for (int j = 0; j < 4; ++j) {
                const int row = 16 * mt + 4 * fq + j;
                const float e = __expf(sG[row]); eg[mt][j] = e;
                const float vv = bf2f(VV[row * 136 + 16 * w + fr]);
                tmp[mt][j] = vv - sB[row] * e * kS[mt][j];
            }
#pragma unroll
        for (int ks = 0; ks < 2; ++ks) {
            const bf16x8 tf = mk8(pk4(tmp[2 * ks]), pk4(tmp[2 * ks + 1]));
#pragma unroll
            for (int mt = 0; mt < 4; ++mt) vn[mt] = MFMA16(ldfragp(TM, 16 * mt + fr, 72, 32 * ks, fq), tf, vn[mt]);
        }
#pragma unroll
        for (int mt = 0; mt < 4; ++mt) o[mt] = eg[mt] * qS[mt];
#pragma unroll
        for (int ks = 0; ks < 2; ++ks) {
            const bf16x8 vf = mk8(pk4(vn[2 * ks]), pk4(vn[2 * ks + 1]));
#pragma unroll
            for (int mt = 0; mt < 4; ++mt) o[mt] = MFMA16(ldfragp(AQ, 16 * mt + fr, 72, 32 * ks, fq), vf, o[mt]);
        }
        const float dl = __expf(glast);
#pragma unroll
        for (int mt = 0; mt < 4; ++mt)
#pragma unroll
            for (int j = 0; j < 4; ++j) vn[mt][j] *= __expf(glast - sG[16 * mt + 4 * fq + j]);
#pragma unroll
        for (int mt = 0; mt < 8; ++mt) S[mt] = S[mt] * dl;
#pragma unroll
        for (int ks = 0; ks < 2; ++ks) {
            const bf16x8 vf = mk8(pk4(vn[2 * ks]), pk4(vn[2 * ks + 1]));
#pragma unroll
            for (int mt = 0; mt < 8; ++mt) S[mt] = MFMA16(ldfragp(KT, 16 * mt + fr, 72, 32 * ks, fq), vf, S[mt]);
        }
#pragma unroll
        for (int mt = 0; mt < 4; ++mt)
#pragma unroll
            for (int j = 0; j < 4; ++j) {
                float p = o[mt][j] * o[mt][j];
                p += __shfl_xor(p, 1); p += __shfl_xor(p, 2); p += __shfl_xor(p, 4); p += __shfl_xor(p, 8);
                if (fr == 0) RED[(16 * mt + 4 * fq + j) * 8 + w] = p;
            }
        __syncthreads();
#pragma unroll
        for (int mt = 0; mt < 4; ++mt)
#pragma unroll
            for (int j = 0; j < 4; ++j) {
                const int row = 16 * mt + 4 * fq + j;
                const f32x4 r0 = *(const f32x4*)(RED + row * 8), r1 = *(const f32x4*)(RED + row * 8 + 4);
                const float ssum = ((r0[0] + r0[1]) + (r0[2] + r0[3])) + ((r1[0] + r1[1]) + (r1[2] + r1[3]));
                const float rs = rsqrtf(ssum * (1.f / 128.f) + 1e-6f);
                bf16_t* zp = ((bf16_t*)(F.ws + WS_P)) + (size_t)(t0 + row) * LDP + C_ZA + dvc;
                const float z = bf2f(ZZ[row * 136 + 16 * w + fr]);
                if (!F.dry) *zp = (bf16_t)(pk2(o[mt][j] * rs * gn * silu(z), 0.f) & 0xffff);
            }
    }
    float* so = sample ? F.out + O_GDN_S + ((size_t)((l * 8 + (s - 16)) * 4 + h) * 128) * 128 : F.out + O_GDN_P + ((size_t)((l * 16 + s) * 4 + h) * 128) * 128;
#pragma unroll
    for (int mt = 0; mt < 8; ++mt)
#pragma unroll
        for (int j = 0; j < 4; ++j) if (!F.dry) so[(size_t)(16 * mt + 4 * fq + j) * 128 + 16 * w + fr] = S[mt][j];
}

DEV void g2_gla(const Frame& F0, int l, int s, int h) {
    REFRAME;
    bf16_t* QG = (bf16_t*)F.lds;
    bf16_t* KGT = (bf16_t*)(F.lds + 9216);
    bf16_t* AQ = (bf16_t*)(F.lds + 18432);
    float* sDL = (float*)(F.lds + 27648);
    float* RED = (float*)(F.lds + 27904);
    bf16_t* ZZ = (bf16_t*)(F.lds + 29952);
    const int tid = F.tid, lane = F.lane, w = F.wid, fr = lane & 15, fq = lane >> 4;
    const bool sample = s >= 16; const int nchunk = sample ? 1 : 32; const int tbase = sample ? 32768 + (s - 16) * 64 : s * 2048;
    const int dvc = h * 128 + 16 * w + fr;
    f32x4 S[4];
#pragma unroll
    for (int mt = 0; mt < 4; ++mt) {
        if (sample) { const float* sp = F.in[4] + ((size_t)((l * 8 + (s - 16)) * 4 + h) * 64) * 128;
#pragma unroll
            for (int j = 0; j < 4; ++j) S[mt][j] = sp[(size_t)(16 * mt + 4 * fq + j) * 128 + 16 * w + fr]; }
        else S[mt] = (f32x4){0.f, 0.f, 0.f, 0.f};
    }
    const float gn = F.in[17][l * 128 + 16 * w + fr];
    for (int n = 0; n < nchunk; ++n) {
        const int t0 = tbase + n * 64, chunk = t0 >> 6;
        __syncthreads();
        {
            const int r = tid >> 3, c8 = (tid & 7) * 8;
            *(u32x4*)(QG + r * 72 + c8) = *(const u32x4*)(((bf16_t*)(F.ws + WS_P)) + (size_t)(t0 + r) * LDP + C_QB + h * 64 + c8);
            const u32x4 k = *(const u32x4*)(((bf16_t*)(F.ws + WS_P)) + (size_t)(t0 + r) * LDP + C_KB + h * 64 + c8);
            KGT[(c8 + 0) * 72 + r] = (bf16_t)(k.x & 0xffff); KGT[(c8 + 1) * 72 + r] = (bf16_t)(k.x >> 16);
            KGT[(c8 + 2) * 72 + r] = (bf16_t)(k.y & 0xffff); KGT[(c8 + 3) * 72 + r] = (bf16_t)(k.y >> 16);
            KGT[(c8 + 4) * 72 + r] = (bf16_t)(k.z & 0xffff); KGT[(c8 + 5) * 72 + r] = (bf16_t)(k.z >> 16);
            KGT[(c8 + 6) * 72 + r] = (bf16_t)(k.w & 0xffff); KGT[(c8 + 7) * 72 + r] = (bf16_t)(k.w >> 16);
            *(u32x4*)(AQ + r * 72 + c8) = *(const u32x4*)(((bf16_t*)(F.ws + WS_XB)) + (size_t)(t0 + r) * LDE + 512 + h * 64 + c8);
        }
#pragma unroll
        for (int i = 0; i < 2; ++i) { const int p = tid + 512 * i, r = p >> 4, c8 = (p & 15) * 8;
            *(u32x4*)(ZZ + r * 136 + c8) = *(const u32x4*)(((bf16_t*)(F.ws + WS_P)) + (size_t)(t0 + r) * LDP + C_ZB + h * 128 + c8); }
        if (tid < 64) sDL[tid] = ((float*)(F.ws + WS_DL))[((size_t)chunk * 4 + h) * 64 + tid];
        bf16x8 vf[2];
#pragma unroll
        for (int ks = 0; ks < 2; ++ks) {
            unsigned e[8];
#pragma unroll
            for (int j = 0; j < 8; ++j) { const int row = 32 * ks + (j < 4 ? 4 * fq + j : 16 + 4 * fq + (j - 4)); e[j] = ((bf16_t*)(F.ws + WS_P))[(size_t)(t0 + row) * LDP + C_VB + dvc]; }
            u32x4 t; t.x = e[0] | (e[1] << 16); t.y = e[2] | (e[3] << 16); t.z = e[4] | (e[5] << 16); t.w = e[6] | (e[7] << 16);
            vf[ks] = __builtin_bit_cast(bf16x8, t);
        }
        __syncthreads();
        f32x4 o[4];
#pragma unroll
        for (int mt = 0; mt < 4; ++mt) o[mt] = (f32x4){0.f, 0.f, 0.f, 0.f};
#pragma unroll
        for (int ks = 0; ks < 2; ++ks) {
            const bf16x8 sf = mk8(pk4(S[2 * ks]), pk4(S[2 * ks + 1]));
#pragma unroll
            for (int mt = 0; mt < 4; ++mt) {
                o[mt] = MFMA16(ldfragp(QG, 16 * mt + fr, 72, 32 * ks, fq), sf, o[mt]);
                o[mt] = MFMA16(ldfragp(AQ, 16 * mt + fr, 72, 32 * ks, fq), vf[ks], o[mt]);
            }
        }
#pragma unroll
        for (int mt = 0; mt < 4; ++mt) {
#pragma unroll
            for (int j = 0; j < 4; ++j) S[mt][j] *= sDL[16 * mt + 4 * fq + j];
#pragma unroll
            for (int ks = 0; ks < 2; ++ks) S[mt] = MFMA16(ldfragp(KGT, 16 * mt + fr, 72, 32 * ks, fq), vf[ks], S[mt]);
        }
#pragma unroll
        for (int mt = 0; mt < 4; ++mt)
#pragma unroll
            for (int j = 0; j < 4; ++j) {
                float p = o[mt][j] * o[mt][j];
                p += __shfl_xor(p, 1); p += __shfl_xor(p, 2); p += __shfl_xor(p, 4); p += __shfl_xor(p, 8);
                if (fr == 0) RED[(16 * mt + 4 * fq + j) * 8 + w] = p;
            }
        __syncthreads();
#pragma unroll
        for (int mt = 0; mt < 4; ++mt)
#pragma unroll
            for (int j = 0; j < 4; ++j) {
                const int row = 16 * mt + 4 * fq + j;
                const f32x4 r0 = *(const f32x4*)(RED + row * 8), r1 = *(const f32x4*)(RED + row * 8 + 4);
                const float ssum = ((r0[0] + r0[1]) + (r0[2] + r0[3])) + ((r1[0] + r1[1]) + (r1[2] + r1[3]));
                const float rs = rsqrtf(ssum * (1.f / 128.f) + 1e-6f);
                bf16_t* zp = ((bf16_t*)(F.ws + WS_P)) + (size_t)(t0 + row) * LDP + C_ZB + dvc;
                const float z = bf2f(ZZ[row * 136 + 16 * w + fr]);
                if (!F.dry) *zp = (bf16_t)(pk2(o[mt][j] * rs * gn * silu(z), 0.f) & 0xffff);
            }
    }
    float* so = sample ? F.out + O_GLA_S + ((size_t)((l * 8 + (s - 16)) * 4 + h) * 64) * 128 : F.out + O_GLA_P + ((size_t)((l * 16 + s) * 4 + h) * 64) * 128;
#pragma unroll
    for (int mt = 0; mt < 4; ++mt)
#pragma unroll
        for (int j = 0; j < 4; ++j) if (!F.dry) so[(size_t)(16 * mt + 4 * fq + j) * 128 + 16 * w + fr] = S[mt][j];
}

DEV void unpack8(u32x4 u, float (&f)[8]) { f[0] = bflo(u.x); f[1] = bfhi(u.x); f[2] = bflo(u.y); f[3] = bfhi(u.y); f[4] = bflo(u.z); f[5] = bfhi(u.z); f[6] = bflo(u.w); f[7] = bfhi(u.w); }
DEV void load8f(const float* p, float (&f)[8]) { const f32x4 a = *(const f32x4*)p, b = *(const f32x4*)(p + 4); f[0] = a[0]; f[1] = a[1]; f[2] = a[2]; f[3] = a[3]; f[4] = b[0]; f[5] = b[1]; f[6] = b[2]; f[7] = b[3]; }
DEV void ffn_mid(const Frame& F0, int l) {
    REFRAME;
    const float* cw = F.in[29] + (size_t)l * 3 * 5632; const float* cb = F.in[30] + (size_t)l * 5632;
    const bf16_t* halo = ((bf16_t*)(F.ws + WS_KV)); const bf16_t* raw01 = ((bf16_t*)(F.ws + WS_KV + 11714560ull));
    for (int idx = F.bid * 512 + F.tid; idx < 112 * 704; idx += F.nb * 512) {
        const int ti = idx / 704, c4 = (idx % 704) * 4, pm = (ti / 7) * 8 + (ti % 7) + 1;
        const bf16_t* hp = halo + (size_t)(4 * pm - 1) * 2 * 5632; const bf16_t* rp = raw01 + (size_t)pm * 2 * 5632;
        const f32x4 gm2 = unpk4(*(const u32x2*)(hp + c4)), gm1 = unpk4(*(const u32x2*)(hp + 5632 + c4)), g0 = unpk4(*(const u32x2*)(rp + c4)), g1 = unpk4(*(const u32x2*)(rp + 5632 + c4));
        const f32x4 vm2 = unpk4(*(const u32x2*)(hp + 2816 + c4)), vm1 = unpk4(*(const u32x2*)(hp + 5632 + 2816 + c4)), v0 = unpk4(*(const u32x2*)(rp + 2816 + c4)), v1 = unpk4(*(const u32x2*)(rp + 5632 + 2816 + c4));
        const f32x4 wg0 = *(const f32x4*)(cw + c4), wg1 = *(const f32x4*)(cw + 5632 + c4), wg2 = *(const f32x4*)(cw + 2 * 5632 + c4), bg = *(const f32x4*)(cb + c4);
        const f32x4 wv0 = *(const f32x4*)(cw + 2816 + c4), wv1 = *(const f32x4*)(cw + 5632 + 2816 + c4), wv2 = *(const f32x4*)(cw + 2 * 5632 + 2816 + c4), bv = *(const f32x4*)(cb + 2816 + c4);
        f32x4 o0, o1;
#pragma unroll
        for (int j = 0; j < 4; ++j) {
            const float yg0 = wg0[j] * gm2[j] + wg1[j] * gm1[j] + wg2[j] * g0[j] + bg[j], yv0 = wv0[j] * vm2[j] + wv1[j] * vm1[j] + wv2[j] * v0[j] + bv[j];
            const float yg1 = wg0[j] * gm1[j] + wg1[j] * g0[j] + wg2[j] * g1[j] + bg[j], yv1 = wv0[j] * vm1[j] + wv1[j] * v0[j] + wv2[j] * v1[j] + bv[j];
            o0[j] = silu(yg0) * yv0; o1[j] = silu(yg1) * yv1;
        }
        bf16_t* vp = ((bf16_t*)(F.ws + WS_P)) + (size_t)pm * 256 * LDP + c4;
        *(u32x2*)vp = pk4(o0); *(u32x2*)(vp + LDP) = pk4(o1);
    }
}

DEV void final_norm(const Frame& F0) {
    REFRAME;
    const int gw = F.bid * 8 + F.wid, nw = F.nb * 8, lane = F.lane;
    const float* g = F.in[32];
    for (int row = gw; row < TT; row += nw) {
        const float rs = row_rstd(((float*)(F.ws + WS_SSQ)), row);
        float* X = F.out + (size_t)row * 1024;
#pragma unroll
        for (int i = 0; i < 4; ++i) { const int cidx = i * 256 + lane * 4; f32x4 v = *(const f32x4*)(X + cidx); const f32x4 gg = *(const f32x4*)(g + cidx); *(f32x4*)(X + cidx) = v * rs * gg; }
    }
}

#ifdef DBG_COL
DEV void dbg_dump(const Frame& F0) {
    REFRAME;
    for (int i = F.bid * 512 + F.tid; i < TT * 256; i += F.nb * 512) {
        const int row = i >> 8, c = (i & 255) * 4;
        const f32x4 v = c < 512 ? unpk4(*(const u32x2*)(((bf16_t*)(F.ws + WS_P)) + (size_t)row * LDP + DBG_COL + c)) : (f32x4){0.f, 0.f, 0.f, 0.f};
        *(f32x4*)(F.out + (size_t)row * 1024 + c) = (row DBG_ROWSEL) ? v : (f32x4){0.f, 0.f, 0.f, 0.f};
    }
}
#endif
#define XB_TMO      128
#define XB_XCNT(j)  (256  + 64 * (j))
#define XB_XSUB(j)  (1280 + 64 * (j))
#define XB_XGEN(j)  (2304 + 64 * (j))
#define XB_TOP      3328
#define XB_TOPGEN   3392
#define XCD_BAR_WORDS 3456
#define XB_SPIN_CAP (1u << 18)
#define LAS __attribute__((address_space(3)))

__device__ __forceinline__ unsigned xb_ld(unsigned* p)              { return __hip_atomic_load(p, __ATOMIC_RELAXED, __HIP_MEMORY_SCOPE_AGENT); }
__device__ __forceinline__ unsigned xb_add(unsigned* p, unsigned v) { return __hip_atomic_fetch_add(p, v, __ATOMIC_RELAXED, __HIP_MEMORY_SCOPE_AGENT); }
__device__ __forceinline__ unsigned xb_xcc_id() { return (unsigned)__builtin_amdgcn_s_getreg((3 << 11) | 20) & 0xFu; }
#define XB_SPIN(cond, bar) do { unsigned _sp = 0; while (cond) { __builtin_amdgcn_s_sleep(1); \
    if ((++_sp & 255u) == 0u) { if (xb_ld(&(bar)[XB_TMO])) break; if (_sp > XB_SPIN_CAP) { atomicAdd(&(bar)[XB_TMO], 1u); break; } } } } while (0)

struct XcdBarrier {
    unsigned* bar; unsigned x;
    volatile LAS unsigned* st;
};

__device__ __forceinline__ XcdBarrier xcd_barrier_post(unsigned* bar, volatile LAS unsigned* st) {
    XcdBarrier b; b.bar = bar; b.x = xb_xcc_id(); b.st = st;
    if (threadIdx.x == 0) (void)xb_add(&bar[XB_XCNT(b.x)], 1u);
    return b;
}
__device__ __forceinline__ void xcd_barrier_complete(unsigned* bar, unsigned x, unsigned& nloc, unsigned& nx) {
    const unsigned G = gridDim.x * gridDim.y * gridDim.z;
    unsigned sum, cnt, mine, sp = 0u;
    for (;;) {
        sum = 0u; cnt = 0u; mine = 0u;
#pragma unroll
        for (unsigned j = 0; j < 16; ++j) { const unsigned c = xb_ld(&bar[XB_XCNT(j)]); sum += c; cnt += (c > 0u) ? 1u : 0u; mine = (j == x) ? c : mine; }
        if (sum == G) break;
        __builtin_amdgcn_s_sleep(1);
        if ((++sp & 255u) == 0u) { if (xb_ld(&bar[XB_TMO])) break; if (sp > XB_SPIN_CAP) { atomicAdd(&bar[XB_TMO], 1u); break; } }
    }
    nloc = mine > 0u ? mine : 1u; nx = cnt > 0u ? cnt : 1u;
}

__device__ __forceinline__ void xcd_barrier(const XcdBarrier& b) {
    asm volatile("s_waitcnt vmcnt(0)" ::: "memory");
    __syncthreads();
    if (threadIdx.x == 0) {
        unsigned* bar = b.bar;
        __builtin_amdgcn_s_waitcnt(0);
        unsigned nloc = b.st[0], nx = b.st[1];
        if (nloc == 0u) { xcd_barrier_complete(bar, b.x, nloc, nx); b.st[0] = nloc; b.st[1] = nx; }
        const unsigned old = xb_add(&bar[XB_XSUB(b.x)], 1u);
        const unsigned gen = old / nloc;
        if (old + 1u == (gen + 1u) * nloc) {
            __builtin_amdgcn_fence(__ATOMIC_RELEASE, "agent");
            asm volatile("s_waitcnt vmcnt(0)" ::: "memory");
            const unsigned og = xb_add(&bar[XB_TOP], 1u);
            const unsigned tg = og / nx;
            if (og + 1u == (tg + 1u) * nx) xb_add(&bar[XB_TOPGEN], 1u);
            else XB_SPIN(xb_ld(&bar[XB_TOPGEN]) == tg, bar);
            __builtin_amdgcn_fence(__ATOMIC_ACQUIRE, "agent");
            xb_add(&bar[XB_XGEN(b.x)], 1u);
            asm volatile("s_waitcnt vmcnt(0)" ::: "memory");
        } else {
            XB_SPIN(xb_ld(&bar[XB_XGEN(b.x)]) == gen, bar);
            __builtin_amdgcn_fence(__ATOMIC_ACQUIRE, "agent");
            asm volatile("s_waitcnt vmcnt(0)" ::: "memory");
        }
    }
    __syncthreads();
}

__global__ void __launch_bounds__(512, 2) fwd_kernel(Params p) {
    extern __shared__ __attribute__((aligned(16))) unsigned char lds[];
    cg::grid_group grid = cg::this_grid();
    Frame F;
    F.in = (InTab)__builtin_amdgcn_kernarg_segment_ptr(); F.out = p.out; F.ws = p.ws; F.lds = lds;
    F.tid = threadIdx.x; F.lane = threadIdx.x & 63; F.wid = __builtin_amdgcn_readfirstlane(threadIdx.x >> 6); F.nb = gridDim.x; F.bid = blockIdx.x; F.dry = 0;
    volatile LAS unsigned* xst = (volatile LAS unsigned*)(lds + LDS_BYTES - 16);
    if (threadIdx.x == 0) { xst[0] = 0u; xst[1] = 0u; }
    __syncthreads();
    const XcdBarrier xbar = xcd_barrier_post((unsigned*)(p.ws + WS_BAR), xst);
    for (int ph = p.ph_lo; ph < p.ph_hi; ++ph) {
#ifndef PHM
#define PHM 0xffff
#endif
        if (ph == 0) { if (PHM & 0x1000) phase0(F); }
        else if (ph == NPH - 1) { if (PHM & 0x2000) final_norm(F); }
        else {
            const int l = (ph - 1) / 13, k = (ph - 1) % 13;
            int gk = -1;
            switch (k) { case 0: gk = GP_IN; break; case 3: gk = GP_OUT; break; case 4: gk = GP_OUT2; break; case 5: gk = GP_WO; break; case 6: gk = GP_MQ; break; case 7: gk = GP_ATTN; break; case 8: gk = GP_ATTN2; break;
                         case 9: gk = GP_MO; break; case 10: gk = GP_UP; break; case 12: gk = GP_DOWN; break; default: break; }
#ifndef REPMASK
#define REPMASK 0
#endif
            if (gk >= 0 && (PHM & 1)) { const int nrep = ((REPMASK >> k) & 1) ? 2 : 1; for (int rep = 0; rep < nrep; ++rep) gemm_phase(F, gk, l); }
            if (k == 0 && (PHM & 1)) small_proj(F);
            if (k == 3 && (PHM & 8)) sample_kv(F, l);
#ifndef DRYMASK
#define DRYMASK 0
#endif
            for (int dr = ((DRYMASK >> k) & 1); dr >= 0; --dr) {
            F.dry = dr;
            if (k == 1 && (PHM & 2)) {
                for (int it = F.bid; it < NCH * 8; it += F.nb) { const int c = it >> 3, h = it & 3; if (it & 4) g1_gla(F, l, c, h); else g1_gdn(F, l, c, h); }
                __syncthreads();
                if (l > 0 && !dr) cvt_ffn(F, l);
            }
            if (k == 2 && (PHM & 4)) {
                for (int it = F.bid; it < 192; it += F.nb) {
                    int s, h, br;
                    if (it < 128) { br = it & 1; h = (it >> 1) & 3; s = it >> 3; } else { const int v = it - 128; br = v & 1; h = (v >> 1) & 3; s = 16 + (v >> 3); }
                    if (br) g2_gla(F, l, s, h); else g2_gdn(F, l, s, h);
                    __syncthreads();
                }
            }
            if (k == 11 && (PHM & 0x200)) { ffn_mid(F, l); if (l < 3 && !dr) { __syncthreads(); cvt_mixer(F, l + 1); } }
            }
            F.dry = 0;
        }
#ifndef SYNCREP
#define SYNCREP 1
#endif
        if (ph + 1 < p.ph_hi) {
            if (ph == 0) grid.sync();
            else xcd_barrier(xbar);
        }
    }
#ifdef DBG_COL
    __threadfence(); grid.sync(); __threadfence();
    dbg_dump(F);
#endif
}

extern "C" void kernel_launch(void* const* d_in, const int* in_sizes, int n_in, void* d_out, int out_size, void* d_ws, size_t ws_size, hipStream_t stream) {
    static int grid_blocks = 0;
    if (grid_blocks == 0) {
        if (n_in != 33 || ws_size < WS_TOTAL) { fprintf(stderr, "kernel_launch: bad n_in %d or ws %zu < %zu\n", n_in, ws_size, (size_t)WS_TOTAL); grid_blocks = -1; return; }
        int dev = 0, cus = 0, per_cu = 0;
        hipGetDevice(&dev);
        hipDeviceGetAttribute(&cus, hipDeviceAttributeMultiprocessorCount, dev);
        if (hipFuncSetAttribute((const void*)fwd_kernel, hipFuncAttributeMaxDynamicSharedMemorySize, LDS_BYTES) != hipSuccess) { fprintf(stderr, "hipFuncSetAttribute failed\n"); grid_blocks = -1; return; }
        hipOccupancyMaxActiveBlocksPerMultiprocessor(&per_cu, (const void*)fwd_kernel, 512, LDS_BYTES);
        if (per_cu < 1) per_cu = 1;
        (void)hipGetLastError();
        grid_blocks = cus * 1;
        if (grid_blocks <= 0) grid_blocks = 256;
    }
    if (grid_blocks < 0) return;
    Params p{};
    for (int i = 0; i < 33; ++i) p.in[i] = (const float*)d_in[i];
    p.out = (float*)d_out; p.ws = (unsigned char*)d_ws; p.ph_lo = 0; p.ph_hi = PH_HI;
    (void)hipMemsetAsync((unsigned char*)d_ws + WS_BAR, 0, 16384, stream);
    void* args[] = {&p};
    hipError_t e = hipLaunchCooperativeKernel((const void*)fwd_kernel, dim3(grid_blocks), dim3(512), args, LDS_BYTES, stream);
    if (e != hipSuccess) fprintf(stderr, "cooperative launch failed: %s (grid %d)\n", hipGetErrorString(e), grid_blocks);
}
```

```cpp
#include <hip/hip_runtime.h>
#include <hip/hip_cooperative_groups.h>
#include <cstdint>
#include <cstdio>
namespace cg = cooperative_groups;

typedef unsigned short bf16_t;
typedef short bf16x8 __attribute__((ext_vector_type(8)));
typedef float f32x4 __attribute__((ext_vector_type(4)));
typedef float f32x2 __attribute__((ext_vector_type(2)));
typedef unsigned u32x2 __attribute__((ext_vector_type(2)));
typedef unsigned u32x4 __attribute__((ext_vector_type(4)));
#define DEV __device__ __forceinline__

constexpr int DM = 1024, TT = 33280, NCH = 520, LDP = 5632, LDE = 768;
constexpr int C_QA = 0, C_KA = 512, C_VA = 1024, C_ZA = 1536, C_QB = 2048, C_KB = 2304, C_VB = 2560, C_ZB = 3072, C_GA = 3584, C_GB = 4608;
constexpr int C_MRG = 0, C_PR = 1024, C_Q = 2048, C_O = 3072;
constexpr size_t O_Y = 0;
constexpr size_t O_GDN_P = 34078720ull;
constexpr size_t O_GDNC_P = O_GDN_P + 4194304ull;
constexpr size_t O_GLA_P = O_GDNC_P + 294912ull;
constexpr size_t O_FFNC_P = O_GLA_P + 2097152ull;
constexpr size_t O_MEMK = O_FFNC_P + 720896ull;
constexpr size_t O_MEMV = O_MEMK + 16777216ull;
constexpr size_t O_GDN_S = O_MEMV + 16777216ull;
constexpr size_t O_GDNC_S = O_GDN_S + 2097152ull;
constexpr size_t O_GLA_S = O_GDNC_S + 147456ull;
constexpr size_t O_FFNC_S = O_GLA_S + 1048576ull;
constexpr size_t al256(size_t x) { return (x + 255) & ~(size_t)255; }
constexpr size_t WS_WMIX = 0;
constexpr size_t WM_WIN = 0, WM_WSM = WM_WIN + 5632ull * 1024, WM_WOA = WM_WSM + 32 * 1024, WM_WOB = WM_WOA + 524288, WM_WO = WM_WOB + 524288,
                 WM_WMQ = WM_WO + 1048576, WM_WMK = WM_WMQ + 1048576, WM_WMV = WM_WMK + 1048576, WM_WMO = WM_WMV + 1048576, WM_END = WM_WMO + 1048576;
constexpr size_t WS_WFFN = al256(WS_WMIX + WM_END * 2);
constexpr size_t WF_UP = 0, WF_DN = 5632ull * 1024, WF_END = WF_DN + 1024ull * 2816;
constexpr size_t WS_XB = al256(WS_WFFN + WF_END * 2);
constexpr size_t WS_P = al256(WS_XB + (size_t)TT * 1024 * 2);
constexpr size_t WS_KV = al256(WS_P + (size_t)TT * LDP * 2);
constexpr size_t KV_BYTES = 2ull * 6144 * 1024 * 2;
constexpr size_t WS_MB = al256(WS_KV + KV_BYTES);
constexpr size_t WS_MRS = al256(WS_MB + 4096ull * 1024 * 2);
constexpr size_t WS_SSQ = al256(WS_MRS + 4096 * 4);
constexpr size_t WS_SC = al256(WS_SSQ + (size_t)TT * 16 * 4);
constexpr size_t WS_DL = al256(WS_SC + (size_t)TT * 32 * 4);
constexpr size_t WS_BG = al256(WS_DL + 520ull * 4 * 64 * 4);
constexpr size_t WS_BAR = al256(WS_BG + 520ull * 4 * 128 * 4);
constexpr size_t WS_TOTAL = al256(WS_BAR + 16384);
constexpr int LDS_BYTES = 147456;
constexpr int NPH = 54;
#ifndef PH_HI
#define PH_HI NPH
#define REPMASK 0
#define SYNCREP 1
#define DRYMASK 0
#endif

struct Params { const float* in[33]; float* out; unsigned char* ws; int ph_lo, ph_hi; };

typedef __bf16 bf16x2_t __attribute__((ext_vector_type(2)));
DEV unsigned pk2(float lo, float hi) { f32x2 f = {lo, hi}; bf16x2_t v = __builtin_convertvector(f, bf16x2_t); return __builtin_bit_cast(unsigned, v); }
DEV float bf2f(bf16_t b) { return __uint_as_float(((unsigned)b) << 16); }
DEV float bflo(unsigned u) { return __uint_as_float(u << 16); }
DEV float bfhi(unsigned u) { return __uint_as_float(u & 0xffff0000u); }
DEV u32x2 pk4(f32x4 v) { u32x2 r; r.x = pk2(v[0], v[1]); r.y = pk2(v[2], v[3]); return r; }
DEV f32x4 unpk4(u32x2 u) { return (f32x4){bflo(u.x), bfhi(u.x), bflo(u.y), bfhi(u.y)}; }
DEV bf16x8 mk8(u32x2 a, u32x2 b) { u32x4 t = {a.x, a.y, b.x, b.y}; return __builtin_bit_cast(bf16x8, t); }
DEV float sigm(float x) { return 1.f / (1.f + __expf(-x)); }
DEV float silu(float x) { return x / (1.f + __expf(-x)); }
DEV float softplus(float x) { return x > 20.f ? x : __logf(1.f + __expf(x)); }
DEV float logsigmoid(float x) { return fminf(x, 0.f) - __logf(1.f + __expf(-fabsf(x))); }
DEV float row_rstd(const float* ssq, int row) {
    const f32x4 a = *(const f32x4*)(ssq + (size_t)row * 4), b = *(const f32x4*)(ssq + ((size_t)TT + row) * 4);
    const f32x4 c = *(const f32x4*)(ssq + ((size_t)2 * TT + row) * 4), d = *(const f32x4*)(ssq + ((size_t)3 * TT + row) * 4);
    float s = ((a[0] + a[1]) + (a[2] + a[3])) + ((b[0] + b[1]) + (b[2] + b[3])) + ((c[0] + c[1]) + (c[2] + c[3])) + ((d[0] + d[1]) + (d[2] + d[3]));
    return rsqrtf(s * (1.f / 1024.f) + 1e-6f);
}
DEV bf16x8 ldfragp(const bf16_t* base, int row, int stride, int k0, int fq) {
    const bf16_t* p = base + row * stride + k0 + 4 * fq;
    return mk8(*(const u32x2*)p, *(const u32x2*)(p + 16));
}
DEV bf16x8 ldfrag(const bf16_t* base, int row, int stride, int k0, int fq) {
    return *(const bf16x8*)(base + row * stride + k0 + 8 * fq);
}
#define MFMA16(a, b, c) __builtin_amdgcn_mfma_f32_16x16x32_bf16((a), (b), (c), 0, 0, 0)

constexpr int BM = 256, BK = 64, HALF = 128, HT = HALF * BK;
DEV int lds_byte(int r, int c) { int st = (r >> 4) * 2 + (c >> 5), rr = r & 15, cc = c & 31, ob = rr * 64 + cc * 2; return st * 1024 + (ob ^ (((ob >> 9) & 1) << 5)); }
DEV void stage_rc(int b, int& R, int& C) { int st = b / 1024, sb = b % 1024, swz = sb ^ (((sb >> 9) & 1) << 5); R = (st >> 1) * 16 + swz / 64; C = (st & 1) * 32 + (swz % 64) / 2; }

DEV void gemm_core(const bf16_t* __restrict__ A, int lda, const bf16_t* __restrict__ Bt, int ldb, int K, int brow, int bcol, f32x4 (&acc)[2][2][4][2], bf16_t* shm) {
#define SA(b, h) (shm + ((b) * 2 + (h)) * HT)
#define SB(b, h) (shm + (4 + (b) * 2 + (h)) * HT)
#define STAGE(P, BASE, LD, br, kt) do { const char* _gb = (const char*)((BASE) + (long)(br) * (LD) + (long)(kt) * BK); \
    const unsigned _vo = (unsigned)((sr0 * (int)(LD) + sc0) * 2); \
    for (int _i = 0; _i < 2; ++_i) { \
      __builtin_amdgcn_global_load_lds((const unsigned*)(_gb + (long)(_i * 128) * (LD) + _vo), (unsigned*)((char*)(P) + wbase + _i * 8192), 16, 0, 0); } } while (0)
#define LDA(dst, b, h) for (int m = 0; m < 4; ++m) for (int k = 0; k < 2; ++k) \
    dst[m][k] = *reinterpret_cast<const bf16x8*>((char*)SA(b, h) + lds_byte(wr * 64 + m * 16 + fr, k * 32 + fq * 8))
#define LDB(dst, b, h) for (int n = 0; n < 2; ++n) for (int k = 0; k < 2; ++k) \
    dst[n][k] = *reinterpret_cast<const bf16x8*>((char*)SB(b, h) + lds_byte(wc * 32 + n * 16 + fr, k * 32 + fq * 8))
#define MMA(ai, bj, At_, Bt_) do { __builtin_amdgcn_s_setprio(1); \
    for (int m = 0; m < 4; ++m) for (int n = 0; n < 2; ++n) for (int k = 0; k < 2; ++k) \
      acc[ai][bj][m][n] = __builtin_amdgcn_mfma_f32_16x16x32_bf16(Bt_[n][k], At_[m][k], acc[ai][bj][m][n], 0, 0, 0); \
    __builtin_amdgcn_s_setprio(0); } while (0)
#define WAIT_V(n) asm volatile("s_waitcnt vmcnt(" #n ")" ::: "memory")
#define WAIT_L(n) asm volatile("s_waitcnt lgkmcnt(" #n ")" ::: "memory")
#define BAR __builtin_amdgcn_s_barrier()
#define SCHED __builtin_amdgcn_sched_barrier(0)
    int tidx = threadIdx.x; asm volatile("" : "+v"(tidx));
    const int wid = __builtin_amdgcn_readfirstlane(tidx >> 6), lane = tidx & 63, wr = wid >> 2, wc = wid & 3, fr = lane & 15, fq = lane >> 4;
    const int wbase = wid * 1024;
    int sr0, sc0; stage_rc(tidx * 16, sr0, sc0);
#pragma unroll
    for (int a = 0; a < 2; ++a)
#pragma unroll
        for (int b = 0; b < 2; ++b)
#pragma unroll
            for (int m = 0; m < 4; ++m)
#pragma unroll
                for (int n = 0; n < 2; ++n) acc[a][b][m][n] = (f32x4){0.f, 0.f, 0.f, 0.f};
    bf16x8 At[4][2], B0[2][2], B1[2][2];
    const int nt = K / BK;
    STAGE(SB(0, 0), Bt, ldb, bcol, 0); STAGE(SA(0, 0), A, lda, brow, 0);
    STAGE(SB(0, 1), Bt, ldb, bcol + HALF, 0); STAGE(SA(0, 1), A, lda, brow + HALF, 0);
    if (wr == 1) BAR;
    WAIT_V(4); BAR;
    STAGE(SB(1, 0), Bt, ldb, bcol, 1); STAGE(SA(1, 0), A, lda, brow, 1); STAGE(SB(1, 1), Bt, ldb, bcol + HALF, 1);
    WAIT_V(6); BAR;
    for (int t = 0; t < nt - 2; t += 2) {
        LDB(B0, 0, 0); SCHED; LDA(At, 0, 0); STAGE(SA(1, 1), A, lda, brow + HALF, t + 1);
        WAIT_L(8); BAR; WAIT_L(0); MMA(0, 0, At, B0); BAR; SCHED;
        LDB(B1, 0, 1); STAGE(SB(0, 0), Bt, ldb, bcol, t + 2);
        BAR; WAIT_L(0); MMA(0, 1, At, B1); BAR;
        LDA(At, 0, 1); STAGE(SA(0, 0), A, lda, brow, t + 2);
        BAR; WAIT_L(0); MMA(1, 0, At, B0); BAR; SCHED;
        STAGE(SB(0, 1), Bt, ldb, bcol + HALF, t + 2);
        WAIT_V(6); BAR; MMA(1, 1, At, B1); BAR;
        LDB(B0, 1, 0); SCHED; LDA(At, 1, 0); STAGE(SA(0, 1), A, lda, brow + HALF, t + 2);
        WAIT_L(8); BAR; WAIT_L(0); MMA(0, 0, At, B0); BAR; SCHED;
        LDB(B1, 1, 1); STAGE(SB(1, 0), Bt, ldb, bcol, t + 3);
        BAR; WAIT_L(0); MMA(0, 1, At, B1); BAR;
        LDA(At, 1, 1); STAGE(SA(1, 0), A, lda, brow, t + 3);
        BAR; WAIT_L(0); MMA(1, 0, At, B0); BAR; SCHED;
        STAGE(SB(1, 1), Bt, ldb, bcol + HALF, t + 3);
        WAIT_V(6); BAR; MMA(1, 1, At, B1); BAR;
    }
    { LDB(B0, 0, 0); LDA(At, 0, 0); STAGE(SA(1, 1), A, lda, brow + HALF, nt - 1);
      BAR; WAIT_L(0); MMA(0, 0, At, B0); BAR;
      LDB(B1, 0, 1); BAR; WAIT_L(0); MMA(0, 1, At, B1); BAR;
      LDA(At, 0, 1); WAIT_V(4); BAR; WAIT_L(0); MMA(1, 0, At, B0); MMA(1, 1, At, B1); BAR; }
    { LDB(B0, 1, 0); LDA(At, 1, 0); WAIT_V(2); BAR; WAIT_L(0); MMA(0, 0, At, B0); BAR;
      LDB(B1, 1, 1); WAIT_V(0); BAR; WAIT_L(0); MMA(0, 1, At, B1); BAR;
      LDA(At, 1, 1); BAR; WAIT_L(0); MMA(1, 0, At, B0); MMA(1, 1, At, B1); BAR; }
    if (wr == 0) BAR;
    SCHED;
#undef SA
#undef SB
}

typedef const float* const __attribute__((address_space(4)))* InTab;
struct Frame {
    InTab in; float* out; unsigned char* ws; unsigned char* lds;
    int tid, lane, wid, nb, bid, dry;
};
#define REFRAME Frame F = F0; { int t_ = threadIdx.x; asm volatile("" : "+v"(t_)); F.tid = t_; F.lane = t_ & 63; unsigned char* w_ = F.ws; asm volatile("" : "+s"(w_)); F.ws = w_; float* o_ = F.out; asm volatile("" : "+s"(o_)); F.out = o_; InTab i_ = (InTab)__builtin_amdgcn_kernarg_segment_ptr(); asm volatile("" : "+s"(i_)); F.in = i_; int a_ = F.wid, b_ = F.bid, c_ = F.nb; asm volatile("" : "+s"(a_), "+s"(b_), "+s"(c_)); F.wid = a_; F.bid = b_; F.nb = c_; }

enum { EPI_PROJ = 0, EPI_UP, EPI_RESID, EPI_Q, EPI_MEMK, EPI_MEMV, EPI_OUTA, EPI_OUTB, EPI_SOFTMAX, EPI_ATTNO };
struct GDesc { const bf16_t* A; int lda; const bf16_t* Bt; int ldb; int K, brow, bcol, epi, orow, ocol, head, vai, vwr; };

DEV void cvt_mat(const Frame& F0, const float* src, int ldsrc, int K, int N, int wincols, const float* gain, bf16_t* dst) {
    REFRAME;
    float* T = (float*)F.lds;
    const int nkt = K / 64, nnt = N / 64, ntile = nkt * nnt;
    for (int t = F.bid; t < ntile; t += F.nb) {
        const int kt = t / nnt, ntl = t % nnt, k0 = kt * 64, n0 = ntl * 64;
        int coff = 0; if (wincols == 1) coff = (n0 < 1536) ? 0 : (n0 < 3072 ? 8 : 24);
        if (wincols == 2) { const int tl = n0 >> 8, w = n0 & 255; coff = (w < 128 ? 128 * tl + w : 2816 + 128 * tl + (w - 128)) - n0; }
        __syncthreads();
#pragma unroll
        for (int i = 0; i < 2; ++i) {
            const int kr = (F.tid >> 4) + 32 * i, nc = (F.tid & 15) * 4;
            f32x4 v = *(const f32x4*)(src + (size_t)(k0 + kr) * ldsrc + n0 + coff + nc);
            const float g = gain ? gain[k0 + kr] : 1.f;
            T[kr * 65 + nc + 0] = v[0] * g; T[kr * 65 + nc + 1] = v[1] * g; T[kr * 65 + nc + 2] = v[2] * g; T[kr * 65 + nc + 3] = v[3] * g;
        }
        __syncthreads();
        const int n = F.tid >> 3, kc = (F.tid & 7) * 8;
        u32x4 w;
        w.x = pk2(T[(kc + 0) * 65 + n], T[(kc + 1) * 65 + n]); w.y = pk2(T[(kc + 2) * 65 + n], T[(kc + 3) * 65 + n]);
        w.z = pk2(T[(kc + 4) * 65 + n], T[(kc + 5) * 65 + n]); w.w = pk2(T[(kc + 6) * 65 + n], T[(kc + 7) * 65 + n]);
        *(u32x4*)(dst + (size_t)(n0 + n) * K + k0 + kc) = w;
    }
    __syncthreads();
}
DEV void cvt_mixer(const Frame& F0, int l) {
    REFRAME;
    InTab in = F.in;
    cvt_mat(F, in[10] + (size_t)l * 1024 * 5656, 5656, 1024, 5632, 1, in[9] + l * 1024, ((bf16_t*)(F.ws + WS_WMIX)) + WM_WIN);
    cvt_mat(F, in[18] + (size_t)l * 512 * 1024, 1024, 512, 1024, 0, nullptr, ((bf16_t*)(F.ws + WS_WMIX)) + WM_WOA);
    cvt_mat(F, in[19] + (size_t)l * 512 * 1024, 1024, 512, 1024, 0, nullptr, ((bf16_t*)(F.ws + WS_WMIX)) + WM_WOB);
    cvt_mat(F, in[20] + (size_t)l * 1048576, 1024, 1024, 1024, 0, nullptr, ((bf16_t*)(F.ws + WS_WMIX)) + WM_WO);
    cvt_mat(F, in[23] + (size_t)l * 1048576, 1024, 1024, 1024, 0, in[21] + l * 1024, ((bf16_t*)(F.ws + WS_WMIX)) + WM_WMQ);
    cvt_mat(F, in[24] + (size_t)l * 1048576, 1024, 1024, 1024, 0, in[22] + l * 1024, ((bf16_t*)(F.ws + WS_WMIX)) + WM_WMK);
    cvt_mat(F, in[25] + (size_t)l * 1048576, 1024, 1024, 1024, 0, in[22] + l * 1024, ((bf16_t*)(F.ws + WS_WMIX)) + WM_WMV);
    cvt_mat(F, in[26] + (size_t)l * 1048576, 1024, 1024, 1024, 0, nullptr, ((bf16_t*)(F.ws + WS_WMIX)) + WM_WMO);
    const float* win = in[10] + (size_t)l * 1024 * 5656; const float* g = in[9] + l * 1024;
    for (int i = F.bid * 512 + F.tid; i < 32 * 1024; i += F.nb * 512) {
        const int n = i >> 10, k = i & 1023;
        float v = 0.f;
        if (n < 8) v = win[(size_t)k * 5656 + 1536 + n] * g[k]; else if (n < 24) v = win[(size_t)k * 5656 + 3080 + (n - 8)] * g[k];
        ((bf16_t*)(F.ws + WS_WMIX))[WM_WSM + i] = (bf16_t)(pk2(v, 0.f) & 0xffff);
    }
}
DEV void cvt_ffn(const Frame& F, int l) {
    cvt_mat(F, F.in[28] + (size_t)l * 1024 * 5632, 5632, 1024, 5632, 2, F.in[27] + l * 1024, ((bf16_t*)(F.ws + WS_WFFN)) + WF_UP);
    cvt_mat(F, F.in[31] + (size_t)l * 2816 * 1024, 1024, 2816, 1024, 0, nullptr, ((bf16_t*)(F.ws + WS_WFFN)) + WF_DN);
}

DEV void phase0(const Frame& F0) {
    REFRAME;
    const int gw = F.bid * 8 + F.wid, nw = F.nb * 8, lane = F.lane;
    for (int row = gw; row < TT + 4096; row += nw) {
        const bool ismem = row >= TT;
        const float* src = ismem ? F.in[8] + (size_t)(row - TT) * 1024 : (row < 32768 ? F.in[0] + (size_t)row * 1024 : F.in[1] + (size_t)(row - 32768) * 1024);
        f32x4 v[4]; float s = 0.f;
#pragma unroll
        for (int i = 0; i < 4; ++i) { v[i] = *(const f32x4*)(src + lane * 16 + i * 4); s += v[i][0] * v[i][0] + v[i][1] * v[i][1] + v[i][2] * v[i][2] + v[i][3] * v[i][3]; }
        u32x4 w0, w1;
        w0.x = pk2(v[0][0], v[0][1]); w0.y = pk2(v[0][2], v[0][3]); w0.z = pk2(v[1][0], v[1][1]); w0.w = pk2(v[1][2], v[1][3]);
        w1.x = pk2(v[2][0], v[2][1]); w1.y = pk2(v[2][2], v[2][3]); w1.z = pk2(v[3][0], v[3][1]); w1.w = pk2(v[3][2], v[3][3]);
        s += __shfl_xor(s, 1); s += __shfl_xor(s, 2);
        if (!ismem) {
            float* X = F.out + (size_t)row * 1024 + lane * 16;
#pragma unroll
            for (int i = 0; i < 4; ++i) *(f32x4*)(X + i * 4) = v[i];
            bf16_t* xb = ((bf16_t*)(F.ws + WS_XB)) + (size_t)row * 1024 + lane * 16;
            *(u32x4*)xb = w0; *(u32x4*)(xb + 8) = w1;
            if ((lane & 3) == 0) ((float*)(F.ws + WS_SSQ))[((size_t)(lane >> 4) * TT + row) * 4 + ((lane >> 2) & 3)] = s;
        } else {
            const int mr = row - TT;
            bf16_t* mb = ((bf16_t*)(F.ws + WS_MB)) + (size_t)mr * 1024 + lane * 16;
            *(u32x4*)mb = w0; *(u32x4*)(mb + 8) = w1;
            s += __shfl_xor(s, 4); s += __shfl_xor(s, 8); s += __shfl_xor(s, 16); s += __shfl_xor(s, 32);
            if (lane == 0) ((float*)(F.ws + WS_MRS))[mr] = rsqrtf(s * (1.f / 1024.f) + 1e-6f);
        }
    }
    cvt_mixer(F, 0);
    cvt_ffn(F, 0);
}

DEV void small_proj(const Frame& F0) {
    REFRAME;
    const int lane = F.lane, fr = lane & 15, fq = lane >> 4, mt = F.wid & 3, nt = F.wid >> 2;
    for (int c = F.bid; c < NCH; c += F.nb) {
        const int row = c * 64 + mt * 16 + fr;
        const bf16_t* a = ((bf16_t*)(F.ws + WS_XB)) + (size_t)row * 1024 + 8 * fq;
        const bf16_t* b = ((bf16_t*)(F.ws + WS_WMIX)) + WM_WSM + (size_t)(nt * 16 + fr) * 1024 + 8 * fq;
        f32x4 acc = {0.f, 0.f, 0.f, 0.f};
#pragma unroll 4
        for (int k = 0; k < 32; ++k) acc = MFMA16(*(const bf16x8*)(b + k * 32), *(const bf16x8*)(a + k * 32), acc);
        const float rs = row_rstd(((float*)(F.ws + WS_SSQ)), row);
        *(f32x4*)(((float*)(F.ws + WS_SC)) + (size_t)row * 32 + nt * 16 + 4 * fq) = acc * rs;
    }
}

DEV void gemm_epilogue(const Frame& F0, const GDesc& d, int l, f32x4 (&acc)[2][2][4][2]) {
    REFRAME;
    int lane_ = F.lane; asm volatile("" : "+v"(lane_));
    const int wr = F.wid >> 2, wc = F.wid & 3, fr = lane_ & 15, fq = lane_ >> 4;
    float* red = (float*)(F.lds + 131072);
    if (d.epi == EPI_SOFTMAX) {
        float mx[2][4];
#pragma unroll
        for (int ai = 0; ai < 2; ++ai)
#pragma unroll
            for (int m = 0; m < 4; ++m) {
                float v = -3.0e38f;
#pragma unroll
                for (int bj = 0; bj < 2; ++bj)
#pragma unroll
                    for (int n = 0; n < 2; ++n) { const f32x4 x = acc[ai][bj][m][n]; v = fmaxf(v, fmaxf(fmaxf(x[0], x[1]), fmaxf(x[2], x[3]))); }
                v = fmaxf(v, __shfl_xor(v, 16)); v = fmaxf(v, __shfl_xor(v, 32));
                if (fq == 0) red[(ai * 128 + wr * 64 + m * 16 + fr) * 4 + wc] = v;
            }
        __syncthreads();
#pragma unroll
        for (int ai = 0; ai < 2; ++ai)
#pragma unroll
            for (int m = 0; m < 4; ++m) {
                const f32x4 r4 = *(const f32x4*)(red + (ai * 128 + wr * 64 + m * 16 + fr) * 4);
                const float rm = fmaxf(fmaxf(r4[0], r4[1]), fmaxf(r4[2], r4[3]));
                mx[ai][m] = rm; float s = 0.f;
#pragma unroll
                for (int bj = 0; bj < 2; ++bj)
#pragma unroll
                    for (int n = 0; n < 2; ++n) { f32x4 x = acc[ai][bj][m][n];
#pragma unroll
                        for (int j = 0; j < 4; ++j) { x[j] = __expf(x[j] - rm); s += x[j]; }
                        acc[ai][bj][m][n] = x; }
                s += __shfl_xor(s, 16); s += __shfl_xor(s, 32);
                if (fq == 0) red[1024 + (ai * 128 + wr * 64 + m * 16 + fr) * 4 + wc] = s;
            }
        (void)mx;
        __syncthreads();
#pragma unroll
        for (int ai = 0; ai < 2; ++ai)
#pragma unroll
            for (int m = 0; m < 4; ++m) {
                const f32x4 r4 = *(const f32x4*)(red + 1024 + (ai * 128 + wr * 64 + m * 16 + fr) * 4);
                const float inv = 1.f / ((r4[0] + r4[1]) + (r4[2] + r4[3]));
                const bool valid = d.vai < 0 || (d.vai == ai && d.vwr == wr);
                const int row = d.orow + ai * 128 + wr * 64 + m * 16 + fr;
                if (valid) {
#pragma unroll
                    for (int bj = 0; bj < 2; ++bj)
#pragma unroll
                        for (int n = 0; n < 2; ++n) {
                            const int col = bj * 128 + wc * 32 + n * 16 + fq * 4;
                            *(u32x2*)(((bf16_t*)(F.ws + WS_P)) + (size_t)row * LDP + C_PR + d.head * 256 + col) = pk4(acc[ai][bj][m][n] * inv);
                        }
                }
            }
        __syncthreads();
        return;
    }
#pragma unroll
    for (int ai = 0; ai < 2; ++ai)
#pragma unroll
        for (int m = 0; m < 4; ++m) {
            const int row = d.orow + ai * 128 + wr * 64 + m * 16 + fr;
            float rs = 1.f, ss = 0.f;
            if (d.epi == EPI_PROJ || d.epi == EPI_UP || d.epi == EPI_Q) rs = row_rstd(((float*)(F.ws + WS_SSQ)), row);
            if (d.epi == EPI_Q) rs *= 0.0625f;
            if (d.epi == EPI_MEMK) rs = ((float*)(F.ws + WS_MRS))[row];
#pragma unroll
            for (int bj = 0; bj < 2; ++bj)
#pragma unroll
                for (int n = 0; n < 2; ++n) {
                    const int col = d.ocol + bj * 128 + wc * 32 + n * 16 + fq * 4;
                    f32x4 v = acc[ai][bj][m][n];
                    switch (d.epi) {
                    case EPI_UP: {
                        const int row_l = ai * 128 + wr * 64 + m * 16 + fr, cl = bj * 128 + wc * 32 + n * 16 + fq * 4;
                        *(u32x2*)((bf16_t*)F.lds + row_l * 264 + cl) = pk4(v * rs);
                    } break;
                    case EPI_PROJ: {
                        v = v * rs; const u32x2 w = pk4(v);
                        *(u32x2*)(((bf16_t*)(F.ws + WS_P)) + (size_t)row * LDP + col) = w;
                        if (m == 3 && fr >= 13 && col < 1536) {
                            const int chunk = row >> 6, hr = fr - 13;
                            *(u32x2*)(((bf16_t*)(F.ws + WS_KV)) + ((size_t)chunk * 3 + hr) * 1536 + col) = w;
                            if (chunk >= 512 || (chunk & 31) == 31) {
                                float* o = chunk < 512 ? F.out + O_GDNC_P + ((size_t)(l * 16 + (chunk >> 5)) * 3 + hr) * 1536 + col
                                                       : F.out + O_GDNC_S + ((size_t)(l * 8 + (chunk - 512)) * 3 + hr) * 1536 + col;
                                *(f32x4*)o = v;
                            }
                        }
                    } break;
                    case EPI_RESID: {
                        float* X = F.out + (size_t)row * 1024 + col;
                        f32x4 x = *(const f32x4*)X; x = x + v; *(f32x4*)X = x;
                        *(u32x2*)(((bf16_t*)(F.ws + WS_XB)) + (size_t)row * 1024 + col) = pk4(x);
                        ss += (x[0] * x[0] + x[1] * x[1]) + (x[2] * x[2] + x[3] * x[3]);
                    } break;
                    case EPI_Q: *(u32x2*)(((bf16_t*)(F.ws + WS_P)) + (size_t)row * LDP + C_Q + col) = pk4(v * rs); break;
                    case EPI_MEMK: {
                        v = v * rs;
                        *(f32x4*)(F.out + O_MEMK + ((size_t)l * 4096 + row) * 1024 + col) = v;
                        *(u32x2*)(((bf16_t*)(F.ws + WS_KV)) + (size_t)row * 1024 + col) = pk4(v);
                    } break;
                    case EPI_MEMV: {
                        const f32x4 r4 = *(const f32x4*)(((float*)(F.ws + WS_MRS)) + col);
                        v = v * r4;
                        float* o = F.out + O_MEMV + ((size_t)l * 4096 + col) * 1024 + row;
                        o[0] = v[0]; o[1024] = v[1]; o[2048] = v[2]; o[3072] = v[3];
                        const int b = col >> 8, h = row >> 8;
                        *(u32x2*)(((bf16_t*)(F.ws + WS_KV + 6144ull * 1024 * 2)) + ((size_t)(b * 4 + h) * 256 + (row & 255)) * 256 + (col & 255)) = pk4(v);
                    } break;
                    case EPI_OUTA: {
                        const f32x4 g = unpk4(*(const u32x2*)(((bf16_t*)(F.ws + WS_P)) + (size_t)row * LDP + C_GA + col));
                        f32x4 o; for (int j = 0; j < 4; ++j) o[j] = sigm(g[j]) * v[j];
                        *(u32x2*)(((bf16_t*)(F.ws + WS_P)) + (size_t)row * LDP + C_MRG + col) = pk4(o);
                    } break;
                    case EPI_OUTB: {
                        const f32x4 g = unpk4(*(const u32x2*)(((bf16_t*)(F.ws + WS_P)) + (size_t)row * LDP + C_GB + col));
                        f32x4 o = unpk4(*(const u32x2*)(((bf16_t*)(F.ws + WS_P)) + (size_t)row * LDP + C_MRG + col));
                        for (int j = 0; j < 4; ++j) o[j] += sigm(g[j]) * v[j];
                        *(u32x2*)(((bf16_t*)(F.ws + WS_P)) + (size_t)row * LDP + C_MRG + col) = pk4(o);
                    } break;
                    case EPI_ATTNO: {
                        const bool valid = d.vai < 0 || (d.vai == ai && d.vwr == wr);
                        if (valid) *(u32x2*)(((bf16_t*)(F.ws + WS_P)) + (size_t)row * LDP + C_O + d.head * 256 + col) = pk4(v);
                    } break;
                    default: break;
                    }
                }
            if (d.epi == EPI_RESID) {
                ss += __shfl_xor(ss, 16); ss += __shfl_xor(ss, 32);
                if (fq == 0) ((float*)(F.ws + WS_SSQ))[((size_t)(d.ocol >> 8) * TT + row) * 4 + wc] = ss;
            }
        }
    if (d.epi == EPI_UP) {
        bf16_t* ST = (bf16_t*)F.lds;
        const int pm = d.brow >> 8, pn = d.bcol >> 8;
        const bool samp = pm >= 128, needfix = !samp && (pm & 7) != 0;
        bf16_t* halo = ((bf16_t*)(F.ws + WS_KV)); bf16_t* raw01 = ((bf16_t*)(F.ws + WS_KV + 11714560ull));
        __syncthreads();
        {
            const int hsel = F.tid >> 6, cl4 = (F.tid & 63) * 4, ocol = ((cl4 >> 7) ? 2816 : 0) + 128 * pn + (cl4 & 127);
            const int row_l = (hsel >> 1) * 64 + 62 + (hsel & 1), chunk = (d.brow + row_l) >> 6, hr = hsel & 1;
            const u32x2 w = *(const u32x2*)(ST + row_l * 264 + cl4);
            *(u32x2*)(halo + ((size_t)chunk * 2 + hr) * 5632 + ocol) = w;
            if (chunk >= 512 || (chunk & 31) == 31) {
                float* o = chunk < 512 ? F.out + O_FFNC_P + ((size_t)(l * 16 + (chunk >> 5)) * 2 + hr) * 5632 + ocol
                                       : F.out + O_FFNC_S + ((size_t)(l * 8 + (chunk - 512)) * 2 + hr) * 5632 + ocol;
                *(f32x4*)o = unpk4(w);
            }
            if (needfix && hsel < 2) *(u32x2*)(raw01 + ((size_t)pm * 2 + hsel) * 5632 + ocol) = *(const u32x2*)(ST + hsel * 264 + cl4);
        }
        {
            const int cq = F.tid & 31, rg = F.tid >> 5, c4 = cq * 4, gcol = 128 * pn + c4, r0 = rg * 16;
            const float* cw = F.in[29] + (size_t)l * 3 * 5632; const float* cb = F.in[30] + (size_t)l * 5632;
            const f32x4 wg0 = *(const f32x4*)(cw + gcol), wg1 = *(const f32x4*)(cw + 5632 + gcol), wg2 = *(const f32x4*)(cw + 2 * 5632 + gcol), bg = *(const f32x4*)(cb + gcol);
            const f32x4 wv0 = *(const f32x4*)(cw + 2816 + gcol), wv1 = *(const f32x4*)(cw + 5632 + 2816 + gcol), wv2 = *(const f32x4*)(cw + 2 * 5632 + 2816 + gcol), bv = *(const f32x4*)(cb + 2816 + gcol);
            f32x4 g2 = {0.f, 0.f, 0.f, 0.f}, g1 = g2, v2 = g2, v1 = g2; bool skip2 = false;
            if ((samp ? (r0 & 63) : r0) != 0) {
                g2 = unpk4(*(const u32x2*)(ST + (r0 - 2) * 264 + c4)); g1 = unpk4(*(const u32x2*)(ST + (r0 - 1) * 264 + c4));
                v2 = unpk4(*(const u32x2*)(ST + (r0 - 2) * 264 + 128 + c4)); v1 = unpk4(*(const u32x2*)(ST + (r0 - 1) * 264 + 128 + c4));
            } else if (samp) {
                const float* sp = F.in[5] + (size_t)(l * 8 + (((d.brow + r0) >> 6) - 512)) * 2 * 5632;
                g2 = *(const f32x4*)(sp + gcol); g1 = *(const f32x4*)(sp + 5632 + gcol); v2 = *(const f32x4*)(sp + 2816 + gcol); v1 = *(const f32x4*)(sp + 5632 + 2816 + gcol);
            } else skip2 = needfix;
#pragma unroll 4
            for (int i = 0; i < 16; ++i) {
                const int row_l = r0 + i;
                const f32x4 g0 = unpk4(*(const u32x2*)(ST + row_l * 264 + c4)), v0 = unpk4(*(const u32x2*)(ST + row_l * 264 + 128 + c4));
                f32x4 o;
#pragma unroll
                for (int j = 0; j < 4; ++j) { const float yg = wg0[j] * g2[j] + wg1[j] * g1[j] + wg2[j] * g0[j] + bg[j], yv = wv0[j] * v2[j] + wv1[j] * v1[j] + wv2[j] * v0[j] + bv[j]; o[j] = silu(yg) * yv; }
                if (!(skip2 && i < 2)) *(u32x2*)(((bf16_t*)(F.ws + WS_P)) + (size_t)(d.brow + row_l) * LDP + gcol) = pk4(o);
                g2 = g1; g1 = g0; v2 = v1; v1 = v0;
            }
        }
        __syncthreads();
    }
}

DEV void sample_rows_gemm(const Frame& F0, const bf16_t* A, int lda, const bf16_t* Bt, int K, int resid) {
    REFRAME;
    if (F.nb != 256) return;
    const int fr = F.lane & 15, fq = F.lane >> 4, w = F.wid, rgp = F.bid >> 3, cg = F.bid & 7;
    const int row = 32768 + rgp * 16 + fr, colt = cg * 128 + w * 16;
    const bf16_t* ap = A + (size_t)row * lda + 8 * fq;
    const bf16_t* bp = Bt + (size_t)(colt + fr) * K + 8 * fq;
    f32x4 acc = {0.f, 0.f, 0.f, 0.f};
#pragma unroll 8
    for (int k = 0; k < K; k += 32) acc = MFMA16(*(const bf16x8*)(bp + k), *(const bf16x8*)(ap + k), acc);
    const int col = colt + 4 * fq;
    if (resid) {
        float* X = F.out + (size_t)row * 1024 + col;
        f32x4 x = *(const f32x4*)X; x = x + acc; *(f32x4*)X = x;
        *(u32x2*)(((bf16_t*)(F.ws + WS_XB)) + (size_t)row * 1024 + col) = pk4(x);
        float ss = (x[0] * x[0] + x[1] * x[1]) + (x[2] * x[2] + x[3] * x[3]);
        ss += __shfl_xor(ss, 16); ss += __shfl_xor(ss, 32);
        float* red = (float*)F.lds;
        __syncthreads();
        if (fq == 0) red[fr * 8 + w] = ss;
        __syncthreads();
        if (F.tid < 32) {
            const int r = F.tid & 15, g = F.tid >> 4, c0 = cg * 128 + g * 64;
            const float t = (red[r * 8 + g * 4] + red[r * 8 + g * 4 + 1]) + (red[r * 8 + g * 4 + 2] + red[r * 8 + g * 4 + 3]);
            ((float*)(F.ws + WS_SSQ))[((size_t)(c0 >> 8) * TT + 32768 + rgp * 16 + r) * 4 + ((c0 >> 6) & 3)] = t;
        }
        __syncthreads();
    } else {
        const float rs = row_rstd(((float*)(F.ws + WS_SSQ)), row) * 0.0625f;
        *(u32x2*)(((bf16_t*)(F.ws + WS_P)) + (size_t)row * LDP + C_Q + col) = pk4(acc * rs);
    }
}

enum { GP_IN = 0, GP_OUT, GP_WO, GP_MQ, GP_ATTN, GP_MO, GP_UP, GP_DOWN, GP_ATTN2, GP_OUT2 };
DEV void gemm_phase(const Frame& F0, int kind, int l) {
    REFRAME;
    int nunits = 0;
    switch (kind) { case GP_IN: case GP_UP: nunits = 130 * 22; break; case GP_OUT: nunits = 520 + 128; break; case GP_OUT2: nunits = 520; break; case GP_ATTN: case GP_ATTN2: nunits = 512 + 32; break; default: nunits = 520; }
    const bool srow = (F.nb == 256) && (kind == GP_WO || kind == GP_MQ || kind == GP_MO || kind == GP_DOWN);
    if (srow) nunits = 512;
    f32x4 acc[2][2][4][2];
    const bool xmap = (F.nb == 256) && (kind == GP_IN || kind == GP_UP || kind == GP_WO || kind == GP_MQ || kind == GP_MO || kind == GP_DOWN || kind == GP_OUT2);
    const int xcd = F.bid & 7, slot = F.bid >> 3, w_lo = (int)(((long)nunits * xcd) >> 3), w_hi = (int)(((long)nunits * (xcd + 1)) >> 3);
    for (int u0 = xmap ? w_lo + slot : F.bid; u0 < (xmap ? w_hi : nunits); u0 += xmap ? 32 : F.nb) {
        int u = u0;
        if (xmap) { const int nn = (kind == GP_IN || kind == GP_UP) ? 22 : 4; const int nm = srow ? 128 : 130; const int pn_ = u0 / nm, pm_ = u0 % nm; u = pm_ * nn + pn_; }
        GDesc d;
        { const int sub = (kind == GP_ATTN2 || kind == GP_OUT2) ? 1 : 0;
            d.vai = -1; d.vwr = 0; d.head = 0;
            switch (kind) {
            case GP_IN: { const int pm = u / 22, pn = u % 22; d.A = ((bf16_t*)(F.ws + WS_XB)); d.lda = 1024; d.Bt = ((bf16_t*)(F.ws + WS_WMIX)) + WM_WIN; d.ldb = 1024; d.K = 1024; d.brow = pm * 256; d.bcol = pn * 256; d.epi = EPI_PROJ; d.orow = d.brow; d.ocol = d.bcol; } break;
            case GP_UP: { const int pm = u / 22, pn = u % 22; d.A = ((bf16_t*)(F.ws + WS_XB)); d.lda = 1024; d.Bt = ((bf16_t*)(F.ws + WS_WFFN)) + WF_UP; d.ldb = 1024; d.K = 1024; d.brow = pm * 256; d.bcol = pn * 256; d.epi = EPI_UP; d.orow = d.brow; d.ocol = d.bcol; } break;
            case GP_OUT: case GP_OUT2:
                if (u < 520) { const int pm = u >> 2, pn = u & 3; d.A = ((bf16_t*)(F.ws + WS_P)) + (sub == 0 ? C_ZA : C_ZB); d.lda = LDP; d.Bt = ((bf16_t*)(F.ws + WS_WMIX)) + (sub == 0 ? WM_WOA : WM_WOB); d.ldb = 512; d.K = 512;
                               d.brow = pm * 256; d.bcol = pn * 256; d.epi = sub == 0 ? EPI_OUTA : EPI_OUTB; d.orow = d.brow; d.ocol = d.bcol; }
                else if (u < 520 + 64) { const int v = u - 520, pm = v >> 2, pn = v & 3; d.A = ((bf16_t*)(F.ws + WS_MB)); d.lda = 1024; d.Bt = ((bf16_t*)(F.ws + WS_WMIX)) + WM_WMK; d.ldb = 1024; d.K = 1024; d.brow = pm * 256; d.bcol = pn * 256; d.epi = EPI_MEMK; d.orow = d.brow; d.ocol = d.bcol; }
                else { const int v = u - 584, pm = v & 3, pn = v >> 2; d.A = ((bf16_t*)(F.ws + WS_WMIX)) + WM_WMV; d.lda = 1024; d.Bt = ((bf16_t*)(F.ws + WS_MB)); d.ldb = 1024; d.K = 1024; d.brow = pm * 256; d.bcol = pn * 256; d.epi = EPI_MEMV; d.orow = d.brow; d.ocol = d.bcol; }
                break;
            case GP_WO: { const int pm = u >> 2, pn = u & 3; d.A = ((bf16_t*)(F.ws + WS_P)) + C_MRG; d.lda = LDP; d.Bt = ((bf16_t*)(F.ws + WS_WMIX)) + WM_WO; d.ldb = 1024; d.K = 1024; d.brow = pm * 256; d.bcol = pn * 256; d.epi = EPI_RESID; d.orow = d.brow; d.ocol = d.bcol; } break;
            case GP_MQ: { const int pm = u >> 2, pn = u & 3; d.A = ((bf16_t*)(F.ws + WS_XB)); d.lda = 1024; d.Bt = ((bf16_t*)(F.ws + WS_WMIX)) + WM_WMQ; d.ldb = 1024; d.K = 1024; d.brow = pm * 256; d.bcol = pn * 256; d.epi = EPI_Q; d.orow = d.brow; d.ocol = d.bcol; } break;
            case GP_MO: { const int pm = u >> 2, pn = u & 3; d.A = ((bf16_t*)(F.ws + WS_P)) + C_O; d.lda = LDP; d.Bt = ((bf16_t*)(F.ws + WS_WMIX)) + WM_WMO; d.ldb = 1024; d.K = 1024; d.brow = pm * 256; d.bcol = pn * 256; d.epi = EPI_RESID; d.orow = d.brow; d.ocol = d.bcol; } break;
            case GP_DOWN: { const int pm = u >> 2, pn = u & 3; d.A = ((bf16_t*)(F.ws + WS_P)); d.lda = LDP; d.Bt = ((bf16_t*)(F.ws + WS_WFFN)) + WF_DN; d.ldb = 2816; d.K = 2816; d.brow = pm * 256; d.bcol = pn * 256; d.epi = EPI_RESID; d.orow = d.brow; d.ocol = d.bcol; } break;
            case GP_ATTN: case GP_ATTN2: {
                int pm, h, b;
                if (u < 512) { pm = u >> 2; h = u & 3; b = pm >> 3; }
                else { const int v = u - 512; h = v & 3; const int bi = (v >> 2) & 3, t = v >> 4; pm = 128 + t; b = 16 + 4 * t + bi; d.vai = bi >> 1; d.vwr = bi & 1; }
                d.head = h; d.brow = pm * 256; d.orow = d.brow; d.ocol = 0; d.K = 256; d.bcol = 0;
                if (sub == 0) { d.A = ((bf16_t*)(F.ws + WS_P)) + C_Q + h * 256; d.lda = LDP; d.Bt = ((bf16_t*)(F.ws + WS_KV)) + (size_t)b * 256 * 1024 + h * 256; d.ldb = 1024; d.epi = EPI_SOFTMAX; }
                else { d.A = ((bf16_t*)(F.ws + WS_P)) + C_PR + h * 256; d.lda = LDP; d.Bt = ((bf16_t*)(F.ws + WS_KV + 6144ull * 1024 * 2)) + (size_t)(b * 4 + h) * 65536; d.ldb = 256; d.epi = EPI_ATTNO; }
            } break;
            }
        }
        gemm_core(d.A, d.lda, d.Bt, d.ldb, d.K, d.brow, d.bcol, acc, (bf16_t*)F.lds);
        gemm_epilogue(F, d, l, acc);
    }
    if (srow) {
        __syncthreads();
        if (kind == GP_WO) sample_rows_gemm(F, ((bf16_t*)(F.ws + WS_P)) + C_MRG, LDP, ((bf16_t*)(F.ws + WS_WMIX)) + WM_WO, 1024, 1);
        else if (kind == GP_MQ) sample_rows_gemm(F, ((bf16_t*)(F.ws + WS_XB)), 1024, ((bf16_t*)(F.ws + WS_WMIX)) + WM_WMQ, 1024, 0);
        else if (kind == GP_MO) sample_rows_gemm(F, ((bf16_t*)(F.ws + WS_P)) + C_O, LDP, ((bf16_t*)(F.ws + WS_WMIX)) + WM_WMO, 1024, 1);
        else sample_rows_gemm(F, ((bf16_t*)(F.ws + WS_P)), LDP, ((bf16_t*)(F.ws + WS_WFFN)) + WF_DN, 2816, 1);
    }
}

DEV void sample_kv(const Frame& F0, int l) {
    REFRAME;
    const float* ck = F.in[6] + (size_t)l * 2097152; const float* cv = F.in[7] + (size_t)l * 2097152;
    for (int i = F.bid * 512 + F.tid; i < 262144; i += F.nb * 512) {
        const f32x4 a = *(const f32x4*)(ck + (size_t)i * 8), b = *(const f32x4*)(ck + (size_t)i * 8 + 4);
        u32x4 w; w.x = pk2(a[0], a[1]); w.y = pk2(a[2], a[3]); w.z = pk2(b[0], b[1]); w.w = pk2(b[2], b[3]);
        *(u32x4*)(((bf16_t*)(F.ws + WS_KV)) + 4096ull * 1024 + (size_t)i * 8) = w;
        const int dd = i & 255, m8 = (i >> 8) & 31, h = (i >> 13) & 3, bb = i >> 15;
        const float* s = cv + ((size_t)(bb * 256 + m8 * 8) * 4 + h) * 256 + dd;
        u32x4 x; x.x = pk2(s[0], s[1024]); x.y = pk2(s[2048], s[3072]); x.z = pk2(s[4096], s[5120]); x.w = pk2(s[6144], s[7168]);
        *(u32x4*)(((bf16_t*)(F.ws + WS_KV + 6144ull * 1024 * 2)) + ((size_t)((16 + bb) * 4 + h) * 256 + dd) * 256 + m8 * 8) = x;
    }
}

DEV void g1_gdn(const Frame& F0, int l, int c, int h) {
    REFRAME;
    float* Fq = (float*)F.lds;
    bf16_t* VS = (bf16_t*)(F.lds + 66560);
    bf16_t* QN = (bf16_t*)(F.lds + 82944);
    bf16_t* KN = (bf16_t*)(F.lds + 100352);
    float* AM = (float*)(F.lds + 117760);
    float* sB = (float*)(F.lds + 135168); float* sG = sB + 64; float* sRQ = sB + 128; float* sRK = sB + 192;
    const int tid = F.tid, lane = F.lane, t0 = c * 64;
    const bool first = c >= 512 || (c & 31) == 0; const bool sample = c >= 512;
    __syncthreads();
    if (F.wid == 0) {
        const int t = t0 + lane;
        const float braw = ((float*)(F.ws + WS_SC))[(size_t)t * 32 + h], araw = ((float*)(F.ws + WS_SC))[(size_t)t * 32 + 4 + h];
        const float beta = sigm(braw);
        float g = -__expf(F.in[12][l * 4 + h]) * softplus(araw + F.in[13][l * 4 + h]);
#pragma unroll
        for (int off = 1; off < 64; off <<= 1) { const float n = __shfl_up(g, off); if (lane >= off) g += n; }
        sB[lane] = beta; sG[lane] = g;
        if (!F.dry) ((float*)(F.ws + WS_BG))[((size_t)c * 4 + h) * 128 + lane] = beta; if (!F.dry) ((float*)(F.ws + WS_BG))[((size_t)c * 4 + h) * 128 + 64 + lane] = g;
    }
    __syncthreads();
    const float* cw = F.in[11] + (size_t)l * 4 * 1536;
    if (tid < 384) {
        const int cp = tid % 192, rh = tid / 192, which = cp >> 6, cc = (cp & 63) * 2, pcol = which * 512 + h * 128 + cc;
        const f32x2 w0 = *(const f32x2*)(cw + pcol), w1 = *(const f32x2*)(cw + 1536 + pcol), w2 = *(const f32x2*)(cw + 2 * 1536 + pcol), w3 = *(const f32x2*)(cw + 3 * 1536 + pcol);
        float x0[35], x1[35];
#pragma unroll
        for (int i = 0; i < 3; ++i) {
            x0[i] = 0.f; x1[i] = 0.f;
            if (rh == 1) { const unsigned u = *(const unsigned*)(((bf16_t*)(F.ws + WS_P)) + (size_t)(t0 + 29 + i) * LDP + pcol); x0[i] = bflo(u); x1[i] = bfhi(u); }
            else if (!first) { const unsigned u = *(const unsigned*)(((bf16_t*)(F.ws + WS_KV)) + ((size_t)(c - 1) * 3 + i) * 1536 + pcol); x0[i] = bflo(u); x1[i] = bfhi(u); }
            else if (sample) { const f32x2 f = *(const f32x2*)(F.in[3] + ((size_t)(l * 8 + (c - 512)) * 3 + i) * 1536 + pcol); x0[i] = f[0]; x1[i] = f[1]; }
        }
#pragma unroll
        for (int i = 0; i < 32; ++i) { const unsigned u = *(const unsigned*)(((bf16_t*)(F.ws + WS_P)) + (size_t)(t0 + 32 * rh + i) * LDP + pcol); x0[3 + i] = bflo(u); x1[3 + i] = bfhi(u); }
#pragma unroll
        for (int r = 0; r < 32; ++r) {
            float a0 = w0[0] * x0[r] + w1[0] * x0[r + 1] + w2[0] * x0[r + 2] + w3[0] * x0[r + 3];
            float a1 = w0[1] * x1[r] + w1[1] * x1[r + 1] + w2[1] * x1[r + 2] + w3[1] * x1[r + 3];
            a0 = silu(a0); a1 = silu(a1);
            const int rr = 32 * rh + r;
            if (which < 2) { *(f32x2*)(Fq + rr * 260 + which * 128 + cc) = (f32x2){a0, a1}; }
            else { const float be = sB[rr]; *(unsigned*)(VS + rr * 128 + cc) = pk2(a0 * be, a1 * be); }
        }
    }
    __syncthreads();
    {
        const int r = tid >> 3, j = tid & 7; const float* p = Fq + r * 260 + j * 32; float s = 0.f;
#pragma unroll
        for (int i = 0; i < 32; ++i) s += p[i] * p[i];
        s += __shfl_xor(s, 1); s += __shfl_xor(s, 2);
        if ((j & 3) == 0) { if (j == 0) sRQ[r] = rsqrtf(s + 1e-6f) * 0.08838834764831845f; else sRK[r] = rsqrtf(s + 1e-6f); }
    }
    __syncthreads();
    for (int idx = tid; idx < 64 * 64; idx += 512) {
        const int r = idx >> 6, c4 = (idx & 63) * 4; const bool isq = c4 < 128;
        f32x4 v = *(const f32x4*)(Fq + r * 260 + c4); v = v * (isq ? sRQ[r] : sRK[r]);
        const u32x2 w = pk4(v);
        if (isq) { *(u32x2*)(QN + r * 136 + c4) = w; if (!F.dry) *(u32x2*)(((bf16_t*)(F.ws + WS_P)) + (size_t)(t0 + r) * LDP + C_QA + h * 128 + c4) = w; }
        else { *(u32x2*)(KN + r * 136 + c4 - 128) = w; if (!F.dry) *(u32x2*)(((bf16_t*)(F.ws + WS_P)) + (size_t)(t0 + r) * LDP + C_KA + h * 128 + c4 - 128) = w; }
    }
    for (int idx = tid; idx < 64 * 32; idx += 512) {
        const int r = idx >> 5, c4 = (idx & 31) * 4;
        if (!F.dry) *(u32x2*)(((bf16_t*)(F.ws + WS_P)) + (size_t)(t0 + r) * LDP + C_VA + h * 128 + c4) = *(const u32x2*)(VS + r * 128 + c4);
    }
    __syncthreads();
    {
        const int fr = lane & 15, fq = lane >> 4, which = F.wid >> 2, it = F.wid & 3;
        const bf16_t* X = which ? QN : KN;
        const int crow = 16 * it + fr; const float gc = sG[crow], bc = sB[crow];
        for (int jt = 0; jt < 4; ++jt) {
            f32x4 a = {0.f, 0.f, 0.f, 0.f};
            if (jt <= it) {
#pragma unroll
                for (int ks = 0; ks < 4; ++ks) a = MFMA16(ldfrag(KN, 16 * jt + fr, 136, 32 * ks, fq), ldfrag(X, crow, 136, 32 * ks, fq), a);
            }
            f32x4 o;
#pragma unroll
            for (int j = 0; j < 4; ++j) {
                const int s = 16 * jt + 4 * fq + j;
                const bool keep = which ? (s <= crow) : (s < crow);
                const float dec = keep ? __expf(gc - sG[s]) : 0.f;
                o[j] = a[j] * dec * (which ? 1.f : bc);
            }
            if (which) { if (!F.dry) *(u32x2*)(((bf16_t*)(F.ws + WS_XB)) + (size_t)(t0 + crow) * LDE + h * 128 + 64 + 16 * jt + 4 * fq) = pk4(o); }
            else *(f32x4*)(AM + crow * 68 + 16 * jt + 4 * fq) = o;
        }
    }
    __syncthreads();
    if (F.wid == 0) {
        float Tc[64]; const float lanef = (float)lane;
        typedef __attribute__((address_space(3))) const f32x4 LDSF4;
        __attribute__((address_space(3))) const char* aml = (__attribute__((address_space(3))) const char*)AM; asm volatile("" : "+v"(aml));
#pragma unroll
        for (int i = 0; i < 64; ++i) {
            float a = fmaxf(0.f, 1.f - fabsf(lanef - (float)i));
#pragma unroll
            for (int j4 = 0; j4 < (i + 3) / 4; ++j4) {
                const f32x4 av = *(const LDSF4*)(aml + (i * 68 + j4 * 4) * 4);
#pragma unroll
                for (int jj = 0; jj < 4; ++jj) if (j4 * 4 + jj < i) a -= av[jj] * Tc[j4 * 4 + jj];
            }
            Tc[i] = a;
        }
#pragma unroll
        for (int i = 0; i < 64; i += 2) {
            const unsigned w = pk2(Tc[i], Tc[i + 1]);
            if (!F.dry) ((bf16_t*)(F.ws + WS_XB))[(size_t)(t0 + i) * LDE + h * 128 + lane] = (bf16_t)(w & 0xffff);
            if (!F.dry) ((bf16_t*)(F.ws + WS_XB))[(size_t)(t0 + i + 1) * LDE + h * 128 + lane] = (bf16_t)(w >> 16);
        }
    }
}

DEV void g1_gla(const Frame& F0, int l, int c, int h) {
    REFRAME;
    float* GL = (float*)F.lds;
    float* LA = (float*)(F.lds + 4096);
    bf16_t* QG = (bf16_t*)(F.lds + 20736);
    bf16_t* KI = (bf16_t*)(F.lds + 29952);
    const int tid = F.tid, lane = F.lane, t0 = c * 64;
    __syncthreads();
    if (tid < 256) { const int r = tid >> 2, q4 = (tid & 3) * 4; *(f32x4*)(GL + r * 16 + q4) = *(const f32x4*)(((float*)(F.ws + WS_SC)) + (size_t)(t0 + r) * 32 + 8 + q4); }
    __syncthreads();
    {
        const int dk = tid & 63, rb = tid >> 6;
        float w2[16];
#pragma unroll
        for (int i = 0; i < 16; ++i) w2[i] = F.in[15][(size_t)(l * 16 + i) * 256 + h * 64 + dk];
        const float bias = F.in[16][l * 256 + h * 64 + dk];
#pragma unroll
        for (int rr = 0; rr < 8; ++rr) {
            const int r = rb * 8 + rr; float x = bias;
#pragma unroll
            for (int i = 0; i < 16; ++i) x += GL[r * 16 + i] * w2[i];
            LA[r * 65 + dk] = logsigmoid(x) * 0.0625f;
        }
    }
    __syncthreads();
    if (tid < 64) {
        float g = 0.f;
#pragma unroll 8
        for (int r = 0; r < 64; ++r) { g += LA[r * 65 + tid]; LA[r * 65 + tid] = g; }
        if (!F.dry) ((float*)(F.ws + WS_DL))[((size_t)c * 4 + h) * 64 + tid] = __expf(g);
    }
    __syncthreads();
    for (int idx = tid; idx < 64 * 16; idx += 512) {
        const int r = idx >> 4, c4 = (idx & 15) * 4;
        bf16_t* qp = ((bf16_t*)(F.ws + WS_P)) + (size_t)(t0 + r) * LDP + C_QB + h * 64 + c4; bf16_t* kp = ((bf16_t*)(F.ws + WS_P)) + (size_t)(t0 + r) * LDP + C_KB + h * 64 + c4;
        const f32x4 q = unpk4(*(const u32x2*)qp), k = unpk4(*(const u32x2*)kp);
        f32x4 qg, ki, kg;
#pragma unroll
        for (int j = 0; j < 4; ++j) { const float g = LA[r * 65 + c4 + j], gl = LA[63 * 65 + c4 + j];
            qg[j] = q[j] * 0.125f * __expf(g); ki[j] = k[j] * __expf(-g); kg[j] = k[j] * __expf(gl - g); }
        const u32x2 wq = pk4(qg);
        *(u32x2*)(QG + r * 72 + c4) = wq; *(u32x2*)(KI + r * 72 + c4) = pk4(ki);
        if (!F.dry) *(u32x2*)qp = wq; if (!F.dry) *(u32x2*)kp = pk4(kg);
    }
    __syncthreads();
    {
        const int fr = lane & 15, fq = lane >> 4, it = F.wid >> 1; const int crow = 16 * it + fr;
#pragma unroll
        for (int q = 0; q < 2; ++q) {
            const int jt = (F.wid & 1) * 2 + q;
            f32x4 a = {0.f, 0.f, 0.f, 0.f};
            if (jt <= it) {
#pragma unroll
                for (int ks = 0; ks < 2; ++ks) a = MFMA16(ldfrag(KI, 16 * jt + fr, 72, 32 * ks, fq), ldfrag(QG, crow, 72, 32 * ks, fq), a);
            }
#pragma unroll
            for (int j = 0; j < 4; ++j) if (16 * jt + 4 * fq + j > crow) a[j] = 0.f;
            if (!F.dry) *(u32x2*)(((bf16_t*)(F.ws + WS_XB)) + (size_t)(t0 + crow) * LDE + 512 + h * 64 + 16 * jt + 4 * fq) = pk4(a);
        }
    }
}

DEV void g2_gdn(const Frame& F0, int l, int s, int h) {
    REFRAME;
    bf16_t* QN = (bf16_t*)F.lds;
    bf16_t* KN = (bf16_t*)(F.lds + 17408);
    bf16_t* KT = (bf16_t*)(F.lds + 34816);
    bf16_t* TM = (bf16_t*)(F.lds + 53248);
    bf16_t* AQ = (bf16_t*)(F.lds + 62464);
    float* sB = (float*)(F.lds + 71680); float* sG = sB + 64;
    float* RED = (float*)(F.lds + 72192);
    bf16_t* VV = (bf16_t*)(F.lds + 74240);
    bf16_t* ZZ = (bf16_t*)(F.lds + 91648);
    const int tid = F.tid, lane = F.lane, w = F.wid, fr = lane & 15, fq = lane >> 4;
    const bool sample = s >= 16; const int nchunk = sample ? 1 : 32; const int tbase = sample ? 32768 + (s - 16) * 64 : s * 2048;
    const int dvc = h * 128 + 16 * w + fr;
    f32x4 S[8];
#pragma unroll
    for (int mt = 0; mt < 8; ++mt) {
        if (sample) { const float* sp = F.in[2] + ((size_t)((l * 8 + (s - 16)) * 4 + h) * 128) * 128;
#pragma unroll
            for (int j = 0; j < 4; ++j) S[mt][j] = sp[(size_t)(16 * mt + 4 * fq + j) * 128 + 16 * w + fr]; }
        else S[mt] = (f32x4){0.f, 0.f, 0.f, 0.f};
    }
    const float gn = F.in[14][l * 128 + 16 * w + fr];
    for (int n = 0; n < nchunk; ++n) {
        const int t0 = tbase + n * 64;
        __syncthreads();
#pragma unroll
        for (int i = 0; i < 2; ++i) {
            const int p = tid + 512 * i, r = p >> 4, c8 = (p & 15) * 8;
            const u32x4 q = *(const u32x4*)(((bf16_t*)(F.ws + WS_P)) + (size_t)(t0 + r) * LDP + C_QA + h * 128 + c8);
            const u32x4 k = *(const u32x4*)(((bf16_t*)(F.ws + WS_P)) + (size_t)(t0 + r) * LDP + C_KA + h * 128 + c8);
            *(u32x4*)(QN + r * 136 + c8) = q; *(u32x4*)(KN + r * 136 + c8) = k;
            *(u32x4*)(VV + r * 136 + c8) = *(const u32x4*)(((bf16_t*)(F.ws + WS_P)) + (size_t)(t0 + r) * LDP + C_VA + h * 128 + c8);
            *(u32x4*)(ZZ + r * 136 + c8) = *(const u32x4*)(((bf16_t*)(F.ws + WS_P)) + (size_t)(t0 + r) * LDP + C_ZA + h * 128 + c8);
            KT[(c8 + 0) * 72 + r] = (bf16_t)(k.x & 0xffff); KT[(c8 + 1) * 72 + r] = (bf16_t)(k.x >> 16);
            KT[(c8 + 2) * 72 + r] = (bf16_t)(k.y & 0xffff); KT[(c8 + 3) * 72 + r] = (bf16_t)(k.y >> 16);
            KT[(c8 + 4) * 72 + r] = (bf16_t)(k.z & 0xffff); KT[(c8 + 5) * 72 + r] = (bf16_t)(k.z >> 16);
            KT[(c8 + 6) * 72 + r] = (bf16_t)(k.w & 0xffff); KT[(c8 + 7) * 72 + r] = (bf16_t)(k.w >> 16);
        }
        {
            const int r = tid >> 3, c8 = (tid & 7) * 8;
            *(u32x4*)(TM + r * 72 + c8) = *(const u32x4*)(((bf16_t*)(F.ws + WS_XB)) + (size_t)(t0 + r) * LDE + h * 128 + c8);
            *(u32x4*)(AQ + r * 72 + c8) = *(const u32x4*)(((bf16_t*)(F.ws + WS_XB)) + (size_t)(t0 + r) * LDE + h * 128 + 64 + c8);
        }
        if (tid < 128) sB[tid] = ((float*)(F.ws + WS_BG))[((size_t)(t0 >> 6) * 4 + h) * 128 + tid];
        __syncthreads();
        f32x4 kS[4], qS[4], vn[4], o[4];
#pragma unroll
        for (int mt = 0; mt < 4; ++mt) { kS[mt] = (f32x4){0.f, 0.f, 0.f, 0.f}; qS[mt] = kS[mt]; vn[mt] = kS[mt]; }
#pragma unroll
        for (int ks = 0; ks < 4; ++ks) {
            const bf16x8 sf = mk8(pk4(S[2 * ks]), pk4(S[2 * ks + 1]));
#pragma unroll
            for (int mt = 0; mt < 4; ++mt) {
                kS[mt] = MFMA16(ldfragp(KN, 16 * mt + fr, 136, 32 * ks, fq), sf, kS[mt]);
                qS[mt] = MFMA16(ldfragp(QN, 16 * mt + fr, 136, 32 * ks, fq), sf, qS[mt]);
            }
        }
        const float glast = sG[63];
        f32x4 eg[4], tmp[4];
#pragma unroll
        for (int mt = 0; mt < 4; ++mt)
#pragma unroll
            for (int j = 0; j < 4; ++j) {
                const int row = 16 * mt + 4 * fq + j;
                const float e = __expf(sG[row]); eg[mt][j] = e;
                const float vv = bf2f(VV[row * 136 + 16 * w + fr]);
                tmp[mt][j] = vv - sB[row] * e * kS[mt][j];
            }
#pragma unroll
        for (int ks = 0; ks < 2; ++ks) {
            const bf16x8 tf = mk8(pk4(tmp[2 * ks]), pk4(tmp[2 * ks + 1]));
#pragma unroll
            for (int mt = 0; mt < 4; ++mt) vn[mt] = MFMA16(ldfragp(TM, 16 * mt + fr, 72, 32 * ks, fq), tf, vn[mt]);
        }
#pragma unroll
        for (int mt = 0; mt < 4; ++mt) o[mt] = eg[mt] * qS[mt];
#pragma unroll
        for (int ks = 0; ks < 2; ++ks) {
            const bf16x8 vf = mk8(pk4(vn[2 * ks]), pk4(vn[2 * ks + 1]));
#pragma unroll
            for (int mt = 0; mt < 4; ++mt) o[mt] = MFMA16(ldfragp(AQ, 16 * mt + fr, 72, 32 * ks, fq), vf, o[mt]);
        }
        const float dl = __expf(glast);
#pragma unroll
        for (int mt = 0; mt < 4; ++mt)
#pragma unroll
            for (int j = 0; j < 4; ++j) vn[mt][j] *= __expf(glast - sG[16 * mt + 4 * fq + j]);
#pragma unroll
        for (int mt = 0; mt < 8; ++mt) S[mt] = S[mt] * dl;
#pragma unroll
        for (int ks = 0; ks < 2; ++ks) {
            const bf16x8 vf = mk8(pk4(vn[2 * ks]), pk4(vn[2 * ks + 1]));
#pragma unroll
            for (int mt = 0; mt < 8; ++mt) S[mt] = MFMA16(ldfragp(KT, 16 * mt + fr, 72, 32 * ks, fq), vf, S[mt]);
        }
#pragma unroll
        for (int mt = 0; mt < 4; ++mt)
#pragma unroll
            for (int j = 0; j < 4; ++j) {
                float p = o[mt][j] * o[mt][j];
                p += __shfl_xor(p, 1); p += __shfl_xor(p, 2); p += __shfl_xor(p, 4); p += __shfl_xor(p, 8);
                if (fr == 0) RED[(16 * mt + 4 * fq + j) * 8 + w] = p;
            }
        __syncthreads();
#pragma unroll
        for (int mt = 0; mt < 4; ++mt)
#pragma unroll
            for (int j = 0; j < 4; ++j) {
                const int row = 16 * mt + 4 * fq + j;
                const f32x4 r0 = *(const f32x4*)(RED + row * 8), r1 = *(const f32x4*)(RED + row * 8 + 4);
                const float ssum = ((r0[0] + r0[1]) + (r0[2] + r0[3])) + ((r1[0] + r1[1]) + (r1[2] + r1[3]));
                const float rs = rsqrtf(ssum * (1.f / 128.f) + 1e-6f);
                bf16_t* zp = ((bf16_t*)(F.ws + WS_P)) + (size_t)(t0 + row) * LDP + C_ZA + dvc;
                const float z = bf2f(ZZ[row * 136 + 16 * w + fr]);
                if (!F.dry) *zp = (bf16_t)(pk2(o[mt][j] * rs * gn * silu(z), 0.f) & 0xffff);
            }
    }
    float* so = sample ? F.out + O_GDN_S + ((size_t)((l * 8 + (s - 16)) * 4 + h) * 128) * 128 : F.out + O_GDN_P + ((size_t)((l * 16 + s) * 4 + h) * 128) * 128;
#pragma unroll
    for (int mt = 0; mt < 8; ++mt)
#pragma unroll
        for (int j = 0; j < 4; ++j) if (!F.dry) so[(size_t)(16 * mt + 4 * fq + j) * 128 + 16 * w + fr] = S[mt][j];
}

DEV void g2_gla(const Frame& F0, int l, int s, int h) {
    REFRAME;
    bf16_t* QG = (bf16_t*)F.lds;
    bf16_t* KGT = (bf16_t*)(F.lds + 9216);
    bf16_t* AQ = (bf16_t*)(F.lds + 18432);
    float* sDL = (float*)(F.lds + 27648);
    float* RED = (float*)(F.lds + 27904);
    bf16_t* ZZ = (bf16_t*)(F.lds + 29952);
    const int tid = F.tid, lane = F.lane, w = F.wid, fr = lane & 15, fq = lane >> 4;
    const bool sample = s >= 16; const int nchunk = sample ? 1 : 32; const int tbase = sample ? 32768 + (s - 16) * 64 : s * 2048;
    const int dvc = h * 128 + 16 * w + fr;
    f32x4 S[4];
#pragma unroll
    for (int mt = 0; mt < 4; ++mt) {
        if (sample) { const float* sp = F.in[4] + ((size_t)((l * 8 + (s - 16)) * 4 + h) * 64) * 128;
#pragma unroll
            for (int j = 0; j < 4; ++j) S[mt][j] = sp[(size_t)(16 * mt + 4 * fq + j) * 128 + 16 * w + fr]; }
        else S[mt] = (f32x4){0.f, 0.f, 0.f, 0.f};
    }
    const float gn = F.in[17][l * 128 + 16 * w + fr];
    for (int n = 0; n < nchunk; ++n) {
        const int t0 = tbase + n * 64, chunk = t0 >> 6;
        __syncthreads();
        {
            const int r = tid >> 3, c8 = (tid & 7) * 8;
            *(u32x4*)(QG + r * 72 + c8) = *(const u32x4*)(((bf16_t*)(F.ws + WS_P)) + (size_t)(t0 + r) * LDP + C_QB + h * 64 + c8);
            const u32x4 k = *(const u32x4*)(((bf16_t*)(F.ws + WS_P)) + (size_t)(t0 + r) * LDP + C_KB + h * 64 + c8);
            KGT[(c8 + 0) * 72 + r] = (bf16_t)(k.x & 0xffff); KGT[(c8 + 1) * 72 + r] = (bf16_t)(k.x >> 16);
            KGT[(c8 + 2) * 72 + r] = (bf16_t)(k.y & 0xffff); KGT[(c8 + 3) * 72 + r] = (bf16_t)(k.y >> 16);
            KGT[(c8 + 4) * 72 + r] = (bf16_t)(k.z & 0xffff); KGT[(c8 + 5) * 72 + r] = (bf16_t)(k.z >> 16);
            KGT[(c8 + 6) * 72 + r] = (bf16_t)(k.w & 0xffff); KGT[(c8 + 7) * 72 + r] = (bf16_t)(k.w >> 16);
            *(u32x4*)(AQ + r * 72 + c8) = *(const u32x4*)(((bf16_t*)(F.ws + WS_XB)) + (size_t)(t0 + r) * LDE + 512 + h * 64 + c8);
        }
#pragma unroll
        for (int i = 0; i < 2; ++i) { const int p = tid + 512 * i, r = p >> 4, c8 = (p & 15) * 8;
            *(u32x4*)(ZZ + r * 136 + c8) = *(const u32x4*)(((bf16_t*)(F.ws + WS_P)) + (size_t)(t0 + r) * LDP + C_ZB + h * 128 + c8); }
        if (tid < 64) sDL[tid] = ((float*)(F.ws + WS_DL))[((size_t)chunk * 4 + h) * 64 + tid];
        bf16x8 vf[2];
#pragma unroll
        for (int ks = 0; ks < 2; ++ks) {
            unsigned e[8];
#pragma unroll
            for (int j = 0; j < 8; ++j) { const int row = 32 * ks + (j < 4 ? 4 * fq + j : 16 + 4 * fq + (j - 4)); e[j] = ((bf16_t*)(F.ws + WS_P))[(size_t)(t0 + row) * LDP + C_VB + dvc]; }
            u32x4 t; t.x = e[0] | (e[1] << 16); t.y = e[2] | (e[3] << 16); t.z = e[4] | (e[5] << 16); t.w = e[6] | (e[7] << 16);
            vf[ks] = __builtin_bit_cast(bf16x8, t);
        }
        __syncthreads();
        f32x4 o[4];
#pragma unroll
        for (int mt = 0; mt < 4; ++mt) o[mt] = (f32x4){0.f, 0.f, 0.f, 0.f};
#pragma unroll
        for (int ks = 0; ks < 2; ++ks) {
            const bf16x8 sf = mk8(pk4(S[2 * ks]), pk4(S[2 * ks + 1]));
#pragma unroll
            for (int mt = 0; mt < 4; ++mt) {
                o[mt] = MFMA16(ldfragp(QG, 16 * mt + fr, 72, 32 * ks, fq), sf, o[mt]);
                o[mt] = MFMA16(ldfragp(AQ, 16 * mt + fr, 72, 32 * ks, fq), vf[ks], o[mt]);
            }
        }
#pragma unroll
        for (int mt = 0; mt < 4; ++mt) {
#pragma unroll
            for (int j = 0; j < 4; ++j) S[mt][j] *= sDL[16 * mt + 4 * fq + j];
#pragma unroll
            for (int ks = 0; ks < 2; ++ks) S[mt] = MFMA16(ldfragp(KGT, 16 * mt + fr, 72, 32 * ks, fq), vf[ks], S[mt]);
        }
#pragma unroll
        for (int mt = 0; mt < 4; ++mt)
#pragma unroll
            for (int j = 0; j < 4; ++j) {
                float p = o[mt][j] * o[mt][j];
                p += __shfl_xor(p, 1); p += __shfl_xor(p, 2); p += __shfl_xor(p, 4); p += __shfl_xor(p, 8);
                if (fr == 0) RED[(16 * mt + 4 * fq + j) * 8 + w] = p;
            }
        __syncthreads();
#pragma unroll
        for (int mt = 0; mt < 4; ++mt)
#pragma unroll
            for (int j = 0; j < 4; ++j) {
                const int row = 16 * mt + 4 * fq + j;
                const f32x4 r0 = *(const f32x4*)(RED + row * 8), r1 = *(const f32x4*)(RED + row * 8 + 4);
                const float ssum = ((r0[0] + r0[1]) + (r0[2] + r0[3])) + ((r1[0] + r1[1]) + (r1[2] + r1[3]));
                const float rs = rsqrtf(ssum * (1.f / 128.f) + 1e-6f);
                bf16_t* zp = ((bf16_t*)(F.ws + WS_P)) + (size_t)(t0 + row) * LDP + C_ZB + dvc;
                const float z = bf2f(ZZ[row * 136 + 16 * w + fr]);
                if (!F.dry) *zp = (bf16_t)(pk2(o[mt][j] * rs * gn * silu(z), 0.f) & 0xffff);
            }
    }
    float* so = sample ? F.out + O_GLA_S + ((size_t)((l * 8 + (s - 16)) * 4 + h) * 64) * 128 : F.out + O_GLA_P + ((size_t)((l * 16 + s) * 4 + h) * 64) * 128;
#pragma unroll
    for (int mt = 0; mt < 4; ++mt)
#pragma unroll
        for (int j = 0; j < 4; ++j) if (!F.dry) so[(size_t)(16 * mt + 4 * fq + j) * 128 + 16 * w + fr] = S[mt][j];
}

DEV void unpack8(u32x4 u, float (&f)[8]) { f[0] = bflo(u.x); f[1] = bfhi(u.x); f[2] = bflo(u.y); f[3] = bfhi(u.y); f[4] = bflo(u.z); f[5] = bfhi(u.z); f[6] = bflo(u.w); f[7] = bfhi(u.w); }
DEV void load8f(const float* p, float (&f)[8]) { const f32x4 a = *(const f32x4*)p, b = *(const f32x4*)(p + 4); f[0] = a[0]; f[1] = a[1]; f[2] = a[2]; f[3] = a[3]; f[4] = b[0]; f[5] = b[1]; f[6] = b[2]; f[7] = b[3]; }
DEV void ffn_mid(const Frame& F0, int l) {
    REFRAME;
    const float* cw = F.in[29] + (size_t)l * 3 * 5632; const float* cb = F.in[30] + (size_t)l * 5632;
    const bf16_t* halo = ((bf16_t*)(F.ws + WS_KV)); const bf16_t* raw01 = ((bf16_t*)(F.ws + WS_KV + 11714560ull));
    for (int idx = F.bid * 512 + F.tid; idx < 112 * 704; idx += F.nb * 512) {
        const int ti = idx / 704, c4 = (idx % 704) * 4, pm = (ti / 7) * 8 + (ti % 7) + 1;
        const bf16_t* hp = halo + (size_t)(4 * pm - 1) * 2 * 5632; const bf16_t* rp = raw01 + (size_t)pm * 2 * 5632;
        const f32x4 gm2 = unpk4(*(const u32x2*)(hp + c4)), gm1 = unpk4(*(const u32x2*)(hp + 5632 + c4)), g0 = unpk4(*(const u32x2*)(rp + c4)), g1 = unpk4(*(const u32x2*)(rp + 5632 + c4));
        const f32x4 vm2 = unpk4(*(const u32x2*)(hp + 2816 + c4)), vm1 = unpk4(*(const u32x2*)(hp + 5632 + 2816 + c4)), v0 = unpk4(*(const u32x2*)(rp + 2816 + c4)), v1 = unpk4(*(const u32x2*)(rp + 5632 + 2816 + c4));
        const f32x4 wg0 = *(const f32x4*)(cw + c4), wg1 = *(const f32x4*)(cw + 5632 + c4), wg2 = *(const f32x4*)(cw + 2 * 5632 + c4), bg = *(const f32x4*)(cb + c4);
        const f32x4 wv0 = *(const f32x4*)(cw + 2816 + c4), wv1 = *(const f32x4*)(cw + 5632 + 2816 + c4), wv2 = *(const f32x4*)(cw + 2 * 5632 + 2816 + c4), bv = *(const f32x4*)(cb + 2816 + c4);
        f32x4 o0, o1;
#pragma unroll
        for (int j = 0; j < 4; ++j) {
            const float yg0 = wg0[j] * gm2[j] + wg1[j] * gm1[j] + wg2[j] * g0[j] + bg[j], yv0 = wv0[j] * vm2[j] + wv1[j] * vm1[j] + wv2[j] * v0[j] + bv[j];
            const float yg1 = wg0[j] * gm1[j] + wg1[j] * g0[j] + wg2[j] * g1[j] + bg[j], yv1 = wv0[j] * vm1[j] + wv1[j] * v0[j] + wv2[j] * v1[j] + bv[j];
            o0[j] = silu(yg0) * yv0; o1[j] = silu(yg1) * yv1;
        }
        bf16_t* vp = ((bf16_t*)(F.ws + WS_P)) + (size_t)pm * 256 * LDP + c4;
        *(u32x2*)vp = pk4(o0); *(u32x2*)(vp + LDP) = pk4(o1);
    }
}

DEV void final_norm(const Frame& F0) {
    REFRAME;
    const int gw = F.bid * 8 + F.wid, nw = F.nb * 8, lane = F.lane;
    const float* g = F.in[32];
    for (int row = gw; row < TT; row += nw) {
        const float rs = row_rstd(((float*)(F.ws + WS_SSQ)), row);
        float* X = F.out + (size_t)row * 1024;
#pragma unroll
        for (int i = 0; i < 4; ++i) { const int cidx = i * 256 + lane * 4; f32x4 v = *(const f32x4*)(X + cidx); const f32x4 gg = *(const f32x4*)(g + cidx); *(f32x4*)(X + cidx) = v * rs * gg; }
    }
}

#ifdef DBG_COL
DEV void dbg_dump(const Frame& F0) {
    REFRAME;
    for (int i = F.bid * 512 + F.tid; i < TT * 256; i += F.nb * 512) {
        const int row = i >> 8, c = (i & 255) * 4;
        const f32x4 v = c < 512 ? unpk4(*(const u32x2*)(((bf16_t*)(F.ws + WS_P)) + (size_t)row * LDP + DBG_COL + c)) : (f32x4){0.f, 0.f, 0.f, 0.f};
        *(f32x4*)(F.out + (size_t)row * 1024 + c) = (row DBG_ROWSEL) ? v : (f32x4){0.f, 0.f, 0.f, 0.f};
    }
}
#endif
#define XB_TMO      128
#define XB_XCNT(j)  (256  + 64 * (j))
#define XB_XSUB(j)  (1280 + 64 * (j))
#define XB_XGEN(j)  (2304 + 64 * (j))
#define XB_TOP      3328
#define XB_TOPGEN   3392
#define XCD_BAR_WORDS 3456
#define XB_SPIN_CAP (1u << 18)
#define LAS __attribute__((address_space(3)))

__device__ __forceinline__ unsigned xb_ld(unsigned* p)              { return __hip_atomic_load(p, __ATOMIC_RELAXED, __HIP_MEMORY_SCOPE_AGENT); }
__device__ __forceinline__ unsigned xb_add(unsigned* p, unsigned v) { return __hip_atomic_fetch_add(p, v, __ATOMIC_RELAXED, __HIP_MEMORY_SCOPE_AGENT); }
__device__ __forceinline__ unsigned xb_xcc_id() { return (unsigned)__builtin_amdgcn_s_getreg((3 << 11) | 20) & 0xFu; }
#define XB_SPIN(cond, bar) do { unsigned _sp = 0; while (cond) { __builtin_amdgcn_s_sleep(1); \
    if ((++_sp & 255u) == 0u) { if (xb_ld(&(bar)[XB_TMO])) break; if (_sp > XB_SPIN_CAP) { atomicAdd(&(bar)[XB_TMO], 1u); break; } } } } while (0)

struct XcdBarrier {
    unsigned* bar; unsigned x;
    volatile LAS unsigned* st;
};

__device__ __forceinline__ XcdBarrier xcd_barrier_post(unsigned* bar, volatile LAS unsigned* st) {
    XcdBarrier b; b.bar = bar; b.x = xb_xcc_id(); b.st = st;
    if (threadIdx.x == 0) (void)xb_add(&bar[XB_XCNT(b.x)], 1u);
    return b;
}
__device__ __forceinline__ void xcd_barrier_complete(unsigned* bar, unsigned x, unsigned& nloc, unsigned& nx) {
    const unsigned G = gridDim.x * gridDim.y * gridDim.z;
    unsigned sum, cnt, mine, sp = 0u;
    for (;;) {
        sum = 0u; cnt = 0u; mine = 0u;
#pragma unroll
        for (unsigned j = 0; j < 16; ++j) { const unsigned c = xb_ld(&bar[XB_XCNT(j)]); sum += c; cnt += (c > 0u) ? 1u : 0u; mine = (j == x) ? c : mine; }
        if (sum == G) break;
        __builtin_amdgcn_s_sleep(1);
        if ((++sp & 255u) == 0u) { if (xb_ld(&bar[XB_TMO])) break; if (sp > XB_SPIN_CAP) { atomicAdd(&bar[XB_TMO], 1u); break; } }
    }
    nloc = mine > 0u ? mine : 1u; nx = cnt > 0u ? cnt : 1u;
}

__device__ __forceinline__ void xcd_barrier(const XcdBarrier& b) {
    asm volatile("s_waitcnt vmcnt(0)" ::: "memory");
    __syncthreads();
    if (threadIdx.x == 0) {
        unsigned* bar = b.bar;
        __builtin_amdgcn_s_waitcnt(0);
        unsigned nloc = b.st[0], nx = b.st[1];
        if (nloc == 0u) { xcd_barrier_complete(bar, b.x, nloc, nx); b.st[0] = nloc; b.st[1] = nx; }
        const unsigned old = xb_add(&bar[XB_XSUB(b.x)], 1u);
        const unsigned gen = old / nloc;
        if (old + 1u == (gen + 1u) * nloc) {
            __builtin_amdgcn_fence(__ATOMIC_RELEASE, "agent");
            asm volatile("s_waitcnt vmcnt(0)" ::: "memory");
            const unsigned og = xb_add(&bar[XB_TOP], 1u);
            const unsigned tg = og / nx;
            if (og + 1u == (tg + 1u) * nx) xb_add(&bar[XB_TOPGEN], 1u);
            else XB_SPIN(xb_ld(&bar[XB_TOPGEN]) == tg, bar);
            __builtin_amdgcn_fence(__ATOMIC_ACQUIRE, "agent");
            xb_add(&bar[XB_XGEN(b.x)], 1u);
            asm volatile("s_waitcnt vmcnt(0)" ::: "memory");
        } else {
            XB_SPIN(xb_ld(&bar[XB_XGEN(b.x)]) == gen, bar);
            __builtin_amdgcn_fence(__ATOMIC_ACQUIRE, "agent");
            asm volatile("s_waitcnt vmcnt(0)" ::: "memory");
        }
    }
    __syncthreads();
}

__global__ void __launch_bounds__(512, 2) fwd_kernel(Params p) {
    extern __shared__ __attribute__((aligned(16))) unsigned char lds[];
    cg::grid_group grid = cg::this_grid();
    Frame F;
    F.in = (InTab)__builtin_amdgcn_kernarg_segment_ptr(); F.out = p.out; F.ws = p.ws; F.lds = lds;
    F.tid = threadIdx.x; F.lane = threadIdx.x & 63; F.wid = __builtin_amdgcn_readfirstlane(threadIdx.x >> 6); F.nb = gridDim.x; F.bid = blockIdx.x; F.dry = 0;
    volatile LAS unsigned* xst = (volatile LAS unsigned*)(lds + LDS_BYTES - 16);
    if (threadIdx.x == 0) { xst[0] = 0u; xst[1] = 0u; }
    __syncthreads();
    const XcdBarrier xbar = xcd_barrier_post((unsigned*)(p.ws + WS_BAR), xst);
    for (int ph = p.ph_lo; ph < p.ph_hi; ++ph) {
#ifndef PHM
#define PHM 0xffff
#endif
        if (ph == 0) { if (PHM & 0x1000) phase0(F); }
        else if (ph == NPH - 1) { if (PHM & 0x2000) final_norm(F); }
        else {
            const int l = (ph - 1) / 13, k = (ph - 1) % 13;
            int gk = -1;
            switch (k) { case 0: gk = GP_IN; break; case 3: gk = GP_OUT; break; case 4: gk = GP_OUT2; break; case 5: gk = GP_WO; break; case 6: gk = GP_MQ; break; case 7: gk = GP_ATTN; break; case 8: gk = GP_ATTN2; break;
                         case 9: gk = GP_MO; break; case 10: gk = GP_UP; break; case 12: gk = GP_DOWN; break; default: break; }
#ifndef REPMASK
#define REPMASK 0
#endif
            if (gk >= 0 && (PHM & 1)) { const int nrep = ((REPMASK >> k) & 1) ? 2 : 1; for (int rep = 0; rep < nrep; ++rep) gemm_phase(F, gk, l); }
            if (k == 0 && (PHM & 1)) small_proj(F);
            if (k == 3 && (PHM & 8)) sample_kv(F, l);
#ifndef DRYMASK
#define DRYMASK 0
#endif
            for (int dr = ((DRYMASK >> k) & 1); dr >= 0; --dr) {
            F.dry = dr;
            if (k == 1 && (PHM & 2)) {
                for (int it = F.bid; it < NCH * 8; it += F.nb) { const int c = it >> 3, h = it & 3; if (it & 4) g1_gla(F, l, c, h); else g1_gdn(F, l, c, h); }
                __syncthreads();
                if (l > 0 && !dr) cvt_ffn(F, l);
            }
            if (k == 2 && (PHM & 4)) {
                for (int it = F.bid; it < 192; it += F.nb) {
                    int s, h, br;
                    if (it < 128) { br = it & 1; h = (it >> 1) & 3; s = it >> 3; } else { const int v = it - 128; br = v & 1; h = (v >> 1) & 3; s = 16 + (v >> 3); }
                    if (br) g2_gla(F, l, s, h); else g2_gdn(F, l, s, h);
                    __syncthreads();
                }
            }
            if (k == 11 && (PHM & 0x200)) { ffn_mid(F, l); if (l < 3 && !dr) { __syncthreads(); cvt_mixer(F, l + 1); } }
            }
            F.dry = 0;
        }
#ifndef SYNCREP
#define SYNCREP 1
#endif
        if (ph + 1 < p.ph_hi) {
            if (ph == 0) grid.sync();
            else xcd_barrier(xbar);
        }
    }
#ifdef DBG_COL
    __threadfence(); grid.sync(); __threadfence();
    dbg_dump(F);
#endif
}

extern "C" void kernel_launch(void* const* d_in, const int* in_sizes, int n_in, void* d_out, int out_size, void* d_ws, size_t ws_size, hipStream_t stream) {
    static int grid_blocks = 0;
    if (grid_blocks == 0) {
        if (n_in != 33 || ws_size < WS_TOTAL) { fprintf(stderr, "kernel_launch: bad n_in %d or ws %zu < %zu\n", n_in, ws_size, (size_t)WS_TOTAL); grid_blocks = -1; return; }
        int dev = 0, cus = 0, per_cu = 0;
        hipGetDevice(&dev);
        hipDeviceGetAttribute(&cus, hipDeviceAttributeMultiprocessorCount, dev);
        if (hipFuncSetAttribute((const void*)fwd_kernel, hipFuncAttributeMaxDynamicSharedMemorySize, LDS_BYTES) != hipSuccess) { fprintf(stderr, "hipFuncSetAttribute failed\n"); grid_blocks = -1; return; }
        hipOccupancyMaxActiveBlocksPerMultiprocessor(&per_cu, (const void*)fwd_kernel, 512, LDS_BYTES);
        if (per_cu < 1) per_cu = 1;
        (void)hipGetLastError();
        grid_blocks = cus * 1;
        if (grid_blocks <= 0) grid_blocks = 256;
    }
    if (grid_blocks < 0) return;
    Params p{};
    for (int i = 0; i < 33; ++i) p.in[i] = (const float*)d_in[i];
    p.out = (float*)d_out; p.ws = (unsigned char*)d_ws; p.ph_lo = 0; p.ph_hi = PH_HI;
    (void)hipMemsetAsync((unsigned char*)d_ws + WS_BAR, 0, 16384, stream);
    void* args[] = {&p};
    hipError_t e = hipLaunchCooperativeKernel((const void*)fwd_kernel, dim3(grid_blocks), dim3(512), args, LDS_BYTES, stream);
    if (e != hipSuccess) fprintf(stderr, "cooperative launch failed: %s (grid %d)\n", hipGetErrorString(e), grid_blocks);
}
```

```cpp
#include <hip/hip_runtime.h>
#include <hip/hip_cooperative_groups.h>
#include <cstdint>
#include <cstdio>
namespace cg = cooperative_groups;

typedef unsigned short bf16_t;
typedef short bf16x8 __attribute__((ext_vector_type(8)));
typedef float f32x4 __attribute__((ext_vector_type(4)));
typedef float f32x2 __attribute__((ext_vector_type(2)));
typedef unsigned u32x2 __attribute__((ext_vector_type(2)));
typedef unsigned u32x4 __attribute__((ext_vector_type(4)));
#define DEV __device__ __forceinline__

constexpr int DM = 1024, TT = 33280, NCH = 520, LDP = 5632, LDE = 768;
constexpr int C_QA = 0, C_KA = 512, C_VA = 1024, C_ZA = 1536, C_QB = 2048, C_KB = 2304, C_VB = 2560, C_ZB = 3072, C_GA = 3584, C_GB = 4608;
constexpr int C_MRG = 0, C_PR = 1024, C_Q = 2048, C_O = 3072;
constexpr size_t O_Y = 0;
constexpr size_t O_GDN_P = 34078720ull;
constexpr size_t O_GDNC_P = O_GDN_P + 4194304ull;
constexpr size_t O_GLA_P = O_GDNC_P + 294912ull;
constexpr size_t O_FFNC_P = O_GLA_P + 2097152ull;
constexpr size_t O_MEMK = O_FFNC_P + 720896ull;
constexpr size_t O_MEMV = O_MEMK + 16777216ull;
constexpr size_t O_GDN_S = O_MEMV + 16777216ull;
constexpr size_t O_GDNC_S = O_GDN_S + 2097152ull;
constexpr size_t O_GLA_S = O_GDNC_S + 147456ull;
constexpr size_t O_FFNC_S = O_GLA_S + 1048576ull;
constexpr size_t al256(size_t x) { return (x + 255) & ~(size_t)255; }
constexpr size_t WS_WMIX = 0;
constexpr size_t WM_WIN = 0, WM_WSM = WM_WIN + 5632ull * 1024, WM_WOA = WM_WSM + 32 * 1024, WM_WOB = WM_WOA + 524288, WM_WO = WM_WOB + 524288,
                 WM_WMQ = WM_WO + 1048576, WM_WMK = WM_WMQ + 1048576, WM_WMV = WM_WMK + 1048576, WM_WMO = WM_WMV + 1048576, WM_END = WM_WMO + 1048576;
constexpr size_t WS_WFFN = al256(WS_WMIX + WM_END * 2);
constexpr size_t WF_UP = 0, WF_DN = 5632ull * 1024, WF_END = WF_DN + 1024ull * 2816;
constexpr size_t WS_XB = al256(WS_WFFN + WF_END * 2);
constexpr size_t WS_P = al256(WS_XB + (size_t)TT * 1024 * 2);
constexpr size_t WS_KV = al256(WS_P + (size_t)TT * LDP * 2);
constexpr size_t KV_BYTES = 2ull * 6144 * 1024 * 2;
constexpr size_t WS_MB = al256(WS_KV + KV_BYTES);
constexpr size_t WS_MRS = al256(WS_MB + 4096ull * 1024 * 2);
constexpr size_t WS_SSQ = al256(WS_MRS + 4096 * 4);
constexpr size_t WS_SC = al256(WS_SSQ + (size_t)TT * 16 * 4);
constexpr size_t WS_DL = al256(WS_SC + (size_t)TT * 32 * 4);
constexpr size_t WS_BG = al256(WS_DL + 520ull * 4 * 64 * 4);
constexpr size_t WS_BAR = al256(WS_BG + 520ull * 4 * 128 * 4);
constexpr size_t WS_TOTAL = al256(WS_BAR + 16384);
constexpr int LDS_BYTES = 147456;
constexpr int NPH = 54;
#ifndef PH_HI
#define PH_HI NPH
#define REPMASK 0
#define SYNCREP 1
#define DRYMASK 0
#endif

struct Params { const float* in[33]; float* out; unsigned char* ws; int ph_lo, ph_hi; };

typedef __bf16 bf16x2_t __attribute__((ext_vector_type(2)));
DEV unsigned pk2(float lo, float hi) { f32x2 f = {lo, hi}; bf16x2_t v = __builtin_convertvector(f, bf16x2_t); return __builtin_bit_cast(unsigned, v); }
DEV float bf2f(bf16_t b) { return __uint_as_float(((unsigned)b) << 16); }
DEV float bflo(unsigned u) { return __uint_as_float(u << 16); }
DEV float bfhi(unsigned u) { return __uint_as_float(u & 0xffff0000u); }
DEV u32x2 pk4(f32x4 v) { u32x2 r; r.x = pk2(v[0], v[1]); r.y = pk2(v[2], v[3]); return r; }
DEV f32x4 unpk4(u32x2 u) { return (f32x4){bflo(u.x), bfhi(u.x), bflo(u.y), bfhi(u.y)}; }
DEV bf16x8 mk8(u32x2 a, u32x2 b) { u32x4 t = {a.x, a.y, b.x, b.y}; return __builtin_bit_cast(bf16x8, t); }
DEV float sigm(float x) { return 1.f / (1.f + __expf(-x)); }
DEV float silu(float x) { return x / (1.f + __expf(-x)); }
DEV float softplus(float x) { return x > 20.f ? x : __logf(1.f + __expf(x)); }
DEV float logsigmoid(float x) { return fminf(x, 0.f) - __logf(1.f + __expf(-fabsf(x))); }
DEV float row_rstd(const float* ssq, int row) {
    const f32x4 a = *(const f32x4*)(ssq + (size_t)row * 4), b = *(const f32x4*)(ssq + ((size_t)TT + row) * 4);
    const f32x4 c = *(const f32x4*)(ssq + ((size_t)2 * TT + row) * 4), d = *(const f32x4*)(ssq + ((size_t)3 * TT + row) * 4);
    float s = ((a[0] + a[1]) + (a[2] + a[3])) + ((b[0] + b[1]) + (b[2] + b[3])) + ((c[0] + c[1]) + (c[2] + c[3])) + ((d[0] + d[1]) + (d[2] + d[3]));
    return rsqrtf(s * (1.f / 1024.f) + 1e-6f);
}
DEV bf16x8 ldfragp(const bf16_t* base, int row, int stride, int k0, int fq) {
    const bf16_t* p = base + row * stride + k0 + 4 * fq;
    return mk8(*(const u32x2*)p, *(const u32x2*)(p + 16));
}
DEV bf16x8 ldfrag(const bf16_t* base, int row, int stride, int k0, int fq) {
    return *(const bf16x8*)(base + row * stride + k0 + 8 * fq);
}
#define MFMA16(a, b, c) __builtin_amdgcn_mfma_f32_16x16x32_bf16((a), (b), (c), 0, 0, 0)

constexpr int BM = 256, BK = 64, HALF = 128, HT = HALF * BK;
DEV int lds_byte(int r, int c) { int st = (r >> 4) * 2 + (c >> 5), rr = r & 15, cc = c & 31, ob = rr * 64 + cc * 2; return st * 1024 + (ob ^ (((ob >> 9) & 1) << 5)); }
DEV void stage_rc(int b, int& R, int& C) { int st = b / 1024, sb = b % 1024, swz = sb ^ (((sb >> 9) & 1) << 5); R = (st >> 1) * 16 + swz / 64; C = (st & 1) * 32 + (swz % 64) / 2; }

DEV void gemm_core(const bf16_t* __restrict__ A, int lda, const bf16_t* __restrict__ Bt, int ldb, int K, int brow, int bcol, f32x4 (&acc)[2][2][4][2], bf16_t* shm) {
#define SA(b, h) (shm + ((b) * 2 + (h)) * HT)
#define SB(b, h) (shm + (4 + (b) * 2 + (h)) * HT)
#define STAGE(P, BASE, LD, br, kt) do { const char* _gb = (const char*)((BASE) + (long)(br) * (LD) + (long)(kt) * BK); \
    const unsigned _vo = (unsigned)((sr0 * (int)(LD) + sc0) * 2); \
    for (int _i = 0; _i < 2; ++_i) { \
      __builtin_amdgcn_global_load_lds((const unsigned*)(_gb + (long)(_i * 128) * (LD) + _vo), (unsigned*)((char*)(P) + wbase + _i * 8192), 16, 0, 0); } } while (0)
#define LDA(dst, b, h) for (int m = 0; m < 4; ++m) for (int k = 0; k < 2; ++k) \
    dst[m][k] = *reinterpret_cast<const bf16x8*>((char*)SA(b, h) + lds_byte(wr * 64 + m * 16 + fr, k * 32 + fq * 8))
#define LDB(dst, b, h) for (int n = 0; n < 2; ++n) for (int k = 0; k < 2; ++k) \
    dst[n][k] = *reinterpret_cast<const bf16x8*>((char*)SB(b, h) + lds_byte(wc * 32 + n * 16 + fr, k * 32 + fq * 8))
#define MMA(ai, bj, At_, Bt_) do { __builtin_amdgcn_s_setprio(1); \
    for (int m = 0; m < 4; ++m) for (int n = 0; n < 2; ++n) for (int k = 0; k < 2; ++k) \
      acc[ai][bj][m][n] = __builtin_amdgcn_mfma_f32_16x16x32_bf16(Bt_[n][k], At_[m][k], acc[ai][bj][m][n], 0, 0, 0); \
    __builtin_amdgcn_s_setprio(0); } while (0)
#define WAIT_V(n) asm volatile("s_waitcnt vmcnt(" #n ")" ::: "memory")
#define WAIT_L(n) asm volatile("s_waitcnt lgkmcnt(" #n ")" ::: "memory")
#define BAR __builtin_amdgcn_s_barrier()
#define SCHED __builtin_amdgcn_sched_barrier(0)
    int tidx = threadIdx.x; asm volatile("" : "+v"(tidx));
    const int wid = __builtin_amdgcn_readfirstlane(tidx >> 6), lane = tidx & 63, wr = wid >> 2, wc = wid & 3, fr = lane & 15, fq = lane >> 4;
    const int wbase = wid * 1024;
    int sr0, sc0; stage_rc(tidx * 16, sr0, sc0);
#pragma unroll
    for (int a = 0; a < 2; ++a)
#pragma unroll
        for (int b = 0; b < 2; ++b)
#pragma unroll
            for (int m = 0; m < 4; ++m)
#pragma unroll
                for (int n = 0; n < 2; ++n) acc[a][b][m][n] = (f32x4){0.f, 0.f, 0.f, 0.f};
    bf16x8 At[4][2], B0[2][2], B1[2][2];
    const int nt = K / BK;
    STAGE(SB(0, 0), Bt, ldb, bcol, 0); STAGE(SA(0, 0), A, lda, brow, 0);
    STAGE(SB(0, 1), Bt, ldb, bcol + HALF, 0); STAGE(SA(0, 1), A, lda, brow + HALF, 0);
    if (wr == 1) BAR;
    WAIT_V(4); BAR;
    STAGE(SB(1, 0), Bt, ldb, bcol, 1); STAGE(SA(1, 0), A, lda, brow, 1); STAGE(SB(1, 1), Bt, ldb, bcol + HALF, 1);
    WAIT_V(6); BAR;
    for (int t = 0; t < nt - 2; t += 2) {
        LDB(B0, 0, 0); SCHED; LDA(At, 0, 0); STAGE(SA(1, 1), A, lda, brow + HALF, t + 1);
        WAIT_L(8); BAR; WAIT_L(0); MMA(0, 0, At, B0); BAR; SCHED;
        LDB(B1, 0, 1); STAGE(SB(0, 0), Bt, ldb, bcol, t + 2);
        BAR; WAIT_L(0); MMA(0, 1, At, B1); BAR;
        LDA(At, 0, 1); STAGE(SA(0, 0), A, lda, brow, t + 2);
        BAR; WAIT_L(0); MMA(1, 0, At, B0); BAR; SCHED;
        STAGE(SB(0, 1), Bt, ldb, bcol + HALF, t + 2);
        WAIT_V(6); BAR; MMA(1, 1, At, B1); BAR;
        LDB(B0, 1, 0); SCHED; LDA(At, 1, 0); STAGE(SA(0, 1), A, lda, brow + HALF, t + 2);
        WAIT_L(8); BAR; WAIT_L(0); MMA(0, 0, At, B0); BAR; SCHED;
        LDB(B1, 1, 1); STAGE(SB(1, 0), Bt, ldb, bcol, t + 3);
        BAR; WAIT_L(0); MMA(0, 1, At, B1); BAR;
        LDA(At, 1, 1); STAGE(SA(1, 0), A, lda, brow, t + 3);
        BAR; WAIT_L(0); MMA(1, 0, At, B0); BAR; SCHED;
        STAGE(SB(1, 1), Bt, ldb, bcol + HALF, t + 3);
        WAIT_V(6); BAR; MMA(1, 1, At, B1); BAR;
    }
    { LDB(B0, 0, 0); LDA(At, 0, 0); STAGE(SA(1, 1), A, lda, brow + HALF, nt - 1);
      BAR; WAIT_L(0); MMA(0, 0, At, B0); BAR;
      LDB(B1, 0, 1); BAR; WAIT_L(0); MMA(0, 1, At, B1); BAR;
      LDA(At, 0, 1); WAIT_V(4); BAR; WAIT_L(0); MMA(1, 0, At, B0); MMA(1, 1, At, B1); BAR; }
    { LDB(B0, 1, 0); LDA(At, 1, 0); WAIT_V(2); BAR; WAIT_L(0); MMA(0, 0, At, B0); BAR;
      LDB(B1, 1, 1); WAIT_V(0); BAR; WAIT_L(0); MMA(0, 1, At, B1); BAR;
      LDA(At, 1, 1); BAR; WAIT_L(0); MMA(1, 0, At, B0); MMA(1, 1, At, B1); BAR; }
    if (wr == 0) BAR;
    SCHED;
#undef SA
#undef SB
}

typedef const float* const __attribute__((address_space(4)))* InTab;
struct Frame {
    InTab in; float* out; unsigned char* ws; unsigned char* lds;
    int tid, lane, wid, nb, bid, dry;
};
#define REFRAME Frame F = F0; { int t_ = threadIdx.x; asm volatile("" : "+v"(t_)); F.tid = t_; F.lane = t_ & 63; unsigned char* w_ = F.ws; asm volatile("" : "+s"(w_)); F.ws = w_; float* o_ = F.out; asm volatile("" : "+s"(o_)); F.out = o_; InTab i_ = (InTab)__builtin_amdgcn_kernarg_segment_ptr(); asm volatile("" : "+s"(i_)); F.in = i_; int a_ = F.wid, b_ = F.bid, c_ = F.nb; asm volatile("" : "+s"(a_), "+s"(b_), "+s"(c_)); F.wid = a_; F.bid = b_; F.nb = c_; }

enum { EPI_PROJ = 0, EPI_UP, EPI_RESID, EPI_Q, EPI_MEMK, EPI_MEMV, EPI_OUTA, EPI_OUTB, EPI_SOFTMAX, EPI_ATTNO };
struct GDesc { const bf16_t* A; int lda; const bf16_t* Bt; int ldb; int K, brow, bcol, epi, orow, ocol, head, vai, vwr; };

DEV void cvt_mat(const Frame& F0, const float* src, int ldsrc, int K, int N, int wincols, const float* gain, bf16_t* dst) {
    REFRAME;
    float* T = (float*)F.lds;
    const int nkt = K / 64, nnt = N / 64, ntile = nkt * nnt;
    for (int t = F.bid; t < ntile; t += F.nb) {
        const int kt = t / nnt, ntl = t % nnt, k0 = kt * 64, n0 = ntl * 64;
        int coff = 0; if (wincols == 1) coff = (n0 < 1536) ? 0 : (n0 < 3072 ? 8 : 24);
        if (wincols == 2) { const int tl = n0 >> 8, w = n0 & 255; coff = (w < 128 ? 128 * tl + w : 2816 + 128 * tl + (w - 128)) - n0; }
        __syncthreads();
#pragma unroll
        for (int i = 0; i < 2; ++i) {
            const int kr = (F.tid >> 4) + 32 * i, nc = (F.tid & 15) * 4;
            f32x4 v = *(const f32x4*)(src + (size_t)(k0 + kr) * ldsrc + n0 + coff + nc);
            const float g = gain ? gain[k0 + kr] : 1.f;
            T[kr * 65 + nc + 0] = v[0] * g; T[kr * 65 + nc + 1] = v[1] * g; T[kr * 65 + nc + 2] = v[2] * g; T[kr * 65 + nc + 3] = v[3] * g;
        }
        __syncthreads();
        const int n = F.tid >> 3, kc = (F.tid & 7) * 8;
        u32x4 w;
        w.x = pk2(T[(kc + 0) * 65 + n], T[(kc + 1) * 65 + n]); w.y = pk2(T[(kc + 2) * 65 + n], T[(kc + 3) * 65 + n]);
        w.z = pk2(T[(kc + 4) * 65 + n], T[(kc + 5) * 65 + n]); w.w = pk2(T[(kc + 6) * 65 + n], T[(kc + 7) * 65 + n]);
        *(u32x4*)(dst + (size_t)(n0 + n) * K + k0 + kc) = w;
    }
    __syncthreads();
}
DEV void cvt_mixer(const Frame& F0, int l) {
    REFRAME;
    InTab in = F.in;
    cvt_mat(F, in[10] + (size_t)l * 1024 * 5656, 5656, 1024, 5632, 1, in[9] + l * 1024, ((bf16_t*)(F.ws + WS_WMIX)) + WM_WIN);
    cvt_mat(F, in[18] + (size_t)l * 512 * 1024, 1024, 512, 1024, 0, nullptr, ((bf16_t*)(F.ws + WS_WMIX)) + WM_WOA);
    cvt_mat(F, in[19] + (size_t)l * 512 * 1024, 1024, 512, 1024, 0, nullptr, ((bf16_t*)(F.ws + WS_WMIX)) + WM_WOB);
    cvt_mat(F, in[20] + (size_t)l * 1048576, 1024, 1024, 1024, 0, nullptr, ((bf16_t*)(F.ws + WS_WMIX)) + WM_WO);
    cvt_mat(F, in[23] + (size_t)l * 1048576, 1024, 1024, 1024, 0, in[21] + l * 1024, ((bf16_t*)(F.ws + WS_WMIX)) + WM_WMQ);
    cvt_mat(F, in[24] + (size_t)l * 1048576, 1024, 1024, 1024, 0, in[22] + l * 1024, ((bf16_t*)(F.ws + WS_WMIX)) + WM_WMK);
    cvt_mat(F, in[25] + (size_t)l * 1048576, 1024, 1024, 1024, 0, in[22] + l * 1024, ((bf16_t*)(F.ws + WS_WMIX)) + WM_WMV);
    cvt_mat(F, in[26] + (size_t)l * 1048576, 1024, 1024, 1024, 0, nullptr, ((bf16_t*)(F.ws + WS_WMIX)) + WM_WMO);
    const float* win = in[10] + (size_t)l * 1024 * 5656; const float* g = in[9] + l * 1024;
    for (int i = F.bid * 512 + F.tid; i < 32 * 1024; i += F.nb * 512) {
        const int n = i >> 10, k = i & 1023;
        float v = 0.f;
        if (n < 8) v = win[(size_t)k * 5656 + 1536 + n] * g[k]; else if (n < 24) v = win[(size_t)k * 5656 + 3080 + (n - 8)] * g[k];
        ((bf16_t*)(F.ws + WS_WMIX))[WM_WSM + i] = (bf16_t)(pk2(v, 0.f) & 0xffff);
    }
}
DEV void cvt_ffn(const Frame& F, int l) {
    cvt_mat(F, F.in[28] + (size_t)l * 1024 * 5632, 5632, 1024, 5632, 2, F.in[27] + l * 1024, ((bf16_t*)(F.ws + WS_WFFN)) + WF_UP);
    cvt_mat(F, F.in[31] + (size_t)l * 2816 * 1024, 1024, 2816, 1024, 0, nullptr, ((bf16_t*)(F.ws + WS_WFFN)) + WF_DN);
}

DEV void phase0(const Frame& F0) {
    REFRAME;
    const int gw = F.bid * 8 + F.wid, nw = F.nb * 8, lane = F.lane;
    for (int row = gw; row < TT + 4096; row += nw) {
        const bool ismem = row >= TT;
        const float* src = ismem ? F.in[8] + (size_t)(row - TT) * 1024 : (row < 32768 ? F.in[0] + (size_t)row * 1024 : F.in[1] + (size_t)(row - 32768) * 1024);
        f32x4 v[4]; float s = 0.f;
#pragma unroll
        for (int i = 0; i < 4; ++i) { v[i] = *(const f32x4*)(src + lane * 16 + i * 4); s += v[i][0] * v[i][0] + v[i][1] * v[i][1] + v[i][2] * v[i][2] + v[i][3] * v[i][3]; }
        u32x4 w0, w1;
        w0.x = pk2(v[0][0], v[0][1]); w0.y = pk2(v[0][2], v[0][3]); w0.z = pk2(v[1][0], v[1][1]); w0.w = pk2(v[1][2], v[1][3]);
        w1.x = pk2(v[2][0], v[2][1]); w1.y = pk2(v[2][2], v[2][3]); w1.z = pk2(v[3][0], v[3][1]); w1.w = pk2(v[3][2], v[3][3]);
        s += __shfl_xor(s, 1); s += __shfl_xor(s, 2);
        if (!ismem) {
            float* X = F.out + (size_t)row * 1024 + lane * 16;
#pragma unroll
            for (int i = 0; i < 4; ++i) *(f32x4*)(X + i * 4) = v[i];
            bf16_t* xb = ((bf16_t*)(F.ws + WS_XB)) + (size_t)row * 1024 + lane * 16;
            *(u32x4*)xb = w0; *(u32x4*)(xb + 8) = w1;
            if ((lane & 3) == 0) ((float*)(F.ws + WS_SSQ))[((size_t)(lane >> 4) * TT + row) * 4 + ((lane >> 2) & 3)] = s;
        } else {
            const int mr = row - TT;
            bf16_t* mb = ((bf16_t*)(F.ws + WS_MB)) + (size_t)mr * 1024 + lane * 16;
            *(u32x4*)mb = w0; *(u32x4*)(mb + 8) = w1;
            s += __shfl_xor(s, 4); s += __shfl_xor(s, 8); s += __shfl_xor(s, 16); s += __shfl_xor(s, 32);
            if (lane == 0) ((float*)(F.ws + WS_MRS))[mr] = rsqrtf(s * (1.f / 1024.f) + 1e-6f);
        }
    }
    cvt_mixer(F, 0);
    cvt_ffn(F, 0);
}

DEV void small_proj(const Frame& F0) {
    REFRAME;
    const int lane = F.lane, fr = lane & 15, fq = lane >> 4, mt = F.wid & 3, nt = F.wid >> 2;
    for (int c = F.bid; c < NCH; c += F.nb) {
        const int row = c * 64 + mt * 16 + fr;
        const bf16_t* a = ((bf16_t*)(F.ws + WS_XB)) + (size_t)row * 1024 + 8 * fq;
        const bf16_t* b = ((bf16_t*)(F.ws + WS_WMIX)) + WM_WSM + (size_t)(nt * 16 + fr) * 1024 + 8 * fq;
        f32x4 acc = {0.f, 0.f, 0.f, 0.f};
#pragma unroll 4
        for (int k = 0; k < 32; ++k) acc = MFMA16(*(const bf16x8*)(b + k * 32), *(const bf16x8*)(a + k * 32), acc);
        const float rs = row_rstd(((float*)(F.ws + WS_SSQ)), row);
        *(f32x4*)(((float*)(F.ws + WS_SC)) + (size_t)row * 32 + nt * 16 + 4 * fq) = acc * rs;
    }
}

DEV void gemm_epilogue(const Frame& F0, const GDesc& d, int l, f32x4 (&acc)[2][2][4][2]) {
    REFRAME;
    int lane_ = F.lane; asm volatile("" : "+v"(lane_));
    const int wr = F.wid >> 2, wc = F.wid & 3, fr = lane_ & 15, fq = lane_ >> 4;
    float* red = (float*)(F.lds + 131072);
    if (d.epi == EPI_SOFTMAX) {
        float mx[2][4];
#pragma unroll
        for (int ai = 0; ai < 2; ++ai)
#pragma unroll
            for (int m = 0; m < 4; ++m) {
                float v = -3.0e38f;
#pragma unroll
                for (int bj = 0; bj < 2; ++bj)
#pragma unroll
                    for (int n = 0; n < 2; ++n) { const f32x4 x = acc[ai][bj][m][n]; v = fmaxf(v, fmaxf(fmaxf(x[0], x[1]), fmaxf(x[2], x[3]))); }
                v = fmaxf(v, __shfl_xor(v, 16)); v = fmaxf(v, __shfl_xor(v, 32));
                if (fq == 0) red[(ai * 128 + wr * 64 + m * 16 + fr) * 4 + wc] = v;
            }
        __syncthreads();
#pragma unroll
        for (int ai = 0; ai < 2; ++ai)
#pragma unroll
            for (int m = 0; m < 4; ++m) {
                const f32x4 r4 = *(const f32x4*)(red + (ai * 128 + wr * 64 + m * 16 + fr) * 4);
                const float rm = fmaxf(fmaxf(r4[0], r4[1]), fmaxf(r4[2], r4[3]));
                mx[ai][m] = rm; float s = 0.f;
#pragma unroll
                for (int bj = 0; bj < 2; ++bj)
#pragma unroll
                    for (int n = 0; n < 2; ++n) { f32x4 x = acc[ai][bj][m][n];
#pragma unroll
                        for (int j = 0; j < 4; ++j) { x[j] = __expf(x[j] - rm); s += x[j]; }
                        acc[ai][bj][m][n] = x; }
                s += __shfl_xor(s, 16); s += __shfl_xor(s, 32);
                if (fq == 0) red[1024 + (ai * 128 + wr * 64 + m * 16 + fr) * 4 + wc] = s;
            }
        (void)mx;
        __syncthreads();
#pragma unroll
        for (int ai = 0; ai < 2; ++ai)
#pragma unroll
            for (int m = 0; m < 4; ++m) {
                const f32x4 r4 = *(const f32x4*)(red + 1024 + (ai * 128 + wr * 64 + m * 16 + fr) * 4);
                const float inv = 1.f / ((r4[0] + r4[1]) + (r4[2] + r4[3]));
                const bool valid = d.vai < 0 || (d.vai == ai && d.vwr == wr);
                const int row = d.orow + ai * 128 + wr * 64 + m * 16 + fr;
                if (valid) {
#pragma unroll
                    for (int bj = 0; bj < 2; ++bj)
#pragma unroll
                        for (int n = 0; n < 2; ++n) {
                            const int col = bj * 128 + wc * 32 + n * 16 + fq * 4;
                            *(u32x2*)(((bf16_t*)(F.ws + WS_P)) + (size_t)row * LDP + C_PR + d.head * 256 + col) = pk4(acc[ai][bj][m][n] * inv);
                        }
                }
            }
        __syncthreads();
        return;
    }
#pragma unroll
    for (int ai = 0; ai < 2; ++ai)
#pragma unroll
        for (int m = 0; m < 4; ++m) {
            const int row = d.orow + ai * 128 + wr * 64 + m * 16 + fr;
            float rs = 1.f, ss = 0.f;
            if (d.epi == EPI_PROJ || d.epi == EPI_UP || d.epi == EPI_Q) rs = row_rstd(((float*)(F.ws + WS_SSQ)), row);
            if (d.epi == EPI_Q) rs *= 0.0625f;
            if (d.epi == EPI_MEMK) rs = ((float*)(F.ws + WS_MRS))[row];
#pragma unroll
            for (int bj = 0; bj < 2; ++bj)
#pragma unroll
                for (int n = 0; n < 2; ++n) {
                    const int col = d.ocol + bj * 128 + wc * 32 + n * 16 + fq * 4;
                    f32x4 v = acc[ai][bj][m][n];
                    switch (d.epi) {
                    case EPI_UP: {
                        const int row_l = ai * 128 + wr * 64 + m * 16 + fr, cl = bj * 128 + wc * 32 + n * 16 + fq * 4;
                        *(u32x2*)((bf16_t*)F.lds + row_l * 264 + cl) = pk4(v * rs);
                    } break;
                    case EPI_PROJ: {
                        v = v * rs; const u32x2 w = pk4(v);
                        *(u32x2*)(((bf16_t*)(F.ws + WS_P)) + (size_t)row * LDP + col) = w;
                        if (m == 3 && fr >= 13 && col < 1536) {
                            const int chunk = row >> 6, hr = fr - 13;
                            *(u32x2*)(((bf16_t*)(F.ws + WS_KV)) + ((size_t)chunk * 3 + hr) * 1536 + col) = w;
                            if (chunk >= 512 || (chunk & 31) == 31) {
                                float* o = chunk < 512 ? F.out + O_GDNC_P + ((size_t)(l * 16 + (chunk >> 5)) * 3 + hr) * 1536 + col
                                                       : F.out + O_GDNC_S + ((size_t)(l * 8 + (chunk - 512)) * 3 + hr) * 1536 + col;
                                *(f32x4*)o = v;
                            }
                        }
                    } break;
                    case EPI_RESID: {
                        float* X = F.out + (size_t)row * 1024 + col;
                        f32x4 x = *(const f32x4*)X; x = x + v; *(f32x4*)X = x;
                        *(u32x2*)(((bf16_t*)(F.ws + WS_XB)) + (size_t)row * 1024 + col) = pk4(x);
                        ss += (x[0] * x[0] + x[1] * x[1]) + (x[2] * x[2] + x[3] * x[3]);
                    } break;
                    case EPI_Q: *(u32x2*)(((bf16_t*)(F.ws + WS_P)) + (size_t)row * LDP + C_Q + col) = pk4(v * rs); break;
                    case EPI_MEMK: {
                        v = v * rs;
                        *(f32x4*)(F.out + O_MEMK + ((size_t)l * 4096 + row) * 1024 + col) = v;
                        *(u32x2*)(((bf16_t*)(F.ws + WS_KV)) + (size_t)row * 1024 + col) = pk4(v);
                    } break;
                    case EPI_MEMV: {
                        const f32x4 r4 = *(const f32x4*)(((float*)(F.ws + WS_MRS)) + col);
                        v = v * r4;
                        float* o = F.out + O_MEMV + ((size_t)l * 4096 + col) * 1024 + row;
                        o[0] = v[0]; o[1024] = v[1]; o[2048] = v[2]; o[3072] = v[3];
                        const int b = col >> 8, h = row >> 8;
                        *(u32x2*)(((bf16_t*)(F.ws + WS_KV + 6144ull * 1024 * 2)) + ((size_t)(b * 4 + h) * 256 + (row & 255)) * 256 + (col & 255)) = pk4(v);
                    } break;
                    case EPI_OUTA: {
                        const f32x4 g = unpk4(*(const u32x2*)(((bf16_t*)(F.ws + WS_P)) + (size_t)row * LDP + C_GA + col));
                        f32x4 o; for (int j = 0; j < 4; ++j) o[j] = sigm(g[j]) * v[j];
                        *(u32x2*)(((bf16_t*)(F.ws + WS_P)) + (size_t)row * LDP + C_MRG + col) = pk4(o);
                    } break;
                    case EPI_OUTB: {
                        const f32x4 g = unpk4(*(const u32x2*)(((bf16_t*)(F.ws + WS_P)) + (size_t)row * LDP + C_GB + col));
                        f32x4 o = unpk4(*(const u32x2*)(((bf16_t*)(F.ws + WS_P)) + (size_t)row * LDP + C_MRG + col));
                        for (int j = 0; j < 4; ++j) o[j] += sigm(g[j]) * v[j];
                        *(u32x2*)(((bf16_t*)(F.ws + WS_P)) + (size_t)row * LDP + C_MRG + col) = pk4(o);
                    } break;
                    case EPI_ATTNO: {
                        const bool valid = d.vai < 0 || (d.vai == ai && d.vwr == wr);
                        if (valid) *(u32x2*)(((bf16_t*)(F.ws + WS_P)) + (size_t)row * LDP + C_O + d.head * 256 + col) = pk4(v);
                    } break;
                    default: break;
                    }
                }
            if (d.epi == EPI_RESID) {
                ss += __shfl_xor(ss, 16); ss += __shfl_xor(ss, 32);
                if (fq == 0) ((float*)(F.ws + WS_SSQ))[((size_t)(d.ocol >> 8) * TT + row) * 4 + wc] = ss;
            }
        }
    if (d.epi == EPI_UP) {
        bf16_t* ST = (bf16_t*)F.lds;
        const int pm = d.brow >> 8, pn = d.bcol >> 8;
        const bool samp = pm >= 128, needfix = !samp && (pm & 7) != 0;
        bf16_t* halo = ((bf16_t*)(F.ws + WS_KV)); bf16_t* raw01 = ((bf16_t*)(F.ws + WS_KV + 11714560ull));
        __syncthreads();
        {
            const int hsel = F.tid >> 6, cl4 = (F.tid & 63) * 4, ocol = ((cl4 >> 7) ? 2816 : 0) + 128 * pn + (cl4 & 127);
            const int row_l = (hsel >> 1) * 64 + 62 + (hsel & 1), chunk = (d.brow + row_l) >> 6, hr = hsel & 1;
            const u32x2 w = *(const u32x2*)(ST + row_l * 264 + cl4);
            *(u32x2*)(halo + ((size_t)chunk * 2 + hr) * 5632 + ocol) = w;
            if (chunk >= 512 || (chunk & 31) == 31) {
                float* o = chunk < 512 ? F.out + O_FFNC_P + ((size_t)(l * 16 + (chunk >> 5)) * 2 + hr) * 5632 + ocol
                                       : F.out + O_FFNC_S + ((size_t)(l * 8 + (chunk - 512)) * 2 + hr) * 5632 + ocol;
                *(f32x4*)o = unpk4(w);
            }
            if (needfix && hsel < 2) *(u32x2*)(raw01 + ((size_t)pm * 2 + hsel) * 5632 + ocol) = *(const u32x2*)(ST + hsel * 264 + cl4);
        }
        {
            const int cq = F.tid & 31, rg = F.tid >> 5, c4 = cq * 4, gcol = 128 * pn + c4, r0 = rg * 16;
            const float* cw = F.in[29] + (size_t)l * 3 * 5632; const float* cb = F.in[30] + (size_t)l * 5632;
            const f32x4 wg0 = *(const f32x4*)(cw + gcol), wg1 = *(const f32x4*)(cw + 5632 + gcol), wg2 = *(const f32x4*)(cw + 2 * 5632 + gcol), bg = *(const f32x4*)(cb + gcol);
            const f32x4 wv0 = *(const f32x4*)(cw + 2816 + gcol), wv1 = *(const f32x4*)(cw + 5632 + 2816 + gcol), wv2 = *(const f32x4*)(cw + 2 * 5632 + 2816 + gcol), bv = *(const f32x4*)(cb + 2816 + gcol);
            f32x4 g2 = {0.f, 0.f, 0.f, 0.f}, g1 = g2, v2 = g2, v1 = g2; bool skip2 = false;
            if ((samp ? (r0 & 63) : r0) != 0) {
                g2 = unpk4(*(const u32x2*)(ST + (r0 - 2) * 264 + c4)); g1 = unpk4(*(const u32x2*)(ST + (r0 - 1) * 264 + c4));
                v2 = unpk4(*(const u32x2*)(ST + (r0 - 2) * 264 + 128 + c4)); v1 = unpk4(*(const u32x2*)(ST + (r0 - 1) * 264 + 128 + c4));
            } else if (samp) {
                const float* sp = F.in[5] + (size_t)(l * 8 + (((d.brow + r0) >> 6) - 512)) * 2 * 5632;
                g2 = *(const f32x4*)(sp + gcol); g1 = *(const f32x4*)(sp + 5632 + gcol); v2 = *(const f32x4*)(sp + 2816 + gcol); v1 = *(const f32x4*)(sp + 5632 + 2816 + gcol);
            } else skip2 = needfix;
#pragma unroll 4
            for (int i = 0; i < 16; ++i) {
                const int row_l = r0 + i;
                const f32x4 g0 = unpk4(*(const u32x2*)(ST + row_l * 264 + c4)), v0 = unpk4(*(const u32x2*)(ST + row_l * 264 + 128 + c4));
                f32x4 o;
#pragma unroll
                for (int j = 0; j < 4; ++j) { const float yg = wg0[j] * g2[j] + wg1[j] * g1[j] + wg2[j] * g0[j] + bg[j], yv = wv0[j] * v2[j] + wv1[j] * v1[j] + wv2[j] * v0[j] + bv[j]; o[j] = silu(yg) * yv; }
                if (!(skip2 && i < 2)) *(u32x2*)(((bf16_t*)(F.ws + WS_P)) + (size_t)(d.brow + row_l) * LDP + gcol) = pk4(o);
                g2 = g1; g1 = g0; v2 = v1; v1 = v0;
            }
        }
        __syncthreads();
    }
}

DEV void sample_rows_gemm(const Frame& F0, const bf16_t* A, int lda, const bf16_t* Bt, int K, int resid) {
    REFRAME;
    if (F.nb != 256) return;
    const int fr = F.lane & 15, fq = F.lane >> 4, w = F.wid, rgp = F.bid >> 3, cg = F.bid & 7;
    const int row = 32768 + rgp * 16 + fr, colt = cg * 128 + w * 16;
    const bf16_t* ap = A + (size_t)row * lda + 8 * fq;
    const bf16_t* bp = Bt + (size_t)(colt + fr) * K + 8 * fq;
    f32x4 acc = {0.f, 0.f, 0.f, 0.f};
#pragma unroll 8
    for (int k = 0; k < K; k += 32) acc = MFMA16(*(const bf16x8*)(bp + k), *(const bf16x8*)(ap + k), acc);
    const int col = colt + 4 * fq;
    if (resid == 1) {
        float* X = F.out + (size_t)row * 1024 + col;
        f32x4 x = *(const f32x4*)X; x = x + acc; *(f32x4*)X = x;
        *(u32x2*)(((bf16_t*)(F.ws + WS_XB)) + (size_t)row * 1024 + col) = pk4(x);
        float ss = (x[0] * x[0] + x[1] * x[1]) + (x[2] * x[2] + x[3] * x[3]);
        ss += __shfl_xor(ss, 16); ss += __shfl_xor(ss, 32);
        float* red = (float*)F.lds;
        __syncthreads();
        if (fq == 0) red[fr * 8 + w] = ss;
        __syncthreads();
        if (F.tid < 32) {
            const int r = F.tid & 15, g = F.tid >> 4, c0 = cg * 128 + g * 64;
            const float t = (red[r * 8 + g * 4] + red[r * 8 + g * 4 + 1]) + (red[r * 8 + g * 4 + 2] + red[r * 8 + g * 4 + 3]);
            ((float*)(F.ws + WS_SSQ))[((size_t)(c0 >> 8) * TT + 32768 + rgp * 16 + r) * 4 + ((c0 >> 6) & 3)] = t;
        }
        __syncthreads();
    } else if (resid == 0) {
        const float rs = row_rstd(((float*)(F.ws + WS_SSQ)), row) * 0.0625f;
        *(u32x2*)(((bf16_t*)(F.ws + WS_P)) + (size_t)row * LDP + C_Q + col) = pk4(acc * rs);
    } else {
        bf16_t* prow = ((bf16_t*)(F.ws + WS_P)) + (size_t)row * LDP;
        const f32x4 g = unpk4(*(const u32x2*)(prow + (resid == 2 ? C_GA : C_GB) + col));
        f32x4 o = {0.f, 0.f, 0.f, 0.f};
        if (resid == 3) o = unpk4(*(const u32x2*)(prow + C_MRG + col));
#pragma unroll
        for (int j = 0; j < 4; ++j) o[j] += sigm(g[j]) * acc[j];
        *(u32x2*)(prow + C_MRG + col) = pk4(o);
    }
}

enum { GP_IN = 0, GP_OUT, GP_WO, GP_MQ, GP_ATTN, GP_MO, GP_UP, GP_DOWN, GP_ATTN2, GP_OUT2, GP_MEMKV };
DEV void gemm_phase(const Frame& F0, int kind, int l) {
    REFRAME;
    int nunits = 0;
    switch (kind) { case GP_IN: case GP_UP: nunits = 130 * 22; break; case GP_OUT: nunits = 520 + 128; break; case GP_OUT2: nunits = 520; break; case GP_ATTN: case GP_ATTN2: nunits = 512 + 32; break; default: nunits = 520; }
    const bool srow = (F.nb == 256) && (kind == GP_WO || kind == GP_MQ || kind == GP_MO || kind == GP_DOWN || kind == GP_OUT || kind == GP_OUT2);
    if (srow) nunits = 512;
    if (kind == GP_MEMKV) nunits = 128;
    f32x4 acc[2][2][4][2];
    const bool xmap = (F.nb == 256) && (kind == GP_IN || kind == GP_UP || kind == GP_WO || kind == GP_MQ || kind == GP_MO || kind == GP_DOWN || kind == GP_OUT2 || (kind == GP_OUT && srow));
    const int xcd = F.bid & 7, slot = F.bid >> 3, w_lo = (int)(((long)nunits * xcd) >> 3), w_hi = (int)(((long)nunits * (xcd + 1)) >> 3);
    const bool mkv = kind == GP_MEMKV;
    for (int u0 = mkv ? (F.bid >= 192 ? F.bid - 192 : nunits) : (xmap ? w_lo + slot : F.bid); u0 < (xmap ? w_hi : nunits); u0 += mkv ? 64 : (xmap ? 32 : F.nb)) {
        int u = u0;
        if (xmap) { const int nn = (kind == GP_IN || kind == GP_UP) ? 22 : 4; const int nm = srow ? 128 : 130; const int pn_ = u0 / nm, pm_ = u0 % nm; u = pm_ * nn + pn_; }
        GDesc d;
        { const int sub = (kind == GP_ATTN2 || kind == GP_OUT2) ? 1 : 0;
            d.vai = -1; d.vwr = 0; d.head = 0;
            switch (kind) {
            case GP_IN: { const int pm = u / 22, pn = u % 22; d.A = ((bf16_t*)(F.ws + WS_XB)); d.lda = 1024; d.Bt = ((bf16_t*)(F.ws + WS_WMIX)) + WM_WIN; d.ldb = 1024; d.K = 1024; d.brow = pm * 256; d.bcol = pn * 256; d.epi = EPI_PROJ; d.orow = d.brow; d.ocol = d.bcol; } break;
            case GP_UP: { const int pm = u / 22, pn = u % 22; d.A = ((bf16_t*)(F.ws + WS_XB)); d.lda = 1024; d.Bt = ((bf16_t*)(F.ws + WS_WFFN)) + WF_UP; d.ldb = 1024; d.K = 1024; d.brow = pm * 256; d.bcol = pn * 256; d.epi = EPI_UP; d.orow = d.brow; d.ocol = d.bcol; } break;
            case GP_MEMKV: case GP_OUT: case GP_OUT2:
                if (kind == GP_MEMKV) u += 520;
                if (u < 520) { const int pm = u >> 2, pn = u & 3; d.A = ((bf16_t*)(F.ws + WS_P)) + (sub == 0 ? C_ZA : C_ZB); d.lda = LDP; d.Bt = ((bf16_t*)(F.ws + WS_WMIX)) + (sub == 0 ? WM_WOA : WM_WOB); d.ldb = 512; d.K = 512;
                               d.brow = pm * 256; d.bcol = pn * 256; d.epi = sub == 0 ? EPI_OUTA : EPI_OUTB; d.orow = d.brow; d.ocol = d.bcol; }
                else if (u < 520 + 64) { const int v = u - 520, pm = v >> 2, pn = v & 3; d.A = ((bf16_t*)(F.ws + WS_MB)); d.lda = 1024; d.Bt = ((bf16_t*)(F.ws + WS_WMIX)) + WM_WMK; d.ldb = 1024; d.K = 1024; d.brow = pm * 256; d.bcol = pn * 256; d.epi = EPI_MEMK; d.orow = d.brow; d.ocol = d.bcol; }
                else { const int v = u - 584, pm = v & 3, pn = v >> 2; d.A = ((bf16_t*)(F.ws + WS_WMIX)) + WM_WMV; d.lda = 1024; d.Bt = ((bf16_t*)(F.ws + WS_MB)); d.ldb = 1024; d.K = 1024; d.brow = pm * 256; d.bcol = pn * 256; d.epi = EPI_MEMV; d.orow = d.brow; d.ocol = d.bcol; }
                break;
            case GP_WO: { const int pm = u >> 2, pn = u & 3; d.A = ((bf16_t*)(F.ws + WS_P)) + C_MRG; d.lda = LDP; d.Bt = ((bf16_t*)(F.ws + WS_WMIX)) + WM_WO; d.ldb = 1024; d.K = 1024; d.brow = pm * 256; d.bcol = pn * 256; d.epi = EPI_RESID; d.orow = d.brow; d.ocol = d.bcol; } break;
            case GP_MQ: { const int pm = u >> 2, pn = u & 3; d.A = ((bf16_t*)(F.ws + WS_XB)); d.lda = 1024; d.Bt = ((bf16_t*)(F.ws + WS_WMIX)) + WM_WMQ; d.ldb = 1024; d.K = 1024; d.brow = pm * 256; d.bcol = pn * 256; d.epi = EPI_Q; d.orow = d.brow; d.ocol = d.bcol; } break;
            case GP_MO: { const int pm = u >> 2, pn = u & 3; d.A = ((bf16_t*)(F.ws + WS_P)) + C_O; d.lda = LDP; d.Bt = ((bf16_t*)(F.ws + WS_WMIX)) + WM_WMO; d.ldb = 1024; d.K = 1024; d.brow = pm * 256; d.bcol = pn * 256; d.epi = EPI_RESID; d.orow = d.brow; d.ocol = d.bcol; } break;
            case GP_DOWN: { const int pm = u >> 2, pn = u & 3; d.A = ((bf16_t*)(F.ws + WS_P)); d.lda = LDP; d.Bt = ((bf16_t*)(F.ws + WS_WFFN)) + WF_DN; d.ldb = 2816; d.K = 2816; d.brow = pm * 256; d.bcol = pn * 256; d.epi = EPI_RESID; d.orow = d.brow; d.ocol = d.bcol; } break;
            case GP_ATTN: case GP_ATTN2: {
                int pm, h, b;
                if (u < 512) { pm = u >> 2; h = u & 3; b = pm >> 3; }
                else { const int v = u - 512; h = v & 3; const int bi = (v >> 2) & 3, t = v >> 4; pm = 128 + t; b = 16 + 4 * t + bi; d.vai = bi >> 1; d.vwr = bi & 1; }
                d.head = h; d.brow = pm * 256; d.orow = d.brow; d.ocol = 0; d.K = 256; d.bcol = 0;
                if (sub == 0) { d.A = ((bf16_t*)(F.ws + WS_P)) + C_Q + h * 256; d.lda = LDP; d.Bt = ((bf16_t*)(F.ws + WS_KV)) + (size_t)b * 256 * 1024 + h * 256; d.ldb = 1024; d.epi = EPI_SOFTMAX; }
                else { d.A = ((bf16_t*)(F.ws + WS_P)) + C_PR + h * 256; d.lda = LDP; d.Bt = ((bf16_t*)(F.ws + WS_KV + 6144ull * 1024 * 2)) + (size_t)(b * 4 + h) * 65536; d.ldb = 256; d.epi = EPI_ATTNO; }
            } break;
            }
        }
        gemm_core(d.A, d.lda, d.Bt, d.ldb, d.K, d.brow, d.bcol, acc, (bf16_t*)F.lds);
        gemm_epilogue(F, d, l, acc);
    }
    if (srow) {
        __syncthreads();
        if (kind == GP_WO) sample_rows_gemm(F, ((bf16_t*)(F.ws + WS_P)) + C_MRG, LDP, ((bf16_t*)(F.ws + WS_WMIX)) + WM_WO, 1024, 1);
        else if (kind == GP_MQ) sample_rows_gemm(F, ((bf16_t*)(F.ws + WS_XB)), 1024, ((bf16_t*)(F.ws + WS_WMIX)) + WM_WMQ, 1024, 0);
        else if (kind == GP_OUT) sample_rows_gemm(F, ((bf16_t*)(F.ws + WS_P)) + C_ZA, LDP, ((bf16_t*)(F.ws + WS_WMIX)) + WM_WOA, 512, 2);
        else if (kind == GP_OUT2) sample_rows_gemm(F, ((bf16_t*)(F.ws + WS_P)) + C_ZB, LDP, ((bf16_t*)(F.ws + WS_WMIX)) + WM_WOB, 512, 3);
        else if (kind == GP_MO) sample_rows_gemm(F, ((bf16_t*)(F.ws + WS_P)) + C_O, LDP, ((bf16_t*)(F.ws + WS_WMIX)) + WM_WMO, 1024, 1);
        else sample_rows_gemm(F, ((bf16_t*)(F.ws + WS_P)), LDP, ((bf16_t*)(F.ws + WS_WFFN)) + WF_DN, 2816, 1);
    }
}

DEV void sample_kv(const Frame& F0, int l) {
    REFRAME;
    const float* ck = F.in[6] + (size_t)l * 2097152; const float* cv = F.in[7] + (size_t)l * 2097152;
    const bool idle = F.nb == 256;
    if (idle && F.bid < 192) return;
    for (int i = (idle ? F.bid - 192 : F.bid) * 512 + F.tid; i < 262144; i += (idle ? 64 : F.nb) * 512) {
        const f32x4 a = *(const f32x4*)(ck + (size_t)i * 8), b = *(const f32x4*)(ck + (size_t)i * 8 + 4);
        u32x4 w; w.x = pk2(a[0], a[1]); w.y = pk2(a[2], a[3]); w.z = pk2(b[0], b[1]); w.w = pk2(b[2], b[3]);
        *(u32x4*)(((bf16_t*)(F.ws + WS_KV)) + 4096ull * 1024 + (size_t)i * 8) = w;
        const int dd = i & 255, m8 = (i >> 8) & 31, h = (i >> 13) & 3, bb = i >> 15;
        const float* s = cv + ((size_t)(bb * 256 + m8 * 8) * 4 + h) * 256 + dd;
        u32x4 x; x.x = pk2(s[0], s[1024]); x.y = pk2(s[2048], s[3072]); x.z = pk2(s[4096], s[5120]); x.w = pk2(s[6144], s[7168]);
        *(u32x4*)(((bf16_t*)(F.ws + WS_KV + 6144ull * 1024 * 2)) + ((size_t)((16 + bb) * 4 + h) * 256 + dd) * 256 + m8 * 8) = x;
    }
}

DEV void g1_gdn(const Frame& F0, int l, int c, int h) {
    REFRAME;
    float* Fq = (float*)F.lds;
    bf16_t* VS = (bf16_t*)(F.lds + 66560);
    bf16_t* QN = (bf16_t*)(F.lds + 82944);
    bf16_t* KN = (bf16_t*)(F.lds + 100352);
    float* AM = (float*)(F.lds + 117760);
    float* sB = (float*)(F.lds + 135168); float* sG = sB + 64; float* sRQ = sB + 128; float* sRK = sB + 192;
    const int tid = F.tid, lane = F.lane, t0 = c * 64;
    const bool first = c >= 512 || (c & 31) == 0; const bool sample = c >= 512;
    __syncthreads();
    if (F.wid == 0) {
        const int t = t0 + lane;
        const float braw = ((float*)(F.ws + WS_SC))[(size_t)t * 32 + h], araw = ((float*)(F.ws + WS_SC))[(size_t)t * 32 + 4 + h];
        const float beta = sigm(braw);
        float g = -__expf(F.in[12][l * 4 + h]) * softplus(araw + F.in[13][l * 4 + h]);
#pragma unroll
        for (int off = 1; off < 64; off <<= 1) { const float n = __shfl_up(g, off); if (lane >= off) g += n; }
        sB[lane] = beta; sG[lane] = g;
        if (!F.dry) ((float*)(F.ws + WS_BG))[((size_t)c * 4 + h) * 128 + lane] = beta; if (!F.dry) ((float*)(F.ws + WS_BG))[((size_t)c * 4 + h) * 128 + 64 + lane] = g;
    }
    __syncthreads();
    const float* cw = F.in[11] + (size_t)l * 4 * 1536;
    if (tid < 384) {
        const int cp = tid % 192, rh = tid / 192, which = cp >> 6, cc = (cp & 63) * 2, pcol = which * 512 + h * 128 + cc;
        const f32x2 w0 = *(const f32x2*)(cw + pcol), w1 = *(const f32x2*)(cw + 1536 + pcol), w2 = *(const f32x2*)(cw + 2 * 1536 + pcol), w3 = *(const f32x2*)(cw + 3 * 1536 + pcol);
        float x0[35], x1[35];
#pragma unroll
        for (int i = 0; i < 3; ++i) {
            x0[i] = 0.f; x1[i] = 0.f;
            if (rh == 1) { const unsigned u = *(const unsigned*)(((bf16_t*)(F.ws + WS_P)) + (size_t)(t0 + 29 + i) * LDP + pcol); x0[i] = bflo(u); x1[i] = bfhi(u); }
            else if (!first) { const unsigned u = *(const unsigned*)(((bf16_t*)(F.ws + WS_KV)) + ((size_t)(c - 1) * 3 + i) * 1536 + pcol); x0[i] = bflo(u); x1[i] = bfhi(u); }
            else if (sample) { const f32x2 f = *(const f32x2*)(F.in[3] + ((size_t)(l * 8 + (c - 512)) * 3 + i) * 1536 + pcol); x0[i] = f[0]; x1[i] = f[1]; }
        }
#pragma unroll
        for (int i = 0; i < 32; ++i) { const unsigned u = *(const unsigned*)(((bf16_t*)(F.ws + WS_P)) + (size_t)(t0 + 32 * rh + i) * LDP + pcol); x0[3 + i] = bflo(u); x1[3 + i] = bfhi(u); }
#pragma unroll
        for (int r = 0; r < 32; ++r) {
            float a0 = w0[0] * x0[r] + w1[0] * x0[r + 1] + w2[0] * x0[r + 2] + w3[0] * x0[r + 3];
            float a1 = w0[1] * x1[r] + w1[1] * x1[r + 1] + w2[1] * x1[r + 2] + w3[1] * x1[r + 3];
            a0 = silu(a0); a1 = silu(a1);
            const int rr = 32 * rh + r;
            if (which < 2) { *(f32x2*)(Fq + rr * 260 + which * 128 + cc) = (f32x2){a0, a1}; }
            else { const float be = sB[rr]; *(unsigned*)(VS + rr * 128 + cc) = pk2(a0 * be, a1 * be); }
        }
    }
    __syncthreads();
    {
        const int r = tid >> 3, j = tid & 7; const float* p = Fq + r * 260 + j * 32; float s = 0.f;
#pragma unroll
        for (int i = 0; i < 32; ++i) s += p[i] * p[i];
        s += __shfl_xor(s, 1); s += __shfl_xor(s, 2);
        if ((j & 3) == 0) { if (j == 0) sRQ[r] = rsqrtf(s + 1e-6f) * 0.08838834764831845f; else sRK[r] = rsqrtf(s + 1e-6f); }
    }
    __syncthreads();
    for (int idx = tid; idx < 64 * 64; idx += 512) {
        const int r = idx >> 6, c4 = (idx & 63) * 4; const bool isq = c4 < 128;
        f32x4 v = *(const f32x4*)(Fq + r * 260 + c4); v = v * (isq ? sRQ[r] : sRK[r]);
        const u32x2 w = pk4(v);
        if (isq) { *(u32x2*)(QN + r * 136 + c4) = w; if (!F.dry) *(u32x2*)(((bf16_t*)(F.ws + WS_P)) + (size_t)(t0 + r) * LDP + C_QA + h * 128 + c4) = w; }
        else { *(u32x2*)(KN + r * 136 + c4 - 128) = w; if (!F.dry) *(u32x2*)(((bf16_t*)(F.ws + WS_P)) + (size_t)(t0 + r) * LDP + C_KA + h * 128 + c4 - 128) = w; }
    }
    for (int idx = tid; idx < 64 * 32; idx += 512) {
        const int r = idx >> 5, c4 = (idx & 31) * 4;
        if (!F.dry) *(u32x2*)(((bf16_t*)(F.ws + WS_P)) + (size_t)(t0 + r) * LDP + C_VA + h * 128 + c4) = *(const u32x2*)(VS + r * 128 + c4);
    }
    __syncthreads();
    {
        const int fr = lane & 15, fq = lane >> 4, which = F.wid >> 2, it = F.wid & 3;
        const bf16_t* X = which ? QN : KN;
        const int crow = 16 * it + fr; const float gc = sG[crow], bc = sB[crow];
        for (int jt = 0; jt < 4; ++jt) {
            f32x4 a = {0.f, 0.f, 0.f, 0.f};
            if (jt <= it) {
#pragma unroll
                for (int ks = 0; ks < 4; ++ks) a = MFMA16(ldfrag(KN, 16 * jt + fr, 136, 32 * ks, fq), ldfrag(X, crow, 136, 32 * ks, fq), a);
            }
            f32x4 o;
#pragma unroll
            for (int j = 0; j < 4; ++j) {
                const int s = 16 * jt + 4 * fq + j;
                const bool keep = which ? (s <= crow) : (s < crow);
                const float dec = keep ? __expf(gc - sG[s]) : 0.f;
                o[j] = a[j] * dec * (which ? 1.f : bc);
            }
            if (which) { if (!F.dry) *(u32x2*)(((bf16_t*)(F.ws + WS_XB)) + (size_t)(t0 + crow) * LDE + h * 128 + 64 + 16 * jt + 4 * fq) = pk4(o); }
            else *(f32x4*)(AM + crow * 68 + 16 * jt + 4 * fq) = o;
        }
    }
    __syncthreads();
    if (F.wid == 0) {
        float Tc[64]; const float lanef = (float)lane;
        typedef __attribute__((address_space(3))) const f32x4 LDSF4;
        __attribute__((address_space(3))) const char* aml = (__attribute__((address_space(3))) const char*)AM; asm volatile("" : "+v"(aml));
#pragma unroll
        for (int i = 0; i < 64; ++i) {
            float a = fmaxf(0.f, 1.f - fabsf(lanef - (float)i));
#pragma unroll
            for (int j4 = 0; j4 < (i + 3) / 4; ++j4) {
                const f32x4 av = *(const LDSF4*)(aml + (i * 68 + j4 * 4) * 4);
#pragma unroll
                for (int jj = 0; jj < 4; ++jj) if (j4 * 4 + jj < i) a -= av[jj] * Tc[j4 * 4 + jj];
            }
            Tc[i] = a;
        }
#pragma unroll
        for (int i = 0; i < 64; i += 2) {
            const unsigned w = pk2(Tc[i], Tc[i + 1]);
            if (!F.dry) ((bf16_t*)(F.ws + WS_XB))[(size_t)(t0 + i) * LDE + h * 128 + lane] = (bf16_t)(w & 0xffff);
            if (!F.dry) ((bf16_t*)(F.ws + WS_XB))[(size_t)(t0 + i + 1) * LDE + h * 128 + lane] = (bf16_t)(w >> 16);
        }
    }
}

DEV void g1_gla(const Frame& F0, int l, int c, int h) {
    REFRAME;
    float* GL = (float*)F.lds;
    float* LA = (float*)(F.lds + 4096);
    bf16_t* QG = (bf16_t*)(F.lds + 20736);
    bf16_t* KI = (bf16_t*)(F.lds + 29952);
    const int tid = F.tid, lane = F.lane, t0 = c * 64;
    __syncthreads();
    if (tid < 256) { const int r = tid >> 2, q4 = (tid & 3) * 4; *(f32x4*)(GL + r * 16 + q4) = *(const f32x4*)(((float*)(F.ws + WS_SC)) + (size_t)(t0 + r) * 32 + 8 + q4); }
    __syncthreads();
    {
        const int dk = tid & 63, rb = tid >> 6;
        float w2[16];
#pragma unroll
        for (int i = 0; i < 16; ++i) w2[i] = F.in[15][(size_t)(l * 16 + i) * 256 + h * 64 + dk];
        const float bias = F.in[16][l * 256 + h * 64 + dk];
#pragma unroll
        for (int rr = 0; rr < 8; ++rr) {
            const int r = rb * 8 + rr; float x = bias;
#pragma unroll
            for (int i = 0; i < 16; ++i) x += GL[r * 16 + i] * w2[i];
            LA[r * 65 + dk] = logsigmoid(x) * 0.0625f;
        }
    }
    __syncthreads();
    if (tid < 64) {
        float g = 0.f;
#pragma unroll 8
        for (int r = 0; r < 64; ++r) { g += LA[r * 65 + tid]; LA[r * 65 + tid] = g; }
        if (!F.dry) ((float*)(F.ws + WS_DL))[((size_t)c * 4 + h) * 64 + tid] = __expf(g);
    }
    __syncthreads();
    for (int idx = tid; idx < 64 * 16; idx += 512) {
        const int r = idx >> 4, c4 = (idx & 15) * 4;
        bf16_t* qp = ((bf16_t*)(F.ws + WS_P)) + (size_t)(t0 + r) * LDP + C_QB + h * 64 + c4; bf16_t* kp = ((bf16_t*)(F.ws + WS_P)) + (size_t)(t0 + r) * LDP + C_KB + h * 64 + c4;
        const f32x4 q = unpk4(*(const u32x2*)qp), k = unpk4(*(const u32x2*)kp);
        f32x4 qg, ki, kg;
#pragma unroll
        for (int j = 0; j < 4; ++j) { const float g = LA[r * 65 + c4 + j], gl = LA[63 * 65 + c4 + j];
            qg[j] = q[j] * 0.125f * __expf(g); ki[j] = k[j] * __expf(-g); kg[j] = k[j] * __expf(gl - g); }
        const u32x2 wq = pk4(qg);
        *(u32x2*)(QG + r * 72 + c4) = wq; *(u32x2*)(KI + r * 72 + c4) = pk4(ki);
        if (!F.dry) *(u32x2*)qp = wq; if (!F.dry) *(u32x2*)kp = pk4(kg);
    }
    __syncthreads();
    {
        const int fr = lane & 15, fq = lane >> 4, it = F.wid >> 1; const int crow = 16 * it + fr;
#pragma unroll
        for (int q = 0; q < 2; ++q) {
            const int jt = (F.wid & 1) * 2 + q;
            f32x4 a = {0.f, 0.f, 0.f, 0.f};
            if (jt <= it) {
#pragma unroll
                for (int ks = 0; ks < 2; ++ks) a = MFMA16(ldfrag(KI, 16 * jt + fr, 72, 32 * ks, fq), ldfrag(QG, crow, 72, 32 * ks, fq), a);
            }
#pragma unroll
            for (int j = 0; j < 4; ++j) if (16 * jt + 4 * fq + j > crow) a[j] = 0.f;
            if (!F.dry) *(u32x2*)(((bf16_t*)(F.ws + WS_XB)) + (size_t)(t0 + crow) * LDE + 512 + h * 64 + 16 * jt + 4 * fq) = pk4(a);
        }
    }
}

DEV void g2_gdn(const Frame& F0, int l, int s, int h) {
    REFRAME;
    bf16_t* QN = (bf16_t*)F.lds;
    bf16_t* KN = (bf16_t*)(F.lds + 17408);
    bf16_t* KT = (bf16_t*)(F.lds + 34816);
    bf16_t* TM = (bf16_t*)(F.lds + 53248);
    bf16_t* AQ = (bf16_t*)(F.lds + 62464);
    float* sB = (float*)(F.lds + 71680); float* sG = sB + 64;
    float* RED = (float*)(F.lds + 72192);
    bf16_t* VV = (bf16_t*)(F.lds + 74240);
    bf16_t* ZZ = (bf16_t*)(F.lds + 91648);
    const int tid = F.tid, lane = F.lane, w = F.wid, fr = lane & 15, fq = lane >> 4;
    const bool sample = s >= 16; const int nchunk = sample ? 1 : 32; const int tbase = sample ? 32768 + (s - 16) * 64 : s * 2048;
    const int dvc = h * 128 + 16 * w + fr;
    f32x4 S[8];
#pragma unroll
    for (int mt = 0; mt < 8; ++mt) {
        if (sample) { const float* sp = F.in[2] + ((size_t)((l * 8 + (s - 16)) * 4 + h) * 128) * 128;
#pragma unroll
            for (int j = 0; j < 4; ++j) S[mt][j] = sp[(size_t)(16 * mt + 4 * fq + j) * 128 + 16 * w + fr]; }
        else S[mt] = (f32x4){0.f, 0.f, 0.f, 0.f};
    }
    const float gn = F.in[14][l * 128 + 16 * w + fr];
    for (int n = 0; n < nchunk; ++n) {
        const int t0 = tbase + n * 64;
        __syncthreads();
#pragma unroll
        for (int i = 0; i < 2; ++i) {
            const int p = tid + 512 * i, r = p >> 4, c8 = (p & 15) * 8;
            const u32x4 q = *(const u32x4*)(((bf16_t*)(F.ws + WS_P)) + (size_t)(t0 + r) * LDP + C_QA + h * 128 + c8);
            const u32x4 k = *(const u32x4*)(((bf16_t*)(F.ws + WS_P)) + (size_t)(t0 + r) * LDP + C_KA + h * 128 + c8);
            *(u32x4*)(QN + r * 136 + c8) = q; *(u32x4*)(KN + r * 136 + c8) = k;
            *(u32x4*)(VV + r * 136 + c8) = *(const u32x4*)(((bf16_t*)(F.ws + WS_P)) + (size_t)(t0 + r) * LDP + C_VA + h * 128 + c8);
            *(u32x4*)(ZZ + r * 136 + c8) = *(const u32x4*)(((bf16_t*)(F.ws + WS_P)) + (size_t)(t0 + r) * LDP + C_ZA + h * 128 + c8);
            KT[(c8 + 0) * 72 + r] = (bf16_t)(k.x & 0xffff); KT[(c8 + 1) * 72 + r] = (bf16_t)(k.x >> 16);
            KT[(c8 + 2) * 72 + r] = (bf16_t)(k.y & 0xffff); KT[(c8 + 3) * 72 + r] = (bf16_t)(k.y >> 16);
            KT[(c8 + 4) * 72 + r] = (bf16_t)(k.z & 0xffff); KT[(c8 + 5) * 72 + r] = (bf16_t)(k.z >> 16);
            KT[(c8 + 6) * 72 + r] = (bf16_t)(k.w & 0xffff); KT[(c8 + 7) * 72 + r] = (bf16_t)(k.w >> 16);
        }
        {
            const int r = tid >> 3, c8 = (tid & 7) * 8;
            *(u32x4*)(TM + r * 72 + c8) = *(const u32x4*)(((bf16_t*)(F.ws + WS_XB)) + (size_t)(t0 + r) * LDE + h * 128 + c8);
            *(u32x4*)(AQ + r * 72 + c8) = *(const u32x4*)(((bf16_t*)(F.ws + WS_XB)) + (size_t)(t0 + r) * LDE + h * 128 + 64 + c8);
        }
        if (tid < 128) sB[tid] = ((float*)(F.ws + WS_BG))[((size_t)(t0 >> 6) * 4 + h) * 128 + tid];
        __syncthreads();
        f32x4 kS[4], qS[4], vn[4], o[4];
#pragma unroll
        for (int mt = 0; mt < 4; ++mt) { kS[mt] = (f32x4){0.f, 0.f, 0.f, 0.f}; qS[mt] = kS[mt]; vn[mt] = kS[mt]; }
#pragma unroll
        for (int ks = 0; ks < 4; ++ks) {
            const bf16x8 sf = mk8(pk4(S[2 * ks]), pk4(S[2 * ks + 1]));
#pragma unroll
            for (int mt = 0; mt < 4; ++mt) {
                kS[mt] = MFMA16(ldfragp(KN, 16 * mt + fr, 136, 32 * ks, fq), sf, kS[mt]);
                qS[mt] = MFMA16(ldfragp(QN, 16 * mt + fr, 136, 32 * ks, fq), sf, qS[mt]);
            }
        }
        const float glast = sG[63];
        f32x4 eg[4], tmp[4];
#pragma unroll
        for (int mt = 0; mt < 4; ++mt)
#pragma unroll
            for (int j = 0; j < 4; ++j) {
                const int row = 16 * mt + 4 * fq + j;
                const float e = __expf(sG[row]); eg[mt][j] = e;
                const float vv = bf2f(VV[row * 136 + 16 * w + fr]);
                tmp[mt][j] = vv - sB[row] * e * kS[mt][j];
            }
#pragma unroll
        for (int ks = 0; ks < 2; ++ks) {
            const bf16x8 tf = mk8(pk4(tmp[2 * ks]), pk4(tmp[2 * ks + 1]));
#pragma unroll
            for (int mt = 0; mt < 4; ++mt) vn[mt] = MFMA16(ldfragp(TM, 16 * mt + fr, 72, 32 * ks, fq), tf, vn[mt]);
        }
#pragma unroll
        for (int mt = 0; mt < 4; ++mt) o[mt] = eg[mt] * qS[mt];
#pragma unroll
        for (int ks = 0; ks < 2; ++ks) {
            const bf16x8 vf = mk8(pk4(vn[2 * ks]), pk4(vn[2 * ks + 1]));
#pragma unroll
            for (int mt = 0; mt < 4; ++mt) o[mt] = MFMA16(ldfragp(AQ, 16 * mt + fr, 72, 32 * ks, fq), vf, o[mt]);
        }
        const float dl = __expf(glast);
#pragma unroll
        for (int mt = 0; mt < 4; ++mt)
#pragma unroll
            for (int j = 0; j < 4; ++j) vn[mt][j] *= __expf(glast - sG[16 * mt + 4 * fq + j]);
#pragma unroll
        for (int mt = 0; mt < 8; ++mt) S[mt] = S[mt] * dl;
#pragma unroll
        for (int ks = 0; ks < 2; ++ks) {
            const bf16x8 vf = mk8(pk4(vn[2 * ks]), pk4(vn[2 * ks + 1]));
#pragma unroll
            for (int mt = 0; mt < 8; ++mt) S[mt] = MFMA16(ldfragp(KT, 16 * mt + fr, 72, 32 * ks, fq), vf, S[mt]);
        }
#pragma unroll
        for (int mt = 0; mt < 4; ++mt)
#pragma unroll
            for (int j = 0; j < 4; ++j) {
                float p = o[mt][j] * o[mt][j];
                p += __shfl_xor(p, 1); p += __shfl_xor(p, 2); p += __shfl_xor(p, 4); p += __shfl_xor(p, 8);
                if (fr == 0) RED[(16 * mt + 4 * fq + j) * 8 + w] = p;
            }
        __syncthreads();
#pragma unroll
        for (int mt = 0; mt < 4; ++mt)
#pragma unroll
            for (int j = 0; j < 4; ++j) {
                const int row = 16 * mt + 4 * fq + j;
                const f32x4 r0 = *(const f32x4*)(RED + row * 8), r1 = *(const f32x4*)(RED + row * 8 + 4);
                const float ssum = ((r0[0] + r0[1]) + (r0[2] + r0[3])) + ((r1[0] + r1[1]) + (r1[2] + r1[3]));
                const float rs = rsqrtf(ssum * (1.f / 128.f) + 1e-6f);
                bf16_t* zp = ((bf16_t*)(F.ws + WS_P)) + (size_t)(t0 + row) * LDP + C_ZA + dvc;
                const float z = bf2f(ZZ[row * 136 + 16 * w + fr]);
                if (!F.dry) *zp = (bf16_t)(pk2(o[mt][j] * rs * gn * silu(z), 0.f) & 0xffff);
            }
    }
    float* so = sample ? F.out + O_GDN_S + ((size_t)((l * 8 + (s - 16)) * 4 + h) * 128) * 128 : F.out + O_GDN_P + ((size_t)((l * 16 + s) * 4 + h) * 128) * 128;
#pragma unroll
    for (int mt = 0; mt < 8; ++mt)
#pragma unroll
        for (int j = 0; j < 4; ++j) if (!F.dry) so[(size_t)(16 * mt + 4 * fq + j) * 128 + 16 * w + fr] = S[mt][j];
}

DEV void g2_gla(const Frame& F0, int l, int s, int h) {
    REFRAME;
    bf16_t* QG = (bf16_t*)F.lds;
    bf16_t* KGT = (bf16_t*)(F.lds + 9216);
    bf16_t* AQ = (bf16_t*)(F.lds + 18432);
    float* sDL = (float*)(F.lds + 27648);
    float* RED = (float*)(F.lds + 27904);
    bf16_t* ZZ = (bf16_t*)(F.lds + 29952);
    const int tid = F.tid, lane = F.lane, w = F.wid, fr = lane & 15, fq = lane >> 4;
    const bool sample = s >= 16; const int nchunk = sample ? 1 : 32; const int tbase = sample ? 32768 + (s - 16) * 64 : s * 2048;
    const int dvc = h * 128 + 16 * w + fr;
    f32x4 S[4];
#pragma unroll
    for (int mt = 0; mt < 4; ++mt) {
        if (sample) { const float* sp = F.in[4] + ((size_t)((l * 8 + (s - 16)) * 4 + h) * 64) * 128;
#pragma unroll
            for (int j = 0; j < 4; ++j) S[mt][j] = sp[(size_t)(16 * mt + 4 * fq + j) * 128 + 16 * w + fr]; }
        else S[mt] = (f32x4){0.f, 0.f, 0.f, 0.f};
    }
    const float gn = F.in[17][l * 128 + 16 * w + fr];
    for (int n = 0; n < nchunk; ++n) {
        const int t0 = tbase + n * 64, chunk = t0 >> 6;
        __syncthreads();
        {
            const int r = tid >> 3, c8 = (tid & 7) * 8;
            *(u32x4*)(QG + r * 72 + c8) = *(const u32x4*)(((bf16_t*)(F.ws + WS_P)) + (size_t)(t0 + r) * LDP + C_QB + h * 64 + c8);
            const u32x4 k = *(const u32x4*)(((bf16_t*)(F.ws + WS_P)) + (size_t)(t0 + r) * LDP + C_KB + h * 64 + c8);
            KGT[(c8 + 0) * 72 + r] = (bf16_t)(k.x & 0xffff); KGT[(c8 + 1) * 72 + r] = (bf16_t)(k.x >> 16);
            KGT[(c8 + 2) * 72 + r] = (bf16_t)(k.y & 0xffff); KGT[(c8 + 3) * 72 + r] = (bf16_t)(k.y >> 16);
            KGT[(c8 + 4) * 72 + r] = (bf16_t)(k.z & 0xffff); KGT[(c8 + 5) * 72 + r] = (bf16_t)(k.z >> 16);
            KGT[(c8 + 6) * 72 + r] = (bf16_t)(k.w & 0xffff); KGT[(c8 + 7) * 72 + r] = (bf16_t)(k.w >> 16);
            *(u32x4*)(AQ + r * 72 + c8) = *(const u32x4*)(((bf16_t*)(F.ws + WS_XB)) + (size_t)(t0 + r) * LDE + 512 + h * 64 + c8);
        }
#pragma unroll
        for (int i = 0; i < 2; ++i) { const int p = tid + 512 * i, r = p >> 4, c8 = (p & 15) * 8;
            *(u32x4*)(ZZ + r * 136 + c8) = *(const u32x4*)(((bf16_t*)(F.ws + WS_P)) + (size_t)(t0 + r) * LDP + C_ZB + h * 128 + c8); }
        if (tid < 64) sDL[tid] = ((float*)(F.ws + WS_DL))[((size_t)chunk * 4 + h) * 64 + tid];
        bf16x8 vf[2];
#pragma unroll
        for (int ks = 0; ks < 2; ++ks) {
            unsigned e[8];
#pragma unroll
            for (int j = 0; j < 8; ++j) { const int row = 32 * ks + (j < 4 ? 4 * fq + j : 16 + 4 * fq + (j - 4)); e[j] = ((bf16_t*)(F.ws + WS_P))[(size_t)(t0 + row) * LDP + C_VB + dvc]; }
            u32x4 t; t.x = e[0] | (e[1] << 16); t.y = e[2] | (e[3] << 16); t.z = e[4] | (e[5] << 16); t.w = e[6] | (e[7] << 16);
            vf[ks] = __builtin_bit_cast(bf16x8, t);
        }
        __syncthreads();
        f32x4 o[4];
#pragma unroll
        for (int mt = 0; mt < 4; ++mt) o[mt] = (f32x4){0.f, 0.f, 0.f, 0.f};
#pragma unroll
        for (int ks = 0; ks < 2; ++ks) {
            const bf16x8 sf = mk8(pk4(S[2 * ks]), pk4(S[2 * ks + 1]));
#pragma unroll
            for (int mt = 0; mt < 4; ++mt) {
                o[mt] = MFMA16(ldfragp(QG, 16 * mt + fr, 72, 32 * ks, fq), sf, o[mt]);
                o[mt] = MFMA16(ldfragp(AQ, 16 * mt + fr, 72, 32 * ks, fq), vf[ks], o[mt]);
            }
        }
#pragma unroll
        for (int mt = 0; mt < 4; ++mt) {
#pragma unroll
            for (int j = 0; j < 4; ++j) S[mt][j] *= sDL[16 * mt + 4 * fq + j];
#pragma unroll
            for (int ks = 0; ks < 2; ++ks) S[mt] = MFMA16(ldfragp(KGT, 16 * mt + fr, 72, 32 * ks, fq), vf[ks], S[mt]);
        }
#pragma unroll
        for (int mt = 0; mt < 4; ++mt)
#pragma unroll
            for (int j = 0; j < 4; ++j) {
                float p = o[mt][j] * o[mt][j];
                p += __shfl_xor(p, 1); p += __shfl_xor(p, 2); p += __shfl_xor(p, 4); p += __shfl_xor(p, 8);
                if (fr == 0) RED[(16 * mt + 4 * fq + j) * 8 + w] = p;
            }
        __syncthreads();
#pragma unroll
        for (int mt = 0; mt < 4; ++mt)
#pragma unroll
            for (int j = 0; j < 4; ++j) {
                const int row = 16 * mt + 4 * fq + j;
                const f32x4 r0 = *(const f32x4*)(RED + row * 8), r1 = *(const f32x4*)(RED + row * 8 + 4);
                const float ssum = ((r0[0] + r0[1]) + (r0[2] + r0[3])) + ((r1[0] + r1[1]) + (r1[2] + r1[3]));
                const float rs = rsqrtf(ssum * (1.f / 128.f) + 1e-6f);
                bf16_t* zp = ((bf16_t*)(F.ws + WS_P)) + (size_t)(t0 + row) * LDP + C_ZB + dvc;
                const float z = bf2f(ZZ[row * 136 + 16 * w + fr]);
                if (!F.dry) *zp = (bf16_t)(pk2(o[mt][j] * rs * gn * silu(z), 0.f) & 0xffff);
            }
    }
    float* so = sample ? F.out + O_GLA_S + ((size_t)((l * 8 + (s - 16)) * 4 + h) * 64) * 128 : F.out + O_GLA_P + ((size_t)((l * 16 + s) * 4 + h) * 64) * 128;
#pragma unroll
    for (int mt = 0; mt < 4; ++mt)
#pragma unroll
        for (int j = 0; j < 4; ++j) if (!F.dry) so[(size_t)(16 * mt + 4 * fq + j) * 128 + 16 * w + fr] = S[mt][j];
}

DEV void unpack8(u32x4 u, float (&f)[8]) { f[0] = bflo(u.x); f[1] = bfhi(u.x); f[2] = bflo(u.y); f[3] = bfhi(u.y); f[4] = bflo(u.z); f[5] = bfhi(u.z); f[6] = bflo(u.w); f[7] = bfhi(u.w); }
DEV void load8f(const float* p, float (&f)[8]) { const f32x4 a = *(const f32x4*)p, b = *(const f32x4*)(p + 4); f[0] = a[0]; f[1] = a[1]; f[2] = a[2]; f[3] = a[3]; f[4] = b[0]; f[5] = b[1]; f[6] = b[2]; f[7] = b[3]; }
DEV void ffn_mid(const Frame& F0, int l) {
    REFRAME;
    const float* cw = F.in[29] + (size_t)l * 3 * 5632; const float* cb = F.in[30] + (size_t)l * 5632;
    const bf16_t* halo = ((bf16_t*)(F.ws + WS_KV)); const bf16_t* raw01 = ((bf16_t*)(F.ws + WS_KV + 11714560ull));
    for (int idx = F.bid * 512 + F.tid; idx < 112 * 704; idx += F.nb * 512) {
        const int ti = idx / 704, c4 = (idx % 704) * 4, pm = (ti / 7) * 8 + (ti % 7) + 1;
        const bf16_t* hp = halo + (size_t)(4 * pm - 1) * 2 * 5632; const bf16_t* rp = raw01 + (size_t)pm * 2 * 5632;
        const f32x4 gm2 = unpk4(*(const u32x2*)(hp + c4)), gm1 = unpk4(*(const u32x2*)(hp + 5632 + c4)), g0 = unpk4(*(const u32x2*)(rp + c4)), g1 = unpk4(*(const u32x2*)(rp + 5632 + c4));
        const f32x4 vm2 = unpk4(*(const u32x2*)(hp + 2816 + c4)), vm1 = unpk4(*(const u32x2*)(hp + 5632 + 2816 + c4)), v0 = unpk4(*(const u32x2*)(rp + 2816 + c4)), v1 = unpk4(*(const u32x2*)(rp + 5632 + 2816 + c4));
        const f32x4 wg0 = *(const f32x4*)(cw + c4), wg1 = *(const f32x4*)(cw + 5632 + c4), wg2 = *(const f32x4*)(cw + 2 * 5632 + c4), bg = *(const f32x4*)(cb + c4);
        const f32x4 wv0 = *(const f32x4*)(cw + 2816 + c4), wv1 = *(const f32x4*)(cw + 5632 + 2816 + c4), wv2 = *(const f32x4*)(cw + 2 * 5632 + 2816 + c4), bv = *(const f32x4*)(cb + 2816 + c4);
        f32x4 o0, o1;
#pragma unroll
        for (int j = 0; j < 4; ++j) {
            const float yg0 = wg0[j] * gm2[j] + wg1[j] * gm1[j] + wg2[j] * g0[j] + bg[j], yv0 = wv0[j] * vm2[j] + wv1[j] * vm1[j] + wv2[j] * v0[j] + bv[j];
            const float yg1 = wg0[j] * gm1[j] + wg1[j] * g0[j] + wg2[j] * g1[j] + bg[j], yv1 = wv0[j] * vm1[j] + wv1[j] * v0[j] + wv2[j] * v1[j] + bv[j];
            o0[j] = silu(yg0) * yv0; o1[j] = silu(yg1) * yv1;
        }
        bf16_t* vp = ((bf16_t*)(F.ws + WS_P)) + (size_t)pm * 256 * LDP + c4;
        *(u32x2*)vp = pk4(o0); *(u32x2*)(vp + LDP) = pk4(o1);
    }
}

DEV void final_norm(const Frame& F0) {
    REFRAME;
    const int gw = F.bid * 8 + F.wid, nw = F.nb * 8, lane = F.lane;
    const float* g = F.in[32];
    for (int row = gw; row < TT; row += nw) {
        const float rs = row_rstd(((float*)(F.ws + WS_SSQ)), row);
        float* X = F.out + (size_t)row * 1024;
#pragma unroll
        for (int i = 0; i < 4; ++i) { const int cidx = i * 256 + lane * 4; f32x4 v = *(const f32x4*)(X + cidx); const f32x4 gg = *(const f32x4*)(g + cidx); *(f32x4*)(X + cidx) = v * rs * gg; }
    }
}

#ifdef DBG_COL
DEV void dbg_dump(const Frame& F0) {
    REFRAME;
    for (int i = F.bid * 512 + F.tid; i < TT * 256; i += F.nb * 512) {
        const int row = i >> 8, c = (i & 255) * 4;
        const f32x4 v = c < 512 ? unpk4(*(const u32x2*)(((bf16_t*)(F.ws + WS_P)) + (size_t)row * LDP + DBG_COL + c)) : (f32x4){0.f, 0.f, 0.f, 0.f};
        *(f32x4*)(F.out + (size_t)row * 1024 + c) = (row DBG_ROWSEL) ? v : (f32x4){0.f, 0.f, 0.f, 0.f};
    }
}
#endif
#define XB_TMO      128
#define XB_XCNT(j)  (256  + 64 * (j))
#define XB_XSUB(j)  (1280 + 64 * (j))
#define XB_XGEN(j)  (2304 + 64 * (j))
#define XB_TOP      3328
#define XB_TOPGEN   3392
#define XCD_BAR_WORDS 3456
#define XB_SPIN_CAP (1u << 18)
#define LAS __attribute__((address_space(3)))

__device__ __forceinline__ unsigned xb_ld(unsigned* p)              { return __hip_atomic_load(p, __ATOMIC_RELAXED, __HIP_MEMORY_SCOPE_AGENT); }
__device__ __forceinline__ unsigned xb_add(unsigned* p, unsigned v) { return __hip_atomic_fetch_add(p, v, __ATOMIC_RELAXED, __HIP_MEMORY_SCOPE_AGENT); }
__device__ __forceinline__ unsigned xb_xcc_id() { return (unsigned)__builtin_amdgcn_s_getreg((3 << 11) | 20) & 0xFu; }
#define XB_SPIN(cond, bar) do { unsigned _sp = 0; while (cond) { __builtin_amdgcn_s_sleep(1); \
    if ((++_sp & 255u) == 0u) { if (xb_ld(&(bar)[XB_TMO])) break; if (_sp > XB_SPIN_CAP) { atomicAdd(&(bar)[XB_TMO], 1u); break; } } } } while (0)

struct XcdBarrier {
    unsigned* bar; unsigned x;
    volatile LAS unsigned* st;
};

__device__ __forceinline__ XcdBarrier xcd_barrier_post(unsigned* bar, volatile LAS unsigned* st) {
    XcdBarrier b; b.bar = bar; b.x = xb_xcc_id(); b.st = st;
    if (threadIdx.x == 0) (void)xb_add(&bar[XB_XCNT(b.x)], 1u);
    return b;
}
__device__ __forceinline__ void xcd_barrier_complete(unsigned* bar, unsigned x, unsigned& nloc, unsigned& nx) {
    const unsigned G = gridDim.x * gridDim.y * gridDim.z;
    unsigned sum, cnt, mine, sp = 0u;
    for (;;) {
        sum = 0u; cnt = 0u; mine = 0u;
#pragma unroll
        for (unsigned j = 0; j < 16; ++j) { const unsigned c = xb_ld(&bar[XB_XCNT(j)]); sum += c; cnt += (c > 0u) ? 1u : 0u; mine = (j == x) ? c : mine; }
        if (sum == G) break;
        __builtin_amdgcn_s_sleep(1);
        if ((++sp & 255u) == 0u) { if (xb_ld(&bar[XB_TMO])) break; if (sp > XB_SPIN_CAP) { atomicAdd(&bar[XB_TMO], 1u); break; } }
    }
    nloc = mine > 0u ? mine : 1u; nx = cnt > 0u ? cnt : 1u;
}

__device__ __forceinline__ void xcd_barrier(const XcdBarrier& b) {
    asm volatile("s_waitcnt vmcnt(0)" ::: "memory");
    __syncthreads();
    if (threadIdx.x == 0) {
        unsigned* bar = b.bar;
        __builtin_amdgcn_s_waitcnt(0);
        unsigned nloc = b.st[0], nx = b.st[1];
        if (nloc == 0u) { xcd_barrier_complete(bar, b.x, nloc, nx); b.st[0] = nloc; b.st[1] = nx; }
        const unsigned old = xb_add(&bar[XB_XSUB(b.x)], 1u);
        const unsigned gen = old / nloc;
        if (old + 1u == (gen + 1u) * nloc) {
            __builtin_amdgcn_fence(__ATOMIC_RELEASE, "agent");
            asm volatile("s_waitcnt vmcnt(0)" ::: "memory");
            const unsigned og = xb_add(&bar[XB_TOP], 1u);
            const unsigned tg = og / nx;
            if (og + 1u == (tg + 1u) * nx) xb_add(&bar[XB_TOPGEN], 1u);
            else XB_SPIN(xb_ld(&bar[XB_TOPGEN]) == tg, bar);
            __builtin_amdgcn_fence(__ATOMIC_ACQUIRE, "agent");
            xb_add(&bar[XB_XGEN(b.x)], 1u);
            asm volatile("s_waitcnt vmcnt(0)" ::: "memory");
        } else {
            XB_SPIN(xb_ld(&bar[XB_XGEN(b.x)]) == gen, bar);
            __builtin_amdgcn_fence(__ATOMIC_ACQUIRE, "agent");
            asm volatile("s_waitcnt vmcnt(0)" ::: "memory");
        }
    }
    __syncthreads();
}

__global__ void __launch_bounds__(512, 2) fwd_kernel(Params p) {
    extern __shared__ __attribute__((aligned(16))) unsigned char lds[];
    cg::grid_group grid = cg::this_grid();
    Frame F;
    F.in = (InTab)__builtin_amdgcn_kernarg_segment_ptr(); F.out = p.out; F.ws = p.ws; F.lds = lds;
    F.tid = threadIdx.x; F.lane = threadIdx.x & 63; F.wid = __builtin_amdgcn_readfirstlane(threadIdx.x >> 6); F.nb = gridDim.x; F.bid = blockIdx.x; F.dry = 0;
    volatile LAS unsigned* xst = (volatile LAS unsigned*)(lds + LDS_BYTES - 16);
    if (threadIdx.x == 0) { xst[0] = 0u; xst[1] = 0u; }
    __syncthreads();
    const XcdBarrier xbar = xcd_barrier_post((unsigned*)(p.ws + WS_BAR), xst);
    for (int ph = p.ph_lo; ph < p.ph_hi; ++ph) {
#ifndef PHM
#define PHM 0xffff
#endif
        if (ph == 0) { if (PHM & 0x1000) phase0(F); }
        else if (ph == NPH - 1) { if (PHM & 0x2000) final_norm(F); }
        else {
            const int l = (ph - 1) / 13, k = (ph - 1) % 13;
            int gk = -1;
            if (k == 2 && gridDim.x == 256) gk = GP_MEMKV;
            switch (k) { case 0: gk = GP_IN; break; case 3: gk = GP_OUT; break; case 4: gk = GP_OUT2; break; case 5: gk = GP_WO; break; case 6: gk = GP_MQ; break; case 7: gk = GP_ATTN; break; case 8: gk = GP_ATTN2; break;
                         case 9: gk = GP_MO; break; case 10: gk = GP_UP; break; case 12: gk = GP_DOWN; break; default: break; }
#ifndef REPMASK
#define REPMASK 0
#endif
            if (gk >= 0 && (PHM & 1)) { const int nrep = ((REPMASK >> k) & 1) ? 2 : 1; for (int rep = 0; rep < nrep; ++rep) gemm_phase(F, gk, l); }
            if (k == 0 && (PHM & 1)) small_proj(F);
            if (k == (gridDim.x == 256 ? 2 : 3) && (PHM & 8)) sample_kv(F, l);
#ifndef DRYMASK
#define DRYMASK 0
#endif
            for (int dr = ((DRYMASK >> k) & 1); dr >= 0; --dr) {
            F.dry = dr;
            if (k == 1 && (PHM & 2)) {
                for (int it = F.bid; it < NCH * 8; it += F.nb) { const int c = it >> 3, h = it & 3; if (it & 4) g1_gla(F, l, c, h); else g1_gdn(F, l, c, h); }
                __syncthreads();
                if (l > 0 && !dr) cvt_ffn(F, l);
            }
            if (k == 2 && (PHM & 4)) {
                for (int it = F.bid; it < 192; it += F.nb) {
                    int s, h, br;
                    if (it < 128) { br = it & 1; h = (it >> 1) & 3; s = it >> 3; } else { const int v = it - 128; br = v & 1; h = (v >> 1) & 3; s = 16 + (v >> 3); }
                    if (br) g2_gla(F, l, s, h); else g2_gdn(F, l, s, h);
                    __syncthreads();
                }
            }
            if (k == 11 && (PHM & 0x200)) { ffn_mid(F, l); if (l < 3 && !dr) { __syncthreads(); cvt_mixer(F, l + 1); } }
            }
            F.dry = 0;
        }
#ifndef SYNCREP
#define SYNCREP 1
#endif
        if (ph + 1 < p.ph_hi) {
            if (ph == 0) grid.sync();
            else xcd_barrier(xbar);
        }
    }
#ifdef DBG_COL
    __threadfence(); grid.sync(); __threadfence();
    dbg_dump(F);
#endif
}

extern "C" void kernel_launch(void* const* d_in, const int* in_sizes, int n_in, void* d_out, int out_size, void* d_ws, size_t ws_size, hipStream_t stream) {
    static int grid_blocks = 0;
    if (grid_blocks == 0) {
        if (n_in != 33 || ws_size < WS_TOTAL) { fprintf(stderr, "kernel_launch: bad n_in %d or ws %zu < %zu\n", n_in, ws_size, (size_t)WS_TOTAL); grid_blocks = -1; return; }
        int dev = 0, cus = 0, per_cu = 0;
        hipGetDevice(&dev);
        hipDeviceGetAttribute(&cus, hipDeviceAttributeMultiprocessorCount, dev);
        if (hipFuncSetAttribute((const void*)fwd_kernel, hipFuncAttributeMaxDynamicSharedMemorySize, LDS_BYTES) != hipSuccess) { fprintf(stderr, "hipFuncSetAttribute failed\n"); grid_blocks = -1; return; }
        hipOccupancyMaxActiveBlocksPerMultiprocessor(&per_cu, (const void*)fwd_kernel, 512, LDS_BYTES);
        if (per_cu < 1) per_cu = 1;
        (void)hipGetLastError();
        grid_blocks = cus * 1;
        if (grid_blocks <= 0) grid_blocks = 256;
    }
    if (grid_blocks < 0) return;
    Params p{};
    for (int i = 0; i < 33; ++i) p.in[i] = (const float*)d_in[i];
    p.out = (float*)d_out; p.ws = (unsigned char*)d_ws; p.ph_lo = 0; p.ph_hi = PH_HI;
    (void)hipMemsetAsync((unsigned char*)d_ws + WS_BAR, 0, 16384, stream);
    void* args[] = {&p};
    hipError_t e = hipLaunchCooperativeKernel((const void*)fwd_kernel, dim3(grid_blocks), dim3(512), args, LDS_BYTES, stream);
    if (e != hipSuccess) fprintf(stderr, "cooperative launch failed: %s (grid %d)\n", hipGetErrorString(e), grid_blocks);
}
```

```cpp
#include <hip/hip_runtime.h>
#include <hip/hip_cooperative_groups.h>
#include <cstdint>
#include <cstdio>
namespace cg = cooperative_groups;

typedef unsigned short bf16_t;
typedef short bf16x8 __attribute__((ext_vector_type(8)));
typedef float f32x4 __attribute__((ext_vector_type(4)));
typedef float f32x2 __attribute__((ext_vector_type(2)));
typedef unsigned u32x2 __attribute__((ext_vector_type(2)));
typedef unsigned u32x4 __attribute__((ext_vector_type(4)));
#define DEV __device__ __forceinline__

constexpr int DM = 1024, TT = 33280, NCH = 520, LDP = 5632, LDE = 768;
constexpr int C_QA = 0, C_KA = 512, C_VA = 1024, C_ZA = 1536, C_QB = 2048, C_KB = 2304, C_VB = 2560, C_ZB = 3072, C_GA = 3584, C_GB = 4608;
constexpr int C_MRG = 0, C_PR = 1024, C_Q = 2048, C_O = 3072;
constexpr size_t O_Y = 0;
constexpr size_t O_GDN_P = 34078720ull;
constexpr size_t O_GDNC_P = O_GDN_P + 4194304ull;
constexpr size_t O_GLA_P = O_GDNC_P + 294912ull;
constexpr size_t O_FFNC_P = O_GLA_P + 2097152ull;
constexpr size_t O_MEMK = O_FFNC_P + 720896ull;
constexpr size_t O_MEMV = O_MEMK + 16777216ull;
constexpr size_t O_GDN_S = O_MEMV + 16777216ull;
constexpr size_t O_GDNC_S = O_GDN_S + 2097152ull;
constexpr size_t O_GLA_S = O_GDNC_S + 147456ull;
constexpr size_t O_FFNC_S = O_GLA_S + 1048576ull;
constexpr size_t al256(size_t x) { return (x + 255) & ~(size_t)255; }
constexpr size_t WS_WMIX = 0;
constexpr size_t WM_WIN = 0, WM_WSM = WM_WIN + 5632ull * 1024, WM_WOA = WM_WSM + 32 * 1024, WM_WOB = WM_WOA + 524288, WM_WO = WM_WOB + 524288,
                 WM_WMQ = WM_WO + 1048576, WM_WMK = WM_WMQ + 1048576, WM_WMV = WM_WMK + 1048576, WM_WMO = WM_WMV + 1048576, WM_END = WM_WMO + 1048576;
constexpr size_t WS_WFFN = al256(WS_WMIX + WM_END * 2);
constexpr size_t WF_UP = 0, WF_DN = 5632ull * 1024, WF_END = WF_DN + 1024ull * 2816;
constexpr size_t WS_XB = al256(WS_WFFN + WF_END * 2);
constexpr size_t WS_P = al256(WS_XB + (size_t)TT * 1024 * 2);
constexpr size_t WS_KV = al256(WS_P + (size_t)TT * LDP * 2);
constexpr size_t KV_BYTES = 2ull * 6144 * 1024 * 2;
constexpr size_t WS_MB = al256(WS_KV + KV_BYTES);
constexpr size_t WS_MRS = al256(WS_MB + 4096ull * 1024 * 2);
constexpr size_t WS_SSQ = al256(WS_MRS + 4096 * 4);
constexpr size_t WS_SC = al256(WS_SSQ + (size_t)TT * 16 * 4);
constexpr size_t WS_DL = al256(WS_SC + (size_t)TT * 32 * 4);
constexpr size_t WS_BG = al256(WS_DL + 520ull * 4 * 64 * 4);
constexpr size_t WS_BAR = al256(WS_BG + 520ull * 4 * 128 * 4);
constexpr size_t WS_TOTAL = al256(WS_BAR + 16384);
constexpr int LDS_BYTES = 147456;
constexpr int NPH = 54;
#ifndef PH_HI
#define PH_HI NPH
#define REPMASK 0
#define SYNCREP 1
#define DRYMASK 0
#endif

struct Params { const float* in[33]; float* out; unsigned char* ws; int ph_lo, ph_hi; };

typedef __bf16 bf16x2_t __attribute__((ext_vector_type(2)));
DEV unsigned pk2(float lo, float hi) { f32x2 f = {lo, hi}; bf16x2_t v = __builtin_convertvector(f, bf16x2_t); return __builtin_bit_cast(unsigned, v); }
DEV float bf2f(bf16_t b) { return __uint_as_float(((unsigned)b) << 16); }
DEV float bflo(unsigned u) { return __uint_as_float(u << 16); }
DEV float bfhi(unsigned u) { return __uint_as_float(u & 0xffff0000u); }
DEV u32x2 pk4(f32x4 v) { u32x2 r; r.x = pk2(v[0], v[1]); r.y = pk2(v[2], v[3]); return r; }
DEV f32x4 unpk4(u32x2 u) { return (f32x4){bflo(u.x), bfhi(u.x), bflo(u.y), bfhi(u.y)}; }
DEV bf16x8 mk8(u32x2 a, u32x2 b) { u32x4 t = {a.x, a.y, b.x, b.y}; return __builtin_bit_cast(bf16x8, t); }
DEV float sigm(float x) { return 1.f / (1.f + __expf(-x)); }
DEV float silu(float x) { return x / (1.f + __expf(-x)); }
DEV float softplus(float x) { return x > 20.f ? x : __logf(1.f + __expf(x)); }
DEV float logsigmoid(float x) { return fminf(x, 0.f) - __logf(1.f + __expf(-fabsf(x))); }
DEV float row_rstd(const float* ssq, int row) {
    const f32x4 a = *(const f32x4*)(ssq + (size_t)row * 4), b = *(const f32x4*)(ssq + ((size_t)TT + row) * 4);
    const f32x4 c = *(const f32x4*)(ssq + ((size_t)2 * TT + row) * 4), d = *(const f32x4*)(ssq + ((size_t)3 * TT + row) * 4);
    float s = ((a[0] + a[1]) + (a[2] + a[3])) + ((b[0] + b[1]) + (b[2] + b[3])) + ((c[0] + c[1]) + (c[2] + c[3])) + ((d[0] + d[1]) + (d[2] + d[3]));
    return rsqrtf(s * (1.f / 1024.f) + 1e-6f);
}
DEV bf16x8 ldfragp(const bf16_t* base, int row, int stride, int k0, int fq) {
    const bf16_t* p = base + row * stride + k0 + 4 * fq;
    return mk8(*(const u32x2*)p, *(const u32x2*)(p + 16));
}
DEV bf16x8 ldfrag(const bf16_t* base, int row, int stride, int k0, int fq) {
    return *(const bf16x8*)(base + row * stride + k0 + 8 * fq);
}
#define MFMA16(a, b, c) __builtin_amdgcn_mfma_f32_16x16x32_bf16((a), (b), (c), 0, 0, 0)

constexpr int BM = 256, BK = 64, HALF = 128, HT = HALF * BK;
DEV int lds_byte(int r, int c) { int st = (r >> 4) * 2 + (c >> 5), rr = r & 15, cc = c & 31, ob = rr * 64 + cc * 2; return st * 1024 + (ob ^ (((ob >> 9) & 1) << 5)); }
DEV void stage_rc(int b, int& R, int& C) { int st = b / 1024, sb = b % 1024, swz = sb ^ (((sb >> 9) & 1) << 5); R = (st >> 1) * 16 + swz / 64; C = (st & 1) * 32 + (swz % 64) / 2; }

DEV void gemm_core(const bf16_t* __restrict__ A, int lda, const bf16_t* __restrict__ Bt, int ldb, int K, int brow, int bcol, f32x4 (&acc)[2][2][4][2], bf16_t* shm) {
#define SA(b, h) (shm + ((b) * 2 + (h)) * HT)
#define SB(b, h) (shm + (4 + (b) * 2 + (h)) * HT)
#define STAGE(P, BASE, LD, br, kt) do { const char* _gb = (const char*)((BASE) + (long)(br) * (LD) + (long)(kt) * BK); \
    const unsigned _vo = (unsigned)((sr0 * (int)(LD) + sc0) * 2); \
    for (int _i = 0; _i < 2; ++_i) { \
      __builtin_amdgcn_global_load_lds((const unsigned*)(_gb + (long)(_i * 128) * (LD) + _vo), (unsigned*)((char*)(P) + wbase + _i * 8192), 16, 0, 0); } } while (0)
#define LDA(dst, b, h) for (int m = 0; m < 4; ++m) for (int k = 0; k < 2; ++k) \
    dst[m][k] = *reinterpret_cast<const bf16x8*>((char*)SA(b, h) + lds_byte(wr * 64 + m * 16 + fr, k * 32 + fq * 8))
#define LDB(dst, b, h) for (int n = 0; n < 2; ++n) for (int k = 0; k < 2; ++k) \
    dst[n][k] = *reinterpret_cast<const bf16x8*>((char*)SB(b, h) + lds_byte(wc * 32 + n * 16 + fr, k * 32 + fq * 8))
#define MMA(ai, bj, At_, Bt_) do { __builtin_amdgcn_s_setprio(1); \
    for (int m = 0; m < 4; ++m) for (int n = 0; n < 2; ++n) for (int k = 0; k < 2; ++k) \
      acc[ai][bj][m][n] = __builtin_amdgcn_mfma_f32_16x16x32_bf16(Bt_[n][k], At_[m][k], acc[ai][bj][m][n], 0, 0, 0); \
    __builtin_amdgcn_s_setprio(0); } while (0)
#define WAIT_V(n) asm volatile("s_waitcnt vmcnt(" #n ")" ::: "memory")
#define WAIT_L(n) asm volatile("s_waitcnt lgkmcnt(" #n ")" ::: "memory")
#define BAR __builtin_amdgcn_s_barrier()
#define SCHED __builtin_amdgcn_sched_barrier(0)
    int tidx = threadIdx.x; asm volatile("" : "+v"(tidx));
    const int wid = __builtin_amdgcn_readfirstlane(tidx >> 6), lane = tidx & 63, wr = wid >> 2, wc = wid & 3, fr = lane & 15, fq = lane >> 4;
    const int wbase = wid * 1024;
    int sr0, sc0; stage_rc(tidx * 16, sr0, sc0);
#pragma unroll
    for (int a = 0; a < 2; ++a)
#pragma unroll
        for (int b = 0; b < 2; ++b)
#pragma unroll
            for (int m = 0; m < 4; ++m)
#pragma unroll
                for (int n = 0; n < 2; ++n) acc[a][b][m][n] = (f32x4){0.f, 0.f, 0.f, 0.f};
    bf16x8 At[4][2], B0[2][2], B1[2][2];
    const int nt = K / BK;
    STAGE(SB(0, 0), Bt, ldb, bcol, 0); STAGE(SA(0, 0), A, lda, brow, 0);
    STAGE(SB(0, 1), Bt, ldb, bcol + HALF, 0); STAGE(SA(0, 1), A, lda, brow + HALF, 0);
    if (wr == 1) BAR;
    WAIT_V(4); BAR;
    STAGE(SB(1, 0), Bt, ldb, bcol, 1); STAGE(SA(1, 0), A, lda, brow, 1); STAGE(SB(1, 1), Bt, ldb, bcol + HALF, 1);
    WAIT_V(6); BAR;
    for (int t = 0; t < nt - 2; t += 2) {
        LDB(B0, 0, 0); SCHED; LDA(At, 0, 0); STAGE(SA(1, 1), A, lda, brow + HALF, t + 1);
        WAIT_L(8); BAR; WAIT_L(0); MMA(0, 0, At, B0); BAR; SCHED;
        LDB(B1, 0, 1); STAGE(SB(0, 0), Bt, ldb, bcol, t + 2);
        BAR; WAIT_L(0); MMA(0, 1, At, B1); BAR;
        LDA(At, 0, 1); STAGE(SA(0, 0), A, lda, brow, t + 2);
        BAR; WAIT_L(0); MMA(1, 0, At, B0); BAR; SCHED;
        STAGE(SB(0, 1), Bt, ldb, bcol + HALF, t + 2);
        WAIT_V(6); BAR; MMA(1, 1, At, B1); BAR;
        LDB(B0, 1, 0); SCHED; LDA(At, 1, 0); STAGE(SA(0, 1), A, lda, brow + HALF, t + 2);
        WAIT_L(8); BAR; WAIT_L(0); MMA(0, 0, At, B0); BAR; SCHED;
        LDB(B1, 1, 1); STAGE(SB(1, 0), Bt, ldb, bcol, t + 3);
        BAR; WAIT_L(0); MMA(0, 1, At, B1); BAR;
        LDA(At, 1, 1); STAGE(SA(1, 0), A, lda, brow, t + 3);
        BAR; WAIT_L(0); MMA(1, 0, At, B0); BAR; SCHED;
        STAGE(SB(1, 1), Bt, ldb, bcol + HALF, t + 3);
        WAIT_V(6); BAR; MMA(1, 1, At, B1); BAR;
    }
    { LDB(B0, 0, 0); LDA(At, 0, 0); STAGE(SA(1, 1), A, lda, brow + HALF, nt - 1);
      BAR; WAIT_L(0); MMA(0, 0, At, B0); BAR;
      LDB(B1, 0, 1); BAR; WAIT_L(0); MMA(0, 1, At, B1); BAR;
      LDA(At, 0, 1); WAIT_V(4); BAR; WAIT_L(0); MMA(1, 0, At, B0); MMA(1, 1, At, B1); BAR; }
    { LDB(B0, 1, 0); LDA(At, 1, 0); WAIT_V(2); BAR; WAIT_L(0); MMA(0, 0, At, B0); BAR;
      LDB(B1, 1, 1); WAIT_V(0); BAR; WAIT_L(0); MMA(0, 1, At, B1); BAR;
      LDA(At, 1, 1); BAR; WAIT_L(0); MMA(1, 0, At, B0); MMA(1, 1, At, B1); BAR; }
    if (wr == 0) BAR;
    SCHED;
#undef SA
#undef SB
}

typedef const float* const __attribute__((address_space(4)))* InTab;
struct Frame {
    InTab in; float* out; unsigned char* ws; unsigned char* lds;
    int tid, lane, wid, nb, bid, dry;
};
#define REFRAME Frame F = F0; { int t_ = threadIdx.x; asm volatile("" : "+v"(t_)); F.tid = t_; F.lane = t_ & 63; unsigned char* w_ = F.ws; asm volatile("" : "+s"(w_)); F.ws = w_; float* o_ = F.out; asm volatile("" : "+s"(o_)); F.out = o_; InTab i_ = (InTab)__builtin_amdgcn_kernarg_segment_ptr(); asm volatile("" : "+s"(i_)); F.in = i_; int a_ = F.wid, b_ = F.bid, c_ = F.nb; asm volatile("" : "+s"(a_), "+s"(b_), "+s"(c_)); F.wid = a_; F.bid = b_; F.nb = c_; }

enum { EPI_PROJ = 0, EPI_UP, EPI_RESID, EPI_Q, EPI_MEMK, EPI_MEMV, EPI_OUTA, EPI_OUTB, EPI_SOFTMAX, EPI_ATTNO };
struct GDesc { const bf16_t* A; int lda; const bf16_t* Bt; int ldb; int K, brow, bcol, epi, orow, ocol, head, vai, vwr; };

DEV void cvt_mat(const Frame& F0, const float* src, int ldsrc, int K, int N, int wincols, const float* gain, bf16_t* dst) {
    REFRAME;
    float* T = (float*)F.lds;
    const int nkt = K / 64, nnt = N / 64, ntile = nkt * nnt;
    for (int t = F.bid; t < ntile; t += F.nb) {
        const int kt = t / nnt, ntl = t % nnt, k0 = kt * 64, n0 = ntl * 64;
        int coff = 0; if (wincols == 1) coff = (n0 < 1536) ? 0 : (n0 < 3072 ? 8 : 24);
        if (wincols == 2) { const int tl = n0 >> 8, w = n0 & 255; coff = (w < 128 ? 128 * tl + w : 2816 + 128 * tl + (w - 128)) - n0; }
        __syncthreads();
#pragma unroll
        for (int i = 0; i < 2; ++i) {
            const int kr = (F.tid >> 4) + 32 * i, nc = (F.tid & 15) * 4;
            f32x4 v = *(const f32x4*)(src + (size_t)(k0 + kr) * ldsrc + n0 + coff + nc);
            const float g = gain ? gain[k0 + kr] : 1.f;
            T[kr * 65 + nc + 0] = v[0] * g; T[kr * 65 + nc + 1] = v[1] * g; T[kr * 65 + nc + 2] = v[2] * g; T[kr * 65 + nc + 3] = v[3] * g;
        }
        __syncthreads();
        const int n = F.tid >> 3, kc = (F.tid & 7) * 8;
        u32x4 w;
        w.x = pk2(T[(kc + 0) * 65 + n], T[(kc + 1) * 65 + n]); w.y = pk2(T[(kc + 2) * 65 + n], T[(kc + 3) * 65 + n]);
        w.z = pk2(T[(kc + 4) * 65 + n], T[(kc + 5) * 65 + n]); w.w = pk2(T[(kc + 6) * 65 + n], T[(kc + 7) * 65 + n]);
        *(u32x4*)(dst + (size_t)(n0 + n) * K + k0 + kc) = w;
    }
    __syncthreads();
}
DEV void cvt_mixer(const Frame& F0, int l) {
    REFRAME;
    InTab in = F.in;
    cvt_mat(F, in[10] + (size_t)l * 1024 * 5656, 5656, 1024, 5632, 1, in[9] + l * 1024, ((bf16_t*)(F.ws + WS_WMIX)) + WM_WIN);
    cvt_mat(F, in[18] + (size_t)l * 512 * 1024, 1024, 512, 1024, 0, nullptr, ((bf16_t*)(F.ws + WS_WMIX)) + WM_WOA);
    cvt_mat(F, in[19] + (size_t)l * 512 * 1024, 1024, 512, 1024, 0, nullptr, ((bf16_t*)(F.ws + WS_WMIX)) + WM_WOB);
    cvt_mat(F, in[20] + (size_t)l * 1048576, 1024, 1024, 1024, 0, nullptr, ((bf16_t*)(F.ws + WS_WMIX)) + WM_WO);
    cvt_mat(F, in[23] + (size_t)l * 1048576, 1024, 1024, 1024, 0, in[21] + l * 1024, ((bf16_t*)(F.ws + WS_WMIX)) + WM_WMQ);
    cvt_mat(F, in[24] + (size_t)l * 1048576, 1024, 1024, 1024, 0, in[22] + l * 1024, ((bf16_t*)(F.ws + WS_WMIX)) + WM_WMK);
    cvt_mat(F, in[25] + (size_t)l * 1048576, 1024, 1024, 1024, 0, in[22] + l * 1024, ((bf16_t*)(F.ws + WS_WMIX)) + WM_WMV);
    cvt_mat(F, in[26] + (size_t)l * 1048576, 1024, 1024, 1024, 0, nullptr, ((bf16_t*)(F.ws + WS_WMIX)) + WM_WMO);
    const float* win = in[10] + (size_t)l * 1024 * 5656; const float* g = in[9] + l * 1024;
    for (int i = F.bid * 512 + F.tid; i < 32 * 1024; i += F.nb * 512) {
        const int n = i >> 10, k = i & 1023;
        float v = 0.f;
        if (n < 8) v = win[(size_t)k * 5656 + 1536 + n] * g[k]; else if (n < 24) v = win[(size_t)k * 5656 + 3080 + (n - 8)] * g[k];
        ((bf16_t*)(F.ws + WS_WMIX))[WM_WSM + i] = (bf16_t)(pk2(v, 0.f) & 0xffff);
    }
}
DEV void cvt_ffn(const Frame& F, int l) {
    cvt_mat(F, F.in[28] + (size_t)l * 1024 * 5632, 5632, 1024, 5632, 2, F.in[27] + l * 1024, ((bf16_t*)(F.ws + WS_WFFN)) + WF_UP);
    cvt_mat(F, F.in[31] + (size_t)l * 2816 * 1024, 1024, 2816, 1024, 0, nullptr, ((bf16_t*)(F.ws + WS_WFFN)) + WF_DN);
}

DEV void phase0(const Frame& F0) {
    REFRAME;
    const int gw = F.bid * 8 + F.wid, nw = F.nb * 8, lane = F.lane;
    for (int row = gw; row < TT + 4096; row += nw) {
        const bool ismem = row >= TT;
        const float* src = ismem ? F.in[8] + (size_t)(row - TT) * 1024 : (row < 32768 ? F.in[0] + (size_t)row * 1024 : F.in[1] + (size_t)(row - 32768) * 1024);
        f32x4 v[4]; float s = 0.f;
#pragma unroll
        for (int i = 0; i < 4; ++i) { v[i] = *(const f32x4*)(src + lane * 16 + i * 4); s += v[i][0] * v[i][0] + v[i][1] * v[i][1] + v[i][2] * v[i][2] + v[i][3] * v[i][3]; }
        u32x4 w0, w1;
        w0.x = pk2(v[0][0], v[0][1]); w0.y = pk2(v[0][2], v[0][3]); w0.z = pk2(v[1][0], v[1][1]); w0.w = pk2(v[1][2], v[1][3]);
        w1.x = pk2(v[2][0], v[2][1]); w1.y = pk2(v[2][2], v[2][3]); w1.z = pk2(v[3][0], v[3][1]); w1.w = pk2(v[3][2], v[3][3]);
        s += __shfl_xor(s, 1); s += __shfl_xor(s, 2);
        if (!ismem) {
            float* X = F.out + (size_t)row * 1024 + lane * 16;
#pragma unroll
            for (int i = 0; i < 4; ++i) *(f32x4*)(X + i * 4) = v[i];
            bf16_t* xb = ((bf16_t*)(F.ws + WS_XB)) + (size_t)row * 1024 + lane * 16;
            *(u32x4*)xb = w0; *(u32x4*)(xb + 8) = w1;
            if ((lane & 3) == 0) ((float*)(F.ws + WS_SSQ))[((size_t)(lane >> 4) * TT + row) * 4 + ((lane >> 2) & 3)] = s;
        } else {
            const int mr = row - TT;
            bf16_t* mb = ((bf16_t*)(F.ws + WS_MB)) + (size_t)mr * 1024 + lane * 16;
            *(u32x4*)mb = w0; *(u32x4*)(mb + 8) = w1;
            s += __shfl_xor(s, 4); s += __shfl_xor(s, 8); s += __shfl_xor(s, 16); s += __shfl_xor(s, 32);
            if (lane == 0) ((float*)(F.ws + WS_MRS))[mr] = rsqrtf(s * (1.f / 1024.f) + 1e-6f);
        }
    }
    cvt_mixer(F, 0);
    cvt_ffn(F, 0);
}

DEV void small_proj(const Frame& F0) {
    REFRAME;
    const int lane = F.lane, fr = lane & 15, fq = lane >> 4, mt = F.wid & 3, nt = F.wid >> 2;
    for (int c = F.bid; c < NCH; c += F.nb) {
        const int row = c * 64 + mt * 16 + fr;
        const bf16_t* a = ((bf16_t*)(F.ws + WS_XB)) + (size_t)row * 1024 + 8 * fq;
        const bf16_t* b = ((bf16_t*)(F.ws + WS_WMIX)) + WM_WSM + (size_t)(nt * 16 + fr) * 1024 + 8 * fq;
        f32x4 acc = {0.f, 0.f, 0.f, 0.f};
#pragma unroll 4
        for (int k = 0; k < 32; ++k) acc = MFMA16(*(const bf16x8*)(b + k * 32), *(const bf16x8*)(a + k * 32), acc);
        const float rs = row_rstd(((float*)(F.ws + WS_SSQ)), row);
        *(f32x4*)(((float*)(F.ws + WS_SC)) + (size_t)row * 32 + nt * 16 + 4 * fq) = acc * rs;
    }
}

DEV void gemm_epilogue(const Frame& F0, const GDesc& d, int l, f32x4 (&acc)[2][2][4][2]) {
    REFRAME;
    int lane_ = F.lane; asm volatile("" : "+v"(lane_));
    const int wr = F.wid >> 2, wc = F.wid & 3, fr = lane_ & 15, fq = lane_ >> 4;
    float* red = (float*)(F.lds + 131072);
    if (d.epi == EPI_SOFTMAX) {
        float mx[2][4];
#pragma unroll
        for (int ai = 0; ai < 2; ++ai)
#pragma unroll
            for (int m = 0; m < 4; ++m) {
                float v = -3.0e38f;
#pragma unroll
                for (int bj = 0; bj < 2; ++bj)
#pragma unroll
                    for (int n = 0; n < 2; ++n) { const f32x4 x = acc[ai][bj][m][n]; v = fmaxf(v, fmaxf(fmaxf(x[0], x[1]), fmaxf(x[2], x[3]))); }
                v = fmaxf(v, __shfl_xor(v, 16)); v = fmaxf(v, __shfl_xor(v, 32));
                if (fq == 0) red[(ai * 128 + wr * 64 + m * 16 + fr) * 4 + wc] = v;
            }
        __syncthreads();
#pragma unroll
        for (int ai = 0; ai < 2; ++ai)
#pragma unroll
            for (int m = 0; m < 4; ++m) {
                const f32x4 r4 = *(const f32x4*)(red + (ai * 128 + wr * 64 + m * 16 + fr) * 4);
                const float rm = fmaxf(fmaxf(r4[0], r4[1]), fmaxf(r4[2], r4[3]));
                mx[ai][m] = rm; float s = 0.f;
#pragma unroll
                for (int bj = 0; bj < 2; ++bj)
#pragma unroll
                    for (int n = 0; n < 2; ++n) { f32x4 x = acc[ai][bj][m][n];
#pragma unroll
                        for (int j = 0; j < 4; ++j) { x[j] = __expf(x[j] - rm); s += x[j]; }
                        acc[ai][bj][m][n] = x; }
                s += __shfl_xor(s, 16); s += __shfl_xor(s, 32);
                if (fq == 0) red[1024 + (ai * 128 + wr * 64 + m * 16 + fr) * 4 + wc] = s;
            }
        (void)mx;
        __syncthreads();
#pragma unroll
        for (int ai = 0; ai < 2; ++ai)
#pragma unroll
            for (int m = 0; m < 4; ++m) {
                const f32x4 r4 = *(const f32x4*)(red + 1024 + (ai * 128 + wr * 64 + m * 16 + fr) * 4);
                const float inv = 1.f / ((r4[0] + r4[1]) + (r4[2] + r4[3]));
                const bool valid = d.vai < 0 || (d.vai == ai && d.vwr == wr);
                const int row = d.orow + ai * 128 + wr * 64 + m * 16 + fr;
                if (valid) {
#pragma unroll
                    for (int bj = 0; bj < 2; ++bj)
#pragma unroll
                        for (int n = 0; n < 2; ++n) {
                            const int col = bj * 128 + wc * 32 + n * 16 + fq * 4;
                            *(u32x2*)(((bf16_t*)(F.ws + WS_P)) + (size_t)row * LDP + C_PR + d.head * 256 + col) = pk4(acc[ai][bj][m][n] * inv);
                        }
                }
            }
        __syncthreads();
        return;
    }
#pragma unroll
    for (int ai = 0; ai < 2; ++ai)
#pragma unroll
        for (int m = 0; m < 4; ++m) {
            const int row = d.orow + ai * 128 + wr * 64 + m * 16 + fr;
            float rs = 1.f, ss = 0.f;
            if (d.epi == EPI_PROJ || d.epi == EPI_UP || d.epi == EPI_Q) rs = row_rstd(((float*)(F.ws + WS_SSQ)), row);
            if (d.epi == EPI_Q) rs *= 0.0625f;
            if (d.epi == EPI_MEMK) rs = ((float*)(F.ws + WS_MRS))[row];
#pragma unroll
            for (int bj = 0; bj < 2; ++bj)
#pragma unroll
                for (int n = 0; n < 2; ++n) {
                    const int col = d.ocol + bj * 128 + wc * 32 + n * 16 + fq * 4;
                    f32x4 v = acc[ai][bj][m][n];
                    switch (d.epi) {
                    case EPI_UP: {
                        const int row_l = ai * 128 + wr * 64 + m * 16 + fr, cl = bj * 128 + wc * 32 + n * 16 + fq * 4;
                        *(u32x2*)((bf16_t*)F.lds + row_l * 264 + cl) = pk4(v * rs);
                    } break;
                    case EPI_PROJ: {
                        v = v * rs; const u32x2 w = pk4(v);
                        *(u32x2*)(((bf16_t*)(F.ws + WS_P)) + (size_t)row * LDP + col) = w;
                        if (m == 3 && fr >= 13 && col < 1536) {
                            const int chunk = row >> 6, hr = fr - 13;
                            *(u32x2*)(((bf16_t*)(F.ws + WS_KV)) + ((size_t)chunk * 3 + hr) * 1536 + col) = w;
                            if (chunk >= 512 || (chunk & 31) == 31) {
                                float* o = chunk < 512 ? F.out + O_GDNC_P + ((size_t)(l * 16 + (chunk >> 5)) * 3 + hr) * 1536 + col
                                                       : F.out + O_GDNC_S + ((size_t)(l * 8 + (chunk - 512)) * 3 + hr) * 1536 + col;
                                *(f32x4*)o = v;
                            }
                        }
                    } break;
                    case EPI_RESID: {
                        float* X = F.out + (size_t)row * 1024 + col;
                        f32x4 x = *(const f32x4*)X; x = x + v; *(f32x4*)X = x;
                        *(u32x2*)(((bf16_t*)(F.ws + WS_XB)) + (size_t)row * 1024 + col) = pk4(x);
                        ss += (x[0] * x[0] + x[1] * x[1]) + (x[2] * x[2] + x[3] * x[3]);
                    } break;
                    case EPI_Q: *(u32x2*)(((bf16_t*)(F.ws + WS_P)) + (size_t)row * LDP + C_Q + col) = pk4(v * rs); break;
                    case EPI_MEMK: {
                        v = v * rs;
                        *(f32x4*)(F.out + O_MEMK + ((size_t)l * 4096 + row) * 1024 + col) = v;
                        *(u32x2*)(((bf16_t*)(F.ws + WS_KV)) + (size_t)row * 1024 + col) = pk4(v);
                    } break;
                    case EPI_MEMV: {
                        const f32x4 r4 = *(const f32x4*)(((float*)(F.ws + WS_MRS)) + col);
                        v = v * r4;
                        float* o = F.out + O_MEMV + ((size_t)l * 4096 + col) * 1024 + row;
                        o[0] = v[0]; o[1024] = v[1]; o[2048] = v[2]; o[3072] = v[3];
                        const int b = col >> 8, h = row >> 8;
                        *(u32x2*)(((bf16_t*)(F.ws + WS_KV + 6144ull * 1024 * 2)) + ((size_t)(b * 4 + h) * 256 + (row & 255)) * 256 + (col & 255)) = pk4(v);
                    } break;
                    case EPI_OUTA: {
                        const f32x4 g = unpk4(*(const u32x2*)(((bf16_t*)(F.ws + WS_P)) + (size_t)row * LDP + C_GA + col));
                        f32x4 o; for (int j = 0; j < 4; ++j) o[j] = sigm(g[j]) * v[j];
                        *(u32x2*)(((bf16_t*)(F.ws + WS_P)) + (size_t)row * LDP + C_MRG + col) = pk4(o);
                    } break;
                    case EPI_OUTB: {
                        const f32x4 g = unpk4(*(const u32x2*)(((bf16_t*)(F.ws + WS_P)) + (size_t)row * LDP + C_GB + col));
                        f32x4 o = unpk4(*(const u32x2*)(((bf16_t*)(F.ws + WS_P)) + (size_t)row * LDP + C_MRG + col));
                        for (int j = 0; j < 4; ++j) o[j] += sigm(g[j]) * v[j];
                        *(u32x2*)(((bf16_t*)(F.ws + WS_P)) + (size_t)row * LDP + C_MRG + col) = pk4(o);
                    } break;
                    case EPI_ATTNO: {
                        const bool valid = d.vai < 0 || (d.vai == ai && d.vwr == wr);
                        if (valid) *(u32x2*)(((bf16_t*)(F.ws + WS_P)) + (size_t)row * LDP + C_O + d.head * 256 + col) = pk4(v);
                    } break;
                    default: break;
                    }
                }
            if (d.epi == EPI_RESID) {
                ss += __shfl_xor(ss, 16); ss += __shfl_xor(ss, 32);
                if (fq == 0) ((float*)(F.ws + WS_SSQ))[((size_t)(d.ocol >> 8) * TT + row) * 4 + wc] = ss;
            }
        }
    if (d.epi == EPI_UP) {
        bf16_t* ST = (bf16_t*)F.lds;
        const int pm = d.brow >> 8, pn = d.bcol >> 8;
        const bool samp = pm >= 128, needfix = !samp && (pm & 7) != 0;
        bf16_t* halo = ((bf16_t*)(F.ws + WS_KV)); bf16_t* raw01 = ((bf16_t*)(F.ws + WS_KV + 11714560ull));
        __syncthreads();
        {
            const int hsel = F.tid >> 6, cl4 = (F.tid & 63) * 4, ocol = ((cl4 >> 7) ? 2816 : 0) + 128 * pn + (cl4 & 127);
            const int row_l = (hsel >> 1) * 64 + 62 + (hsel & 1), chunk = (d.brow + row_l) >> 6, hr = hsel & 1;
            const u32x2 w = *(const u32x2*)(ST + row_l * 264 + cl4);
            *(u32x2*)(halo + ((size_t)chunk * 2 + hr) * 5632 + ocol) = w;
            if (chunk >= 512 || (chunk & 31) == 31) {
                float* o = chunk < 512 ? F.out + O_FFNC_P + ((size_t)(l * 16 + (chunk >> 5)) * 2 + hr) * 5632 + ocol
                                       : F.out + O_FFNC_S + ((size_t)(l * 8 + (chunk - 512)) * 2 + hr) * 5632 + ocol;
                *(f32x4*)o = unpk4(w);
            }
            if (needfix && hsel < 2) *(u32x2*)(raw01 + ((size_t)pm * 2 + hsel) * 5632 + ocol) = *(const u32x2*)(ST + hsel * 264 + cl4);
        }
        {
            const int cq = F.tid & 31, rg = F.tid >> 5, c4 = cq * 4, gcol = 128 * pn + c4, r0 = rg * 16;
            const float* cw = F.in[29] + (size_t)l * 3 * 5632; const float* cb = F.in[30] + (size_t)l * 5632;
            const f32x4 wg0 = *(const f32x4*)(cw + gcol), wg1 = *(const f32x4*)(cw + 5632 + gcol), wg2 = *(const f32x4*)(cw + 2 * 5632 + gcol), bg = *(const f32x4*)(cb + gcol);
            const f32x4 wv0 = *(const f32x4*)(cw + 2816 + gcol), wv1 = *(const f32x4*)(cw + 5632 + 2816 + gcol), wv2 = *(const f32x4*)(cw + 2 * 5632 + 2816 + gcol), bv = *(const f32x4*)(cb + 2816 + gcol);
            f32x4 g2 = {0.f, 0.f, 0.f, 0.f}, g1 = g2, v2 = g2, v1 = g2; bool skip2 = false;
            if ((samp ? (r0 & 63) : r0) != 0) {
                g2 = unpk4(*(const u32x2*)(ST + (r0 - 2) * 264 + c4)); g1 = unpk4(*(const u32x2*)(ST + (r0 - 1) * 264 + c4));
                v2 = unpk4(*(const u32x2*)(ST + (r0 - 2) * 264 + 128 + c4)); v1 = unpk4(*(const u32x2*)(ST + (r0 - 1) * 264 + 128 + c4));
            } else if (samp) {
                const float* sp = F.in[5] + (size_t)(l * 8 + (((d.brow + r0) >> 6) - 512)) * 2 * 5632;
                g2 = *(const f32x4*)(sp + gcol); g1 = *(const f32x4*)(sp + 5632 + gcol); v2 = *(const f32x4*)(sp + 2816 + gcol); v1 = *(const f32x4*)(sp + 5632 + 2816 + gcol);
            } else skip2 = needfix;
#pragma unroll 4
            for (int i = 0; i < 16; ++i) {
                const int row_l = r0 + i;
                const f32x4 g0 = unpk4(*(const u32x2*)(ST + row_l * 264 + c4)), v0 = unpk4(*(const u32x2*)(ST + row_l * 264 + 128 + c4));
                f32x4 o;
#pragma unroll
                for (int j = 0; j < 4; ++j) { const float yg = wg0[j] * g2[j] + wg1[j] * g1[j] + wg2[j] * g0[j] + bg[j], yv = wv0[j] * v2[j] + wv1[j] * v1[j] + wv2[j] * v0[j] + bv[j]; o[j] = silu(yg) * yv; }
                if (!(skip2 && i < 2)) *(u32x2*)(((bf16_t*)(F.ws + WS_P)) + (size_t)(d.brow + row_l) * LDP + gcol) = pk4(o);
                g2 = g1; g1 = g0; v2 = v1; v1 = v0;
            }
        }
        __syncthreads();
    }
}

DEV void sample_rows_gemm(const Frame& F0, const bf16_t* A, int lda, const bf16_t* Bt, int K, int resid) {
    REFRAME;
    if (F.nb != 256) return;
    const int fr = F.lane & 15, fq = F.lane >> 4, w = F.wid, rgp = F.bid >> 3, cg = F.bid & 7;
    const int row = 32768 + rgp * 16 + fr, colt = cg * 128 + w * 16;
    const bf16_t* ap = A + (size_t)row * lda + 8 * fq;
    const bf16_t* bp = Bt + (size_t)(colt + fr) * K + 8 * fq;
    f32x4 acc = {0.f, 0.f, 0.f, 0.f};
#pragma unroll 8
    for (int k = 0; k < K; k += 32) acc = MFMA16(*(const bf16x8*)(bp + k), *(const bf16x8*)(ap + k), acc);
    const int col = colt + 4 * fq;
    if (resid == 1) {
        float* X = F.out + (size_t)row * 1024 + col;
        f32x4 x = *(const f32x4*)X; x = x + acc; *(f32x4*)X = x;
        *(u32x2*)(((bf16_t*)(F.ws + WS_XB)) + (size_t)row * 1024 + col) = pk4(x);
        float ss = (x[0] * x[0] + x[1] * x[1]) + (x[2] * x[2] + x[3] * x[3]);
        ss += __shfl_xor(ss, 16); ss += __shfl_xor(ss, 32);
        float* red = (float*)F.lds;
        __syncthreads();
        if (fq == 0) red[fr * 8 + w] = ss;
        __syncthreads();
        if (F.tid < 32) {
            const int r = F.tid & 15, g = F.tid >> 4, c0 = cg * 128 + g * 64;
            const float t = (red[r * 8 + g * 4] + red[r * 8 + g * 4 + 1]) + (red[r * 8 + g * 4 + 2] + red[r * 8 + g * 4 + 3]);
            ((float*)(F.ws + WS_SSQ))[((size_t)(c0 >> 8) * TT + 32768 + rgp * 16 + r) * 4 + ((c0 >> 6) & 3)] = t;
        }
        __syncthreads();
    } else if (resid == 0) {
        const float rs = row_rstd(((float*)(F.ws + WS_SSQ)), row) * 0.0625f;
        *(u32x2*)(((bf16_t*)(F.ws + WS_P)) + (size_t)row * LDP + C_Q + col) = pk4(acc * rs);
    } else {
        bf16_t* prow = ((bf16_t*)(F.ws + WS_P)) + (size_t)row * LDP;
        const f32x4 g = unpk4(*(const u32x2*)(prow + (resid == 2 ? C_GA : C_GB) + col));
        f32x4 o = {0.f, 0.f, 0.f, 0.f};
        if (resid == 3) o = unpk4(*(const u32x2*)(prow + C_MRG + col));
#pragma unroll
        for (int j = 0; j < 4; ++j) o[j] += sigm(g[j]) * acc[j];
        *(u32x2*)(prow + C_MRG + col) = pk4(o);
    }
}

enum { GP_IN = 0, GP_OUT, GP_WO, GP_MQ, GP_ATTN, GP_MO, GP_UP, GP_DOWN, GP_ATTN2, GP_OUT2, GP_MEMKV };
DEV void gemm_phase(const Frame& F0, int kind, int l) {
    REFRAME;
    int nunits = 0;
    switch (kind) { case GP_IN: case GP_UP: nunits = 130 * 22; break; case GP_OUT: nunits = 520 + 128; break; case GP_OUT2: nunits = 520; break; case GP_ATTN: case GP_ATTN2: nunits = 512 + 32; break; default: nunits = 520; }
    const bool srow = (F.nb == 256) && (kind == GP_WO || kind == GP_MQ || kind == GP_MO || kind == GP_DOWN || kind == GP_OUT || kind == GP_OUT2);
    if (srow) nunits = 512;
    if (kind == GP_MEMKV) nunits = 128;
    f32x4 acc[2][2][4][2];
    const bool xmap = (F.nb == 256) && (kind == GP_IN || kind == GP_UP || kind == GP_WO || kind == GP_MQ || kind == GP_MO || kind == GP_DOWN || kind == GP_OUT2 || (kind == GP_OUT && srow));
    const int xcd = F.bid & 7, slot = F.bid >> 3, w_lo = (int)(((long)nunits * xcd) >> 3), w_hi = (int)(((long)nunits * (xcd + 1)) >> 3);
    const bool mkv = kind == GP_MEMKV;
    for (int u0 = mkv ? (F.bid >= 192 ? F.bid - 192 : nunits) : (xmap ? w_lo + slot : F.bid); u0 < (xmap ? w_hi : nunits); u0 += mkv ? 64 : (xmap ? 32 : F.nb)) {
        int u = u0;
        if (xmap) { const int nn = (kind == GP_IN || kind == GP_UP) ? 22 : 4; const int nm = srow ? 128 : 130; const int pn_ = u0 / nm, pm_ = u0 % nm; u = pm_ * nn + pn_; }
        GDesc d;
        { const int sub = (kind == GP_ATTN2 || kind == GP_OUT2) ? 1 : 0;
            d.vai = -1; d.vwr = 0; d.head = 0;
            switch (kind) {
            case GP_IN: { const int pm = u / 22, pn = u % 22; d.A = ((bf16_t*)(F.ws + WS_XB)); d.lda = 1024; d.Bt = ((bf16_t*)(F.ws + WS_WMIX)) + WM_WIN; d.ldb = 1024; d.K = 1024; d.brow = pm * 256; d.bcol = pn * 256; d.epi = EPI_PROJ; d.orow = d.brow; d.ocol = d.bcol; } break;
            case GP_UP: { const int pm = u / 22, pn = u % 22; d.A = ((bf16_t*)(F.ws + WS_XB)); d.lda = 1024; d.Bt = ((bf16_t*)(F.ws + WS_WFFN)) + WF_UP; d.ldb = 1024; d.K = 1024; d.brow = pm * 256; d.bcol = pn * 256; d.epi = EPI_UP; d.orow = d.brow; d.ocol = d.bcol; } break;
            case GP_MEMKV: case GP_OUT: case GP_OUT2:
                if (kind == GP_MEMKV) u += 520;
                if (u < 520) { const int pm = u >> 2, pn = u & 3; d.A = ((bf16_t*)(F.ws + WS_P)) + (sub == 0 ? C_ZA : C_ZB); d.lda = LDP; d.Bt = ((bf16_t*)(F.ws + WS_WMIX)) + (sub == 0 ? WM_WOA : WM_WOB); d.ldb = 512; d.K = 512;
                               d.brow = pm * 256; d.bcol = pn * 256; d.epi = sub == 0 ? EPI_OUTA : EPI_OUTB; d.orow = d.brow; d.ocol = d.bcol; }
                else if (u < 520 + 64) { const int v = u - 520, pm = v >> 2, pn = v & 3; d.A = ((bf16_t*)(F.ws + WS_MB)); d.lda = 1024; d.Bt = ((bf16_t*)(F.ws + WS_WMIX)) + WM_WMK; d.ldb = 1024; d.K = 1024; d.brow = pm * 256; d.bcol = pn * 256; d.epi = EPI_MEMK; d.orow = d.brow; d.ocol = d.bcol; }
                else { const int v = u - 584, pm = v & 3, pn = v >> 2; d.A = ((bf16_t*)(F.ws + WS_WMIX)) + WM_WMV; d.lda = 1024; d.Bt = ((bf16_t*)(F.ws + WS_MB)); d.ldb = 1024; d.K = 1024; d.brow = pm * 256; d.bcol = pn * 256; d.epi = EPI_MEMV; d.orow = d.brow; d.ocol = d.bcol; }
                break;
            case GP_WO: { const int pm = u >> 2, pn = u & 3; d.A = ((bf16_t*)(F.ws + WS_P)) + C_MRG; d.lda = LDP; d.Bt = ((bf16_t*)(F.ws + WS_WMIX)) + WM_WO; d.ldb = 1024; d.K = 1024; d.brow = pm * 256; d.bcol = pn * 256; d.epi = EPI_RESID; d.orow = d.brow; d.ocol = d.bcol; } break;
            case GP_MQ: { const int pm = u >> 2, pn = u & 3; d.A = ((bf16_t*)(F.ws + WS_XB)); d.lda = 1024; d.Bt = ((bf16_t*)(F.ws + WS_WMIX)) + WM_WMQ; d.ldb = 1024; d.K = 1024; d.brow = pm * 256; d.bcol = pn * 256; d.epi = EPI_Q; d.orow = d.brow; d.ocol = d.bcol; } break;
            case GP_MO: { const int pm = u >> 2, pn = u & 3; d.A = ((bf16_t*)(F.ws + WS_P)) + C_O; d.lda = LDP; d.Bt = ((bf16_t*)(F.ws + WS_WMIX)) + WM_WMO; d.ldb = 1024; d.K = 1024; d.brow = pm * 256; d.bcol = pn * 256; d.epi = EPI_RESID; d.orow = d.brow; d.ocol = d.bcol; } break;
            case GP_DOWN: { const int pm = u >> 2, pn = u & 3; d.A = ((bf16_t*)(F.ws + WS_P)); d.lda = LDP; d.Bt = ((bf16_t*)(F.ws + WS_WFFN)) + WF_DN; d.ldb = 2816; d.K = 2816; d.brow = pm * 256; d.bcol = pn * 256; d.epi = EPI_RESID; d.orow = d.brow; d.ocol = d.bcol; } break;
            case GP_ATTN: case GP_ATTN2: {
                int pm, h, b;
                if (u < 512) { pm = u >> 2; h = u & 3; b = pm >> 3; }
                else { const int v = u - 512; h = v & 3; const int bi = (v >> 2) & 3, t = v >> 4; pm = 128 + t; b = 16 + 4 * t + bi; d.vai = bi >> 1; d.vwr = bi & 1; }
                d.head = h; d.brow = pm * 256; d.orow = d.brow; d.ocol = 0; d.K = 256; d.bcol = 0;
                if (sub == 0) { d.A = ((bf16_t*)(F.ws + WS_P)) + C_Q + h * 256; d.lda = LDP; d.Bt = ((bf16_t*)(F.ws + WS_KV)) + (size_t)b * 256 * 1024 + h * 256; d.ldb = 1024; d.epi = EPI_SOFTMAX; }
                else { d.A = ((bf16_t*)(F.ws + WS_P)) + C_PR + h * 256; d.lda = LDP; d.Bt = ((bf16_t*)(F.ws + WS_KV + 6144ull * 1024 * 2)) + (size_t)(b * 4 + h) * 65536; d.ldb = 256; d.epi = EPI_ATTNO; }
            } break;
            }
        }
        gemm_core(d.A, d.lda, d.Bt, d.ldb, d.K, d.brow, d.bcol, acc, (bf16_t*)F.lds);
        gemm_epilogue(F, d, l, acc);
    }
    if (srow) {
        __syncthreads();
        if (kind == GP_WO) sample_rows_gemm(F, ((bf16_t*)(F.ws + WS_P)) + C_MRG, LDP, ((bf16_t*)(F.ws + WS_WMIX)) + WM_WO, 1024, 1);
        else if (kind == GP_MQ) sample_rows_gemm(F, ((bf16_t*)(F.ws + WS_XB)), 1024, ((bf16_t*)(F.ws + WS_WMIX)) + WM_WMQ, 1024, 0);
        else if (kind == GP_OUT) sample_rows_gemm(F, ((bf16_t*)(F.ws + WS_P)) + C_ZA, LDP, ((bf16_t*)(F.ws + WS_WMIX)) + WM_WOA, 512, 2);
        else if (kind == GP_OUT2) sample_rows_gemm(F, ((bf16_t*)(F.ws + WS_P)) + C_ZB, LDP, ((bf16_t*)(F.ws + WS_WMIX)) + WM_WOB, 512, 3);
        else if (kind == GP_MO) sample_rows_gemm(F, ((bf16_t*)(F.ws + WS_P)) + C_O, LDP, ((bf16_t*)(F.ws + WS_WMIX)) + WM_WMO, 1024, 1);
        else sample_rows_gemm(F, ((bf16_t*)(F.ws + WS_P)), LDP, ((bf16_t*)(F.ws + WS_WFFN)) + WF_DN, 2816, 1);
    }
}

DEV void sample_kv(const Frame& F0, int l) {
    REFRAME;
    const float* ck = F.in[6] + (size_t)l * 2097152; const float* cv = F.in[7] + (size_t)l * 2097152;
    const bool idle = F.nb == 256;
    if (idle && F.bid < 192) return;
    for (int i = (idle ? F.bid - 192 : F.bid) * 512 + F.tid; i < 262144; i += (idle ? 64 : F.nb) * 512) {
        const f32x4 a = *(const f32x4*)(ck + (size_t)i * 8), b = *(const f32x4*)(ck + (size_t)i * 8 + 4);
        u32x4 w; w.x = pk2(a[0], a[1]); w.y = pk2(a[2], a[3]); w.z = pk2(b[0], b[1]); w.w = pk2(b[2], b[3]);
        *(u32x4*)(((bf16_t*)(F.ws + WS_KV)) + 4096ull * 1024 + (size_t)i * 8) = w;
        const int dd = i & 255, m8 = (i >> 8) & 31, h = (i >> 13) & 3, bb = i >> 15;
        const float* s = cv + ((size_t)(bb * 256 + m8 * 8) * 4 + h) * 256 + dd;
        u32x4 x; x.x = pk2(s[0], s[1024]); x.y = pk2(s[2048], s[3072]); x.z = pk2(s[4096], s[5120]); x.w = pk2(s[6144], s[7168]);
        *(u32x4*)(((bf16_t*)(F.ws + WS_KV + 6144ull * 1024 * 2)) + ((size_t)((16 + bb) * 4 + h) * 256 + dd) * 256 + m8 * 8) = x;
    }
}

DEV void g1_gdn(const Frame& F0, int l, int c, int h) {
    REFRAME;
    float* Fq = (float*)F.lds;
    bf16_t* VS = (bf16_t*)(F.lds + 66560);
    bf16_t* QN = (bf16_t*)(F.lds + 82944);
    bf16_t* KN = (bf16_t*)(F.lds + 100352);
    float* AM = (float*)(F.lds + 117760);
    float* sB = (float*)(F.lds + 135168); float* sG = sB + 64; float* sRQ = sB + 128; float* sRK = sB + 192;
    const int tid = F.tid, lane = F.lane, t0 = c * 64;
    const bool first = c >= 512 || (c & 31) == 0; const bool sample = c >= 512;
    __syncthreads();
    if (F.wid == 0) {
        const int t = t0 + lane;
        const float braw = ((float*)(F.ws + WS_SC))[(size_t)t * 32 + h], araw = ((float*)(F.ws + WS_SC))[(size_t)t * 32 + 4 + h];
        const float beta = sigm(braw);
        float g = -__expf(F.in[12][l * 4 + h]) * softplus(araw + F.in[13][l * 4 + h]);
#pragma unroll
        for (int off = 1; off < 64; off <<= 1) { const float n = __shfl_up(g, off); if (lane >= off) g += n; }
        sB[lane] = beta; sG[lane] = g;
        if (!F.dry) ((float*)(F.ws + WS_BG))[((size_t)c * 4 + h) * 128 + lane] = beta; if (!F.dry) ((float*)(F.ws + WS_BG))[((size_t)c * 4 + h) * 128 + 64 + lane] = g;
    }
    __syncthreads();
    const float* cw = F.in[11] + (size_t)l * 4 * 1536;
    if (tid < 384) {
        const int cp = tid % 192, rh = tid / 192, which = cp >> 6, cc = (cp & 63) * 2, pcol = which * 512 + h * 128 + cc;
        const f32x2 w0 = *(const f32x2*)(cw + pcol), w1 = *(const f32x2*)(cw + 1536 + pcol), w2 = *(const f32x2*)(cw + 2 * 1536 + pcol), w3 = *(const f32x2*)(cw + 3 * 1536 + pcol);
        float x0[35], x1[35];
#pragma unroll
        for (int i = 0; i < 3; ++i) {
            x0[i] = 0.f; x1[i] = 0.f;
            if (rh == 1) { const unsigned u = *(const unsigned*)(((bf16_t*)(F.ws + WS_P)) + (size_t)(t0 + 29 + i) * LDP + pcol); x0[i] = bflo(u); x1[i] = bfhi(u); }
            else if (!first) { const unsigned u = *(const unsigned*)(((bf16_t*)(F.ws + WS_KV)) + ((size_t)(c - 1) * 3 + i) * 1536 + pcol); x0[i] = bflo(u); x1[i] = bfhi(u); }
            else if (sample) { const f32x2 f = *(const f32x2*)(F.in[3] + ((size_t)(l * 8 + (c - 512)) * 3 + i) * 1536 + pcol); x0[i] = f[0]; x1[i] = f[1]; }
        }
#pragma unroll
        for (int i = 0; i < 32; ++i) { const unsigned u = *(const unsigned*)(((bf16_t*)(F.ws + WS_P)) + (size_t)(t0 + 32 * rh + i) * LDP + pcol); x0[3 + i] = bflo(u); x1[3 + i] = bfhi(u); }
#pragma unroll
        for (int r = 0; r < 32; ++r) {
            float a0 = w0[0] * x0[r] + w1[0] * x0[r + 1] + w2[0] * x0[r + 2] + w3[0] * x0[r + 3];
            float a1 = w0[1] * x1[r] + w1[1] * x1[r + 1] + w2[1] * x1[r + 2] + w3[1] * x1[r + 3];
            a0 = silu(a0); a1 = silu(a1);
            const int rr = 32 * rh + r;
            if (which < 2) { *(f32x2*)(Fq + rr * 260 + which * 128 + cc) = (f32x2){a0, a1}; }
            else { const float be = sB[rr]; *(unsigned*)(VS + rr * 128 + cc) = pk2(a0 * be, a1 * be); }
        }
    }
    __syncthreads();
    {
        const int r = tid >> 3, j = tid & 7; const float* p = Fq + r * 260 + j * 32; float s = 0.f;
#pragma unroll
        for (int i = 0; i < 32; ++i) s += p[i] * p[i];
        s += __shfl_xor(s, 1); s += __shfl_xor(s, 2);
        if ((j & 3) == 0) { if (j == 0) sRQ[r] = rsqrtf(s + 1e-6f) * 0.08838834764831845f; else sRK[r] = rsqrtf(s + 1e-6f); }
    }
    __syncthreads();
    for (int idx = tid; idx < 64 * 64; idx += 512) {
        const int r = idx >> 6, c4 = (idx & 63) * 4; const bool isq = c4 < 128;
        f32x4 v = *(const f32x4*)(Fq + r * 260 + c4); v = v * (isq ? sRQ[r] : sRK[r]);
        const u32x2 w = pk4(v);
        if (isq) { *(u32x2*)(QN + r * 136 + c4) = w; if (!F.dry) *(u32x2*)(((bf16_t*)(F.ws + WS_P)) + (size_t)(t0 + r) * LDP + C_QA + h * 128 + c4) = w; }
        else { *(u32x2*)(KN + r * 136 + c4 - 128) = w; if (!F.dry) *(u32x2*)(((bf16_t*)(F.ws + WS_P)) + (size_t)(t0 + r) * LDP + C_KA + h * 128 + c4 - 128) = w; }
    }
    for (int idx = tid; idx < 64 * 32; idx += 512) {
        const int r = idx >> 5, c4 = (idx & 31) * 4;
        if (!F.dry) *(u32x2*)(((bf16_t*)(F.ws + WS_P)) + (size_t)(t0 + r) * LDP + C_VA + h * 128 + c4) = *(const u32x2*)(VS + r * 128 + c4);
    }
    __syncthreads();
    {
        const int fr = lane & 15, fq = lane >> 4, which = F.wid >> 2, it = F.wid & 3;
        const bf16_t* X = which ? QN : KN;
        const int crow = 16 * it + fr; const float gc = sG[crow], bc = sB[crow];
        for (int jt = 0; jt < 4; ++jt) {
            f32x4 a = {0.f, 0.f, 0.f, 0.f};
            if (jt <= it) {
#pragma unroll
                for (int ks = 0; ks < 4; ++ks) a = MFMA16(ldfrag(KN, 16 * jt + fr, 136, 32 * ks, fq), ldfrag(X, crow, 136, 32 * ks, fq), a);
            }
            f32x4 o;
#pragma unroll
            for (int j = 0; j < 4; ++j) {
                const int s = 16 * jt + 4 * fq + j;
                const bool keep = which ? (s <= crow) : (s < crow);
                const float dec = keep ? __expf(gc - sG[s]) : 0.f;
                o[j] = a[j] * dec * (which ? 1.f : bc);
            }
            if (which) { if (!F.dry) *(u32x2*)(((bf16_t*)(F.ws + WS_XB)) + (size_t)(t0 + crow) * LDE + h * 128 + 64 + 16 * jt + 4 * fq) = pk4(o); }
            else *(f32x4*)(AM + crow * 68 + 16 * jt + 4 * fq) = o;
        }
    }
    __syncthreads();
    {
        float* TF = (float*)F.lds;
        float* MS = (float*)(F.lds + 20480);
        const int w = F.wid;
        if (w == 0) {
            const int blk = lane >> 4, cc = lane & 15, base = blk * 16;
            float Tc[16];
#pragma unroll
            for (int i = 0; i < 16; ++i) {
                float a = (i == cc) ? 1.f : 0.f;
#pragma unroll
                for (int j = 0; j < i; ++j) a -= AM[(base + i) * 68 + base + j] * Tc[j];
                Tc[i] = a;
            }
#pragma unroll
            for (int i = 0; i < 16; ++i) TF[(base + i) * 68 + base + cc] = Tc[i];
        }
        __syncthreads();
#pragma unroll 1
        for (int dd = 1; dd < 4; ++dd) {
            if (w < 4 - dd) {
                const int I = w + dd, J = w, r = lane >> 2, c4 = (lane & 3) * 4;
                f32x4 mm = {0.f, 0.f, 0.f, 0.f};
                for (int K = J; K < I; ++K)
#pragma unroll
                    for (int k = 0; k < 16; ++k) { const float a = AM[(I * 16 + r) * 68 + K * 16 + k]; const f32x4 t = *(const f32x4*)(TF + (K * 16 + k) * 68 + J * 16 + c4); mm = mm + a * t; }
                float* ms = MS + w * 256;
                *(f32x4*)(ms + r * 16 + c4) = mm;
                asm volatile("s_waitcnt lgkmcnt(0)" ::: "memory");
                f32x4 o = {0.f, 0.f, 0.f, 0.f};
#pragma unroll
                for (int k = 0; k < 16; ++k) { const float a = TF[(I * 16 + r) * 68 + I * 16 + k]; const f32x4 t = *(const f32x4*)(ms + k * 16 + c4); o = o - a * t; }
                *(f32x4*)(TF + (I * 16 + r) * 68 + J * 16 + c4) = o;
            }
            __syncthreads();
        }
        {
            const int r = tid >> 3, c8 = (tid & 7) * 8; const bool z = (c8 >> 4) > (r >> 4);
            const f32x4 a = z ? (f32x4){0.f, 0.f, 0.f, 0.f} : *(const f32x4*)(TF + r * 68 + c8), b = z ? (f32x4){0.f, 0.f, 0.f, 0.f} : *(const f32x4*)(TF + r * 68 + c8 + 4);
            u32x4 o; o.x = pk2(a[0], a[1]); o.y = pk2(a[2], a[3]); o.z = pk2(b[0], b[1]); o.w = pk2(b[2], b[3]);
            if (!F.dry) *(u32x4*)(((bf16_t*)(F.ws + WS_XB)) + (size_t)(t0 + r) * LDE + h * 128 + c8) = o;
        }
    }
}

DEV void g1_gla(const Frame& F0, int l, int c, int h) {
    REFRAME;
    float* GL = (float*)F.lds;
    float* LA = (float*)(F.lds + 4096);
    bf16_t* QG = (bf16_t*)(F.lds + 20736);
    bf16_t* KI = (bf16_t*)(F.lds + 29952);
    const int tid = F.tid, lane = F.lane, t0 = c * 64;
    __syncthreads();
    if (tid < 256) { const int r = tid >> 2, q4 = (tid & 3) * 4; *(f32x4*)(GL + r * 16 + q4) = *(const f32x4*)(((float*)(F.ws + WS_SC)) + (size_t)(t0 + r) * 32 + 8 + q4); }
    __syncthreads();
    {
        const int dk = tid & 63, rb = tid >> 6;
        float w2[16];
#pragma unroll
        for (int i = 0; i < 16; ++i) w2[i] = F.in[15][(size_t)(l * 16 + i) * 256 + h * 64 + dk];
        const float bias = F.in[16][l * 256 + h * 64 + dk];
#pragma unroll
        for (int rr = 0; rr < 8; ++rr) {
            const int r = rb * 8 + rr; float x = bias;
#pragma unroll
            for (int i = 0; i < 16; ++i) x += GL[r * 16 + i] * w2[i];
            LA[r * 65 + dk] = logsigmoid(x) * 0.0625f;
        }
    }
    __syncthreads();
    if (tid < 64) {
        float g = 0.f;
#pragma unroll 8
        for (int r = 0; r < 64; ++r) { g += LA[r * 65 + tid]; LA[r * 65 + tid] = g; }
        if (!F.dry) ((float*)(F.ws + WS_DL))[((size_t)c * 4 + h) * 64 + tid] = __expf(g);
    }
    __syncthreads();
    for (int idx = tid; idx < 64 * 16; idx += 512) {
        const int r = idx >> 4, c4 = (idx & 15) * 4;
        bf16_t* qp = ((bf16_t*)(F.ws + WS_P)) + (size_t)(t0 + r) * LDP + C_QB + h * 64 + c4; bf16_t* kp = ((bf16_t*)(F.ws + WS_P)) + (size_t)(t0 + r) * LDP + C_KB + h * 64 + c4;
        const f32x4 q = unpk4(*(const u32x2*)qp), k = unpk4(*(const u32x2*)kp);
        f32x4 qg, ki, kg;
#pragma unroll
        for (int j = 0; j < 4; ++j) { const float g = LA[r * 65 + c4 + j], gl = LA[63 * 65 + c4 + j];
            qg[j] = q[j] * 0.125f * __expf(g); ki[j] = k[j] * __expf(-g); kg[j] = k[j] * __expf(gl - g); }
        const u32x2 wq = pk4(qg);
        *(u32x2*)(QG + r * 72 + c4) = wq; *(u32x2*)(KI + r * 72 + c4) = pk4(ki);
        if (!F.dry) *(u32x2*)qp = wq; if (!F.dry) *(u32x2*)kp = pk4(kg);
    }
    __syncthreads();
    {
        const int fr = lane & 15, fq = lane >> 4, it = F.wid >> 1; const int crow = 16 * it + fr;
#pragma unroll
        for (int q = 0; q < 2; ++q) {
            const int jt = (F.wid & 1) * 2 + q;
            f32x4 a = {0.f, 0.f, 0.f, 0.f};
            if (jt <= it) {
#pragma unroll
                for (int ks = 0; ks < 2; ++ks) a = MFMA16(ldfrag(KI, 16 * jt + fr, 72, 32 * ks, fq), ldfrag(QG, crow, 72, 32 * ks, fq), a);
            }
#pragma unroll
            for (int j = 0; j < 4; ++j) if (16 * jt + 4 * fq + j > crow) a[j] = 0.f;
            if (!F.dry) *(u32x2*)(((bf16_t*)(F.ws + WS_XB)) + (size_t)(t0 + crow) * LDE + 512 + h * 64 + 16 * jt + 4 * fq) = pk4(a);
        }
    }
}

DEV void g2_gdn(const Frame& F0, int l, int s, int h) {
    REFRAME;
    bf16_t* QN = (bf16_t*)F.lds;
    bf16_t* KN = (bf16_t*)(F.lds + 17408);
    bf16_t* KT = (bf16_t*)(F.lds + 34816);
    bf16_t* TM = (bf16_t*)(F.lds + 53248);
    bf16_t* AQ = (bf16_t*)(F.lds + 62464);
    float* sB = (float*)(F.lds + 71680); float* sG = sB + 64;
    float* RED = (float*)(F.lds + 72192);
    bf16_t* VV = (bf16_t*)(F.lds + 74240);
    bf16_t* ZZ = (bf16_t*)(F.lds + 91648);
    const int tid = F.tid, lane = F.lane, w = F.wid, fr = lane & 15, fq = lane >> 4;
    const bool sample = s >= 16; const int nchunk = sample ? 1 : 32; const int tbase = sample ? 32768 + (s - 16) * 64 : s * 2048;
    const int dvc = h * 128 + 16 * w + fr;
    f32x4 S[8];
#pragma unroll
    for (int mt = 0; mt < 8; ++mt) {
        if (sample) { const float* sp = F.in[2] + ((size_t)((l * 8 + (s - 16)) * 4 + h) * 128) * 128;
#pragma unroll
            for (int j = 0; j < 4; ++j) S[mt][j] = sp[(size_t)(16 * mt + 4 * fq + j) * 128 + 16 * w + fr]; }
        else S[mt] = (f32x4){0.f, 0.f, 0.f, 0.f};
    }
    const float gn = F.in[14][l * 128 + 16 * w + fr];
    for (int n = 0; n < nchunk; ++n) {
        const int t0 = tbase + n * 64;
        __syncthreads();
#pragma unroll
        for (int i = 0; i < 2; ++i) {
            const int p = tid + 512 * i, r = p >> 4, c8 = (p & 15) * 8;
            const u32x4 q = *(const u32x4*)(((bf16_t*)(F.ws + WS_P)) + (size_t)(t0 + r) * LDP + C_QA + h * 128 + c8);
            const u32x4 k = *(const u32x4*)(((bf16_t*)(F.ws + WS_P)) + (size_t)(t0 + r) * LDP + C_KA + h * 128 + c8);
            *(u32x4*)(QN + r * 136 + c8) = q; *(u32x4*)(KN + r * 136 + c8) = k;
            *(u32x4*)(VV + r * 136 + c8) = *(const u32x4*)(((bf16_t*)(F.ws + WS_P)) + (size_t)(t0 + r) * LDP + C_VA + h * 128 + c8);
            *(u32x4*)(ZZ + r * 136 + c8) = *(const u32x4*)(((bf16_t*)(F.ws + WS_P)) + (size_t)(t0 + r) * LDP + C_ZA + h * 128 + c8);
            KT[(c8 + 0) * 72 + r] = (bf16_t)(k.x & 0xffff); KT[(c8 + 1) * 72 + r] = (bf16_t)(k.x >> 16);
            KT[(c8 + 2) * 72 + r] = (bf16_t)(k.y & 0xffff); KT[(c8 + 3) * 72 + r] = (bf16_t)(k.y >> 16);
            KT[(c8 + 4) * 72 + r] = (bf16_t)(k.z & 0xffff); KT[(c8 + 5) * 72 + r] = (bf16_t)(k.z >> 16);
            KT[(c8 + 6) * 72 + r] = (bf16_t)(k.w & 0xffff); KT[(c8 + 7) * 72 + r] = (bf16_t)(k.w >> 16);
        }
        {
            const int r = tid >> 3, c8 = (tid & 7) * 8;
            *(u32x4*)(TM + r * 72 + c8) = *(const u32x4*)(((bf16_t*)(F.ws + WS_XB)) + (size_t)(t0 + r) * LDE + h * 128 + c8);
            *(u32x4*)(AQ + r * 72 + c8) = *(const u32x4*)(((bf16_t*)(F.ws + WS_XB)) + (size_t)(t0 + r) * LDE + h * 128 + 64 + c8);
        }
        if (tid < 128) sB[tid] = ((float*)(F.ws + WS_BG))[((size_t)(t0 >> 6) * 4 + h) * 128 + tid];
        __syncthreads();
        f32x4 kS[4], qS[4], vn[4], o[4];
#pragma unroll
        for (int mt = 0; mt < 4; ++mt) { kS[mt] = (f32x4){0.f, 0.f, 0.f, 0.f}; qS[mt] = kS[mt]; vn[mt] = kS[mt]; }
#pragma unroll
        for (int ks = 0; ks < 4; ++ks) {
            const bf16x8 sf = mk8(pk4(S[2 * ks]), pk4(S[2 * ks + 1]));
#pragma unroll
            for (int mt = 0; mt < 4; ++mt) {
                kS[mt] = MFMA16(ldfragp(KN, 16 * mt + fr, 136, 32 * ks, fq), sf, kS[mt]);
                qS[mt] = MFMA16(ldfragp(QN, 16 * mt + fr, 136, 32 * ks, fq), sf, qS[mt]);
            }
        }
        const float glast = sG[63];
        f32x4 eg[4], tmp[4];
#pragma unroll
        for (int mt = 0; mt < 4; ++mt)
#pragma unroll
            for (int j = 0; j < 4; ++j) {
                const int row = 16 * mt + 4 * fq + j;
                const float e = __expf(sG[row]); eg[mt][j] = e;
                const float vv = bf2f(VV[row * 136 + 16 * w + fr]);
                tmp[mt][j] = vv - sB[row] * e * kS[mt][j];
            }
#pragma unroll
        for (int ks = 0; ks < 2; ++ks) {
            const bf16x8 tf = mk8(pk4(tmp[2 * ks]), pk4(tmp[2 * ks + 1]));
#pragma unroll
            for (int mt = 0; mt < 4; ++mt) vn[mt] = MFMA16(ldfragp(TM, 16 * mt + fr, 72, 32 * ks, fq), tf, vn[mt]);
        }
#pragma unroll
        for (int mt = 0; mt < 4; ++mt) o[mt] = eg[mt] * qS[mt];
#pragma unroll
        for (int ks = 0; ks < 2; ++ks) {
            const bf16x8 vf = mk8(pk4(vn[2 * ks]), pk4(vn[2 * ks + 1]));
#pragma unroll
            for (int mt = 0; mt < 4; ++mt) o[mt] = MFMA16(ldfragp(AQ, 16 * mt + fr, 72, 32 * ks, fq), vf, o[mt]);
        }
        const float dl = __expf(glast);
#pragma unroll
        for (int mt = 0; mt < 4; ++mt)
#pragma unroll
            for (int j = 0; j < 4; ++j) vn[mt][j] *= __expf(glast - sG[16 * mt + 4 * fq + j]);
#pragma unroll
        for (int mt = 0; mt < 8; ++mt) S[mt] = S[mt] * dl;
#pragma unroll
        for (int ks = 0; ks < 2; ++ks) {
            const bf16x8 vf = mk8(pk4(vn[2 * ks]), pk4(vn[2 * ks + 1]));
#pragma unroll
            for (int mt = 0; mt < 8; ++mt) S[mt] = MFMA16(ldfragp(KT, 16 * mt + fr, 72, 32 * ks, fq), vf, S[mt]);
        }
#pragma unroll
        for (int mt = 0; mt < 4; ++mt)
#pragma unroll
            for (int j = 0; j < 4; ++j) {
                float p = o[mt][j] * o[mt][j];
                p += __shfl_xor(p, 1); p += __shfl_xor(p, 2); p += __shfl_xor(p, 4); p += __shfl_xor(p, 8);
                if (fr == 0) RED[(16 * mt + 4 * fq + j) * 8 + w] = p;
            }
        __syncthreads();
#pragma unroll
        for (int mt = 0; mt < 4; ++mt)
#pragma unroll
            for (int j = 0; j < 4; ++j) {
                const int row = 16 * mt + 4 * fq + j;
                const f32x4 r0 = *(const f32x4*)(RED + row * 8), r1 = *(const f32x4*)(RED + row * 8 + 4);
                const float ssum = ((r0[0] + r0[1]) + (r0[2] + r0[3])) + ((r1[0] + r1[1]) + (r1[2] + r1[3]));
                const float rs = rsqrtf(ssum * (1.f / 128.f) + 1e-6f);
                bf16_t* zp = ((bf16_t*)(F.ws + WS_P)) + (size_t)(t0 + row) * LDP + C_ZA + dvc;
                const float z = bf2f(ZZ[row * 136 + 16 * w + fr]);
                if (!F.dry) *zp = (bf16_t)(pk2(o[mt][j] * rs * gn * silu(z), 0.f) & 0xffff);
            }
    }
    float* so = sample ? F.out + O_GDN_S + ((size_t)((l * 8 + (s - 16)) * 4 + h) * 128) * 128 : F.out + O_GDN_P + ((size_t)((l * 16 + s) * 4 + h) * 128) * 128;
#pragma unroll
    for (int mt = 0; mt < 8; ++mt)
#pragma unroll
        for (int j = 0; j < 4; ++j) if (!F.dry) so[(size_t)(16 * mt + 4 * fq + j) * 128 + 16 * w + fr] = S[mt][j];
}

DEV void g2_gla(const Frame& F0, int l, int s, int h) {
    REFRAME;
    bf16_t* QG = (bf16_t*)F.lds;
    bf16_t* KGT = (bf16_t*)(F.lds + 9216);
    bf16_t* AQ = (bf16_t*)(F.lds + 18432);
    float* sDL = (float*)(F.lds + 27648);
    float* RED = (float*)(F.lds + 27904);
    bf16_t* ZZ = (bf16_t*)(F.lds + 29952);
    const int tid = F.tid, lane = F.lane, w = F.wid, fr = lane & 15, fq = lane >> 4;
    const bool sample = s >= 16; const int nchunk = sample ? 1 : 32; const int tbase = sample ? 32768 + (s - 16) * 64 : s * 2048;
    const int dvc = h * 128 + 16 * w + fr;
    f32x4 S[4];
#pragma unroll
    for (int mt = 0; mt < 4; ++mt) {
        if (sample) { const float* sp = F.in[4] + ((size_t)((l * 8 + (s - 16)) * 4 + h) * 64) * 128;
#pragma unroll
            for (int j = 0; j < 4; ++j) S[mt][j] = sp[(size_t)(16 * mt + 4 * fq + j) * 128 + 16 * w + fr]; }
        else S[mt] = (f32x4){0.f, 0.f, 0.f, 0.f};
    }
    const float gn = F.in[17][l * 128 + 16 * w + fr];
    for (int n = 0; n < nchunk; ++n) {
        const int t0 = tbase + n * 64, chunk = t0 >> 6;
        __syncthreads();
        {
            const int r = tid >> 3, c8 = (tid & 7) * 8;
            *(u32x4*)(QG + r * 72 + c8) = *(const u32x4*)(((bf16_t*)(F.ws + WS_P)) + (size_t)(t0 + r) * LDP + C_QB + h * 64 + c8);
            const u32x4 k = *(const u32x4*)(((bf16_t*)(F.ws + WS_P)) + (size_t)(t0 + r) * LDP + C_KB + h * 64 + c8);
            KGT[(c8 + 0) * 72 + r] = (bf16_t)(k.x & 0xffff); KGT[(c8 + 1) * 72 + r] = (bf16_t)(k.x >> 16);
            KGT[(c8 + 2) * 72 + r] = (bf16_t)(k.y & 0xffff); KGT[(c8 + 3) * 72 + r] = (bf16_t)(k.y >> 16);
            KGT[(c8 + 4) * 72 + r] = (bf16_t)(k.z & 0xffff); KGT[(c8 + 5) * 72 + r] = (bf16_t)(k.z >> 16);
            KGT[(c8 + 6) * 72 + r] = (bf16_t)(k.w & 0xffff); KGT[(c8 + 7) * 72 + r] = (bf16_t)(k.w >> 16);
            *(u32x4*)(AQ + r * 72 + c8) = *(const u32x4*)(((bf16_t*)(F.ws + WS_XB)) + (size_t)(t0 + r) * LDE + 512 + h * 64 + c8);
        }
#pragma unroll
        for (int i = 0; i < 2; ++i) { const int p = tid + 512 * i, r = p >> 4, c8 = (p & 15) * 8;
            *(u32x4*)(ZZ + r * 136 + c8) = *(const u32x4*)(((bf16_t*)(F.ws + WS_P)) + (size_t)(t0 + r) * LDP + C_ZB + h * 128 + c8); }
        if (tid < 64) sDL[tid] = ((float*)(F.ws + WS_DL))[((size_t)chunk * 4 + h) * 64 + tid];
        bf16x8 vf[2];
#pragma unroll
        for (int ks = 0; ks < 2; ++ks) {
            unsigned e[8];
#pragma unroll
            for (int j = 0; j < 8; ++j) { const int row = 32 * ks + (j < 4 ? 4 * fq + j : 16 + 4 * fq + (j - 4)); e[j] = ((bf16_t*)(F.ws + WS_P))[(size_t)(t0 + row) * LDP + C_VB + dvc]; }
            u32x4 t; t.x = e[0] | (e[1] << 16); t.y = e[2] | (e[3] << 16); t.z = e[4] | (e[5] << 16); t.w = e[6] | (e[7] << 16);
            vf[ks] = __builtin_bit_cast(bf16x8, t);
        }
        __syncthreads();
        f32x4 o[4];
#pragma unroll
        for (int mt = 0; mt < 4; ++mt) o[mt] = (f32x4){0.f, 0.f, 0.f, 0.f};
#pragma unroll
        for (int ks = 0; ks < 2; ++ks) {
            const bf16x8 sf = mk8(pk4(S[2 * ks]), pk4(S[2 * ks + 1]));
#pragma unroll
            for (int mt = 0; mt < 4; ++mt) {
                o[mt] = MFMA16(ldfragp(QG, 16 * mt + fr, 72, 32 * ks, fq), sf, o[mt]);
                o[mt] = MFMA16(ldfragp(AQ, 16 * mt + fr, 72, 32 * ks, fq), vf[ks], o[mt]);
            }
        }
#pragma unroll
        for (int mt = 0; mt < 4; ++mt) {
#pragma unroll
            for (int j = 0; j < 4; ++j) S[mt][j] *= sDL[16 * mt + 4 * fq + j];
#pragma unroll
            for (int ks = 0; ks < 2; ++ks) S[mt] = MFMA16(ldfragp(KGT, 16 * mt + fr, 72, 32 * ks, fq), vf[ks], S[mt]);
        }
#pragma unroll
        for (int mt = 0; mt < 4; ++mt)
#pragma unroll
            for (int j = 0; j < 4; ++j) {
                float p = o[mt][j] * o[mt][j];
                p += __shfl_xor(p, 1); p += __shfl_xor(p, 2); p += __shfl_xor(p, 4); p += __shfl_xor(p, 8);
                if (fr == 0) RED[(16 * mt + 4 * fq + j) * 8 + w] = p;
            }
        __syncthreads();
#pragma unroll
        for (int mt = 0; mt < 4; ++mt)
#pragma unroll
            for (int j = 0; j < 4; ++j) {
                const int row = 16 * mt + 4 * fq + j;
                const f32x4 r0 = *(const f32x4*)(RED + row * 8), r1 = *(const f32x4*)(RED + row * 8 + 4);
                const float ssum = ((r0[0] + r0[1]) + (r0[2] + r0[3])) + ((r1[0] + r1[1]) + (r1[2] + r1[3]));
                const float rs = rsqrtf(ssum * (1.f / 128.f) + 1e-6f);
                bf16_t* zp = ((bf16_t*)(F.ws + WS_P)) + (size_t)(t0 + row) * LDP + C_ZB + dvc;
                const float z = bf2f(ZZ[row * 136 + 16 * w + fr]);
                if (!F.dry) *zp = (bf16_t)(pk2(o[mt][j] * rs * gn * silu(z), 0.f) & 0xffff);
            }
    }
    float* so = sample ? F.out + O_GLA_S + ((size_t)((l * 8 + (s - 16)) * 4 + h) * 64) * 128 : F.out + O_GLA_P + ((size_t)((l * 16 + s) * 4 + h) * 64) * 128;
#pragma unroll
    for (int mt = 0; mt < 4; ++mt)
#pragma unroll
        for (int j = 0; j < 4; ++j) if (!F.dry) so[(size_t)(16 * mt + 4 * fq + j) * 128 + 16 * w + fr] = S[mt][j];
}

DEV void unpack8(u32x4 u, float (&f)[8]) { f[0] = bflo(u.x); f[1] = bfhi(u.x); f[2] = bflo(u.y); f[3] = bfhi(u.y); f[4] = bflo(u.z); f[5] = bfhi(u.z); f[6] = bflo(u.w); f[7] = bfhi(u.w); }
DEV void load8f(const float* p, float (&f)[8]) { const f32x4 a = *(const f32x4*)p, b = *(const f32x4*)(p + 4); f[0] = a[0]; f[1] = a[1]; f[2] = a[2]; f[3] = a[3]; f[4] = b[0]; f[5] = b[1]; f[6] = b[2]; f[7] = b[3]; }
DEV void ffn_mid(const Frame& F0, int l) {
    REFRAME;
    const float* cw = F.in[29] + (size_t)l * 3 * 5632; const float* cb = F.in[30] + (size_t)l * 5632;
    const bf16_t* halo = ((bf16_t*)(F.ws + WS_KV)); const bf16_t* raw01 = ((bf16_t*)(F.ws + WS_KV + 11714560ull));
    for (int idx = F.bid * 512 + F.tid; idx < 112 * 704; idx += F.nb * 512) {
        const int ti = idx / 704, c4 = (idx % 704) * 4, pm = (ti / 7) * 8 + (ti % 7) + 1;
        const bf16_t* hp = halo + (size_t)(4 * pm - 1) * 2 * 5632; const bf16_t* rp = raw01 + (size_t)pm * 2 * 5632;
        const f32x4 gm2 = unpk4(*(const u32x2*)(hp + c4)), gm1 = unpk4(*(const u32x2*)(hp + 5632 + c4)), g0 = unpk4(*(const u32x2*)(rp + c4)), g1 = unpk4(*(const u32x2*)(rp + 5632 + c4));
        const f32x4 vm2 = unpk4(*(const u32x2*)(hp + 2816 + c4)), vm1 = unpk4(*(const u32x2*)(hp + 5632 + 2816 + c4)), v0 = unpk4(*(const u32x2*)(rp + 2816 + c4)), v1 = unpk4(*(const u32x2*)(rp + 5632 + 2816 + c4));
        const f32x4 wg0 = *(const f32x4*)(cw + c4), wg1 = *(const f32x4*)(cw + 5632 + c4), wg2 = *(const f32x4*)(cw + 2 * 5632 + c4), bg = *(const f32x4*)(cb + c4);
        const f32x4 wv0 = *(const f32x4*)(cw + 2816 + c4), wv1 = *(const f32x4*)(cw + 5632 + 2816 + c4), wv2 = *(const f32x4*)(cw + 2 * 5632 + 2816 + c4), bv = *(const f32x4*)(cb + 2816 + c4);
        f32x4 o0, o1;
#pragma unroll
        for (int j = 0; j < 4; ++j) {
            const float yg0 = wg0[j] * gm2[j] + wg1[j] * gm1[j] + wg2[j] * g0[j] + bg[j], yv0 = wv0[j] * vm2[j] + wv1[j] * vm1[j] + wv2[j] * v0[j] + bv[j];
            const float yg1 = wg0[j] * gm1[j] + wg1[j] * g0[j] + wg2[j] * g1[j] + bg[j], yv1 = wv0[j] * vm1[j] + wv1[j] * v0[j] + wv2[j] * v1[j] + bv[j];
            o0[j] = silu(yg0) * yv0; o1[j] = silu(yg1) * yv1;
        }
        bf16_t* vp = ((bf16_t*)(F.ws + WS_P)) + (size_t)pm * 256 * LDP + c4;
        *(u32x2*)vp = pk4(o0); *(u32x2*)(vp + LDP) = pk4(o1);
    }
}

DEV void final_norm(const Frame& F0) {
    REFRAME;
    const int gw = F.bid * 8 + F.wid, nw = F.nb * 8, lane = F.lane;
    const float* g = F.in[32];
    for (int row = gw; row < TT; row += nw) {
        const float rs = row_rstd(((float*)(F.ws + WS_SSQ)), row);
        float* X = F.out + (size_t)row * 1024;
#pragma unroll
        for (int i = 0; i < 4; ++i) { const int cidx = i * 256 + lane * 4; f32x4 v = *(const f32x4*)(X + cidx); const f32x4 gg = *(const f32x4*)(g + cidx); *(f32x4*)(X + cidx) = v * rs * gg; }
    }
}

#ifdef DBG_COL
DEV void dbg_dump(const Frame& F0) {
    REFRAME;
    for (int i = F.bid * 512 + F.tid; i < TT * 256; i += F.nb * 512) {
        const int row = i >> 8, c = (i & 255) * 4;
        const f32x4 v = c < 512 ? unpk4(*(const u32x2*)(((bf16_t*)(F.ws + WS_P)) + (size_t)row * LDP + DBG_COL + c)) : (f32x4){0.f, 0.f, 0.f, 0.f};
        *(f32x4*)(F.out + (size_t)row * 1024 + c) = (row DBG_ROWSEL) ? v : (f32x4){0.f, 0.f, 0.f, 0.f};
    }
}
#endif
#define XB_TMO      128
#define XB_XCNT(j)  (256  + 64 * (j))
#define XB_XSUB(j)  (1280 + 64 * (j))
#define XB_XGEN(j)  (2304 + 64 * (j))
#define XB_TOP      3328
#define XB_TOPGEN   3392
#define XCD_BAR_WORDS 3456
#define XB_SPIN_CAP (1u << 18)
#define LAS __attribute__((address_space(3)))

__device__ __forceinline__ unsigned xb_ld(unsigned* p)              { return __hip_atomic_load(p, __ATOMIC_RELAXED, __HIP_MEMORY_SCOPE_AGENT); }
__device__ __forceinline__ unsigned xb_add(unsigned* p, unsigned v) { return __hip_atomic_fetch_add(p, v, __ATOMIC_RELAXED, __HIP_MEMORY_SCOPE_AGENT); }
__device__ __forceinline__ unsigned xb_xcc_id() { return (unsigned)__builtin_amdgcn_s_getreg((3 << 11) | 20) & 0xFu; }
#define XB_SPIN(cond, bar) do { unsigned _sp = 0; while (cond) { __builtin_amdgcn_s_sleep(1); \
    if ((++_sp & 255u) == 0u) { if (xb_ld(&(bar)[XB_TMO])) break; if (_sp > XB_SPIN_CAP) { atomicAdd(&(bar)[XB_TMO], 1u); break; } } } } while (0)

struct XcdBarrier {
    unsigned* bar; unsigned x;
    volatile LAS unsigned* st;
};

__device__ __forceinline__ XcdBarrier xcd_barrier_post(unsigned* bar, volatile LAS unsigned* st) {
    XcdBarrier b; b.bar = bar; b.x = xb_xcc_id(); b.st = st;
    if (threadIdx.x == 0) (void)xb_add(&bar[XB_XCNT(b.x)], 1u);
    return b;
}
__device__ __forceinline__ void xcd_barrier_complete(unsigned* bar, unsigned x, unsigned& nloc, unsigned& nx) {
    const unsigned G = gridDim.x * gridDim.y * gridDim.z;
    unsigned sum, cnt, mine, sp = 0u;
    for (;;) {
        sum = 0u; cnt = 0u; mine = 0u;
#pragma unroll
        for (unsigned j = 0; j < 16; ++j) { const unsigned c = xb_ld(&bar[XB_XCNT(j)]); sum += c; cnt += (c > 0u) ? 1u : 0u; mine = (j == x) ? c : mine; }
        if (sum == G) break;
        __builtin_amdgcn_s_sleep(1);
        if ((++sp & 255u) == 0u) { if (xb_ld(&bar[XB_TMO])) break; if (sp > XB_SPIN_CAP) { atomicAdd(&bar[XB_TMO], 1u); break; } }
    }
    nloc = mine > 0u ? mine : 1u; nx = cnt > 0u ? cnt : 1u;
}

__device__ __forceinline__ void xcd_barrier(const XcdBarrier& b) {
    asm volatile("s_waitcnt vmcnt(0)" ::: "memory");
    __syncthreads();
    if (threadIdx.x == 0) {
        unsigned* bar = b.bar;
        __builtin_amdgcn_s_waitcnt(0);
        unsigned nloc = b.st[0], nx = b.st[1];
        if (nloc == 0u) { xcd_barrier_complete(bar, b.x, nloc, nx); b.st[0] = nloc; b.st[1] = nx; }
        const unsigned old = xb_add(&bar[XB_XSUB(b.x)], 1u);
        const unsigned gen = old / nloc;
        if (old + 1u == (gen + 1u) * nloc) {
            __builtin_amdgcn_fence(__ATOMIC_RELEASE, "agent");
            asm volatile("s_waitcnt vmcnt(0)" ::: "memory");
            const unsigned og = xb_add(&bar[XB_TOP], 1u);
            const unsigned tg = og / nx;
            if (og + 1u == (tg + 1u) * nx) xb_add(&bar[XB_TOPGEN], 1u);
            else XB_SPIN(xb_ld(&bar[XB_TOPGEN]) == tg, bar);
            __builtin_amdgcn_fence(__ATOMIC_ACQUIRE, "agent");
            xb_add(&bar[XB_XGEN(b.x)], 1u);
            asm volatile("s_waitcnt vmcnt(0)" ::: "memory");
        } else {
            XB_SPIN(xb_ld(&bar[XB_XGEN(b.x)]) == gen, bar);
            __builtin_amdgcn_fence(__ATOMIC_ACQUIRE, "agent");
            asm volatile("s_waitcnt vmcnt(0)" ::: "memory");
        }
    }
    __syncthreads();
}

__global__ void __launch_bounds__(512, 2) fwd_kernel(Params p) {
    extern __shared__ __attribute__((aligned(16))) unsigned char lds[];
    cg::grid_group grid = cg::this_grid();
    Frame F;
    F.in = (InTab)__builtin_amdgcn_kernarg_segment_ptr(); F.out = p.out; F.ws = p.ws; F.lds = lds;
    F.tid = threadIdx.x; F.lane = threadIdx.x & 63; F.wid = __builtin_amdgcn_readfirstlane(threadIdx.x >> 6); F.nb = gridDim.x; F.bid = blockIdx.x; F.dry = 0;
    volatile LAS unsigned* xst = (volatile LAS unsigned*)(lds + LDS_BYTES - 16);
    if (threadIdx.x == 0) { xst[0] = 0u; xst[1] = 0u; }
    __syncthreads();
    const XcdBarrier xbar = xcd_barrier_post((unsigned*)(p.ws + WS_BAR), xst);
    for (int ph = p.ph_lo; ph < p.ph_hi; ++ph) {
#ifndef PHM
#define PHM 0xffff
#endif
        if (ph == 0) { if (PHM & 0x1000) phase0(F); }
        else if (ph == NPH - 1) { if (PHM & 0x2000) final_norm(F); }
        else {
            const int l = (ph - 1) / 13, k = (ph - 1) % 13;
            int gk = -1;
            if (k == 2 && gridDim.x == 256) gk = GP_MEMKV;
            switch (k) { case 0: gk = GP_IN; break; case 3: gk = GP_OUT; break; case 4: gk = GP_OUT2; break; case 5: gk = GP_WO; break; case 6: gk = GP_MQ; break; case 7: gk = GP_ATTN; break; case 8: gk = GP_ATTN2; break;
                         case 9: gk = GP_MO; break; case 10: gk = GP_UP; break; case 12: gk = GP_DOWN; break; default: break; }
#ifndef REPMASK
#define REPMASK 0
#endif
            if (gk >= 0 && (PHM & 1)) { const int nrep = ((REPMASK >> k) & 1) ? 2 : 1; for (int rep = 0; rep < nrep; ++rep) gemm_phase(F, gk, l); }
            if (k == 0 && (PHM & 1)) small_proj(F);
            if (k == (gridDim.x == 256 ? 2 : 3) && (PHM & 8)) sample_kv(F, l);
#ifndef DRYMASK
#define DRYMASK 0
#endif
            for (int dr = ((DRYMASK >> k) & 1); dr >= 0; --dr) {
            F.dry = dr;
            if (k == 1 && (PHM & 2)) {
                for (int it = F.bid; it < NCH * 8; it += F.nb) { const int c = it >> 3, h = it & 3; if (it & 4) g1_gla(F, l, c, h); else g1_gdn(F, l, c, h); }
                __syncthreads();
                if (l > 0 && !dr) cvt_ffn(F, l);
            }
            if (k == 2 && (PHM & 4)) {
                for (int it = F.bid; it < 192; it += F.nb) {
                    int s, h, br;
                    if (it < 128) { br = it & 1; h = (it >> 1) & 3; s = it >> 3; } else { const int v = it - 128; br = v & 1; h = (v >> 1) & 3; s = 16 + (v >> 3); }
                    if (br) g2_gla(F, l, s, h); else g2_gdn(F, l, s, h);
                    __syncthreads();
                }
            }
            if (k == 11 && (PHM & 0x200)) { ffn_mid(F, l); if (l < 3 && !dr) { __syncthreads(); cvt_mixer(F, l + 1); } }
            }
            F.dry = 0;
        }
#ifndef SYNCREP
#define SYNCREP 1
#endif
        if (ph + 1 < p.ph_hi) {
            if (ph == 0) grid.sync();
            else xcd_barrier(xbar);
        }
    }
#ifdef DBG_COL
    __threadfence(); grid.sync(); __threadfence();
    dbg_dump(F);
#endif
}

extern "C" void kernel_launch(void* const* d_in, const int* in_sizes, int n_in, void* d_out, int out_size, void* d_ws, size_t ws_size, hipStream_t stream) {
    static int grid_blocks = 0;
    if (grid_blocks == 0) {
        if (n_in != 33 || ws_size < WS_TOTAL) { fprintf(stderr, "kernel_launch: bad n_in %d or ws %zu < %zu\n", n_in, ws_size, (size_t)WS_TOTAL); grid_blocks = -1; return; }
        int dev = 0, cus = 0, per_cu = 0;
        hipGetDevice(&dev);
        hipDeviceGetAttribute(&cus, hipDeviceAttributeMultiprocessorCount, dev);
        if (hipFuncSetAttribute((const void*)fwd_kernel, hipFuncAttributeMaxDynamicSharedMemorySize, LDS_BYTES) != hipSuccess) { fprintf(stderr, "hipFuncSetAttribute failed\n"); grid_blocks = -1; return; }
        hipOccupancyMaxActiveBlocksPerMultiprocessor(&per_cu, (const void*)fwd_kernel, 512, LDS_BYTES);
        if (per_cu < 1) per_cu = 1;
        (void)hipGetLastError();
        grid_blocks = cus * 1;
        if (grid_blocks <= 0) grid_blocks = 256;
    }
    if (grid_blocks < 0) return;
    Params p{};
    for (int i = 0; i < 33; ++i) p.in[i] = (const float*)d_in[i];
    p.out = (float*)d_out; p.ws = (unsigned char*)d_ws; p.ph_lo = 0; p.ph_hi = PH_HI;
    (void)hipMemsetAsync((unsigned char*)d_ws + WS_BAR, 0, 16384, stream);
    void* args[] = {&p};
    hipError_t e = hipLaunchCooperativeKernel((const void*)fwd_kernel, dim3(grid_blocks), dim3(512), args, LDS_BYTES, stream);
    if (e != hipSuccess) fprintf(stderr, "cooperative launch failed: %s (grid %d)\n", hipGetErrorString(e), grid_blocks);
}
```

```cpp
#include <hip/hip_runtime.h>
#include <hip/hip_cooperative_groups.h>
#include <cstdint>
#include <cstdio>
namespace cg = cooperative_groups;

typedef unsigned short bf16_t;
typedef short bf16x8 __attribute__((ext_vector_type(8)));
typedef float f32x4 __attribute__((ext_vector_type(4)));
typedef float f32x2 __attribute__((ext_vector_type(2)));
typedef unsigned u32x2 __attribute__((ext_vector_type(2)));
typedef unsigned u32x4 __attribute__((ext_vector_type(4)));
#define DEV __device__ __forceinline__

constexpr int DM = 1024, TT = 33280, NCH = 520, LDP = 5632, LDE = 768;
constexpr int C_QA = 0, C_KA = 512, C_VA = 1024, C_ZA = 1536, C_QB = 2048, C_KB = 2304, C_VB = 2560, C_ZB = 3072, C_GA = 3584, C_GB = 4608;
constexpr int C_MRG = 0, C_PR = 1024, C_Q = 2048, C_O = 3072;
constexpr size_t O_Y = 0;
constexpr size_t O_GDN_P = 34078720ull;
constexpr size_t O_GDNC_P = O_GDN_P + 4194304ull;
constexpr size_t O_GLA_P = O_GDNC_P + 294912ull;
constexpr size_t O_FFNC_P = O_GLA_P + 2097152ull;
constexpr size_t O_MEMK = O_FFNC_P + 720896ull;
constexpr size_t O_MEMV = O_MEMK + 16777216ull;
constexpr size_t O_GDN_S = O_MEMV + 16777216ull;
constexpr size_t O_GDNC_S = O_GDN_S + 2097152ull;
constexpr size_t O_GLA_S = O_GDNC_S + 147456ull;
constexpr size_t O_FFNC_S = O_GLA_S + 1048576ull;
constexpr size_t al256(size_t x) { return (x + 255) & ~(size_t)255; }
constexpr size_t WS_WMIX = 0;
constexpr size_t WM_WIN = 0, WM_WSM = WM_WIN + 5632ull * 1024, WM_WOA = WM_WSM + 32 * 1024, WM_WOB = WM_WOA + 524288, WM_WO = WM_WOB + 524288,
                 WM_WMQ = WM_WO + 1048576, WM_WMK = WM_WMQ + 1048576, WM_WMV = WM_WMK + 1048576, WM_WMO = WM_WMV + 1048576, WM_END = WM_WMO + 1048576;
constexpr size_t WS_WFFN = al256(WS_WMIX + WM_END * 2);
constexpr size_t WF_UP = 0, WF_DN = 5632ull * 1024, WF_END = WF_DN + 1024ull * 2816;
constexpr size_t WS_XB = al256(WS_WFFN + WF_END * 2);
constexpr size_t WS_P = al256(WS_XB + (size_t)TT * 1024 * 2);
constexpr size_t WS_KV = al256(WS_P + (size_t)TT * LDP * 2);
constexpr size_t KV_BYTES = 2ull * 6144 * 1024 * 2;
constexpr size_t WS_MB = al256(WS_KV + KV_BYTES);
constexpr size_t WS_MRS = al256(WS_MB + 4096ull * 1024 * 2);
constexpr size_t WS_SSQ = al256(WS_MRS + 4096 * 4);
constexpr size_t WS_SC = al256(WS_SSQ + (size_t)TT * 16 * 4);
constexpr size_t WS_DL = al256(WS_SC + (size_t)TT * 32 * 4);
constexpr size_t WS_BG = al256(WS_DL + 520ull * 4 * 64 * 4);
constexpr size_t WS_BAR = al256(WS_BG + 520ull * 4 * 128 * 4);
constexpr size_t WS_TOTAL = al256(WS_BAR + 16384);
constexpr int LDS_BYTES = 147456;
constexpr int NPH = 54;
#ifndef PH_HI
#define PH_HI NPH
#define REPMASK 0
#define SYNCREP 1
#define DRYMASK 0
#endif

struct Params { const float* in[33]; float* out; unsigned char* ws; int ph_lo, ph_hi; };

typedef __bf16 bf16x2_t __attribute__((ext_vector_type(2)));
DEV unsigned pk2(float lo, float hi) { f32x2 f = {lo, hi}; bf16x2_t v = __builtin_convertvector(f, bf16x2_t); return __builtin_bit_cast(unsigned, v); }
DEV float bf2f(bf16_t b) { return __uint_as_float(((unsigned)b) << 16); }
DEV float bflo(unsigned u) { return __uint_as_float(u << 16); }
DEV float bfhi(unsigned u) { return __uint_as_float(u & 0xffff0000u); }
DEV u32x2 pk4(f32x4 v) { u32x2 r; r.x = pk2(v[0], v[1]); r.y = pk2(v[2], v[3]); return r; }
DEV f32x4 unpk4(u32x2 u) { return (f32x4){bflo(u.x), bfhi(u.x), bflo(u.y), bfhi(u.y)}; }
DEV bf16x8 mk8(u32x2 a, u32x2 b) { u32x4 t = {a.x, a.y, b.x, b.y}; return __builtin_bit_cast(bf16x8, t); }
DEV float sigm(float x) { return 1.f / (1.f + __expf(-x)); }
DEV float silu(float x) { return x / (1.f + __expf(-x)); }
DEV float softplus(float x) { return x > 20.f ? x : __logf(1.f + __expf(x)); }
DEV float logsigmoid(float x) { return fminf(x, 0.f) - __logf(1.f + __expf(-fabsf(x))); }
DEV float row_rstd(const float* ssq, int row) {
    const f32x4 a = *(const f32x4*)(ssq + (size_t)row * 4), b = *(const f32x4*)(ssq + ((size_t)TT + row) * 4);
    const f32x4 c = *(const f32x4*)(ssq + ((size_t)2 * TT + row) * 4), d = *(const f32x4*)(ssq + ((size_t)3 * TT + row) * 4);
    float s = ((a[0] + a[1]) + (a[2] + a[3])) + ((b[0] + b[1]) + (b[2] + b[3])) + ((c[0] + c[1]) + (c[2] + c[3])) + ((d[0] + d[1]) + (d[2] + d[3]));
    return rsqrtf(s * (1.f / 1024.f) + 1e-6f);
}
DEV bf16x8 ldfragp(const bf16_t* base, int row, int stride, int k0, int fq) {
    const bf16_t* p = base + row * stride + k0 + 4 * fq;
    return mk8(*(const u32x2*)p, *(const u32x2*)(p + 16));
}
DEV bf16x8 ldfrag(const bf16_t* base, int row, int stride, int k0, int fq) {
    return *(const bf16x8*)(base + row * stride + k0 + 8 * fq);
}
#define MFMA16(a, b, c) __builtin_amdgcn_mfma_f32_16x16x32_bf16((a), (b), (c), 0, 0, 0)

constexpr int BM = 256, BK = 64, HALF = 128, HT = HALF * BK;
DEV int lds_byte(int r, int c) { int st = (r >> 4) * 2 + (c >> 5), rr = r & 15, cc = c & 31, ob = rr * 64 + cc * 2; return st * 1024 + (ob ^ (((ob >> 9) & 1) << 5)); }
DEV void stage_rc(int b, int& R, int& C) { int st = b / 1024, sb = b % 1024, swz = sb ^ (((sb >> 9) & 1) << 5); R = (st >> 1) * 16 + swz / 64; C = (st & 1) * 32 + (swz % 64) / 2; }

DEV void gemm_core(const bf16_t* __restrict__ A, int lda, const bf16_t* __restrict__ Bt, int ldb, int K, int brow, int bcol, f32x4 (&acc)[2][2][4][2], bf16_t* shm) {
#define SA(b, h) (shm + ((b) * 2 + (h)) * HT)
#define SB(b, h) (shm + (4 + (b) * 2 + (h)) * HT)
#define STAGE(P, BASE, LD, br, kt) do { const char* _gb = (const char*)((BASE) + (long)(br) * (LD) + (long)(kt) * BK); \
    const unsigned _vo = (unsigned)((sr0 * (int)(LD) + sc0) * 2); \
    for (int _i = 0; _i < 2; ++_i) { \
      __builtin_amdgcn_global_load_lds((const unsigned*)(_gb + (long)(_i * 128) * (LD) + _vo), (unsigned*)((char*)(P) + wbase + _i * 8192), 16, 0, 0); } } while (0)
#define LDA(dst, b, h) for (int m = 0; m < 4; ++m) for (int k = 0; k < 2; ++k) \
    dst[m][k] = *reinterpret_cast<const bf16x8*>((char*)SA(b, h) + lds_byte(wr * 64 + m * 16 + fr, k * 32 + fq * 8))
#define LDB(dst, b, h) for (int n = 0; n < 2; ++n) for (int k = 0; k < 2; ++k) \
    dst[n][k] = *reinterpret_cast<const bf16x8*>((char*)SB(b, h) + lds_byte(wc * 32 + n * 16 + fr, k * 32 + fq * 8))
#define MMA(ai, bj, At_, Bt_) do { __builtin_amdgcn_s_setprio(1); \
    for (int m = 0; m < 4; ++m) for (int n = 0; n < 2; ++n) for (int k = 0; k < 2; ++k) \
      acc[ai][bj][m][n] = __builtin_amdgcn_mfma_f32_16x16x32_bf16(Bt_[n][k], At_[m][k], acc[ai][bj][m][n], 0, 0, 0); \
    __builtin_amdgcn_s_setprio(0); } while (0)
#define WAIT_V(n) asm volatile("s_waitcnt vmcnt(" #n ")" ::: "memory")
#define WAIT_L(n) asm volatile("s_waitcnt lgkmcnt(" #n ")" ::: "memory")
#define BAR __builtin_amdgcn_s_barrier()
#define SCHED __builtin_amdgcn_sched_barrier(0)
    int tidx = threadIdx.x; asm volatile("" : "+v"(tidx));
    const int wid = __builtin_amdgcn_readfirstlane(tidx >> 6), lane = tidx & 63, wr = wid >> 2, wc = wid & 3, fr = lane & 15, fq = lane >> 4;
    const int wbase = wid * 1024;
    int sr0, sc0; stage_rc(tidx * 16, sr0, sc0);
#pragma unroll
    for (int a = 0; a < 2; ++a)
#pragma unroll
        for (int b = 0; b < 2; ++b)
#pragma unroll
            for (int m = 0; m < 4; ++m)
#pragma unroll
                for (int n = 0; n < 2; ++n) acc[a][b][m][n] = (f32x4){0.f, 0.f, 0.f, 0.f};
    bf16x8 At[4][2], B0[2][2], B1[2][2];
    const int nt = K / BK;
    STAGE(SB(0, 0), Bt, ldb, bcol, 0); STAGE(SA(0, 0), A, lda, brow, 0);
    STAGE(SB(0, 1), Bt, ldb, bcol + HALF, 0); STAGE(SA(0, 1), A, lda, brow + HALF, 0);
    if (wr == 1) BAR;
    WAIT_V(4); BAR;
    STAGE(SB(1, 0), Bt, ldb, bcol, 1); STAGE(SA(1, 0), A, lda, brow, 1); STAGE(SB(1, 1), Bt, ldb, bcol + HALF, 1);
    WAIT_V(6); BAR;
    for (int t = 0; t < nt - 2; t += 2) {
        LDB(B0, 0, 0); SCHED; LDA(At, 0, 0); STAGE(SA(1, 1), A, lda, brow + HALF, t + 1);
        WAIT_L(8); BAR; WAIT_L(0); MMA(0, 0, At, B0); BAR; SCHED;
        LDB(B1, 0, 1); STAGE(SB(0, 0), Bt, ldb, bcol, t + 2);
        BAR; WAIT_L(0); MMA(0, 1, At, B1); BAR;
        LDA(At, 0, 1); STAGE(SA(0, 0), A, lda, brow, t + 2);
        BAR; WAIT_L(0); MMA(1, 0, At, B0); BAR; SCHED;
        STAGE(SB(0, 1), Bt, ldb, bcol + HALF, t + 2);
        WAIT_V(6); BAR; MMA(1, 1, At, B1); BAR;
        LDB(B0, 1, 0); SCHED; LDA(At, 1, 0); STAGE(SA(0, 1), A, lda, brow + HALF, t + 2);
        WAIT_L(8); BAR; WAIT_L(0); MMA(0, 0, At, B0); BAR; SCHED;
        LDB(B1, 1, 1); STAGE(SB(1, 0), Bt, ldb, bcol, t + 3);
        BAR; WAIT_L(0); MMA(0, 1, At, B1); BAR;
        LDA(At, 1, 1); STAGE(SA(1, 0), A, lda, brow, t + 3);
        BAR; WAIT_L(0); MMA(1, 0, At, B0); BAR; SCHED;
        STAGE(SB(1, 1), Bt, ldb, bcol + HALF, t + 3);
        WAIT_V(6); BAR; MMA(1, 1, At, B1); BAR;
    }
    { LDB(B0, 0, 0); LDA(At, 0, 0); STAGE(SA(1, 1), A, lda, brow + HALF, nt - 1);
      BAR; WAIT_L(0); MMA(0, 0, At, B0); BAR;
      LDB(B1, 0, 1); BAR; WAIT_L(0); MMA(0, 1, At, B1); BAR;
      LDA(At, 0, 1); WAIT_V(4); BAR; WAIT_L(0); MMA(1, 0, At, B0); MMA(1, 1, At, B1); BAR; }
    { LDB(B0, 1, 0); LDA(At, 1, 0); WAIT_V(2); BAR; WAIT_L(0); MMA(0, 0, At, B0); BAR;
      LDB(B1, 1, 1); WAIT_V(0); BAR; WAIT_L(0); MMA(0, 1, At, B1); BAR;
      LDA(At, 1, 1); BAR; WAIT_L(0); MMA(1, 0, At, B0); MMA(1, 1, At, B1); BAR; }
    if (wr == 0) BAR;
    SCHED;
#undef SA
#undef SB
}

typedef const float* const __attribute__((address_space(4)))* InTab;
struct Frame {
    InTab in; float* out; unsigned char* ws; unsigned char* lds;
    int tid, lane, wid, nb, bid, dry, cb, cn;
};
#define REFRAME Frame F = F0; { int t_ = threadIdx.x; asm volatile("" : "+v"(t_)); F.tid = t_; F.lane = t_ & 63; unsigned char* w_ = F.ws; asm volatile("" : "+s"(w_)); F.ws = w_; float* o_ = F.out; asm volatile("" : "+s"(o_)); F.out = o_; InTab i_ = (InTab)__builtin_amdgcn_kernarg_segment_ptr(); asm volatile("" : "+s"(i_)); F.in = i_; int a_ = F.wid, b_ = F.bid, c_ = F.nb; asm volatile("" : "+s"(a_), "+s"(b_), "+s"(c_)); F.wid = a_; F.bid = b_; F.nb = c_; }

enum { EPI_PROJ = 0, EPI_UP, EPI_RESID, EPI_Q, EPI_MEMK, EPI_MEMV, EPI_OUTA, EPI_OUTB, EPI_SOFTMAX, EPI_ATTNO };
struct GDesc { const bf16_t* A; int lda; const bf16_t* Bt; int ldb; int K, brow, bcol, epi, orow, ocol, head, vai, vwr; };

DEV void cvt_mat(const Frame& F0, const float* src, int ldsrc, int K, int N, int wincols, const float* gain, bf16_t* dst) {
    REFRAME;
    float* T = (float*)F.lds;
    const int nkt = K / 64, nnt = N / 64, ntile = nkt * nnt;
    for (int t = F.cb; t < ntile; t += F.cn) {
        const int kt = t / nnt, ntl = t % nnt, k0 = kt * 64, n0 = ntl * 64;
        int coff = 0; if (wincols == 1) coff = (n0 < 1536) ? 0 : (n0 < 3072 ? 8 : 24);
        if (wincols == 2) { const int tl = n0 >> 8, w = n0 & 255; coff = (w < 128 ? 128 * tl + w : 2816 + 128 * tl + (w - 128)) - n0; }
        __syncthreads();
#pragma unroll
        for (int i = 0; i < 2; ++i) {
            const int kr = (F.tid >> 4) + 32 * i, nc = (F.tid & 15) * 4;
            f32x4 v = *(const f32x4*)(src + (size_t)(k0 + kr) * ldsrc + n0 + coff + nc);
            const float g = gain ? gain[k0 + kr] : 1.f;
            T[kr * 65 + nc + 0] = v[0] * g; T[kr * 65 + nc + 1] = v[1] * g; T[kr * 65 + nc + 2] = v[2] * g; T[kr * 65 + nc + 3] = v[3] * g;
        }
        __syncthreads();
        const int n = F.tid >> 3, kc = (F.tid & 7) * 8;
        u32x4 w;
        w.x = pk2(T[(kc + 0) * 65 + n], T[(kc + 1) * 65 + n]); w.y = pk2(T[(kc + 2) * 65 + n], T[(kc + 3) * 65 + n]);
        w.z = pk2(T[(kc + 4) * 65 + n], T[(kc + 5) * 65 + n]); w.w = pk2(T[(kc + 6) * 65 + n], T[(kc + 7) * 65 + n]);
        *(u32x4*)(dst + (size_t)(n0 + n) * K + k0 + kc) = w;
    }
    __syncthreads();
}
DEV void cvt_mixer(const Frame& F0, int l) {
    REFRAME;
    InTab in = F.in;
    cvt_mat(F, in[10] + (size_t)l * 1024 * 5656, 5656, 1024, 5632, 1, in[9] + l * 1024, ((bf16_t*)(F.ws + WS_WMIX)) + WM_WIN);
    cvt_mat(F, in[18] + (size_t)l * 512 * 1024, 1024, 512, 1024, 0, nullptr, ((bf16_t*)(F.ws + WS_WMIX)) + WM_WOA);
    cvt_mat(F, in[19] + (size_t)l * 512 * 1024, 1024, 512, 1024, 0, nullptr, ((bf16_t*)(F.ws + WS_WMIX)) + WM_WOB);
    cvt_mat(F, in[20] + (size_t)l * 1048576, 1024, 1024, 1024, 0, nullptr, ((bf16_t*)(F.ws + WS_WMIX)) + WM_WO);
    cvt_mat(F, in[23] + (size_t)l * 1048576, 1024, 1024, 1024, 0, in[21] + l * 1024, ((bf16_t*)(F.ws + WS_WMIX)) + WM_WMQ);
    cvt_mat(F, in[24] + (size_t)l * 1048576, 1024, 1024, 1024, 0, in[22] + l * 1024, ((bf16_t*)(F.ws + WS_WMIX)) + WM_WMK);
    cvt_mat(F, in[25] + (size_t)l * 1048576, 1024, 1024, 1024, 0, in[22] + l * 1024, ((bf16_t*)(F.ws + WS_WMIX)) + WM_WMV);
    cvt_mat(F, in[26] + (size_t)l * 1048576, 1024, 1024, 1024, 0, nullptr, ((bf16_t*)(F.ws + WS_WMIX)) + WM_WMO);
    const float* win = in[10] + (size_t)l * 1024 * 5656; const float* g = in[9] + l * 1024;
    for (int i = F.cb * 512 + F.tid; i < 32 * 1024; i += F.cn * 512) {
        const int n = i >> 10, k = i & 1023;
        float v = 0.f;
        if (n < 8) v = win[(size_t)k * 5656 + 1536 + n] * g[k]; else if (n < 24) v = win[(size_t)k * 5656 + 3080 + (n - 8)] * g[k];
        ((bf16_t*)(F.ws + WS_WMIX))[WM_WSM + i] = (bf16_t)(pk2(v, 0.f) & 0xffff);
    }
}
DEV void cvt_ffn(const Frame& F, int l) {
    cvt_mat(F, F.in[28] + (size_t)l * 1024 * 5632, 5632, 1024, 5632, 2, F.in[27] + l * 1024, ((bf16_t*)(F.ws + WS_WFFN)) + WF_UP);
    cvt_mat(F, F.in[31] + (size_t)l * 2816 * 1024, 1024, 2816, 1024, 0, nullptr, ((bf16_t*)(F.ws + WS_WFFN)) + WF_DN);
}

DEV void phase0(const Frame& F0) {
    REFRAME;
    const int gw = F.bid * 8 + F.wid, nw = F.nb * 8, lane = F.lane;
    for (int row = gw; row < TT + 4096; row += nw) {
        const bool ismem = row >= TT;
        const float* src = ismem ? F.in[8] + (size_t)(row - TT) * 1024 : (row < 32768 ? F.in[0] + (size_t)row * 1024 : F.in[1] + (size_t)(row - 32768) * 1024);
        f32x4 v[4]; float s = 0.f;
#pragma unroll
        for (int i = 0; i < 4; ++i) { v[i] = *(const f32x4*)(src + lane * 16 + i * 4); s += v[i][0] * v[i][0] + v[i][1] * v[i][1] + v[i][2] * v[i][2] + v[i][3] * v[i][3]; }
        u32x4 w0, w1;
        w0.x = pk2(v[0][0], v[0][1]); w0.y = pk2(v[0][2], v[0][3]); w0.z = pk2(v[1][0], v[1][1]); w0.w = pk2(v[1][2], v[1][3]);
        w1.x = pk2(v[2][0], v[2][1]); w1.y = pk2(v[2][2], v[2][3]); w1.z = pk2(v[3][0], v[3][1]); w1.w = pk2(v[3][2], v[3][3]);
        s += __shfl_xor(s, 1); s += __shfl_xor(s, 2);
        if (!ismem) {
            float* X = F.out + (size_t)row * 1024 + lane * 16;
#pragma unroll
            for (int i = 0; i < 4; ++i) *(f32x4*)(X + i * 4) = v[i];
            bf16_t* xb = ((bf16_t*)(F.ws + WS_XB)) + (size_t)row * 1024 + lane * 16;
            *(u32x4*)xb = w0; *(u32x4*)(xb + 8) = w1;
            if ((lane & 3) == 0) ((float*)(F.ws + WS_SSQ))[((size_t)(lane >> 4) * TT + row) * 4 + ((lane >> 2) & 3)] = s;
        } else {
            const int mr = row - TT;
            bf16_t* mb = ((bf16_t*)(F.ws + WS_MB)) + (size_t)mr * 1024 + lane * 16;
            *(u32x4*)mb = w0; *(u32x4*)(mb + 8) = w1;
            s += __shfl_xor(s, 4); s += __shfl_xor(s, 8); s += __shfl_xor(s, 16); s += __shfl_xor(s, 32);
            if (lane == 0) ((float*)(F.ws + WS_MRS))[mr] = rsqrtf(s * (1.f / 1024.f) + 1e-6f);
        }
    }
    cvt_mixer(F, 0);
    cvt_ffn(F, 0);
}

DEV void small_proj(const Frame& F0) {
    REFRAME;
    const int lane = F.lane, fr = lane & 15, fq = lane >> 4, mt = F.wid & 3, nt = F.wid >> 2;
    const bool part = F.nb == 256;
    if (part && (F.bid >> 3) < 6) return;
    for (int c = part ? ((F.bid >> 3) - 6) * 8 + (F.bid & 7) : F.bid; c < NCH; c += part ? 208 : F.nb) {
        const int row = c * 64 + mt * 16 + fr;
        const bf16_t* a = ((bf16_t*)(F.ws + WS_XB)) + (size_t)row * 1024 + 8 * fq;
        const bf16_t* b = ((bf16_t*)(F.ws + WS_WMIX)) + WM_WSM + (size_t)(nt * 16 + fr) * 1024 + 8 * fq;
        f32x4 acc = {0.f, 0.f, 0.f, 0.f};
#pragma unroll 4
        for (int k = 0; k < 32; ++k) acc = MFMA16(*(const bf16x8*)(b + k * 32), *(const bf16x8*)(a + k * 32), acc);
        const float rs = row_rstd(((float*)(F.ws + WS_SSQ)), row);
        *(f32x4*)(((float*)(F.ws + WS_SC)) + (size_t)row * 32 + nt * 16 + 4 * fq) = acc * rs;
    }
}

DEV void gemm_epilogue(const Frame& F0, const GDesc& d, int l, f32x4 (&acc)[2][2][4][2]) {
    REFRAME;
    int lane_ = F.lane; asm volatile("" : "+v"(lane_));
    const int wr = F.wid >> 2, wc = F.wid & 3, fr = lane_ & 15, fq = lane_ >> 4;
    float* red = (float*)(F.lds + 131072);
    if (d.epi == EPI_SOFTMAX) {
        float mx[2][4];
#pragma unroll
        for (int ai = 0; ai < 2; ++ai)
#pragma unroll
            for (int m = 0; m < 4; ++m) {
                float v = -3.0e38f;
#pragma unroll
                for (int bj = 0; bj < 2; ++bj)
#pragma unroll
                    for (int n = 0; n < 2; ++n) { const f32x4 x = acc[ai][bj][m][n]; v = fmaxf(v, fmaxf(fmaxf(x[0], x[1]), fmaxf(x[2], x[3]))); }
                v = fmaxf(v, __shfl_xor(v, 16)); v = fmaxf(v, __shfl_xor(v, 32));
                if (fq == 0) red[(ai * 128 + wr * 64 + m * 16 + fr) * 4 + wc] = v;
            }
        __syncthreads();
#pragma unroll
        for (int ai = 0; ai < 2; ++ai)
#pragma unroll
            for (int m = 0; m < 4; ++m) {
                const f32x4 r4 = *(const f32x4*)(red + (ai * 128 + wr * 64 + m * 16 + fr) * 4);
                const float rm = fmaxf(fmaxf(r4[0], r4[1]), fmaxf(r4[2], r4[3]));
                mx[ai][m] = rm; float s = 0.f;
#pragma unroll
                for (int bj = 0; bj < 2; ++bj)
#pragma unroll
                    for (int n = 0; n < 2; ++n) { f32x4 x = acc[ai][bj][m][n];
#pragma unroll
                        for (int j = 0; j < 4; ++j) { x[j] = __expf(x[j] - rm); s += x[j]; }
                        acc[ai][bj][m][n] = x; }
                s += __shfl_xor(s, 16); s += __shfl_xor(s, 32);
                if (fq == 0) red[1024 + (ai * 128 + wr * 64 + m * 16 + fr) * 4 + wc] = s;
            }
        (void)mx;
        __syncthreads();
#pragma unroll
        for (int ai = 0; ai < 2; ++ai)
#pragma unroll
            for (int m = 0; m < 4; ++m) {
                const f32x4 r4 = *(const f32x4*)(red + 1024 + (ai * 128 + wr * 64 + m * 16 + fr) * 4);
                const float inv = 1.f / ((r4[0] + r4[1]) + (r4[2] + r4[3]));
                const bool valid = d.vai < 0 || (d.vai == ai && d.vwr == wr);
                const int row = d.orow + ai * 128 + wr * 64 + m * 16 + fr;
                if (valid) {
#pragma unroll
                    for (int bj = 0; bj < 2; ++bj)
#pragma unroll
                        for (int n = 0; n < 2; ++n) {
                            const int col = bj * 128 + wc * 32 + n * 16 + fq * 4;
                            *(u32x2*)(((bf16_t*)(F.ws + WS_P)) + (size_t)row * LDP + C_PR + d.head * 256 + col) = pk4(acc[ai][bj][m][n] * inv);
                        }
                }
            }
        __syncthreads();
        return;
    }
#pragma unroll
    for (int ai = 0; ai < 2; ++ai)
#pragma unroll
        for (int m = 0; m < 4; ++m) {
            const int row = d.orow + ai * 128 + wr * 64 + m * 16 + fr;
            float rs = 1.f, ss = 0.f;
            if (d.epi == EPI_PROJ || d.epi == EPI_UP || d.epi == EPI_Q) rs = row_rstd(((float*)(F.ws + WS_SSQ)), row);
            if (d.epi == EPI_Q) rs *= 0.0625f;
            if (d.epi == EPI_MEMK) rs = ((float*)(F.ws + WS_MRS))[row];
#pragma unroll
            for (int bj = 0; bj < 2; ++bj)
#pragma unroll
                for (int n = 0; n < 2; ++n) {
                    const int col = d.ocol + bj * 128 + wc * 32 + n * 16 + fq * 4;
                    f32x4 v = acc[ai][bj][m][n];
                    switch (d.epi) {
                    case EPI_UP: {
                        const int row_l = ai * 128 + wr * 64 + m * 16 + fr, cl = bj * 128 + wc * 32 + n * 16 + fq * 4;
                        *(u32x2*)((bf16_t*)F.lds + row_l * 264 + cl) = pk4(v * rs);
                    } break;
                    case EPI_PROJ: {
                        v = v * rs; const u32x2 w = pk4(v);
                        *(u32x2*)(((bf16_t*)(F.ws + WS_P)) + (size_t)row * LDP + col) = w;
                        if (m == 3 && fr >= 13 && col < 1536) {
                            const int chunk = row >> 6, hr = fr - 13;
                            *(u32x2*)(((bf16_t*)(F.ws + WS_KV)) + ((size_t)chunk * 3 + hr) * 1536 + col) = w;
                            if (chunk >= 512 || (chunk & 31) == 31) {
                                float* o = chunk < 512 ? F.out + O_GDNC_P + ((size_t)(l * 16 + (chunk >> 5)) * 3 + hr) * 1536 + col
                                                       : F.out + O_GDNC_S + ((size_t)(l * 8 + (chunk - 512)) * 3 + hr) * 1536 + col;
                                *(f32x4*)o = v;
                            }
                        }
                    } break;
                    case EPI_RESID: {
                        float* X = F.out + (size_t)row * 1024 + col;
                        f32x4 x = *(const f32x4*)X; x = x + v; *(f32x4*)X = x;
                        *(u32x2*)(((bf16_t*)(F.ws + WS_XB)) + (size_t)row * 1024 + col) = pk4(x);
                        ss += (x[0] * x[0] + x[1] * x[1]) + (x[2] * x[2] + x[3] * x[3]);
                    } break;
                    case EPI_Q: *(u32x2*)(((bf16_t*)(F.ws + WS_P)) + (size_t)row * LDP + C_Q + col) = pk4(v * rs); break;
                    case EPI_MEMK: {
                        v = v * rs;
                        *(f32x4*)(F.out + O_MEMK + ((size_t)l * 4096 + row) * 1024 + col) = v;
                        *(u32x2*)(((bf16_t*)(F.ws + WS_KV)) + (size_t)row * 1024 + col) = pk4(v);
                    } break;
                    case EPI_MEMV: {
                        const f32x4 r4 = *(const f32x4*)(((float*)(F.ws + WS_MRS)) + col);
                        v = v * r4;
                        float* o = F.out + O_MEMV + ((size_t)l * 4096 + col) * 1024 + row;
                        o[0] = v[0]; o[1024] = v[1]; o[2048] = v[2]; o[3072] = v[3];
                        const int b = col >> 8, h = row >> 8;
                        *(u32x2*)(((bf16_t*)(F.ws + WS_KV + 6144ull * 1024 * 2)) + ((size_t)(b * 4 + h) * 256 + (row & 255)) * 256 + (col & 255)) = pk4(v);
                    } break;
                    case EPI_OUTA: {
                        const f32x4 g = unpk4(*(const u32x2*)(((bf16_t*)(F.ws + WS_P)) + (size_t)row * LDP + C_GA + col));
                        f32x4 o; for (int j = 0; j < 4; ++j) o[j] = sigm(g[j]) * v[j];
                        *(u32x2*)(((bf16_t*)(F.ws + WS_P)) + (size_t)row * LDP + C_MRG + col) = pk4(o);
                    } break;
                    case EPI_OUTB: {
                        const f32x4 g = unpk4(*(const u32x2*)(((bf16_t*)(F.ws + WS_P)) + (size_t)row * LDP + C_GB + col));
                        f32x4 o = unpk4(*(const u32x2*)(((bf16_t*)(F.ws + WS_P)) + (size_t)row * LDP + C_MRG + col));
                        for (int j = 0; j < 4; ++j) o[j] += sigm(g[j]) * v[j];
                        *(u32x2*)(((bf16_t*)(F.ws + WS_P)) + (size_t)row * LDP + C_MRG + col) = pk4(o);
                    } break;
                    case EPI_ATTNO: {
                        const bool valid = d.vai < 0 || (d.vai == ai && d.vwr == wr);
                        if (valid) *(u32x2*)(((bf16_t*)(F.ws + WS_P)) + (size_t)row * LDP + C_O + d.head * 256 + col) = pk4(v);
                    } break;
                    default: break;
                    }
                }
            if (d.epi == EPI_RESID) {
                ss += __shfl_xor(ss, 16); ss += __shfl_xor(ss, 32);
                if (fq == 0) ((float*)(F.ws + WS_SSQ))[((size_t)(d.ocol >> 8) * TT + row) * 4 + wc] = ss;
            }
        }
    if (d.epi == EPI_UP) {
        bf16_t* ST = (bf16_t*)F.lds;
        const int pm = d.brow >> 8, pn = d.bcol >> 8;
        const bool samp = pm >= 128, needfix = !samp && (pm & 7) != 0;
        bf16_t* halo = ((bf16_t*)(F.ws + WS_KV)); bf16_t* raw01 = ((bf16_t*)(F.ws + WS_KV + 11714560ull));
        __syncthreads();
        {
            const int hsel = F.tid >> 6, cl4 = (F.tid & 63) * 4, ocol = ((cl4 >> 7) ? 2816 : 0) + 128 * pn + (cl4 & 127);
            const int row_l = (hsel >> 1) * 64 + 62 + (hsel & 1), chunk = (d.brow + row_l) >> 6, hr = hsel & 1;
            const u32x2 w = *(const u32x2*)(ST + row_l * 264 + cl4);
            *(u32x2*)(halo + ((size_t)chunk * 2 + hr) * 5632 + ocol) = w;
            if (chunk >= 512 || (chunk & 31) == 31) {
                float* o = chunk < 512 ? F.out + O_FFNC_P + ((size_t)(l * 16 + (chunk >> 5)) * 2 + hr) * 5632 + ocol
                                       : F.out + O_FFNC_S + ((size_t)(l * 8 + (chunk - 512)) * 2 + hr) * 5632 + ocol;
                *(f32x4*)o = unpk4(w);
            }
            if (needfix && hsel < 2) *(u32x2*)(raw01 + ((size_t)pm * 2 + hsel) * 5632 + ocol) = *(const u32x2*)(ST + hsel * 264 + cl4);
        }
        {
            const int cq = F.tid & 31, rg = F.tid >> 5, c4 = cq * 4, gcol = 128 * pn + c4, r0 = rg * 16;
            const float* cw = F.in[29] + (size_t)l * 3 * 5632; const float* cb = F.in[30] + (size_t)l * 5632;
            const f32x4 wg0 = *(const f32x4*)(cw + gcol), wg1 = *(const f32x4*)(cw + 5632 + gcol), wg2 = *(const f32x4*)(cw + 2 * 5632 + gcol), bg = *(const f32x4*)(cb + gcol);
            const f32x4 wv0 = *(const f32x4*)(cw + 2816 + gcol), wv1 = *(const f32x4*)(cw + 5632 + 2816 + gcol), wv2 = *(const f32x4*)(cw + 2 * 5632 + 2816 + gcol), bv = *(const f32x4*)(cb + 2816 + gcol);
            f32x4 g2 = {0.f, 0.f, 0.f, 0.f}, g1 = g2, v2 = g2, v1 = g2; bool skip2 = false;
            if ((samp ? (r0 & 63) : r0) != 0) {
                g2 = unpk4(*(const u32x2*)(ST + (r0 - 2) * 264 + c4)); g1 = unpk4(*(const u32x2*)(ST + (r0 - 1) * 264 + c4));
                v2 = unpk4(*(const u32x2*)(ST + (r0 - 2) * 264 + 128 + c4)); v1 = unpk4(*(const u32x2*)(ST + (r0 - 1) * 264 + 128 + c4));
            } else if (samp) {
                const float* sp = F.in[5] + (size_t)(l * 8 + (((d.brow + r0) >> 6) - 512)) * 2 * 5632;
                g2 = *(const f32x4*)(sp + gcol); g1 = *(const f32x4*)(sp + 5632 + gcol); v2 = *(const f32x4*)(sp + 2816 + gcol); v1 = *(const f32x4*)(sp + 5632 + 2816 + gcol);
            } else skip2 = needfix;
#pragma unroll 4
            for (int i = 0; i < 16; ++i) {
                const int row_l = r0 + i;
                const f32x4 g0 = unpk4(*(const u32x2*)(ST + row_l * 264 + c4)), v0 = unpk4(*(const u32x2*)(ST + row_l * 264 + 128 + c4));
                f32x4 o;
#pragma unroll
                for (int j = 0; j < 4; ++j) { const float yg = wg0[j] * g2[j] + wg1[j] * g1[j] + wg2[j] * g0[j] + bg[j], yv = wv0[j] * v2[j] + wv1[j] * v1[j] + wv2[j] * v0[j] + bv[j]; o[j] = silu(yg) * yv; }
                if (!(skip2 && i < 2)) *(u32x2*)(((bf16_t*)(F.ws + WS_P)) + (size_t)(d.brow + row_l) * LDP + gcol) = pk4(o);
                g2 = g1; g1 = g0; v2 = v1; v1 = v0;
            }
        }
        __syncthreads();
    }
}

DEV void sample_rows_gemm(const Frame& F0, const bf16_t* A, int lda, const bf16_t* Bt, int K, int resid) {
    REFRAME;
    if (F.nb != 256) return;
    const int fr = F.lane & 15, fq = F.lane >> 4, w = F.wid, rgp = F.bid >> 3, cg = F.bid & 7;
    const int row = 32768 + rgp * 16 + fr, colt = cg * 128 + w * 16;
    const bf16_t* ap = A + (size_t)row * lda + 8 * fq;
    const bf16_t* bp = Bt + (size_t)(colt + fr) * K + 8 * fq;
    f32x4 acc = {0.f, 0.f, 0.f, 0.f};
#pragma unroll 8
    for (int k = 0; k < K; k += 32) acc = MFMA16(*(const bf16x8*)(bp + k), *(const bf16x8*)(ap + k), acc);
    const int col = colt + 4 * fq;
    if (resid == 1) {
        float* X = F.out + (size_t)row * 1024 + col;
        f32x4 x = *(const f32x4*)X; x = x + acc; *(f32x4*)X = x;
        *(u32x2*)(((bf16_t*)(F.ws + WS_XB)) + (size_t)row * 1024 + col) = pk4(x);
        float ss = (x[0] * x[0] + x[1] * x[1]) + (x[2] * x[2] + x[3] * x[3]);
        ss += __shfl_xor(ss, 16); ss += __shfl_xor(ss, 32);
        float* red = (float*)F.lds;
        __syncthreads();
        if (fq == 0) red[fr * 8 + w] = ss;
        __syncthreads();
        if (F.tid < 32) {
            const int r = F.tid & 15, g = F.tid >> 4, c0 = cg * 128 + g * 64;
            const float t = (red[r * 8 + g * 4] + red[r * 8 + g * 4 + 1]) + (red[r * 8 + g * 4 + 2] + red[r * 8 + g * 4 + 3]);
            ((float*)(F.ws + WS_SSQ))[((size_t)(c0 >> 8) * TT + 32768 + rgp * 16 + r) * 4 + ((c0 >> 6) & 3)] = t;
        }
        __syncthreads();
    } else if (resid == 0) {
        const float rs = row_rstd(((float*)(F.ws + WS_SSQ)), row) * 0.0625f;
        *(u32x2*)(((bf16_t*)(F.ws + WS_P)) + (size_t)row * LDP + C_Q + col) = pk4(acc * rs);
    } else {
        bf16_t* prow = ((bf16_t*)(F.ws + WS_P)) + (size_t)row * LDP;
        const f32x4 g = unpk4(*(const u32x2*)(prow + (resid == 2 ? C_GA : C_GB) + col));
        f32x4 o = {0.f, 0.f, 0.f, 0.f};
        if (resid == 3) o = unpk4(*(const u32x2*)(prow + C_MRG + col));
#pragma unroll
        for (int j = 0; j < 4; ++j) o[j] += sigm(g[j]) * acc[j];
        *(u32x2*)(prow + C_MRG + col) = pk4(o);
    }
}

enum { GP_IN = 0, GP_OUT, GP_WO, GP_MQ, GP_ATTN, GP_MO, GP_UP, GP_DOWN, GP_ATTN2, GP_OUT2, GP_MEMKV };
DEV void gemm_phase(const Frame& F0, int kind, int l) {
    REFRAME;
    int nunits = 0;
    switch (kind) { case GP_IN: case GP_UP: nunits = 130 * 22; break; case GP_OUT: nunits = 520 + 128; break; case GP_OUT2: nunits = 520; break; case GP_ATTN: case GP_ATTN2: nunits = 512 + 32; break; default: nunits = 520; }
    const bool srow = (F.nb == 256) && (kind == GP_WO || kind == GP_MQ || kind == GP_MO || kind == GP_DOWN || kind == GP_OUT || kind == GP_OUT2);
    if (srow) nunits = 512;
    if (kind == GP_MEMKV) nunits = 128;
    f32x4 acc[2][2][4][2];
    const bool xmap = (F.nb == 256) && (kind == GP_IN || kind == GP_UP || kind == GP_WO || kind == GP_MQ || kind == GP_MO || kind == GP_DOWN || kind == GP_OUT2 || (kind == GP_OUT && srow));
    const int xcd = F.bid & 7, slot = F.bid >> 3, w_lo = (int)(((long)nunits * xcd) >> 3), w_hi = (int)(((long)nunits * (xcd + 1)) >> 3);
    const bool mkv = kind == GP_MEMKV;
    for (int u0 = mkv ? (F.bid >= 192 ? F.bid - 192 : nunits) : (xmap ? w_lo + slot : F.bid); u0 < (xmap ? w_hi : nunits); u0 += mkv ? 64 : (xmap ? 32 : F.nb)) {
        int u = u0;
        if (xmap) { const int nn = (kind == GP_IN || kind == GP_UP) ? 22 : 4; const int nm = srow ? 128 : 130; const int pn_ = u0 / nm, pm_ = u0 % nm; u = pm_ * nn + pn_; }
        GDesc d;
        { const int sub = (kind == GP_ATTN2 || kind == GP_OUT2) ? 1 : 0;
            d.vai = -1; d.vwr = 0; d.head = 0;
            switch (kind) {
            case GP_IN: { const int pm = u / 22, pn = u % 22; d.A = ((bf16_t*)(F.ws + WS_XB)); d.lda = 1024; d.Bt = ((bf16_t*)(F.ws + WS_WMIX)) + WM_WIN; d.ldb = 1024; d.K = 1024; d.brow = pm * 256; d.bcol = pn * 256; d.epi = EPI_PROJ; d.orow = d.brow; d.ocol = d.bcol; } break;
            case GP_UP: { const int pm = u / 22, pn = u % 22; d.A = ((bf16_t*)(F.ws + WS_XB)); d.lda = 1024; d.Bt = ((bf16_t*)(F.ws + WS_WFFN)) + WF_UP; d.ldb = 1024; d.K = 1024; d.brow = pm * 256; d.bcol = pn * 256; d.epi = EPI_UP; d.orow = d.brow; d.ocol = d.bcol; } break;
            case GP_MEMKV: case GP_OUT: case GP_OUT2:
                if (kind == GP_MEMKV) u += 520;
                if (u < 520) { const int pm = u >> 2, pn = u & 3; d.A = ((bf16_t*)(F.ws + WS_P)) + (sub == 0 ? C_ZA : C_ZB); d.lda = LDP; d.Bt = ((bf16_t*)(F.ws + WS_WMIX)) + (sub == 0 ? WM_WOA : WM_WOB); d.ldb = 512; d.K = 512;
                               d.brow = pm * 256; d.bcol = pn * 256; d.epi = sub == 0 ? EPI_OUTA : EPI_OUTB; d.orow = d.brow; d.ocol = d.bcol; }
                else if (u < 520 + 64) { const int v = u - 520, pm = v >> 2, pn = v & 3; d.A = ((bf16_t*)(F.ws + WS_MB)); d.lda = 1024; d.Bt = ((bf16_t*)(F.ws + WS_WMIX)) + WM_WMK; d.ldb = 1024; d.K = 1024; d.brow = pm * 256; d.bcol = pn * 256; d.epi = EPI_MEMK; d.orow = d.brow; d.ocol = d.bcol; }
                else { const int v = u - 584, pm = v & 3, pn = v >> 2; d.A = ((bf16_t*)(F.ws + WS_WMIX)) + WM_WMV; d.lda = 1024; d.Bt = ((bf16_t*)(F.ws + WS_MB)); d.ldb = 1024; d.K = 1024; d.brow = pm * 256; d.bcol = pn * 256; d.epi = EPI_MEMV; d.orow = d.brow; d.ocol = d.bcol; }
                break;
            case GP_WO: { const int pm = u >> 2, pn = u & 3; d.A = ((bf16_t*)(F.ws + WS_P)) + C_MRG; d.lda = LDP; d.Bt = ((bf16_t*)(F.ws + WS_WMIX)) + WM_WO; d.ldb = 1024; d.K = 1024; d.brow = pm * 256; d.bcol = pn * 256; d.epi = EPI_RESID; d.orow = d.brow; d.ocol = d.bcol; } break;
            case GP_MQ: { const int pm = u >> 2, pn = u & 3; d.A = ((bf16_t*)(F.ws + WS_XB)); d.lda = 1024; d.Bt = ((bf16_t*)(F.ws + WS_WMIX)) + WM_WMQ; d.ldb = 1024; d.K = 1024; d.brow = pm * 256; d.bcol = pn * 256; d.epi = EPI_Q; d.orow = d.brow; d.ocol = d.bcol; } break;
            case GP_MO: { const int pm = u >> 2, pn = u & 3; d.A = ((bf16_t*)(F.ws + WS_P)) + C_O; d.lda = LDP; d.Bt = ((bf16_t*)(F.ws + WS_WMIX)) + WM_WMO; d.ldb = 1024; d.K = 1024; d.brow = pm * 256; d.bcol = pn * 256; d.epi = EPI_RESID; d.orow = d.brow; d.ocol = d.bcol; } break;
            case GP_DOWN: { const int pm = u >> 2, pn = u & 3; d.A = ((bf16_t*)(F.ws + WS_P)); d.lda = LDP; d.Bt = ((bf16_t*)(F.ws + WS_WFFN)) + WF_DN; d.ldb = 2816; d.K = 2816; d.brow = pm * 256; d.bcol = pn * 256; d.epi = EPI_RESID; d.orow = d.brow; d.ocol = d.bcol; } break;
            case GP_ATTN: case GP_ATTN2: {
                int pm, h, b;
                if (u < 512) { pm = u >> 2; h = u & 3; b = pm >> 3; }
                else { const int v = u - 512; h = v & 3; const int bi = (v >> 2) & 3, t = v >> 4; pm = 128 + t; b = 16 + 4 * t + bi; d.vai = bi >> 1; d.vwr = bi & 1; }
                d.head = h; d.brow = pm * 256; d.orow = d.brow; d.ocol = 0; d.K = 256; d.bcol = 0;
                if (sub == 0) { d.A = ((bf16_t*)(F.ws + WS_P)) + C_Q + h * 256; d.lda = LDP; d.Bt = ((bf16_t*)(F.ws + WS_KV)) + (size_t)b * 256 * 1024 + h * 256; d.ldb = 1024; d.epi = EPI_SOFTMAX; }
                else { d.A = ((bf16_t*)(F.ws + WS_P)) + C_PR + h * 256; d.lda = LDP; d.Bt = ((bf16_t*)(F.ws + WS_KV + 6144ull * 1024 * 2)) + (size_t)(b * 4 + h) * 65536; d.ldb = 256; d.epi = EPI_ATTNO; }
            } break;
            }
        }
        gemm_core(d.A, d.lda, d.Bt, d.ldb, d.K, d.brow, d.bcol, acc, (bf16_t*)F.lds);
        gemm_epilogue(F, d, l, acc);
    }
    if (srow) {
        __syncthreads();
        if (kind == GP_WO) sample_rows_gemm(F, ((bf16_t*)(F.ws + WS_P)) + C_MRG, LDP, ((bf16_t*)(F.ws + WS_WMIX)) + WM_WO, 1024, 1);
        else if (kind == GP_MQ) sample_rows_gemm(F, ((bf16_t*)(F.ws + WS_XB)), 1024, ((bf16_t*)(F.ws + WS_WMIX)) + WM_WMQ, 1024, 0);
        else if (kind == GP_OUT) sample_rows_gemm(F, ((bf16_t*)(F.ws + WS_P)) + C_ZA, LDP, ((bf16_t*)(F.ws + WS_WMIX)) + WM_WOA, 512, 2);
        else if (kind == GP_OUT2) sample_rows_gemm(F, ((bf16_t*)(F.ws + WS_P)) + C_ZB, LDP, ((bf16_t*)(F.ws + WS_WMIX)) + WM_WOB, 512, 3);
        else if (kind == GP_MO) sample_rows_gemm(F, ((bf16_t*)(F.ws + WS_P)) + C_O, LDP, ((bf16_t*)(F.ws + WS_WMIX)) + WM_WMO, 1024, 1);
        else sample_rows_gemm(F, ((bf16_t*)(F.ws + WS_P)), LDP, ((bf16_t*)(F.ws + WS_WFFN)) + WF_DN, 2816, 1);
    }
}

DEV void sample_kv(const Frame& F0, int l) {
    REFRAME;
    const float* ck = F.in[6] + (size_t)l * 2097152; const float* cv = F.in[7] + (size_t)l * 2097152;
    const bool idle = F.nb == 256;
    if (idle && F.bid < 192) return;
    for (int i = (idle ? F.bid - 192 : F.bid) * 512 + F.tid; i < 262144; i += (idle ? 64 : F.nb) * 512) {
        const f32x4 a = *(const f32x4*)(ck + (size_t)i * 8), b = *(const f32x4*)(ck + (size_t)i * 8 + 4);
        u32x4 w; w.x = pk2(a[0], a[1]); w.y = pk2(a[2], a[3]); w.z = pk2(b[0], b[1]); w.w = pk2(b[2], b[3]);
        *(u32x4*)(((bf16_t*)(F.ws + WS_KV)) + 4096ull * 1024 + (size_t)i * 8) = w;
        const int dd = i & 255, m8 = (i >> 8) & 31, h = (i >> 13) & 3, bb = i >> 15;
        const float* s = cv + ((size_t)(bb * 256 + m8 * 8) * 4 + h) * 256 + dd;
        u32x4 x; x.x = pk2(s[0], s[1024]); x.y = pk2(s[2048], s[3072]); x.z = pk2(s[4096], s[5120]); x.w = pk2(s[6144], s[7168]);
        *(u32x4*)(((bf16_t*)(F.ws + WS_KV + 6144ull * 1024 * 2)) + ((size_t)((16 + bb) * 4 + h) * 256 + dd) * 256 + m8 * 8) = x;
    }
}

DEV void g1_gdn(const Frame& F0, int l, int c, int h) {
    REFRAME;
    float* Fq = (float*)F.lds;
    bf16_t* VS = (bf16_t*)(F.lds + 66560);
    bf16_t* QN = (bf16_t*)(F.lds + 82944);
    bf16_t* KN = (bf16_t*)(F.lds + 100352);
    float* AM = (float*)(F.lds + 117760);
    float* sB = (float*)(F.lds + 135168); float* sG = sB + 64; float* sRQ = sB + 128; float* sRK = sB + 192;
    const int tid = F.tid, lane = F.lane, t0 = c * 64;
    const bool first = c >= 512 || (c & 31) == 0; const bool sample = c >= 512;
    __syncthreads();
    if (F.wid == 0) {
        const int t = t0 + lane;
        const float braw = ((float*)(F.ws + WS_SC))[(size_t)t * 32 + h], araw = ((float*)(F.ws + WS_SC))[(size_t)t * 32 + 4 + h];
        const float beta = sigm(braw);
        float g = -__expf(F.in[12][l * 4 + h]) * softplus(araw + F.in[13][l * 4 + h]);
#pragma unroll
        for (int off = 1; off < 64; off <<= 1) { const float n = __shfl_up(g, off); if (lane >= off) g += n; }
        sB[lane] = beta; sG[lane] = g;
        if (!F.dry) ((float*)(F.ws + WS_BG))[((size_t)c * 4 + h) * 128 + lane] = beta; if (!F.dry) ((float*)(F.ws + WS_BG))[((size_t)c * 4 + h) * 128 + 64 + lane] = g;
    }
    __syncthreads();
    const float* cw = F.in[11] + (size_t)l * 4 * 1536;
    if (tid < 384) {
        const int cp = tid % 192, rh = tid / 192, which = cp >> 6, cc = (cp & 63) * 2, pcol = which * 512 + h * 128 + cc;
        const f32x2 w0 = *(const f32x2*)(cw + pcol), w1 = *(const f32x2*)(cw + 1536 + pcol), w2 = *(const f32x2*)(cw + 2 * 1536 + pcol), w3 = *(const f32x2*)(cw + 3 * 1536 + pcol);
        float x0[35], x1[35];
#pragma unroll
        for (int i = 0; i < 3; ++i) {
            x0[i] = 0.f; x1[i] = 0.f;
            if (rh == 1) { const unsigned u = *(const unsigned*)(((bf16_t*)(F.ws + WS_P)) + (size_t)(t0 + 29 + i) * LDP + pcol); x0[i] = bflo(u); x1[i] = bfhi(u); }
            else if (!first) { const unsigned u = *(const unsigned*)(((bf16_t*)(F.ws + WS_KV)) + ((size_t)(c - 1) * 3 + i) * 1536 + pcol); x0[i] = bflo(u); x1[i] = bfhi(u); }
            else if (sample) { const f32x2 f = *(const f32x2*)(F.in[3] + ((size_t)(l * 8 + (c - 512)) * 3 + i) * 1536 + pcol); x0[i] = f[0]; x1[i] = f[1]; }
        }
#pragma unroll
        for (int i = 0; i < 32; ++i) { const unsigned u = *(const unsigned*)(((bf16_t*)(F.ws + WS_P)) + (size_t)(t0 + 32 * rh + i) * LDP + pcol); x0[3 + i] = bflo(u); x1[3 + i] = bfhi(u); }
#pragma unroll
        for (int r = 0; r < 32; ++r) {
            float a0 = w0[0] * x0[r] + w1[0] * x0[r + 1] + w2[0] * x0[r + 2] + w3[0] * x0[r + 3];
            float a1 = w0[1] * x1[r] + w1[1] * x1[r + 1] + w2[1] * x1[r + 2] + w3[1] * x1[r + 3];
            a0 = silu(a0); a1 = silu(a1);
            const int rr = 32 * rh + r;
            if (which < 2) { *(f32x2*)(Fq + rr * 260 + which * 128 + cc) = (f32x2){a0, a1}; }
            else { const float be = sB[rr]; *(unsigned*)(VS + rr * 128 + cc) = pk2(a0 * be, a1 * be); }
        }
    }
    __syncthreads();
    {
        const int r = tid >> 3, j = tid & 7; const float* p = Fq + r * 260 + j * 32; float s = 0.f;
#pragma unroll
        for (int i = 0; i < 32; ++i) s += p[i] * p[i];
        s += __shfl_xor(s, 1); s += __shfl_xor(s, 2);
        if ((j & 3) == 0) { if (j == 0) sRQ[r] = rsqrtf(s + 1e-6f) * 0.08838834764831845f; else sRK[r] = rsqrtf(s + 1e-6f); }
    }
    __syncthreads();
    for (int idx = tid; idx < 64 * 64; idx += 512) {
        const int r = idx >> 6, c4 = (idx & 63) * 4; const bool isq = c4 < 128;
        f32x4 v = *(const f32x4*)(Fq + r * 260 + c4); v = v * (isq ? sRQ[r] : sRK[r]);
        const u32x2 w = pk4(v);
        if (isq) { *(u32x2*)(QN + r * 136 + c4) = w; if (!F.dry) *(u32x2*)(((bf16_t*)(F.ws + WS_P)) + (size_t)(t0 + r) * LDP + C_QA + h * 128 + c4) = w; }
        else { *(u32x2*)(KN + r * 136 + c4 - 128) = w; if (!F.dry) *(u32x2*)(((bf16_t*)(F.ws + WS_P)) + (size_t)(t0 + r) * LDP + C_KA + h * 128 + c4 - 128) = w; }
    }
    for (int idx = tid; idx < 64 * 32; idx += 512) {
        const int r = idx >> 5, c4 = (idx & 31) * 4;
        if (!F.dry) *(u32x2*)(((bf16_t*)(F.ws + WS_P)) + (size_t)(t0 + r) * LDP + C_VA + h * 128 + c4) = *(const u32x2*)(VS + r * 128 + c4);
    }
    __syncthreads();
    {
        const int fr = lane & 15, fq = lane >> 4, which = F.wid >> 2, it = F.wid & 3;
        const bf16_t* X = which ? QN : KN;
        const int crow = 16 * it + fr; const float gc = sG[crow], bc = sB[crow];
        for (int jt = 0; jt < 4; ++jt) {
            f32x4 a = {0.f, 0.f, 0.f, 0.f};
            if (jt <= it) {
#pragma unroll
                for (int ks = 0; ks < 4; ++ks) a = MFMA16(ldfrag(KN, 16 * jt + fr, 136, 32 * ks, fq), ldfrag(X, crow, 136, 32 * ks, fq), a);
            }
            f32x4 o;
#pragma unroll
            for (int j = 0; j < 4; ++j) {
                const int s = 16 * jt + 4 * fq + j;
                const bool keep = which ? (s <= crow) : (s < crow);
                const float dec = keep ? __expf(gc - sG[s]) : 0.f;
                o[j] = a[j] * dec * (which ? 1.f : bc);
            }
            if (which) { if (!F.dry) *(u32x2*)(((bf16_t*)(F.ws + WS_XB)) + (size_t)(t0 + crow) * LDE + h * 128 + 64 + 16 * jt + 4 * fq) = pk4(o); }
            else *(f32x4*)(AM + crow * 68 + 16 * jt + 4 * fq) = o;
        }
    }
    __syncthreads();
    {
        float* TF = (float*)F.lds;
        float* MS = (float*)(F.lds + 20480);
        const int w = F.wid;
        if (w == 0) {
            const int blk = lane >> 4, cc = lane & 15, base = blk * 16;
            float Tc[16];
#pragma unroll
            for (int i = 0; i < 16; ++i) {
                float a = (i == cc) ? 1.f : 0.f;
#pragma unroll
                for (int j = 0; j < i; ++j) a -= AM[(base + i) * 68 + base + j] * Tc[j];
                Tc[i] = a;
            }
#pragma unroll
            for (int i = 0; i < 16; ++i) TF[(base + i) * 68 + base + cc] = Tc[i];
        }
        __syncthreads();
#pragma unroll 1
        for (int dd = 1; dd < 4; ++dd) {
            if (w < 4 - dd) {
                const int I = w + dd, J = w, r = lane >> 2, c4 = (lane & 3) * 4;
                f32x4 mm = {0.f, 0.f, 0.f, 0.f};
                for (int K = J; K < I; ++K)
#pragma unroll
                    for (int k = 0; k < 16; ++k) { const float a = AM[(I * 16 + r) * 68 + K * 16 + k]; const f32x4 t = *(const f32x4*)(TF + (K * 16 + k) * 68 + J * 16 + c4); mm = mm + a * t; }
                float* ms = MS + w * 256;
                *(f32x4*)(ms + r * 16 + c4) = mm;
                asm volatile("s_waitcnt lgkmcnt(0)" ::: "memory");
                f32x4 o = {0.f, 0.f, 0.f, 0.f};
#pragma unroll
                for (int k = 0; k < 16; ++k) { const float a = TF[(I * 16 + r) * 68 + I * 16 + k]; const f32x4 t = *(const f32x4*)(ms + k * 16 + c4); o = o - a * t; }
                *(f32x4*)(TF + (I * 16 + r) * 68 + J * 16 + c4) = o;
            }
            __syncthreads();
        }
        {
            const int r = tid >> 3, c8 = (tid & 7) * 8; const bool z = (c8 >> 4) > (r >> 4);
            const f32x4 a = z ? (f32x4){0.f, 0.f, 0.f, 0.f} : *(const f32x4*)(TF + r * 68 + c8), b = z ? (f32x4){0.f, 0.f, 0.f, 0.f} : *(const f32x4*)(TF + r * 68 + c8 + 4);
            u32x4 o; o.x = pk2(a[0], a[1]); o.y = pk2(a[2], a[3]); o.z = pk2(b[0], b[1]); o.w = pk2(b[2], b[3]);
            if (!F.dry) *(u32x4*)(((bf16_t*)(F.ws + WS_XB)) + (size_t)(t0 + r) * LDE + h * 128 + c8) = o;
        }
    }
}

DEV void g1_gla(const Frame& F0, int l, int c, int h) {
    REFRAME;
    float* GL = (float*)F.lds;
    float* LA = (float*)(F.lds + 4096);
    bf16_t* QG = (bf16_t*)(F.lds + 20736);
    bf16_t* KI = (bf16_t*)(F.lds + 29952);
    const int tid = F.tid, lane = F.lane, t0 = c * 64;
    __syncthreads();
    if (tid < 256) { const int r = tid >> 2, q4 = (tid & 3) * 4; *(f32x4*)(GL + r * 16 + q4) = *(const f32x4*)(((float*)(F.ws + WS_SC)) + (size_t)(t0 + r) * 32 + 8 + q4); }
    __syncthreads();
    {
        const int dk = tid & 63, rb = tid >> 6;
        float w2[16];
#pragma unroll
        for (int i = 0; i < 16; ++i) w2[i] = F.in[15][(size_t)(l * 16 + i) * 256 + h * 64 + dk];
        const float bias = F.in[16][l * 256 + h * 64 + dk];
#pragma unroll
        for (int rr = 0; rr < 8; ++rr) {
            const int r = rb * 8 + rr; float x = bias;
#pragma unroll
            for (int i = 0; i < 16; ++i) x += GL[r * 16 + i] * w2[i];
            LA[r * 65 + dk] = logsigmoid(x) * 0.0625f;
        }
    }
    __syncthreads();
    if (tid < 64) {
        float g = 0.f;
#pragma unroll 8
        for (int r = 0; r < 64; ++r) { g += LA[r * 65 + tid]; LA[r * 65 + tid] = g; }
        if (!F.dry) ((float*)(F.ws + WS_DL))[((size_t)c * 4 + h) * 64 + tid] = __expf(g);
    }
    __syncthreads();
    for (int idx = tid; idx < 64 * 16; idx += 512) {
        const int r = idx >> 4, c4 = (idx & 15) * 4;
        bf16_t* qp = ((bf16_t*)(F.ws + WS_P)) + (size_t)(t0 + r) * LDP + C_QB + h * 64 + c4; bf16_t* kp = ((bf16_t*)(F.ws + WS_P)) + (size_t)(t0 + r) * LDP + C_KB + h * 64 + c4;
        const f32x4 q = unpk4(*(const u32x2*)qp), k = unpk4(*(const u32x2*)kp);
        f32x4 qg, ki, kg;
#pragma unroll
        for (int j = 0; j < 4; ++j) { const float g = LA[r * 65 + c4 + j], gl = LA[63 * 65 + c4 + j];
            qg[j] = q[j] * 0.125f * __expf(g); ki[j] = k[j] * __expf(-g); kg[j] = k[j] * __expf(gl - g); }
        const u32x2 wq = pk4(qg);
        *(u32x2*)(QG + r * 72 + c4) = wq; *(u32x2*)(KI + r * 72 + c4) = pk4(ki);
        if (!F.dry) *(u32x2*)qp = wq; if (!F.dry) *(u32x2*)kp = pk4(kg);
    }
    __syncthreads();
    {
        const int fr = lane & 15, fq = lane >> 4, it = F.wid >> 1; const int crow = 16 * it + fr;
#pragma unroll
        for (int q = 0; q < 2; ++q) {
            const int jt = (F.wid & 1) * 2 + q;
            f32x4 a = {0.f, 0.f, 0.f, 0.f};
            if (jt <= it) {
#pragma unroll
                for (int ks = 0; ks < 2; ++ks) a = MFMA16(ldfrag(KI, 16 * jt + fr, 72, 32 * ks, fq), ldfrag(QG, crow, 72, 32 * ks, fq), a);
            }
#pragma unroll
            for (int j = 0; j < 4; ++j) if (16 * jt + 4 * fq + j > crow) a[j] = 0.f;
            if (!F.dry) *(u32x2*)(((bf16_t*)(F.ws + WS_XB)) + (size_t)(t0 + crow) * LDE + 512 + h * 64 + 16 * jt + 4 * fq) = pk4(a);
        }
    }
}

DEV void g2_gdn(const Frame& F0, int l, int s, int h) {
    REFRAME;
    bf16_t* QN = (bf16_t*)F.lds;
    bf16_t* KN = (bf16_t*)(F.lds + 17408);
    bf16_t* KT = (bf16_t*)(F.lds + 34816);
    bf16_t* TM = (bf16_t*)(F.lds + 53248);
    bf16_t* AQ = (bf16_t*)(F.lds + 62464);
    float* sB = (float*)(F.lds + 71680); float* sG = sB + 64;
    float* RED = (float*)(F.lds + 72192);
    bf16_t* VV = (bf16_t*)(F.lds + 74240);
    bf16_t* ZZ = (bf16_t*)(F.lds + 91648);
    const int tid = F.tid, lane = F.lane, w = F.wid, fr = lane & 15, fq = lane >> 4;
    const bool sample = s >= 16; const int nchunk = sample ? 1 : 32; const int tbase = sample ? 32768 + (s - 16) * 64 : s * 2048;
    const int dvc = h * 128 + 16 * w + fr;
    f32x4 S[8];
#pragma unroll
    for (int mt = 0; mt < 8; ++mt) {
        if (sample) { const float* sp = F.in[2] + ((size_t)((l * 8 + (s - 16)) * 4 + h) * 128) * 128;
#pragma unroll
            for (int j = 0; j < 4; ++j) S[mt][j] = sp[(size_t)(16 * mt + 4 * fq + j) * 128 + 16 * w + fr]; }
        else S[mt] = (f32x4){0.f, 0.f, 0.f, 0.f};
    }
    const float gn = F.in[14][l * 128 + 16 * w + fr];
    for (int n = 0; n < nchunk; ++n) {
        const int t0 = tbase + n * 64;
        __syncthreads();
#pragma unroll
        for (int i = 0; i < 2; ++i) {
            const int p = tid + 512 * i, r = p >> 4, c8 = (p & 15) * 8;
            const u32x4 q = *(const u32x4*)(((bf16_t*)(F.ws + WS_P)) + (size_t)(t0 + r) * LDP + C_QA + h * 128 + c8);
            const u32x4 k = *(const u32x4*)(((bf16_t*)(F.ws + WS_P)) + (size_t)(t0 + r) * LDP + C_KA + h * 128 + c8);
            *(u32x4*)(QN + r * 136 + c8) = q; *(u32x4*)(KN + r * 136 + c8) = k;
            *(u32x4*)(VV + r * 136 + c8) = *(const u32x4*)(((bf16_t*)(F.ws + WS_P)) + (size_t)(t0 + r) * LDP + C_VA + h * 128 + c8);
            *(u32x4*)(ZZ + r * 136 + c8) = *(const u32x4*)(((bf16_t*)(F.ws + WS_P)) + (size_t)(t0 + r) * LDP + C_ZA + h * 128 + c8);
            KT[(c8 + 0) * 72 + r] = (bf16_t)(k.x & 0xffff); KT[(c8 + 1) * 72 + r] = (bf16_t)(k.x >> 16);
            KT[(c8 + 2) * 72 + r] = (bf16_t)(k.y & 0xffff); KT[(c8 + 3) * 72 + r] = (bf16_t)(k.y >> 16);
            KT[(c8 + 4) * 72 + r] = (bf16_t)(k.z & 0xffff); KT[(c8 + 5) * 72 + r] = (bf16_t)(k.z >> 16);
            KT[(c8 + 6) * 72 + r] = (bf16_t)(k.w & 0xffff); KT[(c8 + 7) * 72 + r] = (bf16_t)(k.w >> 16);
        }
        {
            const int r = tid >> 3, c8 = (tid & 7) * 8;
            *(u32x4*)(TM + r * 72 + c8) = *(const u32x4*)(((bf16_t*)(F.ws + WS_XB)) + (size_t)(t0 + r) * LDE + h * 128 + c8);
            *(u32x4*)(AQ + r * 72 + c8) = *(const u32x4*)(((bf16_t*)(F.ws + WS_XB)) + (size_t)(t0 + r) * LDE + h * 128 + 64 + c8);
        }
        if (tid < 128) sB[tid] = ((float*)(F.ws + WS_BG))[((size_t)(t0 >> 6) * 4 + h) * 128 + tid];
        __syncthreads();
        f32x4 kS[4], qS[4], vn[4], o[4];
#pragma unroll
        for (int mt = 0; mt < 4; ++mt) { kS[mt] = (f32x4){0.f, 0.f, 0.f, 0.f}; qS[mt] = kS[mt]; vn[mt] = kS[mt]; }
#pragma unroll
        for (int ks = 0; ks < 4; ++ks) {
            const bf16x8 sf = mk8(pk4(S[2 * ks]), pk4(S[2 * ks + 1]));
#pragma unroll
            for (int mt = 0; mt < 4; ++mt) {
                kS[mt] = MFMA16(ldfragp(KN, 16 * mt + fr, 136, 32 * ks, fq), sf, kS[mt]);
                qS[mt] = MFMA16(ldfragp(QN, 16 * mt + fr, 136, 32 * ks, fq), sf, qS[mt]);
            }
        }
        const float glast = sG[63];
        f32x4 eg[4], tmp[4];
#pragma unroll
        for (int mt = 0; mt < 4; ++mt)
#pragma unroll
            for (int j = 0; j < 4; ++j) {
                const int row = 16 * mt + 4 * fq + j;
                const float e = __expf(sG[row]); eg[mt][j] = e;
                const float vv = bf2f(VV[row * 136 + 16 * w + fr]);
                tmp[mt][j] = vv - sB[row] * e * kS[mt][j];
            }
#pragma unroll
        for (int ks = 0; ks < 2; ++ks) {
            const bf16x8 tf = mk8(pk4(tmp[2 * ks]), pk4(tmp[2 * ks + 1]));
#pragma unroll
            for (int mt = 0; mt < 4; ++mt) vn[mt] = MFMA16(ldfragp(TM, 16 * mt + fr, 72, 32 * ks, fq), tf, vn[mt]);
        }
#pragma unroll
        for (int mt = 0; mt < 4; ++mt) o[mt] = eg[mt] * qS[mt];
#pragma unroll
        for (int ks = 0; ks < 2; ++ks) {
            const bf16x8 vf = mk8(pk4(vn[2 * ks]), pk4(vn[2 * ks + 1]));
#pragma unroll
            for (int mt = 0; mt < 4; ++mt) o[mt] = MFMA16(ldfragp(AQ, 16 * mt + fr, 72, 32 * ks, fq), vf, o[mt]);
        }
        const float dl = __expf(glast);
#pragma unroll
        for (int mt = 0; mt < 4; ++mt)
#pragma unroll
            for (int j = 0; j < 4; ++j) vn[mt][j] *= __expf(glast - sG[16 * mt + 4 * fq + j]);
#pragma unroll
        for (int mt = 0; mt < 8; ++mt) S[mt] = S[mt] * dl;
#pragma unroll
        for (int ks = 0; ks < 2; ++ks) {
            const bf16x8 vf = mk8(pk4(vn[2 * ks]), pk4(vn[2 * ks + 1]));
#pragma unroll
            for (int mt = 0; mt < 8; ++mt) S[mt] = MFMA16(ldfragp(KT, 16 * mt + fr, 72, 32 * ks, fq), vf, S[mt]);
        }
#pragma unroll
        for (int mt = 0; mt < 4; ++mt)
#pragma unroll
            for (int j = 0; j < 4; ++j) {
                float p = o[mt][j] * o[mt][j];
                p += __shfl_xor(p, 1); p += __shfl_xor(p, 2); p += __shfl_xor(p, 4); p += __shfl_xor(p, 8);
                if (fr == 0) RED[(16 * mt + 4 * fq + j) * 8 + w] = p;
            }
        __syncthreads();
#pragma unroll
        for (int mt = 0; mt < 4; ++mt)
#pragma unroll
            for (int j = 0; j < 4; ++j) {
                const int row = 16 * mt + 4 * fq + j;
                const f32x4 r0 = *(const f32x4*)(RED + row * 8), r1 = *(const f32x4*)(RED + row * 8 + 4);
                const float ssum = ((r0[0] + r0[1]) + (r0[2] + r0[3])) + ((r1[0] + r1[1]) + (r1[2] + r1[3]));
                const float rs = rsqrtf(ssum * (1.f / 128.f) + 1e-6f);
                bf16_t* zp = ((bf16_t*)(F.ws + WS_P)) + (size_t)(t0 + row) * LDP + C_ZA + dvc;
                const float z = bf2f(ZZ[row * 136 + 16 * w + fr]);
                if (!F.dry) *zp = (bf16_t)(pk2(o[mt][j] * rs * gn * silu(z), 0.f) & 0xffff);
            }
    }
    float* so = sample ? F.out + O_GDN_S + ((size_t)((l * 8 + (s - 16)) * 4 + h) * 128) * 128 : F.out + O_GDN_P + ((size_t)((l * 16 + s) * 4 + h) * 128) * 128;
#pragma unroll
    for (int mt = 0; mt < 8; ++mt)
#pragma unroll
        for (int j = 0; j < 4; ++j) if (!F.dry) so[(size_t)(16 * mt + 4 * fq + j) * 128 + 16 * w + fr] = S[mt][j];
}

DEV void g2_gla(const Frame& F0, int l, int s, int h) {
    REFRAME;
    bf16_t* QG = (bf16_t*)F.lds;
    bf16_t* KGT = (bf16_t*)(F.lds + 9216);
    bf16_t* AQ = (bf16_t*)(F.lds + 18432);
    float* sDL = (float*)(F.lds + 27648);
    float* RED = (float*)(F.lds + 27904);
    bf16_t* ZZ = (bf16_t*)(F.lds + 29952);
    const int tid = F.tid, lane = F.lane, w = F.wid, fr = lane & 15, fq = lane >> 4;
    const bool sample = s >= 16; const int nchunk = sample ? 1 : 32; const int tbase = sample ? 32768 + (s - 16) * 64 : s * 2048;
    const int dvc = h * 128 + 16 * w + fr;
    f32x4 S[4];
#pragma unroll
    for (int mt = 0; mt < 4; ++mt) {
        if (sample) { const float* sp = F.in[4] + ((size_t)((l * 8 + (s - 16)) * 4 + h) * 64) * 128;
#pragma unroll
            for (int j = 0; j < 4; ++j) S[mt][j] = sp[(size_t)(16 * mt + 4 * fq + j) * 128 + 16 * w + fr]; }
        else S[mt] = (f32x4){0.f, 0.f, 0.f, 0.f};
    }
    const float gn = F.in[17][l * 128 + 16 * w + fr];
    for (int n = 0; n < nchunk; ++n) {
        const int t0 = tbase + n * 64, chunk = t0 >> 6;
        __syncthreads();
        {
            const int r = tid >> 3, c8 = (tid & 7) * 8;
            *(u32x4*)(QG + r * 72 + c8) = *(const u32x4*)(((bf16_t*)(F.ws + WS_P)) + (size_t)(t0 + r) * LDP + C_QB + h * 64 + c8);
            const u32x4 k = *(const u32x4*)(((bf16_t*)(F.ws + WS_P)) + (size_t)(t0 + r) * LDP + C_KB + h * 64 + c8);
            KGT[(c8 + 0) * 72 + r] = (bf16_t)(k.x & 0xffff); KGT[(c8 + 1) * 72 + r] = (bf16_t)(k.x >> 16);
            KGT[(c8 + 2) * 72 + r] = (bf16_t)(k.y & 0xffff); KGT[(c8 + 3) * 72 + r] = (bf16_t)(k.y >> 16);
            KGT[(c8 + 4) * 72 + r] = (bf16_t)(k.z & 0xffff); KGT[(c8 + 5) * 72 + r] = (bf16_t)(k.z >> 16);
            KGT[(c8 + 6) * 72 + r] = (bf16_t)(k.w & 0xffff); KGT[(c8 + 7) * 72 + r] = (bf16_t)(k.w >> 16);
            *(u32x4*)(AQ + r * 72 + c8) = *(const u32x4*)(((bf16_t*)(F.ws + WS_XB)) + (size_t)(t0 + r) * LDE + 512 + h * 64 + c8);
        }
#pragma unroll
        for (int i = 0; i < 2; ++i) { const int p = tid + 512 * i, r = p >> 4, c8 = (p & 15) * 8;
            *(u32x4*)(ZZ + r * 136 + c8) = *(const u32x4*)(((bf16_t*)(F.ws + WS_P)) + (size_t)(t0 + r) * LDP + C_ZB + h * 128 + c8); }
        if (tid < 64) sDL[tid] = ((float*)(F.ws + WS_DL))[((size_t)chunk * 4 + h) * 64 + tid];
        bf16x8 vf[2];
#pragma unroll
        for (int ks = 0; ks < 2; ++ks) {
            unsigned e[8];
#pragma unroll
            for (int j = 0; j < 8; ++j) { const int row = 32 * ks + (j < 4 ? 4 * fq + j : 16 + 4 * fq + (j - 4)); e[j] = ((bf16_t*)(F.ws + WS_P))[(size_t)(t0 + row) * LDP + C_VB + dvc]; }
            u32x4 t; t.x = e[0] | (e[1] << 16); t.y = e[2] | (e[3] << 16); t.z = e[4] | (e[5] << 16); t.w = e[6] | (e[7] << 16);
            vf[ks] = __builtin_bit_cast(bf16x8, t);
        }
        __syncthreads();
        f32x4 o[4];
#pragma unroll
        for (int mt = 0; mt < 4; ++mt) o[mt] = (f32x4){0.f, 0.f, 0.f, 0.f};
#pragma unroll
        for (int ks = 0; ks < 2; ++ks) {
            const bf16x8 sf = mk8(pk4(S[2 * ks]), pk4(S[2 * ks + 1]));
#pragma unroll
            for (int mt = 0; mt < 4; ++mt) {
                o[mt] = MFMA16(ldfragp(QG, 16 * mt + fr, 72, 32 * ks, fq), sf, o[mt]);
                o[mt] = MFMA16(ldfragp(AQ, 16 * mt + fr, 72, 32 * ks, fq), vf[ks], o[mt]);
            }
        }
#pragma unroll
        for (int mt = 0; mt < 4; ++mt) {
#pragma unroll
            for (int j = 0; j < 4; ++j) S[mt][j] *= sDL[16 * mt + 4 * fq + j];
#pragma unroll
            for (int ks = 0; ks < 2; ++ks) S[mt] = MFMA16(ldfragp(KGT, 16 * mt + fr, 72, 32 * ks, fq), vf[ks], S[mt]);
        }
#pragma unroll
        for (int mt = 0; mt < 4; ++mt)
#pragma unroll
            for (int j = 0; j < 4; ++j) {
                float p = o[mt][j] * o[mt][j];
                p += __shfl_xor(p, 1); p += __shfl_xor(p, 2); p += __shfl_xor(p, 4); p += __shfl_xor(p, 8);
                if (fr == 0) RED[(16 * mt + 4 * fq + j) * 8 + w] = p;
            }
        __syncthreads();
#pragma unroll
        for (int mt = 0; mt < 4; ++mt)
#pragma unroll
            for (int j = 0; j < 4; ++j) {
                const int row = 16 * mt + 4 * fq + j;
                const f32x4 r0 = *(const f32x4*)(RED + row * 8), r1 = *(const f32x4*)(RED + row * 8 + 4);
                const float ssum = ((r0[0] + r0[1]) + (r0[2] + r0[3])) + ((r1[0] + r1[1]) + (r1[2] + r1[3]));
                const float rs = rsqrtf(ssum * (1.f / 128.f) + 1e-6f);
                bf16_t* zp = ((bf16_t*)(F.ws + WS_P)) + (size_t)(t0 + row) * LDP + C_ZB + dvc;
                const float z = bf2f(ZZ[row * 136 + 16 * w + fr]);
                if (!F.dry) *zp = (bf16_t)(pk2(o[mt][j] * rs * gn * silu(z), 0.f) & 0xffff);
            }
    }
    float* so = sample ? F.out + O_GLA_S + ((size_t)((l * 8 + (s - 16)) * 4 + h) * 64) * 128 : F.out + O_GLA_P + ((size_t)((l * 16 + s) * 4 + h) * 64) * 128;
#pragma unroll
    for (int mt = 0; mt < 4; ++mt)
#pragma unroll
        for (int j = 0; j < 4; ++j) if (!F.dry) so[(size_t)(16 * mt + 4 * fq + j) * 128 + 16 * w + fr] = S[mt][j];
}

DEV void unpack8(u32x4 u, float (&f)[8]) { f[0] = bflo(u.x); f[1] = bfhi(u.x); f[2] = bflo(u.y); f[3] = bfhi(u.y); f[4] = bflo(u.z); f[5] = bfhi(u.z); f[6] = bflo(u.w); f[7] = bfhi(u.w); }
DEV void load8f(const float* p, float (&f)[8]) { const f32x4 a = *(const f32x4*)p, b = *(const f32x4*)(p + 4); f[0] = a[0]; f[1] = a[1]; f[2] = a[2]; f[3] = a[3]; f[4] = b[0]; f[5] = b[1]; f[6] = b[2]; f[7] = b[3]; }
DEV void ffn_mid(const Frame& F0, int l) {
    REFRAME;
    const float* cw = F.in[29] + (size_t)l * 3 * 5632; const float* cb = F.in[30] + (size_t)l * 5632;
    const bf16_t* halo = ((bf16_t*)(F.ws + WS_KV)); const bf16_t* raw01 = ((bf16_t*)(F.ws + WS_KV + 11714560ull));
    for (int idx = F.bid * 512 + F.tid; idx < 112 * 704; idx += F.nb * 512) {
        const int ti = idx / 704, c4 = (idx % 704) * 4, pm = (ti / 7) * 8 + (ti % 7) + 1;
        const bf16_t* hp = halo + (size_t)(4 * pm - 1) * 2 * 5632; const bf16_t* rp = raw01 + (size_t)pm * 2 * 5632;
        const f32x4 gm2 = unpk4(*(const u32x2*)(hp + c4)), gm1 = unpk4(*(const u32x2*)(hp + 5632 + c4)), g0 = unpk4(*(const u32x2*)(rp + c4)), g1 = unpk4(*(const u32x2*)(rp + 5632 + c4));
        const f32x4 vm2 = unpk4(*(const u32x2*)(hp + 2816 + c4)), vm1 = unpk4(*(const u32x2*)(hp + 5632 + 2816 + c4)), v0 = unpk4(*(const u32x2*)(rp + 2816 + c4)), v1 = unpk4(*(const u32x2*)(rp + 5632 + 2816 + c4));
        const f32x4 wg0 = *(const f32x4*)(cw + c4), wg1 = *(const f32x4*)(cw + 5632 + c4), wg2 = *(const f32x4*)(cw + 2 * 5632 + c4), bg = *(const f32x4*)(cb + c4);
        const f32x4 wv0 = *(const f32x4*)(cw + 2816 + c4), wv1 = *(const f32x4*)(cw + 5632 + 2816 + c4), wv2 = *(const f32x4*)(cw + 2 * 5632 + 2816 + c4), bv = *(const f32x4*)(cb + 2816 + c4);
        f32x4 o0, o1;
#pragma unroll
        for (int j = 0; j < 4; ++j) {
            const float yg0 = wg0[j] * gm2[j] + wg1[j] * gm1[j] + wg2[j] * g0[j] + bg[j], yv0 = wv0[j] * vm2[j] + wv1[j] * vm1[j] + wv2[j] * v0[j] + bv[j];
            const float yg1 = wg0[j] * gm1[j] + wg1[j] * g0[j] + wg2[j] * g1[j] + bg[j], yv1 = wv0[j] * vm1[j] + wv1[j] * v0[j] + wv2[j] * v1[j] + bv[j];
            o0[j] = silu(yg0) * yv0; o1[j] = silu(yg1) * yv1;
        }
        bf16_t* vp = ((bf16_t*)(F.ws + WS_P)) + (size_t)pm * 256 * LDP + c4;
        *(u32x2*)vp = pk4(o0); *(u32x2*)(vp + LDP) = pk4(o1);
    }
}

DEV void final_norm(const Frame& F0) {
    REFRAME;
    const int gw = F.bid * 8 + F.wid, nw = F.nb * 8, lane = F.lane;
    const float* g = F.in[32];
    for (int row = gw; row < TT; row += nw) {
        const float rs = row_rstd(((float*)(F.ws + WS_SSQ)), row);
        float* X = F.out + (size_t)row * 1024;
#pragma unroll
        for (int i = 0; i < 4; ++i) { const int cidx = i * 256 + lane * 4; f32x4 v = *(const f32x4*)(X + cidx); const f32x4 gg = *(const f32x4*)(g + cidx); *(f32x4*)(X + cidx) = v * rs * gg; }
    }
}

#ifdef DBG_COL
DEV void dbg_dump(const Frame& F0) {
    REFRAME;
    for (int i = F.bid * 512 + F.tid; i < TT * 256; i += F.nb * 512) {
        const int row = i >> 8, c = (i & 255) * 4;
        const f32x4 v = c < 512 ? unpk4(*(const u32x2*)(((bf16_t*)(F.ws + WS_P)) + (size_t)row * LDP + DBG_COL + c)) : (f32x4){0.f, 0.f, 0.f, 0.f};
        *(f32x4*)(F.out + (size_t)row * 1024 + c) = (row DBG_ROWSEL) ? v : (f32x4){0.f, 0.f, 0.f, 0.f};
    }
}
#endif
#define XB_TMO      128
#define XB_XCNT(j)  (256  + 64 * (j))
#define XB_XSUB(j)  (1280 + 64 * (j))
#define XB_XGEN(j)  (2304 + 64 * (j))
#define XB_TOP      3328
#define XB_TOPGEN   3392
#define XCD_BAR_WORDS 3456
#define XB_SPIN_CAP (1u << 18)
#define LAS __attribute__((address_space(3)))

__device__ __forceinline__ unsigned xb_ld(unsigned* p)              { return __hip_atomic_load(p, __ATOMIC_RELAXED, __HIP_MEMORY_SCOPE_AGENT); }
__device__ __forceinline__ unsigned xb_add(unsigned* p, unsigned v) { return __hip_atomic_fetch_add(p, v, __ATOMIC_RELAXED, __HIP_MEMORY_SCOPE_AGENT); }
__device__ __forceinline__ unsigned xb_xcc_id() { return (unsigned)__builtin_amdgcn_s_getreg((3 << 11) | 20) & 0xFu; }
#define XB_SPIN(cond, bar) do { unsigned _sp = 0; while (cond) { __builtin_amdgcn_s_sleep(1); \
    if ((++_sp & 255u) == 0u) { if (xb_ld(&(bar)[XB_TMO])) break; if (_sp > XB_SPIN_CAP) { atomicAdd(&(bar)[XB_TMO], 1u); break; } } } } while (0)

struct XcdBarrier {
    unsigned* bar; unsigned x;
    volatile LAS unsigned* st;
};

__device__ __forceinline__ XcdBarrier xcd_barrier_post(unsigned* bar, volatile LAS unsigned* st) {
    XcdBarrier b; b.bar = bar; b.x = xb_xcc_id(); b.st = st;
    if (threadIdx.x == 0) (void)xb_add(&bar[XB_XCNT(b.x)], 1u);
    return b;
}
__device__ __forceinline__ void xcd_barrier_complete(unsigned* bar, unsigned x, unsigned& nloc, unsigned& nx) {
    const unsigned G = gridDim.x * gridDim.y * gridDim.z;
    unsigned sum, cnt, mine, sp = 0u;
    for (;;) {
        sum = 0u; cnt = 0u; mine = 0u;
#pragma unroll
        for (unsigned j = 0; j < 16; ++j) { const unsigned c = xb_ld(&bar[XB_XCNT(j)]); sum += c; cnt += (c > 0u) ? 1u : 0u; mine = (j == x) ? c : mine; }
        if (sum == G) break;
        __builtin_amdgcn_s_sleep(1);
        if ((++sp & 255u) == 0u) { if (xb_ld(&bar[XB_TMO])) break; if (sp > XB_SPIN_CAP) { atomicAdd(&bar[XB_TMO], 1u); break; } }
    }
    nloc = mine > 0u ? mine : 1u; nx = cnt > 0u ? cnt : 1u;
}

__device__ __forceinline__ void xcd_barrier(const XcdBarrier& b) {
    asm volatile("s_waitcnt vmcnt(0)" ::: "memory");
    __syncthreads();
    if (threadIdx.x == 0) {
        unsigned* bar = b.bar;
        __builtin_amdgcn_s_waitcnt(0);
        unsigned nloc = b.st[0], nx = b.st[1];
        if (nloc == 0u) { xcd_barrier_complete(bar, b.x, nloc, nx); b.st[0] = nloc; b.st[1] = nx; }
        const unsigned old = xb_add(&bar[XB_XSUB(b.x)], 1u);
        const unsigned gen = old / nloc;
        if (old + 1u == (gen + 1u) * nloc) {
            __builtin_amdgcn_fence(__ATOMIC_RELEASE, "agent");
            asm volatile("s_waitcnt vmcnt(0)" ::: "memory");
            const unsigned og = xb_add(&bar[XB_TOP], 1u);
            const unsigned tg = og / nx;
            if (og + 1u == (tg + 1u) * nx) xb_add(&bar[XB_TOPGEN], 1u);
            else XB_SPIN(xb_ld(&bar[XB_TOPGEN]) == tg, bar);
            __builtin_amdgcn_fence(__ATOMIC_ACQUIRE, "agent");
            xb_add(&bar[XB_XGEN(b.x)], 1u);
            asm volatile("s_waitcnt vmcnt(0)" ::: "memory");
        } else {
            XB_SPIN(xb_ld(&bar[XB_XGEN(b.x)]) == gen, bar);
            __builtin_amdgcn_fence(__ATOMIC_ACQUIRE, "agent");
            asm volatile("s_waitcnt vmcnt(0)" ::: "memory");
        }
    }
    __syncthreads();
}

__global__ void __launch_bounds__(512, 2) fwd_kernel(Params p) {
    extern __shared__ __attribute__((aligned(16))) unsigned char lds[];
    cg::grid_group grid = cg::this_grid();
    Frame F;
    F.in = (InTab)__builtin_amdgcn_kernarg_segment_ptr(); F.out = p.out; F.ws = p.ws; F.lds = lds;
    F.tid = threadIdx.x; F.lane = threadIdx.x & 63; F.wid = __builtin_amdgcn_readfirstlane(threadIdx.x >> 6); F.nb = gridDim.x; F.bid = blockIdx.x; F.dry = 0; F.cb = blockIdx.x; F.cn = gridDim.x;
    volatile LAS unsigned* xst = (volatile LAS unsigned*)(lds + LDS_BYTES - 16);
    if (threadIdx.x == 0) { xst[0] = 0u; xst[1] = 0u; }
    __syncthreads();
    const XcdBarrier xbar = xcd_barrier_post((unsigned*)(p.ws + WS_BAR), xst);
    for (int ph = p.ph_lo; ph < p.ph_hi; ++ph) {
#ifndef PHM
#define PHM 0xffff
#endif
        if (ph == 0) { if (PHM & 0x1000) phase0(F); }
        else if (ph == NPH - 1) { if (PHM & 0x2000) final_norm(F); }
        else {
            const int l = (ph - 1) / 13, k = (ph - 1) % 13;
            int gk = -1;
            if (k == 2 && gridDim.x == 256) gk = GP_MEMKV;
            switch (k) { case 0: gk = GP_IN; break; case 3: gk = GP_OUT; break; case 4: gk = GP_OUT2; break; case 5: gk = GP_WO; break; case 6: gk = GP_MQ; break; case 7: gk = GP_ATTN; break; case 8: gk = GP_ATTN2; break;
                         case 9: gk = GP_MO; break; case 10: gk = GP_UP; break; case 12: gk = GP_DOWN; break; default: break; }
#ifndef REPMASK
#define REPMASK 0
#endif
            if (gk >= 0 && (PHM & 1)) { const int nrep = ((REPMASK >> k) & 1) ? 2 : 1; for (int rep = 0; rep < nrep; ++rep) gemm_phase(F, gk, l); }
            if (k == 0 && (PHM & 1)) small_proj(F);
            if (k == (gridDim.x == 256 ? 2 : 3) && (PHM & 8)) sample_kv(F, l);
            if (gridDim.x == 256 && k == 2 && l > 0 && blockIdx.x >= 192) { Frame G = F; G.cb = (int)blockIdx.x - 192; G.cn = 64; __syncthreads(); cvt_ffn(G, l); }
            if (gridDim.x == 256 && k == 10 && l < 3 && (blockIdx.x >> 3) >= 6) { Frame G = F; G.cb = (((int)blockIdx.x >> 3) - 6) * 8 + ((int)blockIdx.x & 7); G.cn = 208; __syncthreads(); cvt_mixer(G, l + 1); }
#ifndef DRYMASK
#define DRYMASK 0
#endif
            for (int dr = ((DRYMASK >> k) & 1); dr >= 0; --dr) {
            F.dry = dr;
            if (k == 1 && (PHM & 2)) {
                for (int it = F.bid; it < NCH * 8; it += F.nb) { const int c = it >> 3, h = it & 3; if (it & 4) g1_gla(F, l, c, h); else g1_gdn(F, l, c, h); }
                __syncthreads();
                if (l > 0 && !dr && F.nb != 256) cvt_ffn(F, l);
            }
            if (k == 2 && (PHM & 4)) {
                for (int it = F.bid; it < 192; it += F.nb) {
                    int s, h, br;
                    if (it < 128) { br = it & 1; h = (it >> 1) & 3; s = it >> 3; } else { const int v = it - 128; br = v & 1; h = (v >> 1) & 3; s = 16 + (v >> 3); }
                    if (br) g2_gla(F, l, s, h); else g2_gdn(F, l, s, h);
                    __syncthreads();
                }
            }
            if (k == 11 && (PHM & 0x200)) { ffn_mid(F, l); if (l < 3 && !dr && F.nb != 256) { __syncthreads(); cvt_mixer(F, l + 1); } }
            }
            F.dry = 0;
        }
#ifndef SYNCREP
#define SYNCREP 1
#endif
        if (ph + 1 < p.ph_hi) {
            if (ph == 0) grid.sync();
            else xcd_barrier(xbar);
        }
    }
#ifdef DBG_COL
    __threadfence(); grid.sync(); __threadfence();
    dbg_dump(F);
#endif
}

extern "C" void kernel_launch(void* const* d_in, const int* in_sizes, int n_in, void* d_out, int out_size, void* d_ws, size_t ws_size, hipStream_t stream) {
    static int grid_blocks = 0;
    if (grid_blocks == 0) {
        if (n_in != 33 || ws_size < WS_TOTAL) { fprintf(stderr, "kernel_launch: bad n_in %d or ws %zu < %zu\n", n_in, ws_size, (size_t)WS_TOTAL); grid_blocks = -1; return; }
        int dev = 0, cus = 0, per_cu = 0;
        hipGetDevice(&dev);
        hipDeviceGetAttribute(&cus, hipDeviceAttributeMultiprocessorCount, dev);
        if (hipFuncSetAttribute((const void*)fwd_kernel, hipFuncAttributeMaxDynamicSharedMemorySize, LDS_BYTES) != hipSuccess) { fprintf(stderr, "hipFuncSetAttribute failed\n"); grid_blocks = -1; return; }
        hipOccupancyMaxActiveBlocksPerMultiprocessor(&per_cu, (const void*)fwd_kernel, 512, LDS_BYTES);
        if (per_cu < 1) per_cu = 1;
        (void)hipGetLastError();
        grid_blocks = cus * 1;
        if (grid_blocks <= 0) grid_blocks = 256;
    }
    if (grid_blocks < 0) return;
    Params p{};
    for (int i = 0; i < 33; ++i) p.in[i] = (const float*)d_in[i];
    p.out = (float*)d_out; p.ws = (unsigned char*)d_ws; p.ph_lo = 0; p.ph_hi = PH_HI;
    (void)hipMemsetAsync((unsigned char*)d_ws + WS_BAR, 0, 16384, stream);
    void* args[] = {&p};
    hipError_t e = hipLaunchCooperativeKernel((const void*)fwd_kernel, dim3(grid_blocks), dim3(512), args, LDS_BYTES, stream);
    if (e != hipSuccess) fprintf(stderr, "cooperative launch failed: %s (grid %d)\n", hipGetErrorString(e), grid_blocks);
}
```

```cpp
#include <hip/hip_runtime.h>
#include <hip/hip_cooperative_groups.h>
#include <cstdint>
#include <cstdio>
namespace cg = cooperative_groups;

typedef unsigned short bf16_t;
typedef short bf16x8 __attribute__((ext_vector_type(8)));
typedef float f32x4 __attribute__((ext_vector_type(4)));
typedef float f32x2 __attribute__((ext_vector_type(2)));
typedef unsigned u32x2 __attribute__((ext_vector_type(2)));
typedef unsigned u32x4 __attribute__((ext_vector_type(4)));
#define DEV __device__ __forceinline__

constexpr int DM = 1024, TT = 33280, NCH = 520, LDP = 5632, LDE = 768;
constexpr int C_QA = 0, C_KA = 512, C_VA = 1024, C_ZA = 1536, C_QB = 2048, C_KB = 2304, C_VB = 2560, C_ZB = 3072, C_GA = 3584, C_GB = 4608;
constexpr int C_MRG = 0, C_PR = 1024, C_Q = 2048, C_O = 3072;
constexpr size_t O_Y = 0;
constexpr size_t O_GDN_P = 34078720ull;
constexpr size_t O_GDNC_P = O_GDN_P + 4194304ull;
constexpr size_t O_GLA_P = O_GDNC_P + 294912ull;
constexpr size_t O_FFNC_P = O_GLA_P + 2097152ull;
constexpr size_t O_MEMK = O_FFNC_P + 720896ull;
constexpr size_t O_MEMV = O_MEMK + 16777216ull;
constexpr size_t O_GDN_S = O_MEMV + 16777216ull;
constexpr size_t O_GDNC_S = O_GDN_S + 2097152ull;
constexpr size_t O_GLA_S = O_GDNC_S + 147456ull;
constexpr size_t O_FFNC_S = O_GLA_S + 1048576ull;
constexpr size_t al256(size_t x) { return (x + 255) & ~(size_t)255; }
constexpr size_t WS_WMIX = 0;
constexpr size_t WM_WIN = 0, WM_WSM = WM_WIN + 5632ull * 1024, WM_WOA = WM_WSM + 32 * 1024, WM_WOB = WM_WOA + 524288, WM_WO = WM_WOB + 524288,
                 WM_WMQ = WM_WO + 1048576, WM_WMK = WM_WMQ + 1048576, WM_WMV = WM_WMK + 1048576, WM_WMO = WM_WMV + 1048576, WM_END = WM_WMO + 1048576;
constexpr size_t WS_WFFN = al256(WS_WMIX + WM_END * 2);
constexpr size_t WF_UP = 0, WF_DN = 5632ull * 1024, WF_END = WF_DN + 1024ull * 2816;
constexpr size_t WS_XB = al256(WS_WFFN + WF_END * 2);
constexpr size_t WS_P = al256(WS_XB + (size_t)TT * 1024 * 2);
constexpr size_t WS_KV = al256(WS_P + (size_t)TT * LDP * 2);
constexpr size_t KV_BYTES = 2ull * 6144 * 1024 * 2;
constexpr size_t WS_MB = al256(WS_KV + KV_BYTES);
constexpr size_t WS_MRS = al256(WS_MB + 4096ull * 1024 * 2);
constexpr size_t WS_SSQ = al256(WS_MRS + 4096 * 4);
constexpr size_t WS_SC = al256(WS_SSQ + (size_t)TT * 16 * 4);
constexpr size_t WS_DL = al256(WS_SC + (size_t)TT * 32 * 4);
constexpr size_t WS_BG = al256(WS_DL + 520ull * 4 * 64 * 4);
constexpr size_t WS_BAR = al256(WS_BG + 520ull * 4 * 128 * 4);
constexpr size_t WS_TOTAL = al256(WS_BAR + 16384);
constexpr int LDS_BYTES = 147456;
constexpr int NPH = 54;
#ifndef PH_HI
#define PH_HI NPH
#define REPMASK 0
#define SYNCREP 1
#define DRYMASK 0
#endif

struct Params { const float* in[33]; float* out; unsigned char* ws; int ph_lo, ph_hi; };

typedef __bf16 bf16x2_t __attribute__((ext_vector_type(2)));
DEV unsigned pk2(float lo, float hi) { f32x2 f = {lo, hi}; bf16x2_t v = __builtin_convertvector(f, bf16x2_t); return __builtin_bit_cast(unsigned, v); }
DEV float bf2f(bf16_t b) { return __uint_as_float(((unsigned)b) << 16); }
DEV float bflo(unsigned u) { return __uint_as_float(u << 16); }
DEV float bfhi(unsigned u) { return __uint_as_float(u & 0xffff0000u); }
DEV u32x2 pk4(f32x4 v) { u32x2 r; r.x = pk2(v[0], v[1]); r.y = pk2(v[2], v[3]); return r; }
DEV f32x4 unpk4(u32x2 u) { return (f32x4){bflo(u.x), bfhi(u.x), bflo(u.y), bfhi(u.y)}; }
DEV bf16x8 mk8(u32x2 a, u32x2 b) { u32x4 t = {a.x, a.y, b.x, b.y}; return __builtin_bit_cast(bf16x8, t); }
DEV float sigm(float x) { return 1.f / (1.f + __expf(-x)); }
DEV float silu(float x) { return x / (1.f + __expf(-x)); }
DEV float softplus(float x) { return x > 20.f ? x : __logf(1.f + __expf(x)); }
DEV float logsigmoid(float x) { return fminf(x, 0.f) - __logf(1.f + __expf(-fabsf(x))); }
DEV float row_rstd(const float* ssq, int row) {
    const f32x4 a = *(const f32x4*)(ssq + (size_t)row * 4), b = *(const f32x4*)(ssq + ((size_t)TT + row) * 4);
    const f32x4 c = *(const f32x4*)(ssq + ((size_t)2 * TT + row) * 4), d = *(const f32x4*)(ssq + ((size_t)3 * TT + row) * 4);
    float s = ((a[0] + a[1]) + (a[2] + a[3])) + ((b[0] + b[1]) + (b[2] + b[3])) + ((c[0] + c[1]) + (c[2] + c[3])) + ((d[0] + d[1]) + (d[2] + d[3]));
    return rsqrtf(s * (1.f / 1024.f) + 1e-6f);
}
DEV bf16x8 ldfragp(const bf16_t* base, int row, int stride, int k0, int fq) {
    const bf16_t* p = base + row * stride + k0 + 4 * fq;
    return mk8(*(const u32x2*)p, *(const u32x2*)(p + 16));
}
DEV bf16x8 ldfrag(const bf16_t* base, int row, int stride, int k0, int fq) {
    return *(const bf16x8*)(base + row * stride + k0 + 8 * fq);
}
#define MFMA16(a, b, c) __builtin_amdgcn_mfma_f32_16x16x32_bf16((a), (b), (c), 0, 0, 0)

constexpr int BM = 256, BK = 64, HALF = 128, HT = HALF * BK;
DEV int lds_byte(int r, int c) { int st = (r >> 4) * 2 + (c >> 5), rr = r & 15, cc = c & 31, ob = rr * 64 + cc * 2; return st * 1024 + (ob ^ (((ob >> 9) & 1) << 5)); }
DEV void stage_rc(int b, int& R, int& C) { int st = b / 1024, sb = b % 1024, swz = sb ^ (((sb >> 9) & 1) << 5); R = (st >> 1) * 16 + swz / 64; C = (st & 1) * 32 + (swz % 64) / 2; }

DEV void gemm_core(const bf16_t* __restrict__ A, int lda, const bf16_t* __restrict__ Bt, int ldb, int K, int brow, int bcol, f32x4 (&acc)[2][2][4][2], bf16_t* shm) {
#define SA(b, h) (shm + ((b) * 2 + (h)) * HT)
#define SB(b, h) (shm + (4 + (b) * 2 + (h)) * HT)
#define STAGE(P, BASE, LD, br, kt) do { const char* _gb = (const char*)((BASE) + (long)(br) * (LD) + (long)(kt) * BK); \
    const unsigned _vo = (unsigned)((sr0 * (int)(LD) + sc0) * 2); \
    for (int _i = 0; _i < 2; ++_i) { \
      __builtin_amdgcn_global_load_lds((const unsigned*)(_gb + (long)(_i * 128) * (LD) + _vo), (unsigned*)((char*)(P) + wbase + _i * 8192), 16, 0, 0); } } while (0)
#define LDA(dst, b, h) for (int m = 0; m < 4; ++m) for (int k = 0; k < 2; ++k) \
    dst[m][k] = *reinterpret_cast<const bf16x8*>((char*)SA(b, h) + lds_byte(wr * 64 + m * 16 + fr, k * 32 + fq * 8))
#define LDB(dst, b, h) for (int n = 0; n < 2; ++n) for (int k = 0; k < 2; ++k) \
    dst[n][k] = *reinterpret_cast<const bf16x8*>((char*)SB(b, h) + lds_byte(wc * 32 + n * 16 + fr, k * 32 + fq * 8))
#define MMA(ai, bj, At_, Bt_) do { __builtin_amdgcn_s_setprio(1); \
    for (int m = 0; m < 4; ++m) for (int n = 0; n < 2; ++n) for (int k = 0; k < 2; ++k) \
      acc[ai][bj][m][n] = __builtin_amdgcn_mfma_f32_16x16x32_bf16(Bt_[n][k], At_[m][k], acc[ai][bj][m][n], 0, 0, 0); \
    __builtin_amdgcn_s_setprio(0); } while (0)
#define WAIT_V(n) asm volatile("s_waitcnt vmcnt(" #n ")" ::: "memory")
#define WAIT_L(n) asm volatile("s_waitcnt lgkmcnt(" #n ")" ::: "memory")
#define BAR __builtin_amdgcn_s_barrier()
#define SCHED __builtin_amdgcn_sched_barrier(0)
    int tidx = threadIdx.x; asm volatile("" : "+v"(tidx));
    const int wid = __builtin_amdgcn_readfirstlane(tidx >> 6), lane = tidx & 63, wr = wid >> 2, wc = wid & 3, fr = lane & 15, fq = lane >> 4;
    const int wbase = wid * 1024;
    int sr0, sc0; stage_rc(tidx * 16, sr0, sc0);
#pragma unroll
    for (int a = 0; a < 2; ++a)
#pragma unroll
        for (int b = 0; b < 2; ++b)
#pragma unroll
            for (int m = 0; m < 4; ++m)
#pragma unroll
                for (int n = 0; n < 2; ++n) acc[a][b][m][n] = (f32x4){0.f, 0.f, 0.f, 0.f};
    bf16x8 At[4][2], B0[2][2], B1[2][2];
    const int nt = K / BK;
    STAGE(SB(0, 0), Bt, ldb, bcol, 0); STAGE(SA(0, 0), A, lda, brow, 0);
    STAGE(SB(0, 1), Bt, ldb, bcol + HALF, 0); STAGE(SA(0, 1), A, lda, brow + HALF, 0);
    if (wr == 1) BAR;
    WAIT_V(4); BAR;
    STAGE(SB(1, 0), Bt, ldb, bcol, 1); STAGE(SA(1, 0), A, lda, brow, 1); STAGE(SB(1, 1), Bt, ldb, bcol + HALF, 1);
    WAIT_V(6); BAR;
    for (int t = 0; t < nt - 2; t += 2) {
        LDB(B0, 0, 0); SCHED; LDA(At, 0, 0); STAGE(SA(1, 1), A, lda, brow + HALF, t + 1);
        WAIT_L(8); BAR; WAIT_L(0); MMA(0, 0, At, B0); BAR; SCHED;
        LDB(B1, 0, 1); STAGE(SB(0, 0), Bt, ldb, bcol, t + 2);
        BAR; WAIT_L(0); MMA(0, 1, At, B1); BAR;
        LDA(At, 0, 1); STAGE(SA(0, 0), A, lda, brow, t + 2);
        BAR; WAIT_L(0); MMA(1, 0, At, B0); BAR; SCHED;
        STAGE(SB(0, 1), Bt, ldb, bcol + HALF, t + 2);
        WAIT_V(6); BAR; MMA(1, 1, At, B1); BAR;
        LDB(B0, 1, 0); SCHED; LDA(At, 1, 0); STAGE(SA(0, 1), A, lda, brow + HALF, t + 2);
        WAIT_L(8); BAR; WAIT_L(0); MMA(0, 0, At, B0); BAR; SCHED;
        LDB(B1, 1, 1); STAGE(SB(1, 0), Bt, ldb, bcol, t + 3);
        BAR; WAIT_L(0); MMA(0, 1, At, B1); BAR;
        LDA(At, 1, 1); STAGE(SA(1, 0), A, lda, brow, t + 3);
        BAR; WAIT_L(0); MMA(1, 0, At, B0); BAR; SCHED;
        STAGE(SB(1, 1), Bt, ldb, bcol + HALF, t + 3);
        WAIT_V(6); BAR; MMA(1, 1, At, B1); BAR;
    }
    { LDB(B0, 0, 0); LDA(At, 0, 0); STAGE(SA(1, 1), A, lda, brow + HALF, nt - 1);
      BAR; WAIT_L(0); MMA(0, 0, At, B0); BAR;
      LDB(B1, 0, 1); BAR; WAIT_L(0); MMA(0, 1, At, B1); BAR;
      LDA(At, 0, 1); WAIT_V(4); BAR; WAIT_L(0); MMA(1, 0, At, B0); MMA(1, 1, At, B1); BAR; }
    { LDB(B0, 1, 0); LDA(At, 1, 0); WAIT_V(2); BAR; WAIT_L(0); MMA(0, 0, At, B0); BAR;
      LDB(B1, 1, 1); WAIT_V(0); BAR; WAIT_L(0); MMA(0, 1, At, B1); BAR;
      LDA(At, 1, 1); BAR; WAIT_L(0); MMA(1, 0, At, B0); MMA(1, 1, At, B1); BAR; }
    if (wr == 0) BAR;
    SCHED;
#undef SA
#undef SB
}

typedef const float* const __attribute__((address_space(4)))* InTab;
struct Frame {
    InTab in; float* out; unsigned char* ws; unsigned char* lds;
    int tid, lane, wid, nb, bid, dry, cb, cn;
};
#define REFRAME Frame F = F0; { int t_ = threadIdx.x; asm volatile("" : "+v"(t_)); F.tid = t_; F.lane = t_ & 63; unsigned char* w_ = F.ws; asm volatile("" : "+s"(w_)); F.ws = w_; float* o_ = F.out; asm volatile("" : "+s"(o_)); F.out = o_; InTab i_ = (InTab)__builtin_amdgcn_kernarg_segment_ptr(); asm volatile("" : "+s"(i_)); F.in = i_; int a_ = F.wid, b_ = F.bid, c_ = F.nb; asm volatile("" : "+s"(a_), "+s"(b_), "+s"(c_)); F.wid = a_; F.bid = b_; F.nb = c_; }

enum { EPI_PROJ = 0, EPI_UP, EPI_RESID, EPI_Q, EPI_MEMK, EPI_MEMV, EPI_OUTA, EPI_OUTB, EPI_SOFTMAX, EPI_ATTNO };
struct GDesc { const bf16_t* A; int lda; const bf16_t* Bt; int ldb; int K, brow, bcol, epi, orow, ocol, head, vai, vwr; };

DEV void cvt_mat(const Frame& F0, const float* src, int ldsrc, int K, int N, int wincols, const float* gain, bf16_t* dst) {
    REFRAME;
    float* T = (float*)F.lds;
    const int nkt = K / 64, nnt = N / 64, ntile = nkt * nnt;
    for (int t = F.cb; t < ntile; t += F.cn) {
        const int kt = t / nnt, ntl = t % nnt, k0 = kt * 64, n0 = ntl * 64;
        int coff = 0; if (wincols == 1) coff = (n0 < 1536) ? 0 : (n0 < 3072 ? 8 : 24);
        if (wincols == 2) { const int tl = n0 >> 8, w = n0 & 255; coff = (w < 128 ? 128 * tl + w : 2816 + 128 * tl + (w - 128)) - n0; }
        __syncthreads();
#pragma unroll
        for (int i = 0; i < 2; ++i) {
            const int kr = (F.tid >> 4) + 32 * i, nc = (F.tid & 15) * 4;
            f32x4 v = *(const f32x4*)(src + (size_t)(k0 + kr) * ldsrc + n0 + coff + nc);
            const float g = gain ? gain[k0 + kr] : 1.f;
            T[kr * 65 + nc + 0] = v[0] * g; T[kr * 65 + nc + 1] = v[1] * g; T[kr * 65 + nc + 2] = v[2] * g; T[kr * 65 + nc + 3] = v[3] * g;
        }
        __syncthreads();
        const int n = F.tid >> 3, kc = (F.tid & 7) * 8;
        u32x4 w;
        w.x = pk2(T[(kc + 0) * 65 + n], T[(kc + 1) * 65 + n]); w.y = pk2(T[(kc + 2) * 65 + n], T[(kc + 3) * 65 + n]);
        w.z = pk2(T[(kc + 4) * 65 + n], T[(kc + 5) * 65 + n]); w.w = pk2(T[(kc + 6) * 65 + n], T[(kc + 7) * 65 + n]);
        *(u32x4*)(dst + (size_t)(n0 + n) * K + k0 + kc) = w;
    }
    __syncthreads();
}
DEV void cvt_mixer(const Frame& F0, int l) {
    REFRAME;
    InTab in = F.in;
    cvt_mat(F, in[10] + (size_t)l * 1024 * 5656, 5656, 1024, 5632, 1, in[9] + l * 1024, ((bf16_t*)(F.ws + WS_WMIX)) + WM_WIN);
    cvt_mat(F, in[18] + (size_t)l * 512 * 1024, 1024, 512, 1024, 0, nullptr, ((bf16_t*)(F.ws + WS_WMIX)) + WM_WOA);
    cvt_mat(F, in[19] + (size_t)l * 512 * 1024, 1024, 512, 1024, 0, nullptr, ((bf16_t*)(F.ws + WS_WMIX)) + WM_WOB);
    cvt_mat(F, in[20] + (size_t)l * 1048576, 1024, 1024, 1024, 0, nullptr, ((bf16_t*)(F.ws + WS_WMIX)) + WM_WO);
    cvt_mat(F, in[23] + (size_t)l * 1048576, 1024, 1024, 1024, 0, in[21] + l * 1024, ((bf16_t*)(F.ws + WS_WMIX)) + WM_WMQ);
    cvt_mat(F, in[24] + (size_t)l * 1048576, 1024, 1024, 1024, 0, in[22] + l * 1024, ((bf16_t*)(F.ws + WS_WMIX)) + WM_WMK);
    cvt_mat(F, in[25] + (size_t)l * 1048576, 1024, 1024, 1024, 0, in[22] + l * 1024, ((bf16_t*)(F.ws + WS_WMIX)) + WM_WMV);
    cvt_mat(F, in[26] + (size_t)l * 1048576, 1024, 1024, 1024, 0, nullptr, ((bf16_t*)(F.ws + WS_WMIX)) + WM_WMO);
    const float* win = in[10] + (size_t)l * 1024 * 5656; const float* g = in[9] + l * 1024;
    for (int i = F.cb * 512 + F.tid; i < 32 * 1024; i += F.cn * 512) {
        const int n = i >> 10, k = i & 1023;
        float v = 0.f;
        if (n < 8) v = win[(size_t)k * 5656 + 1536 + n] * g[k]; else if (n < 24) v = win[(size_t)k * 5656 + 3080 + (n - 8)] * g[k];
        ((bf16_t*)(F.ws + WS_WMIX))[WM_WSM + i] = (bf16_t)(pk2(v, 0.f) & 0xffff);
    }
}
DEV void cvt_ffn(const Frame& F, int l) {
    cvt_mat(F, F.in[28] + (size_t)l * 1024 * 5632, 5632, 1024, 5632, 2, F.in[27] + l * 1024, ((bf16_t*)(F.ws + WS_WFFN)) + WF_UP);
    cvt_mat(F, F.in[31] + (size_t)l * 2816 * 1024, 1024, 2816, 1024, 0, nullptr, ((bf16_t*)(F.ws + WS_WFFN)) + WF_DN);
}

DEV void phase0(const Frame& F0) {
    REFRAME;
    const int gw = F.bid * 8 + F.wid, nw = F.nb * 8, lane = F.lane;
    for (int row = gw; row < TT + 4096; row += nw) {
        const bool ismem = row >= TT;
        const float* src = ismem ? F.in[8] + (size_t)(row - TT) * 1024 : (row < 32768 ? F.in[0] + (size_t)row * 1024 : F.in[1] + (size_t)(row - 32768) * 1024);
        f32x4 v[4]; float s = 0.f;
#pragma unroll
        for (int i = 0; i < 4; ++i) { v[i] = *(const f32x4*)(src + lane * 16 + i * 4); s += v[i][0] * v[i][0] + v[i][1] * v[i][1] + v[i][2] * v[i][2] + v[i][3] * v[i][3]; }
        u32x4 w0, w1;
        w0.x = pk2(v[0][0], v[0][1]); w0.y = pk2(v[0][2], v[0][3]); w0.z = pk2(v[1][0], v[1][1]); w0.w = pk2(v[1][2], v[1][3]);
        w1.x = pk2(v[2][0], v[2][1]); w1.y = pk2(v[2][2], v[2][3]); w1.z = pk2(v[3][0], v[3][1]); w1.w = pk2(v[3][2], v[3][3]);
        s += __shfl_xor(s, 1); s += __shfl_xor(s, 2);
        if (!ismem) {
            float* X = F.out + (size_t)row * 1024 + lane * 16;
#pragma unroll
            for (int i = 0; i < 4; ++i) *(f32x4*)(X + i * 4) = v[i];
            bf16_t* xb = ((bf16_t*)(F.ws + WS_XB)) + (size_t)row * 1024 + lane * 16;
            *(u32x4*)xb = w0; *(u32x4*)(xb + 8) = w1;
            if ((lane & 3) == 0) ((float*)(F.ws + WS_SSQ))[((size_t)(lane >> 4) * TT + row) * 4 + ((lane >> 2) & 3)] = s;
        } else {
            const int mr = row - TT;
            bf16_t* mb = ((bf16_t*)(F.ws + WS_MB)) + (size_t)mr * 1024 + lane * 16;
            *(u32x4*)mb = w0; *(u32x4*)(mb + 8) = w1;
            s += __shfl_xor(s, 4); s += __shfl_xor(s, 8); s += __shfl_xor(s, 16); s += __shfl_xor(s, 32);
            if (lane == 0) ((float*)(F.ws + WS_MRS))[mr] = rsqrtf(s * (1.f / 1024.f) + 1e-6f);
        }
    }
    cvt_mixer(F, 0);
    cvt_ffn(F, 0);
}

DEV void small_proj(const Frame& F0) {
    REFRAME;
    const int lane = F.lane, fr = lane & 15, fq = lane >> 4, mt = F.wid & 3, nt = F.wid >> 2;
    const bool part = F.nb == 256;
    if (part && (F.bid >> 3) < 6) return;
    for (int c = part ? ((F.bid >> 3) - 6) * 8 + (F.bid & 7) : F.bid; c < NCH; c += part ? 208 : F.nb) {
        const int row = c * 64 + mt * 16 + fr;
        const bf16_t* a = ((bf16_t*)(F.ws + WS_XB)) + (size_t)row * 1024 + 8 * fq;
        const bf16_t* b = ((bf16_t*)(F.ws + WS_WMIX)) + WM_WSM + (size_t)(nt * 16 + fr) * 1024 + 8 * fq;
        f32x4 acc = {0.f, 0.f, 0.f, 0.f};
#pragma unroll 4
        for (int k = 0; k < 32; ++k) acc = MFMA16(*(const bf16x8*)(b + k * 32), *(const bf16x8*)(a + k * 32), acc);
        const float rs = row_rstd(((float*)(F.ws + WS_SSQ)), row);
        *(f32x4*)(((float*)(F.ws + WS_SC)) + (size_t)row * 32 + nt * 16 + 4 * fq) = acc * rs;
    }
}

DEV void gemm_epilogue(const Frame& F0, const GDesc& d, int l, f32x4 (&acc)[2][2][4][2]) {
    REFRAME;
    int lane_ = F.lane; asm volatile("" : "+v"(lane_));
    const int wr = F.wid >> 2, wc = F.wid & 3, fr = lane_ & 15, fq = lane_ >> 4;
    float* red = (float*)(F.lds + 131072);
    if (d.epi == EPI_SOFTMAX) {
        float mx[2][4];
#pragma unroll
        for (int ai = 0; ai < 2; ++ai)
#pragma unroll
            for (int m = 0; m < 4; ++m) {
                float v = -3.0e38f;
#pragma unroll
                for (int bj = 0; bj < 2; ++bj)
#pragma unroll
                    for (int n = 0; n < 2; ++n) { const f32x4 x = acc[ai][bj][m][n]; v = fmaxf(v, fmaxf(fmaxf(x[0], x[1]), fmaxf(x[2], x[3]))); }
                v = fmaxf(v, __shfl_xor(v, 16)); v = fmaxf(v, __shfl_xor(v, 32));
                if (fq == 0) red[(ai * 128 + wr * 64 + m * 16 + fr) * 4 + wc] = v;
            }
        __syncthreads();
#pragma unroll
        for (int ai = 0; ai < 2; ++ai)
#pragma unroll
            for (int m = 0; m < 4; ++m) {
                const f32x4 r4 = *(const f32x4*)(red + (ai * 128 + wr * 64 + m * 16 + fr) * 4);
                const float rm = fmaxf(fmaxf(r4[0], r4[1]), fmaxf(r4[2], r4[3]));
                mx[ai][m] = rm; float s = 0.f;
#pragma unroll
                for (int bj = 0; bj < 2; ++bj)
#pragma unroll
                    for (int n = 0; n < 2; ++n) { f32x4 x = acc[ai][bj][m][n];
#pragma unroll
                        for (int j = 0; j < 4; ++j) { x[j] = __expf(x[j] - rm); s += x[j]; }
                        acc[ai][bj][m][n] = x; }
                s += __shfl_xor(s, 16); s += __shfl_xor(s, 32);
                if (fq == 0) red[1024 + (ai * 128 + wr * 64 + m * 16 + fr) * 4 + wc] = s;
            }
        (void)mx;
        __syncthreads();
#pragma unroll
        for (int ai = 0; ai < 2; ++ai)
#pragma unroll
            for (int m = 0; m < 4; ++m) {
                const f32x4 r4 = *(const f32x4*)(red + 1024 + (ai * 128 + wr * 64 + m * 16 + fr) * 4);
                const float inv = 1.f / ((r4[0] + r4[1]) + (r4[2] + r4[3]));
                const bool valid = d.vai < 0 || (d.vai == ai && d.vwr == wr);
                const int row = d.orow + ai * 128 + wr * 64 + m * 16 + fr;
                if (valid) {
#pragma unroll
                    for (int bj = 0; bj < 2; ++bj)
#pragma unroll
                        for (int n = 0; n < 2; ++n) {
                            const int col = bj * 128 + wc * 32 + n * 16 + fq * 4;
                            *(u32x2*)(((bf16_t*)(F.ws + WS_P)) + (size_t)row * LDP + C_PR + d.head * 256 + col) = pk4(acc[ai][bj][m][n] * inv);
                        }
                }
            }
        __syncthreads();
        return;
    }
#pragma unroll
    for (int ai = 0; ai < 2; ++ai)
#pragma unroll
        for (int m = 0; m < 4; ++m) {
            const int row = d.orow + ai * 128 + wr * 64 + m * 16 + fr;
            float rs = 1.f, ss = 0.f;
            if (d.epi == EPI_PROJ || d.epi == EPI_UP || d.epi == EPI_Q) rs = row_rstd(((float*)(F.ws + WS_SSQ)), row);
            if (d.epi == EPI_Q) rs *= 0.0625f;
            if (d.epi == EPI_MEMK) rs = ((float*)(F.ws + WS_MRS))[row];
#pragma unroll
            for (int bj = 0; bj < 2; ++bj)
#pragma unroll
                for (int n = 0; n < 2; ++n) {
                    const int col = d.ocol + bj * 128 + wc * 32 + n * 16 + fq * 4;
                    f32x4 v = acc[ai][bj][m][n];
                    switch (d.epi) {
                    case EPI_UP: {
                        const int row_l = ai * 128 + wr * 64 + m * 16 + fr, cl = bj * 128 + wc * 32 + n * 16 + fq * 4;
                        *(u32x2*)((bf16_t*)F.lds + row_l * 264 + cl) = pk4(v * rs);
                    } break;
                    case EPI_PROJ: {
                        v = v * rs; const u32x2 w = pk4(v);
                        *(u32x2*)(((bf16_t*)(F.ws + WS_P)) + (size_t)row * LDP + col) = w;
                        if (m == 3 && fr >= 13 && col < 1536) {
                            const int chunk = row >> 6, hr = fr - 13;
                            *(u32x2*)(((bf16_t*)(F.ws + WS_KV)) + ((size_t)chunk * 3 + hr) * 1536 + col) = w;
                            if (chunk >= 512 || (chunk & 31) == 31) {
                                float* o = chunk < 512 ? F.out + O_GDNC_P + ((size_t)(l * 16 + (chunk >> 5)) * 3 + hr) * 1536 + col
                                                       : F.out + O_GDNC_S + ((size_t)(l * 8 + (chunk - 512)) * 3 + hr) * 1536 + col;
                                *(f32x4*)o = v;
                            }
                        }
                    } break;
                    case EPI_RESID: {
                        float* X = F.out + (size_t)row * 1024 + col;
                        f32x4 x = *(const f32x4*)X; x = x + v; *(f32x4*)X = x;
                        *(u32x2*)(((bf16_t*)(F.ws + WS_XB)) + (size_t)row * 1024 + col) = pk4(x);
                        ss += (x[0] * x[0] + x[1] * x[1]) + (x[2] * x[2] + x[3] * x[3]);
                    } break;
                    case EPI_Q: *(u32x2*)(((bf16_t*)(F.ws + WS_P)) + (size_t)row * LDP + C_Q + col) = pk4(v * rs); break;
                    case EPI_MEMK: {
                        v = v * rs;
                        *(f32x4*)(F.out + O_MEMK + ((size_t)l * 4096 + row) * 1024 + col) = v;
                        *(u32x2*)(((bf16_t*)(F.ws + WS_KV)) + (size_t)row * 1024 + col) = pk4(v);
                    } break;
                    case EPI_MEMV: {
                        const f32x4 r4 = *(const f32x4*)(((float*)(F.ws + WS_MRS)) + col);
                        v = v * r4;
                        float* o = F.out + O_MEMV + ((size_t)l * 4096 + col) * 1024 + row;
                        o[0] = v[0]; o[1024] = v[1]; o[2048] = v[2]; o[3072] = v[3];
                        const int b = col >> 8, h = row >> 8;
                        *(u32x2*)(((bf16_t*)(F.ws + WS_KV + 6144ull * 1024 * 2)) + ((size_t)(b * 4 + h) * 256 + (row & 255)) * 256 + (col & 255)) = pk4(v);
                    } break;
                    case EPI_OUTA: {
                        const f32x4 g = unpk4(*(const u32x2*)(((bf16_t*)(F.ws + WS_P)) + (size_t)row * LDP + C_GA + col));
                        f32x4 o; for (int j = 0; j < 4; ++j) o[j] = sigm(g[j]) * v[j];
                        *(u32x2*)(((bf16_t*)(F.ws + WS_P)) + (size_t)row * LDP + C_MRG + col) = pk4(o);
                    } break;
                    case EPI_OUTB: {
                        const f32x4 g = unpk4(*(const u32x2*)(((bf16_t*)(F.ws + WS_P)) + (size_t)row * LDP + C_GB + col));
                        f32x4 o = unpk4(*(const u32x2*)(((bf16_t*)(F.ws + WS_P)) + (size_t)row * LDP + C_MRG + col));
                        for (int j = 0; j < 4; ++j) o[j] += sigm(g[j]) * v[j];
                        *(u32x2*)(((bf16_t*)(F.ws + WS_P)) + (size_t)row * LDP + C_MRG + col) = pk4(o);
                    } break;
                    case EPI_ATTNO: {
                        const bool valid = d.vai < 0 || (d.vai == ai && d.vwr == wr);
                        if (valid) *(u32x2*)(((bf16_t*)(F.ws + WS_P)) + (size_t)row * LDP + C_O + d.head * 256 + col) = pk4(v);
                    } break;
                    default: break;
                    }
                }
            if (d.epi == EPI_RESID) {
                ss += __shfl_xor(ss, 16); ss += __shfl_xor(ss, 32);
                if (fq == 0) ((float*)(F.ws + WS_SSQ))[((size_t)(d.ocol >> 8) * TT + row) * 4 + wc] = ss;
            }
        }
    if (d.epi == EPI_UP) {
        bf16_t* ST = (bf16_t*)F.lds;
        const int pm = d.brow >> 8, pn = d.bcol >> 8;
        const bool samp = pm >= 128, needfix = !samp && (pm & 7) != 0;
        bf16_t* halo = ((bf16_t*)(F.ws + WS_KV)); bf16_t* raw01 = ((bf16_t*)(F.ws + WS_KV + 11714560ull));
        __syncthreads();
        {
            const int hsel = F.tid >> 6, cl4 = (F.tid & 63) * 4, ocol = ((cl4 >> 7) ? 2816 : 0) + 128 * pn + (cl4 & 127);
            const int row_l = (hsel >> 1) * 64 + 62 + (hsel & 1), chunk = (d.brow + row_l) >> 6, hr = hsel & 1;
            const u32x2 w = *(const u32x2*)(ST + row_l * 264 + cl4);
            *(u32x2*)(halo + ((size_t)chunk * 2 + hr) * 5632 + ocol) = w;
            if (chunk >= 512 || (chunk & 31) == 31) {
                float* o = chunk < 512 ? F.out + O_FFNC_P + ((size_t)(l * 16 + (chunk >> 5)) * 2 + hr) * 5632 + ocol
                                       : F.out + O_FFNC_S + ((size_t)(l * 8 + (chunk - 512)) * 2 + hr) * 5632 + ocol;
                *(f32x4*)o = unpk4(w);
            }
            if (needfix && hsel < 2) *(u32x2*)(raw01 + ((size_t)pm * 2 + hsel) * 5632 + ocol) = *(const u32x2*)(ST + hsel * 264 + cl4);
        }
        {
            const int cq = F.tid & 31, rg = F.tid >> 5, c4 = cq * 4, gcol = 128 * pn + c4, r0 = rg * 16;
            const float* cw = F.in[29] + (size_t)l * 3 * 5632; const float* cb = F.in[30] + (size_t)l * 5632;
            const f32x4 wg0 = *(const f32x4*)(cw + gcol), wg1 = *(const f32x4*)(cw + 5632 + gcol), wg2 = *(const f32x4*)(cw + 2 * 5632 + gcol), bg = *(const f32x4*)(cb + gcol);
            const f32x4 wv0 = *(const f32x4*)(cw + 2816 + gcol), wv1 = *(const f32x4*)(cw + 5632 + 2816 + gcol), wv2 = *(const f32x4*)(cw + 2 * 5632 + 2816 + gcol), bv = *(const f32x4*)(cb + 2816 + gcol);
            f32x4 g2 = {0.f, 0.f, 0.f, 0.f}, g1 = g2, v2 = g2, v1 = g2; bool skip2 = false;
            if ((samp ? (r0 & 63) : r0) != 0) {
                g2 = unpk4(*(const u32x2*)(ST + (r0 - 2) * 264 + c4)); g1 = unpk4(*(const u32x2*)(ST + (r0 - 1) * 264 + c4));
                v2 = unpk4(*(const u32x2*)(ST + (r0 - 2) * 264 + 128 + c4)); v1 = unpk4(*(const u32x2*)(ST + (r0 - 1) * 264 + 128 + c4));
            } else if (samp) {
                const float* sp = F.in[5] + (size_t)(l * 8 + (((d.brow + r0) >> 6) - 512)) * 2 * 5632;
                g2 = *(const f32x4*)(sp + gcol); g1 = *(const f32x4*)(sp + 5632 + gcol); v2 = *(const f32x4*)(sp + 2816 + gcol); v1 = *(const f32x4*)(sp + 5632 + 2816 + gcol);
            } else skip2 = needfix;
#pragma unroll 4
            for (int i = 0; i < 16; ++i) {
                const int row_l = r0 + i;
                const f32x4 g0 = unpk4(*(const u32x2*)(ST + row_l * 264 + c4)), v0 = unpk4(*(const u32x2*)(ST + row_l * 264 + 128 + c4));
                f32x4 o;
#pragma unroll
                for (int j = 0; j < 4; ++j) { const float yg = wg0[j] * g2[j] + wg1[j] * g1[j] + wg2[j] * g0[j] + bg[j], yv = wv0[j] * v2[j] + wv1[j] * v1[j] + wv2[j] * v0[j] + bv[j]; o[j] = silu(yg) * yv; }
                if (!(skip2 && i < 2)) *(u32x2*)(((bf16_t*)(F.ws + WS_P)) + (size_t)(d.brow + row_l) * LDP + gcol) = pk4(o);
                g2 = g1; g1 = g0; v2 = v1; v1 = v0;
            }
        }
        __syncthreads();
    }
}

DEV void sample_rows_gemm(const Frame& F0, const bf16_t* A, int lda, const bf16_t* Bt, int K, int resid) {
    REFRAME;
    if (F.nb != 256) return;
    const int fr = F.lane & 15, fq = F.lane >> 4, w = F.wid, rgp = F.bid >> 3, cg = F.bid & 7;
    const int row = 32768 + rgp * 16 + fr, colt = cg * 128 + w * 16;
    const bf16_t* ap = A + (size_t)row * lda + 8 * fq;
    const bf16_t* bp = Bt + (size_t)(colt + fr) * K + 8 * fq;
    f32x4 acc = {0.f, 0.f, 0.f, 0.f};
#pragma unroll 8
    for (int k = 0; k < K; k += 32) acc = MFMA16(*(const bf16x8*)(bp + k), *(const bf16x8*)(ap + k), acc);
    const int col = colt + 4 * fq;
    if (resid == 1) {
        float* X = F.out + (size_t)row * 1024 + col;
        f32x4 x = *(const f32x4*)X; x = x + acc; *(f32x4*)X = x;
        *(u32x2*)(((bf16_t*)(F.ws + WS_XB)) + (size_t)row * 1024 + col) = pk4(x);
        float ss = (x[0] * x[0] + x[1] * x[1]) + (x[2] * x[2] + x[3] * x[3]);
        ss += __shfl_xor(ss, 16); ss += __shfl_xor(ss, 32);
        float* red = (float*)F.lds;
        __syncthreads();
        if (fq == 0) red[fr * 8 + w] = ss;
        __syncthreads();
        if (F.tid < 32) {
            const int r = F.tid & 15, g = F.tid >> 4, c0 = cg * 128 + g * 64;
            const float t = (red[r * 8 + g * 4] + red[r * 8 + g * 4 + 1]) + (red[r * 8 + g * 4 + 2] + red[r * 8 + g * 4 + 3]);
            ((float*)(F.ws + WS_SSQ))[((size_t)(c0 >> 8) * TT + 32768 + rgp * 16 + r) * 4 + ((c0 >> 6) & 3)] = t;
        }
        __syncthreads();
    } else if (resid == 0) {
        const float rs = row_rstd(((float*)(F.ws + WS_SSQ)), row) * 0.0625f;
        *(u32x2*)(((bf16_t*)(F.ws + WS_P)) + (size_t)row * LDP + C_Q + col) = pk4(acc * rs);
    } else {
        bf16_t* prow = ((bf16_t*)(F.ws + WS_P)) + (size_t)row * LDP;
        const f32x4 g = unpk4(*(const u32x2*)(prow + (resid == 2 ? C_GA : C_GB) + col));
        f32x4 o = {0.f, 0.f, 0.f, 0.f};
        if (resid == 3) o = unpk4(*(const u32x2*)(prow + C_MRG + col));
#pragma unroll
        for (int j = 0; j < 4; ++j) o[j] += sigm(g[j]) * acc[j];
        *(u32x2*)(prow + C_MRG + col) = pk4(o);
    }
}

enum { GP_IN = 0, GP_OUT, GP_WO, GP_MQ, GP_ATTN, GP_MO, GP_UP, GP_DOWN, GP_ATTN2, GP_OUT2, GP_MEMKV };
DEV void gemm_phase(const Frame& F0, int kind, int l) {
    REFRAME;
    int nunits = 0;
    switch (kind) { case GP_IN: case GP_UP: nunits = 130 * 22; break; case GP_OUT: nunits = 520 + 128; break; case GP_OUT2: nunits = 520; break; case GP_ATTN: case GP_ATTN2: nunits = 512 + 32; break; default: nunits = 520; }
    const bool srow = (F.nb == 256) && (kind == GP_WO || kind == GP_MQ || kind == GP_MO || kind == GP_DOWN || kind == GP_OUT || kind == GP_OUT2);
    if (srow) nunits = 512;
    if (kind == GP_MEMKV) nunits = 128;
    f32x4 acc[2][2][4][2];
    const bool xmap = (F.nb == 256) && (kind == GP_IN || kind == GP_UP || kind == GP_WO || kind == GP_MQ || kind == GP_MO || kind == GP_DOWN || kind == GP_OUT2 || (kind == GP_OUT && srow));
    const int xcd = F.bid & 7, slot = F.bid >> 3, w_lo = (int)(((long)nunits * xcd) >> 3), w_hi = (int)(((long)nunits * (xcd + 1)) >> 3);
    const bool mkv = kind == GP_MEMKV;
    for (int u0 = mkv ? (F.bid >= 192 ? F.bid - 192 : nunits) : (xmap ? w_lo + slot : F.bid); u0 < (xmap ? w_hi : nunits); u0 += mkv ? 64 : (xmap ? 32 : F.nb)) {
        int u = u0;
        if (xmap) { const int nn = (kind == GP_IN || kind == GP_UP) ? 22 : 4; const int nm = srow ? 128 : 130; const int pn_ = u0 / nm, pm_ = u0 % nm; u = pm_ * nn + pn_; }
        GDesc d;
        { const int sub = (kind == GP_ATTN2 || kind == GP_OUT2) ? 1 : 0;
            d.vai = -1; d.vwr = 0; d.head = 0;
            switch (kind) {
            case GP_IN: { const int pm = u / 22, pn = u % 22; d.A = ((bf16_t*)(F.ws + WS_XB)); d.lda = 1024; d.Bt = ((bf16_t*)(F.ws + WS_WMIX)) + WM_WIN; d.ldb = 1024; d.K = 1024; d.brow = pm * 256; d.bcol = pn * 256; d.epi = EPI_PROJ; d.orow = d.brow; d.ocol = d.bcol; } break;
            case GP_UP: { const int pm = u / 22, pn = u % 22; d.A = ((bf16_t*)(F.ws + WS_XB)); d.lda = 1024; d.Bt = ((bf16_t*)(F.ws + WS_WFFN)) + WF_UP; d.ldb = 1024; d.K = 1024; d.brow = pm * 256; d.bcol = pn * 256; d.epi = EPI_UP; d.orow = d.brow; d.ocol = d.bcol; } break;
            case GP_MEMKV: case GP_OUT: case GP_OUT2:
                if (kind == GP_MEMKV) u += 520;
                if (u < 520) { const int pm = u >> 2, pn = u & 3; d.A = ((bf16_t*)(F.ws + WS_P)) + (sub == 0 ? C_ZA : C_ZB); d.lda = LDP; d.Bt = ((bf16_t*)(F.ws + WS_WMIX)) + (sub == 0 ? WM_WOA : WM_WOB); d.ldb = 512; d.K = 512;
                               d.brow = pm * 256; d.bcol = pn * 256; d.epi = sub == 0 ? EPI_OUTA : EPI_OUTB; d.orow = d.brow; d.ocol = d.bcol; }
                else if (u < 520 + 64) { const int v = u - 520, pm = v >> 2, pn = v & 3; d.A = ((bf16_t*)(F.ws + WS_MB)); d.lda = 1024; d.Bt = ((bf16_t*)(F.ws + WS_WMIX)) + WM_WMK; d.ldb = 1024; d.K = 1024; d.brow = pm * 256; d.bcol = pn * 256; d.epi = EPI_MEMK; d.orow = d.brow; d.ocol = d.bcol; }
                else { const int v = u - 584, pm = v & 3, pn = v >> 2; d.A = ((bf16_t*)(F.ws + WS_WMIX)) + WM_WMV; d.lda = 1024; d.Bt = ((bf16_t*)(F.ws + WS_MB)); d.ldb = 1024; d.K = 1024; d.brow = pm * 256; d.bcol = pn * 256; d.epi = EPI_MEMV; d.orow = d.brow; d.ocol = d.bcol; }
                break;
            case GP_WO: { const int pm = u >> 2, pn = u & 3; d.A = ((bf16_t*)(F.ws + WS_P)) + C_MRG; d.lda = LDP; d.Bt = ((bf16_t*)(F.ws + WS_WMIX)) + WM_WO; d.ldb = 1024; d.K = 1024; d.brow = pm * 256; d.bcol = pn * 256; d.epi = EPI_RESID; d.orow = d.brow; d.ocol = d.bcol; } break;
            case GP_MQ: { const int pm = u >> 2, pn = u & 3; d.A = ((bf16_t*)(F.ws + WS_XB)); d.lda = 1024; d.Bt = ((bf16_t*)(F.ws + WS_WMIX)) + WM_WMQ; d.ldb = 1024; d.K = 1024; d.brow = pm * 256; d.bcol = pn * 256; d.epi = EPI_Q; d.orow = d.brow; d.ocol = d.bcol; } break;
            case GP_MO: { const int pm = u >> 2, pn = u & 3; d.A = ((bf16_t*)(F.ws + WS_P)) + C_O; d.lda = LDP; d.Bt = ((bf16_t*)(F.ws + WS_WMIX)) + WM_WMO; d.ldb = 1024; d.K = 1024; d.brow = pm * 256; d.bcol = pn * 256; d.epi = EPI_RESID; d.orow = d.brow; d.ocol = d.bcol; } break;
            case GP_DOWN: { const int pm = u >> 2, pn = u & 3; d.A = ((bf16_t*)(F.ws + WS_P)); d.lda = LDP; d.Bt = ((bf16_t*)(F.ws + WS_WFFN)) + WF_DN; d.ldb = 2816; d.K = 2816; d.brow = pm * 256; d.bcol = pn * 256; d.epi = EPI_RESID; d.orow = d.brow; d.ocol = d.bcol; } break;
            case GP_ATTN: case GP_ATTN2: {
                int pm, h, b;
                if (u < 512) { pm = u >> 2; h = u & 3; b = pm >> 3; }
                else { const int v = u - 512; h = v & 3; const int bi = (v >> 2) & 3, t = v >> 4; pm = 128 + t; b = 16 + 4 * t + bi; d.vai = bi >> 1; d.vwr = bi & 1; }
                d.head = h; d.brow = pm * 256; d.orow = d.brow; d.ocol = 0; d.K = 256; d.bcol = 0;
                if (sub == 0) { d.A = ((bf16_t*)(F.ws + WS_P)) + C_Q + h * 256; d.lda = LDP; d.Bt = ((bf16_t*)(F.ws + WS_KV)) + (size_t)b * 256 * 1024 + h * 256; d.ldb = 1024; d.epi = EPI_SOFTMAX; }
                else { d.A = ((bf16_t*)(F.ws + WS_P)) + C_PR + h * 256; d.lda = LDP; d.Bt = ((bf16_t*)(F.ws + WS_KV + 6144ull * 1024 * 2)) + (size_t)(b * 4 + h) * 65536; d.ldb = 256; d.epi = EPI_ATTNO; }
            } break;
            }
        }
        gemm_core(d.A, d.lda, d.Bt, d.ldb, d.K, d.brow, d.bcol, acc, (bf16_t*)F.lds);
        gemm_epilogue(F, d, l, acc);
    }
    if (srow) {
        __syncthreads();
        if (kind == GP_WO) sample_rows_gemm(F, ((bf16_t*)(F.ws + WS_P)) + C_MRG, LDP, ((bf16_t*)(F.ws + WS_WMIX)) + WM_WO, 1024, 1);
        else if (kind == GP_MQ) sample_rows_gemm(F, ((bf16_t*)(F.ws + WS_XB)), 1024, ((bf16_t*)(F.ws + WS_WMIX)) + WM_WMQ, 1024, 0);
        else if (kind == GP_OUT) sample_rows_gemm(F, ((bf16_t*)(F.ws + WS_P)) + C_ZA, LDP, ((bf16_t*)(F.ws + WS_WMIX)) + WM_WOA, 512, 2);
        else if (kind == GP_OUT2) sample_rows_gemm(F, ((bf16_t*)(F.ws + WS_P)) + C_ZB, LDP, ((bf16_t*)(F.ws + WS_WMIX)) + WM_WOB, 512, 3);
        else if (kind == GP_MO) sample_rows_gemm(F, ((bf16_t*)(F.ws + WS_P)) + C_O, LDP, ((bf16_t*)(F.ws + WS_WMIX)) + WM_WMO, 1024, 1);
        else sample_rows_gemm(F, ((bf16_t*)(F.ws + WS_P)), LDP, ((bf16_t*)(F.ws + WS_WFFN)) + WF_DN, 2816, 1);
    }
}

DEV void sample_kv(const Frame& F0, int l) {
    REFRAME;
    const float* ck = F.in[6] + (size_t)l * 2097152; const float* cv = F.in[7] + (size_t)l * 2097152;
    const bool idle = F.nb == 256;
    if (idle && F.bid < 192) return;
    for (int i = (idle ? F.bid - 192 : F.bid) * 512 + F.tid; i < 262144; i += (idle ? 64 : F.nb) * 512) {
        const f32x4 a = *(const f32x4*)(ck + (size_t)i * 8), b = *(const f32x4*)(ck + (size_t)i * 8 + 4);
        u32x4 w; w.x = pk2(a[0], a[1]); w.y = pk2(a[2], a[3]); w.z = pk2(b[0], b[1]); w.w = pk2(b[2], b[3]);
        *(u32x4*)(((bf16_t*)(F.ws + WS_KV)) + 4096ull * 1024 + (size_t)i * 8) = w;
        const int dd = i & 255, m8 = (i >> 8) & 31, h = (i >> 13) & 3, bb = i >> 15;
        const float* s = cv + ((size_t)(bb * 256 + m8 * 8) * 4 + h) * 256 + dd;
        u32x4 x; x.x = pk2(s[0], s[1024]); x.y = pk2(s[2048], s[3072]); x.z = pk2(s[4096], s[5120]); x.w = pk2(s[6144], s[7168]);
        *(u32x4*)(((bf16_t*)(F.ws + WS_KV + 6144ull * 1024 * 2)) + ((size_t)((16 + bb) * 4 + h) * 256 + dd) * 256 + m8 * 8) = x;
    }
}

DEV void g1_gdn(const Frame& F0, int l, int c, int h) {
    REFRAME;
    float* Fq = (float*)F.lds;
    bf16_t* VS = (bf16_t*)(F.lds + 66560);
    bf16_t* QN = (bf16_t*)(F.lds + 82944);
    bf16_t* KN = (bf16_t*)(F.lds + 100352);
    float* AM = (float*)(F.lds + 117760);
    float* sB = (float*)(F.lds + 135168); float* sG = sB + 64; float* sRQ = sB + 128; float* sRK = sB + 192;
    const int tid = F.tid, lane = F.lane, t0 = c * 64;
    const bool first = c >= 512 || (c & 31) == 0; const bool sample = c >= 512;
    __syncthreads();
    if (F.wid == 0) {
        const int t = t0 + lane;
        const float braw = ((float*)(F.ws + WS_SC))[(size_t)t * 32 + h], araw = ((float*)(F.ws + WS_SC))[(size_t)t * 32 + 4 + h];
        const float beta = sigm(braw);
        float g = -__expf(F.in[12][l * 4 + h]) * softplus(araw + F.in[13][l * 4 + h]);
#pragma unroll
        for (int off = 1; off < 64; off <<= 1) { const float n = __shfl_up(g, off); if (lane >= off) g += n; }
        sB[lane] = beta; sG[lane] = g;
        if (!F.dry) ((float*)(F.ws + WS_BG))[((size_t)c * 4 + h) * 128 + lane] = beta; if (!F.dry) ((float*)(F.ws + WS_BG))[((size_t)c * 4 + h) * 128 + 64 + lane] = g;
    }
    __syncthreads();
    const float* cw = F.in[11] + (size_t)l * 4 * 1536;
    if (tid < 384) {
        const int cp = tid % 192, rh = tid / 192, which = cp >> 6, cc = (cp & 63) * 2, pcol = which * 512 + h * 128 + cc;
        const f32x2 w0 = *(const f32x2*)(cw + pcol), w1 = *(const f32x2*)(cw + 1536 + pcol), w2 = *(const f32x2*)(cw + 2 * 1536 + pcol), w3 = *(const f32x2*)(cw + 3 * 1536 + pcol);
        float x0[35], x1[35];
#pragma unroll
        for (int i = 0; i < 3; ++i) {
            x0[i] = 0.f; x1[i] = 0.f;
            if (rh == 1) { const unsigned u = *(const unsigned*)(((bf16_t*)(F.ws + WS_P)) + (size_t)(t0 + 29 + i) * LDP + pcol); x0[i] = bflo(u); x1[i] = bfhi(u); }
            else if (!first) { const unsigned u = *(const unsigned*)(((bf16_t*)(F.ws + WS_KV)) + ((size_t)(c - 1) * 3 + i) * 1536 + pcol); x0[i] = bflo(u); x1[i] = bfhi(u); }
            else if (sample) { const f32x2 f = *(const f32x2*)(F.in[3] + ((size_t)(l * 8 + (c - 512)) * 3 + i) * 1536 + pcol); x0[i] = f[0]; x1[i] = f[1]; }
        }
#pragma unroll
        for (int i = 0; i < 32; ++i) { const unsigned u = *(const unsigned*)(((bf16_t*)(F.ws + WS_P)) + (size_t)(t0 + 32 * rh + i) * LDP + pcol); x0[3 + i] = bflo(u); x1[3 + i] = bfhi(u); }
#pragma unroll
        for (int r = 0; r < 32; ++r) {
            float a0 = w0[0] * x0[r] + w1[0] * x0[r + 1] + w2[0] * x0[r + 2] + w3[0] * x0[r + 3];
            float a1 = w0[1] * x1[r] + w1[1] * x1[r + 1] + w2[1] * x1[r + 2] + w3[1] * x1[r + 3];
            a0 = silu(a0); a1 = silu(a1);
            const int rr = 32 * rh + r;
            if (which < 2) { *(f32x2*)(Fq + rr * 260 + which * 128 + cc) = (f32x2){a0, a1}; }
            else { const float be = sB[rr]; *(unsigned*)(VS + rr * 128 + cc) = pk2(a0 * be, a1 * be); }
        }
    }
    __syncthreads();
    {
        const int r = tid >> 3, j = tid & 7; const float* p = Fq + r * 260 + j * 32; float s = 0.f;
#pragma unroll
        for (int i = 0; i < 32; ++i) s += p[i] * p[i];
        s += __shfl_xor(s, 1); s += __shfl_xor(s, 2);
        if ((j & 3) == 0) { if (j == 0) sRQ[r] = rsqrtf(s + 1e-6f) * 0.08838834764831845f; else sRK[r] = rsqrtf(s + 1e-6f); }
    }
    __syncthreads();
    for (int idx = tid; idx < 64 * 64; idx += 512) {
        const int r = idx >> 6, c4 = (idx & 63) * 4; const bool isq = c4 < 128;
        f32x4 v = *(const f32x4*)(Fq + r * 260 + c4); v = v * (isq ? sRQ[r] : sRK[r]);
        const u32x2 w = pk4(v);
        if (isq) { *(u32x2*)(QN + r * 136 + c4) = w; if (!F.dry) *(u32x2*)(((bf16_t*)(F.ws + WS_P)) + (size_t)(t0 + r) * LDP + C_QA + h * 128 + c4) = w; }
        else { *(u32x2*)(KN + r * 136 + c4 - 128) = w; if (!F.dry) *(u32x2*)(((bf16_t*)(F.ws + WS_P)) + (size_t)(t0 + r) * LDP + C_KA + h * 128 + c4 - 128) = w; }
    }
    for (int idx = tid; idx < 64 * 32; idx += 512) {
        const int r = idx >> 5, c4 = (idx & 31) * 4;
        if (!F.dry) *(u32x2*)(((bf16_t*)(F.ws + WS_P)) + (size_t)(t0 + r) * LDP + C_VA + h * 128 + c4) = *(const u32x2*)(VS + r * 128 + c4);
    }
    __syncthreads();
    {
        const int fr = lane & 15, fq = lane >> 4, which = F.wid >> 2, it = F.wid & 3;
        const bf16_t* X = which ? QN : KN;
        const int crow = 16 * it + fr; const float gc = sG[crow], bc = sB[crow];
        for (int jt = 0; jt < 4; ++jt) {
            f32x4 a = {0.f, 0.f, 0.f, 0.f};
            if (jt <= it) {
#pragma unroll
                for (int ks = 0; ks < 4; ++ks) a = MFMA16(ldfrag(KN, 16 * jt + fr, 136, 32 * ks, fq), ldfrag(X, crow, 136, 32 * ks, fq), a);
            }
            f32x4 o;
#pragma unroll
            for (int j = 0; j < 4; ++j) {
                const int s = 16 * jt + 4 * fq + j;
                const bool keep = which ? (s <= crow) : (s < crow);
                const float dec = keep ? __expf(gc - sG[s]) : 0.f;
                o[j] = a[j] * dec * (which ? 1.f : bc);
            }
            if (which) { if (!F.dry) *(u32x2*)(((bf16_t*)(F.ws + WS_XB)) + (size_t)(t0 + crow) * LDE + h * 128 + 64 + 16 * jt + 4 * fq) = pk4(o); }
            else *(f32x4*)(AM + crow * 68 + 16 * jt + 4 * fq) = o;
        }
    }
    __syncthreads();
    {
        float* TF = (float*)F.lds;
        float* MS = (float*)(F.lds + 20480);
        const int w = F.wid;
        if (w == 0) {
            const int blk = lane >> 4, cc = lane & 15, base = blk * 16;
            float Tc[16];
#pragma unroll
            for (int i = 0; i < 16; ++i) {
                float a = (i == cc) ? 1.f : 0.f;
#pragma unroll
                for (int j = 0; j < i; ++j) a -= AM[(base + i) * 68 + base + j] * Tc[j];
                Tc[i] = a;
            }
#pragma unroll
            for (int i = 0; i < 16; ++i) TF[(base + i) * 68 + base + cc] = Tc[i];
        }
        __syncthreads();
#pragma unroll 1
        for (int dd = 1; dd < 4; ++dd) {
            if (w < 4 - dd) {
                const int I = w + dd, J = w, r = lane >> 2, c4 = (lane & 3) * 4;
                f32x4 mm = {0.f, 0.f, 0.f, 0.f};
                for (int K = J; K < I; ++K)
#pragma unroll
                    for (int k = 0; k < 16; ++k) { const float a = AM[(I * 16 + r) * 68 + K * 16 + k]; const f32x4 t = *(const f32x4*)(TF + (K * 16 + k) * 68 + J * 16 + c4); mm = mm + a * t; }
                float* ms = MS + w * 256;
                *(f32x4*)(ms + r * 16 + c4) = mm;
                asm volatile("s_waitcnt lgkmcnt(0)" ::: "memory");
                f32x4 o = {0.f, 0.f, 0.f, 0.f};
#pragma unroll
                for (int k = 0; k < 16; ++k) { const float a = TF[(I * 16 + r) * 68 + I * 16 + k]; const f32x4 t = *(const f32x4*)(ms + k * 16 + c4); o = o - a * t; }
                *(f32x4*)(TF + (I * 16 + r) * 68 + J * 16 + c4) = o;
            }
            __syncthreads();
        }
        {
            const int r = tid >> 3, c8 = (tid & 7) * 8; const bool z = (c8 >> 4) > (r >> 4);
            const f32x4 a = z ? (f32x4){0.f, 0.f, 0.f, 0.f} : *(const f32x4*)(TF + r * 68 + c8), b = z ? (f32x4){0.f, 0.f, 0.f, 0.f} : *(const f32x4*)(TF + r * 68 + c8 + 4);
            u32x4 o; o.x = pk2(a[0], a[1]); o.y = pk2(a[2], a[3]); o.z = pk2(b[0], b[1]); o.w = pk2(b[2], b[3]);
            if (!F.dry) *(u32x4*)(((bf16_t*)(F.ws + WS_XB)) + (size_t)(t0 + r) * LDE + h * 128 + c8) = o;
        }
    }
}

DEV void g1_gla(const Frame& F0, int l, int c, int h) {
    REFRAME;
    float* GL = (float*)F.lds;
    float* LA = (float*)(F.lds + 4096);
    bf16_t* QG = (bf16_t*)(F.lds + 20736);
    bf16_t* KI = (bf16_t*)(F.lds + 29952);
    const int tid = F.tid, lane = F.lane, t0 = c * 64;
    __syncthreads();
    if (tid < 256) { const int r = tid >> 2, q4 = (tid & 3) * 4; *(f32x4*)(GL + r * 16 + q4) = *(const f32x4*)(((float*)(F.ws + WS_SC)) + (size_t)(t0 + r) * 32 + 8 + q4); }
    __syncthreads();
    {
        const int dk = tid & 63, rb = tid >> 6;
        float w2[16];
#pragma unroll
        for (int i = 0; i < 16; ++i) w2[i] = F.in[15][(size_t)(l * 16 + i) * 256 + h * 64 + dk];
        const float bias = F.in[16][l * 256 + h * 64 + dk];
#pragma unroll
        for (int rr = 0; rr < 8; ++rr) {
            const int r = rb * 8 + rr; float x = bias;
#pragma unroll
            for (int i = 0; i < 16; ++i) x += GL[r * 16 + i] * w2[i];
            LA[r * 65 + dk] = logsigmoid(x) * 0.0625f;
        }
    }
    __syncthreads();
    if (tid < 64) {
        float g = 0.f;
#pragma unroll 8
        for (int r = 0; r < 64; ++r) { g += LA[r * 65 + tid]; LA[r * 65 + tid] = g; }
        if (!F.dry) ((float*)(F.ws + WS_DL))[((size_t)c * 4 + h) * 64 + tid] = __expf(g);
    }
    __syncthreads();
    for (int idx = tid; idx < 64 * 16; idx += 512) {
        const int r = idx >> 4, c4 = (idx & 15) * 4;
        bf16_t* qp = ((bf16_t*)(F.ws + WS_P)) + (size_t)(t0 + r) * LDP + C_QB + h * 64 + c4; bf16_t* kp = ((bf16_t*)(F.ws + WS_P)) + (size_t)(t0 + r) * LDP + C_KB + h * 64 + c4;
        const f32x4 q = unpk4(*(const u32x2*)qp), k = unpk4(*(const u32x2*)kp);
        f32x4 qg, ki, kg;
#pragma unroll
        for (int j = 0; j < 4; ++j) { const float g = LA[r * 65 + c4 + j], gl = LA[63 * 65 + c4 + j];
            qg[j] = q[j] * 0.125f * __expf(g); ki[j] = k[j] * __expf(-g); kg[j] = k[j] * __expf(gl - g); }
        const u32x2 wq = pk4(qg);
        *(u32x2*)(QG + r * 72 + c4) = wq; *(u32x2*)(KI + r * 72 + c4) = pk4(ki);
        if (!F.dry) *(u32x2*)qp = wq; if (!F.dry) *(u32x2*)kp = pk4(kg);
    }
    __syncthreads();
    {
        const int fr = lane & 15, fq = lane >> 4, it = F.wid >> 1; const int crow = 16 * it + fr;
#pragma unroll
        for (int q = 0; q < 2; ++q) {
            const int jt = (F.wid & 1) * 2 + q;
            f32x4 a = {0.f, 0.f, 0.f, 0.f};
            if (jt <= it) {
#pragma unroll
                for (int ks = 0; ks < 2; ++ks) a = MFMA16(ldfrag(KI, 16 * jt + fr, 72, 32 * ks, fq), ldfrag(QG, crow, 72, 32 * ks, fq), a);
            }
#pragma unroll
            for (int j = 0; j < 4; ++j) if (16 * jt + 4 * fq + j > crow) a[j] = 0.f;
            if (!F.dry) *(u32x2*)(((bf16_t*)(F.ws + WS_XB)) + (size_t)(t0 + crow) * LDE + 512 + h * 64 + 16 * jt + 4 * fq) = pk4(a);
        }
    }
}

DEV void g2_gdn(const Frame& F0, int l, int s, int h) {
    REFRAME;
    bf16_t* QN = (bf16_t*)F.lds;
    bf16_t* KN = (bf16_t*)(F.lds + 17408);
    bf16_t* KT = (bf16_t*)(F.lds + 34816);
    bf16_t* TM = (bf16_t*)(F.lds + 53248);
    bf16_t* AQ = (bf16_t*)(F.lds + 62464);
    float* sB = (float*)(F.lds + 71680); float* sG = sB + 64;
    float* RED = (float*)(F.lds + 72192);
    bf16_t* VV = (bf16_t*)(F.lds + 74240);
    bf16_t* ZZ0 = (bf16_t*)(F.lds + 91648);
    const int tid = F.tid, lane = F.lane, w = F.wid, fr = lane & 15, fq = lane >> 4;
    const bool sample = s >= 16; const int nchunk = sample ? 1 : 32; const int tbase = sample ? 32768 + (s - 16) * 64 : s * 2048;
    const int dvc = h * 128 + 16 * w + fr;
    f32x4 S[8];
#pragma unroll
    for (int mt = 0; mt < 8; ++mt) {
        if (sample) { const float* sp = F.in[2] + ((size_t)((l * 8 + (s - 16)) * 4 + h) * 128) * 128;
#pragma unroll
            for (int j = 0; j < 4; ++j) S[mt][j] = sp[(size_t)(16 * mt + 4 * fq + j) * 128 + 16 * w + fr]; }
        else S[mt] = (f32x4){0.f, 0.f, 0.f, 0.f};
    }
    const float gn = F.in[14][l * 128 + 16 * w + fr];
    u32x4 pq[2], pk[2], pv[2], pz[2], pt, pa; float pbg = 0.f;
#define G2_FETCH(T0) do { int tq_ = tid; asm volatile("" : "+v"(tq_)); _Pragma("unroll") for (int i = 0; i < 2; ++i) { const int p_ = tq_ + 512 * i, r_ = p_ >> 4, c_ = (p_ & 15) * 8; \
        const bf16_t* rp_ = ((bf16_t*)(F.ws + WS_P)) + (size_t)((T0) + r_) * LDP + h * 128 + c_; \
        pq[i] = *(const u32x4*)(rp_ + C_QA); pk[i] = *(const u32x4*)(rp_ + C_KA); pv[i] = *(const u32x4*)(rp_ + C_VA); pz[i] = *(const u32x4*)(rp_ + C_ZA); } \
      { const int r_ = tq_ >> 3, c_ = (tq_ & 7) * 8; const bf16_t* ep_ = ((bf16_t*)(F.ws + WS_XB)) + (size_t)((T0) + r_) * LDE + h * 128 + c_; pt = *(const u32x4*)ep_; pa = *(const u32x4*)(ep_ + 64); } \
      if (tq_ < 128) pbg = ((float*)(F.ws + WS_BG))[((size_t)((T0) >> 6) * 4 + h) * 128 + tq_]; } while (0)
#define G2_PUT(PAR) do { int tq_ = tid; asm volatile("" : "+v"(tq_)); bf16_t* zz_ = ZZ0 + (PAR) * (64 * 136); _Pragma("unroll") for (int i = 0; i < 2; ++i) { const int p_ = tq_ + 512 * i, r = p_ >> 4, c8 = (p_ & 15) * 8; const u32x4 k = pk[i]; \
        *(u32x4*)(QN + r * 136 + c8) = pq[i]; *(u32x4*)(KN + r * 136 + c8) = k; *(u32x4*)(VV + r * 136 + c8) = pv[i]; *(u32x4*)(zz_ + r * 136 + c8) = pz[i]; \
        KT[(c8 + 0) * 72 + r] = (bf16_t)(k.x & 0xffff); KT[(c8 + 1) * 72 + r] = (bf16_t)(k.x >> 16); KT[(c8 + 2) * 72 + r] = (bf16_t)(k.y & 0xffff); KT[(c8 + 3) * 72 + r] = (bf16_t)(k.y >> 16); \
        KT[(c8 + 4) * 72 + r] = (bf16_t)(k.z & 0xffff); KT[(c8 + 5) * 72 + r] = (bf16_t)(k.z >> 16); KT[(c8 + 6) * 72 + r] = (bf16_t)(k.w & 0xffff); KT[(c8 + 7) * 72 + r] = (bf16_t)(k.w >> 16); } \
      { const int r = tq_ >> 3, c8 = (tq_ & 7) * 8; *(u32x4*)(TM + r * 72 + c8) = pt; *(u32x4*)(AQ + r * 72 + c8) = pa; } \
      if (tq_ < 128) sB[tq_] = pbg; } while (0)
    __syncthreads();
    G2_FETCH(tbase); G2_PUT(0);
    __syncthreads();
    for (int n = 0; n < nchunk; ++n) {
        const int t0 = tbase + n * 64;
        const bf16_t* ZZ = ZZ0 + (n & 1) * (64 * 136);
        f32x4 kS[4], qS[4], vn[4], o[4];
#pragma unroll
        for (int mt = 0; mt < 4; ++mt) { kS[mt] = (f32x4){0.f, 0.f, 0.f, 0.f}; qS[mt] = kS[mt]; vn[mt] = kS[mt]; }
#pragma unroll
        for (int ks = 0; ks < 4; ++ks) {
            const bf16x8 sf = mk8(pk4(S[2 * ks]), pk4(S[2 * ks + 1]));
#pragma unroll
            for (int mt = 0; mt < 4; ++mt) {
                kS[mt] = MFMA16(ldfragp(KN, 16 * mt + fr, 136, 32 * ks, fq), sf, kS[mt]);
                qS[mt] = MFMA16(ldfragp(QN, 16 * mt + fr, 136, 32 * ks, fq), sf, qS[mt]);
            }
        }
        const float glast = sG[63];
        f32x4 eg[4], tmp[4];
#pragma unroll
        for (int mt = 0; mt < 4; ++mt)
#pragma unroll
            for (int j = 0; j < 4; ++j) {
                const int row = 16 * mt + 4 * fq + j;
                const float e = __expf(sG[row]); eg[mt][j] = e;
                const float vv = bf2f(VV[row * 136 + 16 * w + fr]);
                tmp[mt][j] = vv - sB[row] * e * kS[mt][j];
            }
#pragma unroll
        for (int ks = 0; ks < 2; ++ks) {
            const bf16x8 tf = mk8(pk4(tmp[2 * ks]), pk4(tmp[2 * ks + 1]));
#pragma unroll
            for (int mt = 0; mt < 4; ++mt) vn[mt] = MFMA16(ldfragp(TM, 16 * mt + fr, 72, 32 * ks, fq), tf, vn[mt]);
        }
#pragma unroll
        for (int mt = 0; mt < 4; ++mt) o[mt] = eg[mt] * qS[mt];
#pragma unroll
        for (int ks = 0; ks < 2; ++ks) {
            const bf16x8 vf = mk8(pk4(vn[2 * ks]), pk4(vn[2 * ks + 1]));
#pragma unroll
            for (int mt = 0; mt < 4; ++mt) o[mt] = MFMA16(ldfragp(AQ, 16 * mt + fr, 72, 32 * ks, fq), vf, o[mt]);
        }
        const float dl = __expf(glast);
#pragma unroll
        for (int mt = 0; mt < 4; ++mt)
#pragma unroll
            for (int j = 0; j < 4; ++j) vn[mt][j] *= __expf(glast - sG[16 * mt + 4 * fq + j]);
#pragma unroll
        for (int mt = 0; mt < 8; ++mt) S[mt] = S[mt] * dl;
#pragma unroll
        for (int ks = 0; ks < 2; ++ks) {
            const bf16x8 vf = mk8(pk4(vn[2 * ks]), pk4(vn[2 * ks + 1]));
#pragma unroll
            for (int mt = 0; mt < 8; ++mt) S[mt] = MFMA16(ldfragp(KT, 16 * mt + fr, 72, 32 * ks, fq), vf, S[mt]);
        }
#pragma unroll
        for (int mt = 0; mt < 4; ++mt)
#pragma unroll
            for (int j = 0; j < 4; ++j) {
                float p = o[mt][j] * o[mt][j];
                p += __shfl_xor(p, 1); p += __shfl_xor(p, 2); p += __shfl_xor(p, 4); p += __shfl_xor(p, 8);
                if (fr == 0) RED[(16 * mt + 4 * fq + j) * 8 + w] = p;
            }
        __syncthreads();
        if (n + 1 < nchunk) G2_FETCH(t0 + 64);
        __builtin_amdgcn_sched_barrier(0);
#pragma unroll
        for (int mt = 0; mt < 4; ++mt)
#pragma unroll
            for (int j = 0; j < 4; ++j) {
                const int row = 16 * mt + 4 * fq + j;
                const f32x4 r0 = *(const f32x4*)(RED + row * 8), r1 = *(const f32x4*)(RED + row * 8 + 4);
                const float ssum = ((r0[0] + r0[1]) + (r0[2] + r0[3])) + ((r1[0] + r1[1]) + (r1[2] + r1[3]));
                const float rs = rsqrtf(ssum * (1.f / 128.f) + 1e-6f);
                bf16_t* zp = ((bf16_t*)(F.ws + WS_P)) + (size_t)(t0 + row) * LDP + C_ZA + dvc;
                const float z = bf2f(ZZ[row * 136 + 16 * w + fr]);
                if (!F.dry) *zp = (bf16_t)(pk2(o[mt][j] * rs * gn * silu(z), 0.f) & 0xffff);
                __builtin_amdgcn_sched_barrier(0);
            }
        if (n + 1 < nchunk) { G2_PUT((n + 1) & 1); __syncthreads(); }
    }
#undef G2_FETCH
#undef G2_PUT
    float* so = sample ? F.out + O_GDN_S + ((size_t)((l * 8 + (s - 16)) * 4 + h) * 128) * 128 : F.out + O_GDN_P + ((size_t)((l * 16 + s) * 4 + h) * 128) * 128;
#pragma unroll
    for (int mt = 0; mt < 8; ++mt)
#pragma unroll
        for (int j = 0; j < 4; ++j) if (!F.dry) so[(size_t)(16 * mt + 4 * fq + j) * 128 + 16 * w + fr] = S[mt][j];
}

DEV void g2_gla(const Frame& F0, int l, int s, int h) {
    REFRAME;
    bf16_t* QG = (bf16_t*)F.lds;
    bf16_t* KGT = (bf16_t*)(F.lds + 9216);
    bf16_t* AQ = (bf16_t*)(F.lds + 18432);
    float* sDL = (float*)(F.lds + 27648);
    float* RED = (float*)(F.lds + 27904);
    bf16_t* ZZ = (bf16_t*)(F.lds + 29952);
    const int tid = F.tid, lane = F.lane, w = F.wid, fr = lane & 15, fq = lane >> 4;
    const bool sample = s >= 16; const int nchunk = sample ? 1 : 32; const int tbase = sample ? 32768 + (s - 16) * 64 : s * 2048;
    const int dvc = h * 128 + 16 * w + fr;
    f32x4 S[4];
#pragma unroll
    for (int mt = 0; mt < 4; ++mt) {
        if (sample) { const float* sp = F.in[4] + ((size_t)((l * 8 + (s - 16)) * 4 + h) * 64) * 128;
#pragma unroll
            for (int j = 0; j < 4; ++j) S[mt][j] = sp[(size_t)(16 * mt + 4 * fq + j) * 128 + 16 * w + fr]; }
        else S[mt] = (f32x4){0.f, 0.f, 0.f, 0.f};
    }
    const float gn = F.in[17][l * 128 + 16 * w + fr];
    for (int n = 0; n < nchunk; ++n) {
        const int t0 = tbase + n * 64, chunk = t0 >> 6;
        __syncthreads();
        {
            const int r = tid >> 3, c8 = (tid & 7) * 8;
            *(u32x4*)(QG + r * 72 + c8) = *(const u32x4*)(((bf16_t*)(F.ws + WS_P)) + (size_t)(t0 + r) * LDP + C_QB + h * 64 + c8);
            const u32x4 k = *(const u32x4*)(((bf16_t*)(F.ws + WS_P)) + (size_t)(t0 + r) * LDP + C_KB + h * 64 + c8);
            KGT[(c8 + 0) * 72 + r] = (bf16_t)(k.x & 0xffff); KGT[(c8 + 1) * 72 + r] = (bf16_t)(k.x >> 16);
            KGT[(c8 + 2) * 72 + r] = (bf16_t)(k.y & 0xffff); KGT[(c8 + 3) * 72 + r] = (bf16_t)(k.y >> 16);
            KGT[(c8 + 4) * 72 + r] = (bf16_t)(k.z & 0xffff); KGT[(c8 + 5) * 72 + r] = (bf16_t)(k.z >> 16);
            KGT[(c8 + 6) * 72 + r] = (bf16_t)(k.w & 0xffff); KGT[(c8 + 7) * 72 + r] = (bf16_t)(k.w >> 16);
            *(u32x4*)(AQ + r * 72 + c8) = *(const u32x4*)(((bf16_t*)(F.ws + WS_XB)) + (size_t)(t0 + r) * LDE + 512 + h * 64 + c8);
        }
#pragma unroll
        for (int i = 0; i < 2; ++i) { const int p = tid + 512 * i, r = p >> 4, c8 = (p & 15) * 8;
            *(u32x4*)(ZZ + r * 136 + c8) = *(const u32x4*)(((bf16_t*)(F.ws + WS_P)) + (size_t)(t0 + r) * LDP + C_ZB + h * 128 + c8); }
        if (tid < 64) sDL[tid] = ((float*)(F.ws + WS_DL))[((size_t)chunk * 4 + h) * 64 + tid];
        bf16x8 vf[2];
#pragma unroll
        for (int ks = 0; ks < 2; ++ks) {
            unsigned e[8];
#pragma unroll
            for (int j = 0; j < 8; ++j) { const int row = 32 * ks + (j < 4 ? 4 * fq + j : 16 + 4 * fq + (j - 4)); e[j] = ((bf16_t*)(F.ws + WS_P))[(size_t)(t0 + row) * LDP + C_VB + dvc]; }
            u32x4 t; t.x = e[0] | (e[1] << 16); t.y = e[2] | (e[3] << 16); t.z = e[4] | (e[5] << 16); t.w = e[6] | (e[7] << 16);
            vf[ks] = __builtin_bit_cast(bf16x8, t);
        }
        __syncthreads();
        f32x4 o[4];
#pragma unroll
        for (int mt = 0; mt < 4; ++mt) o[mt] = (f32x4){0.f, 0.f, 0.f, 0.f};
#pragma unroll
        for (int ks = 0; ks < 2; ++ks) {
            const bf16x8 sf = mk8(pk4(S[2 * ks]), pk4(S[2 * ks + 1]));
#pragma unroll
            for (int mt = 0; mt < 4; ++mt) {
                o[mt] = MFMA16(ldfragp(QG, 16 * mt + fr, 72, 32 * ks, fq), sf, o[mt]);
                o[mt] = MFMA16(ldfragp(AQ, 16 * mt + fr, 72, 32 * ks, fq), vf[ks], o[mt]);
            }
        }
#pragma unroll
        for (int mt = 0; mt < 4; ++mt) {
#pragma unroll
            for (int j = 0; j < 4; ++j) S[mt][j] *= sDL[16 * mt + 4 * fq + j];
#pragma unroll
            for (int ks = 0; ks < 2; ++ks) S[mt] = MFMA16(ldfragp(KGT, 16 * mt + fr, 72, 32 * ks, fq), vf[ks], S[mt]);
        }
#pragma unroll
        for (int mt = 0; mt < 4; ++mt)
#pragma unroll
            for (int j = 0; j < 4; ++j) {
                float p = o[mt][j] * o[mt][j];
                p += __shfl_xor(p, 1); p += __shfl_xor(p, 2); p += __shfl_xor(p, 4); p += __shfl_xor(p, 8);
                if (fr == 0) RED[(16 * mt + 4 * fq + j) * 8 + w] = p;
            }
        __syncthreads();
#pragma unroll
        for (int mt = 0; mt < 4; ++mt)
#pragma unroll
            for (int j = 0; j < 4; ++j) {
                const int row = 16 * mt + 4 * fq + j;
                const f32x4 r0 = *(const f32x4*)(RED + row * 8), r1 = *(const f32x4*)(RED + row * 8 + 4);
                const float ssum = ((r0[0] + r0[1]) + (r0[2] + r0[3])) + ((r1[0] + r1[1]) + (r1[2] + r1[3]));
                const float rs = rsqrtf(ssum * (1.f / 128.f) + 1e-6f);
                bf16_t* zp = ((bf16_t*)(F.ws + WS_P)) + (size_t)(t0 + row) * LDP + C_ZB + dvc;
                const float z = bf2f(ZZ[row * 136 + 16 * w + fr]);
                if (!F.dry) *zp = (bf16_t)(pk2(o[mt][j] * rs * gn * silu(z), 0.f) & 0xffff);
            }
    }
    float* so = sample ? F.out + O_GLA_S + ((size_t)((l * 8 + (s - 16)) * 4 + h) * 64) * 128 : F.out + O_GLA_P + ((size_t)((l * 16 + s) * 4 + h) * 64) * 128;
#pragma unroll
    for (int mt = 0; mt < 4; ++mt)
#pragma unroll
        for (int j = 0; j < 4; ++j) if (!F.dry) so[(size_t)(16 * mt + 4 * fq + j) * 128 + 16 * w + fr] = S[mt][j];
}

DEV void unpack8(u32x4 u, float (&f)[8]) { f[0] = bflo(u.x); f[1] = bfhi(u.x); f[2] = bflo(u.y); f[3] = bfhi(u.y); f[4] = bflo(u.z); f[5] = bfhi(u.z); f[6] = bflo(u.w); f[7] = bfhi(u.w); }
DEV void load8f(const float* p, float (&f)[8]) { const f32x4 a = *(const f32x4*)p, b = *(const f32x4*)(p + 4); f[0] = a[0]; f[1] = a[1]; f[2] = a[2]; f[3] = a[3]; f[4] = b[0]; f[5] = b[1]; f[6] = b[2]; f[7] = b[3]; }
DEV void ffn_mid(const Frame& F0, int l) {
    REFRAME;
    const float* cw = F.in[29] + (size_t)l * 3 * 5632; const float* cb = F.in[30] + (size_t)l * 5632;
    const bf16_t* halo = ((bf16_t*)(F.ws + WS_KV)); const bf16_t* raw01 = ((bf16_t*)(F.ws + WS_KV + 11714560ull));
    for (int idx = F.bid * 512 + F.tid; idx < 112 * 704; idx += F.nb * 512) {
        const int ti = idx / 704, c4 = (idx % 704) * 4, pm = (ti / 7) * 8 + (ti % 7) + 1;
        const bf16_t* hp = halo + (size_t)(4 * pm - 1) * 2 * 5632; const bf16_t* rp = raw01 + (size_t)pm * 2 * 5632;
        const f32x4 gm2 = unpk4(*(const u32x2*)(hp + c4)), gm1 = unpk4(*(const u32x2*)(hp + 5632 + c4)), g0 = unpk4(*(const u32x2*)(rp + c4)), g1 = unpk4(*(const u32x2*)(rp + 5632 + c4));
        const f32x4 vm2 = unpk4(*(const u32x2*)(hp + 2816 + c4)), vm1 = unpk4(*(const u32x2*)(hp + 5632 + 2816 + c4)), v0 = unpk4(*(const u32x2*)(rp + 2816 + c4)), v1 = unpk4(*(const u32x2*)(rp + 5632 + 2816 + c4));
        const f32x4 wg0 = *(const f32x4*)(cw + c4), wg1 = *(const f32x4*)(cw + 5632 + c4), wg2 = *(const f32x4*)(cw + 2 * 5632 + c4), bg = *(const f32x4*)(cb + c4);
        const f32x4 wv0 = *(const f32x4*)(cw + 2816 + c4), wv1 = *(const f32x4*)(cw + 5632 + 2816 + c4), wv2 = *(const f32x4*)(cw + 2 * 5632 + 2816 + c4), bv = *(const f32x4*)(cb + 2816 + c4);
        f32x4 o0, o1;
#pragma unroll
        for (int j = 0; j < 4; ++j) {
            const float yg0 = wg0[j] * gm2[j] + wg1[j] * gm1[j] + wg2[j] * g0[j] + bg[j], yv0 = wv0[j] * vm2[j] + wv1[j] * vm1[j] + wv2[j] * v0[j] + bv[j];
            const float yg1 = wg0[j] * gm1[j] + wg1[j] * g0[j] + wg2[j] * g1[j] + bg[j], yv1 = wv0[j] * vm1[j] + wv1[j] * v0[j] + wv2[j] * v1[j] + bv[j];
            o0[j] = silu(yg0) * yv0; o1[j] = silu(yg1) * yv1;
        }
        bf16_t* vp = ((bf16_t*)(F.ws + WS_P)) + (size_t)pm * 256 * LDP + c4;
        *(u32x2*)vp = pk4(o0); *(u32x2*)(vp + LDP) = pk4(o1);
    }
}

DEV void final_norm(const Frame& F0) {
    REFRAME;
    const int gw = F.bid * 8 + F.wid, nw = F.nb * 8, lane = F.lane;
    const float* g = F.in[32];
    for (int row = gw; row < TT; row += nw) {
        const float rs = row_rstd(((float*)(F.ws + WS_SSQ)), row);
        float* X = F.out + (size_t)row * 1024;
#pragma unroll
        for (int i = 0; i < 4; ++i) { const int cidx = i * 256 + lane * 4; f32x4 v = *(const f32x4*)(X + cidx); const f32x4 gg = *(const f32x4*)(g + cidx); *(f32x4*)(X + cidx) = v * rs * gg; }
    }
}

#ifdef DBG_COL
DEV void dbg_dump(const Frame& F0) {
    REFRAME;
    for (int i = F.bid * 512 + F.tid; i < TT * 256; i += F.nb * 512) {
        const int row = i >> 8, c = (i & 255) * 4;
        const f32x4 v = c < 512 ? unpk4(*(const u32x2*)(((bf16_t*)(F.ws + WS_P)) + (size_t)row * LDP + DBG_COL + c)) : (f32x4){0.f, 0.f, 0.f, 0.f};
        *(f32x4*)(F.out + (size_t)row * 1024 + c) = (row DBG_ROWSEL) ? v : (f32x4){0.f, 0.f, 0.f, 0.f};
    }
}
#endif
#define XB_TMO      128
#define XB_XCNT(j)  (256  + 64 * (j))
#define XB_XSUB(j)  (1280 + 64 * (j))
#define XB_XGEN(j)  (2304 + 64 * (j))
#define XB_TOP      3328
#define XB_TOPGEN   3392
#define XCD_BAR_WORDS 3456
#define XB_SPIN_CAP (1u << 18)
#define LAS __attribute__((address_space(3)))

__device__ __forceinline__ unsigned xb_ld(unsigned* p)              { return __hip_atomic_load(p, __ATOMIC_RELAXED, __HIP_MEMORY_SCOPE_AGENT); }
__device__ __forceinline__ unsigned xb_add(unsigned* p, unsigned v) { return __hip_atomic_fetch_add(p, v, __ATOMIC_RELAXED, __HIP_MEMORY_SCOPE_AGENT); }
__device__ __forceinline__ unsigned xb_xcc_id() { return (unsigned)__builtin_amdgcn_s_getreg((3 << 11) | 20) & 0xFu; }
#define XB_SPIN(cond, bar) do { unsigned _sp = 0; while (cond) { __builtin_amdgcn_s_sleep(1); \
    if ((++_sp & 255u) == 0u) { if (xb_ld(&(bar)[XB_TMO])) break; if (_sp > XB_SPIN_CAP) { atomicAdd(&(bar)[XB_TMO], 1u); break; } } } } while (0)

struct XcdBarrier {
    unsigned* bar; unsigned x;
    volatile LAS unsigned* st;
};

__device__ __forceinline__ XcdBarrier xcd_barrier_post(unsigned* bar, volatile LAS unsigned* st) {
    XcdBarrier b; b.bar = bar; b.x = xb_xcc_id(); b.st = st;
    if (threadIdx.x == 0) (void)xb_add(&bar[XB_XCNT(b.x)], 1u);
    return b;
}
__device__ __forceinline__ void xcd_barrier_complete(unsigned* bar, unsigned x, unsigned& nloc, unsigned& nx) {
    const unsigned G = gridDim.x * gridDim.y * gridDim.z;
    unsigned sum, cnt, mine, sp = 0u;
    for (;;) {
        sum = 0u; cnt = 0u; mine = 0u;
#pragma unroll
        for (unsigned j = 0; j < 16; ++j) { const unsigned c = xb_ld(&bar[XB_XCNT(j)]); sum += c; cnt += (c > 0u) ? 1u : 0u; mine = (j == x) ? c : mine; }
        if (sum == G) break;
        __builtin_amdgcn_s_sleep(1);
        if ((++sp & 255u) == 0u) { if (xb_ld(&bar[XB_TMO])) break; if (sp > XB_SPIN_CAP) { atomicAdd(&bar[XB_TMO], 1u); break; } }
    }
    nloc = mine > 0u ? mine : 1u; nx = cnt > 0u ? cnt : 1u;
}

__device__ __forceinline__ void xcd_barrier(const XcdBarrier& b) {
    asm volatile("s_waitcnt vmcnt(0)" ::: "memory");
    __syncthreads();
    if (threadIdx.x == 0) {
        unsigned* bar = b.bar;
        __builtin_amdgcn_s_waitcnt(0);
        unsigned nloc = b.st[0], nx = b.st[1];
        if (nloc == 0u) { xcd_barrier_complete(bar, b.x, nloc, nx); b.st[0] = nloc; b.st[1] = nx; }
        const unsigned old = xb_add(&bar[XB_XSUB(b.x)], 1u);
        const unsigned gen = old / nloc;
        if (old + 1u == (gen + 1u) * nloc) {
            __builtin_amdgcn_fence(__ATOMIC_RELEASE, "agent");
            asm volatile("s_waitcnt vmcnt(0)" ::: "memory");
            const unsigned og = xb_add(&bar[XB_TOP], 1u);
            const unsigned tg = og / nx;
            if (og + 1u == (tg + 1u) * nx) xb_add(&bar[XB_TOPGEN], 1u);
            else XB_SPIN(xb_ld(&bar[XB_TOPGEN]) == tg, bar);
            __builtin_amdgcn_fence(__ATOMIC_ACQUIRE, "agent");
            xb_add(&bar[XB_XGEN(b.x)], 1u);
            asm volatile("s_waitcnt vmcnt(0)" ::: "memory");
        } else {
            XB_SPIN(xb_ld(&bar[XB_XGEN(b.x)]) == gen, bar);
            __builtin_amdgcn_fence(__ATOMIC_ACQUIRE, "agent");
            asm volatile("s_waitcnt vmcnt(0)" ::: "memory");
        }
    }
    __syncthreads();
}

__global__ void __launch_bounds__(512, 2) fwd_kernel(Params p) {
    extern __shared__ __attribute__((aligned(16))) unsigned char lds[];
    cg::grid_group grid = cg::this_grid();
    Frame F;
    F.in = (InTab)__builtin_amdgcn_kernarg_segment_ptr(); F.out = p.out; F.ws = p.ws; F.lds = lds;
    F.tid = threadIdx.x; F.lane = threadIdx.x & 63; F.wid = __builtin_amdgcn_readfirstlane(threadIdx.x >> 6); F.nb = gridDim.x; F.bid = blockIdx.x; F.dry = 0; F.cb = blockIdx.x; F.cn = gridDim.x;
    volatile LAS unsigned* xst = (volatile LAS unsigned*)(lds + LDS_BYTES - 16);
    if (threadIdx.x == 0) { xst[0] = 0u; xst[1] = 0u; }
    __syncthreads();
    const XcdBarrier xbar = xcd_barrier_post((unsigned*)(p.ws + WS_BAR), xst);
    for (int ph = p.ph_lo; ph < p.ph_hi; ++ph) {
#ifndef PHM
#define PHM 0xffff
#endif
        if (ph == 0) { if (PHM & 0x1000) phase0(F); }
        else if (ph == NPH - 1) { if (PHM & 0x2000) final_norm(F); }
        else {
            const int l = (ph - 1) / 13, k = (ph - 1) % 13;
            int gk = -1;
            if (k == 2 && gridDim.x == 256) gk = GP_MEMKV;
            switch (k) { case 0: gk = GP_IN; break; case 3: gk = GP_OUT; break; case 4: gk = GP_OUT2; break; case 5: gk = GP_WO; break; case 6: gk = GP_MQ; break; case 7: gk = GP_ATTN; break; case 8: gk = GP_ATTN2; break;
                         case 9: gk = GP_MO; break; case 10: gk = GP_UP; break; case 12: gk = GP_DOWN; break; default: break; }
#ifndef REPMASK
#define REPMASK 0
#endif
            if (gk >= 0 && (PHM & 1)) { const int nrep = ((REPMASK >> k) & 1) ? 2 : 1; for (int rep = 0; rep < nrep; ++rep) gemm_phase(F, gk, l); }
            if (k == 0 && (PHM & 1)) small_proj(F);
            if (k == (gridDim.x == 256 ? 2 : 3) && (PHM & 8)) sample_kv(F, l);
            if (gridDim.x == 256 && k == 2 && l > 0 && blockIdx.x >= 192) { Frame G = F; G.cb = (int)blockIdx.x - 192; G.cn = 64; __syncthreads(); cvt_ffn(G, l); }
            if (gridDim.x == 256 && k == 10 && l < 3 && (blockIdx.x >> 3) >= 6) { Frame G = F; G.cb = (((int)blockIdx.x >> 3) - 6) * 8 + ((int)blockIdx.x & 7); G.cn = 208; __syncthreads(); cvt_mixer(G, l + 1); }
#ifndef DRYMASK
#define DRYMASK 0
#endif
            for (int dr = ((DRYMASK >> k) & 1); dr >= 0; --dr) {
            F.dry = dr;
            if (k == 1 && (PHM & 2)) {
                for (int it = F.bid; it < NCH * 8; it += F.nb) { const int c = it >> 3, h = it & 3; if (it & 4) g1_gla(F, l, c, h); else g1_gdn(F, l, c, h); }
                __syncthreads();
                if (l > 0 && !dr && F.nb != 256) cvt_ffn(F, l);
            }
            if (k == 2 && (PHM & 4)) {
                for (int it = F.bid; it < 192; it += F.nb) {
                    int s, h, br;
                    if (it < 128) { br = it & 1; h = (it >> 1) & 3; s = it >> 3; } else { const int v = it - 128; br = v & 1; h = (v >> 1) & 3; s = 16 + (v >> 3); }
                    if (br) g2_gla(F, l, s, h); else g2_gdn(F, l, s, h);
                    __syncthreads();
                }
            }
            if (k == 11 && (PHM & 0x200)) { ffn_mid(F, l); if (l < 3 && !dr && F.nb != 256) { __syncthreads(); cvt_mixer(F, l + 1); } }
            }
            F.dry = 0;
        }
#ifndef SYNCREP
#define SYNCREP 1
#endif
        if (ph + 1 < p.ph_hi) {
            if (ph == 0) grid.sync();
            else xcd_barrier(xbar);
        }
    }
#ifdef DBG_COL
    __threadfence(); grid.sync(); __threadfence();
    dbg_dump(F);
#endif
}

extern "C" void kernel_launch(void* const* d_in, const int* in_sizes, int n_in, void* d_out, int out_size, void* d_ws, size_t ws_size, hipStream_t stream) {
    static int grid_blocks = 0;
    if (grid_blocks == 0) {
        if (n_in != 33 || ws_size < WS_TOTAL) { fprintf(stderr, "kernel_launch: bad n_in %d or ws %zu < %zu\n", n_in, ws_size, (size_t)WS_TOTAL); grid_blocks = -1; return; }
        int dev = 0, cus = 0, per_cu = 0;
        hipGetDevice(&dev);
        hipDeviceGetAttribute(&cus, hipDeviceAttributeMultiprocessorCount, dev);
        if (hipFuncSetAttribute((const void*)fwd_kernel, hipFuncAttributeMaxDynamicSharedMemorySize, LDS_BYTES) != hipSuccess) { fprintf(stderr, "hipFuncSetAttribute failed\n"); grid_blocks = -1; return; }
        hipOccupancyMaxActiveBlocksPerMultiprocessor(&per_cu, (const void*)fwd_kernel, 512, LDS_BYTES);
        if (per_cu < 1) per_cu = 1;
        (void)hipGetLastError();
        grid_blocks = cus * 1;
        if (grid_blocks <= 0) grid_blocks = 256;
    }
    if (grid_blocks < 0) return;
    Params p{};
    for (int i = 0; i < 33; ++i) p.in[i] = (const float*)d_in[i];
    p.out = (float*)d_out; p.ws = (unsigned char*)d_ws; p.ph_lo = 0; p.ph_hi = PH_HI;
    (void)hipMemsetAsync((unsigned char*)d_ws + WS_BAR, 0, 16384, stream);
    void* args[] = {&p};
    hipError_t e = hipLaunchCooperativeKernel((const void*)fwd_kernel, dim3(grid_blocks), dim3(512), args, LDS_BYTES, stream);
    if (e != hipSuccess) fprintf(stderr, "cooperative launch failed: %s (grid %d)\n", hipGetErrorString(e), grid_blocks);
}
```

```cpp
#include <hip/hip_runtime.h>
#include <hip/hip_cooperative_groups.h>
#include <cstdint>
#include <cstdio>
namespace cg = cooperative_groups;

typedef unsigned short bf16_t;
typedef short bf16x8 __attribute__((ext_vector_type(8)));
typedef float f32x4 __attribute__((ext_vector_type(4)));
typedef float f32x2 __attribute__((ext_vector_type(2)));
typedef unsigned u32x2 __attribute__((ext_vector_type(2)));
typedef unsigned u32x4 __attribute__((ext_vector_type(4)));
#define DEV __device__ __forceinline__

constexpr int DM = 1024, TT = 33280, NCH = 520, LDP = 5632, LDE = 768;
constexpr int C_QA = 0, C_KA = 512, C_VA = 1024, C_ZA = 1536, C_QB = 2048, C_KB = 2304, C_VB = 2560, C_ZB = 3072, C_GA = 3584, C_GB = 4608;
constexpr int C_MRG = 0, C_PR = 1024, C_Q = 2048, C_O = 3072;
constexpr size_t O_Y = 0;
constexpr size_t O_GDN_P = 34078720ull;
constexpr size_t O_GDNC_P = O_GDN_P + 4194304ull;
constexpr size_t O_GLA_P = O_GDNC_P + 294912ull;
constexpr size_t O_FFNC_P = O_GLA_P + 2097152ull;
constexpr size_t O_MEMK = O_FFNC_P + 720896ull;
constexpr size_t O_MEMV = O_MEMK + 16777216ull;
constexpr size_t O_GDN_S = O_MEMV + 16777216ull;
constexpr size_t O_GDNC_S = O_GDN_S + 2097152ull;
constexpr size_t O_GLA_S = O_GDNC_S + 147456ull;
constexpr size_t O_FFNC_S = O_GLA_S + 1048576ull;
constexpr size_t al256(size_t x) { return (x + 255) & ~(size_t)255; }
constexpr size_t WS_WMIX = 0;
constexpr size_t WM_WIN = 0, WM_WSM = WM_WIN + 5632ull * 1024, WM_WOA = WM_WSM + 32 * 1024, WM_WOB = WM_WOA + 524288, WM_WO = WM_WOB + 524288,
                 WM_WMQ = WM_WO + 1048576, WM_WMK = WM_WMQ + 1048576, WM_WMV = WM_WMK + 1048576, WM_WMO = WM_WMV + 1048576, WM_END = WM_WMO + 1048576;
constexpr size_t WS_WFFN = al256(WS_WMIX + WM_END * 2);
constexpr size_t WF_UP = 0, WF_DN = 5632ull * 1024, WF_END = WF_DN + 1024ull * 2816;
constexpr size_t WS_XB = al256(WS_WFFN + WF_END * 2);
constexpr size_t WS_P = al256(WS_XB + (size_t)TT * 1024 * 2);
constexpr size_t WS_KV = al256(WS_P + (size_t)TT * LDP * 2);
constexpr size_t KV_BYTES = 2ull * 6144 * 1024 * 2;
constexpr size_t WS_MB = al256(WS_KV + KV_BYTES);
constexpr size_t WS_MRS = al256(WS_MB + 4096ull * 1024 * 2);
constexpr size_t WS_SSQ = al256(WS_MRS + 4096 * 4);
constexpr size_t WS_SC = al256(WS_SSQ + (size_t)TT * 16 * 4);
constexpr size_t WS_DL = al256(WS_SC + (size_t)TT * 32 * 4);
constexpr size_t WS_BG = al256(WS_DL + 520ull * 4 * 64 * 4);
constexpr size_t WS_BAR = al256(WS_BG + 520ull * 4 * 128 * 4);
constexpr size_t WS_TOTAL = al256(WS_BAR + 16384);
constexpr int LDS_BYTES = 147456;
constexpr int NPH = 54;
#ifndef PH_HI
#define PH_HI NPH
#define REPMASK 0
#define SYNCREP 1
#define DRYMASK 0
#endif

struct Params { const float* in[33]; float* out; unsigned char* ws; int ph_lo, ph_hi; };

typedef __bf16 bf16x2_t __attribute__((ext_vector_type(2)));
DEV unsigned pk2(float lo, float hi) { f32x2 f = {lo, hi}; bf16x2_t v = __builtin_convertvector(f, bf16x2_t); return __builtin_bit_cast(unsigned, v); }
DEV float bf2f(bf16_t b) { return __uint_as_float(((unsigned)b) << 16); }
DEV float bflo(unsigned u) { return __uint_as_float(u << 16); }
DEV float bfhi(unsigned u) { return __uint_as_float(u & 0xffff0000u); }
DEV u32x2 pk4(f32x4 v) { u32x2 r; r.x = pk2(v[0], v[1]); r.y = pk2(v[2], v[3]); return r; }
DEV f32x4 unpk4(u32x2 u) { return (f32x4){bflo(u.x), bfhi(u.x), bflo(u.y), bfhi(u.y)}; }
DEV bf16x8 mk8(u32x2 a, u32x2 b) { u32x4 t = {a.x, a.y, b.x, b.y}; return __builtin_bit_cast(bf16x8, t); }
DEV float sigm(float x) { return 1.f / (1.f + __expf(-x)); }
DEV float silu(float x) { return x / (1.f + __expf(-x)); }
DEV float softplus(float x) { return x > 20.f ? x : __logf(1.f + __expf(x)); }
DEV float logsigmoid(float x) { return fminf(x, 0.f) - __logf(1.f + __expf(-fabsf(x))); }
DEV float row_rstd(const float* ssq, int row) {
    const f32x4 a = *(const f32x4*)(ssq + (size_t)row * 4), b = *(const f32x4*)(ssq + ((size_t)TT + row) * 4);
    const f32x4 c = *(const f32x4*)(ssq + ((size_t)2 * TT + row) * 4), d = *(const f32x4*)(ssq + ((size_t)3 * TT + row) * 4);
    float s = ((a[0] + a[1]) + (a[2] + a[3])) + ((b[0] + b[1]) + (b[2] + b[3])) + ((c[0] + c[1]) + (c[2] + c[3])) + ((d[0] + d[1]) + (d[2] + d[3]));
    return rsqrtf(s * (1.f / 1024.f) + 1e-6f);
}
DEV bf16x8 ldfragp(const bf16_t* base, int row, int stride, int k0, int fq) {
    const bf16_t* p = base + row * stride + k0 + 4 * fq;
    return mk8(*(const u32x2*)p, *(const u32x2*)(p + 16));
}
DEV bf16x8 ldfrag(const bf16_t* base, int row, int stride, int k0, int fq) {
    return *(const bf16x8*)(base + row * stride + k0 + 8 * fq);
}
#define MFMA16(a, b, c) __builtin_amdgcn_mfma_f32_16x16x32_bf16((a), (b), (c), 0, 0, 0)

constexpr int BM = 256, BK = 64, HALF = 128, HT = HALF * BK;
DEV int lds_byte(int r, int c) { int st = (r >> 4) * 2 + (c >> 5), rr = r & 15, cc = c & 31, ob = rr * 64 + cc * 2; return st * 1024 + (ob ^ (((ob >> 9) & 1) << 5)); }
DEV void stage_rc(int b, int& R, int& C) { int st = b / 1024, sb = b % 1024, swz = sb ^ (((sb >> 9) & 1) << 5); R = (st >> 1) * 16 + swz / 64; C = (st & 1) * 32 + (swz % 64) / 2; }

DEV void gemm_core(const bf16_t* __restrict__ A, int lda, const bf16_t* __restrict__ Bt, int ldb, int K, int brow, int bcol, f32x4 (&acc)[2][2][4][2], bf16_t* shm) {
#define SA(b, h) (shm + ((b) * 2 + (h)) * HT)
#define SB(b, h) (shm + (4 + (b) * 2 + (h)) * HT)
#define STAGE(P, BASE, LD, br, kt) do { const char* _gb = (const char*)((BASE) + (long)(br) * (LD) + (long)(kt) * BK); \
    const unsigned _vo = (unsigned)((sr0 * (int)(LD) + sc0) * 2); \
    for (int _i = 0; _i < 2; ++_i) { \
      __builtin_amdgcn_global_load_lds((const unsigned*)(_gb + (long)(_i * 128) * (LD) + _vo), (unsigned*)((char*)(P) + wbase + _i * 8192), 16, 0, 0); } } while (0)
#define LDA(dst, b, h) for (int m = 0; m < 4; ++m) for (int k = 0; k < 2; ++k) \
    dst[m][k] = *reinterpret_cast<const bf16x8*>((char*)SA(b, h) + lds_byte(wr * 64 + m * 16 + fr, k * 32 + fq * 8))
#define LDB(dst, b, h) for (int n = 0; n < 2; ++n) for (int k = 0; k < 2; ++k) \
    dst[n][k] = *reinterpret_cast<const bf16x8*>((char*)SB(b, h) + lds_byte(wc * 32 + n * 16 + fr, k * 32 + fq * 8))
#define MMA(ai, bj, At_, Bt_) do { __builtin_amdgcn_s_setprio(1); \
    for (int m = 0; m < 4; ++m) for (int n = 0; n < 2; ++n) for (int k = 0; k < 2; ++k) \
      acc[ai][bj][m][n] = __builtin_amdgcn_mfma_f32_16x16x32_bf16(Bt_[n][k], At_[m][k], acc[ai][bj][m][n], 0, 0, 0); \
    __builtin_amdgcn_s_setprio(0); } while (0)
#define WAIT_V(n) asm volatile("s_waitcnt vmcnt(" #n ")" ::: "memory")
#define WAIT_L(n) asm volatile("s_waitcnt lgkmcnt(" #n ")" ::: "memory")
#define BAR __builtin_amdgcn_s_barrier()
#define SCHED __builtin_amdgcn_sched_barrier(0)
    int tidx = threadIdx.x; asm volatile("" : "+v"(tidx));
    const int wid = __builtin_amdgcn_readfirstlane(tidx >> 6), lane = tidx & 63, wr = wid >> 2, wc = wid & 3, fr = lane & 15, fq = lane >> 4;
    const int wbase = wid * 1024;
    int sr0, sc0; stage_rc(tidx * 16, sr0, sc0);
#pragma unroll
    for (int a = 0; a < 2; ++a)
#pragma unroll
        for (int b = 0; b < 2; ++b)
#pragma unroll
            for (int m = 0; m < 4; ++m)
#pragma unroll
                for (int n = 0; n < 2; ++n) acc[a][b][m][n] = (f32x4){0.f, 0.f, 0.f, 0.f};
    bf16x8 At[4][2], B0[2][2], B1[2][2];
    const int nt = K / BK;
    STAGE(SB(0, 0), Bt, ldb, bcol, 0); STAGE(SA(0, 0), A, lda, brow, 0);
    STAGE(SB(0, 1), Bt, ldb, bcol + HALF, 0); STAGE(SA(0, 1), A, lda, brow + HALF, 0);
    if (wr == 1) BAR;
    WAIT_V(4); BAR;
    STAGE(SB(1, 0), Bt, ldb, bcol, 1); STAGE(SA(1, 0), A, lda, brow, 1); STAGE(SB(1, 1), Bt, ldb, bcol + HALF, 1);
    WAIT_V(6); BAR;
    for (int t = 0; t < nt - 2; t += 2) {
        LDB(B0, 0, 0); SCHED; LDA(At, 0, 0); STAGE(SA(1, 1), A, lda, brow + HALF, t + 1);
        WAIT_L(8); BAR; WAIT_L(0); MMA(0, 0, At, B0); BAR; SCHED;
        LDB(B1, 0, 1); STAGE(SB(0, 0), Bt, ldb, bcol, t + 2);
        BAR; WAIT_L(0); MMA(0, 1, At, B1); BAR;
        LDA(At, 0, 1); STAGE(SA(0, 0), A, lda, brow, t + 2);
        BAR; WAIT_L(0); MMA(1, 0, At, B0); BAR; SCHED;
        STAGE(SB(0, 1), Bt, ldb, bcol + HALF, t + 2);
        WAIT_V(6); BAR; MMA(1, 1, At, B1); BAR;
        LDB(B0, 1, 0); SCHED; LDA(At, 1, 0); STAGE(SA(0, 1), A, lda, brow + HALF, t + 2);
        WAIT_L(8); BAR; WAIT_L(0); MMA(0, 0, At, B0); BAR; SCHED;
        LDB(B1, 1, 1); STAGE(SB(1, 0), Bt, ldb, bcol, t + 3);
        BAR; WAIT_L(0); MMA(0, 1, At, B1); BAR;
        LDA(At, 1, 1); STAGE(SA(1, 0), A, lda, brow, t + 3);
        BAR; WAIT_L(0); MMA(1, 0, At, B0); BAR; SCHED;
        STAGE(SB(1, 1), Bt, ldb, bcol + HALF, t + 3);
        WAIT_V(6); BAR; MMA(1, 1, At, B1); BAR;
    }
    { LDB(B0, 0, 0); LDA(At, 0, 0); STAGE(SA(1, 1), A, lda, brow + HALF, nt - 1);
      BAR; WAIT_L(0); MMA(0, 0, At, B0); BAR;
      LDB(B1, 0, 1); BAR; WAIT_L(0); MMA(0, 1, At, B1); BAR;
      LDA(At, 0, 1); WAIT_V(4); BAR; WAIT_L(0); MMA(1, 0, At, B0); MMA(1, 1, At, B1); BAR; }
    { LDB(B0, 1, 0); LDA(At, 1, 0); WAIT_V(2); BAR; WAIT_L(0); MMA(0, 0, At, B0); BAR;
      LDB(B1, 1, 1); WAIT_V(0); BAR; WAIT_L(0); MMA(0, 1, At, B1); BAR;
      LDA(At, 1, 1); BAR; WAIT_L(0); MMA(1, 0, At, B0); MMA(1, 1, At, B1); BAR; }
    if (wr == 0) BAR;
    SCHED;
#undef SA
#undef SB
}

typedef const float* const __attribute__((address_space(4)))* InTab;
struct Frame {
    InTab in; float* out; unsigned char* ws; unsigned char* lds;
    int tid, lane, wid, nb, bid, dry, cb, cn;
};
#define REFRAME Frame F = F0; { int t_ = threadIdx.x; asm volatile("" : "+v"(t_)); F.tid = t_; F.lane = t_ & 63; unsigned char* w_ = F.ws; asm volatile("" : "+s"(w_)); F.ws = w_; float* o_ = F.out; asm volatile("" : "+s"(o_)); F.out = o_; InTab i_ = (InTab)__builtin_amdgcn_kernarg_segment_ptr(); asm volatile("" : "+s"(i_)); F.in = i_; int a_ = F.wid, b_ = F.bid, c_ = F.nb; asm volatile("" : "+s"(a_), "+s"(b_), "+s"(c_)); F.wid = a_; F.bid = b_; F.nb = c_; }

enum { EPI_PROJ = 0, EPI_UP, EPI_RESID, EPI_Q, EPI_MEMK, EPI_MEMV, EPI_OUTA, EPI_OUTB, EPI_SOFTMAX, EPI_ATTNO };
struct GDesc { const bf16_t* A; int lda; const bf16_t* Bt; int ldb; int K, brow, bcol, epi, orow, ocol, head, vai, vwr; };

DEV void cvt_mat(const Frame& F0, const float* src, int ldsrc, int K, int N, int wincols, const float* gain, bf16_t* dst) {
    REFRAME;
    float* T = (float*)F.lds;
    const int nkt = K / 64, nnt = N / 64, ntile = nkt * nnt;
    for (int t = F.cb; t < ntile; t += F.cn) {
        const int kt = t / nnt, ntl = t % nnt, k0 = kt * 64, n0 = ntl * 64;
        int coff = 0; if (wincols == 1) coff = (n0 < 1536) ? 0 : (n0 < 3072 ? 8 : 24);
        if (wincols == 2) { const int tl = n0 >> 8, w = n0 & 255; coff = (w < 128 ? 128 * tl + w : 2816 + 128 * tl + (w - 128)) - n0; }
        __syncthreads();
#pragma unroll
        for (int i = 0; i < 2; ++i) {
            const int kr = (F.tid >> 4) + 32 * i, nc = (F.tid & 15) * 4;
            f32x4 v = *(const f32x4*)(src + (size_t)(k0 + kr) * ldsrc + n0 + coff + nc);
            const float g = gain ? gain[k0 + kr] : 1.f;
            T[kr * 65 + nc + 0] = v[0] * g; T[kr * 65 + nc + 1] = v[1] * g; T[kr * 65 + nc + 2] = v[2] * g; T[kr * 65 + nc + 3] = v[3] * g;
        }
        __syncthreads();
        const int n = F.tid >> 3, kc = (F.tid & 7) * 8;
        u32x4 w;
        w.x = pk2(T[(kc + 0) * 65 + n], T[(kc + 1) * 65 + n]); w.y = pk2(T[(kc + 2) * 65 + n], T[(kc + 3) * 65 + n]);
        w.z = pk2(T[(kc + 4) * 65 + n], T[(kc + 5) * 65 + n]); w.w = pk2(T[(kc + 6) * 65 + n], T[(kc + 7) * 65 + n]);
        *(u32x4*)(dst + (size_t)(n0 + n) * K + k0 + kc) = w;
    }
    __syncthreads();
}
DEV void cvt_mixer(const Frame& F0, int l) {
    REFRAME;
    InTab in = F.in;
    cvt_mat(F, in[10] + (size_t)l * 1024 * 5656, 5656, 1024, 5632, 1, in[9] + l * 1024, ((bf16_t*)(F.ws + WS_WMIX)) + WM_WIN);
    cvt_mat(F, in[18] + (size_t)l * 512 * 1024, 1024, 512, 1024, 0, nullptr, ((bf16_t*)(F.ws + WS_WMIX)) + WM_WOA);
    cvt_mat(F, in[19] + (size_t)l * 512 * 1024, 1024, 512, 1024, 0, nullptr, ((bf16_t*)(F.ws + WS_WMIX)) + WM_WOB);
    cvt_mat(F, in[20] + (size_t)l * 1048576, 1024, 1024, 1024, 0, nullptr, ((bf16_t*)(F.ws + WS_WMIX)) + WM_WO);
    cvt_mat(F, in[23] + (size_t)l * 1048576, 1024, 1024, 1024, 0, in[21] + l * 1024, ((bf16_t*)(F.ws + WS_WMIX)) + WM_WMQ);
    cvt_mat(F, in[24] + (size_t)l * 1048576, 1024, 1024, 1024, 0, in[22] + l * 1024, ((bf16_t*)(F.ws + WS_WMIX)) + WM_WMK);
    cvt_mat(F, in[25] + (size_t)l * 1048576, 1024, 1024, 1024, 0, in[22] + l * 1024, ((bf16_t*)(F.ws + WS_WMIX)) + WM_WMV);
    cvt_mat(F, in[26] + (size_t)l * 1048576, 1024, 1024, 1024, 0, nullptr, ((bf16_t*)(F.ws + WS_WMIX)) + WM_WMO);
    const float* win = in[10] + (size_t)l * 1024 * 5656; const float* g = in[9] + l * 1024;
    for (int i = F.cb * 512 + F.tid; i < 32 * 1024; i += F.cn * 512) {
        const int n = i >> 10, k = i & 1023;
        float v = 0.f;
        if (n < 8) v = win[(size_t)k * 5656 + 1536 + n] * g[k]; else if (n < 24) v = win[(size_t)k * 5656 + 3080 + (n - 8)] * g[k];
        ((bf16_t*)(F.ws + WS_WMIX))[WM_WSM + i] = (bf16_t)(pk2(v, 0.f) & 0xffff);
    }
}
DEV void cvt_ffn(const Frame& F, int l) {
    cvt_mat(F, F.in[28] + (size_t)l * 1024 * 5632, 5632, 1024, 5632, 2, F.in[27] + l * 1024, ((bf16_t*)(F.ws + WS_WFFN)) + WF_UP);
    cvt_mat(F, F.in[31] + (size_t)l * 2816 * 1024, 1024, 2816, 1024, 0, nullptr, ((bf16_t*)(F.ws + WS_WFFN)) + WF_DN);
}

DEV void phase0(const Frame& F0) {
    REFRAME;
    const int gw = F.bid * 8 + F.wid, nw = F.nb * 8, lane = F.lane;
    for (int row = gw; row < TT + 4096; row += nw) {
        const bool ismem = row >= TT;
        const float* src = ismem ? F.in[8] + (size_t)(row - TT) * 1024 : (row < 32768 ? F.in[0] + (size_t)row * 1024 : F.in[1] + (size_t)(row - 32768) * 1024);
        f32x4 v[4]; float s = 0.f;
#pragma unroll
        for (int i = 0; i < 4; ++i) { v[i] = *(const f32x4*)(src + lane * 16 + i * 4); s += v[i][0] * v[i][0] + v[i][1] * v[i][1] + v[i][2] * v[i][2] + v[i][3] * v[i][3]; }
        u32x4 w0, w1;
        w0.x = pk2(v[0][0], v[0][1]); w0.y = pk2(v[0][2], v[0][3]); w0.z = pk2(v[1][0], v[1][1]); w0.w = pk2(v[1][2], v[1][3]);
        w1.x = pk2(v[2][0], v[2][1]); w1.y = pk2(v[2][2], v[2][3]); w1.z = pk2(v[3][0], v[3][1]); w1.w = pk2(v[3][2], v[3][3]);
        s += __shfl_xor(s, 1); s += __shfl_xor(s, 2);
        if (!ismem) {
            float* X = F.out + (size_t)row * 1024 + lane * 16;
#pragma unroll
            for (int i = 0; i < 4; ++i) *(f32x4*)(X + i * 4) = v[i];
            bf16_t* xb = ((bf16_t*)(F.ws + WS_XB)) + (size_t)row * 1024 + lane * 16;
            *(u32x4*)xb = w0; *(u32x4*)(xb + 8) = w1;
            if ((lane & 3) == 0) ((float*)(F.ws + WS_SSQ))[((size_t)(lane >> 4) * TT + row) * 4 + ((lane >> 2) & 3)] = s;
        } else {
            const int mr = row - TT;
            bf16_t* mb = ((bf16_t*)(F.ws + WS_MB)) + (size_t)mr * 1024 + lane * 16;
            *(u32x4*)mb = w0; *(u32x4*)(mb + 8) = w1;
            s += __shfl_xor(s, 4); s += __shfl_xor(s, 8); s += __shfl_xor(s, 16); s += __shfl_xor(s, 32);
            if (lane == 0) ((float*)(F.ws + WS_MRS))[mr] = rsqrtf(s * (1.f / 1024.f) + 1e-6f);
        }
    }
    cvt_mixer(F, 0);
    cvt_ffn(F, 0);
}

DEV void small_proj(const Frame& F0) {
    REFRAME;
    const int lane = F.lane, fr = lane & 15, fq = lane >> 4, mt = F.wid & 3, nt = F.wid >> 2;
    const bool part = F.nb == 256;
    if (part && (F.bid >> 3) < 6) return;
    for (int c = part ? ((F.bid >> 3) - 6) * 8 + (F.bid & 7) : F.bid; c < NCH; c += part ? 208 : F.nb) {
        const int row = c * 64 + mt * 16 + fr;
        const bf16_t* a = ((bf16_t*)(F.ws + WS_XB)) + (size_t)row * 1024 + 8 * fq;
        const bf16_t* b = ((bf16_t*)(F.ws + WS_WMIX)) + WM_WSM + (size_t)(nt * 16 + fr) * 1024 + 8 * fq;
        f32x4 acc = {0.f, 0.f, 0.f, 0.f};
#pragma unroll 4
        for (int k = 0; k < 32; ++k) acc = MFMA16(*(const bf16x8*)(b + k * 32), *(const bf16x8*)(a + k * 32), acc);
        const float rs = row_rstd(((float*)(F.ws + WS_SSQ)), row);
        *(f32x4*)(((float*)(F.ws + WS_SC)) + (size_t)row * 32 + nt * 16 + 4 * fq) = acc * rs;
    }
}

DEV void gemm_epilogue(const Frame& F0, const GDesc& d, int l, f32x4 (&acc)[2][2][4][2]) {
    REFRAME;
    int lane_ = F.lane; asm volatile("" : "+v"(lane_));
    const int wr = F.wid >> 2, wc = F.wid & 3, fr = lane_ & 15, fq = lane_ >> 4;
    float* red = (float*)(F.lds + 131072);
    if (d.epi == EPI_SOFTMAX) {
        float mx[2][4];
#pragma unroll
        for (int ai = 0; ai < 2; ++ai)
#pragma unroll
            for (int m = 0; m < 4; ++m) {
                float v = -3.0e38f;
#pragma unroll
                for (int bj = 0; bj < 2; ++bj)
#pragma unroll
                    for (int n = 0; n < 2; ++n) { const f32x4 x = acc[ai][bj][m][n]; v = fmaxf(v, fmaxf(fmaxf(x[0], x[1]), fmaxf(x[2], x[3]))); }
                v = fmaxf(v, __shfl_xor(v, 16)); v = fmaxf(v, __shfl_xor(v, 32));
                if (fq == 0) red[(ai * 128 + wr * 64 + m * 16 + fr) * 4 + wc] = v;
            }
        __syncthreads();
#pragma unroll
        for (int ai = 0; ai < 2; ++ai)
#pragma unroll
            for (int m = 0; m < 4; ++m) {
                const f32x4 r4 = *(const f32x4*)(red + (ai * 128 + wr * 64 + m * 16 + fr) * 4);
                const float rm = fmaxf(fmaxf(r4[0], r4[1]), fmaxf(r4[2], r4[3]));
                mx[ai][m] = rm; float s = 0.f;
#pragma unroll
                for (int bj = 0; bj < 2; ++bj)
#pragma unroll
                    for (int n = 0; n < 2; ++n) { f32x4 x = acc[ai][bj][m][n];
#pragma unroll
                        for (int j = 0; j < 4; ++j) { x[j] = __expf(x[j] - rm); s += x[j]; }
                        acc[ai][bj][m][n] = x; }
                s += __shfl_xor(s, 16); s += __shfl_xor(s, 32);
                if (fq == 0) red[1024 + (ai * 128 + wr * 64 + m * 16 + fr) * 4 + wc] = s;
            }
        (void)mx;
        __syncthreads();
#pragma unroll
        for (int ai = 0; ai < 2; ++ai)
#pragma unroll
            for (int m = 0; m < 4; ++m) {
                const f32x4 r4 = *(const f32x4*)(red + 1024 + (ai * 128 + wr * 64 + m * 16 + fr) * 4);
                const float inv = 1.f / ((r4[0] + r4[1]) + (r4[2] + r4[3]));
                const bool valid = d.vai < 0 || (d.vai == ai && d.vwr == wr);
                const int row = d.orow + ai * 128 + wr * 64 + m * 16 + fr;
                if (valid) {
#pragma unroll
                    for (int bj = 0; bj < 2; ++bj)
#pragma unroll
                        for (int n = 0; n < 2; ++n) {
                            const int col = bj * 128 + wc * 32 + n * 16 + fq * 4;
                            *(u32x2*)(((bf16_t*)(F.ws + WS_P)) + (size_t)row * LDP + C_PR + d.head * 256 + col) = pk4(acc[ai][bj][m][n] * inv);
                        }
                }
            }
        __syncthreads();
        return;
    }
#pragma unroll
    for (int ai = 0; ai < 2; ++ai)
#pragma unroll
        for (int m = 0; m < 4; ++m) {
            const int row = d.orow + ai * 128 + wr * 64 + m * 16 + fr;
            float rs = 1.f, ss = 0.f;
            if (d.epi == EPI_PROJ || d.epi == EPI_UP || d.epi == EPI_Q) rs = row_rstd(((float*)(F.ws + WS_SSQ)), row);
            if (d.epi == EPI_Q) rs *= 0.0625f;
            if (d.epi == EPI_MEMK) rs = ((float*)(F.ws + WS_MRS))[row];
#pragma unroll
            for (int bj = 0; bj < 2; ++bj)
#pragma unroll
                for (int n = 0; n < 2; ++n) {
                    const int col = d.ocol + bj * 128 + wc * 32 + n * 16 + fq * 4;
                    f32x4 v = acc[ai][bj][m][n];
                    switch (d.epi) {
                    case EPI_UP: {
                        const int row_l = ai * 128 + wr * 64 + m * 16 + fr, cl = bj * 128 + wc * 32 + n * 16 + fq * 4;
                        *(u32x2*)((bf16_t*)F.lds + row_l * 264 + cl) = pk4(v * rs);
                    } break;
                    case EPI_PROJ: {
                        v = v * rs; const u32x2 w = pk4(v);
                        *(u32x2*)(((bf16_t*)(F.ws + WS_P)) + (size_t)row * LDP + col) = w;
                        if (m == 3 && fr >= 13 && col < 1536) {
                            const int chunk = row >> 6, hr = fr - 13;
                            *(u32x2*)(((bf16_t*)(F.ws + WS_KV)) + ((size_t)chunk * 3 + hr) * 1536 + col) = w;
                            if (chunk >= 512 || (chunk & 31) == 31) {
                                float* o = chunk < 512 ? F.out + O_GDNC_P + ((size_t)(l * 16 + (chunk >> 5)) * 3 + hr) * 1536 + col
                                                       : F.out + O_GDNC_S + ((size_t)(l * 8 + (chunk - 512)) * 3 + hr) * 1536 + col;
                                *(f32x4*)o = v;
                            }
                        }
                    } break;
                    case EPI_RESID: {
                        float* X = F.out + (size_t)row * 1024 + col;
                        f32x4 x = *(const f32x4*)X; x = x + v; *(f32x4*)X = x;
                        *(u32x2*)(((bf16_t*)(F.ws + WS_XB)) + (size_t)row * 1024 + col) = pk4(x);
                        ss += (x[0] * x[0] + x[1] * x[1]) + (x[2] * x[2] + x[3] * x[3]);
                    } break;
                    case EPI_Q: *(u32x2*)(((bf16_t*)(F.ws + WS_P)) + (size_t)row * LDP + C_Q + col) = pk4(v * rs); break;
                    case EPI_MEMK: {
                        v = v * rs;
                        *(f32x4*)(F.out + O_MEMK + ((size_t)l * 4096 + row) * 1024 + col) = v;
                        *(u32x2*)(((bf16_t*)(F.ws + WS_KV)) + (size_t)row * 1024 + col) = pk4(v);
                    } break;
                    case EPI_MEMV: {
                        const f32x4 r4 = *(const f32x4*)(((float*)(F.ws + WS_MRS)) + col);
                        v = v * r4;
                        float* o = F.out + O_MEMV + ((size_t)l * 4096 + col) * 1024 + row;
                        o[0] = v[0]; o[1024] = v[1]; o[2048] = v[2]; o[3072] = v[3];
                        const int b = col >> 8, h = row >> 8;
                        *(u32x2*)(((bf16_t*)(F.ws + WS_KV + 6144ull * 1024 * 2)) + ((size_t)(b * 4 + h) * 256 + (row & 255)) * 256 + (col & 255)) = pk4(v);
                    } break;
                    case EPI_OUTA: {
                        const f32x4 g = unpk4(*(const u32x2*)(((bf16_t*)(F.ws + WS_P)) + (size_t)row * LDP + C_GA + col));
                        f32x4 o; for (int j = 0; j < 4; ++j) o[j] = sigm(g[j]) * v[j];
                        *(u32x2*)(((bf16_t*)(F.ws + WS_P)) + (size_t)row * LDP + C_MRG + col) = pk4(o);
                    } break;
                    case EPI_OUTB: {
                        const f32x4 g = unpk4(*(const u32x2*)(((bf16_t*)(F.ws + WS_P)) + (size_t)row * LDP + C_GB + col));
                        f32x4 o = unpk4(*(const u32x2*)(((bf16_t*)(F.ws + WS_P)) + (size_t)row * LDP + C_MRG + col));
                        for (int j = 0; j < 4; ++j) o[j] += sigm(g[j]) * v[j];
                        *(u32x2*)(((bf16_t*)(F.ws + WS_P)) + (size_t)row * LDP + C_MRG + col) = pk4(o);
                    } break;
                    case EPI_ATTNO: {
                        const bool valid = d.vai < 0 || (d.vai == ai && d.vwr == wr);
                        if (valid) *(u32x2*)(((bf16_t*)(F.ws + WS_P)) + (size_t)row * LDP + C_O + d.head * 256 + col) = pk4(v);
                    } break;
                    default: break;
                    }
                }
            if (d.epi == EPI_RESID) {
                ss += __shfl_xor(ss, 16); ss += __shfl_xor(ss, 32);
                if (fq == 0) ((float*)(F.ws + WS_SSQ))[((size_t)(d.ocol >> 8) * TT + row) * 4 + wc] = ss;
            }
        }
    if (d.epi == EPI_UP) {
        bf16_t* ST = (bf16_t*)F.lds;
        const int pm = d.brow >> 8, pn = d.bcol >> 8;
        const bool samp = pm >= 128, needfix = !samp && (pm & 7) != 0;
        bf16_t* halo = ((bf16_t*)(F.ws + WS_KV)); bf16_t* raw01 = ((bf16_t*)(F.ws + WS_KV + 11714560ull));
        __syncthreads();
        {
            const int hsel = F.tid >> 6, cl4 = (F.tid & 63) * 4, ocol = ((cl4 >> 7) ? 2816 : 0) + 128 * pn + (cl4 & 127);
            const int row_l = (hsel >> 1) * 64 + 62 + (hsel & 1), chunk = (d.brow + row_l) >> 6, hr = hsel & 1;
            const u32x2 w = *(const u32x2*)(ST + row_l * 264 + cl4);
            *(u32x2*)(halo + ((size_t)chunk * 2 + hr) * 5632 + ocol) = w;
            if (chunk >= 512 || (chunk & 31) == 31) {
                float* o = chunk < 512 ? F.out + O_FFNC_P + ((size_t)(l * 16 + (chunk >> 5)) * 2 + hr) * 5632 + ocol
                                       : F.out + O_FFNC_S + ((size_t)(l * 8 + (chunk - 512)) * 2 + hr) * 5632 + ocol;
                *(f32x4*)o = unpk4(w);
            }
            if (needfix && hsel < 2) *(u32x2*)(raw01 + ((size_t)pm * 2 + hsel) * 5632 + ocol) = *(const u32x2*)(ST + hsel * 264 + cl4);
        }
        {
            const int cq = F.tid & 31, rg = F.tid >> 5, c4 = cq * 4, gcol = 128 * pn + c4, r0 = rg * 16;
            const float* cw = F.in[29] + (size_t)l * 3 * 5632; const float* cb = F.in[30] + (size_t)l * 5632;
            const f32x4 wg0 = *(const f32x4*)(cw + gcol), wg1 = *(const f32x4*)(cw + 5632 + gcol), wg2 = *(const f32x4*)(cw + 2 * 5632 + gcol), bg = *(const f32x4*)(cb + gcol);
            const f32x4 wv0 = *(const f32x4*)(cw + 2816 + gcol), wv1 = *(const f32x4*)(cw + 5632 + 2816 + gcol), wv2 = *(const f32x4*)(cw + 2 * 5632 + 2816 + gcol), bv = *(const f32x4*)(cb + 2816 + gcol);
            f32x4 g2 = {0.f, 0.f, 0.f, 0.f}, g1 = g2, v2 = g2, v1 = g2; bool skip2 = false;
            if ((samp ? (r0 & 63) : r0) != 0) {
                g2 = unpk4(*(const u32x2*)(ST + (r0 - 2) * 264 + c4)); g1 = unpk4(*(const u32x2*)(ST + (r0 - 1) * 264 + c4));
                v2 = unpk4(*(const u32x2*)(ST + (r0 - 2) * 264 + 128 + c4)); v1 = unpk4(*(const u32x2*)(ST + (r0 - 1) * 264 + 128 + c4));
            } else if (samp) {
                const float* sp = F.in[5] + (size_t)(l * 8 + (((d.brow + r0) >> 6) - 512)) * 2 * 5632;
                g2 = *(const f32x4*)(sp + gcol); g1 = *(const f32x4*)(sp + 5632 + gcol); v2 = *(const f32x4*)(sp + 2816 + gcol); v1 = *(const f32x4*)(sp + 5632 + 2816 + gcol);
            } else skip2 = needfix;
#pragma unroll 4
            for (int i = 0; i < 16; ++i) {
                const int row_l = r0 + i;
                const f32x4 g0 = unpk4(*(const u32x2*)(ST + row_l * 264 + c4)), v0 = unpk4(*(const u32x2*)(ST + row_l * 264 + 128 + c4));
                f32x4 o;
#pragma unroll
                for (int j = 0; j < 4; ++j) { const float yg = wg0[j] * g2[j] + wg1[j] * g1[j] + wg2[j] * g0[j] + bg[j], yv = wv0[j] * v2[j] + wv1[j] * v1[j] + wv2[j] * v0[j] + bv[j]; o[j] = silu(yg) * yv; }
                if (!(skip2 && i < 2)) *(u32x2*)(((bf16_t*)(F.ws + WS_P)) + (size_t)(d.brow + row_l) * LDP + gcol) = pk4(o);
                g2 = g1; g1 = g0; v2 = v1; v1 = v0;
            }
        }
        __syncthreads();
    }
}

DEV void sample_rows_gemm(const Frame& F0, const bf16_t* A, int lda, const bf16_t* Bt, int K, int resid) {
    REFRAME;
    if (F.nb != 256) return;
    const int fr = F.lane & 15, fq = F.lane >> 4, w = F.wid, rgp = F.bid >> 3, cg = F.bid & 7;
    const int row = 32768 + rgp * 16 + fr, colt = cg * 128 + w * 16;
    const bf16_t* ap = A + (size_t)row * lda + 8 * fq;
    const bf16_t* bp = Bt + (size_t)(colt + fr) * K + 8 * fq;
    f32x4 acc = {0.f, 0.f, 0.f, 0.f};
#pragma unroll 8
    for (int k = 0; k < K; k += 32) acc = MFMA16(*(const bf16x8*)(bp + k), *(const bf16x8*)(ap + k), acc);
    const int col = colt + 4 * fq;
    if (resid == 1) {
        float* X = F.out + (size_t)row * 1024 + col;
        f32x4 x = *(const f32x4*)X; x = x + acc; *(f32x4*)X = x;
        *(u32x2*)(((bf16_t*)(F.ws + WS_XB)) + (size_t)row * 1024 + col) = pk4(x);
        float ss = (x[0] * x[0] + x[1] * x[1]) + (x[2] * x[2] + x[3] * x[3]);
        ss += __shfl_xor(ss, 16); ss += __shfl_xor(ss, 32);
        float* red = (float*)F.lds;
        __syncthreads();
        if (fq == 0) red[fr * 8 + w] = ss;
        __syncthreads();
        if (F.tid < 32) {
            const int r = F.tid & 15, g = F.tid >> 4, c0 = cg * 128 + g * 64;
            const float t = (red[r * 8 + g * 4] + red[r * 8 + g * 4 + 1]) + (red[r * 8 + g * 4 + 2] + red[r * 8 + g * 4 + 3]);
            ((float*)(F.ws + WS_SSQ))[((size_t)(c0 >> 8) * TT + 32768 + rgp * 16 + r) * 4 + ((c0 >> 6) & 3)] = t;
        }
        __syncthreads();
    } else if (resid == 0) {
        const float rs = row_rstd(((float*)(F.ws + WS_SSQ)), row) * 0.0625f;
        *(u32x2*)(((bf16_t*)(F.ws + WS_P)) + (size_t)row * LDP + C_Q + col) = pk4(acc * rs);
    } else {
        bf16_t* prow = ((bf16_t*)(F.ws + WS_P)) + (size_t)row * LDP;
        const f32x4 g = unpk4(*(const u32x2*)(prow + (resid == 2 ? C_GA : C_GB) + col));
        f32x4 o = {0.f, 0.f, 0.f, 0.f};
        if (resid == 3) o = unpk4(*(const u32x2*)(prow + C_MRG + col));
#pragma unroll
        for (int j = 0; j < 4; ++j) o[j] += sigm(g[j]) * acc[j];
        *(u32x2*)(prow + C_MRG + col) = pk4(o);
    }
}

enum { GP_IN = 0, GP_OUT, GP_WO, GP_MQ, GP_ATTN, GP_MO, GP_UP, GP_DOWN, GP_ATTN2, GP_OUT2, GP_MEMKV };
DEV void gemm_phase(const Frame& F0, int kind, int l) {
    REFRAME;
    int nunits = 0;
    switch (kind) { case GP_IN: case GP_UP: nunits = 130 * 22; break; case GP_OUT: nunits = 520 + 128; break; case GP_OUT2: nunits = 520; break; case GP_ATTN: case GP_ATTN2: nunits = 512 + 32; break; default: nunits = 520; }
    const bool srow = (F.nb == 256) && (kind == GP_WO || kind == GP_MQ || kind == GP_MO || kind == GP_DOWN || kind == GP_OUT || kind == GP_OUT2);
    if (srow) nunits = 512;
    if (kind == GP_MEMKV) nunits = 128;
    f32x4 acc[2][2][4][2];
    const bool xmap = (F.nb == 256) && (kind == GP_IN || kind == GP_UP || kind == GP_WO || kind == GP_MQ || kind == GP_MO || kind == GP_DOWN || kind == GP_OUT2 || (kind == GP_OUT && srow));
    const int xcd = F.bid & 7, slot = F.bid >> 3, w_lo = (int)(((long)nunits * xcd) >> 3), w_hi = (int)(((long)nunits * (xcd + 1)) >> 3);
    const bool mkv = kind == GP_MEMKV;
    for (int u0 = mkv ? (F.bid >= 192 ? F.bid - 192 : nunits) : (xmap ? w_lo + slot : F.bid); u0 < (xmap ? w_hi : nunits); u0 += mkv ? 64 : (xmap ? 32 : F.nb)) {
        int u = u0;
        if (xmap) { const int nn = (kind == GP_IN || kind == GP_UP) ? 22 : 4; const int nm = srow ? 128 : 130; const int pn_ = u0 / nm, pm_ = u0 % nm; u = pm_ * nn + pn_; }
        GDesc d;
        { const int sub = (kind == GP_ATTN2 || kind == GP_OUT2) ? 1 : 0;
            d.vai = -1; d.vwr = 0; d.head = 0;
            switch (kind) {
            case GP_IN: { const int pm = u / 22, pn = u % 22; d.A = ((bf16_t*)(F.ws + WS_XB)); d.lda = 1024; d.Bt = ((bf16_t*)(F.ws + WS_WMIX)) + WM_WIN; d.ldb = 1024; d.K = 1024; d.brow = pm * 256; d.bcol = pn * 256; d.epi = EPI_PROJ; d.orow = d.brow; d.ocol = d.bcol; } break;
            case GP_UP: { const int pm = u / 22, pn = u % 22; d.A = ((bf16_t*)(F.ws + WS_XB)); d.lda = 1024; d.Bt = ((bf16_t*)(F.ws + WS_WFFN)) + WF_UP; d.ldb = 1024; d.K = 1024; d.brow = pm * 256; d.bcol = pn * 256; d.epi = EPI_UP; d.orow = d.brow; d.ocol = d.bcol; } break;
            case GP_MEMKV: case GP_OUT: case GP_OUT2:
                if (kind == GP_MEMKV) u += 520;
                if (u < 520) { const int pm = u >> 2, pn = u & 3; d.A = ((bf16_t*)(F.ws + WS_P)) + (sub == 0 ? C_ZA : C_ZB); d.lda = LDP; d.Bt = ((bf16_t*)(F.ws + WS_WMIX)) + (sub == 0 ? WM_WOA : WM_WOB); d.ldb = 512; d.K = 512;
                               d.brow = pm * 256; d.bcol = pn * 256; d.epi = sub == 0 ? EPI_OUTA : EPI_OUTB; d.orow = d.brow; d.ocol = d.bcol; }
                else if (u < 520 + 64) { const int v = u - 520, pm = v >> 2, pn = v & 3; d.A = ((bf16_t*)(F.ws + WS_MB)); d.lda = 1024; d.Bt = ((bf16_t*)(F.ws + WS_WMIX)) + WM_WMK; d.ldb = 1024; d.K = 1024; d.brow = pm * 256; d.bcol = pn * 256; d.epi = EPI_MEMK; d.orow = d.brow; d.ocol = d.bcol; }
                else { const int v = u - 584, pm = v & 3, pn = v >> 2; d.A = ((bf16_t*)(F.ws + WS_WMIX)) + WM_WMV; d.lda = 1024; d.Bt = ((bf16_t*)(F.ws + WS_MB)); d.ldb = 1024; d.K = 1024; d.brow = pm * 256; d.bcol = pn * 256; d.epi = EPI_MEMV; d.orow = d.brow; d.ocol = d.bcol; }
                break;
            case GP_WO: { const int pm = u >> 2, pn = u & 3; d.A = ((bf16_t*)(F.ws + WS_P)) + C_MRG; d.lda = LDP; d.Bt = ((bf16_t*)(F.ws + WS_WMIX)) + WM_WO; d.ldb = 1024; d.K = 1024; d.brow = pm * 256; d.bcol = pn * 256; d.epi = EPI_RESID; d.orow = d.brow; d.ocol = d.bcol; } break;
            case GP_MQ: { const int pm = u >> 2, pn = u & 3; d.A = ((bf16_t*)(F.ws + WS_XB)); d.lda = 1024; d.Bt = ((bf16_t*)(F.ws + WS_WMIX)) + WM_WMQ; d.ldb = 1024; d.K = 1024; d.brow = pm * 256; d.bcol = pn * 256; d.epi = EPI_Q; d.orow = d.brow; d.ocol = d.bcol; } break;
            case GP_MO: { const int pm = u >> 2, pn = u & 3; d.A = ((bf16_t*)(F.ws + WS_P)) + C_O; d.lda = LDP; d.Bt = ((bf16_t*)(F.ws + WS_WMIX)) + WM_WMO; d.ldb = 1024; d.K = 1024; d.brow = pm * 256; d.bcol = pn * 256; d.epi = EPI_RESID; d.orow = d.brow; d.ocol = d.bcol; } break;
            case GP_DOWN: { const int pm = u >> 2, pn = u & 3; d.A = ((bf16_t*)(F.ws + WS_P)); d.lda = LDP; d.Bt = ((bf16_t*)(F.ws + WS_WFFN)) + WF_DN; d.ldb = 2816; d.K = 2816; d.brow = pm * 256; d.bcol = pn * 256; d.epi = EPI_RESID; d.orow = d.brow; d.ocol = d.bcol; } break;
            case GP_ATTN: case GP_ATTN2: {
                int pm, h, b;
                if (u < 512) { pm = u >> 2; h = u & 3; b = pm >> 3; }
                else { const int v = u - 512; h = v & 3; const int bi = (v >> 2) & 3, t = v >> 4; pm = 128 + t; b = 16 + 4 * t + bi; d.vai = bi >> 1; d.vwr = bi & 1; }
                d.head = h; d.brow = pm * 256; d.orow = d.brow; d.ocol = 0; d.K = 256; d.bcol = 0;
                if (sub == 0) { d.A = ((bf16_t*)(F.ws + WS_P)) + C_Q + h * 256; d.lda = LDP; d.Bt = ((bf16_t*)(F.ws + WS_KV)) + (size_t)b * 256 * 1024 + h * 256; d.ldb = 1024; d.epi = EPI_SOFTMAX; }
                else { d.A = ((bf16_t*)(F.ws + WS_P)) + C_PR + h * 256; d.lda = LDP; d.Bt = ((bf16_t*)(F.ws + WS_KV + 6144ull * 1024 * 2)) + (size_t)(b * 4 + h) * 65536; d.ldb = 256; d.epi = EPI_ATTNO; }
            } break;
            }
        }
        gemm_core(d.A, d.lda, d.Bt, d.ldb, d.K, d.brow, d.bcol, acc, (bf16_t*)F.lds);
        gemm_epilogue(F, d, l, acc);
    }
    if (srow) {
        __syncthreads();
        if (kind == GP_WO) sample_rows_gemm(F, ((bf16_t*)(F.ws + WS_P)) + C_MRG, LDP, ((bf16_t*)(F.ws + WS_WMIX)) + WM_WO, 1024, 1);
        else if (kind == GP_MQ) sample_rows_gemm(F, ((bf16_t*)(F.ws + WS_XB)), 1024, ((bf16_t*)(F.ws + WS_WMIX)) + WM_WMQ, 1024, 0);
        else if (kind == GP_OUT) sample_rows_gemm(F, ((bf16_t*)(F.ws + WS_P)) + C_ZA, LDP, ((bf16_t*)(F.ws + WS_WMIX)) + WM_WOA, 512, 2);
        else if (kind == GP_OUT2) sample_rows_gemm(F, ((bf16_t*)(F.ws + WS_P)) + C_ZB, LDP, ((bf16_t*)(F.ws + WS_WMIX)) + WM_WOB, 512, 3);
        else if (kind == GP_MO) sample_rows_gemm(F, ((bf16_t*)(F.ws + WS_P)) + C_O, LDP, ((bf16_t*)(F.ws + WS_WMIX)) + WM_WMO, 1024, 1);
        else sample_rows_gemm(F, ((bf16_t*)(F.ws + WS_P)), LDP, ((bf16_t*)(F.ws + WS_WFFN)) + WF_DN, 2816, 1);
    }
}

DEV void sample_kv(const Frame& F0, int l) {
    REFRAME;
    const float* ck = F.in[6] + (size_t)l * 2097152; const float* cv = F.in[7] + (size_t)l * 2097152;
    const bool idle = F.nb == 256;
    if (idle && F.bid < 192) return;
    for (int i = (idle ? F.bid - 192 : F.bid) * 512 + F.tid; i < 262144; i += (idle ? 64 : F.nb) * 512) {
        const f32x4 a = *(const f32x4*)(ck + (size_t)i * 8), b = *(const f32x4*)(ck + (size_t)i * 8 + 4);
        u32x4 w; w.x = pk2(a[0], a[1]); w.y = pk2(a[2], a[3]); w.z = pk2(b[0], b[1]); w.w = pk2(b[2], b[3]);
        *(u32x4*)(((bf16_t*)(F.ws + WS_KV)) + 4096ull * 1024 + (size_t)i * 8) = w;
        const int dd = i & 255, m8 = (i >> 8) & 31, h = (i >> 13) & 3, bb = i >> 15;
        const float* s = cv + ((size_t)(bb * 256 + m8 * 8) * 4 + h) * 256 + dd;
        u32x4 x; x.x = pk2(s[0], s[1024]); x.y = pk2(s[2048], s[3072]); x.z = pk2(s[4096], s[5120]); x.w = pk2(s[6144], s[7168]);
        *(u32x4*)(((bf16_t*)(F.ws + WS_KV + 6144ull * 1024 * 2)) + ((size_t)((16 + bb) * 4 + h) * 256 + dd) * 256 + m8 * 8) = x;
    }
}

DEV void g1_gdn(const Frame& F0, int l, int c, int h) {
    REFRAME;
    float* Fq = (float*)F.lds;
    bf16_t* VS = (bf16_t*)(F.lds + 66560);
    bf16_t* QN = (bf16_t*)(F.lds + 82944);
    bf16_t* KN = (bf16_t*)(F.lds + 100352);
    float* AM = (float*)(F.lds + 117760);
    float* sB = (float*)(F.lds + 135168); float* sG = sB + 64; float* sRQ = sB + 128; float* sRK = sB + 192;
    const int tid = F.tid, lane = F.lane, t0 = c * 64;
    const bool first = c >= 512 || (c & 31) == 0; const bool sample = c >= 512;
    __syncthreads();
    if (F.wid == 0) {
        const int t = t0 + lane;
        const float braw = ((float*)(F.ws + WS_SC))[(size_t)t * 32 + h], araw = ((float*)(F.ws + WS_SC))[(size_t)t * 32 + 4 + h];
        const float beta = sigm(braw);
        float g = -__expf(F.in[12][l * 4 + h]) * softplus(araw + F.in[13][l * 4 + h]);
#pragma unroll
        for (int off = 1; off < 64; off <<= 1) { const float n = __shfl_up(g, off); if (lane >= off) g += n; }
        sB[lane] = beta; sG[lane] = g;
        if (!F.dry) ((float*)(F.ws + WS_BG))[((size_t)c * 4 + h) * 128 + lane] = beta; if (!F.dry) ((float*)(F.ws + WS_BG))[((size_t)c * 4 + h) * 128 + 64 + lane] = g;
    }
    __syncthreads();
    const float* cw = F.in[11] + (size_t)l * 4 * 1536;
    if (tid < 384) {
        const int cp = tid % 192, rh = tid / 192, which = cp >> 6, cc = (cp & 63) * 2, pcol = which * 512 + h * 128 + cc;
        const f32x2 w0 = *(const f32x2*)(cw + pcol), w1 = *(const f32x2*)(cw + 1536 + pcol), w2 = *(const f32x2*)(cw + 2 * 1536 + pcol), w3 = *(const f32x2*)(cw + 3 * 1536 + pcol);
        float x0[35], x1[35];
#pragma unroll
        for (int i = 0; i < 3; ++i) {
            x0[i] = 0.f; x1[i] = 0.f;
            if (rh == 1) { const unsigned u = *(const unsigned*)(((bf16_t*)(F.ws + WS_P)) + (size_t)(t0 + 29 + i) * LDP + pcol); x0[i] = bflo(u); x1[i] = bfhi(u); }
            else if (!first) { const unsigned u = *(const unsigned*)(((bf16_t*)(F.ws + WS_KV)) + ((size_t)(c - 1) * 3 + i) * 1536 + pcol); x0[i] = bflo(u); x1[i] = bfhi(u); }
            else if (sample) { const f32x2 f = *(const f32x2*)(F.in[3] + ((size_t)(l * 8 + (c - 512)) * 3 + i) * 1536 + pcol); x0[i] = f[0]; x1[i] = f[1]; }
        }
#pragma unroll
        for (int i = 0; i < 32; ++i) { const unsigned u = *(const unsigned*)(((bf16_t*)(F.ws + WS_P)) + (size_t)(t0 + 32 * rh + i) * LDP + pcol); x0[3 + i] = bflo(u); x1[3 + i] = bfhi(u); }
#pragma unroll
        for (int r = 0; r < 32; ++r) {
            float a0 = w0[0] * x0[r] + w1[0] * x0[r + 1] + w2[0] * x0[r + 2] + w3[0] * x0[r + 3];
            float a1 = w0[1] * x1[r] + w1[1] * x1[r + 1] + w2[1] * x1[r + 2] + w3[1] * x1[r + 3];
            a0 = silu(a0); a1 = silu(a1);
            const int rr = 32 * rh + r;
            if (which < 2) { *(f32x2*)(Fq + rr * 260 + which * 128 + cc) = (f32x2){a0, a1}; }
            else { const float be = sB[rr]; *(unsigned*)(VS + rr * 128 + cc) = pk2(a0 * be, a1 * be); }
        }
    }
    __syncthreads();
    {
        const int r = tid >> 3, j = tid & 7; const float* p = Fq + r * 260 + j * 32; float s = 0.f;
#pragma unroll
        for (int i = 0; i < 32; ++i) s += p[i] * p[i];
        s += __shfl_xor(s, 1); s += __shfl_xor(s, 2);
        if ((j & 3) == 0) { if (j == 0) sRQ[r] = rsqrtf(s + 1e-6f) * 0.08838834764831845f; else sRK[r] = rsqrtf(s + 1e-6f); }
    }
    __syncthreads();
    for (int idx = tid; idx < 64 * 64; idx += 512) {
        const int r = idx >> 6, c4 = (idx & 63) * 4; const bool isq = c4 < 128;
        f32x4 v = *(const f32x4*)(Fq + r * 260 + c4); v = v * (isq ? sRQ[r] : sRK[r]);
        const u32x2 w = pk4(v);
        if (isq) { *(u32x2*)(QN + r * 136 + c4) = w; if (!F.dry) *(u32x2*)(((bf16_t*)(F.ws + WS_P)) + (size_t)(t0 + r) * LDP + C_QA + h * 128 + c4) = w; }
        else { *(u32x2*)(KN + r * 136 + c4 - 128) = w; if (!F.dry) *(u32x2*)(((bf16_t*)(F.ws + WS_P)) + (size_t)(t0 + r) * LDP + C_KA + h * 128 + c4 - 128) = w; }
    }
    for (int idx = tid; idx < 64 * 32; idx += 512) {
        const int r = idx >> 5, c4 = (idx & 31) * 4;
        if (!F.dry) *(u32x2*)(((bf16_t*)(F.ws + WS_P)) + (size_t)(t0 + r) * LDP + C_VA + h * 128 + c4) = *(const u32x2*)(VS + r * 128 + c4);
    }
    __syncthreads();
    {
        const int fr = lane & 15, fq = lane >> 4, which = F.wid >> 2, it = F.wid & 3;
        const bf16_t* X = which ? QN : KN;
        const int crow = 16 * it + fr; const float gc = sG[crow], bc = sB[crow];
        for (int jt = 0; jt < 4; ++jt) {
            f32x4 a = {0.f, 0.f, 0.f, 0.f};
            if (jt <= it) {
#pragma unroll
                for (int ks = 0; ks < 4; ++ks) a = MFMA16(ldfrag(KN, 16 * jt + fr, 136, 32 * ks, fq), ldfrag(X, crow, 136, 32 * ks, fq), a);
            }
            f32x4 o;
#pragma unroll
            for (int j = 0; j < 4; ++j) {
                const int s = 16 * jt + 4 * fq + j;
                const bool keep = which ? (s <= crow) : (s < crow);
                const float dec = keep ? __expf(gc - sG[s]) : 0.f;
                o[j] = a[j] * dec * (which ? 1.f : bc);
            }
            if (which) { if (!F.dry) *(u32x2*)(((bf16_t*)(F.ws + WS_XB)) + (size_t)(t0 + crow) * LDE + h * 128 + 64 + 16 * jt + 4 * fq) = pk4(o); }
            else *(f32x4*)(AM + crow * 68 + 16 * jt + 4 * fq) = o;
        }
    }
    __syncthreads();
    {
        float* TF = (float*)F.lds;
        float* MS = (float*)(F.lds + 20480);
        const int w = F.wid;
        if (w == 0) {
            const int blk = lane >> 4, cc = lane & 15, base = blk * 16;
            float Tc[16];
#pragma unroll
            for (int i = 0; i < 16; ++i) {
                float a = (i == cc) ? 1.f : 0.f;
#pragma unroll
                for (int j = 0; j < i; ++j) a -= AM[(base + i) * 68 + base + j] * Tc[j];
                Tc[i] = a;
            }
#pragma unroll
            for (int i = 0; i < 16; ++i) TF[(base + i) * 68 + base + cc] = Tc[i];
        }
        __syncthreads();
#pragma unroll 1
        for (int dd = 1; dd < 4; ++dd) {
            if (w < 4 - dd) {
                const int I = w + dd, J = w, r = lane >> 2, c4 = (lane & 3) * 4;
                f32x4 mm = {0.f, 0.f, 0.f, 0.f};
                for (int K = J; K < I; ++K)
#pragma unroll
                    for (int k = 0; k < 16; ++k) { const float a = AM[(I * 16 + r) * 68 + K * 16 + k]; const f32x4 t = *(const f32x4*)(TF + (K * 16 + k) * 68 + J * 16 + c4); mm = mm + a * t; }
                float* ms = MS + w * 256;
                *(f32x4*)(ms + r * 16 + c4) = mm;
                asm volatile("s_waitcnt lgkmcnt(0)" ::: "memory");
                f32x4 o = {0.f, 0.f, 0.f, 0.f};
#pragma unroll
                for (int k = 0; k < 16; ++k) { const float a = TF[(I * 16 + r) * 68 + I * 16 + k]; const f32x4 t = *(const f32x4*)(ms + k * 16 + c4); o = o - a * t; }
                *(f32x4*)(TF + (I * 16 + r) * 68 + J * 16 + c4) = o;
            }
            __syncthreads();
        }
        {
            const int r = tid >> 3, c8 = (tid & 7) * 8; const bool z = (c8 >> 4) > (r >> 4);
            const f32x4 a = z ? (f32x4){0.f, 0.f, 0.f, 0.f} : *(const f32x4*)(TF + r * 68 + c8), b = z ? (f32x4){0.f, 0.f, 0.f, 0.f} : *(const f32x4*)(TF + r * 68 + c8 + 4);
            u32x4 o; o.x = pk2(a[0], a[1]); o.y = pk2(a[2], a[3]); o.z = pk2(b[0], b[1]); o.w = pk2(b[2], b[3]);
            if (!F.dry) *(u32x4*)(((bf16_t*)(F.ws + WS_XB)) + (size_t)(t0 + r) * LDE + h * 128 + c8) = o;
        }
    }
}

DEV void g1_gla(const Frame& F0, int l, int c, int h) {
    REFRAME;
    float* GL = (float*)F.lds;
    float* LA = (float*)(F.lds + 4096);
    bf16_t* QG = (bf16_t*)(F.lds + 20736);
    bf16_t* KI = (bf16_t*)(F.lds + 29952);
    const int tid = F.tid, lane = F.lane, t0 = c * 64;
    __syncthreads();
    if (tid < 256) { const int r = tid >> 2, q4 = (tid & 3) * 4; *(f32x4*)(GL + r * 16 + q4) = *(const f32x4*)(((float*)(F.ws + WS_SC)) + (size_t)(t0 + r) * 32 + 8 + q4); }
    __syncthreads();
    {
        const int dk = tid & 63, rb = tid >> 6;
        float w2[16];
#pragma unroll
        for (int i = 0; i < 16; ++i) w2[i] = F.in[15][(size_t)(l * 16 + i) * 256 + h * 64 + dk];
        const float bias = F.in[16][l * 256 + h * 64 + dk];
#pragma unroll
        for (int rr = 0; rr < 8; ++rr) {
            const int r = rb * 8 + rr; float x = bias;
#pragma unroll
            for (int i = 0; i < 16; ++i) x += GL[r * 16 + i] * w2[i];
            LA[r * 65 + dk] = logsigmoid(x) * 0.0625f;
        }
    }
    __syncthreads();
    if (tid < 64) {
        float g = 0.f;
#pragma unroll 8
        for (int r = 0; r < 64; ++r) { g += LA[r * 65 + tid]; LA[r * 65 + tid] = g; }
        if (!F.dry) ((float*)(F.ws + WS_DL))[((size_t)c * 4 + h) * 64 + tid] = __expf(g);
    }
    __syncthreads();
    for (int idx = tid; idx < 64 * 16; idx += 512) {
        const int r = idx >> 4, c4 = (idx & 15) * 4;
        bf16_t* qp = ((bf16_t*)(F.ws + WS_P)) + (size_t)(t0 + r) * LDP + C_QB + h * 64 + c4; bf16_t* kp = ((bf16_t*)(F.ws + WS_P)) + (size_t)(t0 + r) * LDP + C_KB + h * 64 + c4;
        const f32x4 q = unpk4(*(const u32x2*)qp), k = unpk4(*(const u32x2*)kp);
        f32x4 qg, ki, kg;
#pragma unroll
        for (int j = 0; j < 4; ++j) { const float g = LA[r * 65 + c4 + j], gl = LA[63 * 65 + c4 + j];
            qg[j] = q[j] * 0.125f * __expf(g); ki[j] = k[j] * __expf(-g); kg[j] = k[j] * __expf(gl - g); }
        const u32x2 wq = pk4(qg);
        *(u32x2*)(QG + r * 72 + c4) = wq; *(u32x2*)(KI + r * 72 + c4) = pk4(ki);
        if (!F.dry) *(u32x2*)qp = wq; if (!F.dry) *(u32x2*)kp = pk4(kg);
    }
    __syncthreads();
    {
        const int fr = lane & 15, fq = lane >> 4, it = F.wid >> 1; const int crow = 16 * it + fr;
#pragma unroll
        for (int q = 0; q < 2; ++q) {
            const int jt = (F.wid & 1) * 2 + q;
            f32x4 a = {0.f, 0.f, 0.f, 0.f};
            if (jt <= it) {
#pragma unroll
                for (int ks = 0; ks < 2; ++ks) a = MFMA16(ldfrag(KI, 16 * jt + fr, 72, 32 * ks, fq), ldfrag(QG, crow, 72, 32 * ks, fq), a);
            }
#pragma unroll
            for (int j = 0; j < 4; ++j) if (16 * jt + 4 * fq + j > crow) a[j] = 0.f;
            if (!F.dry) *(u32x2*)(((bf16_t*)(F.ws + WS_XB)) + (size_t)(t0 + crow) * LDE + 512 + h * 64 + 16 * jt + 4 * fq) = pk4(a);
        }
    }
}

DEV void g2_gdn(const Frame& F0, int l, int s, int h) {
    REFRAME;
    bf16_t* QN = (bf16_t*)F.lds;
    bf16_t* KN = (bf16_t*)(F.lds + 17408);
    bf16_t* KT = (bf16_t*)(F.lds + 34816);
    bf16_t* TM = (bf16_t*)(F.lds + 53248);
    bf16_t* AQ = (bf16_t*)(F.lds + 62464);
    float* sB = (float*)(F.lds + 71680); float* sG = sB + 64;
    float* RED = (float*)(F.lds + 72192);
    bf16_t* VV = (bf16_t*)(F.lds + 74240);
    bf16_t* ZZ0 = (bf16_t*)(F.lds + 91648);
    const int tid = F.tid, lane = F.lane, w = F.wid, fr = lane & 15, fq = lane >> 4;
    const bool sample = s >= 16; const int nchunk = sample ? 1 : 32; const int tbase = sample ? 32768 + (s - 16) * 64 : s * 2048;
    const int dvc = h * 128 + 16 * w + fr;
    f32x4 S[8];
#pragma unroll
    for (int mt = 0; mt < 8; ++mt) {
        if (sample) { const float* sp = F.in[2] + ((size_t)((l * 8 + (s - 16)) * 4 + h) * 128) * 128;
#pragma unroll
            for (int j = 0; j < 4; ++j) S[mt][j] = sp[(size_t)(16 * mt + 4 * fq + j) * 128 + 16 * w + fr]; }
        else S[mt] = (f32x4){0.f, 0.f, 0.f, 0.f};
    }
    const float gn = F.in[14][l * 128 + 16 * w + fr];
    u32x4 pq[2], pk[2], pv[2], pz[2], pt, pa; float pbg = 0.f;
#define G2_FETCH(T0) do { int tq_ = tid; asm volatile("" : "+v"(tq_)); _Pragma("unroll") for (int i = 0; i < 2; ++i) { const int p_ = tq_ + 512 * i, r_ = p_ >> 4, c_ = (p_ & 15) * 8; \
        const bf16_t* rp_ = ((bf16_t*)(F.ws + WS_P)) + (size_t)((T0) + r_) * LDP + h * 128 + c_; \
        pq[i] = *(const u32x4*)(rp_ + C_QA); pk[i] = *(const u32x4*)(rp_ + C_KA); pv[i] = *(const u32x4*)(rp_ + C_VA); pz[i] = *(const u32x4*)(rp_ + C_ZA); } \
      { const int r_ = tq_ >> 3, c_ = (tq_ & 7) * 8; const bf16_t* ep_ = ((bf16_t*)(F.ws + WS_XB)) + (size_t)((T0) + r_) * LDE + h * 128 + c_; pt = *(const u32x4*)ep_; pa = *(const u32x4*)(ep_ + 64); } \
      if (tq_ < 128) pbg = ((float*)(F.ws + WS_BG))[((size_t)((T0) >> 6) * 4 + h) * 128 + tq_]; } while (0)
#define G2_PUT(PAR) do { int tq_ = tid; asm volatile("" : "+v"(tq_)); bf16_t* zz_ = ZZ0 + (PAR) * (64 * 136); _Pragma("unroll") for (int i = 0; i < 2; ++i) { const int p_ = tq_ + 512 * i, r = p_ >> 4, c8 = (p_ & 15) * 8; const u32x4 k = pk[i]; \
        *(u32x4*)(QN + r * 136 + c8) = pq[i]; *(u32x4*)(KN + r * 136 + c8) = k; *(u32x4*)(VV + r * 136 + c8) = pv[i]; *(u32x4*)(zz_ + r * 136 + c8) = pz[i]; \
        KT[(c8 + 0) * 72 + r] = (bf16_t)(k.x & 0xffff); KT[(c8 + 1) * 72 + r] = (bf16_t)(k.x >> 16); KT[(c8 + 2) * 72 + r] = (bf16_t)(k.y & 0xffff); KT[(c8 + 3) * 72 + r] = (bf16_t)(k.y >> 16); \
        KT[(c8 + 4) * 72 + r] = (bf16_t)(k.z & 0xffff); KT[(c8 + 5) * 72 + r] = (bf16_t)(k.z >> 16); KT[(c8 + 6) * 72 + r] = (bf16_t)(k.w & 0xffff); KT[(c8 + 7) * 72 + r] = (bf16_t)(k.w >> 16); } \
      { const int r = tq_ >> 3, c8 = (tq_ & 7) * 8; *(u32x4*)(TM + r * 72 + c8) = pt; *(u32x4*)(AQ + r * 72 + c8) = pa; } \
      if (tq_ < 128) sB[tq_] = pbg; } while (0)
    __syncthreads();
    G2_FETCH(tbase); G2_PUT(0);
    __syncthreads();
    for (int n = 0; n < nchunk; ++n) {
        const int t0 = tbase + n * 64;
        const bf16_t* ZZ = ZZ0 + (n & 1) * (64 * 136);
        f32x4 kS[4], qS[4], vn[4], o[4];
#pragma unroll
        for (int mt = 0; mt < 4; ++mt) { kS[mt] = (f32x4){0.f, 0.f, 0.f, 0.f}; qS[mt] = kS[mt]; vn[mt] = kS[mt]; }
#pragma unroll
        for (int ks = 0; ks < 4; ++ks) {
            const bf16x8 sf = mk8(pk4(S[2 * ks]), pk4(S[2 * ks + 1]));
#pragma unroll
            for (int mt = 0; mt < 4; ++mt) {
                kS[mt] = MFMA16(ldfragp(KN, 16 * mt + fr, 136, 32 * ks, fq), sf, kS[mt]);
                qS[mt] = MFMA16(ldfragp(QN, 16 * mt + fr, 136, 32 * ks, fq), sf, qS[mt]);
            }
        }
        const float glast = sG[63];
        f32x4 eg[4], tmp[4];
#pragma unroll
        for (int mt = 0; mt < 4; ++mt)
#pragma unroll
            for (int j = 0; j < 4; ++j) {
                const int row = 16 * mt + 4 * fq + j;
                const float e = __expf(sG[row]); eg[mt][j] = e;
                const float vv = bf2f(VV[row * 136 + 16 * w + fr]);
                tmp[mt][j] = vv - sB[row] * e * kS[mt][j];
            }
#pragma unroll
        for (int ks = 0; ks < 2; ++ks) {
            const bf16x8 tf = mk8(pk4(tmp[2 * ks]), pk4(tmp[2 * ks + 1]));
#pragma unroll
            for (int mt = 0; mt < 4; ++mt) vn[mt] = MFMA16(ldfragp(TM, 16 * mt + fr, 72, 32 * ks, fq), tf, vn[mt]);
        }
#pragma unroll
        for (int mt = 0; mt < 4; ++mt) o[mt] = eg[mt] * qS[mt];
#pragma unroll
        for (int ks = 0; ks < 2; ++ks) {
            const bf16x8 vf = mk8(pk4(vn[2 * ks]), pk4(vn[2 * ks + 1]));
#pragma unroll
            for (int mt = 0; mt < 4; ++mt) o[mt] = MFMA16(ldfragp(AQ, 16 * mt + fr, 72, 32 * ks, fq), vf, o[mt]);
        }
        const float dl = __expf(glast);
#pragma unroll
        for (int mt = 0; mt < 4; ++mt)
#pragma unroll
            for (int j = 0; j < 4; ++j) vn[mt][j] *= __expf(glast - sG[16 * mt + 4 * fq + j]);
#pragma unroll
        for (int mt = 0; mt < 8; ++mt) S[mt] = S[mt] * dl;
#pragma unroll
        for (int ks = 0; ks < 2; ++ks) {
            const bf16x8 vf = mk8(pk4(vn[2 * ks]), pk4(vn[2 * ks + 1]));
#pragma unroll
            for (int mt = 0; mt < 8; ++mt) S[mt] = MFMA16(ldfragp(KT, 16 * mt + fr, 72, 32 * ks, fq), vf, S[mt]);
        }
#pragma unroll
        for (int mt = 0; mt < 4; ++mt)
#pragma unroll
            for (int j = 0; j < 4; ++j) {
                float p = o[mt][j] * o[mt][j];
                p += __shfl_xor(p, 1); p += __shfl_xor(p, 2); p += __shfl_xor(p, 4); p += __shfl_xor(p, 8);
                if (fr == 0) RED[(16 * mt + 4 * fq + j) * 8 + w] = p;
            }
        __syncthreads();
        if (n + 1 < nchunk) G2_FETCH(t0 + 64);
        __builtin_amdgcn_sched_barrier(0);
#pragma unroll
        for (int mt = 0; mt < 4; ++mt)
#pragma unroll
            for (int j = 0; j < 4; ++j) {
                const int row = 16 * mt + 4 * fq + j;
                const f32x4 r0 = *(const f32x4*)(RED + row * 8), r1 = *(const f32x4*)(RED + row * 8 + 4);
                const float ssum = ((r0[0] + r0[1]) + (r0[2] + r0[3])) + ((r1[0] + r1[1]) + (r1[2] + r1[3]));
                const float rs = rsqrtf(ssum * (1.f / 128.f) + 1e-6f);
                bf16_t* zp = ((bf16_t*)(F.ws + WS_P)) + (size_t)(t0 + row) * LDP + C_ZA + dvc;
                const float z = bf2f(ZZ[row * 136 + 16 * w + fr]);
                if (!F.dry) *zp = (bf16_t)(pk2(o[mt][j] * rs * gn * silu(z), 0.f) & 0xffff);
                __builtin_amdgcn_sched_barrier(0);
            }
        if (n + 1 < nchunk) { G2_PUT((n + 1) & 1); __syncthreads(); }
    }
#undef G2_FETCH
#undef G2_PUT
    float* so = sample ? F.out + O_GDN_S + ((size_t)((l * 8 + (s - 16)) * 4 + h) * 128) * 128 : F.out + O_GDN_P + ((size_t)((l * 16 + s) * 4 + h) * 128) * 128;
#pragma unroll
    for (int mt = 0; mt < 8; ++mt)
#pragma unroll
        for (int j = 0; j < 4; ++j) if (!F.dry) so[(size_t)(16 * mt + 4 * fq + j) * 128 + 16 * w + fr] = S[mt][j];
}

DEV void g2_gla(const Frame& F0, int l, int s, int h) {
    REFRAME;
    bf16_t* QG = (bf16_t*)F.lds;
    bf16_t* KGT = (bf16_t*)(F.lds + 9216);
    bf16_t* AQ = (bf16_t*)(F.lds + 18432);
    float* sDL = (float*)(F.lds + 27648);
    float* RED = (float*)(F.lds + 27904);
    bf16_t* ZZ = (bf16_t*)(F.lds + 29952);
    const int tid = F.tid, lane = F.lane, w = F.wid, fr = lane & 15, fq = lane >> 4;
    const bool sample = s >= 16; const int nchunk = sample ? 1 : 32; const int tbase = sample ? 32768 + (s - 16) * 64 : s * 2048;
    const int dvc = h * 128 + 16 * w + fr;
    f32x4 S[4];
#pragma unroll
    for (int mt = 0; mt < 4; ++mt) {
        if (sample) { const float* sp = F.in[4] + ((size_t)((l * 8 + (s - 16)) * 4 + h) * 64) * 128;
#pragma unroll
            for (int j = 0; j < 4; ++j) S[mt][j] = sp[(size_t)(16 * mt + 4 * fq + j) * 128 + 16 * w + fr]; }
        else S[mt] = (f32x4){0.f, 0.f, 0.f, 0.f};
    }
    const float gn = F.in[17][l * 128 + 16 * w + fr];
    for (int n = 0; n < nchunk; ++n) {
        const int t0 = tbase + n * 64, chunk = t0 >> 6;
        __syncthreads();
        {
            const int r = tid >> 3, c8 = (tid & 7) * 8;
            *(u32x4*)(QG + r * 72 + c8) = *(const u32x4*)(((bf16_t*)(F.ws + WS_P)) + (size_t)(t0 + r) * LDP + C_QB + h * 64 + c8);
            const u32x4 k = *(const u32x4*)(((bf16_t*)(F.ws + WS_P)) + (size_t)(t0 + r) * LDP + C_KB + h * 64 + c8);
            KGT[(c8 + 0) * 72 + r] = (bf16_t)(k.x & 0xffff); KGT[(c8 + 1) * 72 + r] = (bf16_t)(k.x >> 16);
            KGT[(c8 + 2) * 72 + r] = (bf16_t)(k.y & 0xffff); KGT[(c8 + 3) * 72 + r] = (bf16_t)(k.y >> 16);
            KGT[(c8 + 4) * 72 + r] = (bf16_t)(k.z & 0xffff); KGT[(c8 + 5) * 72 + r] = (bf16_t)(k.z >> 16);
            KGT[(c8 + 6) * 72 + r] = (bf16_t)(k.w & 0xffff); KGT[(c8 + 7) * 72 + r] = (bf16_t)(k.w >> 16);
            *(u32x4*)(AQ + r * 72 + c8) = *(const u32x4*)(((bf16_t*)(F.ws + WS_XB)) + (size_t)(t0 + r) * LDE + 512 + h * 64 + c8);
        }
#pragma unroll
        for (int i = 0; i < 2; ++i) { const int p = tid + 512 * i, r = p >> 4, c8 = (p & 15) * 8;
            *(u32x4*)(ZZ + r * 136 + c8) = *(const u32x4*)(((bf16_t*)(F.ws + WS_P)) + (size_t)(t0 + r) * LDP + C_ZB + h * 128 + c8); }
        if (tid < 64) sDL[tid] = ((float*)(F.ws + WS_DL))[((size_t)chunk * 4 + h) * 64 + tid];
        bf16x8 vf[2];
#pragma unroll
        for (int ks = 0; ks < 2; ++ks) {
            unsigned e[8];
#pragma unroll
            for (int j = 0; j < 8; ++j) { const int row = 32 * ks + (j < 4 ? 4 * fq + j : 16 + 4 * fq + (j - 4)); e[j] = ((bf16_t*)(F.ws + WS_P))[(size_t)(t0 + row) * LDP + C_VB + dvc]; }
            u32x4 t; t.x = e[0] | (e[1] << 16); t.y = e[2] | (e[3] << 16); t.z = e[4] | (e[5] << 16); t.w = e[6] | (e[7] << 16);
            vf[ks] = __builtin_bit_cast(bf16x8, t);
        }
        __syncthreads();
        f32x4 o[4];
#pragma unroll
        for (int mt = 0; mt < 4; ++mt) o[mt] = (f32x4){0.f, 0.f, 0.f, 0.f};
#pragma unroll
        for (int ks = 0; ks < 2; ++ks) {
            const bf16x8 sf = mk8(pk4(S[2 * ks]), pk4(S[2 * ks + 1]));
#pragma unroll
            for (int mt = 0; mt < 4; ++mt) {
                o[mt] = MFMA16(ldfragp(QG, 16 * mt + fr, 72, 32 * ks, fq), sf, o[mt]);
                o[mt] = MFMA16(ldfragp(AQ, 16 * mt + fr, 72, 32 * ks, fq), vf[ks], o[mt]);
            }
        }
#pragma unroll
        for (int mt = 0; mt < 4; ++mt) {
#pragma unroll
            for (int j = 0; j < 4; ++j) S[mt][j] *= sDL[16 * mt + 4 * fq + j];
#pragma unroll
            for (int ks = 0; ks < 2; ++ks) S[mt] = MFMA16(ldfragp(KGT, 16 * mt + fr, 72, 32 * ks, fq), vf[ks], S[mt]);
        }
#pragma unroll
        for (int mt = 0; mt < 4; ++mt)
#pragma unroll
            for (int j = 0; j < 4; ++j) {
                float p = o[mt][j] * o[mt][j];
                p += __shfl_xor(p, 1); p += __shfl_xor(p, 2); p += __shfl_xor(p, 4); p += __shfl_xor(p, 8);
                if (fr == 0) RED[(16 * mt + 4 * fq + j) * 8 + w] = p;
            }
        __syncthreads();
#pragma unroll
        for (int mt = 0; mt < 4; ++mt)
#pragma unroll
            for (int j = 0; j < 4; ++j) {
                const int row = 16 * mt + 4 * fq + j;
                const f32x4 r0 = *(const f32x4*)(RED + row * 8), r1 = *(const f32x4*)(RED + row * 8 + 4);
                const float ssum = ((r0[0] + r0[1]) + (r0[2] + r0[3])) + ((r1[0] + r1[1]) + (r1[2] + r1[3]));
                const float rs = rsqrtf(ssum * (1.f / 128.f) + 1e-6f);
                bf16_t* zp = ((bf16_t*)(F.ws + WS_P)) + (size_t)(t0 + row) * LDP + C_ZB + dvc;
                const float z = bf2f(ZZ[row * 136 + 16 * w + fr]);
                if (!F.dry) *zp = (bf16_t)(pk2(o[mt][j] * rs * gn * silu(z), 0.f) & 0xffff);
            }
    }
    float* so = sample ? F.out + O_GLA_S + ((size_t)((l * 8 + (s - 16)) * 4 + h) * 64) * 128 : F.out + O_GLA_P + ((size_t)((l * 16 + s) * 4 + h) * 64) * 128;
#pragma unroll
    for (int mt = 0; mt < 4; ++mt)
#pragma unroll
        for (int j = 0; j < 4; ++j) if (!F.dry) so[(size_t)(16 * mt + 4 * fq + j) * 128 + 16 * w + fr] = S[mt][j];
}

DEV void unpack8(u32x4 u, float (&f)[8]) { f[0] = bflo(u.x); f[1] = bfhi(u.x); f[2] = bflo(u.y); f[3] = bfhi(u.y); f[4] = bflo(u.z); f[5] = bfhi(u.z); f[6] = bflo(u.w); f[7] = bfhi(u.w); }
DEV void load8f(const float* p, float (&f)[8]) { const f32x4 a = *(const f32x4*)p, b = *(const f32x4*)(p + 4); f[0] = a[0]; f[1] = a[1]; f[2] = a[2]; f[3] = a[3]; f[4] = b[0]; f[5] = b[1]; f[6] = b[2]; f[7] = b[3]; }
DEV void ffn_mid(const Frame& F0, int l) {
    REFRAME;
    const float* cw = F.in[29] + (size_t)l * 3 * 5632; const float* cb = F.in[30] + (size_t)l * 5632;
    const bf16_t* halo = ((bf16_t*)(F.ws + WS_KV)); const bf16_t* raw01 = ((bf16_t*)(F.ws + WS_KV + 11714560ull));
    for (int idx = F.bid * 512 + F.tid; idx < 112 * 704; idx += F.nb * 512) {
        const int ti = idx / 704, c4 = (idx % 704) * 4, pm = (ti / 7) * 8 + (ti % 7) + 1;
        const bf16_t* hp = halo + (size_t)(4 * pm - 1) * 2 * 5632; const bf16_t* rp = raw01 + (size_t)pm * 2 * 5632;
        const f32x4 gm2 = unpk4(*(const u32x2*)(hp + c4)), gm1 = unpk4(*(const u32x2*)(hp + 5632 + c4)), g0 = unpk4(*(const u32x2*)(rp + c4)), g1 = unpk4(*(const u32x2*)(rp + 5632 + c4));
        const f32x4 vm2 = unpk4(*(const u32x2*)(hp + 2816 + c4)), vm1 = unpk4(*(const u32x2*)(hp + 5632 + 2816 + c4)), v0 = unpk4(*(const u32x2*)(rp + 2816 + c4)), v1 = unpk4(*(const u32x2*)(rp + 5632 + 2816 + c4));
        const f32x4 wg0 = *(const f32x4*)(cw + c4), wg1 = *(const f32x4*)(cw + 5632 + c4), wg2 = *(const f32x4*)(cw + 2 * 5632 + c4), bg = *(const f32x4*)(cb + c4);
        const f32x4 wv0 = *(const f32x4*)(cw + 2816 + c4), wv1 = *(const f32x4*)(cw + 5632 + 2816 + c4), wv2 = *(const f32x4*)(cw + 2 * 5632 + 2816 + c4), bv = *(const f32x4*)(cb + 2816 + c4);
        f32x4 o0, o1;
#pragma unroll
        for (int j = 0; j < 4; ++j) {
            const float yg0 = wg0[j] * gm2[j] + wg1[j] * gm1[j] + wg2[j] * g0[j] + bg[j], yv0 = wv0[j] * vm2[j] + wv1[j] * vm1[j] + wv2[j] * v0[j] + bv[j];
            const float yg1 = wg0[j] * gm1[j] + wg1[j] * g0[j] + wg2[j] * g1[j] + bg[j], yv1 = wv0[j] * vm1[j] + wv1[j] * v0[j] + wv2[j] * v1[j] + bv[j];
            o0[j] = silu(yg0) * yv0; o1[j] = silu(yg1) * yv1;
        }
        bf16_t* vp = ((bf16_t*)(F.ws + WS_P)) + (size_t)pm * 256 * LDP + c4;
        *(u32x2*)vp = pk4(o0); *(u32x2*)(vp + LDP) = pk4(o1);
    }
}

DEV void final_norm(const Frame& F0) {
    REFRAME;
    const int gw = F.bid * 8 + F.wid, nw = F.nb * 8, lane = F.lane;
    const float* g = F.in[32];
    for (int row = gw; row < TT; row += nw) {
        const float rs = row_rstd(((float*)(F.ws + WS_SSQ)), row);
        float* X = F.out + (size_t)row * 1024;
#pragma unroll
        for (int i = 0; i < 4; ++i) { const int cidx = i * 256 + lane * 4; f32x4 v = *(const f32x4*)(X + cidx); const f32x4 gg = *(const f32x4*)(g + cidx); *(f32x4*)(X + cidx) = v * rs * gg; }
    }
}

#ifdef DBG_COL
DEV void dbg_dump(const Frame& F0) {
    REFRAME;
    for (int i = F.bid * 512 + F.tid; i < TT * 256; i += F.nb * 512) {
        const int row = i >> 8, c = (i & 255) * 4;
        const f32x4 v = c < 512 ? unpk4(*(const u32x2*)(((bf16_t*)(F.ws + WS_P)) + (size_t)row * LDP + DBG_COL + c)) : (f32x4){0.f, 0.f, 0.f, 0.f};
        *(f32x4*)(F.out + (size_t)row * 1024 + c) = (row DBG_ROWSEL) ? v : (f32x4){0.f, 0.f, 0.f, 0.f};
    }
}
#endif
#define XB_TMO      128
#define XB_XCNT(j)  (256  + 64 * (j))
#define XB_XSUB(j)  (1280 + 64 * (j))
#define XB_XGEN(j)  (2304 + 64 * (j))
#define XB_TOP      3328
#define XB_TOPGEN   3392
#define XCD_BAR_WORDS 3456
#define XB_SPIN_CAP (1u << 18)
#define LAS __attribute__((address_space(3)))

__device__ __forceinline__ unsigned xb_ld(unsigned* p)              { return __hip_atomic_load(p, __ATOMIC_RELAXED, __HIP_MEMORY_SCOPE_AGENT); }
__device__ __forceinline__ unsigned xb_add(unsigned* p, unsigned v) { return __hip_atomic_fetch_add(p, v, __ATOMIC_RELAXED, __HIP_MEMORY_SCOPE_AGENT); }
__device__ __forceinline__ unsigned xb_xcc_id() { return (unsigned)__builtin_amdgcn_s_getreg((3 << 11) | 20) & 0xFu; }
#define XB_SPIN(cond, bar) do { unsigned _sp = 0; while (cond) { __builtin_amdgcn_s_sleep(1); \
    if ((++_sp & 255u) == 0u) { if (xb_ld(&(bar)[XB_TMO])) break; if (_sp > XB_SPIN_CAP) { atomicAdd(&(bar)[XB_TMO], 1u); break; } } } } while (0)

struct XcdBarrier {
    unsigned* bar; unsigned x;
    volatile LAS unsigned* st;
};

__device__ __forceinline__ XcdBarrier xcd_barrier_post(unsigned* bar, volatile LAS unsigned* st) {
    XcdBarrier b; b.bar = bar; b.x = xb_xcc_id(); b.st = st;
    if (threadIdx.x == 0) (void)xb_add(&bar[XB_XCNT(b.x)], 1u);
    return b;
}
__device__ __forceinline__ void xcd_barrier_complete(unsigned* bar, unsigned x, unsigned& nloc, unsigned& nx) {
    const unsigned G = gridDim.x * gridDim.y * gridDim.z;
    unsigned sum, cnt, mine, sp = 0u;
    for (;;) {
        sum = 0u; cnt = 0u; mine = 0u;
#pragma unroll
        for (unsigned j = 0; j < 16; ++j) { const unsigned c = xb_ld(&bar[XB_XCNT(j)]); sum += c; cnt += (c > 0u) ? 1u : 0u; mine = (j == x) ? c : mine; }
        if (sum == G) break;
        __builtin_amdgcn_s_sleep(1);
        if ((++sp & 255u) == 0u) { if (xb_ld(&bar[XB_TMO])) break; if (sp > XB_SPIN_CAP) { atomicAdd(&bar[XB_TMO], 1u); break; } }
    }
    nloc = mine > 0u ? mine : 1u; nx = cnt > 0u ? cnt : 1u;
}

__device__ __forceinline__ void xcd_barrier(const XcdBarrier& b) {
    asm volatile("s_waitcnt vmcnt(0)" ::: "memory");
    __syncthreads();
    if (threadIdx.x == 0) {
        unsigned* bar = b.bar;
        __builtin_amdgcn_s_waitcnt(0);
        unsigned nloc = b.st[0], nx = b.st[1];
        if (nloc == 0u) { xcd_barrier_complete(bar, b.x, nloc, nx); b.st[0] = nloc; b.st[1] = nx; }
        const unsigned old = xb_add(&bar[XB_XSUB(b.x)], 1u);
        const unsigned gen = old / nloc;
        if (old + 1u == (gen + 1u) * nloc) {
            __builtin_amdgcn_fence(__ATOMIC_RELEASE, "agent");
            asm volatile("s_waitcnt vmcnt(0)" ::: "memory");
            const unsigned og = xb_add(&bar[XB_TOP], 1u);
            const unsigned tg = og / nx;
            if (og + 1u == (tg + 1u) * nx) xb_add(&bar[XB_TOPGEN], 1u);
            else XB_SPIN(xb_ld(&bar[XB_TOPGEN]) == tg, bar);
            __builtin_amdgcn_fence(__ATOMIC_ACQUIRE, "agent");
            xb_add(&bar[XB_XGEN(b.x)], 1u);
            asm volatile("s_waitcnt vmcnt(0)" ::: "memory");
        } else {
            XB_SPIN(xb_ld(&bar[XB_XGEN(b.x)]) == gen, bar);
            __builtin_amdgcn_fence(__ATOMIC_ACQUIRE, "agent");
            asm volatile("s_waitcnt vmcnt(0)" ::: "memory");
        }
    }
    __syncthreads();
}

__global__ void __launch_bounds__(512, 2) fwd_kernel(Params p) {
    extern __shared__ __attribute__((aligned(16))) unsigned char lds[];
    cg::grid_group grid = cg::this_grid();
    Frame F;
    F.in = (InTab)__builtin_amdgcn_kernarg_segment_ptr(); F.out = p.out; F.ws = p.ws; F.lds = lds;
    F.tid = threadIdx.x; F.lane = threadIdx.x & 63; F.wid = __builtin_amdgcn_readfirstlane(threadIdx.x >> 6); F.nb = gridDim.x; F.bid = blockIdx.x; F.dry = 0; F.cb = blockIdx.x; F.cn = gridDim.x;
    volatile LAS unsigned* xst = (volatile LAS unsigned*)(lds + LDS_BYTES - 16);
    if (threadIdx.x == 0) { xst[0] = 0u; xst[1] = 0u; }
    __syncthreads();
    const XcdBarrier xbar = xcd_barrier_post((unsigned*)(p.ws + WS_BAR), xst);
    for (int ph = p.ph_lo; ph < p.ph_hi; ++ph) {
#ifndef PHM
#define PHM 0xffff
#endif
        if (ph == 0) { if (PHM & 0x1000) phase0(F); }
        else if (ph == NPH - 1) { if (PHM & 0x2000) final_norm(F); }
        else {
            const int l = (ph - 1) / 13, k = (ph - 1) % 13;
            int gk = -1;
            if (k == 2 && gridDim.x == 256) gk = GP_MEMKV;
            switch (k) { case 0: gk = GP_IN; break; case 3: gk = GP_OUT; break; case 4: gk = GP_OUT2; break; case 5: gk = GP_WO; break; case 6: gk = GP_MQ; break; case 7: gk = GP_ATTN; break; case 8: gk = GP_ATTN2; break;
                         case 9: gk = GP_MO; break; case 10: gk = GP_UP; break; case 12: gk = GP_DOWN; break; default: break; }
#ifndef REPMASK
#define REPMASK 0
#endif
            if (gk >= 0 && (PHM & 1)) { const int nrep = ((REPMASK >> k) & 1) ? 2 : 1; for (int rep = 0; rep < nrep; ++rep) gemm_phase(F, gk, l); }
            if (k == 0 && (PHM & 1)) small_proj(F);
            if (k == (gridDim.x == 256 ? 2 : 3) && (PHM & 8)) sample_kv(F, l);
            if (gridDim.x == 256 && k == 2 && l > 0 && blockIdx.x >= 128) { Frame G = F; G.cb = (int)blockIdx.x - 128; G.cn = 128; __syncthreads(); cvt_ffn(G, l); }
            if (gridDim.x == 256 && k == 10 && l < 3 && (blockIdx.x >> 3) >= 6) { Frame G = F; G.cb = (((int)blockIdx.x >> 3) - 6) * 8 + ((int)blockIdx.x & 7); G.cn = 208; __syncthreads(); cvt_mixer(G, l + 1); }
#ifndef DRYMASK
#define DRYMASK 0
#endif
            for (int dr = ((DRYMASK >> k) & 1); dr >= 0; --dr) {
            F.dry = dr;
            if (k == 1 && (PHM & 2)) {
                for (int it = F.bid; it < NCH * 8; it += F.nb) { const int c = it >> 3, h = it & 3; if (it & 4) g1_gla(F, l, c, h); else g1_gdn(F, l, c, h); }
                __syncthreads();
                if (l > 0 && !dr && F.nb != 256) cvt_ffn(F, l);
            }
            if (k == 2 && (PHM & 4)) {
                for (int it = F.bid; it < 192; it += F.nb) {
                    int s, h, br;
                    if (it < 128) { br = it & 1; h = (it >> 1) & 3; s = it >> 3; } else { const int v = it - 128; br = v & 1; h = (v >> 1) & 3; s = 16 + (v >> 3); }
                    if (br) g2_gla(F, l, s, h); else g2_gdn(F, l, s, h);
                    __syncthreads();
                }
            }
            if (k == 11 && (PHM & 0x200)) { ffn_mid(F, l); if (l < 3 && !dr && F.nb != 256) { __syncthreads(); cvt_mixer(F, l + 1); } }
            }
            F.dry = 0;
        }
#ifndef SYNCREP
#define SYNCREP 1
#endif
        if (ph + 1 < p.ph_hi) {
            if (ph == 0) grid.sync();
            else xcd_barrier(xbar);
        }
    }
#ifdef DBG_COL
    __threadfence(); grid.sync(); __threadfence();
    dbg_dump(F);
#endif
}

extern "C" void kernel_launch(void* const* d_in, const int* in_sizes, int n_in, void* d_out, int out_size, void* d_ws, size_t ws_size, hipStream_t stream) {
    static int grid_blocks = 0;
    if (grid_blocks == 0) {
        if (n_in != 33 || ws_size < WS_TOTAL) { fprintf(stderr, "kernel_launch: bad n_in %d or ws %zu < %zu\n", n_in, ws_size, (size_t)WS_TOTAL); grid_blocks = -1; return; }
        int dev = 0, cus = 0, per_cu = 0;
        hipGetDevice(&dev);
        hipDeviceGetAttribute(&cus, hipDeviceAttributeMultiprocessorCount, dev);
        if (hipFuncSetAttribute((const void*)fwd_kernel, hipFuncAttributeMaxDynamicSharedMemorySize, LDS_BYTES) != hipSuccess) { fprintf(stderr, "hipFuncSetAttribute failed\n"); grid_blocks = -1; return; }
        hipOccupancyMaxActiveBlocksPerMultiprocessor(&per_cu, (const void*)fwd_kernel, 512, LDS_BYTES);
        if (per_cu < 1) per_cu = 1;
        (void)hipGetLastError();
        grid_blocks = cus * 1;
        if (grid_blocks <= 0) grid_blocks = 256;
    }
    if (grid_blocks < 0) return;
    Params p{};
    for (int i = 0; i < 33; ++i) p.in[i] = (const float*)d_in[i];
    p.out = (float*)d_out; p.ws = (unsigned char*)d_ws; p.ph_lo = 0; p.ph_hi = PH_HI;
    (void)hipMemsetAsync((unsigned char*)d_ws + WS_BAR, 0, 16384, stream);
    void* args[] = {&p};
    hipError_t e = hipLaunchCooperativeKernel((const void*)fwd_kernel, dim3(grid_blocks), dim3(512), args, LDS_BYTES, stream);
    if (e != hipSuccess) fprintf(stderr, "cooperative launch failed: %s (grid %d)\n", hipGetErrorString(e), grid_blocks);
}
```

```cpp
#include <hip/hip_runtime.h>
#include <hip/hip_cooperative_groups.h>
#include <cstdint>
#include <cstdio>
namespace cg = cooperative_groups;

typedef unsigned short bf16_t;
typedef short bf16x8 __attribute__((ext_vector_type(8)));
typedef float f32x4 __attribute__((ext_vector_type(4)));
typedef float f32x2 __attribute__((ext_vector_type(2)));
typedef unsigned u32x2 __attribute__((ext_vector_type(2)));
typedef unsigned u32x4 __attribute__((ext_vector_type(4)));
#define DEV __device__ __forceinline__

constexpr int DM = 1024, TT = 33280, NCH = 520, LDP = 5632, LDE = 768;
constexpr int C_QA = 0, C_KA = 512, C_VA = 1024, C_ZA = 1536, C_QB = 2048, C_KB = 2304, C_VB = 2560, C_ZB = 3072, C_GA = 3584, C_GB = 4608;
constexpr int C_MRG = 0, C_PR = 1024, C_Q = 2048, C_O = 3072;
constexpr size_t O_Y = 0;
constexpr size_t O_GDN_P = 34078720ull;
constexpr size_t O_GDNC_P = O_GDN_P + 4194304ull;
constexpr size_t O_GLA_P = O_GDNC_P + 294912ull;
constexpr size_t O_FFNC_P = O_GLA_P + 2097152ull;
constexpr size_t O_MEMK = O_FFNC_P + 720896ull;
constexpr size_t O_MEMV = O_MEMK + 16777216ull;
constexpr size_t O_GDN_S = O_MEMV + 16777216ull;
constexpr size_t O_GDNC_S = O_GDN_S + 2097152ull;
constexpr size_t O_GLA_S = O_GDNC_S + 147456ull;
constexpr size_t O_FFNC_S = O_GLA_S + 1048576ull;
constexpr size_t al256(size_t x) { return (x + 255) & ~(size_t)255; }
constexpr size_t WS_WMIX = 0;
constexpr size_t WM_WIN = 0, WM_WSM = WM_WIN + 5632ull * 1024, WM_WOA = WM_WSM + 32 * 1024, WM_WOB = WM_WOA + 524288, WM_WO = WM_WOB + 524288,
                 WM_WMQ = WM_WO + 1048576, WM_WMK = WM_WMQ + 1048576, WM_WMV = WM_WMK + 1048576, WM_WMO = WM_WMV + 1048576, WM_END = WM_WMO + 1048576;
constexpr size_t WS_WFFN = al256(WS_WMIX + WM_END * 2);
constexpr size_t WF_UP = 0, WF_DN = 5632ull * 1024, WF_END = WF_DN + 1024ull * 2816;
constexpr size_t WS_XB = al256(WS_WFFN + WF_END * 2);
constexpr size_t WS_P = al256(WS_XB + (size_t)TT * 1024 * 2);
constexpr size_t WS_KV = al256(WS_P + (size_t)TT * LDP * 2);
constexpr size_t KV_BYTES = 2ull * 6144 * 1024 * 2;
constexpr size_t WS_MB = al256(WS_KV + KV_BYTES);
constexpr size_t WS_MRS = al256(WS_MB + 4096ull * 1024 * 2);
constexpr size_t WS_SSQ = al256(WS_MRS + 4096 * 4);
constexpr size_t WS_SC = al256(WS_SSQ + (size_t)TT * 16 * 4);
constexpr size_t WS_DL = al256(WS_SC + (size_t)TT * 32 * 4);
constexpr size_t WS_BG = al256(WS_DL + 520ull * 4 * 64 * 4);
constexpr size_t WS_BAR = al256(WS_BG + 520ull * 4 * 128 * 4);
constexpr size_t WS_TOTAL = al256(WS_BAR + 16384);
constexpr int LDS_BYTES = 147456;
constexpr int NPH = 54;
#ifndef PH_HI
#define PH_HI NPH
#define REPMASK 0
#define SYNCREP 1
#define DRYMASK 0
#endif

struct Params { const float* in[33]; float* out; unsigned char* ws; int ph_lo, ph_hi; };

typedef __bf16 bf16x2_t __attribute__((ext_vector_type(2)));
DEV unsigned pk2(float lo, float hi) { f32x2 f = {lo, hi}; bf16x2_t v = __builtin_convertvector(f, bf16x2_t); return __builtin_bit_cast(unsigned, v); }
DEV float bf2f(bf16_t b) { return __uint_as_float(((unsigned)b) << 16); }
DEV float bflo(unsigned u) { return __uint_as_float(u << 16); }
DEV float bfhi(unsigned u) { return __uint_as_float(u & 0xffff0000u); }
DEV u32x2 pk4(f32x4 v) { u32x2 r; r.x = pk2(v[0], v[1]); r.y = pk2(v[2], v[3]); return r; }
DEV f32x4 unpk4(u32x2 u) { return (f32x4){bflo(u.x), bfhi(u.x), bflo(u.y), bfhi(u.y)}; }
DEV bf16x8 mk8(u32x2 a, u32x2 b) { u32x4 t = {a.x, a.y, b.x, b.y}; return __builtin_bit_cast(bf16x8, t); }
DEV float sigm(float x) { return 1.f / (1.f + __expf(-x)); }
DEV float silu(float x) { return x / (1.f + __expf(-x)); }
DEV float softplus(float x) { return x > 20.f ? x : __logf(1.f + __expf(x)); }
DEV float logsigmoid(float x) { return fminf(x, 0.f) - __logf(1.f + __expf(-fabsf(x))); }
DEV float row_rstd(const float* ssq, int row) {
    const f32x4 a = *(const f32x4*)(ssq + (size_t)row * 4), b = *(const f32x4*)(ssq + ((size_t)TT + row) * 4);
    const f32x4 c = *(const f32x4*)(ssq + ((size_t)2 * TT + row) * 4), d = *(const f32x4*)(ssq + ((size_t)3 * TT + row) * 4);
    float s = ((a[0] + a[1]) + (a[2] + a[3])) + ((b[0] + b[1]) + (b[2] + b[3])) + ((c[0] + c[1]) + (c[2] + c[3])) + ((d[0] + d[1]) + (d[2] + d[3]));
    return rsqrtf(s * (1.f / 1024.f) + 1e-6f);
}
DEV bf16x8 ldfragp(const bf16_t* base, int row, int stride, int k0, int fq) {
    const bf16_t* p = base + row * stride + k0 + 4 * fq;
    return mk8(*(const u32x2*)p, *(const u32x2*)(p + 16));
}
DEV bf16x8 ldfrag(const bf16_t* base, int row, int stride, int k0, int fq) {
    return *(const bf16x8*)(base + row * stride + k0 + 8 * fq);
}
#define MFMA16(a, b, c) __builtin_amdgcn_mfma_f32_16x16x32_bf16((a), (b), (c), 0, 0, 0)

constexpr int BM = 256, BK = 64, HALF = 128, HT = HALF * BK;
DEV int lds_byte(int r, int c) { int st = (r >> 4) * 2 + (c >> 5), rr = r & 15, cc = c & 31, ob = rr * 64 + cc * 2; return st * 1024 + (ob ^ (((ob >> 9) & 1) << 5)); }
DEV void stage_rc(int b, int& R, int& C) { int st = b / 1024, sb = b % 1024, swz = sb ^ (((sb >> 9) & 1) << 5); R = (st >> 1) * 16 + swz / 64; C = (st & 1) * 32 + (swz % 64) / 2; }

DEV void gemm_core(const bf16_t* __restrict__ A, int lda, const bf16_t* __restrict__ Bt, int ldb, int K, int brow, int bcol, f32x4 (&acc)[2][2][4][2], bf16_t* shm) {
#define SA(b, h) (shm + ((b) * 2 + (h)) * HT)
#define SB(b, h) (shm + (4 + (b) * 2 + (h)) * HT)
#define STAGE(P, BASE, LD, br, kt) do { const char* _gb = (const char*)((BASE) + (long)(br) * (LD) + (long)(kt) * BK); \
    const unsigned _vo = (unsigned)((sr0 * (int)(LD) + sc0) * 2); \
    for (int _i = 0; _i < 2; ++_i) { \
      __builtin_amdgcn_global_load_lds((const unsigned*)(_gb + (long)(_i * 128) * (LD) + _vo), (unsigned*)((char*)(P) + wbase + _i * 8192), 16, 0, 0); } } while (0)
#define LDA(dst, b, h) for (int m = 0; m < 4; ++m) for (int k = 0; k < 2; ++k) \
    dst[m][k] = *reinterpret_cast<const bf16x8*>((char*)SA(b, h) + lds_byte(wr * 64 + m * 16 + fr, k * 32 + fq * 8))
#define LDB(dst, b, h) for (int n = 0; n < 2; ++n) for (int k = 0; k < 2; ++k) \
    dst[n][k] = *reinterpret_cast<const bf16x8*>((char*)SB(b, h) + lds_byte(wc * 32 + n * 16 + fr, k * 32 + fq * 8))
#define MMA(ai, bj, At_, Bt_) do { __builtin_amdgcn_s_setprio(1); \
    for (int m = 0; m < 4; ++m) for (int n = 0; n < 2; ++n) for (int k = 0; k < 2; ++k) \
      acc[ai][bj][m][n] = __builtin_amdgcn_mfma_f32_16x16x32_bf16(Bt_[n][k], At_[m][k], acc[ai][bj][m][n], 0, 0, 0); \
    __builtin_amdgcn_s_setprio(0); } while (0)
#define WAIT_V(n) asm volatile("s_waitcnt vmcnt(" #n ")" ::: "memory")
#define WAIT_L(n) asm volatile("s_waitcnt lgkmcnt(" #n ")" ::: "memory")
#define BAR __builtin_amdgcn_s_barrier()
#define SCHED __builtin_amdgcn_sched_barrier(0)
    int tidx = threadIdx.x; asm volatile("" : "+v"(tidx));
    const int wid = __builtin_amdgcn_readfirstlane(tidx >> 6), lane = tidx & 63, wr = wid >> 2, wc = wid & 3, fr = lane & 15, fq = lane >> 4;
    const int wbase = wid * 1024;
    int sr0, sc0; stage_rc(tidx * 16, sr0, sc0);
#pragma unroll
    for (int a = 0; a < 2; ++a)
#pragma unroll
        for (int b = 0; b < 2; ++b)
#pragma unroll
            for (int m = 0; m < 4; ++m)
#pragma unroll
                for (int n = 0; n < 2; ++n) acc[a][b][m][n] = (f32x4){0.f, 0.f, 0.f, 0.f};
    bf16x8 At[4][2], B0[2][2], B1[2][2];
    const int nt = K / BK;
    STAGE(SB(0, 0), Bt, ldb, bcol, 0); STAGE(SA(0, 0), A, lda, brow, 0);
    STAGE(SB(0, 1), Bt, ldb, bcol + HALF, 0); STAGE(SA(0, 1), A, lda, brow + HALF, 0);
    if (wr == 1) BAR;
    WAIT_V(4); BAR;
    STAGE(SB(1, 0), Bt, ldb, bcol, 1); STAGE(SA(1, 0), A, lda, brow, 1); STAGE(SB(1, 1), Bt, ldb, bcol + HALF, 1);
    WAIT_V(6); BAR;
    for (int t = 0; t < nt - 2; t += 2) {
        LDB(B0, 0, 0); SCHED; LDA(At, 0, 0); STAGE(SA(1, 1), A, lda, brow + HALF, t + 1);
        WAIT_L(8); BAR; WAIT_L(0); MMA(0, 0, At, B0); BAR; SCHED;
        LDB(B1, 0, 1); STAGE(SB(0, 0), Bt, ldb, bcol, t + 2);
        BAR; WAIT_L(0); MMA(0, 1, At, B1); BAR;
        LDA(At, 0, 1); STAGE(SA(0, 0), A, lda, brow, t + 2);
        BAR; WAIT_L(0); MMA(1, 0, At, B0); BAR; SCHED;
        STAGE(SB(0, 1), Bt, ldb, bcol + HALF, t + 2);
        WAIT_V(6); BAR; MMA(1, 1, At, B1); BAR;
        LDB(B0, 1, 0); SCHED; LDA(At, 1, 0); STAGE(SA(0, 1), A, lda, brow + HALF, t + 2);
        WAIT_L(8); BAR; WAIT_L(0); MMA(0, 0, At, B0); BAR; SCHED;
        LDB(B1, 1, 1); STAGE(SB(1, 0), Bt, ldb, bcol, t + 3);
        BAR; WAIT_L(0); MMA(0, 1, At, B1); BAR;
        LDA(At, 1, 1); STAGE(SA(1, 0), A, lda, brow, t + 3);
        BAR; WAIT_L(0); MMA(1, 0, At, B0); BAR; SCHED;
        STAGE(SB(1, 1), Bt, ldb, bcol + HALF, t + 3);
        WAIT_V(6); BAR; MMA(1, 1, At, B1); BAR;
    }
    { LDB(B0, 0, 0); LDA(At, 0, 0); STAGE(SA(1, 1), A, lda, brow + HALF, nt - 1);
      BAR; WAIT_L(0); MMA(0, 0, At, B0); BAR;
      LDB(B1, 0, 1); BAR; WAIT_L(0); MMA(0, 1, At, B1); BAR;
      LDA(At, 0, 1); WAIT_V(4); BAR; WAIT_L(0); MMA(1, 0, At, B0); MMA(1, 1, At, B1); BAR; }
    { LDB(B0, 1, 0); LDA(At, 1, 0); WAIT_V(2); BAR; WAIT_L(0); MMA(0, 0, At, B0); BAR;
      LDB(B1, 1, 1); WAIT_V(0); BAR; WAIT_L(0); MMA(0, 1, At, B1); BAR;
      LDA(At, 1, 1); BAR; WAIT_L(0); MMA(1, 0, At, B0); MMA(1, 1, At, B1); BAR; }
    if (wr == 0) BAR;
    SCHED;
#undef SA
#undef SB
}

typedef const float* const __attribute__((address_space(4)))* InTab;
struct Frame {
    InTab in; float* out; unsigned char* ws; unsigned char* lds;
    int tid, lane, wid, nb, bid, dry, cb, cn;
};
#define REFRAME Frame F = F0; { int t_ = threadIdx.x; asm volatile("" : "+v"(t_)); F.tid = t_; F.lane = t_ & 63; unsigned char* w_ = F.ws; asm volatile("" : "+s"(w_)); F.ws = w_; float* o_ = F.out; asm volatile("" : "+s"(o_)); F.out = o_; InTab i_ = (InTab)__builtin_amdgcn_kernarg_segment_ptr(); asm volatile("" : "+s"(i_)); F.in = i_; int a_ = F.wid, b_ = F.bid, c_ = F.nb; asm volatile("" : "+s"(a_), "+s"(b_), "+s"(c_)); F.wid = a_; F.bid = b_; F.nb = c_; }

enum { EPI_PROJ = 0, EPI_UP, EPI_RESID, EPI_Q, EPI_MEMK, EPI_MEMV, EPI_OUTA, EPI_OUTB, EPI_SOFTMAX, EPI_ATTNO };
struct GDesc { const bf16_t* A; int lda; const bf16_t* Bt; int ldb; int K, brow, bcol, epi, orow, ocol, head, vai, vwr; };

DEV void cvt_mat(const Frame& F0, const float* src, int ldsrc, int K, int N, int wincols, const float* gain, bf16_t* dst) {
    REFRAME;
    float* T = (float*)F.lds;
    const int nkt = K / 64, nnt = N / 64, ntile = nkt * nnt;
    for (int t = F.cb; t < ntile; t += F.cn) {
        const int kt = t / nnt, ntl = t % nnt, k0 = kt * 64, n0 = ntl * 64;
        int coff = 0; if (wincols == 1) coff = (n0 < 1536) ? 0 : (n0 < 3072 ? 8 : 24);
        if (wincols == 2) { const int tl = n0 >> 8, w = n0 & 255; coff = (w < 128 ? 128 * tl + w : 2816 + 128 * tl + (w - 128)) - n0; }
        __syncthreads();
#pragma unroll
        for (int i = 0; i < 2; ++i) {
            const int kr = (F.tid >> 4) + 32 * i, nc = (F.tid & 15) * 4;
            f32x4 v = *(const f32x4*)(src + (size_t)(k0 + kr) * ldsrc + n0 + coff + nc);
            const float g = gain ? gain[k0 + kr] : 1.f;
            T[kr * 65 + nc + 0] = v[0] * g; T[kr * 65 + nc + 1] = v[1] * g; T[kr * 65 + nc + 2] = v[2] * g; T[kr * 65 + nc + 3] = v[3] * g;
        }
        __syncthreads();
        const int n = F.tid >> 3, kc = (F.tid & 7) * 8;
        u32x4 w;
        w.x = pk2(T[(kc + 0) * 65 + n], T[(kc + 1) * 65 + n]); w.y = pk2(T[(kc + 2) * 65 + n], T[(kc + 3) * 65 + n]);
        w.z = pk2(T[(kc + 4) * 65 + n], T[(kc + 5) * 65 + n]); w.w = pk2(T[(kc + 6) * 65 + n], T[(kc + 7) * 65 + n]);
        *(u32x4*)(dst + (size_t)(n0 + n) * K + k0 + kc) = w;
    }
    __syncthreads();
}
DEV void cvt_mixer(const Frame& F0, int l) {
    REFRAME;
    InTab in = F.in;
    cvt_mat(F, in[10] + (size_t)l * 1024 * 5656, 5656, 1024, 5632, 1, in[9] + l * 1024, ((bf16_t*)(F.ws + WS_WMIX)) + WM_WIN);
    cvt_mat(F, in[18] + (size_t)l * 512 * 1024, 1024, 512, 1024, 0, nullptr, ((bf16_t*)(F.ws + WS_WMIX)) + WM_WOA);
    cvt_mat(F, in[19] + (size_t)l * 512 * 1024, 1024, 512, 1024, 0, nullptr, ((bf16_t*)(F.ws + WS_WMIX)) + WM_WOB);
    cvt_mat(F, in[20] + (size_t)l * 1048576, 1024, 1024, 1024, 0, nullptr, ((bf16_t*)(F.ws + WS_WMIX)) + WM_WO);
    cvt_mat(F, in[23] + (size_t)l * 1048576, 1024, 1024, 1024, 0, in[21] + l * 1024, ((bf16_t*)(F.ws + WS_WMIX)) + WM_WMQ);
    cvt_mat(F, in[24] + (size_t)l * 1048576, 1024, 1024, 1024, 0, in[22] + l * 1024, ((bf16_t*)(F.ws + WS_WMIX)) + WM_WMK);
    cvt_mat(F, in[25] + (size_t)l * 1048576, 1024, 1024, 1024, 0, in[22] + l * 1024, ((bf16_t*)(F.ws + WS_WMIX)) + WM_WMV);
    cvt_mat(F, in[26] + (size_t)l * 1048576, 1024, 1024, 1024, 0, nullptr, ((bf16_t*)(F.ws + WS_WMIX)) + WM_WMO);
    const float* win = in[10] + (size_t)l * 1024 * 5656; const float* g = in[9] + l * 1024;
    for (int i = F.cb * 512 + F.tid; i < 32 * 1024; i += F.cn * 512) {
        const int n = i >> 10, k = i & 1023;
        float v = 0.f;
        if (n < 8) v = win[(size_t)k * 5656 + 1536 + n] * g[k]; else if (n < 24) v = win[(size_t)k * 5656 + 3080 + (n - 8)] * g[k];
        ((bf16_t*)(F.ws + WS_WMIX))[WM_WSM + i] = (bf16_t)(pk2(v, 0.f) & 0xffff);
    }
}
DEV void cvt_ffn(const Frame& F, int l) {
    cvt_mat(F, F.in[28] + (size_t)l * 1024 * 5632, 5632, 1024, 5632, 2, F.in[27] + l * 1024, ((bf16_t*)(F.ws + WS_WFFN)) + WF_UP);
    cvt_mat(F, F.in[31] + (size_t)l * 2816 * 1024, 1024, 2816, 1024, 0, nullptr, ((bf16_t*)(F.ws + WS_WFFN)) + WF_DN);
}

DEV void phase0(const Frame& F0) {
    REFRAME;
    const int gw = F.bid * 8 + F.wid, nw = F.nb * 8, lane = F.lane;
    for (int row = gw; row < TT + 4096; row += nw) {
        const bool ismem = row >= TT;
        const float* src = ismem ? F.in[8] + (size_t)(row - TT) * 1024 : (row < 32768 ? F.in[0] + (size_t)row * 1024 : F.in[1] + (size_t)(row - 32768) * 1024);
        f32x4 v[4]; float s = 0.f;
#pragma unroll
        for (int i = 0; i < 4; ++i) { v[i] = *(const f32x4*)(src + lane * 16 + i * 4); s += v[i][0] * v[i][0] + v[i][1] * v[i][1] + v[i][2] * v[i][2] + v[i][3] * v[i][3]; }
        u32x4 w0, w1;
        w0.x = pk2(v[0][0], v[0][1]); w0.y = pk2(v[0][2], v[0][3]); w0.z = pk2(v[1][0], v[1][1]); w0.w = pk2(v[1][2], v[1][3]);
        w1.x = pk2(v[2][0], v[2][1]); w1.y = pk2(v[2][2], v[2][3]); w1.z = pk2(v[3][0], v[3][1]); w1.w = pk2(v[3][2], v[3][3]);
        s += __shfl_xor(s, 1); s += __shfl_xor(s, 2);
        if (!ismem) {
            float* X = F.out + (size_t)row * 1024 + lane * 16;
#pragma unroll
            for (int i = 0; i < 4; ++i) *(f32x4*)(X + i * 4) = v[i];
            bf16_t* xb = ((bf16_t*)(F.ws + WS_XB)) + (size_t)row * 1024 + lane * 16;
            *(u32x4*)xb = w0; *(u32x4*)(xb + 8) = w1;
            if ((lane & 3) == 0) ((float*)(F.ws + WS_SSQ))[((size_t)(lane >> 4) * TT + row) * 4 + ((lane >> 2) & 3)] = s;
        } else {
            const int mr = row - TT;
            bf16_t* mb = ((bf16_t*)(F.ws + WS_MB)) + (size_t)mr * 1024 + lane * 16;
            *(u32x4*)mb = w0; *(u32x4*)(mb + 8) = w1;
            s += __shfl_xor(s, 4); s += __shfl_xor(s, 8); s += __shfl_xor(s, 16); s += __shfl_xor(s, 32);
            if (lane == 0) ((float*)(F.ws + WS_MRS))[mr] = rsqrtf(s * (1.f / 1024.f) + 1e-6f);
        }
    }
    cvt_mixer(F, 0);
    cvt_ffn(F, 0);
}

DEV void small_proj(const Frame& F0) {
    REFRAME;
    const int lane = F.lane, fr = lane & 15, fq = lane >> 4, mt = F.wid & 3, nt = F.wid >> 2;
    const bool part = F.nb == 256;
    if (part && (F.bid >> 3) < 6) return;
    for (int c = part ? ((F.bid >> 3) - 6) * 8 + (F.bid & 7) : F.bid; c < NCH; c += part ? 208 : F.nb) {
        const int row = c * 64 + mt * 16 + fr;
        const bf16_t* a = ((bf16_t*)(F.ws + WS_XB)) + (size_t)row * 1024 + 8 * fq;
        const bf16_t* b = ((bf16_t*)(F.ws + WS_WMIX)) + WM_WSM + (size_t)(nt * 16 + fr) * 1024 + 8 * fq;
        f32x4 acc = {0.f, 0.f, 0.f, 0.f};
#pragma unroll 4
        for (int k = 0; k < 32; ++k) acc = MFMA16(*(const bf16x8*)(b + k * 32), *(const bf16x8*)(a + k * 32), acc);
        const float rs = row_rstd(((float*)(F.ws + WS_SSQ)), row);
        *(f32x4*)(((float*)(F.ws + WS_SC)) + (size_t)row * 32 + nt * 16 + 4 * fq) = acc * rs;
    }
}

DEV void gemm_epilogue(const Frame& F0, const GDesc& d, int l, f32x4 (&acc)[2][2][4][2]) {
    REFRAME;
    int lane_ = F.lane; asm volatile("" : "+v"(lane_));
    const int wr = F.wid >> 2, wc = F.wid & 3, fr = lane_ & 15, fq = lane_ >> 4;
    float* red = (float*)(F.lds + 131072);
    if (d.epi == EPI_SOFTMAX) {
        float mx[2][4];
#pragma unroll
        for (int ai = 0; ai < 2; ++ai)
#pragma unroll
            for (int m = 0; m < 4; ++m) {
                float v = -3.0e38f;
#pragma unroll
                for (int bj = 0; bj < 2; ++bj)
#pragma unroll
                    for (int n = 0; n < 2; ++n) { const f32x4 x = acc[ai][bj][m][n]; v = fmaxf(v, fmaxf(fmaxf(x[0], x[1]), fmaxf(x[2], x[3]))); }
                v = fmaxf(v, __shfl_xor(v, 16)); v = fmaxf(v, __shfl_xor(v, 32));
                if (fq == 0) red[(ai * 128 + wr * 64 + m * 16 + fr) * 4 + wc] = v;
            }
        __syncthreads();
#pragma unroll
        for (int ai = 0; ai < 2; ++ai)
#pragma unroll
            for (int m = 0; m < 4; ++m) {
                const f32x4 r4 = *(const f32x4*)(red + (ai * 128 + wr * 64 + m * 16 + fr) * 4);
                const float rm = fmaxf(fmaxf(r4[0], r4[1]), fmaxf(r4[2], r4[3]));
                mx[ai][m] = rm; float s = 0.f;
#pragma unroll
                for (int bj = 0; bj < 2; ++bj)
#pragma unroll
                    for (int n = 0; n < 2; ++n) { f32x4 x = acc[ai][bj][m][n];
#pragma unroll
                        for (int j = 0; j < 4; ++j) { x[j] = __expf(x[j] - rm); s += x[j]; }
                        acc[ai][bj][m][n] = x; }
                s += __shfl_xor(s, 16); s += __shfl_xor(s, 32);
                if (fq == 0) red[1024 + (ai * 128 + wr * 64 + m * 16 + fr) * 4 + wc] = s;
            }
        (void)mx;
        __syncthreads();
#pragma unroll
        for (int ai = 0; ai < 2; ++ai)
#pragma unroll
            for (int m = 0; m < 4; ++m) {
                const f32x4 r4 = *(const f32x4*)(red + 1024 + (ai * 128 + wr * 64 + m * 16 + fr) * 4);
                const float inv = 1.f / ((r4[0] + r4[1]) + (r4[2] + r4[3]));
                const bool valid = d.vai < 0 || (d.vai == ai && d.vwr == wr);
                const int row = d.orow + ai * 128 + wr * 64 + m * 16 + fr;
                if (valid) {
#pragma unroll
                    for (int bj = 0; bj < 2; ++bj)
#pragma unroll
                        for (int n = 0; n < 2; ++n) {
                            const int col = bj * 128 + wc * 32 + n * 16 + fq * 4;
                            *(u32x2*)(((bf16_t*)(F.ws + WS_P)) + (size_t)row * LDP + C_PR + d.head * 256 + col) = pk4(acc[ai][bj][m][n] * inv);
                        }
                }
            }
        __syncthreads();
        return;
    }
#pragma unroll
    for (int ai = 0; ai < 2; ++ai)
#pragma unroll
        for (int m = 0; m < 4; ++m) {
            const int row = d.orow + ai * 128 + wr * 64 + m * 16 + fr;
            float rs = 1.f, ss = 0.f;
            if (d.epi == EPI_PROJ || d.epi == EPI_UP || d.epi == EPI_Q) rs = row_rstd(((float*)(F.ws + WS_SSQ)), row);
            if (d.epi == EPI_Q) rs *= 0.0625f;
            if (d.epi == EPI_MEMK) rs = ((float*)(F.ws + WS_MRS))[row];
#pragma unroll
            for (int bj = 0; bj < 2; ++bj)
#pragma unroll
                for (int n = 0; n < 2; ++n) {
                    const int col = d.ocol + bj * 128 + wc * 32 + n * 16 + fq * 4;
                    f32x4 v = acc[ai][bj][m][n];
                    switch (d.epi) {
                    case EPI_UP: {
                        const int row_l = ai * 128 + wr * 64 + m * 16 + fr, cl = bj * 128 + wc * 32 + n * 16 + fq * 4;
                        *(u32x2*)((bf16_t*)F.lds + row_l * 264 + cl) = pk4(v * rs);
                    } break;
                    case EPI_PROJ: {
                        v = v * rs; const u32x2 w = pk4(v);
                        *(u32x2*)(((bf16_t*)(F.ws + WS_P)) + (size_t)row * LDP + col) = w;
                        if (m == 3 && fr >= 13 && col < 1536) {
                            const int chunk = row >> 6, hr = fr - 13;
                            *(u32x2*)(((bf16_t*)(F.ws + WS_KV)) + ((size_t)chunk * 3 + hr) * 1536 + col) = w;
                            if (chunk >= 512 || (chunk & 31) == 31) {
                                float* o = chunk < 512 ? F.out + O_GDNC_P + ((size_t)(l * 16 + (chunk >> 5)) * 3 + hr) * 1536 + col
                                                       : F.out + O_GDNC_S + ((size_t)(l * 8 + (chunk - 512)) * 3 + hr) * 1536 + col;
                                *(f32x4*)o = v;
                            }
                        }
                    } break;
                    case EPI_RESID: {
                        float* X = F.out + (size_t)row * 1024 + col;
                        f32x4 x = *(const f32x4*)X; x = x + v; *(f32x4*)X = x;
                        *(u32x2*)(((bf16_t*)(F.ws + WS_XB)) + (size_t)row * 1024 + col) = pk4(x);
                        ss += (x[0] * x[0] + x[1] * x[1]) + (x[2] * x[2] + x[3] * x[3]);
                    } break;
                    case EPI_Q: *(u32x2*)(((bf16_t*)(F.ws + WS_P)) + (size_t)row * LDP + C_Q + col) = pk4(v * rs); break;
                    case EPI_MEMK: {
                        v = v * rs;
                        *(f32x4*)(F.out + O_MEMK + ((size_t)l * 4096 + row) * 1024 + col) = v;
                        *(u32x2*)(((bf16_t*)(F.ws + WS_KV)) + (size_t)row * 1024 + col) = pk4(v);
                    } break;
                    case EPI_MEMV: {
                        const f32x4 r4 = *(const f32x4*)(((float*)(F.ws + WS_MRS)) + col);
                        v = v * r4;
                        float* o = F.out + O_MEMV + ((size_t)l * 4096 + col) * 1024 + row;
                        o[0] = v[0]; o[1024] = v[1]; o[2048] = v[2]; o[3072] = v[3];
                        const int b = col >> 8, h = row >> 8;
                        *(u32x2*)(((bf16_t*)(F.ws + WS_KV + 6144ull * 1024 * 2)) + ((size_t)(b * 4 + h) * 256 + (row & 255)) * 256 + (col & 255)) = pk4(v);
                    } break;
                    case EPI_OUTA: {
                        const f32x4 g = unpk4(*(const u32x2*)(((bf16_t*)(F.ws + WS_P)) + (size_t)row * LDP + C_GA + col));
                        f32x4 o; for (int j = 0; j < 4; ++j) o[j] = sigm(g[j]) * v[j];
                        *(u32x2*)(((bf16_t*)(F.ws + WS_P)) + (size_t)row * LDP + C_MRG + col) = pk4(o);
                    } break;
                    case EPI_OUTB: {
                        const f32x4 g = unpk4(*(const u32x2*)(((bf16_t*)(F.ws + WS_P)) + (size_t)row * LDP + C_GB + col));
                        f32x4 o = unpk4(*(const u32x2*)(((bf16_t*)(F.ws + WS_P)) + (size_t)row * LDP + C_MRG + col));
                        for (int j = 0; j < 4; ++j) o[j] += sigm(g[j]) * v[j];
                        *(u32x2*)(((bf16_t*)(F.ws + WS_P)) + (size_t)row * LDP + C_MRG + col) = pk4(o);
                    } break;
                    case EPI_ATTNO: {
                        const bool valid = d.vai < 0 || (d.vai == ai && d.vwr == wr);
                        if (valid) *(u32x2*)(((bf16_t*)(F.ws + WS_P)) + (size_t)row * LDP + C_O + d.head * 256 + col) = pk4(v);
                    } break;
                    default: break;
                    }
                }
            if (d.epi == EPI_RESID) {
                ss += __shfl_xor(ss, 16); ss += __shfl_xor(ss, 32);
                if (fq == 0) ((float*)(F.ws + WS_SSQ))[((size_t)(d.ocol >> 8) * TT + row) * 4 + wc] = ss;
            }
        }
    if (d.epi == EPI_UP) {
        bf16_t* ST = (bf16_t*)F.lds;
        const int pm = d.brow >> 8, pn = d.bcol >> 8;
        const bool samp = pm >= 128, needfix = !samp && (pm & 7) != 0;
        bf16_t* halo = ((bf16_t*)(F.ws + WS_KV)); bf16_t* raw01 = ((bf16_t*)(F.ws + WS_KV + 11714560ull));
        __syncthreads();
        {
            const int hsel = F.tid >> 6, cl4 = (F.tid & 63) * 4, ocol = ((cl4 >> 7) ? 2816 : 0) + 128 * pn + (cl4 & 127);
            const int row_l = (hsel >> 1) * 64 + 62 + (hsel & 1), chunk = (d.brow + row_l) >> 6, hr = hsel & 1;
            const u32x2 w = *(const u32x2*)(ST + row_l * 264 + cl4);
            *(u32x2*)(halo + ((size_t)chunk * 2 + hr) * 5632 + ocol) = w;
            if (chunk >= 512 || (chunk & 31) == 31) {
                float* o = chunk < 512 ? F.out + O_FFNC_P + ((size_t)(l * 16 + (chunk >> 5)) * 2 + hr) * 5632 + ocol
                                       : F.out + O_FFNC_S + ((size_t)(l * 8 + (chunk - 512)) * 2 + hr) * 5632 + ocol;
                *(f32x4*)o = unpk4(w);
            }
            if (needfix && hsel < 2) *(u32x2*)(raw01 + ((size_t)pm * 2 + hsel) * 5632 + ocol) = *(const u32x2*)(ST + hsel * 264 + cl4);
        }
        {
            const int cq = F.tid & 31, rg = F.tid >> 5, c4 = cq * 4, gcol = 128 * pn + c4, r0 = rg * 16;
            const float* cw = F.in[29] + (size_t)l * 3 * 5632; const float* cb = F.in[30] + (size_t)l * 5632;
            const f32x4 wg0 = *(const f32x4*)(cw + gcol), wg1 = *(const f32x4*)(cw + 5632 + gcol), wg2 = *(const f32x4*)(cw + 2 * 5632 + gcol), bg = *(const f32x4*)(cb + gcol);
            const f32x4 wv0 = *(const f32x4*)(cw + 2816 + gcol), wv1 = *(const f32x4*)(cw + 5632 + 2816 + gcol), wv2 = *(const f32x4*)(cw + 2 * 5632 + 2816 + gcol), bv = *(const f32x4*)(cb + 2816 + gcol);
            f32x4 g2 = {0.f, 0.f, 0.f, 0.f}, g1 = g2, v2 = g2, v1 = g2; bool skip2 = false;
            if ((samp ? (r0 & 63) : r0) != 0) {
                g2 = unpk4(*(const u32x2*)(ST + (r0 - 2) * 264 + c4)); g1 = unpk4(*(const u32x2*)(ST + (r0 - 1) * 264 + c4));
                v2 = unpk4(*(const u32x2*)(ST + (r0 - 2) * 264 + 128 + c4)); v1 = unpk4(*(const u32x2*)(ST + (r0 - 1) * 264 + 128 + c4));
            } else if (samp) {
                const float* sp = F.in[5] + (size_t)(l * 8 + (((d.brow + r0) >> 6) - 512)) * 2 * 5632;
                g2 = *(const f32x4*)(sp + gcol); g1 = *(const f32x4*)(sp + 5632 + gcol); v2 = *(const f32x4*)(sp + 2816 + gcol); v1 = *(const f32x4*)(sp + 5632 + 2816 + gcol);
            } else skip2 = needfix;
#pragma unroll 4
            for (int i = 0; i < 16; ++i) {
                const int row_l = r0 + i;
                const f32x4 g0 = unpk4(*(const u32x2*)(ST + row_l * 264 + c4)), v0 = unpk4(*(const u32x2*)(ST + row_l * 264 + 128 + c4));
                f32x4 o;
#pragma unroll
                for (int j = 0; j < 4; ++j) { const float yg = wg0[j] * g2[j] + wg1[j] * g1[j] + wg2[j] * g0[j] + bg[j], yv = wv0[j] * v2[j] + wv1[j] * v1[j] + wv2[j] * v0[j] + bv[j]; o[j] = silu(yg) * yv; }
                if (!(skip2 && i < 2)) *(u32x2*)(((bf16_t*)(F.ws + WS_P)) + (size_t)(d.brow + row_l) * LDP + gcol) = pk4(o);
                g2 = g1; g1 = g0; v2 = v1; v1 = v0;
            }
        }
        __syncthreads();
    }
}

DEV void sample_rows_gemm(const Frame& F0, const bf16_t* A, int lda, const bf16_t* Bt, int K, int resid) {
    REFRAME;
    if (F.nb != 256) return;
    const int fr = F.lane & 15, fq = F.lane >> 4, w = F.wid, rgp = F.bid >> 3, cg = F.bid & 7;
    const int row = 32768 + rgp * 16 + fr, colt = cg * 128 + w * 16;
    const bf16_t* ap = A + (size_t)row * lda + 8 * fq;
    const bf16_t* bp = Bt + (size_t)(colt + fr) * K + 8 * fq;
    f32x4 acc = {0.f, 0.f, 0.f, 0.f};
#pragma unroll 8
    for (int k = 0; k < K; k += 32) acc = MFMA16(*(const bf16x8*)(bp + k), *(const bf16x8*)(ap + k), acc);
    const int col = colt + 4 * fq;
    if (resid == 1) {
        float* X = F.out + (size_t)row * 1024 + col;
        f32x4 x = *(const f32x4*)X; x = x + acc; *(f32x4*)X = x;
        *(u32x2*)(((bf16_t*)(F.ws + WS_XB)) + (size_t)row * 1024 + col) = pk4(x);
        float ss = (x[0] * x[0] + x[1] * x[1]) + (x[2] * x[2] + x[3] * x[3]);
        ss += __shfl_xor(ss, 16); ss += __shfl_xor(ss, 32);
        float* red = (float*)F.lds;
        __syncthreads();
        if (fq == 0) red[fr * 8 + w] = ss;
        __syncthreads();
        if (F.tid < 32) {
            const int r = F.tid & 15, g = F.tid >> 4, c0 = cg * 128 + g * 64;
            const float t = (red[r * 8 + g * 4] + red[r * 8 + g * 4 + 1]) + (red[r * 8 + g * 4 + 2] + red[r * 8 + g * 4 + 3]);
            ((float*)(F.ws + WS_SSQ))[((size_t)(c0 >> 8) * TT + 32768 + rgp * 16 + r) * 4 + ((c0 >> 6) & 3)] = t;
        }
        __syncthreads();
    } else if (resid == 0) {
        const float rs = row_rstd(((float*)(F.ws + WS_SSQ)), row) * 0.0625f;
        *(u32x2*)(((bf16_t*)(F.ws + WS_P)) + (size_t)row * LDP + C_Q + col) = pk4(acc * rs);
    } else {
        bf16_t* prow = ((bf16_t*)(F.ws + WS_P)) + (size_t)row * LDP;
        const f32x4 g = unpk4(*(const u32x2*)(prow + (resid == 2 ? C_GA : C_GB) + col));
        f32x4 o = {0.f, 0.f, 0.f, 0.f};
        if (resid == 3) o = unpk4(*(const u32x2*)(prow + C_MRG + col));
#pragma unroll
        for (int j = 0; j < 4; ++j) o[j] += sigm(g[j]) * acc[j];
        *(u32x2*)(prow + C_MRG + col) = pk4(o);
    }
}

enum { GP_IN = 0, GP_OUT, GP_WO, GP_MQ, GP_ATTN, GP_MO, GP_UP, GP_DOWN, GP_ATTN2, GP_OUT2, GP_MEMKV };
DEV void gemm_phase(const Frame& F0, int kind, int l) {
    REFRAME;
    int nunits = 0;
    switch (kind) { case GP_IN: case GP_UP: nunits = 130 * 22; break; case GP_OUT: nunits = 520 + 128; break; case GP_OUT2: nunits = 520; break; case GP_ATTN: case GP_ATTN2: nunits = 512 + 32; break; default: nunits = 520; }
    const bool srow = (F.nb == 256) && (kind == GP_WO || kind == GP_MQ || kind == GP_MO || kind == GP_DOWN || kind == GP_OUT || kind == GP_OUT2);
    if (srow) nunits = 512;
    if (kind == GP_MEMKV) nunits = 128;
    f32x4 acc[2][2][4][2];
    const bool xmap = (F.nb == 256) && (kind == GP_IN || kind == GP_UP || kind == GP_WO || kind == GP_MQ || kind == GP_MO || kind == GP_DOWN || kind == GP_OUT2 || (kind == GP_OUT && srow));
    const int xcd = F.bid & 7, slot = F.bid >> 3, w_lo = (int)(((long)nunits * xcd) >> 3), w_hi = (int)(((long)nunits * (xcd + 1)) >> 3);
    const bool mkv = kind == GP_MEMKV;
    for (int u0 = mkv ? (F.bid >= 192 ? F.bid - 192 : nunits) : (xmap ? w_lo + slot : F.bid); u0 < (xmap ? w_hi : nunits); u0 += mkv ? 64 : (xmap ? 32 : F.nb)) {
        int u = u0;
        if (xmap) { const int nn = (kind == GP_IN || kind == GP_UP) ? 22 : 4; const int nm = srow ? 128 : 130; const int pn_ = u0 / nm, pm_ = u0 % nm; u = pm_ * nn + pn_; }
        GDesc d;
        { const int sub = (kind == GP_ATTN2 || kind == GP_OUT2) ? 1 : 0;
            d.vai = -1; d.vwr = 0; d.head = 0;
            switch (kind) {
            case GP_IN: { const int pm = u / 22, pn = u % 22; d.A = ((bf16_t*)(F.ws + WS_XB)); d.lda = 1024; d.Bt = ((bf16_t*)(F.ws + WS_WMIX)) + WM_WIN; d.ldb = 1024; d.K = 1024; d.brow = pm * 256; d.bcol = pn * 256; d.epi = EPI_PROJ; d.orow = d.brow; d.ocol = d.bcol; } break;
            case GP_UP: { const int pm = u / 22, pn = u % 22; d.A = ((bf16_t*)(F.ws + WS_XB)); d.lda = 1024; d.Bt = ((bf16_t*)(F.ws + WS_WFFN)) + WF_UP; d.ldb = 1024; d.K = 1024; d.brow = pm * 256; d.bcol = pn * 256; d.epi = EPI_UP; d.orow = d.brow; d.ocol = d.bcol; } break;
            case GP_MEMKV: case GP_OUT: case GP_OUT2:
                if (kind == GP_MEMKV) u += 520;
                if (u < 520) { const int pm = u >> 2, pn = u & 3; d.A = ((bf16_t*)(F.ws + WS_P)) + (sub == 0 ? C_ZA : C_ZB); d.lda = LDP; d.Bt = ((bf16_t*)(F.ws + WS_WMIX)) + (sub == 0 ? WM_WOA : WM_WOB); d.ldb = 512; d.K = 512;
                               d.brow = pm * 256; d.bcol = pn * 256; d.epi = sub == 0 ? EPI_OUTA : EPI_OUTB; d.orow = d.brow; d.ocol = d.bcol; }
                else if (u < 520 + 64) { const int v = u - 520, pm = v >> 2, pn = v & 3; d.A = ((bf16_t*)(F.ws + WS_MB)); d.lda = 1024; d.Bt = ((bf16_t*)(F.ws + WS_WMIX)) + WM_WMK; d.ldb = 1024; d.K = 1024; d.brow = pm * 256; d.bcol = pn * 256; d.epi = EPI_MEMK; d.orow = d.brow; d.ocol = d.bcol; }
                else { const int v = u - 584, pm = v & 3, pn = v >> 2; d.A = ((bf16_t*)(F.ws + WS_WMIX)) + WM_WMV; d.lda = 1024; d.Bt = ((bf16_t*)(F.ws + WS_MB)); d.ldb = 1024; d.K = 1024; d.brow = pm * 256; d.bcol = pn * 256; d.epi = EPI_MEMV; d.orow = d.brow; d.ocol = d.bcol; }
                break;
            case GP_WO: { const int pm = u >> 2, pn = u & 3; d.A = ((bf16_t*)(F.ws + WS_P)) + C_MRG; d.lda = LDP; d.Bt = ((bf16_t*)(F.ws + WS_WMIX)) + WM_WO; d.ldb = 1024; d.K = 1024; d.brow = pm * 256; d.bcol = pn * 256; d.epi = EPI_RESID; d.orow = d.brow; d.ocol = d.bcol; } break;
            case GP_MQ: { const int pm = u >> 2, pn = u & 3; d.A = ((bf16_t*)(F.ws + WS_XB)); d.lda = 1024; d.Bt = ((bf16_t*)(F.ws + WS_WMIX)) + WM_WMQ; d.ldb = 1024; d.K = 1024; d.brow = pm * 256; d.bcol = pn * 256; d.epi = EPI_Q; d.orow = d.brow; d.ocol = d.bcol; } break;
            case GP_MO: { const int pm = u >> 2, pn = u & 3; d.A = ((bf16_t*)(F.ws + WS_P)) + C_O; d.lda = LDP; d.Bt = ((bf16_t*)(F.ws + WS_WMIX)) + WM_WMO; d.ldb = 1024; d.K = 1024; d.brow = pm * 256; d.bcol = pn * 256; d.epi = EPI_RESID; d.orow = d.brow; d.ocol = d.bcol; } break;
            case GP_DOWN: { const int pm = u >> 2, pn = u & 3; d.A = ((bf16_t*)(F.ws + WS_P)); d.lda = LDP; d.Bt = ((bf16_t*)(F.ws + WS_WFFN)) + WF_DN; d.ldb = 2816; d.K = 2816; d.brow = pm * 256; d.bcol = pn * 256; d.epi = EPI_RESID; d.orow = d.brow; d.ocol = d.bcol; } break;
            case GP_ATTN: case GP_ATTN2: {
                int pm, h, b;
                if (u < 512) { pm = u >> 2; h = u & 3; b = pm >> 3; }
                else { const int v = u - 512; h = v & 3; const int bi = (v >> 2) & 3, t = v >> 4; pm = 128 + t; b = 16 + 4 * t + bi; d.vai = bi >> 1; d.vwr = bi & 1; }
                d.head = h; d.brow = pm * 256; d.orow = d.brow; d.ocol = 0; d.K = 256; d.bcol = 0;
                if (sub == 0) { d.A = ((bf16_t*)(F.ws + WS_P)) + C_Q + h * 256; d.lda = LDP; d.Bt = ((bf16_t*)(F.ws + WS_KV)) + (size_t)b * 256 * 1024 + h * 256; d.ldb = 1024; d.epi = EPI_SOFTMAX; }
                else { d.A = ((bf16_t*)(F.ws + WS_P)) + C_PR + h * 256; d.lda = LDP; d.Bt = ((bf16_t*)(F.ws + WS_KV + 6144ull * 1024 * 2)) + (size_t)(b * 4 + h) * 65536; d.ldb = 256; d.epi = EPI_ATTNO; }
            } break;
            }
        }
        gemm_core(d.A, d.lda, d.Bt, d.ldb, d.K, d.brow, d.bcol, acc, (bf16_t*)F.lds);
        gemm_epilogue(F, d, l, acc);
    }
    if (srow) {
        __syncthreads();
        if (kind == GP_WO) sample_rows_gemm(F, ((bf16_t*)(F.ws + WS_P)) + C_MRG, LDP, ((bf16_t*)(F.ws + WS_WMIX)) + WM_WO, 1024, 1);
        else if (kind == GP_MQ) sample_rows_gemm(F, ((bf16_t*)(F.ws + WS_XB)), 1024, ((bf16_t*)(F.ws + WS_WMIX)) + WM_WMQ, 1024, 0);
        else if (kind == GP_OUT) sample_rows_gemm(F, ((bf16_t*)(F.ws + WS_P)) + C_ZA, LDP, ((bf16_t*)(F.ws + WS_WMIX)) + WM_WOA, 512, 2);
        else if (kind == GP_OUT2) sample_rows_gemm(F, ((bf16_t*)(F.ws + WS_P)) + C_ZB, LDP, ((bf16_t*)(F.ws + WS_WMIX)) + WM_WOB, 512, 3);
        else if (kind == GP_MO) sample_rows_gemm(F, ((bf16_t*)(F.ws + WS_P)) + C_O, LDP, ((bf16_t*)(F.ws + WS_WMIX)) + WM_WMO, 1024, 1);
        else sample_rows_gemm(F, ((bf16_t*)(F.ws + WS_P)), LDP, ((bf16_t*)(F.ws + WS_WFFN)) + WF_DN, 2816, 1);
    }
}

DEV void sample_kv(const Frame& F0, int l) {
    REFRAME;
    const float* ck = F.in[6] + (size_t)l * 2097152; const float* cv = F.in[7] + (size_t)l * 2097152;
    const bool idle = F.nb == 256;
    if (idle && F.bid < 192) return;
    for (int i = (idle ? F.bid - 192 : F.bid) * 512 + F.tid; i < 262144; i += (idle ? 64 : F.nb) * 512) {
        const f32x4 a = *(const f32x4*)(ck + (size_t)i * 8), b = *(const f32x4*)(ck + (size_t)i * 8 + 4);
        u32x4 w; w.x = pk2(a[0], a[1]); w.y = pk2(a[2], a[3]); w.z = pk2(b[0], b[1]); w.w = pk2(b[2], b[3]);
        *(u32x4*)(((bf16_t*)(F.ws + WS_KV)) + 4096ull * 1024 + (size_t)i * 8) = w;
        const int dd = i & 255, m8 = (i >> 8) & 31, h = (i >> 13) & 3, bb = i >> 15;
        const float* s = cv + ((size_t)(bb * 256 + m8 * 8) * 4 + h) * 256 + dd;
        u32x4 x; x.x = pk2(s[0], s[1024]); x.y = pk2(s[2048], s[3072]); x.z = pk2(s[4096], s[5120]); x.w = pk2(s[6144], s[7168]);
        *(u32x4*)(((bf16_t*)(F.ws + WS_KV + 6144ull * 1024 * 2)) + ((size_t)((16 + bb) * 4 + h) * 256 + dd) * 256 + m8 * 8) = x;
    }
}

DEV void g1_gdn(const Frame& F0, int l, int c, int h) {
    REFRAME;
    float* Fq = (float*)F.lds;
    bf16_t* VS = (bf16_t*)(F.lds + 66560);
    bf16_t* QN = (bf16_t*)(F.lds + 82944);
    bf16_t* KN = (bf16_t*)(F.lds + 100352);
    float* AM = (float*)(F.lds + 117760);
    float* sB = (float*)(F.lds + 135168); float* sG = sB + 64; float* sRQ = sB + 128; float* sRK = sB + 192;
    const int tid = F.tid, lane = F.lane, t0 = c * 64;
    const bool first = c >= 512 || (c & 31) == 0; const bool sample = c >= 512;
    __syncthreads();
    if (F.wid == 7) {
        const int t = t0 + lane;
        const float braw = ((float*)(F.ws + WS_SC))[(size_t)t * 32 + h], araw = ((float*)(F.ws + WS_SC))[(size_t)t * 32 + 4 + h];
        const float beta = sigm(braw);
        float g = -__expf(F.in[12][l * 4 + h]) * softplus(araw + F.in[13][l * 4 + h]);
#pragma unroll
        for (int off = 1; off < 64; off <<= 1) { const float n = __shfl_up(g, off); if (lane >= off) g += n; }
        sB[lane] = beta; sG[lane] = g;
        if (!F.dry) ((float*)(F.ws + WS_BG))[((size_t)c * 4 + h) * 128 + lane] = beta; if (!F.dry) ((float*)(F.ws + WS_BG))[((size_t)c * 4 + h) * 128 + 64 + lane] = g;
    }
    const float* cw = F.in[11] + (size_t)l * 4 * 1536;
    if (tid < 384) {
        const int cp = tid % 192, rh = tid / 192, which = cp >> 6, cc = (cp & 63) * 2, pcol = which * 512 + h * 128 + cc;
        const f32x2 w0 = *(const f32x2*)(cw + pcol), w1 = *(const f32x2*)(cw + 1536 + pcol), w2 = *(const f32x2*)(cw + 2 * 1536 + pcol), w3 = *(const f32x2*)(cw + 3 * 1536 + pcol);
        float x0[35], x1[35];
#pragma unroll
        for (int i = 0; i < 3; ++i) {
            x0[i] = 0.f; x1[i] = 0.f;
            if (rh == 1) { const unsigned u = *(const unsigned*)(((bf16_t*)(F.ws + WS_P)) + (size_t)(t0 + 29 + i) * LDP + pcol); x0[i] = bflo(u); x1[i] = bfhi(u); }
            else if (!first) { const unsigned u = *(const unsigned*)(((bf16_t*)(F.ws + WS_KV)) + ((size_t)(c - 1) * 3 + i) * 1536 + pcol); x0[i] = bflo(u); x1[i] = bfhi(u); }
            else if (sample) { const f32x2 f = *(const f32x2*)(F.in[3] + ((size_t)(l * 8 + (c - 512)) * 3 + i) * 1536 + pcol); x0[i] = f[0]; x1[i] = f[1]; }
        }
#pragma unroll
        for (int i = 0; i < 32; ++i) { const unsigned u = *(const unsigned*)(((bf16_t*)(F.ws + WS_P)) + (size_t)(t0 + 32 * rh + i) * LDP + pcol); x0[3 + i] = bflo(u); x1[3 + i] = bfhi(u); }
#pragma unroll
        for (int r = 0; r < 32; ++r) {
            float a0 = w0[0] * x0[r] + w1[0] * x0[r + 1] + w2[0] * x0[r + 2] + w3[0] * x0[r + 3];
            float a1 = w0[1] * x1[r] + w1[1] * x1[r + 1] + w2[1] * x1[r + 2] + w3[1] * x1[r + 3];
            a0 = silu(a0); a1 = silu(a1);
            const int rr = 32 * rh + r;
            if (which < 2) { *(f32x2*)(Fq + rr * 260 + which * 128 + cc) = (f32x2){a0, a1}; }
            else { *(unsigned*)(VS + rr * 128 + cc) = pk2(a0, a1); }
        }
    }
    __syncthreads();
    {
        const int r = tid >> 3, j = tid & 7; const float* p = Fq + r * 260 + j * 32; float s = 0.f;
#pragma unroll
        for (int i = 0; i < 32; ++i) s += p[i] * p[i];
        s += __shfl_xor(s, 1); s += __shfl_xor(s, 2);
        if ((j & 3) == 0) { if (j == 0) sRQ[r] = rsqrtf(s + 1e-6f) * 0.08838834764831845f; else sRK[r] = rsqrtf(s + 1e-6f); }
    }
    __syncthreads();
    for (int idx = tid; idx < 64 * 64; idx += 512) {
        const int r = idx >> 6, c4 = (idx & 63) * 4; const bool isq = c4 < 128;
        f32x4 v = *(const f32x4*)(Fq + r * 260 + c4); v = v * (isq ? sRQ[r] : sRK[r]);
        const u32x2 w = pk4(v);
        if (isq) { *(u32x2*)(QN + r * 136 + c4) = w; if (!F.dry) *(u32x2*)(((bf16_t*)(F.ws + WS_P)) + (size_t)(t0 + r) * LDP + C_QA + h * 128 + c4) = w; }
        else { *(u32x2*)(KN + r * 136 + c4 - 128) = w; if (!F.dry) *(u32x2*)(((bf16_t*)(F.ws + WS_P)) + (size_t)(t0 + r) * LDP + C_KA + h * 128 + c4 - 128) = w; }
    }
    for (int idx = tid; idx < 64 * 32; idx += 512) {
        const int r = idx >> 5, c4 = (idx & 31) * 4;
        if (!F.dry) *(u32x2*)(((bf16_t*)(F.ws + WS_P)) + (size_t)(t0 + r) * LDP + C_VA + h * 128 + c4) = pk4(unpk4(*(const u32x2*)(VS + r * 128 + c4)) * sB[r]);
    }
    __syncthreads();
    {
        const int fr = lane & 15, fq = lane >> 4, which = F.wid >> 2, it = F.wid & 3;
        const bf16_t* X = which ? QN : KN;
        const int crow = 16 * it + fr; const float gc = sG[crow], bc = sB[crow];
        for (int jt = 0; jt < 4; ++jt) {
            f32x4 a = {0.f, 0.f, 0.f, 0.f};
            if (jt <= it) {
#pragma unroll
                for (int ks = 0; ks < 4; ++ks) a = MFMA16(ldfrag(KN, 16 * jt + fr, 136, 32 * ks, fq), ldfrag(X, crow, 136, 32 * ks, fq), a);
            }
            f32x4 o;
#pragma unroll
            for (int j = 0; j < 4; ++j) {
                const int s = 16 * jt + 4 * fq + j;
                const bool keep = which ? (s <= crow) : (s < crow);
                const float dec = keep ? __expf(gc - sG[s]) : 0.f;
                o[j] = a[j] * dec * (which ? 1.f : bc);
            }
            if (which) { if (!F.dry) *(u32x2*)(((bf16_t*)(F.ws + WS_XB)) + (size_t)(t0 + crow) * LDE + h * 128 + 64 + 16 * jt + 4 * fq) = pk4(o); }
            else *(f32x4*)(AM + crow * 68 + 16 * jt + 4 * fq) = o;
        }
    }
    __syncthreads();
    {
        float* TF = (float*)F.lds;
        float* MS = (float*)(F.lds + 20480);
        const int w = F.wid;
        if (w == 0) {
            const int blk = lane >> 4, cc = lane & 15, base = blk * 16;
            float Tc[16];
#pragma unroll
            for (int i = 0; i < 16; ++i) {
                float a = (i == cc) ? 1.f : 0.f;
#pragma unroll
                for (int j = 0; j < i; ++j) a -= AM[(base + i) * 68 + base + j] * Tc[j];
                Tc[i] = a;
            }
#pragma unroll
            for (int i = 0; i < 16; ++i) TF[(base + i) * 68 + base + cc] = Tc[i];
        }
        __syncthreads();
#pragma unroll 1
        for (int dd = 1; dd < 4; ++dd) {
            if (w < 4 - dd) {
                const int I = w + dd, J = w, r = lane >> 2, c4 = (lane & 3) * 4;
                f32x4 mm = {0.f, 0.f, 0.f, 0.f};
                for (int K = J; K < I; ++K)
#pragma unroll
                    for (int k = 0; k < 16; ++k) { const float a = AM[(I * 16 + r) * 68 + K * 16 + k]; const f32x4 t = *(const f32x4*)(TF + (K * 16 + k) * 68 + J * 16 + c4); mm = mm + a * t; }
                float* ms = MS + w * 256;
                *(f32x4*)(ms + r * 16 + c4) = mm;
                asm volatile("s_waitcnt lgkmcnt(0)" ::: "memory");
                f32x4 o = {0.f, 0.f, 0.f, 0.f};
#pragma unroll
                for (int k = 0; k < 16; ++k) { const float a = TF[(I * 16 + r) * 68 + I * 16 + k]; const f32x4 t = *(const f32x4*)(ms + k * 16 + c4); o = o - a * t; }
                *(f32x4*)(TF + (I * 16 + r) * 68 + J * 16 + c4) = o;
            }
            __syncthreads();
        }
        {
            const int r = tid >> 3, c8 = (tid & 7) * 8; const bool z = (c8 >> 4) > (r >> 4);
            const f32x4 a = z ? (f32x4){0.f, 0.f, 0.f, 0.f} : *(const f32x4*)(TF + r * 68 + c8), b = z ? (f32x4){0.f, 0.f, 0.f, 0.f} : *(const f32x4*)(TF + r * 68 + c8 + 4);
            u32x4 o; o.x = pk2(a[0], a[1]); o.y = pk2(a[2], a[3]); o.z = pk2(b[0], b[1]); o.w = pk2(b[2], b[3]);
            if (!F.dry) *(u32x4*)(((bf16_t*)(F.ws + WS_XB)) + (size_t)(t0 + r) * LDE + h * 128 + c8) = o;
        }
    }
}

DEV void g1_gla(const Frame& F0, int l, int c, int h) {
    REFRAME;
    float* GL = (float*)F.lds;
    float* LA = (float*)(F.lds + 4096);
    bf16_t* QG = (bf16_t*)(F.lds + 20736);
    bf16_t* KI = (bf16_t*)(F.lds + 29952);
    const int tid = F.tid, lane = F.lane, t0 = c * 64;
    __syncthreads();
    if (tid < 256) { const int r = tid >> 2, q4 = (tid & 3) * 4; *(f32x4*)(GL + r * 16 + q4) = *(const f32x4*)(((float*)(F.ws + WS_SC)) + (size_t)(t0 + r) * 32 + 8 + q4); }
    __syncthreads();
    {
        const int dk = tid & 63, rb = tid >> 6;
        float w2[16];
#pragma unroll
        for (int i = 0; i < 16; ++i) w2[i] = F.in[15][(size_t)(l * 16 + i) * 256 + h * 64 + dk];
        const float bias = F.in[16][l * 256 + h * 64 + dk];
#pragma unroll
        for (int rr = 0; rr < 8; ++rr) {
            const int r = rb * 8 + rr; float x = bias;
#pragma unroll
            for (int i = 0; i < 16; ++i) x += GL[r * 16 + i] * w2[i];
            LA[r * 65 + dk] = logsigmoid(x) * 0.0625f;
        }
    }
    __syncthreads();
    if (tid < 64) {
        float g = 0.f;
#pragma unroll 8
        for (int r = 0; r < 64; ++r) { g += LA[r * 65 + tid]; LA[r * 65 + tid] = g; }
        if (!F.dry) ((float*)(F.ws + WS_DL))[((size_t)c * 4 + h) * 64 + tid] = __expf(g);
    }
    __syncthreads();
    for (int idx = tid; idx < 64 * 16; idx += 512) {
        const int r = idx >> 4, c4 = (idx & 15) * 4;
        bf16_t* qp = ((bf16_t*)(F.ws + WS_P)) + (size_t)(t0 + r) * LDP + C_QB + h * 64 + c4; bf16_t* kp = ((bf16_t*)(F.ws + WS_P)) + (size_t)(t0 + r) * LDP + C_KB + h * 64 + c4;
        const f32x4 q = unpk4(*(const u32x2*)qp), k = unpk4(*(const u32x2*)kp);
        f32x4 qg, ki, kg;
#pragma unroll
        for (int j = 0; j < 4; ++j) { const float g = LA[r * 65 + c4 + j], gl = LA[63 * 65 + c4 + j];
            qg[j] = q[j] * 0.125f * __expf(g); ki[j] = k[j] * __expf(-g); kg[j] = k[j] * __expf(gl - g); }
        const u32x2 wq = pk4(qg);
        *(u32x2*)(QG + r * 72 + c4) = wq; *(u32x2*)(KI + r * 72 + c4) = pk4(ki);
        if (!F.dry) *(u32x2*)qp = wq; if (!F.dry) *(u32x2*)kp = pk4(kg);
    }
    __syncthreads();
    {
        const int fr = lane & 15, fq = lane >> 4, it = F.wid >> 1; const int crow = 16 * it + fr;
#pragma unroll
        for (int q = 0; q < 2; ++q) {
            const int jt = (F.wid & 1) * 2 + q;
            f32x4 a = {0.f, 0.f, 0.f, 0.f};
            if (jt <= it) {
#pragma unroll
                for (int ks = 0; ks < 2; ++ks) a = MFMA16(ldfrag(KI, 16 * jt + fr, 72, 32 * ks, fq), ldfrag(QG, crow, 72, 32 * ks, fq), a);
            }
#pragma unroll
            for (int j = 0; j < 4; ++j) if (16 * jt + 4 * fq + j > crow) a[j] = 0.f;
            if (!F.dry) *(u32x2*)(((bf16_t*)(F.ws + WS_XB)) + (size_t)(t0 + crow) * LDE + 512 + h * 64 + 16 * jt + 4 * fq) = pk4(a);
        }
    }
}

DEV void g2_gdn(const Frame& F0, int l, int s, int h) {
    REFRAME;
    bf16_t* QN = (bf16_t*)F.lds;
    bf16_t* KN = (bf16_t*)(F.lds + 17408);
    bf16_t* KT = (bf16_t*)(F.lds + 34816);
    bf16_t* TM = (bf16_t*)(F.lds + 53248);
    bf16_t* AQ = (bf16_t*)(F.lds + 62464);
    float* sB = (float*)(F.lds + 71680); float* sG = sB + 64;
    float* RED = (float*)(F.lds + 72192);
    bf16_t* VV = (bf16_t*)(F.lds + 74240);
    bf16_t* ZZ0 = (bf16_t*)(F.lds + 91648);
    const int tid = F.tid, lane = F.lane, w = F.wid, fr = lane & 15, fq = lane >> 4;
    const bool sample = s >= 16; const int nchunk = sample ? 1 : 32; const int tbase = sample ? 32768 + (s - 16) * 64 : s * 2048;
    const int dvc = h * 128 + 16 * w + fr;
    f32x4 S[8];
#pragma unroll
    for (int mt = 0; mt < 8; ++mt) {
        if (sample) { const float* sp = F.in[2] + ((size_t)((l * 8 + (s - 16)) * 4 + h) * 128) * 128;
#pragma unroll
            for (int j = 0; j < 4; ++j) S[mt][j] = sp[(size_t)(16 * mt + 4 * fq + j) * 128 + 16 * w + fr]; }
        else S[mt] = (f32x4){0.f, 0.f, 0.f, 0.f};
    }
    const float gn = F.in[14][l * 128 + 16 * w + fr];
    u32x4 pq[2], pk[2], pv[2], pz[2], pt, pa; float pbg = 0.f;
#define G2_FETCH(T0) do { int tq_ = tid; asm volatile("" : "+v"(tq_)); _Pragma("unroll") for (int i = 0; i < 2; ++i) { const int p_ = tq_ + 512 * i, r_ = p_ >> 4, c_ = (p_ & 15) * 8; \
        const bf16_t* rp_ = ((bf16_t*)(F.ws + WS_P)) + (size_t)((T0) + r_) * LDP + h * 128 + c_; \
        pq[i] = *(const u32x4*)(rp_ + C_QA); pk[i] = *(const u32x4*)(rp_ + C_KA); pv[i] = *(const u32x4*)(rp_ + C_VA); pz[i] = *(const u32x4*)(rp_ + C_ZA); } \
      { const int r_ = tq_ >> 3, c_ = (tq_ & 7) * 8; const bf16_t* ep_ = ((bf16_t*)(F.ws + WS_XB)) + (size_t)((T0) + r_) * LDE + h * 128 + c_; pt = *(const u32x4*)ep_; pa = *(const u32x4*)(ep_ + 64); } \
      if (tq_ < 128) pbg = ((float*)(F.ws + WS_BG))[((size_t)((T0) >> 6) * 4 + h) * 128 + tq_]; } while (0)
#define G2_PUT(PAR) do { int tq_ = tid; asm volatile("" : "+v"(tq_)); bf16_t* zz_ = ZZ0 + (PAR) * (64 * 136); _Pragma("unroll") for (int i = 0; i < 2; ++i) { const int p_ = tq_ + 512 * i, r = p_ >> 4, c8 = (p_ & 15) * 8; const u32x4 k = pk[i]; \
        *(u32x4*)(QN + r * 136 + c8) = pq[i]; *(u32x4*)(KN + r * 136 + c8) = k; *(u32x4*)(VV + r * 136 + c8) = pv[i]; *(u32x4*)(zz_ + r * 136 + c8) = pz[i]; \
        KT[(c8 + 0) * 72 + r] = (bf16_t)(k.x & 0xffff); KT[(c8 + 1) * 72 + r] = (bf16_t)(k.x >> 16); KT[(c8 + 2) * 72 + r] = (bf16_t)(k.y & 0xffff); KT[(c8 + 3) * 72 + r] = (bf16_t)(k.y >> 16); \
        KT[(c8 + 4) * 72 + r] = (bf16_t)(k.z & 0xffff); KT[(c8 + 5) * 72 + r] = (bf16_t)(k.z >> 16); KT[(c8 + 6) * 72 + r] = (bf16_t)(k.w & 0xffff); KT[(c8 + 7) * 72 + r] = (bf16_t)(k.w >> 16); } \
      { const int r = tq_ >> 3, c8 = (tq_ & 7) * 8; *(u32x4*)(TM + r * 72 + c8) = pt; *(u32x4*)(AQ + r * 72 + c8) = pa; } \
      if (tq_ < 128) sB[tq_] = pbg; } while (0)
    __syncthreads();
    G2_FETCH(tbase); G2_PUT(0);
    __syncthreads();
    for (int n = 0; n < nchunk; ++n) {
        const int t0 = tbase + n * 64;
        const bf16_t* ZZ = ZZ0 + (n & 1) * (64 * 136);
        f32x4 kS[4], qS[4], vn[4], o[4];
#pragma unroll
        for (int mt = 0; mt < 4; ++mt) { kS[mt] = (f32x4){0.f, 0.f, 0.f, 0.f}; qS[mt] = kS[mt]; vn[mt] = kS[mt]; }
#pragma unroll
        for (int ks = 0; ks < 4; ++ks) {
            const bf16x8 sf = mk8(pk4(S[2 * ks]), pk4(S[2 * ks + 1]));
#pragma unroll
            for (int mt = 0; mt < 4; ++mt) {
                kS[mt] = MFMA16(ldfragp(KN, 16 * mt + fr, 136, 32 * ks, fq), sf, kS[mt]);
                qS[mt] = MFMA16(ldfragp(QN, 16 * mt + fr, 136, 32 * ks, fq), sf, qS[mt]);
            }
        }
        const float glast = sG[63];
        f32x4 eg[4], tmp[4];
#pragma unroll
        for (int mt = 0; mt < 4; ++mt)
#pragma unroll
            for (int j = 0; j < 4; ++j) {
                const int row = 16 * mt + 4 * fq + j;
                const float e = __expf(sG[row]); eg[mt][j] = e;
                const float vv = bf2f(VV[row * 136 + 16 * w + fr]);
                tmp[mt][j] = vv - sB[row] * e * kS[mt][j];
            }
#pragma unroll
        for (int ks = 0; ks < 2; ++ks) {
            const bf16x8 tf = mk8(pk4(tmp[2 * ks]), pk4(tmp[2 * ks + 1]));
#pragma unroll
            for (int mt = 0; mt < 4; ++mt) vn[mt] = MFMA16(ldfragp(TM, 16 * mt + fr, 72, 32 * ks, fq), tf, vn[mt]);
        }
#pragma unroll
        for (int mt = 0; mt < 4; ++mt) o[mt] = eg[mt] * qS[mt];
#pragma unroll
        for (int ks = 0; ks < 2; ++ks) {
            const bf16x8 vf = mk8(pk4(vn[2 * ks]), pk4(vn[2 * ks + 1]));
#pragma unroll
            for (int mt = 0; mt < 4; ++mt) o[mt] = MFMA16(ldfragp(AQ, 16 * mt + fr, 72, 32 * ks, fq), vf, o[mt]);
        }
        const float dl = __expf(glast);
#pragma unroll
        for (int mt = 0; mt < 4; ++mt)
#pragma unroll
            for (int j = 0; j < 4; ++j) vn[mt][j] *= __expf(glast - sG[16 * mt + 4 * fq + j]);
#pragma unroll
        for (int mt = 0; mt < 8; ++mt) S[mt] = S[mt] * dl;
#pragma unroll
        for (int ks = 0; ks < 2; ++ks) {
            const bf16x8 vf = mk8(pk4(vn[2 * ks]), pk4(vn[2 * ks + 1]));
#pragma unroll
            for (int mt = 0; mt < 8; ++mt) S[mt] = MFMA16(ldfragp(KT, 16 * mt + fr, 72, 32 * ks, fq), vf, S[mt]);
        }
#pragma unroll
        for (int mt = 0; mt < 4; ++mt)
#pragma unroll
            for (int j = 0; j < 4; ++j) {
                float p = o[mt][j] * o[mt][j];
                p += __shfl_xor(p, 1); p += __shfl_xor(p, 2); p += __shfl_xor(p, 4); p += __shfl_xor(p, 8);
                if (fr == 0) RED[(16 * mt + 4 * fq + j) * 8 + w] = p;
            }
        __syncthreads();
        if (n + 1 < nchunk) G2_FETCH(t0 + 64);
        __builtin_amdgcn_sched_barrier(0);
#pragma unroll
        for (int mt = 0; mt < 4; ++mt)
#pragma unroll
            for (int j = 0; j < 4; ++j) {
                const int row = 16 * mt + 4 * fq + j;
                const f32x4 r0 = *(const f32x4*)(RED + row * 8), r1 = *(const f32x4*)(RED + row * 8 + 4);
                const float ssum = ((r0[0] + r0[1]) + (r0[2] + r0[3])) + ((r1[0] + r1[1]) + (r1[2] + r1[3]));
                const float rs = rsqrtf(ssum * (1.f / 128.f) + 1e-6f);
                bf16_t* zp = ((bf16_t*)(F.ws + WS_P)) + (size_t)(t0 + row) * LDP + C_ZA + dvc;
                const float z = bf2f(ZZ[row * 136 + 16 * w + fr]);
                if (!F.dry) *zp = (bf16_t)(pk2(o[mt][j] * rs * gn * silu(z), 0.f) & 0xffff);
                __builtin_amdgcn_sched_barrier(0);
            }
        if (n + 1 < nchunk) { G2_PUT((n + 1) & 1); __syncthreads(); }
    }
#undef G2_FETCH
#undef G2_PUT
    float* so = sample ? F.out + O_GDN_S + ((size_t)((l * 8 + (s - 16)) * 4 + h) * 128) * 128 : F.out + O_GDN_P + ((size_t)((l * 16 + s) * 4 + h) * 128) * 128;
#pragma unroll
    for (int mt = 0; mt < 8; ++mt)
#pragma unroll
        for (int j = 0; j < 4; ++j) if (!F.dry) so[(size_t)(16 * mt + 4 * fq + j) * 128 + 16 * w + fr] = S[mt][j];
}

DEV void g2_gla(const Frame& F0, int l, int s, int h) {
    REFRAME;
    bf16_t* QG = (bf16_t*)F.lds;
    bf16_t* KGT = (bf16_t*)(F.lds + 9216);
    bf16_t* AQ = (bf16_t*)(F.lds + 18432);
    float* sDL = (float*)(F.lds + 27648);
    float* RED = (float*)(F.lds + 27904);
    bf16_t* ZZ = (bf16_t*)(F.lds + 29952);
    const int tid = F.tid, lane = F.lane, w = F.wid, fr = lane & 15, fq = lane >> 4;
    const bool sample = s >= 16; const int nchunk = sample ? 1 : 32; const int tbase = sample ? 32768 + (s - 16) * 64 : s * 2048;
    const int dvc = h * 128 + 16 * w + fr;
    f32x4 S[4];
#pragma unroll
    for (int mt = 0; mt < 4; ++mt) {
        if (sample) { const float* sp = F.in[4] + ((size_t)((l * 8 + (s - 16)) * 4 + h) * 64) * 128;
#pragma unroll
            for (int j = 0; j < 4; ++j) S[mt][j] = sp[(size_t)(16 * mt + 4 * fq + j) * 128 + 16 * w + fr]; }
        else S[mt] = (f32x4){0.f, 0.f, 0.f, 0.f};
    }
    const float gn = F.in[17][l * 128 + 16 * w + fr];
    for (int n = 0; n < nchunk; ++n) {
        const int t0 = tbase + n * 64, chunk = t0 >> 6;
        __syncthreads();
        {
            const int r = tid >> 3, c8 = (tid & 7) * 8;
            *(u32x4*)(QG + r * 72 + c8) = *(const u32x4*)(((bf16_t*)(F.ws + WS_P)) + (size_t)(t0 + r) * LDP + C_QB + h * 64 + c8);
            const u32x4 k = *(const u32x4*)(((bf16_t*)(F.ws + WS_P)) + (size_t)(t0 + r) * LDP + C_KB + h * 64 + c8);
            KGT[(c8 + 0) * 72 + r] = (bf16_t)(k.x & 0xffff); KGT[(c8 + 1) * 72 + r] = (bf16_t)(k.x >> 16);
            KGT[(c8 + 2) * 72 + r] = (bf16_t)(k.y & 0xffff); KGT[(c8 + 3) * 72 + r] = (bf16_t)(k.y >> 16);
            KGT[(c8 + 4) * 72 + r] = (bf16_t)(k.z & 0xffff); KGT[(c8 + 5) * 72 + r] = (bf16_t)(k.z >> 16);
            KGT[(c8 + 6) * 72 + r] = (bf16_t)(k.w & 0xffff); KGT[(c8 + 7) * 72 + r] = (bf16_t)(k.w >> 16);
            *(u32x4*)(AQ + r * 72 + c8) = *(const u32x4*)(((bf16_t*)(F.ws + WS_XB)) + (size_t)(t0 + r) * LDE + 512 + h * 64 + c8);
        }
#pragma unroll
        for (int i = 0; i < 2; ++i) { const int p = tid + 512 * i, r = p >> 4, c8 = (p & 15) * 8;
            *(u32x4*)(ZZ + r * 136 + c8) = *(const u32x4*)(((bf16_t*)(F.ws + WS_P)) + (size_t)(t0 + r) * LDP + C_ZB + h * 128 + c8); }
        if (tid < 64) sDL[tid] = ((float*)(F.ws + WS_DL))[((size_t)chunk * 4 + h) * 64 + tid];
        bf16x8 vf[2];
#pragma unroll
        for (int ks = 0; ks < 2; ++ks) {
            unsigned e[8];
#pragma unroll
            for (int j = 0; j < 8; ++j) { const int row = 32 * ks + (j < 4 ? 4 * fq + j : 16 + 4 * fq + (j - 4)); e[j] = ((bf16_t*)(F.ws + WS_P))[(size_t)(t0 + row) * LDP + C_VB + dvc]; }
            u32x4 t; t.x = e[0] | (e[1] << 16); t.y = e[2] | (e[3] << 16); t.z = e[4] | (e[5] << 16); t.w = e[6] | (e[7] << 16);
            vf[ks] = __builtin_bit_cast(bf16x8, t);
        }
        __syncthreads();
        f32x4 o[4];
#pragma unroll
        for (int mt = 0; mt < 4; ++mt) o[mt] = (f32x4){0.f, 0.f, 0.f, 0.f};
#pragma unroll
        for (int ks = 0; ks < 2; ++ks) {
            const bf16x8 sf = mk8(pk4(S[2 * ks]), pk4(S[2 * ks + 1]));
#pragma unroll
            for (int mt = 0; mt < 4; ++mt) {
                o[mt] = MFMA16(ldfragp(QG, 16 * mt + fr, 72, 32 * ks, fq), sf, o[mt]);
                o[mt] = MFMA16(ldfragp(AQ, 16 * mt + fr, 72, 32 * ks, fq), vf[ks], o[mt]);
            }
        }
#pragma unroll
        for (int mt = 0; mt < 4; ++mt) {
#pragma unroll
            for (int j = 0; j < 4; ++j) S[mt][j] *= sDL[16 * mt + 4 * fq + j];
#pragma unroll
            for (int ks = 0; ks < 2; ++ks) S[mt] = MFMA16(ldfragp(KGT, 16 * mt + fr, 72, 32 * ks, fq), vf[ks], S[mt]);
        }
#pragma unroll
        for (int mt = 0; mt < 4; ++mt)
#pragma unroll
            for (int j = 0; j < 4; ++j) {
                float p = o[mt][j] * o[mt][j];
                p += __shfl_xor(p, 1); p += __shfl_xor(p, 2); p += __shfl_xor(p, 4); p += __shfl_xor(p, 8);
                if (fr == 0) RED[(16 * mt + 4 * fq + j) * 8 + w] = p;
            }
        __syncthreads();
#pragma unroll
        for (int mt = 0; mt < 4; ++mt)
#pragma unroll
            for (int j = 0; j < 4; ++j) {
                const int row = 16 * mt + 4 * fq + j;
                const f32x4 r0 = *(const f32x4*)(RED + row * 8), r1 = *(const f32x4*)(RED + row * 8 + 4);
                const float ssum = ((r0[0] + r0[1]) + (r0[2] + r0[3])) + ((r1[0] + r1[1]) + (r1[2] + r1[3]));
                const float rs = rsqrtf(ssum * (1.f / 128.f) + 1e-6f);
                bf16_t* zp = ((bf16_t*)(F.ws + WS_P)) + (size_t)(t0 + row) * LDP + C_ZB + dvc;
                const float z = bf2f(ZZ[row * 136 + 16 * w + fr]);
                if (!F.dry) *zp = (bf16_t)(pk2(o[mt][j] * rs * gn * silu(z), 0.f) & 0xffff);
            }
    }
    float* so = sample ? F.out + O_GLA_S + ((size_t)((l * 8 + (s - 16)) * 4 + h) * 64) * 128 : F.out + O_GLA_P + ((size_t)((l * 16 + s) * 4 + h) * 64) * 128;
#pragma unroll
    for (int mt = 0; mt < 4; ++mt)
#pragma unroll
        for (int j = 0; j < 4; ++j) if (!F.dry) so[(size_t)(16 * mt + 4 * fq + j) * 128 + 16 * w + fr] = S[mt][j];
}

DEV void unpack8(u32x4 u, float (&f)[8]) { f[0] = bflo(u.x); f[1] = bfhi(u.x); f[2] = bflo(u.y); f[3] = bfhi(u.y); f[4] = bflo(u.z); f[5] = bfhi(u.z); f[6] = bflo(u.w); f[7] = bfhi(u.w); }
DEV void load8f(const float* p, float (&f)[8]) { const f32x4 a = *(const f32x4*)p, b = *(const f32x4*)(p + 4); f[0] = a[0]; f[1] = a[1]; f[2] = a[2]; f[3] = a[3]; f[4] = b[0]; f[5] = b[1]; f[6] = b[2]; f[7] = b[3]; }
DEV void ffn_mid(const Frame& F0, int l) {
    REFRAME;
    const float* cw = F.in[29] + (size_t)l * 3 * 5632; const float* cb = F.in[30] + (size_t)l * 5632;
    const bf16_t* halo = ((bf16_t*)(F.ws + WS_KV)); const bf16_t* raw01 = ((bf16_t*)(F.ws + WS_KV + 11714560ull));
    for (int idx = F.bid * 512 + F.tid; idx < 112 * 704; idx += F.nb * 512) {
        const int ti = idx / 704, c4 = (idx % 704) * 4, pm = (ti / 7) * 8 + (ti % 7) + 1;
        const bf16_t* hp = halo + (size_t)(4 * pm - 1) * 2 * 5632; const bf16_t* rp = raw01 + (size_t)pm * 2 * 5632;
        const f32x4 gm2 = unpk4(*(const u32x2*)(hp + c4)), gm1 = unpk4(*(const u32x2*)(hp + 5632 + c4)), g0 = unpk4(*(const u32x2*)(rp + c4)), g1 = unpk4(*(const u32x2*)(rp + 5632 + c4));
        const f32x4 vm2 = unpk4(*(const u32x2*)(hp + 2816 + c4)), vm1 = unpk4(*(const u32x2*)(hp + 5632 + 2816 + c4)), v0 = unpk4(*(const u32x2*)(rp + 2816 + c4)), v1 = unpk4(*(const u32x2*)(rp + 5632 + 2816 + c4));
        const f32x4 wg0 = *(const f32x4*)(cw + c4), wg1 = *(const f32x4*)(cw + 5632 + c4), wg2 = *(const f32x4*)(cw + 2 * 5632 + c4), bg = *(const f32x4*)(cb + c4);
        const f32x4 wv0 = *(const f32x4*)(cw + 2816 + c4), wv1 = *(const f32x4*)(cw + 5632 + 2816 + c4), wv2 = *(const f32x4*)(cw + 2 * 5632 + 2816 + c4), bv = *(const f32x4*)(cb + 2816 + c4);
        f32x4 o0, o1;
#pragma unroll
        for (int j = 0; j < 4; ++j) {
            const float yg0 = wg0[j] * gm2[j] + wg1[j] * gm1[j] + wg2[j] * g0[j] + bg[j], yv0 = wv0[j] * vm2[j] + wv1[j] * vm1[j] + wv2[j] * v0[j] + bv[j];
            const float yg1 = wg0[j] * gm1[j] + wg1[j] * g0[j] + wg2[j] * g1[j] + bg[j], yv1 = wv0[j] * vm1[j] + wv1[j] * v0[j] + wv2[j] * v1[j] + bv[j];
            o0[j] = silu(yg0) * yv0; o1[j] = silu(yg1) * yv1;
        }
        bf16_t* vp = ((bf16_t*)(F.ws + WS_P)) + (size_t)pm * 256 * LDP + c4;
        *(u32x2*)vp = pk4(o0); *(u32x2*)(vp + LDP) = pk4(o1);
    }
}

DEV void final_norm(const Frame& F0) {
    REFRAME;
    const int gw = F.bid * 8 + F.wid, nw = F.nb * 8, lane = F.lane;
    const float* g = F.in[32];
    for (int row = gw; row < TT; row += nw) {
        const float rs = row_rstd(((float*)(F.ws + WS_SSQ)), row);
        float* X = F.out + (size_t)row * 1024;
#pragma unroll
        for (int i = 0; i < 4; ++i) { const int cidx = i * 256 + lane * 4; f32x4 v = *(const f32x4*)(X + cidx); const f32x4 gg = *(const f32x4*)(g + cidx); *(f32x4*)(X + cidx) = v * rs * gg; }
    }
}

#ifdef DBG_COL
DEV void dbg_dump(const Frame& F0) {
    REFRAME;
    for (int i = F.bid * 512 + F.tid; i < TT * 256; i += F.nb * 512) {
        const int row = i >> 8, c = (i & 255) * 4;
        const f32x4 v = c < 512 ? unpk4(*(const u32x2*)(((bf16_t*)(F.ws + WS_P)) + (size_t)row * LDP + DBG_COL + c)) : (f32x4){0.f, 0.f, 0.f, 0.f};
        *(f32x4*)(F.out + (size_t)row * 1024 + c) = (row DBG_ROWSEL) ? v : (f32x4){0.f, 0.f, 0.f, 0.f};
    }
}
#endif
#define XB_TMO      128
#define XB_XCNT(j)  (256  + 64 * (j))
#define XB_XSUB(j)  (1280 + 64 * (j))
#define XB_XGEN(j)  (2304 + 64 * (j))
#define XB_TOP      3328
#define XB_TOPGEN   3392
#define XCD_BAR_WORDS 3456
#define XB_SPIN_CAP (1u << 18)
#define LAS __attribute__((address_space(3)))

__device__ __forceinline__ unsigned xb_ld(unsigned* p)              { return __hip_atomic_load(p, __ATOMIC_RELAXED, __HIP_MEMORY_SCOPE_AGENT); }
__device__ __forceinline__ unsigned xb_add(unsigned* p, unsigned v) { return __hip_atomic_fetch_add(p, v, __ATOMIC_RELAXED, __HIP_MEMORY_SCOPE_AGENT); }
__device__ __forceinline__ unsigned xb_xcc_id() { return (unsigned)__builtin_amdgcn_s_getreg((3 << 11) | 20) & 0xFu; }
#define XB_SPIN(cond, bar) do { unsigned _sp = 0; while (cond) { __builtin_amdgcn_s_sleep(1); \
    if ((++_sp & 255u) == 0u) { if (xb_ld(&(bar)[XB_TMO])) break; if (_sp > XB_SPIN_CAP) { atomicAdd(&(bar)[XB_TMO], 1u); break; } } } } while (0)

struct XcdBarrier {
    unsigned* bar; unsigned x;
    volatile LAS unsigned* st;
};

__device__ __forceinline__ XcdBarrier xcd_barrier_post(unsigned* bar, volatile LAS unsigned* st) {
    XcdBarrier b; b.bar = bar; b.x = xb_xcc_id(); b.st = st;
    if (threadIdx.x == 0) (void)xb_add(&bar[XB_XCNT(b.x)], 1u);
    return b;
}
__device__ __forceinline__ void xcd_barrier_complete(unsigned* bar, unsigned x, unsigned& nloc, unsigned& nx) {
    const unsigned G = gridDim.x * gridDim.y * gridDim.z;
    unsigned sum, cnt, mine, sp = 0u;
    for (;;) {
        sum = 0u; cnt = 0u; mine = 0u;
#pragma unroll
        for (unsigned j = 0; j < 16; ++j) { const unsigned c = xb_ld(&bar[XB_XCNT(j)]); sum += c; cnt += (c > 0u) ? 1u : 0u; mine = (j == x) ? c : mine; }
        if (sum == G) break;
        __builtin_amdgcn_s_sleep(1);
        if ((++sp & 255u) == 0u) { if (xb_ld(&bar[XB_TMO])) break; if (sp > XB_SPIN_CAP) { atomicAdd(&bar[XB_TMO], 1u); break; } }
    }
    nloc = mine > 0u ? mine : 1u; nx = cnt > 0u ? cnt : 1u;
}

__device__ __forceinline__ void xcd_barrier(const XcdBarrier& b) {
    asm volatile("s_waitcnt vmcnt(0)" ::: "memory");
    __syncthreads();
    if (threadIdx.x == 0) {
        unsigned* bar = b.bar;
        __builtin_amdgcn_s_waitcnt(0);
        unsigned nloc = b.st[0], nx = b.st[1];
        if (nloc == 0u) { xcd_barrier_complete(bar, b.x, nloc, nx); b.st[0] = nloc; b.st[1] = nx; }
        const unsigned old = xb_add(&bar[XB_XSUB(b.x)], 1u);
        const unsigned gen = old / nloc;
        if (old + 1u == (gen + 1u) * nloc) {
            __builtin_amdgcn_fence(__ATOMIC_RELEASE, "agent");
            asm volatile("s_waitcnt vmcnt(0)" ::: "memory");
            const unsigned og = xb_add(&bar[XB_TOP], 1u);
            const unsigned tg = og / nx;
            if (og + 1u == (tg + 1u) * nx) xb_add(&bar[XB_TOPGEN], 1u);
            else XB_SPIN(xb_ld(&bar[XB_TOPGEN]) == tg, bar);
            __builtin_amdgcn_fence(__ATOMIC_ACQUIRE, "agent");
            xb_add(&bar[XB_XGEN(b.x)], 1u);
            asm volatile("s_waitcnt vmcnt(0)" ::: "memory");
        } else {
            XB_SPIN(xb_ld(&bar[XB_XGEN(b.x)]) == gen, bar);
            __builtin_amdgcn_fence(__ATOMIC_ACQUIRE, "agent");
            asm volatile("s_waitcnt vmcnt(0)" ::: "memory");
        }
    }
    __syncthreads();
}

__global__ void __launch_bounds__(512, 2) fwd_kernel(Params p) {
    extern __shared__ __attribute__((aligned(16))) unsigned char lds[];
    cg::grid_group grid = cg::this_grid();
    Frame F;
    F.in = (InTab)__builtin_amdgcn_kernarg_segment_ptr(); F.out = p.out; F.ws = p.ws; F.lds = lds;
    F.tid = threadIdx.x; F.lane = threadIdx.x & 63; F.wid = __builtin_amdgcn_readfirstlane(threadIdx.x >> 6); F.nb = gridDim.x; F.bid = blockIdx.x; F.dry = 0; F.cb = blockIdx.x; F.cn = gridDim.x;
    volatile LAS unsigned* xst = (volatile LAS unsigned*)(lds + LDS_BYTES - 16);
    if (threadIdx.x == 0) { xst[0] = 0u; xst[1] = 0u; }
    __syncthreads();
    const XcdBarrier xbar = xcd_barrier_post((unsigned*)(p.ws + WS_BAR), xst);
    for (int ph = p.ph_lo; ph < p.ph_hi; ++ph) {
#ifndef PHM
#define PHM 0xffff
#endif
        if (ph == 0) { if (PHM & 0x1000) phase0(F); }
        else if (ph == NPH - 1) { if (PHM & 0x2000) final_norm(F); }
        else {
            const int l = (ph - 1) / 13, k = (ph - 1) % 13;
            int gk = -1;
            if (k == 2 && gridDim.x == 256) gk = GP_MEMKV;
            switch (k) { case 0: gk = GP_IN; break; case 3: gk = GP_OUT; break; case 4: gk = GP_OUT2; break; case 5: gk = GP_WO; break; case 6: gk = GP_MQ; break; case 7: gk = GP_ATTN; break; case 8: gk = GP_ATTN2; break;
                         case 9: gk = GP_MO; break; case 10: gk = GP_UP; break; case 12: gk = GP_DOWN; break; default: break; }
#ifndef REPMASK
#define REPMASK 0
#endif
            if (gk >= 0 && (PHM & 1)) { const int nrep = ((REPMASK >> k) & 1) ? 2 : 1; for (int rep = 0; rep < nrep; ++rep) gemm_phase(F, gk, l); }
            if (k == 0 && (PHM & 1)) small_proj(F);
            if (k == (gridDim.x == 256 ? 2 : 3) && (PHM & 8)) sample_kv(F, l);
            if (gridDim.x == 256 && k == 2 && l > 0 && blockIdx.x >= 128) { Frame G = F; G.cb = (int)blockIdx.x - 128; G.cn = 128; __syncthreads(); cvt_ffn(G, l); }
            if (gridDim.x == 256 && k == 10 && l < 3 && (blockIdx.x >> 3) >= 6) { Frame G = F; G.cb = (((int)blockIdx.x >> 3) - 6) * 8 + ((int)blockIdx.x & 7); G.cn = 208; __syncthreads(); cvt_mixer(G, l + 1); }
#ifndef DRYMASK
#define DRYMASK 0
#endif
            for (int dr = ((DRYMASK >> k) & 1); dr >= 0; --dr) {
            F.dry = dr;
            if (k == 1 && (PHM & 2)) {
                for (int it = F.bid; it < NCH * 8; it += F.nb) { const int c = it >> 3, h = it & 3; if (it & 4) g1_gla(F, l, c, h); else g1_gdn(F, l, c, h); }
                __syncthreads();
                if (l > 0 && !dr && F.nb != 256) cvt_ffn(F, l);
            }
            if (k == 2 && (PHM & 4)) {
                for (int it = F.bid; it < 192; it += F.nb) {
                    int s, h, br;
                    if (it < 128) { br = it & 1; h = (it >> 1) & 3; s = it >> 3; } else { const int v = it - 128; br = v & 1; h = (v >> 1) & 3; s = 16 + (v >> 3); }
                    if (br) g2_gla(F, l, s, h); else g2_gdn(F, l, s, h);
                    __syncthreads();
                }
            }
            if (k == 11 && (PHM & 0x200)) { ffn_mid(F, l); if (l < 3 && !dr && F.nb != 256) { __syncthreads(); cvt_mixer(F, l + 1); } }
            }
            F.dry = 0;
        }
#ifndef SYNCREP
#define SYNCREP 1
#endif
        if (ph + 1 < p.ph_hi) {
            if (ph == 0) grid.sync();
            else xcd_barrier(xbar);
        }
    }
#ifdef DBG_COL
    __threadfence(); grid.sync(); __threadfence();
    dbg_dump(F);
#endif
}

extern "C" void kernel_launch(void* const* d_in, const int* in_sizes, int n_in, void* d_out, int out_size, void* d_ws, size_t ws_size, hipStream_t stream) {
    static int grid_blocks = 0;
    if (grid_blocks == 0) {
        if (n_in != 33 || ws_size < WS_TOTAL) { fprintf(stderr, "kernel_launch: bad n_in %d or ws %zu < %zu\n", n_in, ws_size, (size_t)WS_TOTAL); grid_blocks = -1; return; }
        int dev = 0, cus = 0, per_cu = 0;
        hipGetDevice(&dev);
        hipDeviceGetAttribute(&cus, hipDeviceAttributeMultiprocessorCount, dev);
        if (hipFuncSetAttribute((const void*)fwd_kernel, hipFuncAttributeMaxDynamicSharedMemorySize, LDS_BYTES) != hipSuccess) { fprintf(stderr, "hipFuncSetAttribute failed\n"); grid_blocks = -1; return; }
        hipOccupancyMaxActiveBlocksPerMultiprocessor(&per_cu, (const void*)fwd_kernel, 512, LDS_BYTES);
        if (per_cu < 1) per_cu = 1;
        (void)hipGetLastError();
        grid_blocks = cus * 1;
        if (grid_blocks <= 0) grid_blocks = 256;
    }
    if (grid_blocks < 0) return;
    Params p{};
    for (int i = 0; i < 33; ++i) p.in[i] = (const float*)d_in[i];
    p.out = (float*)d_out; p.ws = (unsigned char*)d_ws; p.ph_lo = 0; p.ph_hi = PH_HI;
    (void)hipMemsetAsync((unsigned char*)d_ws + WS_BAR, 0, 16384, stream);
    void* args[] = {&p};
    hipError_t e = hipLaunchCooperativeKernel((const void*)fwd_kernel, dim3(grid_blocks), dim3(512), args, LDS_BYTES, stream);
    if (e != hipSuccess) fprintf(stderr, "cooperative launch failed: %s (grid %d)\n", hipGetErrorString(e), grid_blocks);
}
```

```cpp
#include <hip/hip_runtime.h>
#include <hip/hip_cooperative_groups.h>
#include <cstdint>
#include <cstdio>
namespace cg = cooperative_groups;

typedef unsigned short bf16_t;
typedef short bf16x8 __attribute__((ext_vector_type(8)));
typedef float f32x4 __attribute__((ext_vector_type(4)));
typedef float f32x2 __attribute__((ext_vector_type(2)));
typedef unsigned u32x2 __attribute__((ext_vector_type(2)));
typedef unsigned u32x4 __attribute__((ext_vector_type(4)));
#define DEV __device__ __forceinline__

constexpr int DM = 1024, TT = 33280, NCH = 520, LDP = 5632, LDE = 768;
constexpr int C_QA = 0, C_KA = 512, C_VA = 1024, C_ZA = 1536, C_QB = 2048, C_KB = 2304, C_VB = 2560, C_ZB = 3072, C_GA = 3584, C_GB = 4608;
constexpr int C_MRG = 0, C_PR = 1024, C_Q = 2048, C_O = 3072;
constexpr size_t O_Y = 0;
constexpr size_t O_GDN_P = 34078720ull;
constexpr size_t O_GDNC_P = O_GDN_P + 4194304ull;
constexpr size_t O_GLA_P = O_GDNC_P + 294912ull;
constexpr size_t O_FFNC_P = O_GLA_P + 2097152ull;
constexpr size_t O_MEMK = O_FFNC_P + 720896ull;
constexpr size_t O_MEMV = O_MEMK + 16777216ull;
constexpr size_t O_GDN_S = O_MEMV + 16777216ull;
constexpr size_t O_GDNC_S = O_GDN_S + 2097152ull;
constexpr size_t O_GLA_S = O_GDNC_S + 147456ull;
constexpr size_t O_FFNC_S = O_GLA_S + 1048576ull;
constexpr size_t al256(size_t x) { return (x + 255) & ~(size_t)255; }
constexpr size_t WS_WMIX = 0;
constexpr size_t WM_WIN = 0, WM_WSM = WM_WIN + 5632ull * 1024, WM_WOA = WM_WSM + 32 * 1024, WM_WOB = WM_WOA + 524288, WM_WO = WM_WOB + 524288,
                 WM_WMQ = WM_WO + 1048576, WM_WMK = WM_WMQ + 1048576, WM_WMV = WM_WMK + 1048576, WM_WMO = WM_WMV + 1048576, WM_END = WM_WMO + 1048576;
constexpr size_t WS_WFFN = al256(WS_WMIX + WM_END * 2);
constexpr size_t WF_UP = 0, WF_DN = 5632ull * 1024, WF_END = WF_DN + 1024ull * 2816;
constexpr size_t WS_XB = al256(WS_WFFN + WF_END * 2);
constexpr size_t WS_P = al256(WS_XB + (size_t)TT * 1024 * 2);
constexpr size_t WS_KV = al256(WS_P + (size_t)TT * LDP * 2);
constexpr size_t KV_BYTES = 2ull * 6144 * 1024 * 2;
constexpr size_t WS_MB = al256(WS_KV + KV_BYTES);
constexpr size_t WS_MRS = al256(WS_MB + 4096ull * 1024 * 2);
constexpr size_t WS_SSQ = al256(WS_MRS + 4096 * 4);
constexpr size_t WS_SC = al256(WS_SSQ + (size_t)TT * 16 * 4);
constexpr size_t WS_DL = al256(WS_SC + (size_t)TT * 32 * 4);
constexpr size_t WS_BG = al256(WS_DL + 520ull * 4 * 64 * 4);
constexpr size_t WS_BAR = al256(WS_BG + 520ull * 4 * 128 * 4);
constexpr size_t WS_TOTAL = al256(WS_BAR + 16384);
constexpr int LDS_BYTES = 147456;
constexpr int NPH = 54;
#ifndef PH_HI
#define PH_HI NPH
#define REPMASK 0
#define SYNCREP 1
#define DRYMASK 0
#endif

struct Params { const float* in[33]; float* out; unsigned char* ws; int ph_lo, ph_hi; };

typedef __bf16 bf16x2_t __attribute__((ext_vector_type(2)));
DEV unsigned pk2(float lo, float hi) { f32x2 f = {lo, hi}; bf16x2_t v = __builtin_convertvector(f, bf16x2_t); return __builtin_bit_cast(unsigned, v); }
DEV float bf2f(bf16_t b) { return __uint_as_float(((unsigned)b) << 16); }
DEV float bflo(unsigned u) { return __uint_as_float(u << 16); }
DEV float bfhi(unsigned u) { return __uint_as_float(u & 0xffff0000u); }
DEV u32x2 pk4(f32x4 v) { u32x2 r; r.x = pk2(v[0], v[1]); r.y = pk2(v[2], v[3]); return r; }
DEV f32x4 unpk4(u32x2 u) { return (f32x4){bflo(u.x), bfhi(u.x), bflo(u.y), bfhi(u.y)}; }
DEV bf16x8 mk8(u32x2 a, u32x2 b) { u32x4 t = {a.x, a.y, b.x, b.y}; return __builtin_bit_cast(bf16x8, t); }
DEV float sigm(float x) { return 1.f / (1.f + __expf(-x)); }
DEV float silu(float x) { return x / (1.f + __expf(-x)); }
DEV float softplus(float x) { return x > 20.f ? x : __logf(1.f + __expf(x)); }
DEV float logsigmoid(float x) { return fminf(x, 0.f) - __logf(1.f + __expf(-fabsf(x))); }
DEV float row_rstd(const float* ssq, int row) {
    const f32x4 a = *(const f32x4*)(ssq + (size_t)row * 4), b = *(const f32x4*)(ssq + ((size_t)TT + row) * 4);
    const f32x4 c = *(const f32x4*)(ssq + ((size_t)2 * TT + row) * 4), d = *(const f32x4*)(ssq + ((size_t)3 * TT + row) * 4);
    float s = ((a[0] + a[1]) + (a[2] + a[3])) + ((b[0] + b[1]) + (b[2] + b[3])) + ((c[0] + c[1]) + (c[2] + c[3])) + ((d[0] + d[1]) + (d[2] + d[3]));
    return rsqrtf(s * (1.f / 1024.f) + 1e-6f);
}
DEV bf16x8 ldfragp(const bf16_t* base, int row, int stride, int k0, int fq) {
    const bf16_t* p = base + row * stride + k0 + 4 * fq;
    return mk8(*(const u32x2*)p, *(const u32x2*)(p + 16));
}
DEV bf16x8 ldfrag(const bf16_t* base, int row, int stride, int k0, int fq) {
    return *(const bf16x8*)(base + row * stride + k0 + 8 * fq);
}
#define MFMA16(a, b, c) __builtin_amdgcn_mfma_f32_16x16x32_bf16((a), (b), (c), 0, 0, 0)

constexpr int BM = 256, BK = 64, HALF = 128, HT = HALF * BK;
DEV int lds_byte(int r, int c) { int st = (r >> 4) * 2 + (c >> 5), rr = r & 15, cc = c & 31, ob = rr * 64 + cc * 2; return st * 1024 + (ob ^ (((ob >> 9) & 1) << 5)); }
DEV void stage_rc(int b, int& R, int& C) { int st = b / 1024, sb = b % 1024, swz = sb ^ (((sb >> 9) & 1) << 5); R = (st >> 1) * 16 + swz / 64; C = (st & 1) * 32 + (swz % 64) / 2; }

DEV void gemm_core(const bf16_t* __restrict__ A, int lda, const bf16_t* __restrict__ Bt, int ldb, int K, int brow, int bcol, f32x4 (&acc)[2][2][4][2], bf16_t* shm) {
#define SA(b, h) (shm + ((b) * 2 + (h)) * HT)
#define SB(b, h) (shm + (4 + (b) * 2 + (h)) * HT)
#define STAGE(P, BASE, LD, br, kt) do { const char* _gb = (const char*)((BASE) + (long)(br) * (LD) + (long)(kt) * BK); \
    const unsigned _vo = (unsigned)((sr0 * (int)(LD) + sc0) * 2); \
    for (int _i = 0; _i < 2; ++_i) { \
      __builtin_amdgcn_global_load_lds((const unsigned*)(_gb + (long)(_i * 128) * (LD) + _vo), (unsigned*)((char*)(P) + wbase + _i * 8192), 16, 0, 0); } } while (0)
#define LDA(dst, b, h) for (int m = 0; m < 4; ++m) for (int k = 0; k < 2; ++k) \
    dst[m][k] = *reinterpret_cast<const bf16x8*>((char*)SA(b, h) + lds_byte(wr * 64 + m * 16 + fr, k * 32 + fq * 8))
#define LDB(dst, b, h) for (int n = 0; n < 2; ++n) for (int k = 0; k < 2; ++k) \
    dst[n][k] = *reinterpret_cast<const bf16x8*>((char*)SB(b, h) + lds_byte(wc * 32 + n * 16 + fr, k * 32 + fq * 8))
#define MMA(ai, bj, At_, Bt_) do { __builtin_amdgcn_s_setprio(1); \
    for (int m = 0; m < 4; ++m) for (int n = 0; n < 2; ++n) for (int k = 0; k < 2; ++k) \
      acc[ai][bj][m][n] = __builtin_amdgcn_mfma_f32_16x16x32_bf16(Bt_[n][k], At_[m][k], acc[ai][bj][m][n], 0, 0, 0); \
    __builtin_amdgcn_s_setprio(0); } while (0)
#define WAIT_V(n) asm volatile("s_waitcnt vmcnt(" #n ")" ::: "memory")
#define WAIT_L(n) asm volatile("s_waitcnt lgkmcnt(" #n ")" ::: "memory")
#define BAR __builtin_amdgcn_s_barrier()
#define SCHED __builtin_amdgcn_sched_barrier(0)
    int tidx = threadIdx.x; asm volatile("" : "+v"(tidx));
    const int wid = __builtin_amdgcn_readfirstlane(tidx >> 6), lane = tidx & 63, wr = wid >> 2, wc = wid & 3, fr = lane & 15, fq = lane >> 4;
    const int wbase = wid * 1024;
    int sr0, sc0; stage_rc(tidx * 16, sr0, sc0);
#pragma unroll
    for (int a = 0; a < 2; ++a)
#pragma unroll
        for (int b = 0; b < 2; ++b)
#pragma unroll
            for (int m = 0; m < 4; ++m)
#pragma unroll
                for (int n = 0; n < 2; ++n) acc[a][b][m][n] = (f32x4){0.f, 0.f, 0.f, 0.f};
    bf16x8 At[4][2], B0[2][2], B1[2][2];
    const int nt = K / BK;
    STAGE(SB(0, 0), Bt, ldb, bcol, 0); STAGE(SA(0, 0), A, lda, brow, 0);
    STAGE(SB(0, 1), Bt, ldb, bcol + HALF, 0); STAGE(SA(0, 1), A, lda, brow + HALF, 0);
    if (wr == 1) BAR;
    WAIT_V(4); BAR;
    STAGE(SB(1, 0), Bt, ldb, bcol, 1); STAGE(SA(1, 0), A, lda, brow, 1); STAGE(SB(1, 1), Bt, ldb, bcol + HALF, 1);
    WAIT_V(6); BAR;
    for (int t = 0; t < nt - 2; t += 2) {
        LDB(B0, 0, 0); SCHED; LDA(At, 0, 0); STAGE(SA(1, 1), A, lda, brow + HALF, t + 1);
        WAIT_L(8); BAR; WAIT_L(0); MMA(0, 0, At, B0); BAR; SCHED;
        LDB(B1, 0, 1); STAGE(SB(0, 0), Bt, ldb, bcol, t + 2);
        BAR; WAIT_L(0); MMA(0, 1, At, B1); BAR;
        LDA(At, 0, 1); STAGE(SA(0, 0), A, lda, brow, t + 2);
        BAR; WAIT_L(0); MMA(1, 0, At, B0); BAR; SCHED;
        STAGE(SB(0, 1), Bt, ldb, bcol + HALF, t + 2);
        WAIT_V(6); BAR; MMA(1, 1, At, B1); BAR;
        LDB(B0, 1, 0); SCHED; LDA(At, 1, 0); STAGE(SA(0, 1), A, lda, brow + HALF, t + 2);
        WAIT_L(8); BAR; WAIT_L(0); MMA(0, 0, At, B0); BAR; SCHED;
        LDB(B1, 1, 1); STAGE(SB(1, 0), Bt, ldb, bcol, t + 3);
        BAR; WAIT_L(0); MMA(0, 1, At, B1); BAR;
        LDA(At, 1, 1); STAGE(SA(1, 0), A, lda, brow, t + 3);
        BAR; WAIT_L(0); MMA(1, 0, At, B0); BAR; SCHED;
        STAGE(SB(1, 1), Bt, ldb, bcol + HALF, t + 3);
        WAIT_V(6); BAR; MMA(1, 1, At, B1); BAR;
    }
    { LDB(B0, 0, 0); LDA(At, 0, 0); STAGE(SA(1, 1), A, lda, brow + HALF, nt - 1);
      BAR; WAIT_L(0); MMA(0, 0, At, B0); BAR;
      LDB(B1, 0, 1); BAR; WAIT_L(0); MMA(0, 1, At, B1); BAR;
      LDA(At, 0, 1); WAIT_V(4); BAR; WAIT_L(0); MMA(1, 0, At, B0); MMA(1, 1, At, B1); BAR; }
    { LDB(B0, 1, 0); LDA(At, 1, 0); WAIT_V(2); BAR; WAIT_L(0); MMA(0, 0, At, B0); BAR;
      LDB(B1, 1, 1); WAIT_V(0); BAR; WAIT_L(0); MMA(0, 1, At, B1); BAR;
      LDA(At, 1, 1); BAR; WAIT_L(0); MMA(1, 0, At, B0); MMA(1, 1, At, B1); BAR; }
    if (wr == 0) BAR;
    SCHED;
#undef SA
#undef SB
}

typedef const float* const __attribute__((address_space(4)))* InTab;
struct Frame {
    InTab in; float* out; unsigned char* ws; unsigned char* lds;
    int tid, lane, wid, nb, bid, dry, cb, cn;
};
#define REFRAME Frame F = F0; { int t_ = threadIdx.x; asm volatile("" : "+v"(t_)); F.tid = t_; F.lane = t_ & 63; unsigned char* w_ = F.ws; asm volatile("" : "+s"(w_)); F.ws = w_; float* o_ = F.out; asm volatile("" : "+s"(o_)); F.out = o_; InTab i_ = (InTab)__builtin_amdgcn_kernarg_segment_ptr(); asm volatile("" : "+s"(i_)); F.in = i_; int a_ = F.wid, b_ = F.bid, c_ = F.nb; asm volatile("" : "+s"(a_), "+s"(b_), "+s"(c_)); F.wid = a_; F.bid = b_; F.nb = c_; }

enum { EPI_PROJ = 0, EPI_UP, EPI_RESID, EPI_Q, EPI_MEMK, EPI_MEMV, EPI_OUTA, EPI_OUTB, EPI_SOFTMAX, EPI_ATTNO };
struct GDesc { const bf16_t* A; int lda; const bf16_t* Bt; int ldb; int K, brow, bcol, epi, orow, ocol, head, vai, vwr; };

DEV void cvt_mat(const Frame& F0, const float* src, int ldsrc, int K, int N, int wincols, const float* gain, bf16_t* dst) {
    REFRAME;
    float* T = (float*)F.lds;
    const int nkt = K / 64, nnt = N / 64, ntile = nkt * nnt;
    for (int t = F.cb; t < ntile; t += F.cn) {
        const int kt = t / nnt, ntl = t % nnt, k0 = kt * 64, n0 = ntl * 64;
        int coff = 0; if (wincols == 1) coff = (n0 < 1536) ? 0 : (n0 < 3072 ? 8 : 24);
        if (wincols == 2) { const int tl = n0 >> 8, w = n0 & 255; coff = (w < 128 ? 128 * tl + w : 2816 + 128 * tl + (w - 128)) - n0; }
        __syncthreads();
#pragma unroll
        for (int i = 0; i < 2; ++i) {
            const int kr = (F.tid >> 4) + 32 * i, nc = (F.tid & 15) * 4;
            f32x4 v = *(const f32x4*)(src + (size_t)(k0 + kr) * ldsrc + n0 + coff + nc);
            const float g = gain ? gain[k0 + kr] : 1.f;
            T[kr * 65 + nc + 0] = v[0] * g; T[kr * 65 + nc + 1] = v[1] * g; T[kr * 65 + nc + 2] = v[2] * g; T[kr * 65 + nc + 3] = v[3] * g;
        }
        __syncthreads();
        const int n = F.tid >> 3, kc = (F.tid & 7) * 8;
        u32x4 w;
        w.x = pk2(T[(kc + 0) * 65 + n], T[(kc + 1) * 65 + n]); w.y = pk2(T[(kc + 2) * 65 + n], T[(kc + 3) * 65 + n]);
        w.z = pk2(T[(kc + 4) * 65 + n], T[(kc + 5) * 65 + n]); w.w = pk2(T[(kc + 6) * 65 + n], T[(kc + 7) * 65 + n]);
        *(u32x4*)(dst + (size_t)(n0 + n) * K + k0 + kc) = w;
    }
    __syncthreads();
}
DEV void cvt_mixer(const Frame& F0, int l) {
    REFRAME;
    InTab in = F.in;
    cvt_mat(F, in[10] + (size_t)l * 1024 * 5656, 5656, 1024, 5632, 1, in[9] + l * 1024, ((bf16_t*)(F.ws + WS_WMIX)) + WM_WIN);
    cvt_mat(F, in[18] + (size_t)l * 512 * 1024, 1024, 512, 1024, 0, nullptr, ((bf16_t*)(F.ws + WS_WMIX)) + WM_WOA);
    cvt_mat(F, in[19] + (size_t)l * 512 * 1024, 1024, 512, 1024, 0, nullptr, ((bf16_t*)(F.ws + WS_WMIX)) + WM_WOB);
    cvt_mat(F, in[20] + (size_t)l * 1048576, 1024, 1024, 1024, 0, nullptr, ((bf16_t*)(F.ws + WS_WMIX)) + WM_WO);
    cvt_mat(F, in[23] + (size_t)l * 1048576, 1024, 1024, 1024, 0, in[21] + l * 1024, ((bf16_t*)(F.ws + WS_WMIX)) + WM_WMQ);
    cvt_mat(F, in[24] + (size_t)l * 1048576, 1024, 1024, 1024, 0, in[22] + l * 1024, ((bf16_t*)(F.ws + WS_WMIX)) + WM_WMK);
    cvt_mat(F, in[25] + (size_t)l * 1048576, 1024, 1024, 1024, 0, in[22] + l * 1024, ((bf16_t*)(F.ws + WS_WMIX)) + WM_WMV);
    cvt_mat(F, in[26] + (size_t)l * 1048576, 1024, 1024, 1024, 0, nullptr, ((bf16_t*)(F.ws + WS_WMIX)) + WM_WMO);
    const float* win = in[10] + (size_t)l * 1024 * 5656; const float* g = in[9] + l * 1024;
    for (int i = F.cb * 512 + F.tid; i < 32 * 1024; i += F.cn * 512) {
        const int n = i >> 10, k = i & 1023;
        float v = 0.f;
        if (n < 8) v = win[(size_t)k * 5656 + 1536 + n] * g[k]; else if (n < 24) v = win[(size_t)k * 5656 + 3080 + (n - 8)] * g[k];
        ((bf16_t*)(F.ws + WS_WMIX))[WM_WSM + i] = (bf16_t)(pk2(v, 0.f) & 0xffff);
    }
}
DEV void cvt_ffn(const Frame& F, int l) {
    cvt_mat(F, F.in[28] + (size_t)l * 1024 * 5632, 5632, 1024, 5632, 2, F.in[27] + l * 1024, ((bf16_t*)(F.ws + WS_WFFN)) + WF_UP);
    cvt_mat(F, F.in[31] + (size_t)l * 2816 * 1024, 1024, 2816, 1024, 0, nullptr, ((bf16_t*)(F.ws + WS_WFFN)) + WF_DN);
}

DEV void phase0(const Frame& F0) {
    REFRAME;
    const int gw = F.bid * 8 + F.wid, nw = F.nb * 8, lane = F.lane;
    for (int row = gw; row < TT + 4096; row += nw) {
        const bool ismem = row >= TT;
        const float* src = ismem ? F.in[8] + (size_t)(row - TT) * 1024 : (row < 32768 ? F.in[0] + (size_t)row * 1024 : F.in[1] + (size_t)(row - 32768) * 1024);
        f32x4 v[4]; float s = 0.f;
#pragma unroll
        for (int i = 0; i < 4; ++i) { v[i] = *(const f32x4*)(src + lane * 16 + i * 4); s += v[i][0] * v[i][0] + v[i][1] * v[i][1] + v[i][2] * v[i][2] + v[i][3] * v[i][3]; }
        u32x4 w0, w1;
        w0.x = pk2(v[0][0], v[0][1]); w0.y = pk2(v[0][2], v[0][3]); w0.z = pk2(v[1][0], v[1][1]); w0.w = pk2(v[1][2], v[1][3]);
        w1.x = pk2(v[2][0], v[2][1]); w1.y = pk2(v[2][2], v[2][3]); w1.z = pk2(v[3][0], v[3][1]); w1.w = pk2(v[3][2], v[3][3]);
        s += __shfl_xor(s, 1); s += __shfl_xor(s, 2);
        if (!ismem) {
            float* X = F.out + (size_t)row * 1024 + lane * 16;
#pragma unroll
            for (int i = 0; i < 4; ++i) *(f32x4*)(X + i * 4) = v[i];
            bf16_t* xb = ((bf16_t*)(F.ws + WS_XB)) + (size_t)row * 1024 + lane * 16;
            *(u32x4*)xb = w0; *(u32x4*)(xb + 8) = w1;
            if ((lane & 3) == 0) ((float*)(F.ws + WS_SSQ))[((size_t)(lane >> 4) * TT + row) * 4 + ((lane >> 2) & 3)] = s;
        } else {
            const int mr = row - TT;
            bf16_t* mb = ((bf16_t*)(F.ws + WS_MB)) + (size_t)mr * 1024 + lane * 16;
            *(u32x4*)mb = w0; *(u32x4*)(mb + 8) = w1;
            s += __shfl_xor(s, 4); s += __shfl_xor(s, 8); s += __shfl_xor(s, 16); s += __shfl_xor(s, 32);
            if (lane == 0) ((float*)(F.ws + WS_MRS))[mr] = rsqrtf(s * (1.f / 1024.f) + 1e-6f);
        }
    }
    cvt_mixer(F, 0);
    cvt_ffn(F, 0);
}

DEV void small_proj(const Frame& F0) {
    REFRAME;
    const int lane = F.lane, fr = lane & 15, fq = lane >> 4, mt = F.wid & 3, nt = F.wid >> 2;
    const bool part = F.nb == 256;
    if (part && (F.bid >> 3) < 6) return;
    for (int c = part ? ((F.bid >> 3) - 6) * 8 + (F.bid & 7) : F.bid; c < NCH; c += part ? 208 : F.nb) {
        const int row = c * 64 + mt * 16 + fr;
        const bf16_t* a = ((bf16_t*)(F.ws + WS_XB)) + (size_t)row * 1024 + 8 * fq;
        const bf16_t* b = ((bf16_t*)(F.ws + WS_WMIX)) + WM_WSM + (size_t)(nt * 16 + fr) * 1024 + 8 * fq;
        f32x4 acc = {0.f, 0.f, 0.f, 0.f};
#pragma unroll 4
        for (int k = 0; k < 32; ++k) acc = MFMA16(*(const bf16x8*)(b + k * 32), *(const bf16x8*)(a + k * 32), acc);
        const float rs = row_rstd(((float*)(F.ws + WS_SSQ)), row);
        *(f32x4*)(((float*)(F.ws + WS_SC)) + (size_t)row * 32 + nt * 16 + 4 * fq) = acc * rs;
    }
}

DEV void gemm_epilogue(const Frame& F0, const GDesc& d, int l, f32x4 (&acc)[2][2][4][2]) {
    REFRAME;
    int lane_ = F.lane; asm volatile("" : "+v"(lane_));
    const int wr = F.wid >> 2, wc = F.wid & 3, fr = lane_ & 15, fq = lane_ >> 4;
    float* red = (float*)(F.lds + 131072);
    if (d.epi == EPI_SOFTMAX) {
        float mx[2][4];
#pragma unroll
        for (int ai = 0; ai < 2; ++ai)
#pragma unroll
            for (int m = 0; m < 4; ++m) {
                float v = -3.0e38f;
#pragma unroll
                for (int bj = 0; bj < 2; ++bj)
#pragma unroll
                    for (int n = 0; n < 2; ++n) { const f32x4 x = acc[ai][bj][m][n]; v = fmaxf(v, fmaxf(fmaxf(x[0], x[1]), fmaxf(x[2], x[3]))); }
                v = fmaxf(v, __shfl_xor(v, 16)); v = fmaxf(v, __shfl_xor(v, 32));
                if (fq == 0) red[(ai * 128 + wr * 64 + m * 16 + fr) * 4 + wc] = v;
            }
        __syncthreads();
#pragma unroll
        for (int ai = 0; ai < 2; ++ai)
#pragma unroll
            for (int m = 0; m < 4; ++m) {
                const f32x4 r4 = *(const f32x4*)(red + (ai * 128 + wr * 64 + m * 16 + fr) * 4);
                const float rm = fmaxf(fmaxf(r4[0], r4[1]), fmaxf(r4[2], r4[3]));
                mx[ai][m] = rm; float s = 0.f;
#pragma unroll
                for (int bj = 0; bj < 2; ++bj)
#pragma unroll
                    for (int n = 0; n < 2; ++n) { f32x4 x = acc[ai][bj][m][n];
#pragma unroll
                        for (int j = 0; j < 4; ++j) { x[j] = __expf(x[j] - rm); s += x[j]; }
                        acc[ai][bj][m][n] = x; }
                s += __shfl_xor(s, 16); s += __shfl_xor(s, 32);
                if (fq == 0) red[1024 + (ai * 128 + wr * 64 + m * 16 + fr) * 4 + wc] = s;
            }
        (void)mx;
        __syncthreads();
#pragma unroll
        for (int ai = 0; ai < 2; ++ai)
#pragma unroll
            for (int m = 0; m < 4; ++m) {
                const f32x4 r4 = *(const f32x4*)(red + 1024 + (ai * 128 + wr * 64 + m * 16 + fr) * 4);
                const float inv = 1.f / ((r4[0] + r4[1]) + (r4[2] + r4[3]));
                const bool valid = d.vai < 0 || (d.vai == ai && d.vwr == wr);
                const int row = d.orow + ai * 128 + wr * 64 + m * 16 + fr;
                if (valid) {
#pragma unroll
                    for (int bj = 0; bj < 2; ++bj)
#pragma unroll
                        for (int n = 0; n < 2; ++n) {
                            const int col = bj * 128 + wc * 32 + n * 16 + fq * 4;
                            *(u32x2*)(((bf16_t*)(F.ws + WS_P)) + (size_t)row * LDP + C_PR + d.head * 256 + col) = pk4(acc[ai][bj][m][n] * inv);
                        }
                }
            }
        __syncthreads();
        return;
    }
#pragma unroll
    for (int ai = 0; ai < 2; ++ai)
#pragma unroll
        for (int m = 0; m < 4; ++m) {
            const int row = d.orow + ai * 128 + wr * 64 + m * 16 + fr;
            float rs = 1.f, ss = 0.f;
            if (d.epi == EPI_PROJ || d.epi == EPI_UP || d.epi == EPI_Q) rs = row_rstd(((float*)(F.ws + WS_SSQ)), row);
            if (d.epi == EPI_Q) rs *= 0.0625f;
            if (d.epi == EPI_MEMK) rs = ((float*)(F.ws + WS_MRS))[row];
#pragma unroll
            for (int bj = 0; bj < 2; ++bj)
#pragma unroll
                for (int n = 0; n < 2; ++n) {
                    const int col = d.ocol + bj * 128 + wc * 32 + n * 16 + fq * 4;
                    f32x4 v = acc[ai][bj][m][n];
                    switch (d.epi) {
                    case EPI_UP: {
                        const int row_l = ai * 128 + wr * 64 + m * 16 + fr, cl = bj * 128 + wc * 32 + n * 16 + fq * 4;
                        *(u32x2*)((bf16_t*)F.lds + row_l * 264 + cl) = pk4(v * rs);
                    } break;
                    case EPI_PROJ: {
                        v = v * rs; const u32x2 w = pk4(v);
                        *(u32x2*)(((bf16_t*)(F.ws + WS_P)) + (size_t)row * LDP + col) = w;
                        if (m == 3 && fr >= 13 && col < 1536) {
                            const int chunk = row >> 6, hr = fr - 13;
                            *(u32x2*)(((bf16_t*)(F.ws + WS_KV)) + ((size_t)chunk * 3 + hr) * 1536 + col) = w;
                            if (chunk >= 512 || (chunk & 31) == 31) {
                                float* o = chunk < 512 ? F.out + O_GDNC_P + ((size_t)(l * 16 + (chunk >> 5)) * 3 + hr) * 1536 + col
                                                       : F.out + O_GDNC_S + ((size_t)(l * 8 + (chunk - 512)) * 3 + hr) * 1536 + col;
                                *(f32x4*)o = v;
                            }
                        }
                    } break;
                    case EPI_RESID: {
                        float* X = F.out + (size_t)row * 1024 + col;
                        f32x4 x = *(const f32x4*)X; x = x + v; *(f32x4*)X = x;
                        *(u32x2*)(((bf16_t*)(F.ws + WS_XB)) + (size_t)row * 1024 + col) = pk4(x);
                        ss += (x[0] * x[0] + x[1] * x[1]) + (x[2] * x[2] + x[3] * x[3]);
                    } break;
                    case EPI_Q: *(u32x2*)(((bf16_t*)(F.ws + WS_P)) + (size_t)row * LDP + C_Q + col) = pk4(v * rs); break;
                    case EPI_MEMK: {
                        v = v * rs;
                        *(f32x4*)(F.out + O_MEMK + ((size_t)l * 4096 + row) * 1024 + col) = v;
                        *(u32x2*)(((bf16_t*)(F.ws + WS_KV)) + (size_t)row * 1024 + col) = pk4(v);
                    } break;
                    case EPI_MEMV: {
                        const f32x4 r4 = *(const f32x4*)(((float*)(F.ws + WS_MRS)) + col);
                        v = v * r4;
                        float* o = F.out + O_MEMV + ((size_t)l * 4096 + col) * 1024 + row;
                        o[0] = v[0]; o[1024] = v[1]; o[2048] = v[2]; o[3072] = v[3];
                        const int b = col >> 8, h = row >> 8;
                        *(u32x2*)(((bf16_t*)(F.ws + WS_KV + 6144ull * 1024 * 2)) + ((size_t)(b * 4 + h) * 256 + (row & 255)) * 256 + (col & 255)) = pk4(v);
                    } break;
                    case EPI_OUTA: {
                        const f32x4 g = unpk4(*(const u32x2*)(((bf16_t*)(F.ws + WS_P)) + (size_t)row * LDP + C_GA + col));
                        f32x4 o; for (int j = 0; j < 4; ++j) o[j] = sigm(g[j]) * v[j];
                        *(u32x2*)(((bf16_t*)(F.ws + WS_P)) + (size_t)row * LDP + C_MRG + col) = pk4(o);
                    } break;
                    case EPI_OUTB: {
                        const f32x4 g = unpk4(*(const u32x2*)(((bf16_t*)(F.ws + WS_P)) + (size_t)row * LDP + C_GB + col));
                        f32x4 o = unpk4(*(const u32x2*)(((bf16_t*)(F.ws + WS_P)) + (size_t)row * LDP + C_MRG + col));
                        for (int j = 0; j < 4; ++j) o[j] += sigm(g[j]) * v[j];
                        *(u32x2*)(((bf16_t*)(F.ws + WS_P)) + (size_t)row * LDP + C_MRG + col) = pk4(o);
                    } break;
                    case EPI_ATTNO: {
                        const bool valid = d.vai < 0 || (d.vai == ai && d.vwr == wr);
                        if (valid) *(u32x2*)(((bf16_t*)(F.ws + WS_P)) + (size_t)row * LDP + C_O + d.head * 256 + col) = pk4(v);
                    } break;
                    default: break;
                    }
                }
            if (d.epi == EPI_RESID) {
                ss += __shfl_xor(ss, 16); ss += __shfl_xor(ss, 32);
                if (fq == 0) ((float*)(F.ws + WS_SSQ))[((size_t)(d.ocol >> 8) * TT + row) * 4 + wc] = ss;
            }
        }
    if (d.epi == EPI_UP) {
        bf16_t* ST = (bf16_t*)F.lds;
        const int pm = d.brow >> 8, pn = d.bcol >> 8;
        const bool samp = pm >= 128, needfix = !samp && (pm & 7) != 0;
        bf16_t* halo = ((bf16_t*)(F.ws + WS_KV)); bf16_t* raw01 = ((bf16_t*)(F.ws + WS_KV + 11714560ull));
        __syncthreads();
        {
            const int hsel = F.tid >> 6, cl4 = (F.tid & 63) * 4, ocol = ((cl4 >> 7) ? 2816 : 0) + 128 * pn + (cl4 & 127);
            const int row_l = (hsel >> 1) * 64 + 62 + (hsel & 1), chunk = (d.brow + row_l) >> 6, hr = hsel & 1;
            const u32x2 w = *(const u32x2*)(ST + row_l * 264 + cl4);
            *(u32x2*)(halo + ((size_t)chunk * 2 + hr) * 5632 + ocol) = w;
            if (chunk >= 512 || (chunk & 31) == 31) {
                float* o = chunk < 512 ? F.out + O_FFNC_P + ((size_t)(l * 16 + (chunk >> 5)) * 2 + hr) * 5632 + ocol
                                       : F.out + O_FFNC_S + ((size_t)(l * 8 + (chunk - 512)) * 2 + hr) * 5632 + ocol;
                *(f32x4*)o = unpk4(w);
            }
            if (needfix && hsel < 2) *(u32x2*)(raw01 + ((size_t)pm * 2 + hsel) * 5632 + ocol) = *(const u32x2*)(ST + hsel * 264 + cl4);
        }
        {
            const int cq = F.tid & 31, rg = F.tid >> 5, c4 = cq * 4, gcol = 128 * pn + c4, r0 = rg * 16;
            const float* cw = F.in[29] + (size_t)l * 3 * 5632; const float* cb = F.in[30] + (size_t)l * 5632;
            const f32x4 wg0 = *(const f32x4*)(cw + gcol), wg1 = *(const f32x4*)(cw + 5632 + gcol), wg2 = *(const f32x4*)(cw + 2 * 5632 + gcol), bg = *(const f32x4*)(cb + gcol);
            const f32x4 wv0 = *(const f32x4*)(cw + 2816 + gcol), wv1 = *(const f32x4*)(cw + 5632 + 2816 + gcol), wv2 = *(const f32x4*)(cw + 2 * 5632 + 2816 + gcol), bv = *(const f32x4*)(cb + 2816 + gcol);
            f32x4 g2 = {0.f, 0.f, 0.f, 0.f}, g1 = g2, v2 = g2, v1 = g2; bool skip2 = false;
            if ((samp ? (r0 & 63) : r0) != 0) {
                g2 = unpk4(*(const u32x2*)(ST + (r0 - 2) * 264 + c4)); g1 = unpk4(*(const u32x2*)(ST + (r0 - 1) * 264 + c4));
                v2 = unpk4(*(const u32x2*)(ST + (r0 - 2) * 264 + 128 + c4)); v1 = unpk4(*(const u32x2*)(ST + (r0 - 1) * 264 + 128 + c4));
            } else if (samp) {
                const float* sp = F.in[5] + (size_t)(l * 8 + (((d.brow + r0) >> 6) - 512)) * 2 * 5632;
                g2 = *(const f32x4*)(sp + gcol); g1 = *(const f32x4*)(sp + 5632 + gcol); v2 = *(const f32x4*)(sp + 2816 + gcol); v1 = *(const f32x4*)(sp + 5632 + 2816 + gcol);
            } else skip2 = needfix;
#pragma unroll 4
            for (int i = 0; i < 16; ++i) {
                const int row_l = r0 + i;
                const f32x4 g0 = unpk4(*(const u32x2*)(ST + row_l * 264 + c4)), v0 = unpk4(*(const u32x2*)(ST + row_l * 264 + 128 + c4));
                f32x4 o;
#pragma unroll
                for (int j = 0; j < 4; ++j) { const float yg = wg0[j] * g2[j] + wg1[j] * g1[j] + wg2[j] * g0[j] + bg[j], yv = wv0[j] * v2[j] + wv1[j] * v1[j] + wv2[j] * v0[j] + bv[j]; o[j] = silu(yg) * yv; }
                if (!(skip2 && i < 2)) *(u32x2*)(((bf16_t*)(F.ws + WS_P)) + (size_t)(d.brow + row_l) * LDP + gcol) = pk4(o);
                g2 = g1; g1 = g0; v2 = v1; v1 = v0;
            }
        }
        __syncthreads();
    }
}

DEV void sample_rows_gemm(const Frame& F0, const bf16_t* A, int lda, const bf16_t* Bt, int K, int resid) {
    REFRAME;
    if (F.nb != 256) return;
    const int fr = F.lane & 15, fq = F.lane >> 4, w = F.wid, rgp = F.bid >> 3, cg = F.bid & 7;
    const int row = 32768 + rgp * 16 + fr, colt = cg * 128 + w * 16;
    const bf16_t* ap = A + (size_t)row * lda + 8 * fq;
    const bf16_t* bp = Bt + (size_t)(colt + fr) * K + 8 * fq;
    f32x4 acc = {0.f, 0.f, 0.f, 0.f};
#pragma unroll 8
    for (int k = 0; k < K; k += 32) acc = MFMA16(*(const bf16x8*)(bp + k), *(const bf16x8*)(ap + k), acc);
    const int col = colt + 4 * fq;
    if (resid == 1) {
        float* X = F.out + (size_t)row * 1024 + col;
        f32x4 x = *(const f32x4*)X; x = x + acc; *(f32x4*)X = x;
        *(u32x2*)(((bf16_t*)(F.ws + WS_XB)) + (size_t)row * 1024 + col) = pk4(x);
        float ss = (x[0] * x[0] + x[1] * x[1]) + (x[2] * x[2] + x[3] * x[3]);
        ss += __shfl_xor(ss, 16); ss += __shfl_xor(ss, 32);
        float* red = (float*)F.lds;
        __syncthreads();
        if (fq == 0) red[fr * 8 + w] = ss;
        __syncthreads();
        if (F.tid < 32) {
            const int r = F.tid & 15, g = F.tid >> 4, c0 = cg * 128 + g * 64;
            const float t = (red[r * 8 + g * 4] + red[r * 8 + g * 4 + 1]) + (red[r * 8 + g * 4 + 2] + red[r * 8 + g * 4 + 3]);
            ((float*)(F.ws + WS_SSQ))[((size_t)(c0 >> 8) * TT + 32768 + rgp * 16 + r) * 4 + ((c0 >> 6) & 3)] = t;
        }
        __syncthreads();
    } else if (resid == 0) {
        const float rs = row_rstd(((float*)(F.ws + WS_SSQ)), row) * 0.0625f;
        *(u32x2*)(((bf16_t*)(F.ws + WS_P)) + (size_t)row * LDP + C_Q + col) = pk4(acc * rs);
    } else {
        bf16_t* prow = ((bf16_t*)(F.ws + WS_P)) + (size_t)row * LDP;
        const f32x4 g = unpk4(*(const u32x2*)(prow + (resid == 2 ? C_GA : C_GB) + col));
        f32x4 o = {0.f, 0.f, 0.f, 0.f};
        if (resid == 3) o = unpk4(*(const u32x2*)(prow + C_MRG + col));
#pragma unroll
        for (int j = 0; j < 4; ++j) o[j] += sigm(g[j]) * acc[j];
        *(u32x2*)(prow + C_MRG + col) = pk4(o);
    }
}

enum { GP_IN = 0, GP_OUT, GP_WO, GP_MQ, GP_ATTN, GP_MO, GP_UP, GP_DOWN, GP_ATTN2, GP_OUT2, GP_MEMKV };
DEV void gemm_phase(const Frame& F0, int kind, int l) {
    REFRAME;
    int nunits = 0;
    switch (kind) { case GP_IN: case GP_UP: nunits = 130 * 22; break; case GP_OUT: nunits = 520 + 128; break; case GP_OUT2: nunits = 520; break; case GP_ATTN: case GP_ATTN2: nunits = 512 + 32; break; default: nunits = 520; }
    const bool srow = (F.nb == 256) && (kind == GP_WO || kind == GP_MQ || kind == GP_MO || kind == GP_DOWN || kind == GP_OUT || kind == GP_OUT2);
    if (srow) nunits = 512;
    if (kind == GP_MEMKV) nunits = 128;
    f32x4 acc[2][2][4][2];
    const bool xmap = (F.nb == 256) && (kind == GP_IN || kind == GP_UP || kind == GP_WO || kind == GP_MQ || kind == GP_MO || kind == GP_DOWN || kind == GP_OUT2 || (kind == GP_OUT && srow));
    const int xcd = F.bid & 7, slot = F.bid >> 3, w_lo = (int)(((long)nunits * xcd) >> 3), w_hi = (int)(((long)nunits * (xcd + 1)) >> 3);
    const bool mkv = kind == GP_MEMKV;
    for (int u0 = mkv ? (F.bid >= 192 ? F.bid - 192 : nunits) : (xmap ? w_lo + slot : F.bid); u0 < (xmap ? w_hi : nunits); u0 += mkv ? 64 : (xmap ? 32 : F.nb)) {
        for (int sb = 0; sb < ((kind == GP_OUT && srow) ? 2 : 1); ++sb) {
        int u = u0;
        if (xmap) { const int nn = (kind == GP_IN || kind == GP_UP) ? 22 : 4; const int nm = srow ? 128 : 130; const int pn_ = u0 / nm, pm_ = u0 % nm; u = pm_ * nn + pn_; }
        GDesc d;
        { const int sub = (kind == GP_ATTN2 || kind == GP_OUT2 || sb) ? 1 : 0;
            d.vai = -1; d.vwr = 0; d.head = 0;
            switch (kind) {
            case GP_IN: { const int pm = u / 22, pn = u % 22; d.A = ((bf16_t*)(F.ws + WS_XB)); d.lda = 1024; d.Bt = ((bf16_t*)(F.ws + WS_WMIX)) + WM_WIN; d.ldb = 1024; d.K = 1024; d.brow = pm * 256; d.bcol = pn * 256; d.epi = EPI_PROJ; d.orow = d.brow; d.ocol = d.bcol; } break;
            case GP_UP: { const int pm = u / 22, pn = u % 22; d.A = ((bf16_t*)(F.ws + WS_XB)); d.lda = 1024; d.Bt = ((bf16_t*)(F.ws + WS_WFFN)) + WF_UP; d.ldb = 1024; d.K = 1024; d.brow = pm * 256; d.bcol = pn * 256; d.epi = EPI_UP; d.orow = d.brow; d.ocol = d.bcol; } break;
            case GP_MEMKV: case GP_OUT: case GP_OUT2:
                if (kind == GP_MEMKV) u += 520;
                if (u < 520) { const int pm = u >> 2, pn = u & 3; d.A = ((bf16_t*)(F.ws + WS_P)) + (sub == 0 ? C_ZA : C_ZB); d.lda = LDP; d.Bt = ((bf16_t*)(F.ws + WS_WMIX)) + (sub == 0 ? WM_WOA : WM_WOB); d.ldb = 512; d.K = 512;
                               d.brow = pm * 256; d.bcol = pn * 256; d.epi = sub == 0 ? EPI_OUTA : EPI_OUTB; d.orow = d.brow; d.ocol = d.bcol; }
                else if (u < 520 + 64) { const int v = u - 520, pm = v >> 2, pn = v & 3; d.A = ((bf16_t*)(F.ws + WS_MB)); d.lda = 1024; d.Bt = ((bf16_t*)(F.ws + WS_WMIX)) + WM_WMK; d.ldb = 1024; d.K = 1024; d.brow = pm * 256; d.bcol = pn * 256; d.epi = EPI_MEMK; d.orow = d.brow; d.ocol = d.bcol; }
                else { const int v = u - 584, pm = v & 3, pn = v >> 2; d.A = ((bf16_t*)(F.ws + WS_WMIX)) + WM_WMV; d.lda = 1024; d.Bt = ((bf16_t*)(F.ws + WS_MB)); d.ldb = 1024; d.K = 1024; d.brow = pm * 256; d.bcol = pn * 256; d.epi = EPI_MEMV; d.orow = d.brow; d.ocol = d.bcol; }
                break;
            case GP_WO: { const int pm = u >> 2, pn = u & 3; d.A = ((bf16_t*)(F.ws + WS_P)) + C_MRG; d.lda = LDP; d.Bt = ((bf16_t*)(F.ws + WS_WMIX)) + WM_WO; d.ldb = 1024; d.K = 1024; d.brow = pm * 256; d.bcol = pn * 256; d.epi = EPI_RESID; d.orow = d.brow; d.ocol = d.bcol; } break;
            case GP_MQ: { const int pm = u >> 2, pn = u & 3; d.A = ((bf16_t*)(F.ws + WS_XB)); d.lda = 1024; d.Bt = ((bf16_t*)(F.ws + WS_WMIX)) + WM_WMQ; d.ldb = 1024; d.K = 1024; d.brow = pm * 256; d.bcol = pn * 256; d.epi = EPI_Q; d.orow = d.brow; d.ocol = d.bcol; } break;
            case GP_MO: { const int pm = u >> 2, pn = u & 3; d.A = ((bf16_t*)(F.ws + WS_P)) + C_O; d.lda = LDP; d.Bt = ((bf16_t*)(F.ws + WS_WMIX)) + WM_WMO; d.ldb = 1024; d.K = 1024; d.brow = pm * 256; d.bcol = pn * 256; d.epi = EPI_RESID; d.orow = d.brow; d.ocol = d.bcol; } break;
            case GP_DOWN: { const int pm = u >> 2, pn = u & 3; d.A = ((bf16_t*)(F.ws + WS_P)); d.lda = LDP; d.Bt = ((bf16_t*)(F.ws + WS_WFFN)) + WF_DN; d.ldb = 2816; d.K = 2816; d.brow = pm * 256; d.bcol = pn * 256; d.epi = EPI_RESID; d.orow = d.brow; d.ocol = d.bcol; } break;
            case GP_ATTN: case GP_ATTN2: {
                int pm, h, b;
                if (u < 512) { pm = u >> 2; h = u & 3; b = pm >> 3; }
                else { const int v = u - 512; h = v & 3; const int bi = (v >> 2) & 3, t = v >> 4; pm = 128 + t; b = 16 + 4 * t + bi; d.vai = bi >> 1; d.vwr = bi & 1; }
                d.head = h; d.brow = pm * 256; d.orow = d.brow; d.ocol = 0; d.K = 256; d.bcol = 0;
                if (sub == 0) { d.A = ((bf16_t*)(F.ws + WS_P)) + C_Q + h * 256; d.lda = LDP; d.Bt = ((bf16_t*)(F.ws + WS_KV)) + (size_t)b * 256 * 1024 + h * 256; d.ldb = 1024; d.epi = EPI_SOFTMAX; }
                else { d.A = ((bf16_t*)(F.ws + WS_P)) + C_PR + h * 256; d.lda = LDP; d.Bt = ((bf16_t*)(F.ws + WS_KV + 6144ull * 1024 * 2)) + (size_t)(b * 4 + h) * 65536; d.ldb = 256; d.epi = EPI_ATTNO; }
            } break;
            }
        }
        if (sb) { asm volatile("s_waitcnt vmcnt(0)" ::: "memory"); __syncthreads(); }
        gemm_core(d.A, d.lda, d.Bt, d.ldb, d.K, d.brow, d.bcol, acc, (bf16_t*)F.lds);
        gemm_epilogue(F, d, l, acc);
        }
    }
    if (srow) {
        __syncthreads();
        if (kind == GP_WO) sample_rows_gemm(F, ((bf16_t*)(F.ws + WS_P)) + C_MRG, LDP, ((bf16_t*)(F.ws + WS_WMIX)) + WM_WO, 1024, 1);
        else if (kind == GP_MQ) sample_rows_gemm(F, ((bf16_t*)(F.ws + WS_XB)), 1024, ((bf16_t*)(F.ws + WS_WMIX)) + WM_WMQ, 1024, 0);
        else if (kind == GP_OUT) { sample_rows_gemm(F, ((bf16_t*)(F.ws + WS_P)) + C_ZA, LDP, ((bf16_t*)(F.ws + WS_WMIX)) + WM_WOA, 512, 2); asm volatile("s_waitcnt vmcnt(0)" ::: "memory");
                                   sample_rows_gemm(F, ((bf16_t*)(F.ws + WS_P)) + C_ZB, LDP, ((bf16_t*)(F.ws + WS_WMIX)) + WM_WOB, 512, 3); }
        else if (kind == GP_OUT2) sample_rows_gemm(F, ((bf16_t*)(F.ws + WS_P)) + C_ZB, LDP, ((bf16_t*)(F.ws + WS_WMIX)) + WM_WOB, 512, 3);
        else if (kind == GP_MO) sample_rows_gemm(F, ((bf16_t*)(F.ws + WS_P)) + C_O, LDP, ((bf16_t*)(F.ws + WS_WMIX)) + WM_WMO, 1024, 1);
        else sample_rows_gemm(F, ((bf16_t*)(F.ws + WS_P)), LDP, ((bf16_t*)(F.ws + WS_WFFN)) + WF_DN, 2816, 1);
    }
}

DEV void sample_kv(const Frame& F0, int l) {
    REFRAME;
    const float* ck = F.in[6] + (size_t)l * 2097152; const float* cv = F.in[7] + (size_t)l * 2097152;
    const bool idle = F.nb == 256;
    if (idle && F.bid < 192) return;
    for (int i = (idle ? F.bid - 192 : F.bid) * 512 + F.tid; i < 262144; i += (idle ? 64 : F.nb) * 512) {
        const f32x4 a = *(const f32x4*)(ck + (size_t)i * 8), b = *(const f32x4*)(ck + (size_t)i * 8 + 4);
        u32x4 w; w.x = pk2(a[0], a[1]); w.y = pk2(a[2], a[3]); w.z = pk2(b[0], b[1]); w.w = pk2(b[2], b[3]);
        *(u32x4*)(((bf16_t*)(F.ws + WS_KV)) + 4096ull * 1024 + (size_t)i * 8) = w;
        const int dd = i & 255, m8 = (i >> 8) & 31, h = (i >> 13) & 3, bb = i >> 15;
        const float* s = cv + ((size_t)(bb * 256 + m8 * 8) * 4 + h) * 256 + dd;
        u32x4 x; x.x = pk2(s[0], s[1024]); x.y = pk2(s[2048], s[3072]); x.z = pk2(s[4096], s[5120]); x.w = pk2(s[6144], s[7168]);
        *(u32x4*)(((bf16_t*)(F.ws + WS_KV + 6144ull * 1024 * 2)) + ((size_t)((16 + bb) * 4 + h) * 256 + dd) * 256 + m8 * 8) = x;
    }
}

DEV void g1_gdn(const Frame& F0, int l, int c, int h) {
    REFRAME;
    float* Fq = (float*)F.lds;
    bf16_t* VS = (bf16_t*)(F.lds + 66560);
    bf16_t* QN = (bf16_t*)(F.lds + 82944);
    bf16_t* KN = (bf16_t*)(F.lds + 100352);
    float* AM = (float*)(F.lds + 117760);
    float* sB = (float*)(F.lds + 135168); float* sG = sB + 64; float* sRQ = sB + 128; float* sRK = sB + 192;
    const int tid = F.tid, lane = F.lane, t0 = c * 64;
    const bool first = c >= 512 || (c & 31) == 0; const bool sample = c >= 512;
    __syncthreads();
    if (F.wid == 7) {
        const int t = t0 + lane;
        const float braw = ((float*)(F.ws + WS_SC))[(size_t)t * 32 + h], araw = ((float*)(F.ws + WS_SC))[(size_t)t * 32 + 4 + h];
        const float beta = sigm(braw);
        float g = -__expf(F.in[12][l * 4 + h]) * softplus(araw + F.in[13][l * 4 + h]);
#pragma unroll
        for (int off = 1; off < 64; off <<= 1) { const float n = __shfl_up(g, off); if (lane >= off) g += n; }
        sB[lane] = beta; sG[lane] = g;
        if (!F.dry) ((float*)(F.ws + WS_BG))[((size_t)c * 4 + h) * 128 + lane] = beta; if (!F.dry) ((float*)(F.ws + WS_BG))[((size_t)c * 4 + h) * 128 + 64 + lane] = g;
    }
    const float* cw = F.in[11] + (size_t)l * 4 * 1536;
    if (tid < 384) {
        const int cp = tid % 192, rh = tid / 192, which = cp >> 6, cc = (cp & 63) * 2, pcol = which * 512 + h * 128 + cc;
        const f32x2 w0 = *(const f32x2*)(cw + pcol), w1 = *(const f32x2*)(cw + 1536 + pcol), w2 = *(const f32x2*)(cw + 2 * 1536 + pcol), w3 = *(const f32x2*)(cw + 3 * 1536 + pcol);
        float x0[35], x1[35];
#pragma unroll
        for (int i = 0; i < 3; ++i) {
            x0[i] = 0.f; x1[i] = 0.f;
            if (rh == 1) { const unsigned u = *(const unsigned*)(((bf16_t*)(F.ws + WS_P)) + (size_t)(t0 + 29 + i) * LDP + pcol); x0[i] = bflo(u); x1[i] = bfhi(u); }
            else if (!first) { const unsigned u = *(const unsigned*)(((bf16_t*)(F.ws + WS_KV)) + ((size_t)(c - 1) * 3 + i) * 1536 + pcol); x0[i] = bflo(u); x1[i] = bfhi(u); }
            else if (sample) { const f32x2 f = *(const f32x2*)(F.in[3] + ((size_t)(l * 8 + (c - 512)) * 3 + i) * 1536 + pcol); x0[i] = f[0]; x1[i] = f[1]; }
        }
#pragma unroll
        for (int i = 0; i < 32; ++i) { const unsigned u = *(const unsigned*)(((bf16_t*)(F.ws + WS_P)) + (size_t)(t0 + 32 * rh + i) * LDP + pcol); x0[3 + i] = bflo(u); x1[3 + i] = bfhi(u); }
#pragma unroll
        for (int r = 0; r < 32; ++r) {
            float a0 = w0[0] * x0[r] + w1[0] * x0[r + 1] + w2[0] * x0[r + 2] + w3[0] * x0[r + 3];
            float a1 = w0[1] * x1[r] + w1[1] * x1[r + 1] + w2[1] * x1[r + 2] + w3[1] * x1[r + 3];
            a0 = silu(a0); a1 = silu(a1);
            const int rr = 32 * rh + r;
            if (which < 2) { *(f32x2*)(Fq + rr * 260 + which * 128 + cc) = (f32x2){a0, a1}; }
            else { *(unsigned*)(VS + rr * 128 + cc) = pk2(a0, a1); }
        }
    }
    __syncthreads();
    {
        const int r = tid >> 3, j = tid & 7; const float* p = Fq + r * 260 + j * 32; float s = 0.f;
#pragma unroll
        for (int i = 0; i < 32; ++i) s += p[i] * p[i];
        s += __shfl_xor(s, 1); s += __shfl_xor(s, 2);
        if ((j & 3) == 0) { if (j == 0) sRQ[r] = rsqrtf(s + 1e-6f) * 0.08838834764831845f; else sRK[r] = rsqrtf(s + 1e-6f); }
    }
    __syncthreads();
    for (int idx = tid; idx < 64 * 64; idx += 512) {
        const int r = idx >> 6, c4 = (idx & 63) * 4; const bool isq = c4 < 128;
        f32x4 v = *(const f32x4*)(Fq + r * 260 + c4); v = v * (isq ? sRQ[r] : sRK[r]);
        const u32x2 w = pk4(v);
        if (isq) { *(u32x2*)(QN + r * 136 + c4) = w; if (!F.dry) *(u32x2*)(((bf16_t*)(F.ws + WS_P)) + (size_t)(t0 + r) * LDP + C_QA + h * 128 + c4) = w; }
        else { *(u32x2*)(KN + r * 136 + c4 - 128) = w; if (!F.dry) *(u32x2*)(((bf16_t*)(F.ws + WS_P)) + (size_t)(t0 + r) * LDP + C_KA + h * 128 + c4 - 128) = w; }
    }
    for (int idx = tid; idx < 64 * 32; idx += 512) {
        const int r = idx >> 5, c4 = (idx & 31) * 4;
        if (!F.dry) *(u32x2*)(((bf16_t*)(F.ws + WS_P)) + (size_t)(t0 + r) * LDP + C_VA + h * 128 + c4) = pk4(unpk4(*(const u32x2*)(VS + r * 128 + c4)) * sB[r]);
    }
    __syncthreads();
    {
        const int fr = lane & 15, fq = lane >> 4, which = F.wid >> 2, it = F.wid & 3;
        const bf16_t* X = which ? QN : KN;
        const int crow = 16 * it + fr; const float gc = sG[crow], bc = sB[crow];
        for (int jt = 0; jt < 4; ++jt) {
            f32x4 a = {0.f, 0.f, 0.f, 0.f};
            if (jt <= it) {
#pragma unroll
                for (int ks = 0; ks < 4; ++ks) a = MFMA16(ldfrag(KN, 16 * jt + fr, 136, 32 * ks, fq), ldfrag(X, crow, 136, 32 * ks, fq), a);
            }
            f32x4 o;
#pragma unroll
            for (int j = 0; j < 4; ++j) {
                const int s = 16 * jt + 4 * fq + j;
                const bool keep = which ? (s <= crow) : (s < crow);
                const float dec = keep ? __expf(gc - sG[s]) : 0.f;
                o[j] = a[j] * dec * (which ? 1.f : bc);
            }
            if (which) { if (!F.dry) *(u32x2*)(((bf16_t*)(F.ws + WS_XB)) + (size_t)(t0 + crow) * LDE + h * 128 + 64 + 16 * jt + 4 * fq) = pk4(o); }
            else *(f32x4*)(AM + crow * 68 + 16 * jt + 4 * fq) = o;
        }
    }
    __syncthreads();
    {
        float* TF = (float*)F.lds;
        float* MS = (float*)(F.lds + 20480);
        const int w = F.wid;
        if (w == 0) {
            const int blk = lane >> 4, cc = lane & 15, base = blk * 16;
            float Tc[16];
#pragma unroll
            for (int i = 0; i < 16; ++i) {
                float a = (i == cc) ? 1.f : 0.f;
#pragma unroll
                for (int j = 0; j < i; ++j) a -= AM[(base + i) * 68 + base + j] * Tc[j];
                Tc[i] = a;
            }
#pragma unroll
            for (int i = 0; i < 16; ++i) TF[(base + i) * 68 + base + cc] = Tc[i];
        }
        __syncthreads();
#pragma unroll 1
        for (int dd = 1; dd < 4; ++dd) {
            if (w < 4 - dd) {
                const int I = w + dd, J = w, r = lane >> 2, c4 = (lane & 3) * 4;
                f32x4 mm = {0.f, 0.f, 0.f, 0.f};
                for (int K = J; K < I; ++K)
#pragma unroll
                    for (int k = 0; k < 16; ++k) { const float a = AM[(I * 16 + r) * 68 + K * 16 + k]; const f32x4 t = *(const f32x4*)(TF + (K * 16 + k) * 68 + J * 16 + c4); mm = mm + a * t; }
                float* ms = MS + w * 256;
                *(f32x4*)(ms + r * 16 + c4) = mm;
                asm volatile("s_waitcnt lgkmcnt(0)" ::: "memory");
                f32x4 o = {0.f, 0.f, 0.f, 0.f};
#pragma unroll
                for (int k = 0; k < 16; ++k) { const float a = TF[(I * 16 + r) * 68 + I * 16 + k]; const f32x4 t = *(const f32x4*)(ms + k * 16 + c4); o = o - a * t; }
                *(f32x4*)(TF + (I * 16 + r) * 68 + J * 16 + c4) = o;
            }
            __syncthreads();
        }
        {
            const int r = tid >> 3, c8 = (tid & 7) * 8; const bool z = (c8 >> 4) > (r >> 4);
            const f32x4 a = z ? (f32x4){0.f, 0.f, 0.f, 0.f} : *(const f32x4*)(TF + r * 68 + c8), b = z ? (f32x4){0.f, 0.f, 0.f, 0.f} : *(const f32x4*)(TF + r * 68 + c8 + 4);
            u32x4 o; o.x = pk2(a[0], a[1]); o.y = pk2(a[2], a[3]); o.z = pk2(b[0], b[1]); o.w = pk2(b[2], b[3]);
            if (!F.dry) *(u32x4*)(((bf16_t*)(F.ws + WS_XB)) + (size_t)(t0 + r) * LDE + h * 128 + c8) = o;
        }
    }
}

DEV void g1_gla(const Frame& F0, int l, int c, int h) {
    REFRAME;
    float* GL = (float*)F.lds;
    float* LA = (float*)(F.lds + 4096);
    bf16_t* QG = (bf16_t*)(F.lds + 20736);
    bf16_t* KI = (bf16_t*)(F.lds + 29952);
    const int tid = F.tid, lane = F.lane, t0 = c * 64;
    __syncthreads();
    if (tid < 256) { const int r = tid >> 2, q4 = (tid & 3) * 4; *(f32x4*)(GL + r * 16 + q4) = *(const f32x4*)(((float*)(F.ws + WS_SC)) + (size_t)(t0 + r) * 32 + 8 + q4); }
    __syncthreads();
    {
        const int dk = tid & 63, rb = tid >> 6;
        float w2[16];
#pragma unroll
        for (int i = 0; i < 16; ++i) w2[i] = F.in[15][(size_t)(l * 16 + i) * 256 + h * 64 + dk];
        const float bias = F.in[16][l * 256 + h * 64 + dk];
#pragma unroll
        for (int rr = 0; rr < 8; ++rr) {
            const int r = rb * 8 + rr; float x = bias;
#pragma unroll
            for (int i = 0; i < 16; ++i) x += GL[r * 16 + i] * w2[i];
            LA[r * 65 + dk] = logsigmoid(x) * 0.0625f;
        }
    }
    __syncthreads();
    if (tid < 64) {
        float g = 0.f;
#pragma unroll 8
        for (int r = 0; r < 64; ++r) { g += LA[r * 65 + tid]; LA[r * 65 + tid] = g; }
        if (!F.dry) ((float*)(F.ws + WS_DL))[((size_t)c * 4 + h) * 64 + tid] = __expf(g);
    }
    __syncthreads();
    for (int idx = tid; idx < 64 * 16; idx += 512) {
        const int r = idx >> 4, c4 = (idx & 15) * 4;
        bf16_t* qp = ((bf16_t*)(F.ws + WS_P)) + (size_t)(t0 + r) * LDP + C_QB + h * 64 + c4; bf16_t* kp = ((bf16_t*)(F.ws + WS_P)) + (size_t)(t0 + r) * LDP + C_KB + h * 64 + c4;
        const f32x4 q = unpk4(*(const u32x2*)qp), k = unpk4(*(const u32x2*)kp);
        f32x4 qg, ki, kg;
#pragma unroll
        for (int j = 0; j < 4; ++j) { const float g = LA[r * 65 + c4 + j], gl = LA[63 * 65 + c4 + j];
            qg[j] = q[j] * 0.125f * __expf(g); ki[j] = k[j] * __expf(-g); kg[j] = k[j] * __expf(gl - g); }
        const u32x2 wq = pk4(qg);
        *(u32x2*)(QG + r * 72 + c4) = wq; *(u32x2*)(KI + r * 72 + c4) = pk4(ki);
        if (!F.dry) *(u32x2*)qp = wq; if (!F.dry) *(u32x2*)kp = pk4(kg);
    }
    __syncthreads();
    {
        const int fr = lane & 15, fq = lane >> 4, it = F.wid >> 1; const int crow = 16 * it + fr;
#pragma unroll
        for (int q = 0; q < 2; ++q) {
            const int jt = (F.wid & 1) * 2 + q;
            f32x4 a = {0.f, 0.f, 0.f, 0.f};
            if (jt <= it) {
#pragma unroll
                for (int ks = 0; ks < 2; ++ks) a = MFMA16(ldfrag(KI, 16 * jt + fr, 72, 32 * ks, fq), ldfrag(QG, crow, 72, 32 * ks, fq), a);
            }
#pragma unroll
            for (int j = 0; j < 4; ++j) if (16 * jt + 4 * fq + j > crow) a[j] = 0.f;
            if (!F.dry) *(u32x2*)(((bf16_t*)(F.ws + WS_XB)) + (size_t)(t0 + crow) * LDE + 512 + h * 64 + 16 * jt + 4 * fq) = pk4(a);
        }
    }
}

DEV void g2_gdn(const Frame& F0, int l, int s, int h) {
    REFRAME;
    bf16_t* QN = (bf16_t*)F.lds;
    bf16_t* KN = (bf16_t*)(F.lds + 17408);
    bf16_t* KT = (bf16_t*)(F.lds + 34816);
    bf16_t* TM = (bf16_t*)(F.lds + 53248);
    bf16_t* AQ = (bf16_t*)(F.lds + 62464);
    float* sB = (float*)(F.lds + 71680); float* sG = sB + 64;
    float* RED = (float*)(F.lds + 72192);
    bf16_t* VV = (bf16_t*)(F.lds + 74240);
    bf16_t* ZZ0 = (bf16_t*)(F.lds + 91648);
    const int tid = F.tid, lane = F.lane, w = F.wid, fr = lane & 15, fq = lane >> 4;
    const bool sample = s >= 16; const int nchunk = sample ? 1 : 32; const int tbase = sample ? 32768 + (s - 16) * 64 : s * 2048;
    const int dvc = h * 128 + 16 * w + fr;
    f32x4 S[8];
#pragma unroll
    for (int mt = 0; mt < 8; ++mt) {
        if (sample) { const float* sp = F.in[2] + ((size_t)((l * 8 + (s - 16)) * 4 + h) * 128) * 128;
#pragma unroll
            for (int j = 0; j < 4; ++j) S[mt][j] = sp[(size_t)(16 * mt + 4 * fq + j) * 128 + 16 * w + fr]; }
        else S[mt] = (f32x4){0.f, 0.f, 0.f, 0.f};
    }
    const float gn = F.in[14][l * 128 + 16 * w + fr];
    u32x4 pq[2], pk[2], pv[2], pz[2], pt, pa; float pbg = 0.f;
#define G2_FETCH(T0) do { int tq_ = tid; asm volatile("" : "+v"(tq_)); _Pragma("unroll") for (int i = 0; i < 2; ++i) { const int p_ = tq_ + 512 * i, r_ = p_ >> 4, c_ = (p_ & 15) * 8; \
        const bf16_t* rp_ = ((bf16_t*)(F.ws + WS_P)) + (size_t)((T0) + r_) * LDP + h * 128 + c_; \
        pq[i] = *(const u32x4*)(rp_ + C_QA); pk[i] = *(const u32x4*)(rp_ + C_KA); pv[i] = *(const u32x4*)(rp_ + C_VA); pz[i] = *(const u32x4*)(rp_ + C_ZA); } \
      { const int r_ = tq_ >> 3, c_ = (tq_ & 7) * 8; const bf16_t* ep_ = ((bf16_t*)(F.ws + WS_XB)) + (size_t)((T0) + r_) * LDE + h * 128 + c_; pt = *(const u32x4*)ep_; pa = *(const u32x4*)(ep_ + 64); } \
      if (tq_ < 128) pbg = ((float*)(F.ws + WS_BG))[((size_t)((T0) >> 6) * 4 + h) * 128 + tq_]; } while (0)
#define G2_PUT(PAR) do { int tq_ = tid; asm volatile("" : "+v"(tq_)); bf16_t* zz_ = ZZ0 + (PAR) * (64 * 136); _Pragma("unroll") for (int i = 0; i < 2; ++i) { const int p_ = tq_ + 512 * i, r = p_ >> 4, c8 = (p_ & 15) * 8; const u32x4 k = pk[i]; \
        *(u32x4*)(QN + r * 136 + c8) = pq[i]; *(u32x4*)(KN + r * 136 + c8) = k; *(u32x4*)(VV + r * 136 + c8) = pv[i]; *(u32x4*)(zz_ + r * 136 + c8) = pz[i]; \
        KT[(c8 + 0) * 72 + r] = (bf16_t)(k.x & 0xffff); KT[(c8 + 1) * 72 + r] = (bf16_t)(k.x >> 16); KT[(c8 + 2) * 72 + r] = (bf16_t)(k.y & 0xffff); KT[(c8 + 3) * 72 + r] = (bf16_t)(k.y >> 16); \
        KT[(c8 + 4) * 72 + r] = (bf16_t)(k.z & 0xffff); KT[(c8 + 5) * 72 + r] = (bf16_t)(k.z >> 16); KT[(c8 + 6) * 72 + r] = (bf16_t)(k.w & 0xffff); KT[(c8 + 7) * 72 + r] = (bf16_t)(k.w >> 16); } \
      { const int r = tq_ >> 3, c8 = (tq_ & 7) * 8; *(u32x4*)(TM + r * 72 + c8) = pt; *(u32x4*)(AQ + r * 72 + c8) = pa; } \
      if (tq_ < 128) sB[tq_] = pbg; } while (0)
    __syncthreads();
    G2_FETCH(tbase); G2_PUT(0);
    __syncthreads();
    for (int n = 0; n < nchunk; ++n) {
        const int t0 = tbase + n * 64;
        const bf16_t* ZZ = ZZ0 + (n & 1) * (64 * 136);
        f32x4 kS[4], qS[4], vn[4], o[4];
#pragma unroll
        for (int mt = 0; mt < 4; ++mt) { kS[mt] = (f32x4){0.f, 0.f, 0.f, 0.f}; qS[mt] = kS[mt]; vn[mt] = kS[mt]; }
#pragma unroll
        for (int ks = 0; ks < 4; ++ks) {
            const bf16x8 sf = mk8(pk4(S[2 * ks]), pk4(S[2 * ks + 1]));
#pragma unroll
            for (int mt = 0; mt < 4; ++mt) {
                kS[mt] = MFMA16(ldfragp(KN, 16 * mt + fr, 136, 32 * ks, fq), sf, kS[mt]);
                qS[mt] = MFMA16(ldfragp(QN, 16 * mt + fr, 136, 32 * ks, fq), sf, qS[mt]);
            }
        }
        const float glast = sG[63];
        f32x4 eg[4], tmp[4];
#pragma unroll
        for (int mt = 0; mt < 4; ++mt)
#pragma unroll
            for (int j = 0; j < 4; ++j) {
                const int row = 16 * mt + 4 * fq + j;
                const float e = __expf(sG[row]); eg[mt][j] = e;
                const float vv = bf2f(VV[row * 136 + 16 * w + fr]);
                tmp[mt][j] = vv - sB[row] * e * kS[mt][j];
            }
#pragma unroll
        for (int ks = 0; ks < 2; ++ks) {
            const bf16x8 tf = mk8(pk4(tmp[2 * ks]), pk4(tmp[2 * ks + 1]));
#pragma unroll
            for (int mt = 0; mt < 4; ++mt) vn[mt] = MFMA16(ldfragp(TM, 16 * mt + fr, 72, 32 * ks, fq), tf, vn[mt]);
        }
#pragma unroll
        for (int mt = 0; mt < 4; ++mt) o[mt] = eg[mt] * qS[mt];
#pragma unroll
        for (int ks = 0; ks < 2; ++ks) {
            const bf16x8 vf = mk8(pk4(vn[2 * ks]), pk4(vn[2 * ks + 1]));
#pragma unroll
            for (int mt = 0; mt < 4; ++mt) o[mt] = MFMA16(ldfragp(AQ, 16 * mt + fr, 72, 32 * ks, fq), vf, o[mt]);
        }
        const float dl = __expf(glast);
#pragma unroll
        for (int mt = 0; mt < 4; ++mt)
#pragma unroll
            for (int j = 0; j < 4; ++j) vn[mt][j] *= __expf(glast - sG[16 * mt + 4 * fq + j]);
#pragma unroll
        for (int mt = 0; mt < 8; ++mt) S[mt] = S[mt] * dl;
#pragma unroll
        for (int ks = 0; ks < 2; ++ks) {
            const bf16x8 vf = mk8(pk4(vn[2 * ks]), pk4(vn[2 * ks + 1]));
#pragma unroll
            for (int mt = 0; mt < 8; ++mt) S[mt] = MFMA16(ldfragp(KT, 16 * mt + fr, 72, 32 * ks, fq), vf, S[mt]);
        }
#pragma unroll
        for (int mt = 0; mt < 4; ++mt)
#pragma unroll
            for (int j = 0; j < 4; ++j) {
                float p = o[mt][j] * o[mt][j];
                p += __shfl_xor(p, 1); p += __shfl_xor(p, 2); p += __shfl_xor(p, 4); p += __shfl_xor(p, 8);
                if (fr == 0) RED[(16 * mt + 4 * fq + j) * 8 + w] = p;
            }
        __syncthreads();
        if (n + 1 < nchunk) G2_FETCH(t0 + 64);
        __builtin_amdgcn_sched_barrier(0);
#pragma unroll
        for (int mt = 0; mt < 4; ++mt)
#pragma unroll
            for (int j = 0; j < 4; ++j) {
                const int row = 16 * mt + 4 * fq + j;
                const f32x4 r0 = *(const f32x4*)(RED + row * 8), r1 = *(const f32x4*)(RED + row * 8 + 4);
                const float ssum = ((r0[0] + r0[1]) + (r0[2] + r0[3])) + ((r1[0] + r1[1]) + (r1[2] + r1[3]));
                const float rs = rsqrtf(ssum * (1.f / 128.f) + 1e-6f);
                bf16_t* zp = ((bf16_t*)(F.ws + WS_P)) + (size_t)(t0 + row) * LDP + C_ZA + dvc;
                const float z = bf2f(ZZ[row * 136 + 16 * w + fr]);
                if (!F.dry) *zp = (bf16_t)(pk2(o[mt][j] * rs * gn * silu(z), 0.f) & 0xffff);
                __builtin_amdgcn_sched_barrier(0);
            }
        if (n + 1 < nchunk) { G2_PUT((n + 1) & 1); __syncthreads(); }
    }
#undef G2_FETCH
#undef G2_PUT
    float* so = sample ? F.out + O_GDN_S + ((size_t)((l * 8 + (s - 16)) * 4 + h) * 128) * 128 : F.out + O_GDN_P + ((size_t)((l * 16 + s) * 4 + h) * 128) * 128;
#pragma unroll
    for (int mt = 0; mt < 8; ++mt)
#pragma unroll
        for (int j = 0; j < 4; ++j) if (!F.dry) so[(size_t)(16 * mt + 4 * fq + j) * 128 + 16 * w + fr] = S[mt][j];
}

DEV void g2_gla(const Frame& F0, int l, int s, int h) {
    REFRAME;
    bf16_t* QG = (bf16_t*)F.lds;
    bf16_t* KGT = (bf16_t*)(F.lds + 9216);
    bf16_t* AQ = (bf16_t*)(F.lds + 18432);
    float* sDL = (float*)(F.lds + 27648);
    float* RED = (float*)(F.lds + 27904);
    bf16_t* ZZ = (bf16_t*)(F.lds + 29952);
    const int tid = F.tid, lane = F.lane, w = F.wid, fr = lane & 15, fq = lane >> 4;
    const bool sample = s >= 16; const int nchunk = sample ? 1 : 32; const int tbase = sample ? 32768 + (s - 16) * 64 : s * 2048;
    const int dvc = h * 128 + 16 * w + fr;
    f32x4 S[4];
#pragma unroll
    for (int mt = 0; mt < 4; ++mt) {
        if (sample) { const float* sp = F.in[4] + ((size_t)((l * 8 + (s - 16)) * 4 + h) * 64) * 128;
#pragma unroll
            for (int j = 0; j < 4; ++j) S[mt][j] = sp[(size_t)(16 * mt + 4 * fq + j) * 128 + 16 * w + fr]; }
        else S[mt] = (f32x4){0.f, 0.f, 0.f, 0.f};
    }
    const float gn = F.in[17][l * 128 + 16 * w + fr];
    for (int n = 0; n < nchunk; ++n) {
        const int t0 = tbase + n * 64, chunk = t0 >> 6;
        __syncthreads();
        {
            const int r = tid >> 3, c8 = (tid & 7) * 8;
            *(u32x4*)(QG + r * 72 + c8) = *(const u32x4*)(((bf16_t*)(F.ws + WS_P)) + (size_t)(t0 + r) * LDP + C_QB + h * 64 + c8);
            const u32x4 k = *(const u32x4*)(((bf16_t*)(F.ws + WS_P)) + (size_t)(t0 + r) * LDP + C_KB + h * 64 + c8);
            KGT[(c8 + 0) * 72 + r] = (bf16_t)(k.x & 0xffff); KGT[(c8 + 1) * 72 + r] = (bf16_t)(k.x >> 16);
            KGT[(c8 + 2) * 72 + r] = (bf16_t)(k.y & 0xffff); KGT[(c8 + 3) * 72 + r] = (bf16_t)(k.y >> 16);
            KGT[(c8 + 4) * 72 + r] = (bf16_t)(k.z & 0xffff); KGT[(c8 + 5) * 72 + r] = (bf16_t)(k.z >> 16);
            KGT[(c8 + 6) * 72 + r] = (bf16_t)(k.w & 0xffff); KGT[(c8 + 7) * 72 + r] = (bf16_t)(k.w >> 16);
            *(u32x4*)(AQ + r * 72 + c8) = *(const u32x4*)(((bf16_t*)(F.ws + WS_XB)) + (size_t)(t0 + r) * LDE + 512 + h * 64 + c8);
        }
#pragma unroll
        for (int i = 0; i < 2; ++i) { const int p = tid + 512 * i, r = p >> 4, c8 = (p & 15) * 8;
            *(u32x4*)(ZZ + r * 136 + c8) = *(const u32x4*)(((bf16_t*)(F.ws + WS_P)) + (size_t)(t0 + r) * LDP + C_ZB + h * 128 + c8); }
        if (tid < 64) sDL[tid] = ((float*)(F.ws + WS_DL))[((size_t)chunk * 4 + h) * 64 + tid];
        bf16x8 vf[2];
#pragma unroll
        for (int ks = 0; ks < 2; ++ks) {
            unsigned e[8];
#pragma unroll
            for (int j = 0; j < 8; ++j) { const int row = 32 * ks + (j < 4 ? 4 * fq + j : 16 + 4 * fq + (j - 4)); e[j] = ((bf16_t*)(F.ws + WS_P))[(size_t)(t0 + row) * LDP + C_VB + dvc]; }
            u32x4 t; t.x = e[0] | (e[1] << 16); t.y = e[2] | (e[3] << 16); t.z = e[4] | (e[5] << 16); t.w = e[6] | (e[7] << 16);
            vf[ks] = __builtin_bit_cast(bf16x8, t);
        }
        __syncthreads();
        f32x4 o[4];
#pragma unroll
        for (int mt = 0; mt < 4; ++mt) o[mt] = (f32x4){0.f, 0.f, 0.f, 0.f};
#pragma unroll
        for (int ks = 0; ks < 2; ++ks) {
            const bf16x8 sf = mk8(pk4(S[2 * ks]), pk4(S[2 * ks + 1]));
#pragma unroll
            for (int mt = 0; mt < 4; ++mt) {
                o[mt] = MFMA16(ldfragp(QG, 16 * mt + fr, 72, 32 * ks, fq), sf, o[mt]);
                o[mt] = MFMA16(ldfragp(AQ, 16 * mt + fr, 72, 32 * ks, fq), vf[ks], o[mt]);
            }
        }
#pragma unroll
        for (int mt = 0; mt < 4; ++mt) {
#pragma unroll
            for (int j = 0; j < 4; ++j) S[mt][j] *= sDL[16 * mt + 4 * fq + j];
#pragma unroll
            for (int ks = 0; ks < 2; ++ks) S[mt] = MFMA16(ldfragp(KGT, 16 * mt + fr, 72, 32 * ks, fq), vf[ks], S[mt]);
        }
#pragma unroll
        for (int mt = 0; mt < 4; ++mt)
#pragma unroll
            for (int j = 0; j < 4; ++j) {
                float p = o[mt][j] * o[mt][j];
                p += __shfl_xor(p, 1); p += __shfl_xor(p, 2); p += __shfl_xor(p, 4); p += __shfl_xor(p, 8);
                if (fr == 0) RED[(16 * mt + 4 * fq + j) * 8 + w] = p;
            }
        __syncthreads();
#pragma unroll
        for (int mt = 0; mt < 4; ++mt)
#pragma unroll
            for (int j = 0; j < 4; ++j) {
                const int row = 16 * mt + 4 * fq + j;
                const f32x4 r0 = *(const f32x4*)(RED + row * 8), r1 = *(const f32x4*)(RED + row * 8 + 4);
                const float ssum = ((r0[0] + r0[1]) + (r0[2] + r0[3])) + ((r1[0] + r1[1]) + (r1[2] + r1[3]));
                const float rs = rsqrtf(ssum * (1.f / 128.f) + 1e-6f);
                bf16_t* zp = ((bf16_t*)(F.ws + WS_P)) + (size_t)(t0 + row) * LDP + C_ZB + dvc;
                const float z = bf2f(ZZ[row * 136 + 16 * w + fr]);
                if (!F.dry) *zp = (bf16_t)(pk2(o[mt][j] * rs * gn * silu(z), 0.f) & 0xffff);
            }
    }
    float* so = sample ? F.out + O_GLA_S + ((size_t)((l * 8 + (s - 16)) * 4 + h) * 64) * 128 : F.out + O_GLA_P + ((size_t)((l * 16 + s) * 4 + h) * 64) * 128;
#pragma unroll
    for (int mt = 0; mt < 4; ++mt)
#pragma unroll
        for (int j = 0; j < 4; ++j) if (!F.dry) so[(size_t)(16 * mt + 4 * fq + j) * 128 + 16 * w + fr] = S[mt][j];
}

DEV void unpack8(u32x4 u, float (&f)[8]) { f[0] = bflo(u.x); f[1] = bfhi(u.x); f[2] = bflo(u.y); f[3] = bfhi(u.y); f[4] = bflo(u.z); f[5] = bfhi(u.z); f[6] = bflo(u.w); f[7] = bfhi(u.w); }
DEV void load8f(const float* p, float (&f)[8]) { const f32x4 a = *(const f32x4*)p, b = *(const f32x4*)(p + 4); f[0] = a[0]; f[1] = a[1]; f[2] = a[2]; f[3] = a[3]; f[4] = b[0]; f[5] = b[1]; f[6] = b[2]; f[7] = b[3]; }
DEV void ffn_mid(const Frame& F0, int l) {
    REFRAME;
    const float* cw = F.in[29] + (size_t)l * 3 * 5632; const float* cb = F.in[30] + (size_t)l * 5632;
    const bf16_t* halo = ((bf16_t*)(F.ws + WS_KV)); const bf16_t* raw01 = ((bf16_t*)(F.ws + WS_KV + 11714560ull));
    for (int idx = F.bid * 512 + F.tid; idx < 112 * 704; idx += F.nb * 512) {
        const int ti = idx / 704, c4 = (idx % 704) * 4, pm = (ti / 7) * 8 + (ti % 7) + 1;
        const bf16_t* hp = halo + (size_t)(4 * pm - 1) * 2 * 5632; const bf16_t* rp = raw01 + (size_t)pm * 2 * 5632;
        const f32x4 gm2 = unpk4(*(const u32x2*)(hp + c4)), gm1 = unpk4(*(const u32x2*)(hp + 5632 + c4)), g0 = unpk4(*(const u32x2*)(rp + c4)), g1 = unpk4(*(const u32x2*)(rp + 5632 + c4));
        const f32x4 vm2 = unpk4(*(const u32x2*)(hp + 2816 + c4)), vm1 = unpk4(*(const u32x2*)(hp + 5632 + 2816 + c4)), v0 = unpk4(*(const u32x2*)(rp + 2816 + c4)), v1 = unpk4(*(const u32x2*)(rp + 5632 + 2816 + c4));
        const f32x4 wg0 = *(const f32x4*)(cw + c4), wg1 = *(const f32x4*)(cw + 5632 + c4), wg2 = *(const f32x4*)(cw + 2 * 5632 + c4), bg = *(const f32x4*)(cb + c4);
        const f32x4 wv0 = *(const f32x4*)(cw + 2816 + c4), wv1 = *(const f32x4*)(cw + 5632 + 2816 + c4), wv2 = *(const f32x4*)(cw + 2 * 5632 + 2816 + c4), bv = *(const f32x4*)(cb + 2816 + c4);
        f32x4 o0, o1;
#pragma unroll
        for (int j = 0; j < 4; ++j) {
            const float yg0 = wg0[j] * gm2[j] + wg1[j] * gm1[j] + wg2[j] * g0[j] + bg[j], yv0 = wv0[j] * vm2[j] + wv1[j] * vm1[j] + wv2[j] * v0[j] + bv[j];
            const float yg1 = wg0[j] * gm1[j] + wg1[j] * g0[j] + wg2[j] * g1[j] + bg[j], yv1 = wv0[j] * vm1[j] + wv1[j] * v0[j] + wv2[j] * v1[j] + bv[j];
            o0[j] = silu(yg0) * yv0; o1[j] = silu(yg1) * yv1;
        }
        bf16_t* vp = ((bf16_t*)(F.ws + WS_P)) + (size_t)pm * 256 * LDP + c4;
        *(u32x2*)vp = pk4(o0); *(u32x2*)(vp + LDP) = pk4(o1);
    }
}

DEV void final_norm(const Frame& F0) {
    REFRAME;
    const int gw = F.bid * 8 + F.wid, nw = F.nb * 8, lane = F.lane;
    const float* g = F.in[32];
    for (int row = gw; row < TT; row += nw) {
        const float rs = row_rstd(((float*)(F.ws + WS_SSQ)), row);
        float* X = F.out + (size_t)row * 1024;
#pragma unroll
        for (int i = 0; i < 4; ++i) { const int cidx = i * 256 + lane * 4; f32x4 v = *(const f32x4*)(X + cidx); const f32x4 gg = *(const f32x4*)(g + cidx); *(f32x4*)(X + cidx) = v * rs * gg; }
    }
}

#ifdef DBG_COL
DEV void dbg_dump(const Frame& F0) {
    REFRAME;
    for (int i = F.bid * 512 + F.tid; i < TT * 256; i += F.nb * 512) {
        const int row = i >> 8, c = (i & 255) * 4;
        const f32x4 v = c < 512 ? unpk4(*(const u32x2*)(((bf16_t*)(F.ws + WS_P)) + (size_t)row * LDP + DBG_COL + c)) : (f32x4){0.f, 0.f, 0.f, 0.f};
        *(f32x4*)(F.out + (size_t)row * 1024 + c) = (row DBG_ROWSEL) ? v : (f32x4){0.f, 0.f, 0.f, 0.f};
    }
}
#endif
#define XB_TMO      128
#define XB_XCNT(j)  (256  + 64 * (j))
#define XB_XSUB(j)  (1280 + 64 * (j))
#define XB_XGEN(j)  (2304 + 64 * (j))
#define XB_TOP      3328
#define XB_TOPGEN   3392
#define XCD_BAR_WORDS 3456
#define XB_SPIN_CAP (1u << 18)
#define LAS __attribute__((address_space(3)))

__device__ __forceinline__ unsigned xb_ld(unsigned* p)              { return __hip_atomic_load(p, __ATOMIC_RELAXED, __HIP_MEMORY_SCOPE_AGENT); }
__device__ __forceinline__ unsigned xb_add(unsigned* p, unsigned v) { return __hip_atomic_fetch_add(p, v, __ATOMIC_RELAXED, __HIP_MEMORY_SCOPE_AGENT); }
__device__ __forceinline__ unsigned xb_xcc_id() { return (unsigned)__builtin_amdgcn_s_getreg((3 << 11) | 20) & 0xFu; }
#define XB_SPIN(cond, bar) do { unsigned _sp = 0; while (cond) { __builtin_amdgcn_s_sleep(1); \
    if ((++_sp & 255u) == 0u) { if (xb_ld(&(bar)[XB_TMO])) break; if (_sp > XB_SPIN_CAP) { atomicAdd(&(bar)[XB_TMO], 1u); break; } } } } while (0)

struct XcdBarrier {
    unsigned* bar; unsigned x;
    volatile LAS unsigned* st;
};

__device__ __forceinline__ XcdBarrier xcd_barrier_post(unsigned* bar, volatile LAS unsigned* st) {
    XcdBarrier b; b.bar = bar; b.x = xb_xcc_id(); b.st = st;
    if (threadIdx.x == 0) (void)xb_add(&bar[XB_XCNT(b.x)], 1u);
    return b;
}
__device__ __forceinline__ void xcd_barrier_complete(unsigned* bar, unsigned x, unsigned& nloc, unsigned& nx) {
    const unsigned G = gridDim.x * gridDim.y * gridDim.z;
    unsigned sum, cnt, mine, sp = 0u;
    for (;;) {
        sum = 0u; cnt = 0u; mine = 0u;
#pragma unroll
        for (unsigned j = 0; j < 16; ++j) { const unsigned c = xb_ld(&bar[XB_XCNT(j)]); sum += c; cnt += (c > 0u) ? 1u : 0u; mine = (j == x) ? c : mine; }
        if (sum == G) break;
        __builtin_amdgcn_s_sleep(1);
        if ((++sp & 255u) == 0u) { if (xb_ld(&bar[XB_TMO])) break; if (sp > XB_SPIN_CAP) { atomicAdd(&bar[XB_TMO], 1u); break; } }
    }
    nloc = mine > 0u ? mine : 1u; nx = cnt > 0u ? cnt : 1u;
}

__device__ __forceinline__ void xcd_barrier(const XcdBarrier& b) {
    asm volatile("s_waitcnt vmcnt(0)" ::: "memory");
    __syncthreads();
    if (threadIdx.x == 0) {
        unsigned* bar = b.bar;
        __builtin_amdgcn_s_waitcnt(0);
        unsigned nloc = b.st[0], nx = b.st[1];
        if (nloc == 0u) { xcd_barrier_complete(bar, b.x, nloc, nx); b.st[0] = nloc; b.st[1] = nx; }
        const unsigned old = xb_add(&bar[XB_XSUB(b.x)], 1u);
        const unsigned gen = old / nloc;
        if (old + 1u == (gen + 1u) * nloc) {
            __builtin_amdgcn_fence(__ATOMIC_RELEASE, "agent");
            asm volatile("s_waitcnt vmcnt(0)" ::: "memory");
            const unsigned og = xb_add(&bar[XB_TOP], 1u);
            const unsigned tg = og / nx;
            if (og + 1u == (tg + 1u) * nx) xb_add(&bar[XB_TOPGEN], 1u);
            else XB_SPIN(xb_ld(&bar[XB_TOPGEN]) == tg, bar);
            __builtin_amdgcn_fence(__ATOMIC_ACQUIRE, "agent");
            xb_add(&bar[XB_XGEN(b.x)], 1u);
            asm volatile("s_waitcnt vmcnt(0)" ::: "memory");
        } else {
            XB_SPIN(xb_ld(&bar[XB_XGEN(b.x)]) == gen, bar);
            __builtin_amdgcn_fence(__ATOMIC_ACQUIRE, "agent");
            asm volatile("s_waitcnt vmcnt(0)" ::: "memory");
        }
    }
    __syncthreads();
}

__global__ void __launch_bounds__(512, 2) fwd_kernel(Params p) {
    extern __shared__ __attribute__((aligned(16))) unsigned char lds[];
    cg::grid_group grid = cg::this_grid();
    Frame F;
    F.in = (InTab)__builtin_amdgcn_kernarg_segment_ptr(); F.out = p.out; F.ws = p.ws; F.lds = lds;
    F.tid = threadIdx.x; F.lane = threadIdx.x & 63; F.wid = __builtin_amdgcn_readfirstlane(threadIdx.x >> 6); F.nb = gridDim.x; F.bid = blockIdx.x; F.dry = 0; F.cb = blockIdx.x; F.cn = gridDim.x;
    volatile LAS unsigned* xst = (volatile LAS unsigned*)(lds + LDS_BYTES - 16);
    if (threadIdx.x == 0) { xst[0] = 0u; xst[1] = 0u; }
    __syncthreads();
    const XcdBarrier xbar = xcd_barrier_post((unsigned*)(p.ws + WS_BAR), xst);
    for (int ph = p.ph_lo; ph < p.ph_hi; ++ph) {
        if (gridDim.x == 256 && ph > 0 && ph < NPH - 1 && ((ph - 1) % 13) == 4) continue;
#ifndef PHM
#define PHM 0xffff
#endif
        if (ph == 0) { if (PHM & 0x1000) phase0(F); }
        else if (ph == NPH - 1) { if (PHM & 0x2000) final_norm(F); }
        else {
            const int l = (ph - 1) / 13, k = (ph - 1) % 13;
            int gk = -1;
            if (k == 2 && gridDim.x == 256) gk = GP_MEMKV;
            switch (k) { case 0: gk = GP_IN; break; case 3: gk = GP_OUT; break; case 4: gk = GP_OUT2; break; case 5: gk = GP_WO; break; case 6: gk = GP_MQ; break; case 7: gk = GP_ATTN; break; case 8: gk = GP_ATTN2; break;
                         case 9: gk = GP_MO; break; case 10: gk = GP_UP; break; case 12: gk = GP_DOWN; break; default: break; }
#ifndef REPMASK
#define REPMASK 0
#endif
            if (gk >= 0 && (PHM & 1)) { const int nrep = ((REPMASK >> k) & 1) ? 2 : 1; for (int rep = 0; rep < nrep; ++rep) gemm_phase(F, gk, l); }
            if (k == 0 && (PHM & 1)) small_proj(F);
            if (k == (gridDim.x == 256 ? 2 : 3) && (PHM & 8)) sample_kv(F, l);
            if (gridDim.x == 256 && k == 2 && l > 0 && blockIdx.x >= 128) { Frame G = F; G.cb = (int)blockIdx.x - 128; G.cn = 128; __syncthreads(); cvt_ffn(G, l); }
            if (gridDim.x == 256 && k == 10 && l < 3 && (blockIdx.x >> 3) >= 6) { Frame G = F; G.cb = (((int)blockIdx.x >> 3) - 6) * 8 + ((int)blockIdx.x & 7); G.cn = 208; __syncthreads(); cvt_mixer(G, l + 1); }
#ifndef DRYMASK
#define DRYMASK 0
#endif
            for (int dr = ((DRYMASK >> k) & 1); dr >= 0; --dr) {
            F.dry = dr;
            if (k == 1 && (PHM & 2)) {
                for (int it = F.bid; it < NCH * 8; it += F.nb) { const int c = it >> 3, h = it & 3; if (it & 4) g1_gla(F, l, c, h); else g1_gdn(F, l, c, h); }
                __syncthreads();
                if (l > 0 && !dr && F.nb != 256) cvt_ffn(F, l);
            }
            if (k == 2 && (PHM & 4)) {
                for (int it = F.bid; it < 192; it += F.nb) {
                    int s, h, br;
                    if (it < 128) { br = it & 1; h = (it >> 1) & 3; s = it >> 3; } else { const int v = it - 128; br = v & 1; h = (v >> 1) & 3; s = 16 + (v >> 3); }
                    if (br) g2_gla(F, l, s, h); else g2_gdn(F, l, s, h);
                    __syncthreads();
                }
            }
            if (k == 11 && (PHM & 0x200)) { ffn_mid(F, l); if (l < 3 && !dr && F.nb != 256) { __syncthreads(); cvt_mixer(F, l + 1); } }
            }
            F.dry = 0;
        }
#ifndef SYNCREP
#define SYNCREP 1
#endif
        if (ph + 1 < p.ph_hi) {
            if (ph == 0) grid.sync();
            else xcd_barrier(xbar);
        }
    }
#ifdef DBG_COL
    __threadfence(); grid.sync(); __threadfence();
    dbg_dump(F);
#endif
}

extern "C" void kernel_launch(void* const* d_in, const int* in_sizes, int n_in, void* d_out, int out_size, void* d_ws, size_t ws_size, hipStream_t stream) {
    static int grid_blocks = 0;
    if (grid_blocks == 0) {
        if (n_in != 33 || ws_size < WS_TOTAL) { fprintf(stderr, "kernel_launch: bad n_in %d or ws %zu < %zu\n", n_in, ws_size, (size_t)WS_TOTAL); grid_blocks = -1; return; }
        int dev = 0, cus = 0, per_cu = 0;
        hipGetDevice(&dev);
        hipDeviceGetAttribute(&cus, hipDeviceAttributeMultiprocessorCount, dev);
        if (hipFuncSetAttribute((const void*)fwd_kernel, hipFuncAttributeMaxDynamicSharedMemorySize, LDS_BYTES) != hipSuccess) { fprintf(stderr, "hipFuncSetAttribute failed\n"); grid_blocks = -1; return; }
        hipOccupancyMaxActiveBlocksPerMultiprocessor(&per_cu, (const void*)fwd_kernel, 512, LDS_BYTES);
        if (per_cu < 1) per_cu = 1;
        (void)hipGetLastError();
        grid_blocks = cus * 1;
        if (grid_blocks <= 0) grid_blocks = 256;
    }
    if (grid_blocks < 0) return;
    Params p{};
    for (int i = 0; i < 33; ++i) p.in[i] = (const float*)d_in[i];
    p.out = (float*)d_out; p.ws = (unsigned char*)d_ws; p.ph_lo = 0; p.ph_hi = PH_HI;
    (void)hipMemsetAsync((unsigned char*)d_ws + WS_BAR, 0, 16384, stream);
    void* args[] = {&p};
    hipError_t e = hipLaunchCooperativeKernel((const void*)fwd_kernel, dim3(grid_blocks), dim3(512), args, LDS_BYTES, stream);
    if (e != hipSuccess) fprintf(stderr, "cooperative launch failed: %s (grid %d)\n", hipGetErrorString(e), grid_blocks);
}
```

```cpp
#include <hip/hip_runtime.h>
#include <hip/hip_cooperative_groups.h>
#include <cstdint>
#include <cstdio>
namespace cg = cooperative_groups;

typedef unsigned short bf16_t;
typedef short bf16x8 __attribute__((ext_vector_type(8)));
typedef float f32x4 __attribute__((ext_vector_type(4)));
typedef float f32x2 __attribute__((ext_vector_type(2)));
typedef unsigned u32x2 __attribute__((ext_vector_type(2)));
typedef unsigned u32x4 __attribute__((ext_vector_type(4)));
#define DEV __device__ __forceinline__

constexpr int DM = 1024, TT = 33280, NCH = 520, LDP = 5632, LDE = 768;
constexpr int C_QA = 0, C_KA = 512, C_VA = 1024, C_ZA = 1536, C_QB = 2048, C_KB = 2304, C_VB = 2560, C_ZB = 3072, C_GA = 3584, C_GB = 4608;
constexpr int C_MRG = 0, C_PR = 1024, C_Q = 2048, C_O = 3072;
constexpr size_t O_Y = 0;
constexpr size_t O_GDN_P = 34078720ull;
constexpr size_t O_GDNC_P = O_GDN_P + 4194304ull;
constexpr size_t O_GLA_P = O_GDNC_P + 294912ull;
constexpr size_t O_FFNC_P = O_GLA_P + 2097152ull;
constexpr size_t O_MEMK = O_FFNC_P + 720896ull;
constexpr size_t O_MEMV = O_MEMK + 16777216ull;
constexpr size_t O_GDN_S = O_MEMV + 16777216ull;
constexpr size_t O_GDNC_S = O_GDN_S + 2097152ull;
constexpr size_t O_GLA_S = O_GDNC_S + 147456ull;
constexpr size_t O_FFNC_S = O_GLA_S + 1048576ull;
constexpr size_t al256(size_t x) { return (x + 255) & ~(size_t)255; }
constexpr size_t WS_WMIX = 0;
constexpr size_t WM_WIN = 0, WM_WSM = WM_WIN + 5632ull * 1024, WM_WOA = WM_WSM + 32 * 1024, WM_WOB = WM_WOA + 524288, WM_WO = WM_WOB + 524288,
                 WM_WMQ = WM_WO + 1048576, WM_WMK = WM_WMQ + 1048576, WM_WMV = WM_WMK + 1048576, WM_WMO = WM_WMV + 1048576, WM_END = WM_WMO + 1048576;
constexpr size_t WS_WFFN = al256(WS_WMIX + WM_END * 2);
constexpr size_t WF_UP = 0, WF_DN = 5632ull * 1024, WF_END = WF_DN + 1024ull * 2816;
constexpr size_t WS_XB = al256(WS_WFFN + WF_END * 2);
constexpr size_t WS_P = al256(WS_XB + (size_t)TT * 1024 * 2);
constexpr size_t WS_KV = al256(WS_P + (size_t)TT * LDP * 2);
constexpr size_t KV_BYTES = 2ull * 6144 * 1024 * 2;
constexpr size_t WS_MB = al256(WS_KV + KV_BYTES);
constexpr size_t WS_MRS = al256(WS_MB + 4096ull * 1024 * 2);
constexpr size_t WS_SSQ = al256(WS_MRS + 4096 * 4);
constexpr size_t WS_SC = al256(WS_SSQ + (size_t)TT * 16 * 4);
constexpr size_t WS_DL = al256(WS_SC + (size_t)TT * 32 * 4);
constexpr size_t WS_BG = al256(WS_DL + 520ull * 4 * 64 * 4);
constexpr size_t WS_BAR = al256(WS_BG + 520ull * 4 * 128 * 4);
constexpr size_t WS_TOTAL = al256(WS_BAR + 16384);
constexpr int LDS_BYTES = 147456;
constexpr int NPH = 54;
#ifndef PH_HI
#define PH_HI NPH
#define REPMASK 0
#define SYNCREP 1
#define DRYMASK 0
#endif

struct Params { const float* in[33]; float* out; unsigned char* ws; int ph_lo, ph_hi; };

typedef __bf16 bf16x2_t __attribute__((ext_vector_type(2)));
DEV unsigned pk2(float lo, float hi) { f32x2 f = {lo, hi}; bf16x2_t v = __builtin_convertvector(f, bf16x2_t); return __builtin_bit_cast(unsigned, v); }
DEV float bf2f(bf16_t b) { return __uint_as_float(((unsigned)b) << 16); }
DEV float bflo(unsigned u) { return __uint_as_float(u << 16); }
DEV float bfhi(unsigned u) { return __uint_as_float(u & 0xffff0000u); }
DEV u32x2 pk4(f32x4 v) { u32x2 r; r.x = pk2(v[0], v[1]); r.y = pk2(v[2], v[3]); return r; }
DEV f32x4 unpk4(u32x2 u) { return (f32x4){bflo(u.x), bfhi(u.x), bflo(u.y), bfhi(u.y)}; }
DEV bf16x8 mk8(u32x2 a, u32x2 b) { u32x4 t = {a.x, a.y, b.x, b.y}; return __builtin_bit_cast(bf16x8, t); }
DEV float sigm(float x) { return 1.f / (1.f + __expf(-x)); }
DEV float silu(float x) { return x / (1.f + __expf(-x)); }
DEV float softplus(float x) { return x > 20.f ? x : __logf(1.f + __expf(x)); }
DEV float logsigmoid(float x) { return fminf(x, 0.f) - __logf(1.f + __expf(-fabsf(x))); }
DEV float row_rstd(const float* ssq, int row) {
    const f32x4 a = *(const f32x4*)(ssq + (size_t)row * 4), b = *(const f32x4*)(ssq + ((size_t)TT + row) * 4);
    const f32x4 c = *(const f32x4*)(ssq + ((size_t)2 * TT + row) * 4), d = *(const f32x4*)(ssq + ((size_t)3 * TT + row) * 4);
    float s = ((a[0] + a[1]) + (a[2] + a[3])) + ((b[0] + b[1]) + (b[2] + b[3])) + ((c[0] + c[1]) + (c[2] + c[3])) + ((d[0] + d[1]) + (d[2] + d[3]));
    return rsqrtf(s * (1.f / 1024.f) + 1e-6f);
}
DEV bf16x8 ldfragp(const bf16_t* base, int row, int stride, int k0, int fq) {
    const bf16_t* p = base + row * stride + k0 + 4 * fq;
    return mk8(*(const u32x2*)p, *(const u32x2*)(p + 16));
}
DEV bf16x8 ldfrag(const bf16_t* base, int row, int stride, int k0, int fq) {
    return *(const bf16x8*)(base + row * stride + k0 + 8 * fq);
}
#define MFMA16(a, b, c) __builtin_amdgcn_mfma_f32_16x16x32_bf16((a), (b), (c), 0, 0, 0)

constexpr int BM = 256, BK = 64, HALF = 128, HT = HALF * BK;
DEV int lds_byte(int r, int c) { int st = (r >> 4) * 2 + (c >> 5), rr = r & 15, cc = c & 31, ob = rr * 64 + cc * 2; return st * 1024 + (ob ^ (((ob >> 9) & 1) << 5)); }
DEV void stage_rc(int b, int& R, int& C) { int st = b / 1024, sb = b % 1024, swz = sb ^ (((sb >> 9) & 1) << 5); R = (st >> 1) * 16 + swz / 64; C = (st & 1) * 32 + (swz % 64) / 2; }

DEV void gemm_core(const bf16_t* __restrict__ A, int lda, const bf16_t* __restrict__ Bt, int ldb, int K, int brow, int bcol, f32x4 (&acc)[2][2][4][2], bf16_t* shm) {
#define SA(b, h) (shm + ((b) * 2 + (h)) * HT)
#define SB(b, h) (shm + (4 + (b) * 2 + (h)) * HT)
#define STAGE(P, BASE, LD, br, kt) do { const char* _gb = (const char*)((BASE) + (long)(br) * (LD) + (long)(kt) * BK); \
    const unsigned _vo = (unsigned)((sr0 * (int)(LD) + sc0) * 2); \
    for (int _i = 0; _i < 2; ++_i) { \
      __builtin_amdgcn_global_load_lds((const unsigned*)(_gb + (long)(_i * 128) * (LD) + _vo), (unsigned*)((char*)(P) + wbase + _i * 8192), 16, 0, 0); } } while (0)
#define LDA(dst, b, h) for (int m = 0; m < 4; ++m) for (int k = 0; k < 2; ++k) \
    dst[m][k] = *reinterpret_cast<const bf16x8*>((char*)SA(b, h) + lds_byte(wr * 64 + m * 16 + fr, k * 32 + fq * 8))
#define LDB(dst, b, h) for (int n = 0; n < 2; ++n) for (int k = 0; k < 2; ++k) \
    dst[n][k] = *reinterpret_cast<const bf16x8*>((char*)SB(b, h) + lds_byte(wc * 32 + n * 16 + fr, k * 32 + fq * 8))
#define MMA(ai, bj, At_, Bt_) do { __builtin_amdgcn_s_setprio(1); \
    for (int m = 0; m < 4; ++m) for (int n = 0; n < 2; ++n) for (int k = 0; k < 2; ++k) \
      acc[ai][bj][m][n] = __builtin_amdgcn_mfma_f32_16x16x32_bf16(Bt_[n][k], At_[m][k], acc[ai][bj][m][n], 0, 0, 0); \
    __builtin_amdgcn_s_setprio(0); } while (0)
#define WAIT_V(n) asm volatile("s_waitcnt vmcnt(" #n ")" ::: "memory")
#define WAIT_L(n) asm volatile("s_waitcnt lgkmcnt(" #n ")" ::: "memory")
#define BAR __builtin_amdgcn_s_barrier()
#define SCHED __builtin_amdgcn_sched_barrier(0)
    int tidx = threadIdx.x; asm volatile("" : "+v"(tidx));
    const int wid = __builtin_amdgcn_readfirstlane(tidx >> 6), lane = tidx & 63, wr = wid >> 2, wc = wid & 3, fr = lane & 15, fq = lane >> 4;
    const int wbase = wid * 1024;
    int sr0, sc0; stage_rc(tidx * 16, sr0, sc0);
#pragma unroll
    for (int a = 0; a < 2; ++a)
#pragma unroll
        for (int b = 0; b < 2; ++b)
#pragma unroll
            for (int m = 0; m < 4; ++m)
#pragma unroll
                for (int n = 0; n < 2; ++n) acc[a][b][m][n] = (f32x4){0.f, 0.f, 0.f, 0.f};
    bf16x8 At[4][2], B0[2][2], B1[2][2];
    const int nt = K / BK;
    STAGE(SB(0, 0), Bt, ldb, bcol, 0); STAGE(SA(0, 0), A, lda, brow, 0);
    STAGE(SB(0, 1), Bt, ldb, bcol + HALF, 0); STAGE(SA(0, 1), A, lda, brow + HALF, 0);
    if (wr == 1) BAR;
    WAIT_V(4); BAR;
    STAGE(SB(1, 0), Bt, ldb, bcol, 1); STAGE(SA(1, 0), A, lda, brow, 1); STAGE(SB(1, 1), Bt, ldb, bcol + HALF, 1);
    WAIT_V(6); BAR;
    for (int t = 0; t < nt - 2; t += 2) {
        LDB(B0, 0, 0); SCHED; LDA(At, 0, 0); STAGE(SA(1, 1), A, lda, brow + HALF, t + 1);
        WAIT_L(8); BAR; WAIT_L(0); MMA(0, 0, At, B0); BAR; SCHED;
        LDB(B1, 0, 1); STAGE(SB(0, 0), Bt, ldb, bcol, t + 2);
        BAR; WAIT_L(0); MMA(0, 1, At, B1); BAR;
        LDA(At, 0, 1); STAGE(SA(0, 0), A, lda, brow, t + 2);
        BAR; WAIT_L(0); MMA(1, 0, At, B0); BAR; SCHED;
        STAGE(SB(0, 1), Bt, ldb, bcol + HALF, t + 2);
        WAIT_V(6); BAR; MMA(1, 1, At, B1); BAR;
        LDB(B0, 1, 0); SCHED; LDA(At, 1, 0); STAGE(SA(0, 1), A, lda, brow + HALF, t + 2);
        WAIT_L(8); BAR; WAIT_L(0); MMA(0, 0, At, B0); BAR; SCHED;
        LDB(B1, 1, 1); STAGE(SB(1, 0), Bt, ldb, bcol, t + 3);
        BAR; WAIT_L(0); MMA(0, 1, At, B1); BAR;
        LDA(At, 1, 1); STAGE(SA(1, 0), A, lda, brow, t + 3);
        BAR; WAIT_L(0); MMA(1, 0, At, B0); BAR; SCHED;
        STAGE(SB(1, 1), Bt, ldb, bcol + HALF, t + 3);
        WAIT_V(6); BAR; MMA(1, 1, At, B1); BAR;
    }
    { LDB(B0, 0, 0); LDA(At, 0, 0); STAGE(SA(1, 1), A, lda, brow + HALF, nt - 1);
      BAR; WAIT_L(0); MMA(0, 0, At, B0); BAR;
      LDB(B1, 0, 1); BAR; WAIT_L(0); MMA(0, 1, At, B1); BAR;
      LDA(At, 0, 1); WAIT_V(4); BAR; WAIT_L(0); MMA(1, 0, At, B0); MMA(1, 1, At, B1); BAR; }
    { LDB(B0, 1, 0); LDA(At, 1, 0); WAIT_V(2); BAR; WAIT_L(0); MMA(0, 0, At, B0); BAR;
      LDB(B1, 1, 1); WAIT_V(0); BAR; WAIT_L(0); MMA(0, 1, At, B1); BAR;
      LDA(At, 1, 1); BAR; WAIT_L(0); MMA(1, 0, At, B0); MMA(1, 1, At, B1); BAR; }
    if (wr == 0) BAR;
    SCHED;
#undef SA
#undef SB
}

typedef const float* const __attribute__((address_space(4)))* InTab;
struct Frame {
    InTab in; float* out; unsigned char* ws; unsigned char* lds;
    int tid, lane, wid, nb, bid, dry, cb, cn;
};
#define REFRAME Frame F = F0; { int t_ = threadIdx.x; asm volatile("" : "+v"(t_)); F.tid = t_; F.lane = t_ & 63; unsigned char* w_ = F.ws; asm volatile("" : "+s"(w_)); F.ws = w_; float* o_ = F.out; asm volatile("" : "+s"(o_)); F.out = o_; InTab i_ = (InTab)__builtin_amdgcn_kernarg_segment_ptr(); asm volatile("" : "+s"(i_)); F.in = i_; int a_ = F.wid, b_ = F.bid, c_ = F.nb; asm volatile("" : "+s"(a_), "+s"(b_), "+s"(c_)); F.wid = a_; F.bid = b_; F.nb = c_; }

enum { EPI_PROJ = 0, EPI_UP, EPI_RESID, EPI_Q, EPI_MEMK, EPI_MEMV, EPI_OUTA, EPI_OUTB, EPI_SOFTMAX, EPI_ATTNO };
struct GDesc { const bf16_t* A; int lda; const bf16_t* Bt; int ldb; int K, brow, bcol, epi, orow, ocol, head, vai, vwr; };

DEV void cvt_mat(const Frame& F0, const float* src, int ldsrc, int K, int N, int wincols, const float* gain, bf16_t* dst) {
    REFRAME;
    float* T = (float*)F.lds;
    const int nkt = K / 64, nnt = N / 64, ntile = nkt * nnt;
    for (int t = F.cb; t < ntile; t += F.cn) {
        const int kt = t / nnt, ntl = t % nnt, k0 = kt * 64, n0 = ntl * 64;
        int coff = 0; if (wincols == 1) coff = (n0 < 1536) ? 0 : (n0 < 3072 ? 8 : 24);
        if (wincols == 2) { const int tl = n0 >> 8, w = n0 & 255; coff = (w < 128 ? 128 * tl + w : 2816 + 128 * tl + (w - 128)) - n0; }
        __syncthreads();
#pragma unroll
        for (int i = 0; i < 2; ++i) {
            const int kr = (F.tid >> 4) + 32 * i, nc = (F.tid & 15) * 4;
            f32x4 v = *(const f32x4*)(src + (size_t)(k0 + kr) * ldsrc + n0 + coff + nc);
            const float g = gain ? gain[k0 + kr] : 1.f;
            T[kr * 65 + nc + 0] = v[0] * g; T[kr * 65 + nc + 1] = v[1] * g; T[kr * 65 + nc + 2] = v[2] * g; T[kr * 65 + nc + 3] = v[3] * g;
        }
        __syncthreads();
        const int n = F.tid >> 3, kc = (F.tid & 7) * 8;
        u32x4 w;
        w.x = pk2(T[(kc + 0) * 65 + n], T[(kc + 1) * 65 + n]); w.y = pk2(T[(kc + 2) * 65 + n], T[(kc + 3) * 65 + n]);
        w.z = pk2(T[(kc + 4) * 65 + n], T[(kc + 5) * 65 + n]); w.w = pk2(T[(kc + 6) * 65 + n], T[(kc + 7) * 65 + n]);
        *(u32x4*)(dst + (size_t)(n0 + n) * K + k0 + kc) = w;
    }
    __syncthreads();
}
DEV void cvt_mixer(const Frame& F0, int l) {
    REFRAME;
    InTab in = F.in;
    cvt_mat(F, in[10] + (size_t)l * 1024 * 5656, 5656, 1024, 5632, 1, in[9] + l * 1024, ((bf16_t*)(F.ws + WS_WMIX)) + WM_WIN);
    cvt_mat(F, in[18] + (size_t)l * 512 * 1024, 1024, 512, 1024, 0, nullptr, ((bf16_t*)(F.ws + WS_WMIX)) + WM_WOA);
    cvt_mat(F, in[19] + (size_t)l * 512 * 1024, 1024, 512, 1024, 0, nullptr, ((bf16_t*)(F.ws + WS_WMIX)) + WM_WOB);
    cvt_mat(F, in[20] + (size_t)l * 1048576, 1024, 1024, 1024, 0, nullptr, ((bf16_t*)(F.ws + WS_WMIX)) + WM_WO);
    cvt_mat(F, in[23] + (size_t)l * 1048576, 1024, 1024, 1024, 0, in[21] + l * 1024, ((bf16_t*)(F.ws + WS_WMIX)) + WM_WMQ);
    cvt_mat(F, in[24] + (size_t)l * 1048576, 1024, 1024, 1024, 0, in[22] + l * 1024, ((bf16_t*)(F.ws + WS_WMIX)) + WM_WMK);
    cvt_mat(F, in[25] + (size_t)l * 1048576, 1024, 1024, 1024, 0, in[22] + l * 1024, ((bf16_t*)(F.ws + WS_WMIX)) + WM_WMV);
    cvt_mat(F, in[26] + (size_t)l * 1048576, 1024, 1024, 1024, 0, nullptr, ((bf16_t*)(F.ws + WS_WMIX)) + WM_WMO);
    const float* win = in[10] + (size_t)l * 1024 * 5656; const float* g = in[9] + l * 1024;
    for (int i = F.cb * 512 + F.tid; i < 32 * 1024; i += F.cn * 512) {
        const int n = i >> 10, k = i & 1023;
        float v = 0.f;
        if (n < 8) v = win[(size_t)k * 5656 + 1536 + n] * g[k]; else if (n < 24) v = win[(size_t)k * 5656 + 3080 + (n - 8)] * g[k];
        ((bf16_t*)(F.ws + WS_WMIX))[WM_WSM + i] = (bf16_t)(pk2(v, 0.f) & 0xffff);
    }
}
DEV void cvt_ffn(const Frame& F, int l) {
    cvt_mat(F, F.in[28] + (size_t)l * 1024 * 5632, 5632, 1024, 5632, 2, F.in[27] + l * 1024, ((bf16_t*)(F.ws + WS_WFFN)) + WF_UP);
    cvt_mat(F, F.in[31] + (size_t)l * 2816 * 1024, 1024, 2816, 1024, 0, nullptr, ((bf16_t*)(F.ws + WS_WFFN)) + WF_DN);
}

DEV void phase0(const Frame& F0) {
    REFRAME;
    const int gw = F.bid * 8 + F.wid, nw = F.nb * 8, lane = F.lane;
    for (int row = gw; row < TT + 4096; row += nw) {
        const bool ismem = row >= TT;
        const float* src = ismem ? F.in[8] + (size_t)(row - TT) * 1024 : (row < 32768 ? F.in[0] + (size_t)row * 1024 : F.in[1] + (size_t)(row - 32768) * 1024);
        f32x4 v[4]; float s = 0.f;
#pragma unroll
        for (int i = 0; i < 4; ++i) { v[i] = *(const f32x4*)(src + lane * 16 + i * 4); s += v[i][0] * v[i][0] + v[i][1] * v[i][1] + v[i][2] * v[i][2] + v[i][3] * v[i][3]; }
        u32x4 w0, w1;
        w0.x = pk2(v[0][0], v[0][1]); w0.y = pk2(v[0][2], v[0][3]); w0.z = pk2(v[1][0], v[1][1]); w0.w = pk2(v[1][2], v[1][3]);
        w1.x = pk2(v[2][0], v[2][1]); w1.y = pk2(v[2][2], v[2][3]); w1.z = pk2(v[3][0], v[3][1]); w1.w = pk2(v[3][2], v[3][3]);
        s += __shfl_xor(s, 1); s += __shfl_xor(s, 2);
        if (!ismem) {
            bf16_t* xb = ((bf16_t*)(F.ws + WS_XB)) + (size_t)row * 1024 + lane * 16;
            *(u32x4*)xb = w0; *(u32x4*)(xb + 8) = w1;
            if ((lane & 3) == 0) ((float*)(F.ws + WS_SSQ))[((size_t)(lane >> 4) * TT + row) * 4 + ((lane >> 2) & 3)] = s;
        } else {
            const int mr = row - TT;
            bf16_t* mb = ((bf16_t*)(F.ws + WS_MB)) + (size_t)mr * 1024 + lane * 16;
            *(u32x4*)mb = w0; *(u32x4*)(mb + 8) = w1;
            s += __shfl_xor(s, 4); s += __shfl_xor(s, 8); s += __shfl_xor(s, 16); s += __shfl_xor(s, 32);
            if (lane == 0) ((float*)(F.ws + WS_MRS))[mr] = rsqrtf(s * (1.f / 1024.f) + 1e-6f);
        }
    }
    cvt_mixer(F, 0);
    cvt_ffn(F, 0);
}

DEV void small_proj(const Frame& F0) {
    REFRAME;
    const int lane = F.lane, fr = lane & 15, fq = lane >> 4, mt = F.wid & 3, nt = F.wid >> 2;
    const bool part = F.nb == 256;
    if (part && (F.bid >> 3) < 6) return;
    for (int c = part ? ((F.bid >> 3) - 6) * 8 + (F.bid & 7) : F.bid; c < NCH; c += part ? 208 : F.nb) {
        const int row = c * 64 + mt * 16 + fr;
        const bf16_t* a = ((bf16_t*)(F.ws + WS_XB)) + (size_t)row * 1024 + 8 * fq;
        const bf16_t* b = ((bf16_t*)(F.ws + WS_WMIX)) + WM_WSM + (size_t)(nt * 16 + fr) * 1024 + 8 * fq;
        f32x4 acc = {0.f, 0.f, 0.f, 0.f};
#pragma unroll 4
        for (int k = 0; k < 32; ++k) acc = MFMA16(*(const bf16x8*)(b + k * 32), *(const bf16x8*)(a + k * 32), acc);
        const float rs = row_rstd(((float*)(F.ws + WS_SSQ)), row);
        *(f32x4*)(((float*)(F.ws + WS_SC)) + (size_t)row * 32 + nt * 16 + 4 * fq) = acc * rs;
    }
}

DEV void gemm_epilogue(const Frame& F0, const GDesc& d, int l, f32x4 (&acc)[2][2][4][2]) {
    REFRAME;
    int lane_ = F.lane; asm volatile("" : "+v"(lane_));
    const int wr = F.wid >> 2, wc = F.wid & 3, fr = lane_ & 15, fq = lane_ >> 4;
    float* red = (float*)(F.lds + 131072);
    if (d.epi == EPI_SOFTMAX) {
        float mx[2][4];
#pragma unroll
        for (int ai = 0; ai < 2; ++ai)
#pragma unroll
            for (int m = 0; m < 4; ++m) {
                float v = -3.0e38f;
#pragma unroll
                for (int bj = 0; bj < 2; ++bj)
#pragma unroll
                    for (int n = 0; n < 2; ++n) { const f32x4 x = acc[ai][bj][m][n]; v = fmaxf(v, fmaxf(fmaxf(x[0], x[1]), fmaxf(x[2], x[3]))); }
                v = fmaxf(v, __shfl_xor(v, 16)); v = fmaxf(v, __shfl_xor(v, 32));
                if (fq == 0) red[(ai * 128 + wr * 64 + m * 16 + fr) * 4 + wc] = v;
            }
        __syncthreads();
#pragma unroll
        for (int ai = 0; ai < 2; ++ai)
#pragma unroll
            for (int m = 0; m < 4; ++m) {
                const f32x4 r4 = *(const f32x4*)(red + (ai * 128 + wr * 64 + m * 16 + fr) * 4);
                const float rm = fmaxf(fmaxf(r4[0], r4[1]), fmaxf(r4[2], r4[3]));
                mx[ai][m] = rm; float s = 0.f;
#pragma unroll
                for (int bj = 0; bj < 2; ++bj)
#pragma unroll
                    for (int n = 0; n < 2; ++n) { f32x4 x = acc[ai][bj][m][n];
#pragma unroll
                        for (int j = 0; j < 4; ++j) { x[j] = __expf(x[j] - rm); s += x[j]; }
                        acc[ai][bj][m][n] = x; }
                s += __shfl_xor(s, 16); s += __shfl_xor(s, 32);
                if (fq == 0) red[1024 + (ai * 128 + wr * 64 + m * 16 + fr) * 4 + wc] = s;
            }
        (void)mx;
        __syncthreads();
#pragma unroll
        for (int ai = 0; ai < 2; ++ai)
#pragma unroll
            for (int m = 0; m < 4; ++m) {
                const f32x4 r4 = *(const f32x4*)(red + 1024 + (ai * 128 + wr * 64 + m * 16 + fr) * 4);
                const float inv = 1.f / ((r4[0] + r4[1]) + (r4[2] + r4[3]));
                const bool valid = d.vai < 0 || (d.vai == ai && d.vwr == wr);
                const int row = d.orow + ai * 128 + wr * 64 + m * 16 + fr;
                if (valid) {
#pragma unroll
                    for (int bj = 0; bj < 2; ++bj)
#pragma unroll
                        for (int n = 0; n < 2; ++n) {
                            const int col = bj * 128 + wc * 32 + n * 16 + fq * 4;
                            *(u32x2*)(((bf16_t*)(F.ws + WS_P)) + (size_t)row * LDP + C_PR + d.head * 256 + col) = pk4(acc[ai][bj][m][n] * inv);
                        }
                }
            }
        __syncthreads();
        return;
    }
#pragma unroll
    for (int ai = 0; ai < 2; ++ai)
#pragma unroll
        for (int m = 0; m < 4; ++m) {
            const int row = d.orow + ai * 128 + wr * 64 + m * 16 + fr;
            float rs = 1.f, ss = 0.f;
            if (d.epi == EPI_PROJ || d.epi == EPI_UP || d.epi == EPI_Q) rs = row_rstd(((float*)(F.ws + WS_SSQ)), row);
            if (d.epi == EPI_Q) rs *= 0.0625f;
            if (d.epi == EPI_MEMK) rs = ((float*)(F.ws + WS_MRS))[row];
#pragma unroll
            for (int bj = 0; bj < 2; ++bj)
#pragma unroll
                for (int n = 0; n < 2; ++n) {
                    const int col = d.ocol + bj * 128 + wc * 32 + n * 16 + fq * 4;
                    f32x4 v = acc[ai][bj][m][n];
                    switch (d.epi) {
                    case EPI_UP: {
                        const int row_l = ai * 128 + wr * 64 + m * 16 + fr, cl = bj * 128 + wc * 32 + n * 16 + fq * 4;
                        *(u32x2*)((bf16_t*)F.lds + row_l * 264 + cl) = pk4(v * rs);
                    } break;
                    case EPI_PROJ: {
                        v = v * rs; const u32x2 w = pk4(v);
                        *(u32x2*)(((bf16_t*)(F.ws + WS_P)) + (size_t)row * LDP + col) = w;
                        if (m == 3 && fr >= 13 && col < 1536) {
                            const int chunk = row >> 6, hr = fr - 13;
                            *(u32x2*)(((bf16_t*)(F.ws + WS_KV)) + ((size_t)chunk * 3 + hr) * 1536 + col) = w;
                            if (chunk >= 512 || (chunk & 31) == 31) {
                                float* o = chunk < 512 ? F.out + O_GDNC_P + ((size_t)(l * 16 + (chunk >> 5)) * 3 + hr) * 1536 + col
                                                       : F.out + O_GDNC_S + ((size_t)(l * 8 + (chunk - 512)) * 3 + hr) * 1536 + col;
                                *(f32x4*)o = v;
                            }
                        }
                    } break;
                    case EPI_RESID: {
                        float* X = F.out + (size_t)row * 1024 + col;
                        const float* Xs = d.head ? (row < 32768 ? F.in[0] + (size_t)row * 1024 + col : F.in[1] + (size_t)(row - 32768) * 1024 + col) : X;
                        f32x4 x = *(const f32x4*)Xs; x = x + v; *(f32x4*)X = x;
                        *(u32x2*)(((bf16_t*)(F.ws + WS_XB)) + (size_t)row * 1024 + col) = pk4(x);
                        ss += (x[0] * x[0] + x[1] * x[1]) + (x[2] * x[2] + x[3] * x[3]);
                    } break;
                    case EPI_Q: *(u32x2*)(((bf16_t*)(F.ws + WS_P)) + (size_t)row * LDP + C_Q + col) = pk4(v * rs); break;
                    case EPI_MEMK: {
                        v = v * rs;
                        *(f32x4*)(F.out + O_MEMK + ((size_t)l * 4096 + row) * 1024 + col) = v;
                        *(u32x2*)(((bf16_t*)(F.ws + WS_KV)) + (size_t)row * 1024 + col) = pk4(v);
                    } break;
                    case EPI_MEMV: {
                        const f32x4 r4 = *(const f32x4*)(((float*)(F.ws + WS_MRS)) + col);
                        v = v * r4;
                        float* o = F.out + O_MEMV + ((size_t)l * 4096 + col) * 1024 + row;
                        o[0] = v[0]; o[1024] = v[1]; o[2048] = v[2]; o[3072] = v[3];
                        const int b = col >> 8, h = row >> 8;
                        *(u32x2*)(((bf16_t*)(F.ws + WS_KV + 6144ull * 1024 * 2)) + ((size_t)(b * 4 + h) * 256 + (row & 255)) * 256 + (col & 255)) = pk4(v);
                    } break;
                    case EPI_OUTA: {
                        const f32x4 g = unpk4(*(const u32x2*)(((bf16_t*)(F.ws + WS_P)) + (size_t)row * LDP + C_GA + col));
                        f32x4 o; for (int j = 0; j < 4; ++j) o[j] = sigm(g[j]) * v[j];
                        *(u32x2*)(((bf16_t*)(F.ws + WS_P)) + (size_t)row * LDP + C_MRG + col) = pk4(o);
                    } break;
                    case EPI_OUTB: {
                        const f32x4 g = unpk4(*(const u32x2*)(((bf16_t*)(F.ws + WS_P)) + (size_t)row * LDP + C_GB + col));
                        f32x4 o = unpk4(*(const u32x2*)(((bf16_t*)(F.ws + WS_P)) + (size_t)row * LDP + C_MRG + col));
                        for (int j = 0; j < 4; ++j) o[j] += sigm(g[j]) * v[j];
                        *(u32x2*)(((bf16_t*)(F.ws + WS_P)) + (size_t)row * LDP + C_MRG + col) = pk4(o);
                    } break;
                    case EPI_ATTNO: {
                        const bool valid = d.vai < 0 || (d.vai == ai && d.vwr == wr);
                        if (valid) *(u32x2*)(((bf16_t*)(F.ws + WS_P)) + (size_t)row * LDP + C_O + d.head * 256 + col) = pk4(v);
                    } break;
                    default: break;
                    }
                }
            if (d.epi == EPI_RESID) {
                ss += __shfl_xor(ss, 16); ss += __shfl_xor(ss, 32);
                if (fq == 0) ((float*)(F.ws + WS_SSQ))[((size_t)(d.ocol >> 8) * TT + row) * 4 + wc] = ss;
            }
        }
    if (d.epi == EPI_UP) {
        bf16_t* ST = (bf16_t*)F.lds;
        const int pm = d.brow >> 8, pn = d.bcol >> 8;
        const bool samp = pm >= 128, needfix = !samp && (pm & 7) != 0;
        bf16_t* halo = ((bf16_t*)(F.ws + WS_KV)); bf16_t* raw01 = ((bf16_t*)(F.ws + WS_KV + 11714560ull));
        __syncthreads();
        {
            const int hsel = F.tid >> 6, cl4 = (F.tid & 63) * 4, ocol = ((cl4 >> 7) ? 2816 : 0) + 128 * pn + (cl4 & 127);
            const int row_l = (hsel >> 1) * 64 + 62 + (hsel & 1), chunk = (d.brow + row_l) >> 6, hr = hsel & 1;
            const u32x2 w = *(const u32x2*)(ST + row_l * 264 + cl4);
            *(u32x2*)(halo + ((size_t)chunk * 2 + hr) * 5632 + ocol) = w;
            if (chunk >= 512 || (chunk & 31) == 31) {
                float* o = chunk < 512 ? F.out + O_FFNC_P + ((size_t)(l * 16 + (chunk >> 5)) * 2 + hr) * 5632 + ocol
                                       : F.out + O_FFNC_S + ((size_t)(l * 8 + (chunk - 512)) * 2 + hr) * 5632 + ocol;
                *(f32x4*)o = unpk4(w);
            }
            if (needfix && hsel < 2) *(u32x2*)(raw01 + ((size_t)pm * 2 + hsel) * 5632 + ocol) = *(const u32x2*)(ST + hsel * 264 + cl4);
        }
        {
            const int cq = F.tid & 31, rg = F.tid >> 5, c4 = cq * 4, gcol = 128 * pn + c4, r0 = rg * 16;
            const float* cw = F.in[29] + (size_t)l * 3 * 5632; const float* cb = F.in[30] + (size_t)l * 5632;
            const f32x4 wg0 = *(const f32x4*)(cw + gcol), wg1 = *(const f32x4*)(cw + 5632 + gcol), wg2 = *(const f32x4*)(cw + 2 * 5632 + gcol), bg = *(const f32x4*)(cb + gcol);
            const f32x4 wv0 = *(const f32x4*)(cw + 2816 + gcol), wv1 = *(const f32x4*)(cw + 5632 + 2816 + gcol), wv2 = *(const f32x4*)(cw + 2 * 5632 + 2816 + gcol), bv = *(const f32x4*)(cb + 2816 + gcol);
            f32x4 g2 = {0.f, 0.f, 0.f, 0.f}, g1 = g2, v2 = g2, v1 = g2; bool skip2 = false;
            if ((samp ? (r0 & 63) : r0) != 0) {
                g2 = unpk4(*(const u32x2*)(ST + (r0 - 2) * 264 + c4)); g1 = unpk4(*(const u32x2*)(ST + (r0 - 1) * 264 + c4));
                v2 = unpk4(*(const u32x2*)(ST + (r0 - 2) * 264 + 128 + c4)); v1 = unpk4(*(const u32x2*)(ST + (r0 - 1) * 264 + 128 + c4));
            } else if (samp) {
                const float* sp = F.in[5] + (size_t)(l * 8 + (((d.brow + r0) >> 6) - 512)) * 2 * 5632;
                g2 = *(const f32x4*)(sp + gcol); g1 = *(const f32x4*)(sp + 5632 + gcol); v2 = *(const f32x4*)(sp + 2816 + gcol); v1 = *(const f32x4*)(sp + 5632 + 2816 + gcol);
            } else skip2 = needfix;
#pragma unroll 4
            for (int i = 0; i < 16; ++i) {
                const int row_l = r0 + i;
                const f32x4 g0 = unpk4(*(const u32x2*)(ST + row_l * 264 + c4)), v0 = unpk4(*(const u32x2*)(ST + row_l * 264 + 128 + c4));
                f32x4 o;
#pragma unroll
                for (int j = 0; j < 4; ++j) { const float yg = wg0[j] * g2[j] + wg1[j] * g1[j] + wg2[j] * g0[j] + bg[j], yv = wv0[j] * v2[j] + wv1[j] * v1[j] + wv2[j] * v0[j] + bv[j]; o[j] = silu(yg) * yv; }
                if (!(skip2 && i < 2)) *(u32x2*)(((bf16_t*)(F.ws + WS_P)) + (size_t)(d.brow + row_l) * LDP + gcol) = pk4(o);
                g2 = g1; g1 = g0; v2 = v1; v1 = v0;
            }
        }
        __syncthreads();
    }
}

DEV void sample_rows_gemm(const Frame& F0, const bf16_t* A, int lda, const bf16_t* Bt, int K, int resid) {
    REFRAME;
    if (F.nb != 256) return;
    const int fr = F.lane & 15, fq = F.lane >> 4, w = F.wid, rgp = F.bid >> 3, cg = F.bid & 7;
    const int row = 32768 + rgp * 16 + fr, colt = cg * 128 + w * 16;
    const bf16_t* ap = A + (size_t)row * lda + 8 * fq;
    const bf16_t* bp = Bt + (size_t)(colt + fr) * K + 8 * fq;
    f32x4 acc = {0.f, 0.f, 0.f, 0.f};
#pragma unroll 8
    for (int k = 0; k < K; k += 32) acc = MFMA16(*(const bf16x8*)(bp + k), *(const bf16x8*)(ap + k), acc);
    const int col = colt + 4 * fq;
    if (resid == 1 || resid == 4) {
        float* X = F.out + (size_t)row * 1024 + col;
        const float* Xs = resid == 4 ? F.in[1] + (size_t)(row - 32768) * 1024 + col : X;
        f32x4 x = *(const f32x4*)Xs; x = x + acc; *(f32x4*)X = x;
        *(u32x2*)(((bf16_t*)(F.ws + WS_XB)) + (size_t)row * 1024 + col) = pk4(x);
        float ss = (x[0] * x[0] + x[1] * x[1]) + (x[2] * x[2] + x[3] * x[3]);
        ss += __shfl_xor(ss, 16); ss += __shfl_xor(ss, 32);
        float* red = (float*)F.lds;
        __syncthreads();
        if (fq == 0) red[fr * 8 + w] = ss;
        __syncthreads();
        if (F.tid < 32) {
            const int r = F.tid & 15, g = F.tid >> 4, c0 = cg * 128 + g * 64;
            const float t = (red[r * 8 + g * 4] + red[r * 8 + g * 4 + 1]) + (red[r * 8 + g * 4 + 2] + red[r * 8 + g * 4 + 3]);
            ((float*)(F.ws + WS_SSQ))[((size_t)(c0 >> 8) * TT + 32768 + rgp * 16 + r) * 4 + ((c0 >> 6) & 3)] = t;
        }
        __syncthreads();
    } else if (resid == 0) {
        const float rs = row_rstd(((float*)(F.ws + WS_SSQ)), row) * 0.0625f;
        *(u32x2*)(((bf16_t*)(F.ws + WS_P)) + (size_t)row * LDP + C_Q + col) = pk4(acc * rs);
    } else {
        bf16_t* prow = ((bf16_t*)(F.ws + WS_P)) + (size_t)row * LDP;
        const f32x4 g = unpk4(*(const u32x2*)(prow + (resid == 2 ? C_GA : C_GB) + col));
        f32x4 o = {0.f, 0.f, 0.f, 0.f};
        if (resid == 3) o = unpk4(*(const u32x2*)(prow + C_MRG + col));
#pragma unroll
        for (int j = 0; j < 4; ++j) o[j] += sigm(g[j]) * acc[j];
        *(u32x2*)(prow + C_MRG + col) = pk4(o);
    }
}

enum { GP_IN = 0, GP_OUT, GP_WO, GP_MQ, GP_ATTN, GP_MO, GP_UP, GP_DOWN, GP_ATTN2, GP_OUT2, GP_MEMKV };
DEV void gemm_phase(const Frame& F0, int kind, int l) {
    REFRAME;
    int nunits = 0;
    switch (kind) { case GP_IN: case GP_UP: nunits = 130 * 22; break; case GP_OUT: nunits = 520 + 128; break; case GP_OUT2: nunits = 520; break; case GP_ATTN: case GP_ATTN2: nunits = 512 + 32; break; default: nunits = 520; }
    const bool srow = (F.nb == 256) && (kind == GP_WO || kind == GP_MQ || kind == GP_MO || kind == GP_DOWN || kind == GP_OUT || kind == GP_OUT2);
    if (srow) nunits = 512;
    if (kind == GP_MEMKV) nunits = 128;
    f32x4 acc[2][2][4][2];
    const bool xmap = (F.nb == 256) && (kind == GP_IN || kind == GP_UP || kind == GP_WO || kind == GP_MQ || kind == GP_MO || kind == GP_DOWN || kind == GP_OUT2 || (kind == GP_OUT && srow));
    const int xcd = F.bid & 7, slot = F.bid >> 3, w_lo = (int)(((long)nunits * xcd) >> 3), w_hi = (int)(((long)nunits * (xcd + 1)) >> 3);
    const bool mkv = kind == GP_MEMKV;
    for (int u0 = mkv ? (F.bid >= 192 ? F.bid - 192 : nunits) : (xmap ? w_lo + slot : F.bid); u0 < (xmap ? w_hi : nunits); u0 += mkv ? 64 : (xmap ? 32 : F.nb)) {
        for (int sb = 0; sb < ((kind == GP_OUT && srow) ? 2 : 1); ++sb) {
        int u = u0;
        if (xmap) { const int nn = (kind == GP_IN || kind == GP_UP) ? 22 : 4; const int nm = srow ? 128 : 130; const int pn_ = u0 / nm, pm_ = u0 % nm; u = pm_ * nn + pn_; }
        GDesc d;
        { const int sub = (kind == GP_ATTN2 || kind == GP_OUT2 || sb) ? 1 : 0;
            d.vai = -1; d.vwr = 0; d.head = 0;
            switch (kind) {
            case GP_IN: { const int pm = u / 22, pn = u % 22; d.A = ((bf16_t*)(F.ws + WS_XB)); d.lda = 1024; d.Bt = ((bf16_t*)(F.ws + WS_WMIX)) + WM_WIN; d.ldb = 1024; d.K = 1024; d.brow = pm * 256; d.bcol = pn * 256; d.epi = EPI_PROJ; d.orow = d.brow; d.ocol = d.bcol; } break;
            case GP_UP: { const int pm = u / 22, pn = u % 22; d.A = ((bf16_t*)(F.ws + WS_XB)); d.lda = 1024; d.Bt = ((bf16_t*)(F.ws + WS_WFFN)) + WF_UP; d.ldb = 1024; d.K = 1024; d.brow = pm * 256; d.bcol = pn * 256; d.epi = EPI_UP; d.orow = d.brow; d.ocol = d.bcol; } break;
            case GP_MEMKV: case GP_OUT: case GP_OUT2:
                if (kind == GP_MEMKV) u += 520;
                if (u < 520) { const int pm = u >> 2, pn = u & 3; d.A = ((bf16_t*)(F.ws + WS_P)) + (sub == 0 ? C_ZA : C_ZB); d.lda = LDP; d.Bt = ((bf16_t*)(F.ws + WS_WMIX)) + (sub == 0 ? WM_WOA : WM_WOB); d.ldb = 512; d.K = 512;
                               d.brow = pm * 256; d.bcol = pn * 256; d.epi = sub == 0 ? EPI_OUTA : EPI_OUTB; d.orow = d.brow; d.ocol = d.bcol; }
                else if (u < 520 + 64) { const int v = u - 520, pm = v >> 2, pn = v & 3; d.A = ((bf16_t*)(F.ws + WS_MB)); d.lda = 1024; d.Bt = ((bf16_t*)(F.ws + WS_WMIX)) + WM_WMK; d.ldb = 1024; d.K = 1024; d.brow = pm * 256; d.bcol = pn * 256; d.epi = EPI_MEMK; d.orow = d.brow; d.ocol = d.bcol; }
                else { const int v = u - 584, pm = v & 3, pn = v >> 2; d.A = ((bf16_t*)(F.ws + WS_WMIX)) + WM_WMV; d.lda = 1024; d.Bt = ((bf16_t*)(F.ws + WS_MB)); d.ldb = 1024; d.K = 1024; d.brow = pm * 256; d.bcol = pn * 256; d.epi = EPI_MEMV; d.orow = d.brow; d.ocol = d.bcol; }
                break;
            case GP_WO: { d.head = (l == 0); const int pm = u >> 2, pn = u & 3; d.A = ((bf16_t*)(F.ws + WS_P)) + C_MRG; d.lda = LDP; d.Bt = ((bf16_t*)(F.ws + WS_WMIX)) + WM_WO; d.ldb = 1024; d.K = 1024; d.brow = pm * 256; d.bcol = pn * 256; d.epi = EPI_RESID; d.orow = d.brow; d.ocol = d.bcol; } break;
            case GP_MQ: { const int pm = u >> 2, pn = u & 3; d.A = ((bf16_t*)(F.ws + WS_XB)); d.lda = 1024; d.Bt = ((bf16_t*)(F.ws + WS_WMIX)) + WM_WMQ; d.ldb = 1024; d.K = 1024; d.brow = pm * 256; d.bcol = pn * 256; d.epi = EPI_Q; d.orow = d.brow; d.ocol = d.bcol; } break;
            case GP_MO: { const int pm = u >> 2, pn = u & 3; d.A = ((bf16_t*)(F.ws + WS_P)) + C_O; d.lda = LDP; d.Bt = ((bf16_t*)(F.ws + WS_WMIX)) + WM_WMO; d.ldb = 1024; d.K = 1024; d.brow = pm * 256; d.bcol = pn * 256; d.epi = EPI_RESID; d.orow = d.brow; d.ocol = d.bcol; } break;
            case GP_DOWN: { const int pm = u >> 2, pn = u & 3; d.A = ((bf16_t*)(F.ws + WS_P)); d.lda = LDP; d.Bt = ((bf16_t*)(F.ws + WS_WFFN)) + WF_DN; d.ldb = 2816; d.K = 2816; d.brow = pm * 256; d.bcol = pn * 256; d.epi = EPI_RESID; d.orow = d.brow; d.ocol = d.bcol; } break;
            case GP_ATTN: case GP_ATTN2: {
                int pm, h, b;
                if (u < 512) { pm = u >> 2; h = u & 3; b = pm >> 3; }
                else { const int v = u - 512; h = v & 3; const int bi = (v >> 2) & 3, t = v >> 4; pm = 128 + t; b = 16 + 4 * t + bi; d.vai = bi >> 1; d.vwr = bi & 1; }
                d.head = h; d.brow = pm * 256; d.orow = d.brow; d.ocol = 0; d.K = 256; d.bcol = 0;
                if (sub == 0) { d.A = ((bf16_t*)(F.ws + WS_P)) + C_Q + h * 256; d.lda = LDP; d.Bt = ((bf16_t*)(F.ws + WS_KV)) + (size_t)b * 256 * 1024 + h * 256; d.ldb = 1024; d.epi = EPI_SOFTMAX; }
                else { d.A = ((bf16_t*)(F.ws + WS_P)) + C_PR + h * 256; d.lda = LDP; d.Bt = ((bf16_t*)(F.ws + WS_KV + 6144ull * 1024 * 2)) + (size_t)(b * 4 + h) * 65536; d.ldb = 256; d.epi = EPI_ATTNO; }
            } break;
            }
        }
        if (sb) { asm volatile("s_waitcnt vmcnt(0)" ::: "memory"); __syncthreads(); }
        gemm_core(d.A, d.lda, d.Bt, d.ldb, d.K, d.brow, d.bcol, acc, (bf16_t*)F.lds);
        gemm_epilogue(F, d, l, acc);
        }
    }
    if (srow) {
        __syncthreads();
        if (kind == GP_WO) sample_rows_gemm(F, ((bf16_t*)(F.ws + WS_P)) + C_MRG, LDP, ((bf16_t*)(F.ws + WS_WMIX)) + WM_WO, 1024, l == 0 ? 4 : 1);
        else if (kind == GP_MQ) sample_rows_gemm(F, ((bf16_t*)(F.ws + WS_XB)), 1024, ((bf16_t*)(F.ws + WS_WMIX)) + WM_WMQ, 1024, 0);
        else if (kind == GP_OUT) { sample_rows_gemm(F, ((bf16_t*)(F.ws + WS_P)) + C_ZA, LDP, ((bf16_t*)(F.ws + WS_WMIX)) + WM_WOA, 512, 2); asm volatile("s_waitcnt vmcnt(0)" ::: "memory");
                                   sample_rows_gemm(F, ((bf16_t*)(F.ws + WS_P)) + C_ZB, LDP, ((bf16_t*)(F.ws + WS_WMIX)) + WM_WOB, 512, 3); }
        else if (kind == GP_OUT2) sample_rows_gemm(F, ((bf16_t*)(F.ws + WS_P)) + C_ZB, LDP, ((bf16_t*)(F.ws + WS_WMIX)) + WM_WOB, 512, 3);
        else if (kind == GP_MO) sample_rows_gemm(F, ((bf16_t*)(F.ws + WS_P)) + C_O, LDP, ((bf16_t*)(F.ws + WS_WMIX)) + WM_WMO, 1024, 1);
        else sample_rows_gemm(F, ((bf16_t*)(F.ws + WS_P)), LDP, ((bf16_t*)(F.ws + WS_WFFN)) + WF_DN, 2816, 1);
    }
}

DEV void sample_kv(const Frame& F0, int l) {
    REFRAME;
    const float* ck = F.in[6] + (size_t)l * 2097152; const float* cv = F.in[7] + (size_t)l * 2097152;
    const bool idle = F.nb == 256;
    if (idle && F.bid < 192) return;
    for (int i = (idle ? F.bid - 192 : F.bid) * 512 + F.tid; i < 262144; i += (idle ? 64 : F.nb) * 512) {
        const f32x4 a = *(const f32x4*)(ck + (size_t)i * 8), b = *(const f32x4*)(ck + (size_t)i * 8 + 4);
        u32x4 w; w.x = pk2(a[0], a[1]); w.y = pk2(a[2], a[3]); w.z = pk2(b[0], b[1]); w.w = pk2(b[2], b[3]);
        *(u32x4*)(((bf16_t*)(F.ws + WS_KV)) + 4096ull * 1024 + (size_t)i * 8) = w;
        const int dd = i & 255, m8 = (i >> 8) & 31, h = (i >> 13) & 3, bb = i >> 15;
        const float* s = cv + ((size_t)(bb * 256 + m8 * 8) * 4 + h) * 256 + dd;
        u32x4 x; x.x = pk2(s[0], s[1024]); x.y = pk2(s[2048], s[3072]); x.z = pk2(s[4096], s[5120]); x.w = pk2(s[6144], s[7168]);
        *(u32x4*)(((bf16_t*)(F.ws + WS_KV + 6144ull * 1024 * 2)) + ((size_t)((16 + bb) * 4 + h) * 256 + dd) * 256 + m8 * 8) = x;
    }
}

DEV void g1_gdn(const Frame& F0, int l, int c, int h) {
    REFRAME;
    float* Fq = (float*)F.lds;
    bf16_t* VS = (bf16_t*)(F.lds + 66560);
    bf16_t* QN = (bf16_t*)(F.lds + 82944);
    bf16_t* KN = (bf16_t*)(F.lds + 100352);
    float* AM = (float*)(F.lds + 117760);
    float* sB = (float*)(F.lds + 135168); float* sG = sB + 64; float* sRQ = sB + 128; float* sRK = sB + 192;
    const int tid = F.tid, lane = F.lane, t0 = c * 64;
    const bool first = c >= 512 || (c & 31) == 0; const bool sample = c >= 512;
    __syncthreads();
    if (F.wid == 7) {
        const int t = t0 + lane;
        const float braw = ((float*)(F.ws + WS_SC))[(size_t)t * 32 + h], araw = ((float*)(F.ws + WS_SC))[(size_t)t * 32 + 4 + h];
        const float beta = sigm(braw);
        float g = -__expf(F.in[12][l * 4 + h]) * softplus(araw + F.in[13][l * 4 + h]);
#pragma unroll
        for (int off = 1; off < 64; off <<= 1) { const float n = __shfl_up(g, off); if (lane >= off) g += n; }
        sB[lane] = beta; sG[lane] = g;
        if (!F.dry) ((float*)(F.ws + WS_BG))[((size_t)c * 4 + h) * 128 + lane] = beta; if (!F.dry) ((float*)(F.ws + WS_BG))[((size_t)c * 4 + h) * 128 + 64 + lane] = g;
    }
    const float* cw = F.in[11] + (size_t)l * 4 * 1536;
    if (tid < 384) {
        const int cp = tid % 192, rh = tid / 192, which = cp >> 6, cc = (cp & 63) * 2, pcol = which * 512 + h * 128 + cc;
        const f32x2 w0 = *(const f32x2*)(cw + pcol), w1 = *(const f32x2*)(cw + 1536 + pcol), w2 = *(const f32x2*)(cw + 2 * 1536 + pcol), w3 = *(const f32x2*)(cw + 3 * 1536 + pcol);
        float x0[35], x1[35];
#pragma unroll
        for (int i = 0; i < 3; ++i) {
            x0[i] = 0.f; x1[i] = 0.f;
            if (rh == 1) { const unsigned u = *(const unsigned*)(((bf16_t*)(F.ws + WS_P)) + (size_t)(t0 + 29 + i) * LDP + pcol); x0[i] = bflo(u); x1[i] = bfhi(u); }
            else if (!first) { const unsigned u = *(const unsigned*)(((bf16_t*)(F.ws + WS_KV)) + ((size_t)(c - 1) * 3 + i) * 1536 + pcol); x0[i] = bflo(u); x1[i] = bfhi(u); }
            else if (sample) { const f32x2 f = *(const f32x2*)(F.in[3] + ((size_t)(l * 8 + (c - 512)) * 3 + i) * 1536 + pcol); x0[i] = f[0]; x1[i] = f[1]; }
        }
#pragma unroll
        for (int i = 0; i < 32; ++i) { const unsigned u = *(const unsigned*)(((bf16_t*)(F.ws + WS_P)) + (size_t)(t0 + 32 * rh + i) * LDP + pcol); x0[3 + i] = bflo(u); x1[3 + i] = bfhi(u); }
#pragma unroll
        for (int r = 0; r < 32; ++r) {
            float a0 = w0[0] * x0[r] + w1[0] * x0[r + 1] + w2[0] * x0[r + 2] + w3[0] * x0[r + 3];
            float a1 = w0[1] * x1[r] + w1[1] * x1[r + 1] + w2[1] * x1[r + 2] + w3[1] * x1[r + 3];
            a0 = silu(a0); a1 = silu(a1);
            const int rr = 32 * rh + r;
            if (which < 2) { *(f32x2*)(Fq + rr * 260 + which * 128 + cc) = (f32x2){a0, a1}; }
            else { *(unsigned*)(VS + rr * 128 + cc) = pk2(a0, a1); }
        }
    }
    __syncthreads();
    {
        const int r = tid >> 3, j = tid & 7; const float* p = Fq + r * 260 + j * 32; float s = 0.f;
#pragma unroll
        for (int i = 0; i < 32; ++i) s += p[i] * p[i];
        s += __shfl_xor(s, 1); s += __shfl_xor(s, 2);
        if ((j & 3) == 0) { if (j == 0) sRQ[r] = rsqrtf(s + 1e-6f) * 0.08838834764831845f; else sRK[r] = rsqrtf(s + 1e-6f); }
    }
    __syncthreads();
    for (int idx = tid; idx < 64 * 64; idx += 512) {
        const int r = idx >> 6, c4 = (idx & 63) * 4; const bool isq = c4 < 128;
        f32x4 v = *(const f32x4*)(Fq + r * 260 + c4); v = v * (isq ? sRQ[r] : sRK[r]);
        const u32x2 w = pk4(v);
        if (isq) { *(u32x2*)(QN + r * 136 + c4) = w; if (!F.dry) *(u32x2*)(((bf16_t*)(F.ws + WS_P)) + (size_t)(t0 + r) * LDP + C_QA + h * 128 + c4) = w; }
        else { *(u32x2*)(KN + r * 136 + c4 - 128) = w; if (!F.dry) *(u32x2*)(((bf16_t*)(F.ws + WS_P)) + (size_t)(t0 + r) * LDP + C_KA + h * 128 + c4 - 128) = w; }
    }
    for (int idx = tid; idx < 64 * 32; idx += 512) {
        const int r = idx >> 5, c4 = (idx & 31) * 4;
        if (!F.dry) *(u32x2*)(((bf16_t*)(F.ws + WS_P)) + (size_t)(t0 + r) * LDP + C_VA + h * 128 + c4) = pk4(unpk4(*(const u32x2*)(VS + r * 128 + c4)) * sB[r]);
    }
    __syncthreads();
    {
        const int fr = lane & 15, fq = lane >> 4, which = F.wid >> 2, it = F.wid & 3;
        const bf16_t* X = which ? QN : KN;
        const int crow = 16 * it + fr; const float gc = sG[crow], bc = sB[crow];
        for (int jt = 0; jt < 4; ++jt) {
            f32x4 a = {0.f, 0.f, 0.f, 0.f};
            if (jt <= it) {
#pragma unroll
                for (int ks = 0; ks < 4; ++ks) a = MFMA16(ldfrag(KN, 16 * jt + fr, 136, 32 * ks, fq), ldfrag(X, crow, 136, 32 * ks, fq), a);
            }
            f32x4 o;
#pragma unroll
            for (int j = 0; j < 4; ++j) {
                const int s = 16 * jt + 4 * fq + j;
                const bool keep = which ? (s <= crow) : (s < crow);
                const float dec = keep ? __expf(gc - sG[s]) : 0.f;
                o[j] = a[j] * dec * (which ? 1.f : bc);
            }
            if (which) { if (!F.dry) *(u32x2*)(((bf16_t*)(F.ws + WS_XB)) + (size_t)(t0 + crow) * LDE + h * 128 + 64 + 16 * jt + 4 * fq) = pk4(o); }
            else *(f32x4*)(AM + crow * 68 + 16 * jt + 4 * fq) = o;
        }
    }
    __syncthreads();
    {
        float* TF = (float*)F.lds;
        float* MS = (float*)(F.lds + 20480);
        const int w = F.wid;
        if (w == 0) {
            const int blk = lane >> 4, cc = lane & 15, base = blk * 16;
            float Tc[16];
#pragma unroll
            for (int i = 0; i < 16; ++i) {
                float a = (i == cc) ? 1.f : 0.f;
#pragma unroll
                for (int j = 0; j < i; ++j) a -= AM[(base + i) * 68 + base + j] * Tc[j];
                Tc[i] = a;
            }
#pragma unroll
            for (int i = 0; i < 16; ++i) TF[(base + i) * 68 + base + cc] = Tc[i];
        }
        __syncthreads();
#pragma unroll 1
        for (int dd = 1; dd < 4; ++dd) {
            if (w < 4 - dd) {
                const int I = w + dd, J = w, r = lane >> 2, c4 = (lane & 3) * 4;
                f32x4 mm = {0.f, 0.f, 0.f, 0.f};
                for (int K = J; K < I; ++K)
#pragma unroll
                    for (int k = 0; k < 16; ++k) { const float a = AM[(I * 16 + r) * 68 + K * 16 + k]; const f32x4 t = *(const f32x4*)(TF + (K * 16 + k) * 68 + J * 16 + c4); mm = mm + a * t; }
                float* ms = MS + w * 256;
                *(f32x4*)(ms + r * 16 + c4) = mm;
                asm volatile("s_waitcnt lgkmcnt(0)" ::: "memory");
                f32x4 o = {0.f, 0.f, 0.f, 0.f};
#pragma unroll
                for (int k = 0; k < 16; ++k) { const float a = TF[(I * 16 + r) * 68 + I * 16 + k]; const f32x4 t = *(const f32x4*)(ms + k * 16 + c4); o = o - a * t; }
                *(f32x4*)(TF + (I * 16 + r) * 68 + J * 16 + c4) = o;
            }
            __syncthreads();
        }
        {
            const int r = tid >> 3, c8 = (tid & 7) * 8; const bool z = (c8 >> 4) > (r >> 4);
            const f32x4 a = z ? (f32x4){0.f, 0.f, 0.f, 0.f} : *(const f32x4*)(TF + r * 68 + c8), b = z ? (f32x4){0.f, 0.f, 0.f, 0.f} : *(const f32x4*)(TF + r * 68 + c8 + 4);
            u32x4 o; o.x = pk2(a[0], a[1]); o.y = pk2(a[2], a[3]); o.z = pk2(b[0], b[1]); o.w = pk2(b[2], b[3]);
            if (!F.dry) *(u32x4*)(((bf16_t*)(F.ws + WS_XB)) + (size_t)(t0 + r) * LDE + h * 128 + c8) = o;
        }
    }
}

DEV void g1_gla(const Frame& F0, int l, int c, int h) {
    REFRAME;
    float* GL = (float*)F.lds;
    float* LA = (float*)(F.lds + 4096);
    bf16_t* QG = (bf16_t*)(F.lds + 20736);
    bf16_t* KI = (bf16_t*)(F.lds + 29952);
    const int tid = F.tid, lane = F.lane, t0 = c * 64;
    __syncthreads();
    if (tid < 256) { const int r = tid >> 2, q4 = (tid & 3) * 4; *(f32x4*)(GL + r * 16 + q4) = *(const f32x4*)(((float*)(F.ws + WS_SC)) + (size_t)(t0 + r) * 32 + 8 + q4); }
    __syncthreads();
    {
        const int dk = tid & 63, rb = tid >> 6;
        float w2[16];
#pragma unroll
        for (int i = 0; i < 16; ++i) w2[i] = F.in[15][(size_t)(l * 16 + i) * 256 + h * 64 + dk];
        const float bias = F.in[16][l * 256 + h * 64 + dk];
#pragma unroll
        for (int rr = 0; rr < 8; ++rr) {
            const int r = rb * 8 + rr; float x = bias;
#pragma unroll
            for (int i = 0; i < 16; ++i) x += GL[r * 16 + i] * w2[i];
            LA[r * 65 + dk] = logsigmoid(x) * 0.0625f;
        }
    }
    __syncthreads();
    if (tid < 64) {
        float g = 0.f;
#pragma unroll 8
        for (int r = 0; r < 64; ++r) { g += LA[r * 65 + tid]; LA[r * 65 + tid] = g; }
        if (!F.dry) ((float*)(F.ws + WS_DL))[((size_t)c * 4 + h) * 64 + tid] = __expf(g);
    }
    __syncthreads();
    for (int idx = tid; idx < 64 * 16; idx += 512) {
        const int r = idx >> 4, c4 = (idx & 15) * 4;
        bf16_t* qp = ((bf16_t*)(F.ws + WS_P)) + (size_t)(t0 + r) * LDP + C_QB + h * 64 + c4; bf16_t* kp = ((bf16_t*)(F.ws + WS_P)) + (size_t)(t0 + r) * LDP + C_KB + h * 64 + c4;
        const f32x4 q = unpk4(*(const u32x2*)qp), k = unpk4(*(const u32x2*)kp);
        f32x4 qg, ki, kg;
#pragma unroll
        for (int j = 0; j < 4; ++j) { const float g = LA[r * 65 + c4 + j], gl = LA[63 * 65 + c4 + j];
            qg[j] = q[j] * 0.125f * __expf(g); ki[j] = k[j] * __expf(-g); kg[j] = k[j] * __expf(gl - g); }
        const u32x2 wq = pk4(qg);
        *(u32x2*)(QG + r * 72 + c4) = wq; *(u32x2*)(KI + r * 72 + c4) = pk4(ki);
        if (!F.dry) *(u32x2*)qp = wq; if (!F.dry) *(u32x2*)kp = pk4(kg);
    }
    __syncthreads();
    {
        const int fr = lane & 15, fq = lane >> 4, it = F.wid >> 1; const int crow = 16 * it + fr;
#pragma unroll
        for (int q = 0; q < 2; ++q) {
            const int jt = (F.wid & 1) * 2 + q;
            f32x4 a = {0.f, 0.f, 0.f, 0.f};
            if (jt <= it) {
#pragma unroll
                for (int ks = 0; ks < 2; ++ks) a = MFMA16(ldfrag(KI, 16 * jt + fr, 72, 32 * ks, fq), ldfrag(QG, crow, 72, 32 * ks, fq), a);
            }
#pragma unroll
            for (int j = 0; j < 4; ++j) if (16 * jt + 4 * fq + j > crow) a[j] = 0.f;
            if (!F.dry) *(u32x2*)(((bf16_t*)(F.ws + WS_XB)) + (size_t)(t0 + crow) * LDE + 512 + h * 64 + 16 * jt + 4 * fq) = pk4(a);
        }
    }
}

DEV void g2_gdn(const Frame& F0, int l, int s, int h) {
    REFRAME;
    bf16_t* QN = (bf16_t*)F.lds;
    bf16_t* KN = (bf16_t*)(F.lds + 17408);
    bf16_t* KT = (bf16_t*)(F.lds + 34816);
    bf16_t* TM = (bf16_t*)(F.lds + 53248);
    bf16_t* AQ = (bf16_t*)(F.lds + 62464);
    float* sB = (float*)(F.lds + 71680); float* sG = sB + 64;
    float* RED = (float*)(F.lds + 72192);
    bf16_t* VV = (bf16_t*)(F.lds + 74240);
    bf16_t* ZZ0 = (bf16_t*)(F.lds + 91648);
    const int tid = F.tid, lane = F.lane, w = F.wid, fr = lane & 15, fq = lane >> 4;
    const bool sample = s >= 16; const int nchunk = sample ? 1 : 32; const int tbase = sample ? 32768 + (s - 16) * 64 : s * 2048;
    const int dvc = h * 128 + 16 * w + fr;
    f32x4 S[8];
#pragma unroll
    for (int mt = 0; mt < 8; ++mt) {
        if (sample) { const float* sp = F.in[2] + ((size_t)((l * 8 + (s - 16)) * 4 + h) * 128) * 128;
#pragma unroll
            for (int j = 0; j < 4; ++j) S[mt][j] = sp[(size_t)(16 * mt + 4 * fq + j) * 128 + 16 * w + fr]; }
        else S[mt] = (f32x4){0.f, 0.f, 0.f, 0.f};
    }
    const float gn = F.in[14][l * 128 + 16 * w + fr];
    u32x4 pq[2], pk[2], pv[2], pz[2], pt, pa; float pbg = 0.f;
#define G2_FETCH(T0) do { int tq_ = tid; asm volatile("" : "+v"(tq_)); _Pragma("unroll") for (int i = 0; i < 2; ++i) { const int p_ = tq_ + 512 * i, r_ = p_ >> 4, c_ = (p_ & 15) * 8; \
        const bf16_t* rp_ = ((bf16_t*)(F.ws + WS_P)) + (size_t)((T0) + r_) * LDP + h * 128 + c_; \
        pq[i] = *(const u32x4*)(rp_ + C_QA); pk[i] = *(const u32x4*)(rp_ + C_KA); pv[i] = *(const u32x4*)(rp_ + C_VA); pz[i] = *(const u32x4*)(rp_ + C_ZA); } \
      { const int r_ = tq_ >> 3, c_ = (tq_ & 7) * 8; const bf16_t* ep_ = ((bf16_t*)(F.ws + WS_XB)) + (size_t)((T0) + r_) * LDE + h * 128 + c_; pt = *(const u32x4*)ep_; pa = *(const u32x4*)(ep_ + 64); } \
      if (tq_ < 128) pbg = ((float*)(F.ws + WS_BG))[((size_t)((T0) >> 6) * 4 + h) * 128 + tq_]; } while (0)
#define G2_PUT(PAR) do { int tq_ = tid; asm volatile("" : "+v"(tq_)); bf16_t* zz_ = ZZ0 + (PAR) * (64 * 136); _Pragma("unroll") for (int i = 0; i < 2; ++i) { const int p_ = tq_ + 512 * i, r = p_ >> 4, c8 = (p_ & 15) * 8; const u32x4 k = pk[i]; \
        *(u32x4*)(QN + r * 136 + c8) = pq[i]; *(u32x4*)(KN + r * 136 + c8) = k; *(u32x4*)(VV + r * 136 + c8) = pv[i]; *(u32x4*)(zz_ + r * 136 + c8) = pz[i]; \
        KT[(c8 + 0) * 72 + r] = (bf16_t)(k.x & 0xffff); KT[(c8 + 1) * 72 + r] = (bf16_t)(k.x >> 16); KT[(c8 + 2) * 72 + r] = (bf16_t)(k.y & 0xffff); KT[(c8 + 3) * 72 + r] = (bf16_t)(k.y >> 16); \
        KT[(c8 + 4) * 72 + r] = (bf16_t)(k.z & 0xffff); KT[(c8 + 5) * 72 + r] = (bf16_t)(k.z >> 16); KT[(c8 + 6) * 72 + r] = (bf16_t)(k.w & 0xffff); KT[(c8 + 7) * 72 + r] = (bf16_t)(k.w >> 16); } \
      { const int r = tq_ >> 3, c8 = (tq_ & 7) * 8; *(u32x4*)(TM + r * 72 + c8) = pt; *(u32x4*)(AQ + r * 72 + c8) = pa; } \
      if (tq_ < 128) sB[tq_] = pbg; } while (0)
    __syncthreads();
    G2_FETCH(tbase); G2_PUT(0);
    __syncthreads();
    for (int n = 0; n < nchunk; ++n) {
        const int t0 = tbase + n * 64;
        const bf16_t* ZZ = ZZ0 + (n & 1) * (64 * 136);
        f32x4 kS[4], qS[4], vn[4], o[4];
#pragma unroll
        for (int mt = 0; mt < 4; ++mt) { kS[mt] = (f32x4){0.f, 0.f, 0.f, 0.f}; qS[mt] = kS[mt]; vn[mt] = kS[mt]; }
#pragma unroll
        for (int ks = 0; ks < 4; ++ks) {
            const bf16x8 sf = mk8(pk4(S[2 * ks]), pk4(S[2 * ks + 1]));
#pragma unroll
            for (int mt = 0; mt < 4; ++mt) {
                kS[mt] = MFMA16(ldfragp(KN, 16 * mt + fr, 136, 32 * ks, fq), sf, kS[mt]);
                qS[mt] = MFMA16(ldfragp(QN, 16 * mt + fr, 136, 32 * ks, fq), sf, qS[mt]);
            }
        }
        const float glast = sG[63];
        f32x4 eg[4], tmp[4];
#pragma unroll
        for (int mt = 0; mt < 4; ++mt)
#pragma unroll
            for (int j = 0; j < 4; ++j) {
                const int row = 16 * mt + 4 * fq + j;
                const float e = __expf(sG[row]); eg[mt][j] = e;
                const float vv = bf2f(VV[row * 136 + 16 * w + fr]);
                tmp[mt][j] = vv - sB[row] * e * kS[mt][j];
            }
#pragma unroll
        for (int ks = 0; ks < 2; ++ks) {
            const bf16x8 tf = mk8(pk4(tmp[2 * ks]), pk4(tmp[2 * ks + 1]));
#pragma unroll
            for (int mt = 0; mt < 4; ++mt) vn[mt] = MFMA16(ldfragp(TM, 16 * mt + fr, 72, 32 * ks, fq), tf, vn[mt]);
        }
#pragma unroll
        for (int mt = 0; mt < 4; ++mt) o[mt] = eg[mt] * qS[mt];
#pragma unroll
        for (int ks = 0; ks < 2; ++ks) {
            const bf16x8 vf = mk8(pk4(vn[2 * ks]), pk4(vn[2 * ks + 1]));
#pragma unroll
            for (int mt = 0; mt < 4; ++mt) o[mt] = MFMA16(ldfragp(AQ, 16 * mt + fr, 72, 32 * ks, fq), vf, o[mt]);
        }
        const float dl = __expf(glast);
#pragma unroll
        for (int mt = 0; mt < 4; ++mt)
#pragma unroll
            for (int j = 0; j < 4; ++j) vn[mt][j] *= __expf(glast - sG[16 * mt + 4 * fq + j]);
#pragma unroll
        for (int mt = 0; mt < 8; ++mt) S[mt] = S[mt] * dl;
#pragma unroll
        for (int ks = 0; ks < 2; ++ks) {
            const bf16x8 vf = mk8(pk4(vn[2 * ks]), pk4(vn[2 * ks + 1]));
#pragma unroll
            for (int mt = 0; mt < 8; ++mt) S[mt] = MFMA16(ldfragp(KT, 16 * mt + fr, 72, 32 * ks, fq), vf, S[mt]);
        }
#pragma unroll
        for (int mt = 0; mt < 4; ++mt)
#pragma unroll
            for (int j = 0; j < 4; ++j) {
                float p = o[mt][j] * o[mt][j];
                p += __shfl_xor(p, 1); p += __shfl_xor(p, 2); p += __shfl_xor(p, 4); p += __shfl_xor(p, 8);
                if (fr == 0) RED[(16 * mt + 4 * fq + j) * 8 + w] = p;
            }
        __syncthreads();
        if (n + 1 < nchunk) G2_FETCH(t0 + 64);
        __builtin_amdgcn_sched_barrier(0);
#pragma unroll
        for (int mt = 0; mt < 4; ++mt)
#pragma unroll
            for (int j = 0; j < 4; ++j) {
                const int row = 16 * mt + 4 * fq + j;
                const f32x4 r0 = *(const f32x4*)(RED + row * 8), r1 = *(const f32x4*)(RED + row * 8 + 4);
                const float ssum = ((r0[0] + r0[1]) + (r0[2] + r0[3])) + ((r1[0] + r1[1]) + (r1[2] + r1[3]));
                const float rs = rsqrtf(ssum * (1.f / 128.f) + 1e-6f);
                bf16_t* zp = ((bf16_t*)(F.ws + WS_P)) + (size_t)(t0 + row) * LDP + C_ZA + dvc;
                const float z = bf2f(ZZ[row * 136 + 16 * w + fr]);
                if (!F.dry) *zp = (bf16_t)(pk2(o[mt][j] * rs * gn * silu(z), 0.f) & 0xffff);
                __builtin_amdgcn_sched_barrier(0);
            }
        if (n + 1 < nchunk) { G2_PUT((n + 1) & 1); __syncthreads(); }
    }
#undef G2_FETCH
#undef G2_PUT
    float* so = sample ? F.out + O_GDN_S + ((size_t)((l * 8 + (s - 16)) * 4 + h) * 128) * 128 : F.out + O_GDN_P + ((size_t)((l * 16 + s) * 4 + h) * 128) * 128;
#pragma unroll
    for (int mt = 0; mt < 8; ++mt)
#pragma unroll
        for (int j = 0; j < 4; ++j) if (!F.dry) so[(size_t)(16 * mt + 4 * fq + j) * 128 + 16 * w + fr] = S[mt][j];
}

DEV void g2_gla(const Frame& F0, int l, int s, int h) {
    REFRAME;
    bf16_t* QG = (bf16_t*)F.lds;
    bf16_t* KGT = (bf16_t*)(F.lds + 9216);
    bf16_t* AQ = (bf16_t*)(F.lds + 18432);
    float* sDL = (float*)(F.lds + 27648);
    float* RED = (float*)(F.lds + 27904);
    bf16_t* ZZ = (bf16_t*)(F.lds + 29952);
    const int tid = F.tid, lane = F.lane, w = F.wid, fr = lane & 15, fq = lane >> 4;
    const bool sample = s >= 16; const int nchunk = sample ? 1 : 32; const int tbase = sample ? 32768 + (s - 16) * 64 : s * 2048;
    const int dvc = h * 128 + 16 * w + fr;
    f32x4 S[4];
#pragma unroll
    for (int mt = 0; mt < 4; ++mt) {
        if (sample) { const float* sp = F.in[4] + ((size_t)((l * 8 + (s - 16)) * 4 + h) * 64) * 128;
#pragma unroll
            for (int j = 0; j < 4; ++j) S[mt][j] = sp[(size_t)(16 * mt + 4 * fq + j) * 128 + 16 * w + fr]; }
        else S[mt] = (f32x4){0.f, 0.f, 0.f, 0.f};
    }
    const float gn = F.in[17][l * 128 + 16 * w + fr];
    for (int n = 0; n < nchunk; ++n) {
        const int t0 = tbase + n * 64, chunk = t0 >> 6;
        __syncthreads();
        {
            const int r = tid >> 3, c8 = (tid & 7) * 8;
            *(u32x4*)(QG + r * 72 + c8) = *(const u32x4*)(((bf16_t*)(F.ws + WS_P)) + (size_t)(t0 + r) * LDP + C_QB + h * 64 + c8);
            const u32x4 k = *(const u32x4*)(((bf16_t*)(F.ws + WS_P)) + (size_t)(t0 + r) * LDP + C_KB + h * 64 + c8);
            KGT[(c8 + 0) * 72 + r] = (bf16_t)(k.x & 0xffff); KGT[(c8 + 1) * 72 + r] = (bf16_t)(k.x >> 16);
            KGT[(c8 + 2) * 72 + r] = (bf16_t)(k.y & 0xffff); KGT[(c8 + 3) * 72 + r] = (bf16_t)(k.y >> 16);
            KGT[(c8 + 4) * 72 + r] = (bf16_t)(k.z & 0xffff); KGT[(c8 + 5) * 72 + r] = (bf16_t)(k.z >> 16);
            KGT[(c8 + 6) * 72 + r] = (bf16_t)(k.w & 0xffff); KGT[(c8 + 7) * 72 + r] = (bf16_t)(k.w >> 16);
            *(u32x4*)(AQ + r * 72 + c8) = *(const u32x4*)(((bf16_t*)(F.ws + WS_XB)) + (size_t)(t0 + r) * LDE + 512 + h * 64 + c8);
        }
#pragma unroll
        for (int i = 0; i < 2; ++i) { const int p = tid + 512 * i, r = p >> 4, c8 = (p & 15) * 8;
            *(u32x4*)(ZZ + r * 136 + c8) = *(const u32x4*)(((bf16_t*)(F.ws + WS_P)) + (size_t)(t0 + r) * LDP + C_ZB + h * 128 + c8); }
        if (tid < 64) sDL[tid] = ((float*)(F.ws + WS_DL))[((size_t)chunk * 4 + h) * 64 + tid];
        bf16x8 vf[2];
#pragma unroll
        for (int ks = 0; ks < 2; ++ks) {
            unsigned e[8];
#pragma unroll
            for (int j = 0; j < 8; ++j) { const int row = 32 * ks + (j < 4 ? 4 * fq + j : 16 + 4 * fq + (j - 4)); e[j] = ((bf16_t*)(F.ws + WS_P))[(size_t)(t0 + row) * LDP + C_VB + dvc]; }
            u32x4 t; t.x = e[0] | (e[1] << 16); t.y = e[2] | (e[3] << 16); t.z = e[4] | (e[5] << 16); t.w = e[6] | (e[7] << 16);
            vf[ks] = __builtin_bit_cast(bf16x8, t);
        }
        __syncthreads();
        f32x4 o[4];
#pragma unroll
        for (int mt = 0; mt < 4; ++mt) o[mt] = (f32x4){0.f, 0.f, 0.f, 0.f};
#pragma unroll
        for (int ks = 0; ks < 2; ++ks) {
            const bf16x8 sf = mk8(pk4(S[2 * ks]), pk4(S[2 * ks + 1]));
#pragma unroll
            for (int mt = 0; mt < 4; ++mt) {
                o[mt] = MFMA16(ldfragp(QG, 16 * mt + fr, 72, 32 * ks, fq), sf, o[mt]);
                o[mt] = MFMA16(ldfragp(AQ, 16 * mt + fr, 72, 32 * ks, fq), vf[ks], o[mt]);
            }
        }
#pragma unroll
        for (int mt = 0; mt < 4; ++mt) {
#pragma unroll
            for (int j = 0; j < 4; ++j) S[mt][j] *= sDL[16 * mt + 4 * fq + j];
#pragma unroll
            for (int ks = 0; ks < 2; ++ks) S[mt] = MFMA16(ldfragp(KGT, 16 * mt + fr, 72, 32 * ks, fq), vf[ks], S[mt]);
        }
#pragma unroll
        for (int mt = 0; mt < 4; ++mt)
#pragma unroll
            for (int j = 0; j < 4; ++j) {
                float p = o[mt][j] * o[mt][j];
                p += __shfl_xor(p, 1); p += __shfl_xor(p, 2); p += __shfl_xor(p, 4); p += __shfl_xor(p, 8);
                if (fr == 0) RED[(16 * mt + 4 * fq + j) * 8 + w] = p;
            }
        __syncthreads();
#pragma unroll
        for (int mt = 0; mt < 4; ++mt)
#pragma unroll
            for (int j = 0; j < 4; ++j) {
                const int row = 16 * mt + 4 * fq + j;
                const f32x4 r0 = *(const f32x4*)(RED + row * 8), r1 = *(const f32x4*)(RED + row * 8 + 4);
                const float ssum = ((r0[0] + r0[1]) + (r0[2] + r0[3])) + ((r1[0] + r1[1]) + (r1[2] + r1[3]));
                const float rs = rsqrtf(ssum * (1.f / 128.f) + 1e-6f);
                bf16_t* zp = ((bf16_t*)(F.ws + WS_P)) + (size_t)(t0 + row) * LDP + C_ZB + dvc;
                const float z = bf2f(ZZ[row * 136 + 16 * w + fr]);
                if (!F.dry) *zp = (bf16_t)(pk2(o[mt][j] * rs * gn * silu(z), 0.f) & 0xffff);
            }
    }
    float* so = sample ? F.out + O_GLA_S + ((size_t)((l * 8 + (s - 16)) * 4 + h) * 64) * 128 : F.out + O_GLA_P + ((size_t)((l * 16 + s) * 4 + h) * 64) * 128;
#pragma unroll
    for (int mt = 0; mt < 4; ++mt)
#pragma unroll
        for (int j = 0; j < 4; ++j) if (!F.dry) so[(size_t)(16 * mt + 4 * fq + j) * 128 + 16 * w + fr] = S[mt][j];
}

DEV void unpack8(u32x4 u, float (&f)[8]) { f[0] = bflo(u.x); f[1] = bfhi(u.x); f[2] = bflo(u.y); f[3] = bfhi(u.y); f[4] = bflo(u.z); f[5] = bfhi(u.z); f[6] = bflo(u.w); f[7] = bfhi(u.w); }
DEV void load8f(const float* p, float (&f)[8]) { const f32x4 a = *(const f32x4*)p, b = *(const f32x4*)(p + 4); f[0] = a[0]; f[1] = a[1]; f[2] = a[2]; f[3] = a[3]; f[4] = b[0]; f[5] = b[1]; f[6] = b[2]; f[7] = b[3]; }
DEV void ffn_mid(const Frame& F0, int l) {
    REFRAME;
    const float* cw = F.in[29] + (size_t)l * 3 * 5632; const float* cb = F.in[30] + (size_t)l * 5632;
    const bf16_t* halo = ((bf16_t*)(F.ws + WS_KV)); const bf16_t* raw01 = ((bf16_t*)(F.ws + WS_KV + 11714560ull));
    for (int idx = F.bid * 512 + F.tid; idx < 112 * 704; idx += F.nb * 512) {
        const int ti = idx / 704, c4 = (idx % 704) * 4, pm = (ti / 7) * 8 + (ti % 7) + 1;
        const bf16_t* hp = halo + (size_t)(4 * pm - 1) * 2 * 5632; const bf16_t* rp = raw01 + (size_t)pm * 2 * 5632;
        const f32x4 gm2 = unpk4(*(const u32x2*)(hp + c4)), gm1 = unpk4(*(const u32x2*)(hp + 5632 + c4)), g0 = unpk4(*(const u32x2*)(rp + c4)), g1 = unpk4(*(const u32x2*)(rp + 5632 + c4));
        const f32x4 vm2 = unpk4(*(const u32x2*)(hp + 2816 + c4)), vm1 = unpk4(*(const u32x2*)(hp + 5632 + 2816 + c4)), v0 = unpk4(*(const u32x2*)(rp + 2816 + c4)), v1 = unpk4(*(const u32x2*)(rp + 5632 + 2816 + c4));
        const f32x4 wg0 = *(const f32x4*)(cw + c4), wg1 = *(const f32x4*)(cw + 5632 + c4), wg2 = *(const f32x4*)(cw + 2 * 5632 + c4), bg = *(const f32x4*)(cb + c4);
        const f32x4 wv0 = *(const f32x4*)(cw + 2816 + c4), wv1 = *(const f32x4*)(cw + 5632 + 2816 + c4), wv2 = *(const f32x4*)(cw + 2 * 5632 + 2816 + c4), bv = *(const f32x4*)(cb + 2816 + c4);
        f32x4 o0, o1;
#pragma unroll
        for (int j = 0; j < 4; ++j) {
            const float yg0 = wg0[j] * gm2[j] + wg1[j] * gm1[j] + wg2[j] * g0[j] + bg[j], yv0 = wv0[j] * vm2[j] + wv1[j] * vm1[j] + wv2[j] * v0[j] + bv[j];
            const float yg1 = wg0[j] * gm1[j] + wg1[j] * g0[j] + wg2[j] * g1[j] + bg[j], yv1 = wv0[j] * vm1[j] + wv1[j] * v0[j] + wv2[j] * v1[j] + bv[j];
            o0[j] = silu(yg0) * yv0; o1[j] = silu(yg1) * yv1;
        }
        bf16_t* vp = ((bf16_t*)(F.ws + WS_P)) + (size_t)pm * 256 * LDP + c4;
        *(u32x2*)vp = pk4(o0); *(u32x2*)(vp + LDP) = pk4(o1);
    }
}

DEV void final_norm(const Frame& F0) {
    REFRAME;
    const int gw = F.bid * 8 + F.wid, nw = F.nb * 8, lane = F.lane;
    const float* g = F.in[32];
    for (int row = gw; row < TT; row += nw) {
        const float rs = row_rstd(((float*)(F.ws + WS_SSQ)), row);
        float* X = F.out + (size_t)row * 1024;
#pragma unroll
        for (int i = 0; i < 4; ++i) { const int cidx = i * 256 + lane * 4; f32x4 v = *(const f32x4*)(X + cidx); const f32x4 gg = *(const f32x4*)(g + cidx); *(f32x4*)(X + cidx) = v * rs * gg; }
    }
}

#ifdef DBG_COL
DEV void dbg_dump(const Frame& F0) {
    REFRAME;
    for (int i = F.bid * 512 + F.tid; i < TT * 256; i += F.nb * 512) {
        const int row = i >> 8, c = (i & 255) * 4;
        const f32x4 v = c < 512 ? unpk4(*(const u32x2*)(((bf16_t*)(F.ws + WS_P)) + (size_t)row * LDP + DBG_COL + c)) : (f32x4){0.f, 0.f, 0.f, 0.f};
        *(f32x4*)(F.out + (size_t)row * 1024 + c) = (row DBG_ROWSEL) ? v : (f32x4){0.f, 0.f, 0.f, 0.f};
    }
}
#endif
#define XB_TMO      128
#define XB_XCNT(j)  (256  + 64 * (j))
#define XB_XSUB(j)  (1280 + 64 * (j))
#define XB_XGEN(j)  (2304 + 64 * (j))
#define XB_TOP      3328
#define XB_TOPGEN   3392
#define XCD_BAR_WORDS 3456
#define XB_SPIN_CAP (1u << 18)
#define LAS __attribute__((address_space(3)))

__device__ __forceinline__ unsigned xb_ld(unsigned* p)              { return __hip_atomic_load(p, __ATOMIC_RELAXED, __HIP_MEMORY_SCOPE_AGENT); }
__device__ __forceinline__ unsigned xb_add(unsigned* p, unsigned v) { return __hip_atomic_fetch_add(p, v, __ATOMIC_RELAXED, __HIP_MEMORY_SCOPE_AGENT); }
__device__ __forceinline__ unsigned xb_xcc_id() { return (unsigned)__builtin_amdgcn_s_getreg((3 << 11) | 20) & 0xFu; }
#define XB_SPIN(cond, bar) do { unsigned _sp = 0; while (cond) { __builtin_amdgcn_s_sleep(1); \
    if ((++_sp & 255u) == 0u) { if (xb_ld(&(bar)[XB_TMO])) break; if (_sp > XB_SPIN_CAP) { atomicAdd(&(bar)[XB_TMO], 1u); break; } } } } while (0)

struct XcdBarrier {
    unsigned* bar; unsigned x;
    volatile LAS unsigned* st;
};

__device__ __forceinline__ XcdBarrier xcd_barrier_post(unsigned* bar, volatile LAS unsigned* st) {
    XcdBarrier b; b.bar = bar; b.x = xb_xcc_id(); b.st = st;
    if (threadIdx.x == 0) (void)xb_add(&bar[XB_XCNT(b.x)], 1u);
    return b;
}
__device__ __forceinline__ void xcd_barrier_complete(unsigned* bar, unsigned x, unsigned& nloc, unsigned& nx) {
    const unsigned G = gridDim.x * gridDim.y * gridDim.z;
    unsigned sum, cnt, mine, sp = 0u;
    for (;;) {
        sum = 0u; cnt = 0u; mine = 0u;
#pragma unroll
        for (unsigned j = 0; j < 16; ++j) { const unsigned c = xb_ld(&bar[XB_XCNT(j)]); sum += c; cnt += (c > 0u) ? 1u : 0u; mine = (j == x) ? c : mine; }
        if (sum == G) break;
        __builtin_amdgcn_s_sleep(1);
        if ((++sp & 255u) == 0u) { if (xb_ld(&bar[XB_TMO])) break; if (sp > XB_SPIN_CAP) { atomicAdd(&bar[XB_TMO], 1u); break; } }
    }
    nloc = mine > 0u ? mine : 1u; nx = cnt > 0u ? cnt : 1u;
}

__device__ __forceinline__ void xcd_barrier(const XcdBarrier& b) {
    asm volatile("s_waitcnt vmcnt(0)" ::: "memory");
    __syncthreads();
    if (threadIdx.x == 0) {
        unsigned* bar = b.bar;
        __builtin_amdgcn_s_waitcnt(0);
        unsigned nloc = b.st[0], nx = b.st[1];
        if (nloc == 0u) { xcd_barrier_complete(bar, b.x, nloc, nx); b.st[0] = nloc; b.st[1] = nx; }
        const unsigned old = xb_add(&bar[XB_XSUB(b.x)], 1u);
        const unsigned gen = old / nloc;
        if (old + 1u == (gen + 1u) * nloc) {
            __builtin_amdgcn_fence(__ATOMIC_RELEASE, "agent");
            asm volatile("s_waitcnt vmcnt(0)" ::: "memory");
            const unsigned og = xb_add(&bar[XB_TOP], 1u);
            const unsigned tg = og / nx;
            if (og + 1u == (tg + 1u) * nx) xb_add(&bar[XB_TOPGEN], 1u);
            else XB_SPIN(xb_ld(&bar[XB_TOPGEN]) == tg, bar);
            __builtin_amdgcn_fence(__ATOMIC_ACQUIRE, "agent");
            xb_add(&bar[XB_XGEN(b.x)], 1u);
            asm volatile("s_waitcnt vmcnt(0)" ::: "memory");
        } else {
            XB_SPIN(xb_ld(&bar[XB_XGEN(b.x)]) == gen, bar);
            __builtin_amdgcn_fence(__ATOMIC_ACQUIRE, "agent");
            asm volatile("s_waitcnt vmcnt(0)" ::: "memory");
        }
    }
    __syncthreads();
}

__global__ void __launch_bounds__(512, 2) fwd_kernel(Params p) {
    extern __shared__ __attribute__((aligned(16))) unsigned char lds[];
    cg::grid_group grid = cg::this_grid();
    Frame F;
    F.in = (InTab)__builtin_amdgcn_kernarg_segment_ptr(); F.out = p.out; F.ws = p.ws; F.lds = lds;
    F.tid = threadIdx.x; F.lane = threadIdx.x & 63; F.wid = __builtin_amdgcn_readfirstlane(threadIdx.x >> 6); F.nb = gridDim.x; F.bid = blockIdx.x; F.dry = 0; F.cb = blockIdx.x; F.cn = gridDim.x;
    volatile LAS unsigned* xst = (volatile LAS unsigned*)(lds + LDS_BYTES - 16);
    if (threadIdx.x == 0) { xst[0] = 0u; xst[1] = 0u; }
    __syncthreads();
    const XcdBarrier xbar = xcd_barrier_post((unsigned*)(p.ws + WS_BAR), xst);
    for (int ph = p.ph_lo; ph < p.ph_hi; ++ph) {
        if (gridDim.x == 256 && ph > 0 && ph < NPH - 1 && ((ph - 1) % 13) == 4) continue;
#ifndef PHM
#define PHM 0xffff
#endif
        if (ph == 0) { if (PHM & 0x1000) phase0(F); }
        else if (ph == NPH - 1) { if (PHM & 0x2000) final_norm(F); }
        else {
            const int l = (ph - 1) / 13, k = (ph - 1) % 13;
            int gk = -1;
            if (k == 2 && gridDim.x == 256) gk = GP_MEMKV;
            switch (k) { case 0: gk = GP_IN; break; case 3: gk = GP_OUT; break; case 4: gk = GP_OUT2; break; case 5: gk = GP_WO; break; case 6: gk = GP_MQ; break; case 7: gk = GP_ATTN; break; case 8: gk = GP_ATTN2; break;
                         case 9: gk = GP_MO; break; case 10: gk = GP_UP; break; case 12: gk = GP_DOWN; break; default: break; }
#ifndef REPMASK
#define REPMASK 0
#endif
            if (gk >= 0 && (PHM & 1)) { const int nrep = ((REPMASK >> k) & 1) ? 2 : 1; for (int rep = 0; rep < nrep; ++rep) gemm_phase(F, gk, l); }
            if (k == 0 && (PHM & 1)) small_proj(F);
            if (k == (gridDim.x == 256 ? 2 : 3) && (PHM & 8)) sample_kv(F, l);
            if (gridDim.x == 256 && k == 2 && l > 0 && blockIdx.x >= 128) { Frame G = F; G.cb = (int)blockIdx.x - 128; G.cn = 128; __syncthreads(); cvt_ffn(G, l); }
            if (gridDim.x == 256 && k == 10 && l < 3 && (blockIdx.x >> 3) >= 6) { Frame G = F; G.cb = (((int)blockIdx.x >> 3) - 6) * 8 + ((int)blockIdx.x & 7); G.cn = 208; __syncthreads(); cvt_mixer(G, l + 1); }
#ifndef DRYMASK
#define DRYMASK 0
#endif
            for (int dr = ((DRYMASK >> k) & 1); dr >= 0; --dr) {
            F.dry = dr;
            if (k == 1 && (PHM & 2)) {
                for (int it = F.bid; it < NCH * 8; it += F.nb) { const int c = it >> 3, h = it & 3; if (it & 4) g1_gla(F, l, c, h); else g1_gdn(F, l, c, h); }
                __syncthreads();
                if (l > 0 && !dr && F.nb != 256) cvt_ffn(F, l);
            }
            if (k == 2 && (PHM & 4)) {
                for (int it = F.bid; it < 192; it += F.nb) {
                    int s, h, br;
                    if (it < 128) { br = it & 1; h = (it >> 1) & 3; s = it >> 3; } else { const int v = it - 128; br = v & 1; h = (v >> 1) & 3; s = 16 + (v >> 3); }
                    if (br) g2_gla(F, l, s, h); else g2_gdn(F, l, s, h);
                    __syncthreads();
                }
            }
            if (k == 11 && (PHM & 0x200)) { ffn_mid(F, l); if (l < 3 && !dr && F.nb != 256) { __syncthreads(); cvt_mixer(F, l + 1); } }
            }
            F.dry = 0;
        }
#ifndef SYNCREP
#define SYNCREP 1
#endif
        if (ph + 1 < p.ph_hi) {
            if (ph == 0) grid.sync();
            else xcd_barrier(xbar);
        }
    }
#ifdef DBG_COL
    __threadfence(); grid.sync(); __threadfence();
    dbg_dump(F);
#endif
}

extern "C" void kernel_launch(void* const* d_in, const int* in_sizes, int n_in, void* d_out, int out_size, void* d_ws, size_t ws_size, hipStream_t stream) {
    static int grid_blocks = 0;
    if (grid_blocks == 0) {
        if (n_in != 33 || ws_size < WS_TOTAL) { fprintf(stderr, "kernel_launch: bad n_in %d or ws %zu < %zu\n", n_in, ws_size, (size_t)WS_TOTAL); grid_blocks = -1; return; }
        int dev = 0, cus = 0, per_cu = 0;
        hipGetDevice(&dev);
        hipDeviceGetAttribute(&cus, hipDeviceAttributeMultiprocessorCount, dev);
        if (hipFuncSetAttribute((const void*)fwd_kernel, hipFuncAttributeMaxDynamicSharedMemorySize, LDS_BYTES) != hipSuccess) { fprintf(stderr, "hipFuncSetAttribute failed\n"); grid_blocks = -1; return; }
        hipOccupancyMaxActiveBlocksPerMultiprocessor(&per_cu, (const void*)fwd_kernel, 512, LDS_BYTES);
        if (per_cu < 1) per_cu = 1;
        (void)hipGetLastError();
        grid_blocks = cus * 1;
        if (grid_blocks <= 0) grid_blocks = 256;
    }
    if (grid_blocks < 0) return;
    Params p{};
    for (int i = 0; i < 33; ++i) p.in[i] = (const float*)d_in[i];
    p.out = (float*)d_out; p.ws = (unsigned char*)d_ws; p.ph_lo = 0; p.ph_hi = PH_HI;
    (void)hipMemsetAsync((unsigned char*)d_ws + WS_BAR, 0, 16384, stream);
    void* args[] = {&p};
    hipError_t e = hipLaunchCooperativeKernel((const void*)fwd_kernel, dim3(grid_blocks), dim3(512), args, LDS_BYTES, stream);
    if (e != hipSuccess) fprintf(stderr, "cooperative launch failed: %s (grid %d)\n", hipGetErrorString(e), grid_blocks);
}
```

```cpp
#include <hip/hip_runtime.h>
#include <hip/hip_cooperative_groups.h>
#include <cstdint>
#include <cstdio>
namespace cg = cooperative_groups;

typedef unsigned short bf16_t;
typedef short bf16x8 __attribute__((ext_vector_type(8)));
typedef float f32x4 __attribute__((ext_vector_type(4)));
typedef float f32x2 __attribute__((ext_vector_type(2)));
typedef unsigned u32x2 __attribute__((ext_vector_type(2)));
typedef unsigned u32x4 __attribute__((ext_vector_type(4)));
#define DEV __device__ __forceinline__

constexpr int DM = 1024, TT = 33280, NCH = 520, LDP = 5632, LDE = 768;
constexpr int C_QA = 0, C_KA = 512, C_VA = 1024, C_ZA = 1536, C_QB = 2048, C_KB = 2304, C_VB = 2560, C_ZB = 3072, C_GA = 3584, C_GB = 4608;
constexpr int C_MRG = 0, C_PR = 1024, C_Q = 2048, C_O = 3072;
constexpr size_t O_Y = 0;
constexpr size_t O_GDN_P = 34078720ull;
constexpr size_t O_GDNC_P = O_GDN_P + 4194304ull;
constexpr size_t O_GLA_P = O_GDNC_P + 294912ull;
constexpr size_t O_FFNC_P = O_GLA_P + 2097152ull;
constexpr size_t O_MEMK = O_FFNC_P + 720896ull;
constexpr size_t O_MEMV = O_MEMK + 16777216ull;
constexpr size_t O_GDN_S = O_MEMV + 16777216ull;
constexpr size_t O_GDNC_S = O_GDN_S + 2097152ull;
constexpr size_t O_GLA_S = O_GDNC_S + 147456ull;
constexpr size_t O_FFNC_S = O_GLA_S + 1048576ull;
constexpr size_t al256(size_t x) { return (x + 255) & ~(size_t)255; }
constexpr size_t WS_WMIX = 0;
constexpr size_t WM_WIN = 0, WM_WSM = WM_WIN + 5632ull * 1024, WM_WOA = WM_WSM + 32 * 1024, WM_WOB = WM_WOA + 524288, WM_WO = WM_WOB + 524288,
                 WM_WMQ = WM_WO + 1048576, WM_WMK = WM_WMQ + 1048576, WM_WMV = WM_WMK + 1048576, WM_WMO = WM_WMV + 1048576, WM_END = WM_WMO + 1048576;
constexpr size_t WS_WFFN = al256(WS_WMIX + WM_END * 2);
constexpr size_t WF_UP = 0, WF_DN = 5632ull * 1024, WF_END = WF_DN + 1024ull * 2816;
constexpr size_t WS_XB = al256(WS_WFFN + WF_END * 2);
constexpr size_t WS_P = al256(WS_XB + (size_t)TT * 1024 * 2);
constexpr size_t WS_KV = al256(WS_P + (size_t)TT * LDP * 2);
constexpr size_t KV_BYTES = 2ull * 6144 * 1024 * 2;
constexpr size_t WS_MB = al256(WS_KV + KV_BYTES);
constexpr size_t WS_MRS = al256(WS_MB + 4096ull * 1024 * 2);
constexpr size_t WS_SSQ = al256(WS_MRS + 4096 * 4);
constexpr size_t WS_SC = al256(WS_SSQ + (size_t)TT * 16 * 4);
constexpr size_t WS_DL = al256(WS_SC + (size_t)TT * 32 * 4);
constexpr size_t WS_BG = al256(WS_DL + 520ull * 4 * 64 * 4);
constexpr size_t WS_BAR = al256(WS_BG + 520ull * 4 * 128 * 4);
constexpr size_t WS_TOTAL = al256(WS_BAR + 16384);
constexpr int LDS_BYTES = 147456;
constexpr int NPH = 54;
#ifndef PH_HI
#define PH_HI NPH
#define REPMASK 0
#define SYNCREP 1
#define DRYMASK 0
#endif

struct Params { const float* in[33]; float* out; unsigned char* ws; int ph_lo, ph_hi; };

typedef __bf16 bf16x2_t __attribute__((ext_vector_type(2)));
DEV unsigned pk2(float lo, float hi) { f32x2 f = {lo, hi}; bf16x2_t v = __builtin_convertvector(f, bf16x2_t); return __builtin_bit_cast(unsigned, v); }
DEV float bf2f(bf16_t b) { return __uint_as_float(((unsigned)b) << 16); }
DEV float bflo(unsigned u) { return __uint_as_float(u << 16); }
DEV float bfhi(unsigned u) { return __uint_as_float(u & 0xffff0000u); }
DEV u32x2 pk4(f32x4 v) { u32x2 r; r.x = pk2(v[0], v[1]); r.y = pk2(v[2], v[3]); return r; }
DEV f32x4 unpk4(u32x2 u) { return (f32x4){bflo(u.x), bfhi(u.x), bflo(u.y), bfhi(u.y)}; }
DEV bf16x8 mk8(u32x2 a, u32x2 b) { u32x4 t = {a.x, a.y, b.x, b.y}; return __builtin_bit_cast(bf16x8, t); }
DEV float sigm(float x) { return 1.f / (1.f + __expf(-x)); }
DEV float silu(float x) { return x / (1.f + __expf(-x)); }
DEV float softplus(float x) { return x > 20.f ? x : __logf(1.f + __expf(x)); }
DEV float logsigmoid(float x) { return fminf(x, 0.f) - __logf(1.f + __expf(-fabsf(x))); }
DEV float row_rstd(const float* ssq, int row) {
    const f32x4 a = *(const f32x4*)(ssq + (size_t)row * 4), b = *(const f32x4*)(ssq + ((size_t)TT + row) * 4);
    const f32x4 c = *(const f32x4*)(ssq + ((size_t)2 * TT + row) * 4), d = *(const f32x4*)(ssq + ((size_t)3 * TT + row) * 4);
    float s = ((a[0] + a[1]) + (a[2] + a[3])) + ((b[0] + b[1]) + (b[2] + b[3])) + ((c[0] + c[1]) + (c[2] + c[3])) + ((d[0] + d[1]) + (d[2] + d[3]));
    return rsqrtf(s * (1.f / 1024.f) + 1e-6f);
}
DEV bf16x8 ldfragp(const bf16_t* base, int row, int stride, int k0, int fq) {
    const bf16_t* p = base + row * stride + k0 + 4 * fq;
    return mk8(*(const u32x2*)p, *(const u32x2*)(p + 16));
}
DEV bf16x8 ldfrag(const bf16_t* base, int row, int stride, int k0, int fq) {
    return *(const bf16x8*)(base + row * stride + k0 + 8 * fq);
}
#define MFMA16(a, b, c) __builtin_amdgcn_mfma_f32_16x16x32_bf16((a), (b), (c), 0, 0, 0)

constexpr int BM = 256, BK = 64, HALF = 128, HT = HALF * BK;
DEV int lds_byte(int r, int c) { int st = (r >> 4) * 2 + (c >> 5), rr = r & 15, cc = c & 31, ob = rr * 64 + cc * 2; return st * 1024 + (ob ^ (((ob >> 9) & 1) << 5)); }
DEV void stage_rc(int b, int& R, int& C) { int st = b / 1024, sb = b % 1024, swz = sb ^ (((sb >> 9) & 1) << 5); R = (st >> 1) * 16 + swz / 64; C = (st & 1) * 32 + (swz % 64) / 2; }

DEV void gemm_core(const bf16_t* __restrict__ A, int lda, const bf16_t* __restrict__ Bt, int ldb, int K, int brow, int bcol, f32x4 (&acc)[2][2][4][2], bf16_t* shm) {
#define SA(b, h) (shm + ((b) * 2 + (h)) * HT)
#define SB(b, h) (shm + (4 + (b) * 2 + (h)) * HT)
#define STAGE(P, BASE, LD, br, kt) do { const char* _gb = (const char*)((BASE) + (long)(br) * (LD) + (long)(kt) * BK); \
    const unsigned _vo = (unsigned)((sr0 * (int)(LD) + sc0) * 2); \
    for (int _i = 0; _i < 2; ++_i) { \
      __builtin_amdgcn_global_load_lds((const unsigned*)(_gb + (long)(_i * 128) * (LD) + _vo), (unsigned*)((char*)(P) + wbase + _i * 8192), 16, 0, 0); } } while (0)
#define LDA(dst, b, h) for (int m = 0; m < 4; ++m) for (int k = 0; k < 2; ++k) \
    dst[m][k] = *reinterpret_cast<const bf16x8*>((char*)SA(b, h) + lds_byte(wr * 64 + m * 16 + fr, k * 32 + fq * 8))
#define LDB(dst, b, h) for (int n = 0; n < 2; ++n) for (int k = 0; k < 2; ++k) \
    dst[n][k] = *reinterpret_cast<const bf16x8*>((char*)SB(b, h) + lds_byte(wc * 32 + n * 16 + fr, k * 32 + fq * 8))
#define MMA(ai, bj, At_, Bt_) do { __builtin_amdgcn_s_setprio(1); \
    for (int m = 0; m < 4; ++m) for (int n = 0; n < 2; ++n) for (int k = 0; k < 2; ++k) \
      acc[ai][bj][m][n] = __builtin_amdgcn_mfma_f32_16x16x32_bf16(Bt_[n][k], At_[m][k], acc[ai][bj][m][n], 0, 0, 0); \
    __builtin_amdgcn_s_setprio(0); } while (0)
#define WAIT_V(n) asm volatile("s_waitcnt vmcnt(" #n ")" ::: "memory")
#define WAIT_L(n) asm volatile("s_waitcnt lgkmcnt(" #n ")" ::: "memory")
#define BAR __builtin_amdgcn_s_barrier()
#define SCHED __builtin_amdgcn_sched_barrier(0)
    int tidx = threadIdx.x; asm volatile("" : "+v"(tidx));
    const int wid = __builtin_amdgcn_readfirstlane(tidx >> 6), lane = tidx & 63, wr = wid >> 2, wc = wid & 3, fr = lane & 15, fq = lane >> 4;
    const int wbase = wid * 1024;
    int sr0, sc0; stage_rc(tidx * 16, sr0, sc0);
#pragma unroll
    for (int a = 0; a < 2; ++a)
#pragma unroll
        for (int b = 0; b < 2; ++b)
#pragma unroll
            for (int m = 0; m < 4; ++m)
#pragma unroll
                for (int n = 0; n < 2; ++n) acc[a][b][m][n] = (f32x4){0.f, 0.f, 0.f, 0.f};
    bf16x8 At[4][2], B0[2][2], B1[2][2];
    const int nt = K / BK;
    STAGE(SB(0, 0), Bt, ldb, bcol, 0); STAGE(SA(0, 0), A, lda, brow, 0);
    STAGE(SB(0, 1), Bt, ldb, bcol + HALF, 0); STAGE(SA(0, 1), A, lda, brow + HALF, 0);
    if (wr == 1) BAR;
    WAIT_V(4); BAR;
    STAGE(SB(1, 0), Bt, ldb, bcol, 1); STAGE(SA(1, 0), A, lda, brow, 1); STAGE(SB(1, 1), Bt, ldb, bcol + HALF, 1);
    WAIT_V(6); BAR;
    for (int t = 0; t < nt - 2; t += 2) {
        LDB(B0, 0, 0); SCHED; LDA(At, 0, 0); STAGE(SA(1, 1), A, lda, brow + HALF, t + 1);
        WAIT_L(8); BAR; WAIT_L(0); MMA(0, 0, At, B0); BAR; SCHED;
        LDB(B1, 0, 1); STAGE(SB(0, 0), Bt, ldb, bcol, t + 2);
        BAR; WAIT_L(0); MMA(0, 1, At, B1); BAR;
        LDA(At, 0, 1); STAGE(SA(0, 0), A, lda, brow, t + 2);
        BAR; WAIT_L(0); MMA(1, 0, At, B0); BAR; SCHED;
        STAGE(SB(0, 1), Bt, ldb, bcol + HALF, t + 2);
        WAIT_V(6); BAR; MMA(1, 1, At, B1); BAR;
        LDB(B0, 1, 0); SCHED; LDA(At, 1, 0); STAGE(SA(0, 1), A, lda, brow + HALF, t + 2);
        WAIT_L(8); BAR; WAIT_L(0); MMA(0, 0, At, B0); BAR; SCHED;
        LDB(B1, 1, 1); STAGE(SB(1, 0), Bt, ldb, bcol, t + 3);
        BAR; WAIT_L(0); MMA(0, 1, At, B1); BAR;
        LDA(At, 1, 1); STAGE(SA(1, 0), A, lda, brow, t + 3);
        BAR; WAIT_L(0); MMA(1, 0, At, B0); BAR; SCHED;
        STAGE(SB(1, 1), Bt, ldb, bcol + HALF, t + 3);
        WAIT_V(6); BAR; MMA(1, 1, At, B1); BAR;
    }
    { LDB(B0, 0, 0); LDA(At, 0, 0); STAGE(SA(1, 1), A, lda, brow + HALF, nt - 1);
      BAR; WAIT_L(0); MMA(0, 0, At, B0); BAR;
      LDB(B1, 0, 1); BAR; WAIT_L(0); MMA(0, 1, At, B1); BAR;
      LDA(At, 0, 1); WAIT_V(4); BAR; WAIT_L(0); MMA(1, 0, At, B0); MMA(1, 1, At, B1); BAR; }
    { LDB(B0, 1, 0); LDA(At, 1, 0); WAIT_V(2); BAR; WAIT_L(0); MMA(0, 0, At, B0); BAR;
      LDB(B1, 1, 1); WAIT_V(0); BAR; WAIT_L(0); MMA(0, 1, At, B1); BAR;
      LDA(At, 1, 1); BAR; WAIT_L(0); MMA(1, 0, At, B0); MMA(1, 1, At, B1); BAR; }
    if (wr == 0) BAR;
    SCHED;
#undef SA
#undef SB
}

typedef const float* const __attribute__((address_space(4)))* InTab;
struct Frame {
    InTab in; float* out; unsigned char* ws; unsigned char* lds;
    int tid, lane, wid, nb, bid, dry, cb, cn;
};
#define REFRAME Frame F = F0; { int t_ = threadIdx.x; asm volatile("" : "+v"(t_)); F.tid = t_; F.lane = t_ & 63; unsigned char* w_ = F.ws; asm volatile("" : "+s"(w_)); F.ws = w_; float* o_ = F.out; asm volatile("" : "+s"(o_)); F.out = o_; InTab i_ = (InTab)__builtin_amdgcn_kernarg_segment_ptr(); asm volatile("" : "+s"(i_)); F.in = i_; int a_ = F.wid, b_ = F.bid, c_ = F.nb; asm volatile("" : "+s"(a_), "+s"(b_), "+s"(c_)); F.wid = a_; F.bid = b_; F.nb = c_; }

enum { EPI_PROJ = 0, EPI_UP, EPI_RESID, EPI_Q, EPI_MEMK, EPI_MEMV, EPI_OUTA, EPI_OUTB, EPI_SOFTMAX, EPI_ATTNO };
struct GDesc { const bf16_t* A; int lda; const bf16_t* Bt; int ldb; int K, brow, bcol, epi, orow, ocol, head, vai, vwr; };

DEV void cvt_mat(const Frame& F0, const float* src, int ldsrc, int K, int N, int wincols, const float* gain, bf16_t* dst) {
    REFRAME;
    float* T = (float*)F.lds;
    const int nkt = K / 64, nnt = N / 64, ntile = nkt * nnt;
    for (int t = F.cb; t < ntile; t += F.cn) {
        const int kt = t / nnt, ntl = t % nnt, k0 = kt * 64, n0 = ntl * 64;
        int coff = 0; if (wincols == 1) coff = (n0 < 1536) ? 0 : (n0 < 3072 ? 8 : 24);
        if (wincols == 2) { const int tl = n0 >> 8, w = n0 & 255; coff = (w < 128 ? 128 * tl + w : 2816 + 128 * tl + (w - 128)) - n0; }
        __syncthreads();
#pragma unroll
        for (int i = 0; i < 2; ++i) {
            const int kr = (F.tid >> 4) + 32 * i, nc = (F.tid & 15) * 4;
            f32x4 v = *(const f32x4*)(src + (size_t)(k0 + kr) * ldsrc + n0 + coff + nc);
            const float g = gain ? gain[k0 + kr] : 1.f;
            T[kr * 65 + nc + 0] = v[0] * g; T[kr * 65 + nc + 1] = v[1] * g; T[kr * 65 + nc + 2] = v[2] * g; T[kr * 65 + nc + 3] = v[3] * g;
        }
        __syncthreads();
        const int n = F.tid >> 3, kc = (F.tid & 7) * 8;
        u32x4 w;
        w.x = pk2(T[(kc + 0) * 65 + n], T[(kc + 1) * 65 + n]); w.y = pk2(T[(kc + 2) * 65 + n], T[(kc + 3) * 65 + n]);
        w.z = pk2(T[(kc + 4) * 65 + n], T[(kc + 5) * 65 + n]); w.w = pk2(T[(kc + 6) * 65 + n], T[(kc + 7) * 65 + n]);
        *(u32x4*)(dst + (size_t)(n0 + n) * K + k0 + kc) = w;
    }
    __syncthreads();
}
DEV void cvt_mixer(const Frame& F0, int l) {
    REFRAME;
    InTab in = F.in;
    cvt_mat(F, in[10] + (size_t)l * 1024 * 5656, 5656, 1024, 5632, 1, in[9] + l * 1024, ((bf16_t*)(F.ws + WS_WMIX)) + WM_WIN);
    cvt_mat(F, in[18] + (size_t)l * 512 * 1024, 1024, 512, 1024, 0, nullptr, ((bf16_t*)(F.ws + WS_WMIX)) + WM_WOA);
    cvt_mat(F, in[19] + (size_t)l * 512 * 1024, 1024, 512, 1024, 0, nullptr, ((bf16_t*)(F.ws + WS_WMIX)) + WM_WOB);
    cvt_mat(F, in[20] + (size_t)l * 1048576, 1024, 1024, 1024, 0, nullptr, ((bf16_t*)(F.ws + WS_WMIX)) + WM_WO);
    cvt_mat(F, in[23] + (size_t)l * 1048576, 1024, 1024, 1024, 0, in[21] + l * 1024, ((bf16_t*)(F.ws + WS_WMIX)) + WM_WMQ);
    cvt_mat(F, in[24] + (size_t)l * 1048576, 1024, 1024, 1024, 0, in[22] + l * 1024, ((bf16_t*)(F.ws + WS_WMIX)) + WM_WMK);
    cvt_mat(F, in[25] + (size_t)l * 1048576, 1024, 1024, 1024, 0, in[22] + l * 1024, ((bf16_t*)(F.ws + WS_WMIX)) + WM_WMV);
    cvt_mat(F, in[26] + (size_t)l * 1048576, 1024, 1024, 1024, 0, nullptr, ((bf16_t*)(F.ws + WS_WMIX)) + WM_WMO);
    const float* win = in[10] + (size_t)l * 1024 * 5656; const float* g = in[9] + l * 1024;
    for (int i = F.cb * 512 + F.tid; i < 32 * 1024; i += F.cn * 512) {
        const int n = i >> 10, k = i & 1023;
        float v = 0.f;
        if (n < 8) v = win[(size_t)k * 5656 + 1536 + n] * g[k]; else if (n < 24) v = win[(size_t)k * 5656 + 3080 + (n - 8)] * g[k];
        ((bf16_t*)(F.ws + WS_WMIX))[WM_WSM + i] = (bf16_t)(pk2(v, 0.f) & 0xffff);
    }
}
DEV void cvt_ffn(const Frame& F, int l) {
    cvt_mat(F, F.in[28] + (size_t)l * 1024 * 5632, 5632, 1024, 5632, 2, F.in[27] + l * 1024, ((bf16_t*)(F.ws + WS_WFFN)) + WF_UP);
    cvt_mat(F, F.in[31] + (size_t)l * 2816 * 1024, 1024, 2816, 1024, 0, nullptr, ((bf16_t*)(F.ws + WS_WFFN)) + WF_DN);
}

DEV void phase0(const Frame& F0) {
    REFRAME;
    const int gw = F.bid * 8 + F.wid, nw = F.nb * 8, lane = F.lane;
    for (int row = gw; row < TT + 4096; row += nw) {
        const bool ismem = row >= TT;
        const float* src = ismem ? F.in[8] + (size_t)(row - TT) * 1024 : (row < 32768 ? F.in[0] + (size_t)row * 1024 : F.in[1] + (size_t)(row - 32768) * 1024);
        f32x4 v[4]; float s = 0.f;
#pragma unroll
        for (int i = 0; i < 4; ++i) { v[i] = *(const f32x4*)(src + lane * 16 + i * 4); s += v[i][0] * v[i][0] + v[i][1] * v[i][1] + v[i][2] * v[i][2] + v[i][3] * v[i][3]; }
        u32x4 w0, w1;
        w0.x = pk2(v[0][0], v[0][1]); w0.y = pk2(v[0][2], v[0][3]); w0.z = pk2(v[1][0], v[1][1]); w0.w = pk2(v[1][2], v[1][3]);
        w1.x = pk2(v[2][0], v[2][1]); w1.y = pk2(v[2][2], v[2][3]); w1.z = pk2(v[3][0], v[3][1]); w1.w = pk2(v[3][2], v[3][3]);
        s += __shfl_xor(s, 1); s += __shfl_xor(s, 2);
        if (!ismem) {
            bf16_t* xb = ((bf16_t*)(F.ws + WS_XB)) + (size_t)row * 1024 + lane * 16;
            *(u32x4*)xb = w0; *(u32x4*)(xb + 8) = w1;
            if ((lane & 3) == 0) ((float*)(F.ws + WS_SSQ))[((size_t)(lane >> 4) * TT + row) * 4 + ((lane >> 2) & 3)] = s;
        } else {
            const int mr = row - TT;
            bf16_t* mb = ((bf16_t*)(F.ws + WS_MB)) + (size_t)mr * 1024 + lane * 16;
            *(u32x4*)mb = w0; *(u32x4*)(mb + 8) = w1;
            s += __shfl_xor(s, 4); s += __shfl_xor(s, 8); s += __shfl_xor(s, 16); s += __shfl_xor(s, 32);
            if (lane == 0) ((float*)(F.ws + WS_MRS))[mr] = rsqrtf(s * (1.f / 1024.f) + 1e-6f);
        }
    }
    cvt_mixer(F, 0);
    if (F.nb != 256) cvt_ffn(F, 0);
}

DEV void small_proj(const Frame& F0) {
    REFRAME;
    const int lane = F.lane, fr = lane & 15, fq = lane >> 4, mt = F.wid & 3, nt = F.wid >> 2;
    const bool part = F.nb == 256;
    if (part && (F.bid >> 3) < 6) return;
    for (int c = part ? ((F.bid >> 3) - 6) * 8 + (F.bid & 7) : F.bid; c < NCH; c += part ? 208 : F.nb) {
        const int row = c * 64 + mt * 16 + fr;
        const bf16_t* a = ((bf16_t*)(F.ws + WS_XB)) + (size_t)row * 1024 + 8 * fq;
        const bf16_t* b = ((bf16_t*)(F.ws + WS_WMIX)) + WM_WSM + (size_t)(nt * 16 + fr) * 1024 + 8 * fq;
        f32x4 acc = {0.f, 0.f, 0.f, 0.f};
#pragma unroll 4
        for (int k = 0; k < 32; ++k) acc = MFMA16(*(const bf16x8*)(b + k * 32), *(const bf16x8*)(a + k * 32), acc);
        const float rs = row_rstd(((float*)(F.ws + WS_SSQ)), row);
        *(f32x4*)(((float*)(F.ws + WS_SC)) + (size_t)row * 32 + nt * 16 + 4 * fq) = acc * rs;
    }
}

DEV void gemm_epilogue(const Frame& F0, const GDesc& d, int l, f32x4 (&acc)[2][2][4][2]) {
    REFRAME;
    int lane_ = F.lane; asm volatile("" : "+v"(lane_));
    const int wr = F.wid >> 2, wc = F.wid & 3, fr = lane_ & 15, fq = lane_ >> 4;
    float* red = (float*)(F.lds + 131072);
    if (d.epi == EPI_SOFTMAX) {
        float mx[2][4];
#pragma unroll
        for (int ai = 0; ai < 2; ++ai)
#pragma unroll
            for (int m = 0; m < 4; ++m) {
                float v = -3.0e38f;
#pragma unroll
                for (int bj = 0; bj < 2; ++bj)
#pragma unroll
                    for (int n = 0; n < 2; ++n) { const f32x4 x = acc[ai][bj][m][n]; v = fmaxf(v, fmaxf(fmaxf(x[0], x[1]), fmaxf(x[2], x[3]))); }
                v = fmaxf(v, __shfl_xor(v, 16)); v = fmaxf(v, __shfl_xor(v, 32));
                if (fq == 0) red[(ai * 128 + wr * 64 + m * 16 + fr) * 4 + wc] = v;
            }
        __syncthreads();
#pragma unroll
        for (int ai = 0; ai < 2; ++ai)
#pragma unroll
            for (int m = 0; m < 4; ++m) {
                const f32x4 r4 = *(const f32x4*)(red + (ai * 128 + wr * 64 + m * 16 + fr) * 4);
                const float rm = fmaxf(fmaxf(r4[0], r4[1]), fmaxf(r4[2], r4[3]));
                mx[ai][m] = rm; float s = 0.f;
#pragma unroll
                for (int bj = 0; bj < 2; ++bj)
#pragma unroll
                    for (int n = 0; n < 2; ++n) { f32x4 x = acc[ai][bj][m][n];
#pragma unroll
                        for (int j = 0; j < 4; ++j) { x[j] = __expf(x[j] - rm); s += x[j]; }
                        acc[ai][bj][m][n] = x; }
                s += __shfl_xor(s, 16); s += __shfl_xor(s, 32);
                if (fq == 0) red[1024 + (ai * 128 + wr * 64 + m * 16 + fr) * 4 + wc] = s;
            }
        (void)mx;
        __syncthreads();
#pragma unroll
        for (int ai = 0; ai < 2; ++ai)
#pragma unroll
            for (int m = 0; m < 4; ++m) {
                const f32x4 r4 = *(const f32x4*)(red + 1024 + (ai * 128 + wr * 64 + m * 16 + fr) * 4);
                const float inv = 1.f / ((r4[0] + r4[1]) + (r4[2] + r4[3]));
                const bool valid = d.vai < 0 || (d.vai == ai && d.vwr == wr);
                const int row = d.orow + ai * 128 + wr * 64 + m * 16 + fr;
                if (valid) {
#pragma unroll
                    for (int bj = 0; bj < 2; ++bj)
#pragma unroll
                        for (int n = 0; n < 2; ++n) {
                            const int col = bj * 128 + wc * 32 + n * 16 + fq * 4;
                            *(u32x2*)(((bf16_t*)(F.ws + WS_P)) + (size_t)row * LDP + C_PR + d.head * 256 + col) = pk4(acc[ai][bj][m][n] * inv);
                        }
                }
            }
        __syncthreads();
        return;
    }
#pragma unroll
    for (int ai = 0; ai < 2; ++ai)
#pragma unroll
        for (int m = 0; m < 4; ++m) {
            const int row = d.orow + ai * 128 + wr * 64 + m * 16 + fr;
            float rs = 1.f, ss = 0.f;
            if (d.epi == EPI_PROJ || d.epi == EPI_UP || d.epi == EPI_Q) rs = row_rstd(((float*)(F.ws + WS_SSQ)), row);
            if (d.epi == EPI_Q) rs *= 0.0625f;
            if (d.epi == EPI_MEMK) rs = ((float*)(F.ws + WS_MRS))[row];
#pragma unroll
            for (int bj = 0; bj < 2; ++bj)
#pragma unroll
                for (int n = 0; n < 2; ++n) {
                    const int col = d.ocol + bj * 128 + wc * 32 + n * 16 + fq * 4;
                    f32x4 v = acc[ai][bj][m][n];
                    switch (d.epi) {
                    case EPI_UP: {
                        const int row_l = ai * 128 + wr * 64 + m * 16 + fr, cl = bj * 128 + wc * 32 + n * 16 + fq * 4;
                        *(u32x2*)((bf16_t*)F.lds + row_l * 264 + cl) = pk4(v * rs);
                    } break;
                    case EPI_PROJ: {
                        v = v * rs; const u32x2 w = pk4(v);
                        *(u32x2*)(((bf16_t*)(F.ws + WS_P)) + (size_t)row * LDP + col) = w;
                        if (m == 3 && fr >= 13 && col < 1536) {
                            const int chunk = row >> 6, hr = fr - 13;
                            *(u32x2*)(((bf16_t*)(F.ws + WS_KV)) + ((size_t)chunk * 3 + hr) * 1536 + col) = w;
                            if (chunk >= 512 || (chunk & 31) == 31) {
                                float* o = chunk < 512 ? F.out + O_GDNC_P + ((size_t)(l * 16 + (chunk >> 5)) * 3 + hr) * 1536 + col
                                                       : F.out + O_GDNC_S + ((size_t)(l * 8 + (chunk - 512)) * 3 + hr) * 1536 + col;
                                *(f32x4*)o = v;
                            }
                        }
                    } break;
                    case EPI_RESID: {
                        float* X = F.out + (size_t)row * 1024 + col;
                        const float* Xs = d.head ? (row < 32768 ? F.in[0] + (size_t)row * 1024 + col : F.in[1] + (size_t)(row - 32768) * 1024 + col) : X;
                        f32x4 x = *(const f32x4*)Xs; x = x + v; *(f32x4*)X = x;
                        *(u32x2*)(((bf16_t*)(F.ws + WS_XB)) + (size_t)row * 1024 + col) = pk4(x);
                        ss += (x[0] * x[0] + x[1] * x[1]) + (x[2] * x[2] + x[3] * x[3]);
                    } break;
                    case EPI_Q: *(u32x2*)(((bf16_t*)(F.ws + WS_P)) + (size_t)row * LDP + C_Q + col) = pk4(v * rs); break;
                    case EPI_MEMK: {
                        v = v * rs;
                        *(f32x4*)(F.out + O_MEMK + ((size_t)l * 4096 + row) * 1024 + col) = v;
                        *(u32x2*)(((bf16_t*)(F.ws + WS_KV)) + (size_t)row * 1024 + col) = pk4(v);
                    } break;
                    case EPI_MEMV: {
                        const f32x4 r4 = *(const f32x4*)(((float*)(F.ws + WS_MRS)) + col);
                        v = v * r4;
                        float* o = F.out + O_MEMV + ((size_t)l * 4096 + col) * 1024 + row;
                        o[0] = v[0]; o[1024] = v[1]; o[2048] = v[2]; o[3072] = v[3];
                        const int b = col >> 8, h = row >> 8;
                        *(u32x2*)(((bf16_t*)(F.ws + WS_KV + 6144ull * 1024 * 2)) + ((size_t)(b * 4 + h) * 256 + (row & 255)) * 256 + (col & 255)) = pk4(v);
                    } break;
                    case EPI_OUTA: {
                        const f32x4 g = unpk4(*(const u32x2*)(((bf16_t*)(F.ws + WS_P)) + (size_t)row * LDP + C_GA + col));
                        f32x4 o; for (int j = 0; j < 4; ++j) o[j] = sigm(g[j]) * v[j];
                        *(u32x2*)(((bf16_t*)(F.ws + WS_P)) + (size_t)row * LDP + C_MRG + col) = pk4(o);
                    } break;
                    case EPI_OUTB: {
                        const f32x4 g = unpk4(*(const u32x2*)(((bf16_t*)(F.ws + WS_P)) + (size_t)row * LDP + C_GB + col));
                        f32x4 o = unpk4(*(const u32x2*)(((bf16_t*)(F.ws + WS_P)) + (size_t)row * LDP + C_MRG + col));
                        for (int j = 0; j < 4; ++j) o[j] += sigm(g[j]) * v[j];
                        *(u32x2*)(((bf16_t*)(F.ws + WS_P)) + (size_t)row * LDP + C_MRG + col) = pk4(o);
                    } break;
                    case EPI_ATTNO: {
                        const bool valid = d.vai < 0 || (d.vai == ai && d.vwr == wr);
                        if (valid) *(u32x2*)(((bf16_t*)(F.ws + WS_P)) + (size_t)row * LDP + C_O + d.head * 256 + col) = pk4(v);
                    } break;
                    default: break;
                    }
                }
            if (d.epi == EPI_RESID) {
                ss += __shfl_xor(ss, 16); ss += __shfl_xor(ss, 32);
                if (fq == 0) ((float*)(F.ws + WS_SSQ))[((size_t)(d.ocol >> 8) * TT + row) * 4 + wc] = ss;
            }
        }
    if (d.epi == EPI_UP) {
        bf16_t* ST = (bf16_t*)F.lds;
        const int pm = d.brow >> 8, pn = d.bcol >> 8;
        const bool samp = pm >= 128, needfix = !samp && (pm & 7) != 0;
        bf16_t* halo = ((bf16_t*)(F.ws + WS_KV)); bf16_t* raw01 = ((bf16_t*)(F.ws + WS_KV + 11714560ull));
        __syncthreads();
        {
            const int hsel = F.tid >> 6, cl4 = (F.tid & 63) * 4, ocol = ((cl4 >> 7) ? 2816 : 0) + 128 * pn + (cl4 & 127);
            const int row_l = (hsel >> 1) * 64 + 62 + (hsel & 1), chunk = (d.brow + row_l) >> 6, hr = hsel & 1;
            const u32x2 w = *(const u32x2*)(ST + row_l * 264 + cl4);
            *(u32x2*)(halo + ((size_t)chunk * 2 + hr) * 5632 + ocol) = w;
            if (chunk >= 512 || (chunk & 31) == 31) {
                float* o = chunk < 512 ? F.out + O_FFNC_P + ((size_t)(l * 16 + (chunk >> 5)) * 2 + hr) * 5632 + ocol
                                       : F.out + O_FFNC_S + ((size_t)(l * 8 + (chunk - 512)) * 2 + hr) * 5632 + ocol;
                *(f32x4*)o = unpk4(w);
            }
            if (needfix && hsel < 2) *(u32x2*)(raw01 + ((size_t)pm * 2 + hsel) * 5632 + ocol) = *(const u32x2*)(ST + hsel * 264 + cl4);
        }
        {
            const int cq = F.tid & 31, rg = F.tid >> 5, c4 = cq * 4, gcol = 128 * pn + c4, r0 = rg * 16;
            const float* cw = F.in[29] + (size_t)l * 3 * 5632; const float* cb = F.in[30] + (size_t)l * 5632;
            const f32x4 wg0 = *(const f32x4*)(cw + gcol), wg1 = *(const f32x4*)(cw + 5632 + gcol), wg2 = *(const f32x4*)(cw + 2 * 5632 + gcol), bg = *(const f32x4*)(cb + gcol);
            const f32x4 wv0 = *(const f32x4*)(cw + 2816 + gcol), wv1 = *(const f32x4*)(cw + 5632 + 2816 + gcol), wv2 = *(const f32x4*)(cw + 2 * 5632 + 2816 + gcol), bv = *(const f32x4*)(cb + 2816 + gcol);
            f32x4 g2 = {0.f, 0.f, 0.f, 0.f}, g1 = g2, v2 = g2, v1 = g2; bool skip2 = false;
            if ((samp ? (r0 & 63) : r0) != 0) {
                g2 = unpk4(*(const u32x2*)(ST + (r0 - 2) * 264 + c4)); g1 = unpk4(*(const u32x2*)(ST + (r0 - 1) * 264 + c4));
                v2 = unpk4(*(const u32x2*)(ST + (r0 - 2) * 264 + 128 + c4)); v1 = unpk4(*(const u32x2*)(ST + (r0 - 1) * 264 + 128 + c4));
            } else if (samp) {
                const float* sp = F.in[5] + (size_t)(l * 8 + (((d.brow + r0) >> 6) - 512)) * 2 * 5632;
                g2 = *(const f32x4*)(sp + gcol); g1 = *(const f32x4*)(sp + 5632 + gcol); v2 = *(const f32x4*)(sp + 2816 + gcol); v1 = *(const f32x4*)(sp + 5632 + 2816 + gcol);
            } else skip2 = needfix;
#pragma unroll 4
            for (int i = 0; i < 16; ++i) {
                const int row_l = r0 + i;
                const f32x4 g0 = unpk4(*(const u32x2*)(ST + row_l * 264 + c4)), v0 = unpk4(*(const u32x2*)(ST + row_l * 264 + 128 + c4));
                f32x4 o;
#pragma unroll
                for (int j = 0; j < 4; ++j) { const float yg = wg0[j] * g2[j] + wg1[j] * g1[j] + wg2[j] * g0[j] + bg[j], yv = wv0[j] * v2[j] + wv1[j] * v1[j] + wv2[j] * v0[j] + bv[j]; o[j] = silu(yg) * yv; }
                if (!(skip2 && i < 2)) *(u32x2*)(((bf16_t*)(F.ws + WS_P)) + (size_t)(d.brow + row_l) * LDP + gcol) = pk4(o);
                g2 = g1; g1 = g0; v2 = v1; v1 = v0;
            }
        }
        __syncthreads();
    }
}

DEV void sample_rows_gemm(const Frame& F0, const bf16_t* A, int lda, const bf16_t* Bt, int K, int resid) {
    REFRAME;
    if (F.nb != 256) return;
    const int fr = F.lane & 15, fq = F.lane >> 4, w = F.wid, rgp = F.bid >> 3, cg = F.bid & 7;
    const int row = 32768 + rgp * 16 + fr, colt = cg * 128 + w * 16;
    const bf16_t* ap = A + (size_t)row * lda + 8 * fq;
    const bf16_t* bp = Bt + (size_t)(colt + fr) * K + 8 * fq;
    f32x4 acc = {0.f, 0.f, 0.f, 0.f};
#pragma unroll 8
    for (int k = 0; k < K; k += 32) acc = MFMA16(*(const bf16x8*)(bp + k), *(const bf16x8*)(ap + k), acc);
    const int col = colt + 4 * fq;
    if (resid == 1 || resid == 4) {
        float* X = F.out + (size_t)row * 1024 + col;
        const float* Xs = resid == 4 ? F.in[1] + (size_t)(row - 32768) * 1024 + col : X;
        f32x4 x = *(const f32x4*)Xs; x = x + acc; *(f32x4*)X = x;
        *(u32x2*)(((bf16_t*)(F.ws + WS_XB)) + (size_t)row * 1024 + col) = pk4(x);
        float ss = (x[0] * x[0] + x[1] * x[1]) + (x[2] * x[2] + x[3] * x[3]);
        ss += __shfl_xor(ss, 16); ss += __shfl_xor(ss, 32);
        float* red = (float*)F.lds;
        __syncthreads();
        if (fq == 0) red[fr * 8 + w] = ss;
        __syncthreads();
        if (F.tid < 32) {
            const int r = F.tid & 15, g = F.tid >> 4, c0 = cg * 128 + g * 64;
            const float t = (red[r * 8 + g * 4] + red[r * 8 + g * 4 + 1]) + (red[r * 8 + g * 4 + 2] + red[r * 8 + g * 4 + 3]);
            ((float*)(F.ws + WS_SSQ))[((size_t)(c0 >> 8) * TT + 32768 + rgp * 16 + r) * 4 + ((c0 >> 6) & 3)] = t;
        }
        __syncthreads();
    } else if (resid == 0) {
        const float rs = row_rstd(((float*)(F.ws + WS_SSQ)), row) * 0.0625f;
        *(u32x2*)(((bf16_t*)(F.ws + WS_P)) + (size_t)row * LDP + C_Q + col) = pk4(acc * rs);
    } else {
        bf16_t* prow = ((bf16_t*)(F.ws + WS_P)) + (size_t)row * LDP;
        const f32x4 g = unpk4(*(const u32x2*)(prow + (resid == 2 ? C_GA : C_GB) + col));
        f32x4 o = {0.f, 0.f, 0.f, 0.f};
        if (resid == 3) o = unpk4(*(const u32x2*)(prow + C_MRG + col));
#pragma unroll
        for (int j = 0; j < 4; ++j) o[j] += sigm(g[j]) * acc[j];
        *(u32x2*)(prow + C_MRG + col) = pk4(o);
    }
}

enum { GP_IN = 0, GP_OUT, GP_WO, GP_MQ, GP_ATTN, GP_MO, GP_UP, GP_DOWN, GP_ATTN2, GP_OUT2, GP_MEMKV };
DEV void gemm_phase(const Frame& F0, int kind, int l) {
    REFRAME;
    int nunits = 0;
    switch (kind) { case GP_IN: case GP_UP: nunits = 130 * 22; break; case GP_OUT: nunits = 520 + 128; break; case GP_OUT2: nunits = 520; break; case GP_ATTN: case GP_ATTN2: nunits = 512 + 32; break; default: nunits = 520; }
    const bool srow = (F.nb == 256) && (kind == GP_WO || kind == GP_MQ || kind == GP_MO || kind == GP_DOWN || kind == GP_OUT || kind == GP_OUT2);
    if (srow) nunits = 512;
    if (kind == GP_MEMKV) nunits = 128;
    f32x4 acc[2][2][4][2];
    const bool xmap = (F.nb == 256) && (kind == GP_IN || kind == GP_UP || kind == GP_WO || kind == GP_MQ || kind == GP_MO || kind == GP_DOWN || kind == GP_OUT2 || (kind == GP_OUT && srow));
    const int xcd = F.bid & 7, slot = F.bid >> 3, w_lo = (int)(((long)nunits * xcd) >> 3), w_hi = (int)(((long)nunits * (xcd + 1)) >> 3);
    const bool mkv = kind == GP_MEMKV;
    for (int u0 = mkv ? (F.bid >= 192 ? F.bid - 192 : nunits) : (xmap ? w_lo + slot : F.bid); u0 < (xmap ? w_hi : nunits); u0 += mkv ? 64 : (xmap ? 32 : F.nb)) {
        for (int sb = 0; sb < ((kind == GP_OUT && srow) ? 2 : 1); ++sb) {
        int u = u0;
        if (xmap) { const int nn = (kind == GP_IN || kind == GP_UP) ? 22 : 4; const int nm = srow ? 128 : 130; const int pn_ = u0 / nm, pm_ = u0 % nm; u = pm_ * nn + pn_; }
        GDesc d;
        { const int sub = (kind == GP_ATTN2 || kind == GP_OUT2 || sb) ? 1 : 0;
            d.vai = -1; d.vwr = 0; d.head = 0;
            switch (kind) {
            case GP_IN: { const int pm = u / 22, pn = u % 22; d.A = ((bf16_t*)(F.ws + WS_XB)); d.lda = 1024; d.Bt = ((bf16_t*)(F.ws + WS_WMIX)) + WM_WIN; d.ldb = 1024; d.K = 1024; d.brow = pm * 256; d.bcol = pn * 256; d.epi = EPI_PROJ; d.orow = d.brow; d.ocol = d.bcol; } break;
            case GP_UP: { const int pm = u / 22, pn = u % 22; d.A = ((bf16_t*)(F.ws + WS_XB)); d.lda = 1024; d.Bt = ((bf16_t*)(F.ws + WS_WFFN)) + WF_UP; d.ldb = 1024; d.K = 1024; d.brow = pm * 256; d.bcol = pn * 256; d.epi = EPI_UP; d.orow = d.brow; d.ocol = d.bcol; } break;
            case GP_MEMKV: case GP_OUT: case GP_OUT2:
                if (kind == GP_MEMKV) u += 520;
                if (u < 520) { const int pm = u >> 2, pn = u & 3; d.A = ((bf16_t*)(F.ws + WS_P)) + (sub == 0 ? C_ZA : C_ZB); d.lda = LDP; d.Bt = ((bf16_t*)(F.ws + WS_WMIX)) + (sub == 0 ? WM_WOA : WM_WOB); d.ldb = 512; d.K = 512;
                               d.brow = pm * 256; d.bcol = pn * 256; d.epi = sub == 0 ? EPI_OUTA : EPI_OUTB; d.orow = d.brow; d.ocol = d.bcol; }
                else if (u < 520 + 64) { const int v = u - 520, pm = v >> 2, pn = v & 3; d.A = ((bf16_t*)(F.ws + WS_MB)); d.lda = 1024; d.Bt = ((bf16_t*)(F.ws + WS_WMIX)) + WM_WMK; d.ldb = 1024; d.K = 1024; d.brow = pm * 256; d.bcol = pn * 256; d.epi = EPI_MEMK; d.orow = d.brow; d.ocol = d.bcol; }
                else { const int v = u - 584, pm = v & 3, pn = v >> 2; d.A = ((bf16_t*)(F.ws + WS_WMIX)) + WM_WMV; d.lda = 1024; d.Bt = ((bf16_t*)(F.ws + WS_MB)); d.ldb = 1024; d.K = 1024; d.brow = pm * 256; d.bcol = pn * 256; d.epi = EPI_MEMV; d.orow = d.brow; d.ocol = d.bcol; }
                break;
            case GP_WO: { d.head = (l == 0); const int pm = u >> 2, pn = u & 3; d.A = ((bf16_t*)(F.ws + WS_P)) + C_MRG; d.lda = LDP; d.Bt = ((bf16_t*)(F.ws + WS_WMIX)) + WM_WO; d.ldb = 1024; d.K = 1024; d.brow = pm * 256; d.bcol = pn * 256; d.epi = EPI_RESID; d.orow = d.brow; d.ocol = d.bcol; } break;
            case GP_MQ: { const int pm = u >> 2, pn = u & 3; d.A = ((bf16_t*)(F.ws + WS_XB)); d.lda = 1024; d.Bt = ((bf16_t*)(F.ws + WS_WMIX)) + WM_WMQ; d.ldb = 1024; d.K = 1024; d.brow = pm * 256; d.bcol = pn * 256; d.epi = EPI_Q; d.orow = d.brow; d.ocol = d.bcol; } break;
            case GP_MO: { const int pm = u >> 2, pn = u & 3; d.A = ((bf16_t*)(F.ws + WS_P)) + C_O; d.lda = LDP; d.Bt = ((bf16_t*)(F.ws + WS_WMIX)) + WM_WMO; d.ldb = 1024; d.K = 1024; d.brow = pm * 256; d.bcol = pn * 256; d.epi = EPI_RESID; d.orow = d.brow; d.ocol = d.bcol; } break;
            case GP_DOWN: { const int pm = u >> 2, pn = u & 3; d.A = ((bf16_t*)(F.ws + WS_P)); d.lda = LDP; d.Bt = ((bf16_t*)(F.ws + WS_WFFN)) + WF_DN; d.ldb = 2816; d.K = 2816; d.brow = pm * 256; d.bcol = pn * 256; d.epi = EPI_RESID; d.orow = d.brow; d.ocol = d.bcol; } break;
            case GP_ATTN: case GP_ATTN2: {
                int pm, h, b;
                if (u < 512) { pm = u >> 2; h = u & 3; b = pm >> 3; }
                else { const int v = u - 512; h = v & 3; const int bi = (v >> 2) & 3, t = v >> 4; pm = 128 + t; b = 16 + 4 * t + bi; d.vai = bi >> 1; d.vwr = bi & 1; }
                d.head = h; d.brow = pm * 256; d.orow = d.brow; d.ocol = 0; d.K = 256; d.bcol = 0;
                if (sub == 0) { d.A = ((bf16_t*)(F.ws + WS_P)) + C_Q + h * 256; d.lda = LDP; d.Bt = ((bf16_t*)(F.ws + WS_KV)) + (size_t)b * 256 * 1024 + h * 256; d.ldb = 1024; d.epi = EPI_SOFTMAX; }
                else { d.A = ((bf16_t*)(F.ws + WS_P)) + C_PR + h * 256; d.lda = LDP; d.Bt = ((bf16_t*)(F.ws + WS_KV + 6144ull * 1024 * 2)) + (size_t)(b * 4 + h) * 65536; d.ldb = 256; d.epi = EPI_ATTNO; }
            } break;
            }
        }
        if (sb) { asm volatile("s_waitcnt vmcnt(0)" ::: "memory"); __syncthreads(); }
        gemm_core(d.A, d.lda, d.Bt, d.ldb, d.K, d.brow, d.bcol, acc, (bf16_t*)F.lds);
        gemm_epilogue(F, d, l, acc);
        }
    }
    if (srow) {
        __syncthreads();
        if (kind == GP_WO) sample_rows_gemm(F, ((bf16_t*)(F.ws + WS_P)) + C_MRG, LDP, ((bf16_t*)(F.ws + WS_WMIX)) + WM_WO, 1024, l == 0 ? 4 : 1);
        else if (kind == GP_MQ) sample_rows_gemm(F, ((bf16_t*)(F.ws + WS_XB)), 1024, ((bf16_t*)(F.ws + WS_WMIX)) + WM_WMQ, 1024, 0);
        else if (kind == GP_OUT) { sample_rows_gemm(F, ((bf16_t*)(F.ws + WS_P)) + C_ZA, LDP, ((bf16_t*)(F.ws + WS_WMIX)) + WM_WOA, 512, 2); asm volatile("s_waitcnt vmcnt(0)" ::: "memory");
                                   sample_rows_gemm(F, ((bf16_t*)(F.ws + WS_P)) + C_ZB, LDP, ((bf16_t*)(F.ws + WS_WMIX)) + WM_WOB, 512, 3); }
        else if (kind == GP_OUT2) sample_rows_gemm(F, ((bf16_t*)(F.ws + WS_P)) + C_ZB, LDP, ((bf16_t*)(F.ws + WS_WMIX)) + WM_WOB, 512, 3);
        else if (kind == GP_MO) sample_rows_gemm(F, ((bf16_t*)(F.ws + WS_P)) + C_O, LDP, ((bf16_t*)(F.ws + WS_WMIX)) + WM_WMO, 1024, 1);
        else sample_rows_gemm(F, ((bf16_t*)(F.ws + WS_P)), LDP, ((bf16_t*)(F.ws + WS_WFFN)) + WF_DN, 2816, 1);
    }
}

DEV void sample_kv(const Frame& F0, int l) {
    REFRAME;
    const float* ck = F.in[6] + (size_t)l * 2097152; const float* cv = F.in[7] + (size_t)l * 2097152;
    const bool idle = F.nb == 256;
    if (idle && F.bid < 192) return;
    for (int i = (idle ? F.bid - 192 : F.bid) * 512 + F.tid; i < 262144; i += (idle ? 64 : F.nb) * 512) {
        const f32x4 a = *(const f32x4*)(ck + (size_t)i * 8), b = *(const f32x4*)(ck + (size_t)i * 8 + 4);
        u32x4 w; w.x = pk2(a[0], a[1]); w.y = pk2(a[2], a[3]); w.z = pk2(b[0], b[1]); w.w = pk2(b[2], b[3]);
        *(u32x4*)(((bf16_t*)(F.ws + WS_KV)) + 4096ull * 1024 + (size_t)i * 8) = w;
        const int dd = i & 255, m8 = (i >> 8) & 31, h = (i >> 13) & 3, bb = i >> 15;
        const float* s = cv + ((size_t)(bb * 256 + m8 * 8) * 4 + h) * 256 + dd;
        u32x4 x; x.x = pk2(s[0], s[1024]); x.y = pk2(s[2048], s[3072]); x.z = pk2(s[4096], s[5120]); x.w = pk2(s[6144], s[7168]);
        *(u32x4*)(((bf16_t*)(F.ws + WS_KV + 6144ull * 1024 * 2)) + ((size_t)((16 + bb) * 4 + h) * 256 + dd) * 256 + m8 * 8) = x;
    }
}

DEV void g1_gdn(const Frame& F0, int l, int c, int h) {
    REFRAME;
    float* Fq = (float*)F.lds;
    bf16_t* VS = (bf16_t*)(F.lds + 66560);
    bf16_t* QN = (bf16_t*)(F.lds + 82944);
    bf16_t* KN = (bf16_t*)(F.lds + 100352);
    float* AM = (float*)(F.lds + 117760);
    float* sB = (float*)(F.lds + 135168); float* sG = sB + 64; float* sRQ = sB + 128; float* sRK = sB + 192;
    const int tid = F.tid, lane = F.lane, t0 = c * 64;
    const bool first = c >= 512 || (c & 31) == 0; const bool sample = c >= 512;
    __syncthreads();
    if (F.wid == 7) {
        const int t = t0 + lane;
        const float braw = ((float*)(F.ws + WS_SC))[(size_t)t * 32 + h], araw = ((float*)(F.ws + WS_SC))[(size_t)t * 32 + 4 + h];
        const float beta = sigm(braw);
        float g = -__expf(F.in[12][l * 4 + h]) * softplus(araw + F.in[13][l * 4 + h]);
#pragma unroll
        for (int off = 1; off < 64; off <<= 1) { const float n = __shfl_up(g, off); if (lane >= off) g += n; }
        sB[lane] = beta; sG[lane] = g;
        if (!F.dry) ((float*)(F.ws + WS_BG))[((size_t)c * 4 + h) * 128 + lane] = beta; if (!F.dry) ((float*)(F.ws + WS_BG))[((size_t)c * 4 + h) * 128 + 64 + lane] = g;
    }
    const float* cw = F.in[11] + (size_t)l * 4 * 1536;
    if (tid < 384) {
        const int cp = tid % 192, rh = tid / 192, which = cp >> 6, cc = (cp & 63) * 2, pcol = which * 512 + h * 128 + cc;
        const f32x2 w0 = *(const f32x2*)(cw + pcol), w1 = *(const f32x2*)(cw + 1536 + pcol), w2 = *(const f32x2*)(cw + 2 * 1536 + pcol), w3 = *(const f32x2*)(cw + 3 * 1536 + pcol);
        float x0[35], x1[35];
#pragma unroll
        for (int i = 0; i < 3; ++i) {
            x0[i] = 0.f; x1[i] = 0.f;
            if (rh == 1) { const unsigned u = *(const unsigned*)(((bf16_t*)(F.ws + WS_P)) + (size_t)(t0 + 29 + i) * LDP + pcol); x0[i] = bflo(u); x1[i] = bfhi(u); }
            else if (!first) { const unsigned u = *(const unsigned*)(((bf16_t*)(F.ws + WS_KV)) + ((size_t)(c - 1) * 3 + i) * 1536 + pcol); x0[i] = bflo(u); x1[i] = bfhi(u); }
            else if (sample) { const f32x2 f = *(const f32x2*)(F.in[3] + ((size_t)(l * 8 + (c - 512)) * 3 + i) * 1536 + pcol); x0[i] = f[0]; x1[i] = f[1]; }
        }
#pragma unroll
        for (int i = 0; i < 32; ++i) { const unsigned u = *(const unsigned*)(((bf16_t*)(F.ws + WS_P)) + (size_t)(t0 + 32 * rh + i) * LDP + pcol); x0[3 + i] = bflo(u); x1[3 + i] = bfhi(u); }
#pragma unroll
        for (int r = 0; r < 32; ++r) {
            float a0 = w0[0] * x0[r] + w1[0] * x0[r + 1] + w2[0] * x0[r + 2] + w3[0] * x0[r + 3];
            float a1 = w0[1] * x1[r] + w1[1] * x1[r + 1] + w2[1] * x1[r + 2] + w3[1] * x1[r + 3];
            a0 = silu(a0); a1 = silu(a1);
            const int rr = 32 * rh + r;
            if (which < 2) { *(f32x2*)(Fq + rr * 260 + which * 128 + cc) = (f32x2){a0, a1}; }
            else { *(unsigned*)(VS + rr * 128 + cc) = pk2(a0, a1); }
        }
    }
    __syncthreads();
    {
        const int r = tid >> 3, j = tid & 7; const float* p = Fq + r * 260 + j * 32; float s = 0.f;
#pragma unroll
        for (int i = 0; i < 32; ++i) s += p[i] * p[i];
        s += __shfl_xor(s, 1); s += __shfl_xor(s, 2);
        if ((j & 3) == 0) { if (j == 0) sRQ[r] = rsqrtf(s + 1e-6f) * 0.08838834764831845f; else sRK[r] = rsqrtf(s + 1e-6f); }
    }
    __syncthreads();
    for (int idx = tid; idx < 64 * 64; idx += 512) {
        const int r = idx >> 6, c4 = (idx & 63) * 4; const bool isq = c4 < 128;
        f32x4 v = *(const f32x4*)(Fq + r * 260 + c4); v = v * (isq ? sRQ[r] : sRK[r]);
        const u32x2 w = pk4(v);
        if (isq) { *(u32x2*)(QN + r * 136 + c4) = w; if (!F.dry) *(u32x2*)(((bf16_t*)(F.ws + WS_P)) + (size_t)(t0 + r) * LDP + C_QA + h * 128 + c4) = w; }
        else { *(u32x2*)(KN + r * 136 + c4 - 128) = w; if (!F.dry) *(u32x2*)(((bf16_t*)(F.ws + WS_P)) + (size_t)(t0 + r) * LDP + C_KA + h * 128 + c4 - 128) = w; }
    }
    for (int idx = tid; idx < 64 * 32; idx += 512) {
        const int r = idx >> 5, c4 = (idx & 31) * 4;
        if (!F.dry) *(u32x2*)(((bf16_t*)(F.ws + WS_P)) + (size_t)(t0 + r) * LDP + C_VA + h * 128 + c4) = pk4(unpk4(*(const u32x2*)(VS + r * 128 + c4)) * sB[r]);
    }
    __syncthreads();
    {
        const int fr = lane & 15, fq = lane >> 4, which = F.wid >> 2, it = F.wid & 3;
        const bf16_t* X = which ? QN : KN;
        const int crow = 16 * it + fr; const float gc = sG[crow], bc = sB[crow];
        for (int jt = 0; jt < 4; ++jt) {
            f32x4 a = {0.f, 0.f, 0.f, 0.f};
            if (jt <= it) {
#pragma unroll
                for (int ks = 0; ks < 4; ++ks) a = MFMA16(ldfrag(KN, 16 * jt + fr, 136, 32 * ks, fq), ldfrag(X, crow, 136, 32 * ks, fq), a);
            }
            f32x4 o;
#pragma unroll
            for (int j = 0; j < 4; ++j) {
                const int s = 16 * jt + 4 * fq + j;
                const bool keep = which ? (s <= crow) : (s < crow);
                const float dec = keep ? __expf(gc - sG[s]) : 0.f;
                o[j] = a[j] * dec * (which ? 1.f : bc);
            }
            if (which) { if (!F.dry) *(u32x2*)(((bf16_t*)(F.ws + WS_XB)) + (size_t)(t0 + crow) * LDE + h * 128 + 64 + 16 * jt + 4 * fq) = pk4(o); }
            else *(f32x4*)(AM + crow * 68 + 16 * jt + 4 * fq) = o;
        }
    }
    __syncthreads();
    {
        float* TF = (float*)F.lds;
        float* MS = (float*)(F.lds + 20480);
        const int w = F.wid;
        if (w == 0) {
            const int blk = lane >> 4, cc = lane & 15, base = blk * 16;
            float Tc[16];
#pragma unroll
            for (int i = 0; i < 16; ++i) {
                float a = (i == cc) ? 1.f : 0.f;
#pragma unroll
                for (int j = 0; j < i; ++j) a -= AM[(base + i) * 68 + base + j] * Tc[j];
                Tc[i] = a;
            }
#pragma unroll
            for (int i = 0; i < 16; ++i) TF[(base + i) * 68 + base + cc] = Tc[i];
        }
        __syncthreads();
#pragma unroll 1
        for (int dd = 1; dd < 4; ++dd) {
            if (w < 4 - dd) {
                const int I = w + dd, J = w, r = lane >> 2, c4 = (lane & 3) * 4;
                f32x4 mm = {0.f, 0.f, 0.f, 0.f};
                for (int K = J; K < I; ++K)
#pragma unroll
                    for (int k = 0; k < 16; ++k) { const float a = AM[(I * 16 + r) * 68 + K * 16 + k]; const f32x4 t = *(const f32x4*)(TF + (K * 16 + k) * 68 + J * 16 + c4); mm = mm + a * t; }
                float* ms = MS + w * 256;
                *(f32x4*)(ms + r * 16 + c4) = mm;
                asm volatile("s_waitcnt lgkmcnt(0)" ::: "memory");
                f32x4 o = {0.f, 0.f, 0.f, 0.f};
#pragma unroll
                for (int k = 0; k < 16; ++k) { const float a = TF[(I * 16 + r) * 68 + I * 16 + k]; const f32x4 t = *(const f32x4*)(ms + k * 16 + c4); o = o - a * t; }
                *(f32x4*)(TF + (I * 16 + r) * 68 + J * 16 + c4) = o;
            }
            __syncthreads();
        }
        {
            const int r = tid >> 3, c8 = (tid & 7) * 8; const bool z = (c8 >> 4) > (r >> 4);
            const f32x4 a = z ? (f32x4){0.f, 0.f, 0.f, 0.f} : *(const f32x4*)(TF + r * 68 + c8), b = z ? (f32x4){0.f, 0.f, 0.f, 0.f} : *(const f32x4*)(TF + r * 68 + c8 + 4);
            u32x4 o; o.x = pk2(a[0], a[1]); o.y = pk2(a[2], a[3]); o.z = pk2(b[0], b[1]); o.w = pk2(b[2], b[3]);
            if (!F.dry) *(u32x4*)(((bf16_t*)(F.ws + WS_XB)) + (size_t)(t0 + r) * LDE + h * 128 + c8) = o;
        }
    }
}

DEV void g1_gla(const Frame& F0, int l, int c, int h) {
    REFRAME;
    float* GL = (float*)F.lds;
    float* LA = (float*)(F.lds + 4096);
    bf16_t* QG = (bf16_t*)(F.lds + 20736);
    bf16_t* KI = (bf16_t*)(F.lds + 29952);
    const int tid = F.tid, lane = F.lane, t0 = c * 64;
    __syncthreads();
    if (tid < 256) { const int r = tid >> 2, q4 = (tid & 3) * 4; *(f32x4*)(GL + r * 16 + q4) = *(const f32x4*)(((float*)(F.ws + WS_SC)) + (size_t)(t0 + r) * 32 + 8 + q4); }
    __syncthreads();
    {
        const int dk = tid & 63, rb = tid >> 6;
        float w2[16];
#pragma unroll
        for (int i = 0; i < 16; ++i) w2[i] = F.in[15][(size_t)(l * 16 + i) * 256 + h * 64 + dk];
        const float bias = F.in[16][l * 256 + h * 64 + dk];
#pragma unroll
        for (int rr = 0; rr < 8; ++rr) {
            const int r = rb * 8 + rr; float x = bias;
#pragma unroll
            for (int i = 0; i < 16; ++i) x += GL[r * 16 + i] * w2[i];
            LA[r * 65 + dk] = logsigmoid(x) * 0.0625f;
        }
    }
    __syncthreads();
    if (tid < 64) {
        float g = 0.f;
#pragma unroll 8
        for (int r = 0; r < 64; ++r) { g += LA[r * 65 + tid]; LA[r * 65 + tid] = g; }
        if (!F.dry) ((float*)(F.ws + WS_DL))[((size_t)c * 4 + h) * 64 + tid] = __expf(g);
    }
    __syncthreads();
    for (int idx = tid; idx < 64 * 16; idx += 512) {
        const int r = idx >> 4, c4 = (idx & 15) * 4;
        bf16_t* qp = ((bf16_t*)(F.ws + WS_P)) + (size_t)(t0 + r) * LDP + C_QB + h * 64 + c4; bf16_t* kp = ((bf16_t*)(F.ws + WS_P)) + (size_t)(t0 + r) * LDP + C_KB + h * 64 + c4;
        const f32x4 q = unpk4(*(const u32x2*)qp), k = unpk4(*(const u32x2*)kp);
        f32x4 qg, ki, kg;
#pragma unroll
        for (int j = 0; j < 4; ++j) { const float g = LA[r * 65 + c4 + j], gl = LA[63 * 65 + c4 + j];
            qg[j] = q[j] * 0.125f * __expf(g); ki[j] = k[j] * __expf(-g); kg[j] = k[j] * __expf(gl - g); }
        const u32x2 wq = pk4(qg);
        *(u32x2*)(QG + r * 72 + c4) = wq; *(u32x2*)(KI + r * 72 + c4) = pk4(ki);
        if (!F.dry) *(u32x2*)qp = wq; if (!F.dry) *(u32x2*)kp = pk4(kg);
    }
    __syncthreads();
    {
        const int fr = lane & 15, fq = lane >> 4, it = F.wid >> 1; const int crow = 16 * it + fr;
#pragma unroll
        for (int q = 0; q < 2; ++q) {
            const int jt = (F.wid & 1) * 2 + q;
            f32x4 a = {0.f, 0.f, 0.f, 0.f};
            if (jt <= it) {
#pragma unroll
                for (int ks = 0; ks < 2; ++ks) a = MFMA16(ldfrag(KI, 16 * jt + fr, 72, 32 * ks, fq), ldfrag(QG, crow, 72, 32 * ks, fq), a);
            }
#pragma unroll
            for (int j = 0; j < 4; ++j) if (16 * jt + 4 * fq + j > crow) a[j] = 0.f;
            if (!F.dry) *(u32x2*)(((bf16_t*)(F.ws + WS_XB)) + (size_t)(t0 + crow) * LDE + 512 + h * 64 + 16 * jt + 4 * fq) = pk4(a);
        }
    }
}

DEV void g2_gdn(const Frame& F0, int l, int s, int h) {
    REFRAME;
    bf16_t* QN = (bf16_t*)F.lds;
    bf16_t* KN = (bf16_t*)(F.lds + 17408);
    bf16_t* KT = (bf16_t*)(F.lds + 34816);
    bf16_t* TM = (bf16_t*)(F.lds + 53248);
    bf16_t* AQ = (bf16_t*)(F.lds + 62464);
    float* sB = (float*)(F.lds + 71680); float* sG = sB + 64;
    float* RED = (float*)(F.lds + 72192);
    bf16_t* VV = (bf16_t*)(F.lds + 74240);
    bf16_t* ZZ0 = (bf16_t*)(F.lds + 91648);
    const int tid = F.tid, lane = F.lane, w = F.wid, fr = lane & 15, fq = lane >> 4;
    const bool sample = s >= 16; const int nchunk = sample ? 1 : 32; const int tbase = sample ? 32768 + (s - 16) * 64 : s * 2048;
    const int dvc = h * 128 + 16 * w + fr;
    f32x4 S[8];
#pragma unroll
    for (int mt = 0; mt < 8; ++mt) {
        if (sample) { const float* sp = F.in[2] + ((size_t)((l * 8 + (s - 16)) * 4 + h) * 128) * 128;
#pragma unroll
            for (int j = 0; j < 4; ++j) S[mt][j] = sp[(size_t)(16 * mt + 4 * fq + j) * 128 + 16 * w + fr]; }
        else S[mt] = (f32x4){0.f, 0.f, 0.f, 0.f};
    }
    const float gn = F.in[14][l * 128 + 16 * w + fr];
    u32x4 pq[2], pk[2], pv[2], pz[2], pt, pa; float pbg = 0.f;
#define G2_FETCH(T0) do { int tq_ = tid; asm volatile("" : "+v"(tq_)); _Pragma("unroll") for (int i = 0; i < 2; ++i) { const int p_ = tq_ + 512 * i, r_ = p_ >> 4, c_ = (p_ & 15) * 8; \
        const bf16_t* rp_ = ((bf16_t*)(F.ws + WS_P)) + (size_t)((T0) + r_) * LDP + h * 128 + c_; \
        pq[i] = *(const u32x4*)(rp_ + C_QA); pk[i] = *(const u32x4*)(rp_ + C_KA); pv[i] = *(const u32x4*)(rp_ + C_VA); pz[i] = *(const u32x4*)(rp_ + C_ZA); } \
      { const int r_ = tq_ >> 3, c_ = (tq_ & 7) * 8; const bf16_t* ep_ = ((bf16_t*)(F.ws + WS_XB)) + (size_t)((T0) + r_) * LDE + h * 128 + c_; pt = *(const u32x4*)ep_; pa = *(const u32x4*)(ep_ + 64); } \
      if (tq_ < 128) pbg = ((float*)(F.ws + WS_BG))[((size_t)((T0) >> 6) * 4 + h) * 128 + tq_]; } while (0)
#define G2_PUT(PAR) do { int tq_ = tid; asm volatile("" : "+v"(tq_)); bf16_t* zz_ = ZZ0 + (PAR) * (64 * 136); _Pragma("unroll") for (int i = 0; i < 2; ++i) { const int p_ = tq_ + 512 * i, r = p_ >> 4, c8 = (p_ & 15) * 8; const u32x4 k = pk[i]; \
        *(u32x4*)(QN + r * 136 + c8) = pq[i]; *(u32x4*)(KN + r * 136 + c8) = k; *(u32x4*)(VV + r * 136 + c8) = pv[i]; *(u32x4*)(zz_ + r * 136 + c8) = pz[i]; \
        KT[(c8 + 0) * 72 + r] = (bf16_t)(k.x & 0xffff); KT[(c8 + 1) * 72 + r] = (bf16_t)(k.x >> 16); KT[(c8 + 2) * 72 + r] = (bf16_t)(k.y & 0xffff); KT[(c8 + 3) * 72 + r] = (bf16_t)(k.y >> 16); \
        KT[(c8 + 4) * 72 + r] = (bf16_t)(k.z & 0xffff); KT[(c8 + 5) * 72 + r] = (bf16_t)(k.z >> 16); KT[(c8 + 6) * 72 + r] = (bf16_t)(k.w & 0xffff); KT[(c8 + 7) * 72 + r] = (bf16_t)(k.w >> 16); } \
      { const int r = tq_ >> 3, c8 = (tq_ & 7) * 8; *(u32x4*)(TM + r * 72 + c8) = pt; *(u32x4*)(AQ + r * 72 + c8) = pa; } \
      if (tq_ < 128) sB[tq_] = pbg; } while (0)
    __syncthreads();
    G2_FETCH(tbase); G2_PUT(0);
    __syncthreads();
    for (int n = 0; n < nchunk; ++n) {
        const int t0 = tbase + n * 64;
        const bf16_t* ZZ = ZZ0 + (n & 1) * (64 * 136);
        f32x4 kS[4], qS[4], vn[4], o[4];
#pragma unroll
        for (int mt = 0; mt < 4; ++mt) { kS[mt] = (f32x4){0.f, 0.f, 0.f, 0.f}; qS[mt] = kS[mt]; vn[mt] = kS[mt]; }
#pragma unroll
        for (int ks = 0; ks < 4; ++ks) {
            const bf16x8 sf = mk8(pk4(S[2 * ks]), pk4(S[2 * ks + 1]));
#pragma unroll
            for (int mt = 0; mt < 4; ++mt) {
                kS[mt] = MFMA16(ldfragp(KN, 16 * mt + fr, 136, 32 * ks, fq), sf, kS[mt]);
                qS[mt] = MFMA16(ldfragp(QN, 16 * mt + fr, 136, 32 * ks, fq), sf, qS[mt]);
            }
        }
        const float glast = sG[63];
        f32x4 eg[4], tmp[4];
#pragma unroll
        for (int mt = 0; mt < 4; ++mt)
#pragma unroll
            for (int j = 0; j < 4; ++j) {
                const int row = 16 * mt + 4 * fq + j;
                const float e = __expf(sG[row]); eg[mt][j] = e;
                const float vv = bf2f(VV[row * 136 + 16 * w + fr]);
                tmp[mt][j] = vv - sB[row] * e * kS[mt][j];
            }
#pragma unroll
        for (int ks = 0; ks < 2; ++ks) {
            const bf16x8 tf = mk8(pk4(tmp[2 * ks]), pk4(tmp[2 * ks + 1]));
#pragma unroll
            for (int mt = 0; mt < 4; ++mt) vn[mt] = MFMA16(ldfragp(TM, 16 * mt + fr, 72, 32 * ks, fq), tf, vn[mt]);
        }
#pragma unroll
        for (int mt = 0; mt < 4; ++mt) o[mt] = eg[mt] * qS[mt];
#pragma unroll
        for (int ks = 0; ks < 2; ++ks) {
            const bf16x8 vf = mk8(pk4(vn[2 * ks]), pk4(vn[2 * ks + 1]));
#pragma unroll
            for (int mt = 0; mt < 4; ++mt) o[mt] = MFMA16(ldfragp(AQ, 16 * mt + fr, 72, 32 * ks, fq), vf, o[mt]);
        }
        const float dl = __expf(glast);
#pragma unroll
        for (int mt = 0; mt < 4; ++mt)
#pragma unroll
            for (int j = 0; j < 4; ++j) vn[mt][j] *= __expf(glast - sG[16 * mt + 4 * fq + j]);
#pragma unroll
        for (int mt = 0; mt < 8; ++mt) S[mt] = S[mt] * dl;
#pragma unroll
        for (int ks = 0; ks < 2; ++ks) {
            const bf16x8 vf = mk8(pk4(vn[2 * ks]), pk4(vn[2 * ks + 1]));
#pragma unroll
            for (int mt = 0; mt < 8; ++mt) S[mt] = MFMA16(ldfragp(KT, 16 * mt + fr, 72, 32 * ks, fq), vf, S[mt]);
        }
#pragma unroll
        for (int mt = 0; mt < 4; ++mt)
#pragma unroll
            for (int j = 0; j < 4; ++j) {
                float p = o[mt][j] * o[mt][j];
                p += __shfl_xor(p, 1); p += __shfl_xor(p, 2); p += __shfl_xor(p, 4); p += __shfl_xor(p, 8);
                if (fr == 0) RED[(16 * mt + 4 * fq + j) * 8 + w] = p;
            }
        __syncthreads();
        if (n + 1 < nchunk) G2_FETCH(t0 + 64);
        __builtin_amdgcn_sched_barrier(0);
#pragma unroll
        for (int mt = 0; mt < 4; ++mt)
#pragma unroll
            for (int j = 0; j < 4; ++j) {
                const int row = 16 * mt + 4 * fq + j;
                const f32x4 r0 = *(const f32x4*)(RED + row * 8), r1 = *(const f32x4*)(RED + row * 8 + 4);
                const float ssum = ((r0[0] + r0[1]) + (r0[2] + r0[3])) + ((r1[0] + r1[1]) + (r1[2] + r1[3]));
                const float rs = rsqrtf(ssum * (1.f / 128.f) + 1e-6f);
                bf16_t* zp = ((bf16_t*)(F.ws + WS_P)) + (size_t)(t0 + row) * LDP + C_ZA + dvc;
                const float z = bf2f(ZZ[row * 136 + 16 * w + fr]);
                if (!F.dry) *zp = (bf16_t)(pk2(o[mt][j] * rs * gn * silu(z), 0.f) & 0xffff);
                __builtin_amdgcn_sched_barrier(0);
            }
        if (n + 1 < nchunk) { G2_PUT((n + 1) & 1); __syncthreads(); }
    }
#undef G2_FETCH
#undef G2_PUT
    float* so = sample ? F.out + O_GDN_S + ((size_t)((l * 8 + (s - 16)) * 4 + h) * 128) * 128 : F.out + O_GDN_P + ((size_t)((l * 16 + s) * 4 + h) * 128) * 128;
#pragma unroll
    for (int mt = 0; mt < 8; ++mt)
#pragma unroll
        for (int j = 0; j < 4; ++j) if (!F.dry) so[(size_t)(16 * mt + 4 * fq + j) * 128 + 16 * w + fr] = S[mt][j];
}

DEV void g2_gla(const Frame& F0, int l, int s, int h) {
    REFRAME;
    bf16_t* QG = (bf16_t*)F.lds;
    bf16_t* KGT = (bf16_t*)(F.lds + 9216);
    bf16_t* AQ = (bf16_t*)(F.lds + 18432);
    float* sDL = (float*)(F.lds + 27648);
    float* RED = (float*)(F.lds + 27904);
    bf16_t* ZZ = (bf16_t*)(F.lds + 29952);
    const int tid = F.tid, lane = F.lane, w = F.wid, fr = lane & 15, fq = lane >> 4;
    const bool sample = s >= 16; const int nchunk = sample ? 1 : 32; const int tbase = sample ? 32768 + (s - 16) * 64 : s * 2048;
    const int dvc = h * 128 + 16 * w + fr;
    f32x4 S[4];
#pragma unroll
    for (int mt = 0; mt < 4; ++mt) {
        if (sample) { const float* sp = F.in[4] + ((size_t)((l * 8 + (s - 16)) * 4 + h) * 64) * 128;
#pragma unroll
            for (int j = 0; j < 4; ++j) S[mt][j] = sp[(size_t)(16 * mt + 4 * fq + j) * 128 + 16 * w + fr]; }
        else S[mt] = (f32x4){0.f, 0.f, 0.f, 0.f};
    }
    const float gn = F.in[17][l * 128 + 16 * w + fr];
    for (int n = 0; n < nchunk; ++n) {
        const int t0 = tbase + n * 64, chunk = t0 >> 6;
        __syncthreads();
        {
            const int r = tid >> 3, c8 = (tid & 7) * 8;
            *(u32x4*)(QG + r * 72 + c8) = *(const u32x4*)(((bf16_t*)(F.ws + WS_P)) + (size_t)(t0 + r) * LDP + C_QB + h * 64 + c8);
            const u32x4 k = *(const u32x4*)(((bf16_t*)(F.ws + WS_P)) + (size_t)(t0 + r) * LDP + C_KB + h * 64 + c8);
            KGT[(c8 + 0) * 72 + r] = (bf16_t)(k.x & 0xffff); KGT[(c8 + 1) * 72 + r] = (bf16_t)(k.x >> 16);
            KGT[(c8 + 2) * 72 + r] = (bf16_t)(k.y & 0xffff); KGT[(c8 + 3) * 72 + r] = (bf16_t)(k.y >> 16);
            KGT[(c8 + 4) * 72 + r] = (bf16_t)(k.z & 0xffff); KGT[(c8 + 5) * 72 + r] = (bf16_t)(k.z >> 16);
            KGT[(c8 + 6) * 72 + r] = (bf16_t)(k.w & 0xffff); KGT[(c8 + 7) * 72 + r] = (bf16_t)(k.w >> 16);
            *(u32x4*)(AQ + r * 72 + c8) = *(const u32x4*)(((bf16_t*)(F.ws + WS_XB)) + (size_t)(t0 + r) * LDE + 512 + h * 64 + c8);
        }
#pragma unroll
        for (int i = 0; i < 2; ++i) { const int p = tid + 512 * i, r = p >> 4, c8 = (p & 15) * 8;
            *(u32x4*)(ZZ + r * 136 + c8) = *(const u32x4*)(((bf16_t*)(F.ws + WS_P)) + (size_t)(t0 + r) * LDP + C_ZB + h * 128 + c8); }
        if (tid < 64) sDL[tid] = ((float*)(F.ws + WS_DL))[((size_t)chunk * 4 + h) * 64 + tid];
        bf16x8 vf[2];
#pragma unroll
        for (int ks = 0; ks < 2; ++ks) {
            unsigned e[8];
#pragma unroll
            for (int j = 0; j < 8; ++j) { const int row = 32 * ks + (j < 4 ? 4 * fq + j : 16 + 4 * fq + (j - 4)); e[j] = ((bf16_t*)(F.ws + WS_P))[(size_t)(t0 + row) * LDP + C_VB + dvc]; }
            u32x4 t; t.x = e[0] | (e[1] << 16); t.y = e[2] | (e[3] << 16); t.z = e[4] | (e[5] << 16); t.w = e[6] | (e[7] << 16);
            vf[ks] = __builtin_bit_cast(bf16x8, t);
        }
        __syncthreads();
        f32x4 o[4];
#pragma unroll
        for (int mt = 0; mt < 4; ++mt) o[mt] = (f32x4){0.f, 0.f, 0.f, 0.f};
#pragma unroll
        for (int ks = 0; ks < 2; ++ks) {
            const bf16x8 sf = mk8(pk4(S[2 * ks]), pk4(S[2 * ks + 1]));
#pragma unroll
            for (int mt = 0; mt < 4; ++mt) {
                o[mt] = MFMA16(ldfragp(QG, 16 * mt + fr, 72, 32 * ks, fq), sf, o[mt]);
                o[mt] = MFMA16(ldfragp(AQ, 16 * mt + fr, 72, 32 * ks, fq), vf[ks], o[mt]);
            }
        }
#pragma unroll
        for (int mt = 0; mt < 4; ++mt) {
#pragma unroll
            for (int j = 0; j < 4; ++j) S[mt][j] *= sDL[16 * mt + 4 * fq + j];
#pragma unroll
            for (int ks = 0; ks < 2; ++ks) S[mt] = MFMA16(ldfragp(KGT, 16 * mt + fr, 72, 32 * ks, fq), vf[ks], S[mt]);
        }
#pragma unroll
        for (int mt = 0; mt < 4; ++mt)
#pragma unroll
            for (int j = 0; j < 4; ++j) {
                float p = o[mt][j] * o[mt][j];
                p += __shfl_xor(p, 1); p += __shfl_xor(p, 2); p += __shfl_xor(p, 4); p += __shfl_xor(p, 8);
                if (fr == 0) RED[(16 * mt + 4 * fq + j) * 8 + w] = p;
            }
        __syncthreads();
#pragma unroll
        for (int mt = 0; mt < 4; ++mt)
#pragma unroll
            for (int j = 0; j < 4; ++j) {
                const int row = 16 * mt + 4 * fq + j;
                const f32x4 r0 = *(const f32x4*)(RED + row * 8), r1 = *(const f32x4*)(RED + row * 8 + 4);
                const float ssum = ((r0[0] + r0[1]) + (r0[2] + r0[3])) + ((r1[0] + r1[1]) + (r1[2] + r1[3]));
                const float rs = rsqrtf(ssum * (1.f / 128.f) + 1e-6f);
                bf16_t* zp = ((bf16_t*)(F.ws + WS_P)) + (size_t)(t0 + row) * LDP + C_ZB + dvc;
                const float z = bf2f(ZZ[row * 136 + 16 * w + fr]);
                if (!F.dry) *zp = (bf16_t)(pk2(o[mt][j] * rs * gn * silu(z), 0.f) & 0xffff);
            }
    }
    float* so = sample ? F.out + O_GLA_S + ((size_t)((l * 8 + (s - 16)) * 4 + h) * 64) * 128 : F.out + O_GLA_P + ((size_t)((l * 16 + s) * 4 + h) * 64) * 128;
#pragma unroll
    for (int mt = 0; mt < 4; ++mt)
#pragma unroll
        for (int j = 0; j < 4; ++j) if (!F.dry) so[(size_t)(16 * mt + 4 * fq + j) * 128 + 16 * w + fr] = S[mt][j];
}

DEV void unpack8(u32x4 u, float (&f)[8]) { f[0] = bflo(u.x); f[1] = bfhi(u.x); f[2] = bflo(u.y); f[3] = bfhi(u.y); f[4] = bflo(u.z); f[5] = bfhi(u.z); f[6] = bflo(u.w); f[7] = bfhi(u.w); }
DEV void load8f(const float* p, float (&f)[8]) { const f32x4 a = *(const f32x4*)p, b = *(const f32x4*)(p + 4); f[0] = a[0]; f[1] = a[1]; f[2] = a[2]; f[3] = a[3]; f[4] = b[0]; f[5] = b[1]; f[6] = b[2]; f[7] = b[3]; }
DEV void ffn_mid(const Frame& F0, int l) {
    REFRAME;
    const float* cw = F.in[29] + (size_t)l * 3 * 5632; const float* cb = F.in[30] + (size_t)l * 5632;
    const bf16_t* halo = ((bf16_t*)(F.ws + WS_KV)); const bf16_t* raw01 = ((bf16_t*)(F.ws + WS_KV + 11714560ull));
    for (int idx = F.bid * 512 + F.tid; idx < 112 * 704; idx += F.nb * 512) {
        const int ti = idx / 704, c4 = (idx % 704) * 4, pm = (ti / 7) * 8 + (ti % 7) + 1;
        const bf16_t* hp = halo + (size_t)(4 * pm - 1) * 2 * 5632; const bf16_t* rp = raw01 + (size_t)pm * 2 * 5632;
        const f32x4 gm2 = unpk4(*(const u32x2*)(hp + c4)), gm1 = unpk4(*(const u32x2*)(hp + 5632 + c4)), g0 = unpk4(*(const u32x2*)(rp + c4)), g1 = unpk4(*(const u32x2*)(rp + 5632 + c4));
        const f32x4 vm2 = unpk4(*(const u32x2*)(hp + 2816 + c4)), vm1 = unpk4(*(const u32x2*)(hp + 5632 + 2816 + c4)), v0 = unpk4(*(const u32x2*)(rp + 2816 + c4)), v1 = unpk4(*(const u32x2*)(rp + 5632 + 2816 + c4));
        const f32x4 wg0 = *(const f32x4*)(cw + c4), wg1 = *(const f32x4*)(cw + 5632 + c4), wg2 = *(const f32x4*)(cw + 2 * 5632 + c4), bg = *(const f32x4*)(cb + c4);
        const f32x4 wv0 = *(const f32x4*)(cw + 2816 + c4), wv1 = *(const f32x4*)(cw + 5632 + 2816 + c4), wv2 = *(const f32x4*)(cw + 2 * 5632 + 2816 + c4), bv = *(const f32x4*)(cb + 2816 + c4);
        f32x4 o0, o1;
#pragma unroll
        for (int j = 0; j < 4; ++j) {
            const float yg0 = wg0[j] * gm2[j] + wg1[j] * gm1[j] + wg2[j] * g0[j] + bg[j], yv0 = wv0[j] * vm2[j] + wv1[j] * vm1[j] + wv2[j] * v0[j] + bv[j];
            const float yg1 = wg0[j] * gm1[j] + wg1[j] * g0[j] + wg2[j] * g1[j] + bg[j], yv1 = wv0[j] * vm1[j] + wv1[j] * v0[j] + wv2[j] * v1[j] + bv[j];
            o0[j] = silu(yg0) * yv0; o1[j] = silu(yg1) * yv1;
        }
        bf16_t* vp = ((bf16_t*)(F.ws + WS_P)) + (size_t)pm * 256 * LDP + c4;
        *(u32x2*)vp = pk4(o0); *(u32x2*)(vp + LDP) = pk4(o1);
    }
}

DEV void final_norm(const Frame& F0) {
    REFRAME;
    const int gw = F.bid * 8 + F.wid, nw = F.nb * 8, lane = F.lane;
    const float* g = F.in[32];
    for (int row = gw; row < TT; row += nw) {
        const float rs = row_rstd(((float*)(F.ws + WS_SSQ)), row);
        float* X = F.out + (size_t)row * 1024;
#pragma unroll
        for (int i = 0; i < 4; ++i) { const int cidx = i * 256 + lane * 4; f32x4 v = *(const f32x4*)(X + cidx); const f32x4 gg = *(const f32x4*)(g + cidx); *(f32x4*)(X + cidx) = v * rs * gg; }
    }
}

#ifdef DBG_COL
DEV void dbg_dump(const Frame& F0) {
    REFRAME;
    for (int i = F.bid * 512 + F.tid; i < TT * 256; i += F.nb * 512) {
        const int row = i >> 8, c = (i & 255) * 4;
        const f32x4 v = c < 512 ? unpk4(*(const u32x2*)(((bf16_t*)(F.ws + WS_P)) + (size_t)row * LDP + DBG_COL + c)) : (f32x4){0.f, 0.f, 0.f, 0.f};
        *(f32x4*)(F.out + (size_t)row * 1024 + c) = (row DBG_ROWSEL) ? v : (f32x4){0.f, 0.f, 0.f, 0.f};
    }
}
#endif
#define XB_TMO      128
#define XB_XCNT(j)  (256  + 64 * (j))
#define XB_XSUB(j)  (1280 + 64 * (j))
#define XB_XGEN(j)  (2304 + 64 * (j))
#define XB_TOP      3328
#define XB_TOPGEN   3392
#define XCD_BAR_WORDS 3456
#define XB_SPIN_CAP (1u << 18)
#define LAS __attribute__((address_space(3)))

__device__ __forceinline__ unsigned xb_ld(unsigned* p)              { return __hip_atomic_load(p, __ATOMIC_RELAXED, __HIP_MEMORY_SCOPE_AGENT); }
__device__ __forceinline__ unsigned xb_add(unsigned* p, unsigned v) { return __hip_atomic_fetch_add(p, v, __ATOMIC_RELAXED, __HIP_MEMORY_SCOPE_AGENT); }
__device__ __forceinline__ unsigned xb_xcc_id() { return (unsigned)__builtin_amdgcn_s_getreg((3 << 11) | 20) & 0xFu; }
#define XB_SPIN(cond, bar) do { unsigned _sp = 0; while (cond) { __builtin_amdgcn_s_sleep(1); \
    if ((++_sp & 255u) == 0u) { if (xb_ld(&(bar)[XB_TMO])) break; if (_sp > XB_SPIN_CAP) { atomicAdd(&(bar)[XB_TMO], 1u); break; } } } } while (0)

struct XcdBarrier {
    unsigned* bar; unsigned x;
    volatile LAS unsigned* st;
};

__device__ __forceinline__ XcdBarrier xcd_barrier_post(unsigned* bar, volatile LAS unsigned* st) {
    XcdBarrier b; b.bar = bar; b.x = xb_xcc_id(); b.st = st;
    if (threadIdx.x == 0) (void)xb_add(&bar[XB_XCNT(b.x)], 1u);
    return b;
}
__device__ __forceinline__ void xcd_barrier_complete(unsigned* bar, unsigned x, unsigned& nloc, unsigned& nx) {
    const unsigned G = gridDim.x * gridDim.y * gridDim.z;
    unsigned sum, cnt, mine, sp = 0u;
    for (;;) {
        sum = 0u; cnt = 0u; mine = 0u;
#pragma unroll
        for (unsigned j = 0; j < 16; ++j) { const unsigned c = xb_ld(&bar[XB_XCNT(j)]); sum += c; cnt += (c > 0u) ? 1u : 0u; mine = (j == x) ? c : mine; }
        if (sum == G) break;
        __builtin_amdgcn_s_sleep(1);
        if ((++sp & 255u) == 0u) { if (xb_ld(&bar[XB_TMO])) break; if (sp > XB_SPIN_CAP) { atomicAdd(&bar[XB_TMO], 1u); break; } }
    }
    nloc = mine > 0u ? mine : 1u; nx = cnt > 0u ? cnt : 1u;
}

__device__ __forceinline__ void xcd_barrier(const XcdBarrier& b) {
    asm volatile("s_waitcnt vmcnt(0)" ::: "memory");
    __syncthreads();
    if (threadIdx.x == 0) {
        unsigned* bar = b.bar;
        __builtin_amdgcn_s_waitcnt(0);
        unsigned nloc = b.st[0], nx = b.st[1];
        if (nloc == 0u) { xcd_barrier_complete(bar, b.x, nloc, nx); b.st[0] = nloc; b.st[1] = nx; }
        const unsigned old = xb_add(&bar[XB_XSUB(b.x)], 1u);
        const unsigned gen = old / nloc;
        if (old + 1u == (gen + 1u) * nloc) {
            __builtin_amdgcn_fence(__ATOMIC_RELEASE, "agent");
            asm volatile("s_waitcnt vmcnt(0)" ::: "memory");
            const unsigned og = xb_add(&bar[XB_TOP], 1u);
            const unsigned tg = og / nx;
            if (og + 1u == (tg + 1u) * nx) xb_add(&bar[XB_TOPGEN], 1u);
            else XB_SPIN(xb_ld(&bar[XB_TOPGEN]) == tg, bar);
            __builtin_amdgcn_fence(__ATOMIC_ACQUIRE, "agent");
            xb_add(&bar[XB_XGEN(b.x)], 1u);
            asm volatile("s_waitcnt vmcnt(0)" ::: "memory");
        } else {
            XB_SPIN(xb_ld(&bar[XB_XGEN(b.x)]) == gen, bar);
            __builtin_amdgcn_fence(__ATOMIC_ACQUIRE, "agent");
            asm volatile("s_waitcnt vmcnt(0)" ::: "memory");
        }
    }
    __syncthreads();
}

__global__ void __launch_bounds__(512, 2) fwd_kernel(Params p) {
    extern __shared__ __attribute__((aligned(16))) unsigned char lds[];
    cg::grid_group grid = cg::this_grid();
    Frame F;
    F.in = (InTab)__builtin_amdgcn_kernarg_segment_ptr(); F.out = p.out; F.ws = p.ws; F.lds = lds;
    F.tid = threadIdx.x; F.lane = threadIdx.x & 63; F.wid = __builtin_amdgcn_readfirstlane(threadIdx.x >> 6); F.nb = gridDim.x; F.bid = blockIdx.x; F.dry = 0; F.cb = blockIdx.x; F.cn = gridDim.x;
    volatile LAS unsigned* xst = (volatile LAS unsigned*)(lds + LDS_BYTES - 16);
    if (threadIdx.x == 0) { xst[0] = 0u; xst[1] = 0u; }
    __syncthreads();
    const XcdBarrier xbar = xcd_barrier_post((unsigned*)(p.ws + WS_BAR), xst);
    for (int ph = p.ph_lo; ph < p.ph_hi; ++ph) {
        if (gridDim.x == 256 && ph > 0 && ph < NPH - 1 && ((ph - 1) % 13) == 4) continue;
#ifndef PHM
#define PHM 0xffff
#endif
        if (ph == 0) { if (PHM & 0x1000) phase0(F); }
        else if (ph == NPH - 1) { if (PHM & 0x2000) final_norm(F); }
        else {
            const int l = (ph - 1) / 13, k = (ph - 1) % 13;
            int gk = -1;
            if (k == 2 && gridDim.x == 256) gk = GP_MEMKV;
            switch (k) { case 0: gk = GP_IN; break; case 3: gk = GP_OUT; break; case 4: gk = GP_OUT2; break; case 5: gk = GP_WO; break; case 6: gk = GP_MQ; break; case 7: gk = GP_ATTN; break; case 8: gk = GP_ATTN2; break;
                         case 9: gk = GP_MO; break; case 10: gk = GP_UP; break; case 12: gk = GP_DOWN; break; default: break; }
#ifndef REPMASK
#define REPMASK 0
#endif
            if (gk >= 0 && (PHM & 1)) { const int nrep = ((REPMASK >> k) & 1) ? 2 : 1; for (int rep = 0; rep < nrep; ++rep) gemm_phase(F, gk, l); }
            if (k == 0 && (PHM & 1)) small_proj(F);
            if (k == (gridDim.x == 256 ? 2 : 3) && (PHM & 8)) sample_kv(F, l);
            if (gridDim.x == 256 && k == 2 && blockIdx.x >= 128) { Frame G = F; G.cb = (int)blockIdx.x - 128; G.cn = 128; __syncthreads(); cvt_ffn(G, l); }
            if (gridDim.x == 256 && k == 10 && l < 3 && (blockIdx.x >> 3) >= 6) { Frame G = F; G.cb = (((int)blockIdx.x >> 3) - 6) * 8 + ((int)blockIdx.x & 7); G.cn = 208; __syncthreads(); cvt_mixer(G, l + 1); }
#ifndef DRYMASK
#define DRYMASK 0
#endif
            for (int dr = ((DRYMASK >> k) & 1); dr >= 0; --dr) {
            F.dry = dr;
            if (k == 1 && (PHM & 2)) {
                for (int it = F.bid; it < NCH * 8; it += F.nb) { const int c = it >> 3, h = it & 3; if (it & 4) g1_gla(F, l, c, h); else g1_gdn(F, l, c, h); }
                __syncthreads();
                if (l > 0 && !dr && F.nb != 256) cvt_ffn(F, l);
            }
            if (k == 2 && (PHM & 4)) {
                for (int it = F.bid; it < 192; it += F.nb) {
                    int s, h, br;
                    if (it < 128) { br = it & 1; h = (it >> 1) & 3; s = it >> 3; } else { const int v = it - 128; br = v & 1; h = (v >> 1) & 3; s = 16 + (v >> 3); }
                    if (br) g2_gla(F, l, s, h); else g2_gdn(F, l, s, h);
                    __syncthreads();
                }
            }
            if (k == 11 && (PHM & 0x200)) { ffn_mid(F, l); if (l < 3 && !dr && F.nb != 256) { __syncthreads(); cvt_mixer(F, l + 1); } }
            }
            F.dry = 0;
        }
#ifndef SYNCREP
#define SYNCREP 1
#endif
        if (ph + 1 < p.ph_hi) {
            if (ph == 0) grid.sync();
            else xcd_barrier(xbar);
        }
    }
#ifdef DBG_COL
    __threadfence(); grid.sync(); __threadfence();
    dbg_dump(F);
#endif
}

extern "C" void kernel_launch(void* const* d_in, const int* in_sizes, int n_in, void* d_out, int out_size, void* d_ws, size_t ws_size, hipStream_t stream) {
    static int grid_blocks = 0;
    if (grid_blocks == 0) {
        if (n_in != 33 || ws_size < WS_TOTAL) { fprintf(stderr, "kernel_launch: bad n_in %d or ws %zu < %zu\n", n_in, ws_size, (size_t)WS_TOTAL); grid_blocks = -1; return; }
        int dev = 0, cus = 0, per_cu = 0;
        hipGetDevice(&dev);
        hipDeviceGetAttribute(&cus, hipDeviceAttributeMultiprocessorCount, dev);
        if (hipFuncSetAttribute((const void*)fwd_kernel, hipFuncAttributeMaxDynamicSharedMemorySize, LDS_BYTES) != hipSuccess) { fprintf(stderr, "hipFuncSetAttribute failed\n"); grid_blocks = -1; return; }
        hipOccupancyMaxActiveBlocksPerMultiprocessor(&per_cu, (const void*)fwd_kernel, 512, LDS_BYTES);
        if (per_cu < 1) per_cu = 1;
        (void)hipGetLastError();
        grid_blocks = cus * 1;
        if (grid_blocks <= 0) grid_blocks = 256;
    }
    if (grid_blocks < 0) return;
    Params p{};
    for (int i = 0; i < 33; ++i) p.in[i] = (const float*)d_in[i];
    p.out = (float*)d_out; p.ws = (unsigned char*)d_ws; p.ph_lo = 0; p.ph_hi = PH_HI;
    (void)hipMemsetAsync((unsigned char*)d_ws + WS_BAR, 0, 16384, stream);
    void* args[] = {&p};
    hipError_t e = hipLaunchCooperativeKernel((const void*)fwd_kernel, dim3(grid_blocks), dim3(512), args, LDS_BYTES, stream);
    if (e != hipSuccess) fprintf(stderr, "cooperative launch failed: %s (grid %d)\n", hipGetErrorString(e), grid_blocks);
}
```
